# Optimizing an MI355X kernel written in HIP

```python
import jax, jax.numpy as jnp
from jax import lax
import numpy as np

D_MODEL = 1024
BATCH = 8
SEQ = 4096
DEPTH = 1

GRID_W = 64
CTX_LEN = 256
HEAD_DIM = 64
N_HEADS_A = 8
N_KV_A = 2
GQA_GROUP = N_HEADS_A // N_KV_A
N_HEADS_B = 8
WIDTH_A = N_HEADS_A * HEAD_DIM
WIDTH_KV_A = N_KV_A * HEAD_DIM
WIDTH_B = N_HEADS_B * HEAD_DIM
MIX_WIDTH = WIDTH_A + WIDTH_B
IN_WIDTH = WIDTH_A + 2 * WIDTH_KV_A + 3 * WIDTH_B
WINDOW = 128
BLOCK_A = 128
NA_ROWS = 8
NA_COLS = 16
NA_Q_COLS = 16
NA_K_COLS = 32
N_EXPERTS = 32
TOP_K = 4
D_FF_EXPERT = D_MODEL
SWIGLU_LIMIT = 7.0
SWIGLU_ALPHA = 1.702
MOE_BLOCK = 128
ROPE_BASE = 10000.0
EPS = 1e-6
NEG_INF = -1e30

kernel_name = 'hybrid_window_natten_moe_dit_block'


def rmsnorm(x, g):
    xf = x.astype(jnp.float32)
    y = xf * lax.rsqrt(jnp.mean(xf * xf, axis=-1, keepdims=True) + EPS)
    return (y * g.astype(jnp.float32)).astype(x.dtype)


def modulate(x, shift, scale):
    return x * (1 + scale) + shift


def rope_1d(x, ang):
    n = x.shape[-1] // 2
    x1, x2 = x[..., :n], x[..., n:]
    cos = jnp.cos(ang)[:, None, :]
    sin = jnp.sin(ang)[:, None, :]
    return jnp.concatenate([x1 * cos - x2 * sin, x2 * cos + x1 * sin], axis=-1)


def axial_rope(x, ang_row, ang_col):
    half = HEAD_DIM // 2
    xf = x.astype(jnp.float32)
    out = jnp.concatenate([rope_1d(xf[..., :half], ang_row), rope_1d(xf[..., half:], ang_col)], axis=-1)
    return out.astype(x.dtype)


def split_projection(p):
    B, T, _ = p.shape
    cuts = [WIDTH_A, WIDTH_A + WIDTH_KV_A, WIDTH_A + 2 * WIDTH_KV_A,
            WIDTH_A + 2 * WIDTH_KV_A + WIDTH_B, WIDTH_A + 2 * WIDTH_KV_A + 2 * WIDTH_B]
    qa, ka, va, qb, kb, vb = jnp.split(p, cuts, axis=-1)
    qa = qa.reshape(B, T, N_HEADS_A, HEAD_DIM)
    ka = ka.reshape(B, T, N_KV_A, HEAD_DIM)
    va = va.reshape(B, T, N_KV_A, HEAD_DIM)
    qb = qb.reshape(B, T, N_HEADS_B, HEAD_DIM)
    kb = kb.reshape(B, T, N_HEADS_B, HEAD_DIM)
    vb = vb.reshape(B, T, N_HEADS_B, HEAD_DIM)
    return qa, ka, va, qb, kb, vb


def window_attention(q, k, v, kc, vc, sink):
    B, L = q.shape[:2]
    C = kc.shape[1]
    nb = L // BLOCK_A
    span = BLOCK_A + 2 * WINDOW
    scale = HEAD_DIM ** -0.5
    kp = jnp.pad(k, ((0, 0), (WINDOW, WINDOW), (0, 0), (0, 0)))
    vp = jnp.pad(v, ((0, 0), (WINDOW, WINDOW), (0, 0), (0, 0)))
    qb = q.reshape(B, nb, BLOCK_A, N_KV_A, GQA_GROUP, HEAD_DIM)
    r = jnp.arange(BLOCK_A)
    j = jnp.arange(span)
    band = jnp.abs(j[None, :] - WINDOW - r[:, None]) <= WINDOW
    sink_g = sink.astype(jnp.float32).reshape(N_KV_A, GQA_GROUP)[None, :, :, None, None]

    def block(i):
        qi = lax.dynamic_index_in_dim(qb, i, axis=1, keepdims=False)
        ki = lax.dynamic_slice_in_dim(kp, i * BLOCK_A, span, axis=1)
        vi = lax.dynamic_slice_in_dim(vp, i * BLOCK_A, span, axis=1)
        kpos = i * BLOCK_A - WINDOW + j
        valid = band & (kpos >= 0)[None, :] & (kpos < L)[None, :]
        s_loc = jnp.einsum('bqkgd,bskd->bkgqs', qi, ki, preferred_element_type=jnp.float32) * scale
        s_loc = jnp.where(valid, s_loc, NEG_INF)
        s_ctx = jnp.einsum('bqkgd,bckd->bkgqc', qi, kc, preferred_element_type=jnp.float32) * scale
        s_sink = jnp.broadcast_to(sink_g, s_ctx.shape[:-1] + (1,))
        p = jax.nn.softmax(jnp.concatenate([s_loc, s_ctx, s_sink], axis=-1), axis=-1)
        p_loc = p[..., :span].astype(v.dtype)
        p_ctx = p[..., span:span + C].astype(v.dtype)
        o = jnp.einsum('bkgqs,bskd->bqkgd', p_loc, vi) + jnp.einsum('bkgqc,bckd->bqkgd', p_ctx, vc)
        return o.reshape(B, BLOCK_A, WIDTH_A)

    out = lax.map(block, jnp.arange(nb))
    return jnp.moveaxis(out, 0, 1).reshape(B, L, WIDTH_A)


def neighbourhood_attention(q, k, v, kc, vc, rpb):
    B, L = q.shape[:2]
    rows_n = L // GRID_W
    kr = min(NA_ROWS, rows_n)
    scale = HEAD_DIM ** -0.5
    qg = q.reshape(B, rows_n, GRID_W, N_HEADS_B, HEAD_DIM)
    kg = k.reshape(B, rows_n, GRID_W, N_HEADS_B, HEAD_DIM)
    vg = v.reshape(B, rows_n, GRID_W, N_HEADS_B, HEAD_DIM)
    n_cb = GRID_W // NA_Q_COLS
    qcol = np.arange(GRID_W)
    col_start = np.clip(qcol - NA_COLS // 2, 0, GRID_W - NA_COLS).reshape(n_cb, NA_Q_COLS)
    blk_start = np.clip(np.arange(n_cb) * NA_Q_COLS - NA_COLS // 2, 0, GRID_W - NA_K_COLS)
    key_cols = blk_start[:, None] + np.arange(NA_K_COLS)
    qcols = qcol.reshape(n_cb, NA_Q_COLS)
    kc3 = key_cols[:, None, :]
    cs3 = col_start[:, :, None]
    col_ok = (kc3 >= cs3) & (kc3 < cs3 + NA_COLS)
    dcol_idx = np.clip(kc3 - qcols[:, :, None] + NA_COLS - 1, 0, 2 * NA_COLS - 2)
    mask = jnp.asarray(col_ok)[:, :, None, :]

    def row_block(r):
        rs = jnp.clip(r - kr // 2, 0, rows_n - kr)
        qr = lax.dynamic_index_in_dim(qg, r, axis=1, keepdims=False).reshape(B, n_cb, NA_Q_COLS, N_HEADS_B, HEAD_DIM)
        k_rows = lax.dynamic_slice_in_dim(kg, rs, kr, axis=1)
        v_rows = lax.dynamic_slice_in_dim(vg, rs, kr, axis=1)
        kblk = k_rows[:, :, key_cols]
        vblk = v_rows[:, :, key_cols]
        drow_idx = rs - r + jnp.arange(kr) + NA_ROWS - 1
        bias = rpb[:, drow_idx][:, :, dcol_idx].astype(jnp.float32)
        bias = jnp.transpose(bias, (0, 2, 3, 1, 4))
        s = jnp.einsum('bnqhd,banchd->bhnqac', qr, kblk, preferred_element_type=jnp.float32) * scale + bias[None]
        s = jnp.where(mask, s, NEG_INF).reshape(B, N_HEADS_B, n_cb, NA_Q_COLS, kr * NA_K_COLS)
        s_ctx = jnp.einsum('bnqhd,bchd->bhnqc', qr, kc, preferred_element_type=jnp.float32) * scale
        p = jax.nn.softmax(jnp.concatenate([s, s_ctx], axis=-1), axis=-1)
        n_loc = kr * NA_K_COLS
        p_loc = p[..., :n_loc].reshape(B, N_HEADS_B, n_cb, NA_Q_COLS, kr, NA_K_COLS).astype(v.dtype)
        p_ctx = p[..., n_loc:].astype(v.dtype)
        o = jnp.einsum('bhnqac,banchd->bnqhd', p_loc, vblk) + jnp.einsum('bhnqc,bchd->bnqhd', p_ctx, vc)
        return o.reshape(B, GRID_W, WIDTH_B)

    out = lax.map(row_block, jnp.arange(rows_n))
    return jnp.moveaxis(out, 0, 1).reshape(B, L, WIDTH_B)


def context_attention(q, k, v, sink):
    B, C, Hq, _ = q.shape
    Hkv = k.shape[2]
    G = Hq // Hkv
    qg = q.reshape(B, C, Hkv, G, HEAD_DIM)
    s = jnp.einsum('bqkgd,bckd->bkgqc', qg, k, preferred_element_type=jnp.float32) * HEAD_DIM ** -0.5
    if sink is not None:
        sink_g = sink.astype(jnp.float32).reshape(Hkv, G)[None, :, :, None, None]
        s = jnp.concatenate([s, jnp.broadcast_to(sink_g, s.shape[:-1] + (1,))], axis=-1)
    p = jax.nn.softmax(s, axis=-1)[..., :C].astype(v.dtype)
    o = jnp.einsum('bkgqc,bckd->bqkgd', p, v)
    return o.reshape(B, C, Hq * HEAD_DIM)


def moe_ffn(h, w_router, b_router, w1, b1, w2, b2):
    B, T, D = h.shape
    n_tok = B * T
    t = h.reshape(n_tok, D)
    logits = jnp.dot(t, w_router, preferred_element_type=jnp.float32) + b_router.astype(jnp.float32)
    top_val, top_idx = lax.top_k(logits, TOP_K)
    top_w = jax.nn.softmax(top_val, axis=-1)
    n_assign = n_tok * TOP_K
    flat_e = top_idx.reshape(-1)
    flat_tok = jnp.repeat(jnp.arange(n_tok, dtype=jnp.int32), TOP_K)
    flat_w = top_w.reshape(-1)
    order = jnp.argsort(flat_e)
    sorted_e = flat_e[order]
    counts = jnp.bincount(flat_e, length=N_EXPERTS)
    padded = (counts + MOE_BLOCK - 1) // MOE_BLOCK * MOE_BLOCK
    pad_end = jnp.cumsum(padded)
    pad_start = pad_end - padded
    grp_start = jnp.cumsum(counts) - counts
    dest = pad_start[sorted_e] + (jnp.arange(n_assign) - grp_start[sorted_e])
    n_blocks = -(-n_assign // MOE_BLOCK) + N_EXPERTS
    n_rows = n_blocks * MOE_BLOCK
    row_tok = jnp.zeros((n_rows,), jnp.int32).at[dest].set(flat_tok[order])
    row_w = jnp.zeros((n_rows,), jnp.float32).at[dest].set(flat_w[order])
    blk_expert = jnp.minimum(jnp.searchsorted(pad_end, jnp.arange(n_blocks) * MOE_BLOCK, side='right'), N_EXPERTS - 1)

    def expert_block(args):
        idx, e = args
        xb = t[idx]
        hu = xb @ w1[e] + b1[e]
        glu = jnp.minimum(hu[:, 0::2], SWIGLU_LIMIT)
        lin = jnp.clip(hu[:, 1::2], -SWIGLU_LIMIT, SWIGLU_LIMIT)
        act = glu * jax.nn.sigmoid(SWIGLU_ALPHA * glu) * (lin + 1)
        return act @ w2[e] + b2[e]

    y = lax.map(expert_block, (row_tok.reshape(n_blocks, MOE_BLOCK), blk_expert))
    y = y.reshape(n_rows, D) * row_w[:, None].astype(y.dtype)
    out = jax.ops.segment_sum(y, row_tok, num_segments=n_tok)
    return out.reshape(B, T, D)


def setup_inputs(seed: int = 0) -> dict:
    key = jax.random.key(seed)
    ks = jax.random.split(key, 22)
    f32 = jnp.float32

    def nrm(k, shape, s):
        return jax.random.normal(k, shape, f32) * s

    def gain(k, shape):
        return 1.0 + 0.05 * jax.random.normal(k, shape, f32)

    return {
        'x': nrm(ks[0], (BATCH, SEQ, D_MODEL), 1.0),
        'c': nrm(ks[1], (BATCH, D_MODEL), 1.0),
        'ctx': nrm(ks[2], (BATCH, CTX_LEN, D_MODEL), 1.0),
        'c_ctx': nrm(ks[3], (D_MODEL,), 1.0),
        'w_ada': nrm(ks[4], (DEPTH, D_MODEL, 6 * D_MODEL), 0.5 * D_MODEL ** -0.5),
        'b_ada': nrm(ks[5], (DEPTH, 6 * D_MODEL), 0.01),
        'g_pre_mix': gain(ks[6], (DEPTH, D_MODEL)),
        'g_post_mix': gain(ks[7], (DEPTH, D_MODEL)),
        'g_pre_ffn': gain(ks[8], (DEPTH, D_MODEL)),
        'g_post_ffn': gain(ks[9], (DEPTH, D_MODEL)),
        'w_in': nrm(ks[10], (DEPTH, D_MODEL, IN_WIDTH), D_MODEL ** -0.5),
        'g_grp_a': gain(ks[11], (DEPTH, WIDTH_A)),
        'g_grp_b': gain(ks[12], (DEPTH, WIDTH_B)),
        'sink_a': nrm(ks[13], (DEPTH, N_HEADS_A), 0.5),
        'rpb_b': nrm(ks[14], (DEPTH, N_HEADS_B, 2 * NA_ROWS - 1, 2 * NA_COLS - 1), 0.2),
        'w_out': nrm(ks[15], (DEPTH, MIX_WIDTH, D_MODEL), MIX_WIDTH ** -0.5),
        'w_router': nrm(ks[16], (DEPTH, D_MODEL, N_EXPERTS), D_MODEL ** -0.5),
        'b_router': nrm(ks[17], (DEPTH, N_EXPERTS), 0.01),
        'w_mlp1': nrm(ks[18], (DEPTH, N_EXPERTS, D_MODEL, 2 * D_FF_EXPERT), D_MODEL ** -0.5),
        'b_mlp1': nrm(ks[19], (DEPTH, N_EXPERTS, 2 * D_FF_EXPERT), 0.01),
        'w_mlp2': nrm(ks[20], (DEPTH, N_EXPERTS, D_FF_EXPERT, D_MODEL), D_FF_EXPERT ** -0.5),
        'b_mlp2': nrm(ks[21], (DEPTH, N_EXPERTS, D_MODEL), 0.01),
    }


def reference(x, c, ctx, c_ctx, w_ada, b_ada, g_pre_mix, g_post_mix, g_pre_ffn, g_post_ffn,
              w_in, g_grp_a, g_grp_b, sink_a, rpb_b, w_out, w_router, b_router,
              w_mlp1, b_mlp1, w_mlp2, b_mlp2):
    B, L, _ = x.shape
    pos = jnp.arange(L)
    rows = (pos // GRID_W).astype(jnp.float32)
    cols = (pos % GRID_W).astype(jnp.float32)
    n_freq = HEAD_DIM // 4
    freqs = ROPE_BASE ** (-jnp.arange(n_freq, dtype=jnp.float32) / n_freq)
    ang_row = rows[:, None] * freqs[None, :]
    ang_col = cols[:, None] * freqs[None, :]

    for layer in range(DEPTH):
        mod = (jax.nn.silu(c) @ w_ada[layer] + b_ada[layer])[:, None, :]
        mod_c = jax.nn.silu(c_ctx) @ w_ada[layer] + b_ada[layer]
        sh1, sc1, ga1, sh2, sc2, ga2 = jnp.split(mod, 6, axis=-1)
        csh1, csc1, cga1, csh2, csc2, cga2 = jnp.split(mod_c, 6, axis=-1)

        h = modulate(rmsnorm(x, g_pre_mix[layer]), sh1, sc1)
        hc = modulate(rmsnorm(ctx, g_pre_mix[layer]), csh1, csc1)
        qa, ka, va, qb, kb, vb = split_projection(h @ w_in[layer])
        qac, kac, vac, qbc, kbc, vbc = split_projection(hc @ w_in[layer])
        qa = axial_rope(qa, ang_row, ang_col)
        ka = axial_rope(ka, ang_row, ang_col)
        oa = window_attention(qa, ka, va, kac, vac, sink_a[layer])
        ob = neighbourhood_attention(qb, kb, vb, kbc, vbc, rpb_b[layer])
        mix = jnp.concatenate([rmsnorm(oa, g_grp_a[layer]), rmsnorm(ob, g_grp_b[layer])], axis=-1) @ w_out[layer]
        x = x + ga1 * rmsnorm(mix, g_post_mix[layer])

        h2 = modulate(rmsnorm(x, g_pre_ffn[layer]), sh2, sc2)
        y = moe_ffn(h2, w_router[layer], b_router[layer], w_mlp1[layer], b_mlp1[layer], w_mlp2[layer], b_mlp2[layer])
        x = x + ga2 * rmsnorm(y, g_post_ffn[layer])

        if layer < DEPTH - 1:
            oac = context_attention(qac, kac, vac, sink_a[layer])
            obc = context_attention(qbc, kbc, vbc, None)
            mixc = jnp.concatenate([rmsnorm(oac, g_grp_a[layer]), rmsnorm(obc, g_grp_b[layer])], axis=-1) @ w_out[layer]
            ctx = ctx + cga1 * rmsnorm(mixc, g_post_mix[layer])
            h2c = modulate(rmsnorm(ctx, g_pre_ffn[layer]), csh2, csc2)
            yc = moe_ffn(h2c, w_router[layer], b_router[layer], w_mlp1[layer], b_mlp1[layer], w_mlp2[layer], b_mlp2[layer])
            ctx = ctx + cga2 * rmsnorm(yc, g_post_ffn[layer])
    return x
```

```cpp
#include <hip/hip_runtime.h>
#include <hip/hip_cooperative_groups.h>
#include <cstdio>
#include <cstdint>
namespace cg = cooperative_groups;

constexpr int D = 1024, NB = 8, L = 4096, CTX = 256;
constexpr int NTOK = NB * L, NCTX = NB * CTX, MROWS = NTOK + NCTX;
constexpr int INW = 2304;
constexpr int C_QA = 0, C_KA = 512, C_VA = 640, C_QB = 768, C_KB = 1280, C_VB = 1792;
constexpr int NE = 32, TOPK = 4, NASG = NTOK * TOPK;
constexpr int PADROWS = NASG + NE * 256;
constexpr float LOG2E = 1.4426950408889634f;
constexpr float QSCALE = 0.125f * LOG2E;
constexpr float EPS = 1e-6f;
constexpr int NTHREADS = 512;

constexpr size_t MiB = 1u << 20;
constexpr size_t WS_CTL = 0;
constexpr size_t CTL_BYTES = 4096;
constexpr size_t WS_MOD = 1 * MiB;
constexpr size_t WS_TAB = 1 * MiB + 256 * 1024;
constexpr size_t WS_OSTAT = 1 * MiB + 512 * 1024;
constexpr size_t WS_WIN = 2 * MiB;
constexpr size_t WS_WOUT = 7 * MiB;
constexpr size_t WS_W2 = 9 * MiB;
constexpr size_t WS_W1 = 73 * MiB;
constexpr size_t WS_HB = 201 * MiB;
constexpr size_t WS_TOPE = 269 * MiB;
constexpr size_t WS_TOPR = WS_TOPE + NASG * 4;
constexpr size_t WS_TOPW = WS_TOPR + NASG * 4;
constexpr size_t WS_ROWTOK = 271 * MiB;
constexpr size_t WS_ROWSLOT = WS_ROWTOK + PADROWS * 4;
constexpr size_t WS_ROWW = WS_ROWSLOT + PADROWS * 4;
constexpr size_t WS_QKV = 273 * MiB;
constexpr size_t WS_O = 426 * MiB;
constexpr size_t WS_MIX = 490 * MiB;
constexpr size_t WS_ACT = 273 * MiB;
constexpr size_t WS_Y = 618 * MiB;
constexpr size_t WS_END = 874 * MiB;
static_assert(WS_ROWW + PADROWS * 4 <= WS_QKV, "map");
static_assert(WS_QKV + (size_t)MROWS * INW * 2 <= WS_O, "map");
static_assert(WS_ACT + (size_t)PADROWS * 1024 * 2 <= WS_Y, "map");

typedef unsigned short bf16_t;
typedef float f32x4 __attribute__((ext_vector_type(4)));
typedef unsigned u32x4 __attribute__((ext_vector_type(4)));
typedef unsigned u32x2 __attribute__((ext_vector_type(2)));

struct Params {
    const float *x, *c, *ctx, *c_ctx, *w_ada, *b_ada, *g_pre_mix, *g_post_mix, *g_pre_ffn, *g_post_ffn, *w_in, *g_grp_a, *g_grp_b,
        *sink_a, *rpb_b, *w_out, *w_router, *b_router, *w_mlp1, *b_mlp1, *w_mlp2, *b_mlp2;
    float* out;
    unsigned char* ws;
};

__device__ __forceinline__ float bf2f(bf16_t h) { return __uint_as_float((unsigned)h << 16); }
__device__ __forceinline__ unsigned f2bf(float f) { unsigned u = __float_as_uint(f); return (u + 0x7fffu + ((u >> 16) & 1u)) >> 16; }
__device__ __forceinline__ unsigned pk2(float lo, float hi) { return f2bf(lo) | (f2bf(hi) << 16); }
__device__ __forceinline__ float wave_sum(float v) {
#pragma unroll
    for (int o = 1; o < 64; o <<= 1) v += __shfl_xor(v, o);
    return v;
}

__device__ void p0_mod(const Params& p, int gtid, int gsize) {
    float* mod = (float*)(p.ws + WS_MOD);
    for (int idx = gtid; idx < 9 * 6144; idx += gsize) {
        const int r = idx / 6144, j = idx % 6144;
        const float* cv = r < 8 ? p.c + r * D : p.c_ctx;
        float acc = p.b_ada[j];
        for (int k = 0; k < D; ++k) { const float cc = cv[k]; acc += (cc / (1.f + __expf(-cc))) * p.w_ada[(size_t)k * 6144 + j]; }
        mod[idx] = acc;
    }
}
__device__ void p0_tab(const Params& p, int gtid, int gsize) {
    float* tab = (float*)(p.ws + WS_TAB);
    for (int idx = gtid; idx < 64 * 16; idx += gsize) {
        const int pos = idx >> 4, i = idx & 15;
        const float freq = exp2f(-(float)i * (13.287712379549449f / 16.f));
        const float ang = (float)pos * freq;
        const float n = rintf(ang * 0.15915494309189535f);
        float r = fmaf(-n, 6.28125f, ang); r = fmaf(-n, 1.9353071795864769e-3f, r);
        tab[idx * 2] = __cosf(r); tab[idx * 2 + 1] = __sinf(r);
    }
}
template <int MODE>
__device__ void transpose_tile(const float* src, int K, int N, bf16_t* dst, int tk, int tn, float* sT, const float* gA, const float* gB) {
    const int tid = threadIdx.x, k0 = tk * 64, n0 = tn * 64;
#pragma unroll
    for (int i = 0; i < 8; ++i) {
        const int e = tid + NTHREADS * i, kl = e >> 6, cc = e & 63;
        float v = src[(size_t)(k0 + kl) * N + n0 + cc];
        int nl = cc;
        if (MODE == 1) { const int f = cc >> 1, n = cc & 1; nl = 32 * (f >> 4) + 16 * n + (f & 15); }
        if (MODE == 2) { const int k = k0 + kl; v *= (k < 512 ? gA[k] : gB[k - 512]); }
        sT[nl * 65 + kl] = v;
    }
    __syncthreads();
    {
        const int nl = tid >> 3, ch = tid & 7; const float* s = sT + nl * 65 + ch * 8;
        u32x4 o; o.x = pk2(s[0], s[1]); o.y = pk2(s[2], s[3]); o.z = pk2(s[4], s[5]); o.w = pk2(s[6], s[7]);
        *(u32x4*)(dst + (size_t)(n0 + nl) * K + k0 + ch * 8) = o;
    }
    __syncthreads();
}
__device__ void p0_weights(const Params& p, float* sT) {
    constexpr int I_IN = 16 * 36, I_OUT = 16 * 16, I_W1 = 16 * 32, I_W2 = 16 * 16;
    constexpr int NITEMS = I_IN + I_OUT + NE * I_W1 + NE * I_W2;
    for (int it = blockIdx.x; it < NITEMS; it += gridDim.x) {
        int r = it;
        if (r < I_IN) { transpose_tile<0>(p.w_in, D, INW, (bf16_t*)(p.ws + WS_WIN), r / 36, r % 36, sT, nullptr, nullptr); continue; } r -= I_IN;
        if (r < I_OUT) { transpose_tile<2>(p.w_out, D, D, (bf16_t*)(p.ws + WS_WOUT), r / 16, r % 16, sT, p.g_grp_a, p.g_grp_b); continue; } r -= I_OUT;
        if (r < NE * I_W1) { const int e = r / I_W1, q = r % I_W1;
            transpose_tile<1>(p.w_mlp1 + (size_t)e * D * 2048, D, 2048, (bf16_t*)(p.ws + WS_W1) + (size_t)e * 2048 * D, q / 32, q % 32, sT, nullptr, nullptr); continue; } r -= NE * I_W1;
        { const int e = r / I_W2, q = r % I_W2;
            transpose_tile<0>(p.w_mlp2 + (size_t)e * D * D, D, D, (bf16_t*)(p.ws + WS_W2) + (size_t)e * D * D, q / 16, q % 16, sT, nullptr, nullptr); }
    }
}

__device__ void p1_h(const Params& p, int gw, int ngw, int lane) {
    const float* mod = (const float*)(p.ws + WS_MOD);
    bf16_t* hb = (bf16_t*)(p.ws + WS_HB);
    for (int m = gw; m < MROWS; m += ngw) {
        const float* xr = m < NTOK ? p.x + (size_t)m * D : p.ctx + (size_t)(m - NTOK) * D;
        const int b = m < NTOK ? m / L : 8;
        const float* sh = mod + b * 6144, * sc = sh + 1024;
        f32x4 v[4]; float s = 0.f;
#pragma unroll
        for (int j = 0; j < 4; ++j) { v[j] = ((const f32x4*)xr)[lane + 64 * j]; s += v[j].x * v[j].x + v[j].y * v[j].y + v[j].z * v[j].z + v[j].w * v[j].w; }
        const float rstd = rsqrtf(wave_sum(s) * (1.f / D) + EPS);
#pragma unroll
        for (int j = 0; j < 4; ++j) {
            const int c0 = 4 * (lane + 64 * j);
            const f32x4 g = *(const f32x4*)(p.g_pre_mix + c0), a = *(const f32x4*)(sc + c0), bsh = *(const f32x4*)(sh + c0);
            const f32x4 o = (v[j] * rstd * g) * (a + 1.f) + bsh;
            u32x2 w; w.x = pk2(o.x, o.y); w.y = pk2(o.z, o.w);
            *(u32x2*)(hb + (size_t)m * D + c0) = w;
        }
    }
}

template <class AL, class BL, class EP>
__device__ __forceinline__ void ngemm_tile(float* sA, float* sB, int m0, int n0, int K, const AL& aload, const BL& bload, const EP& epi) {
    const int tid = threadIdx.x, ty = tid >> 4, tx = tid & 15;
    float acc[4][4];
#pragma unroll
    for (int i = 0; i < 4; ++i)
#pragma unroll
        for (int j = 0; j < 4; ++j) acc[i][j] = 0.f;
    for (int k0 = 0; k0 < K; k0 += 16) {
#pragma unroll
        for (int i = 0; i < 4; ++i) { const int e = tid + NTHREADS * i, r = e >> 4, kk = e & 15; sA[kk * 132 + r] = aload(m0 + r, k0 + kk); }
#pragma unroll
        for (int i = 0; i < 2; ++i) { const int e = tid + NTHREADS * i, n = e >> 4, kk = e & 15; sB[kk * 68 + n] = bload(n0 + n, k0 + kk); }
        __syncthreads();
#pragma unroll
        for (int kk = 0; kk < 16; ++kk) {
            float a[4], b[4];
#pragma unroll
            for (int i = 0; i < 4; ++i) a[i] = sA[kk * 132 + ty * 4 + i];
#pragma unroll
            for (int j = 0; j < 4; ++j) b[j] = sB[kk * 68 + tx + 16 * j];
#pragma unroll
            for (int i = 0; i < 4; ++i)
#pragma unroll
                for (int j = 0; j < 4; ++j) acc[i][j] = fmaf(a[i], b[j], acc[i][j]);
        }
        __syncthreads();
    }
    epi(m0 + ty * 4, n0, tx, acc);
}

__device__ void p2_qkv_naive(const Params& p, float* sA, float* sB) {
    const bf16_t* hb = (const bf16_t*)(p.ws + WS_HB); const bf16_t* wT = (const bf16_t*)(p.ws + WS_WIN);
    bf16_t* qkv = (bf16_t*)(p.ws + WS_QKV); const float* tab = (const float*)(p.ws + WS_TAB);
    constexpr int NTN = INW / 64, NT = (MROWS / 128) * NTN;
    for (int t = blockIdx.x; t < NT; t += gridDim.x) {
        const int m0 = (t / NTN) * 128, n0 = (t % NTN) * 64;
        auto al = [&](int r, int k) { return bf2f(hb[(size_t)r * D + k]); };
        auto bl = [&](int n, int k) { return bf2f(wT[(size_t)n * D + k]); };
        auto ep = [&](int r0, int nn0, int tx, float (&acc)[4][4]) {
#pragma unroll
            for (int i = 0; i < 4; ++i) {
                const int r = r0 + i; float v0 = acc[i][0], v1 = acc[i][1], v2 = acc[i][2], v3 = acc[i][3];
                const bool rope = (nn0 < C_VA) && (r < NTOK);
                if (rope) { const int t = r & (L - 1), pr = t >> 6, pc = t & 63;
                    const float c0 = tab[(pr * 16 + tx) * 2], s0 = tab[(pr * 16 + tx) * 2 + 1], c1 = tab[(pc * 16 + tx) * 2], s1 = tab[(pc * 16 + tx) * 2 + 1];
                    const float a0 = v0 * c0 - v1 * s0, a1 = v1 * c0 + v0 * s0, a2 = v2 * c1 - v3 * s1, a3 = v3 * c1 + v2 * s1; v0 = a0; v1 = a1; v2 = a2; v3 = a3; }
                const bool isq = (nn0 < C_KA) || (nn0 >= C_QB && nn0 < C_KB);
                if (isq) { v0 *= QSCALE; v1 *= QSCALE; v2 *= QSCALE; v3 *= QSCALE; }
                bf16_t* o = qkv + (size_t)r * INW + nn0 + tx;
                o[0] = (bf16_t)f2bf(v0); o[16] = (bf16_t)f2bf(v1); o[32] = (bf16_t)f2bf(v2); o[48] = (bf16_t)f2bf(v3);
            }
        };
        ngemm_tile(sA, sB, m0, n0, D, al, bl, ep);
    }
}

__device__ __forceinline__ void load_row64(const bf16_t* src, float* dst) {
#pragma unroll
    for (int c = 0; c < 8; ++c) { const u32x4 w = *(const u32x4*)(src + c * 8);
        dst[c * 8 + 0] = __uint_as_float(w.x << 16); dst[c * 8 + 1] = __uint_as_float(w.x & 0xffff0000u);
        dst[c * 8 + 2] = __uint_as_float(w.y << 16); dst[c * 8 + 3] = __uint_as_float(w.y & 0xffff0000u);
        dst[c * 8 + 4] = __uint_as_float(w.z << 16); dst[c * 8 + 5] = __uint_as_float(w.z & 0xffff0000u);
        dst[c * 8 + 6] = __uint_as_float(w.w << 16); dst[c * 8 + 7] = __uint_as_float(w.w & 0xffff0000u); }
}
struct OnlineSm { float m, l; };
__device__ __forceinline__ void attn_key(const float (&q)[64], float (&o)[64], OnlineSm& st, const bf16_t* krow, const bf16_t* vrow, float bias) {
    float s = bias;
#pragma unroll
    for (int c = 0; c < 8; ++c) { const u32x4 w = *(const u32x4*)(krow + c * 8);
        s = fmaf(q[c * 8 + 0], __uint_as_float(w.x << 16), s); s = fmaf(q[c * 8 + 1], __uint_as_float(w.x & 0xffff0000u), s);
        s = fmaf(q[c * 8 + 2], __uint_as_float(w.y << 16), s); s = fmaf(q[c * 8 + 3], __uint_as_float(w.y & 0xffff0000u), s);
        s = fmaf(q[c * 8 + 4], __uint_as_float(w.z << 16), s); s = fmaf(q[c * 8 + 5], __uint_as_float(w.z & 0xffff0000u), s);
        s = fmaf(q[c * 8 + 6], __uint_as_float(w.w << 16), s); s = fmaf(q[c * 8 + 7], __uint_as_float(w.w & 0xffff0000u), s); }
    const float mn = fmaxf(st.m, s), sc = exp2f(st.m - mn), pp = exp2f(s - mn);
    st.l = st.l * sc + pp; st.m = mn;
#pragma unroll
    for (int c = 0; c < 8; ++c) { const u32x4 w = *(const u32x4*)(vrow + c * 8);
        o[c * 8 + 0] = fmaf(pp, __uint_as_float(w.x << 16), o[c * 8 + 0] * sc); o[c * 8 + 1] = fmaf(pp, __uint_as_float(w.x & 0xffff0000u), o[c * 8 + 1] * sc);
        o[c * 8 + 2] = fmaf(pp, __uint_as_float(w.y << 16), o[c * 8 + 2] * sc); o[c * 8 + 3] = fmaf(pp, __uint_as_float(w.y & 0xffff0000u), o[c * 8 + 3] * sc);
        o[c * 8 + 4] = fmaf(pp, __uint_as_float(w.z << 16), o[c * 8 + 4] * sc); o[c * 8 + 5] = fmaf(pp, __uint_as_float(w.z & 0xffff0000u), o[c * 8 + 5] * sc);
        o[c * 8 + 6] = fmaf(pp, __uint_as_float(w.w << 16), o[c * 8 + 6] * sc); o[c * 8 + 7] = fmaf(pp, __uint_as_float(w.w & 0xffff0000u), o[c * 8 + 7] * sc); }
}
__device__ __forceinline__ void store_o64(bf16_t* dst, const float (&o)[64], float inv) {
#pragma unroll
    for (int c = 0; c < 8; ++c) { u32x4 w; w.x = pk2(o[c * 8] * inv, o[c * 8 + 1] * inv); w.y = pk2(o[c * 8 + 2] * inv, o[c * 8 + 3] * inv);
        w.z = pk2(o[c * 8 + 4] * inv, o[c * 8 + 5] * inv); w.w = pk2(o[c * 8 + 6] * inv, o[c * 8 + 7] * inv); *(u32x4*)(dst + c * 8) = w; }
}
__device__ void p3_attn_naive(const Params& p, int gtid, int gsize) {
    const bf16_t* qkv = (const bf16_t*)(p.ws + WS_QKV); bf16_t* ob = (bf16_t*)(p.ws + WS_O);
    for (int it = gtid; it < NTOK * 16; it += gsize) {
        const bool isB = it >= NTOK * 8; const int w = isB ? it - NTOK * 8 : it;
        const int h = w & 7, tokg = w >> 3, b = tokg / L, t = tokg % L;
        float q[64], o[64];
#pragma unroll
        for (int d = 0; d < 64; ++d) o[d] = 0.f;
        OnlineSm st;
        if (!isB) {
            const int kvh = h >> 2;
            load_row64(qkv + (size_t)tokg * INW + C_QA + h * 64, q);
            st.m = p.sink_a[h] * LOG2E; st.l = 1.f;
            const int j0 = t - 128 < 0 ? 0 : t - 128, j1 = t + 128 > L - 1 ? L - 1 : t + 128;
            for (int j = j0; j <= j1; ++j) { const bf16_t* row = qkv + (size_t)(b * L + j) * INW; attn_key(q, o, st, row + C_KA + kvh * 64, row + C_VA + kvh * 64, 0.f); }
            for (int c = 0; c < CTX; ++c) { const bf16_t* row = qkv + (size_t)(NTOK + b * CTX + c) * INW; attn_key(q, o, st, row + C_KA + kvh * 64, row + C_VA + kvh * 64, 0.f); }
            store_o64(ob + (size_t)tokg * D + h * 64, o, 1.f / st.l);
        } else {
            load_row64(qkv + (size_t)tokg * INW + C_QB + h * 64, q);
            st.m = -1e30f; st.l = 0.f;
            const int r = t >> 6, c = t & 63;
            const int rs = r - 4 < 0 ? 0 : (r - 4 > 56 ? 56 : r - 4), cs = c - 8 < 0 ? 0 : (c - 8 > 48 ? 48 : c - 8);
            for (int a = 0; a < 8; ++a)
                for (int e = 0; e < 16; ++e) { const int kr = rs + a, kc = cs + e; const bf16_t* row = qkv + (size_t)(b * L + kr * 64 + kc) * INW;
                    const float bias = p.rpb_b[(h * 15 + (kr - r + 7)) * 31 + (kc - c + 15)] * LOG2E;
                    attn_key(q, o, st, row + C_KB + h * 64, row + C_VB + h * 64, bias); }
            for (int cc = 0; cc < CTX; ++cc) { const bf16_t* row = qkv + (size_t)(NTOK + b * CTX + cc) * INW; attn_key(q, o, st, row + C_KB + h * 64, row + C_VB + h * 64, 0.f); }
            store_o64(ob + (size_t)tokg * D + 512 + h * 64, o, 1.f / st.l);
        }
    }
}

__device__ void p4a_ostat(const Params& p, int gw, int ngw, int lane) {
    const bf16_t* ob = (const bf16_t*)(p.ws + WS_O); float* os = (float*)(p.ws + WS_OSTAT);
    for (int m = gw; m < NTOK; m += ngw) {
        const u32x4 wa = *(const u32x4*)(ob + (size_t)m * D + lane * 8), wb = *(const u32x4*)(ob + (size_t)m * D + 512 + lane * 8);
        float sa = 0.f, sb = 0.f;
#pragma unroll
        for (int i = 0; i < 4; ++i) { const unsigned ua = wa[i], ub = wb[i]; const float a0 = __uint_as_float(ua << 16), a1 = __uint_as_float(ua & 0xffff0000u), b0 = __uint_as_float(ub << 16), b1 = __uint_as_float(ub & 0xffff0000u);
            sa += a0 * a0 + a1 * a1; sb += b0 * b0 + b1 * b1; }
        sa = wave_sum(sa); sb = wave_sum(sb);
        if (lane == 0) { os[m * 2] = rsqrtf(sa * (1.f / 512.f) + EPS); os[m * 2 + 1] = rsqrtf(sb * (1.f / 512.f) + EPS); }
    }
}
__device__ void p4b_outproj_naive(const Params& p, float* sA, float* sB) {
    const bf16_t* ob = (const bf16_t*)(p.ws + WS_O); const bf16_t* wT = (const bf16_t*)(p.ws + WS_WOUT); const float* os = (const float*)(p.ws + WS_OSTAT);
    float* mix = (float*)(p.ws + WS_MIX);
    constexpr int NTN = D / 64, NT = (NTOK / 128) * NTN;
    for (int t = blockIdx.x; t < NT; t += gridDim.x) {
        const int m0 = (t / NTN) * 128, n0 = (t % NTN) * 64;
        auto al = [&](int r, int k) { return bf2f(ob[(size_t)r * D + k]) * os[r * 2 + (k >> 9)]; };
        auto bl = [&](int n, int k) { return bf2f(wT[(size_t)n * D + k]); };
        auto ep = [&](int r0, int nn0, int tx, float (&acc)[4][4]) {
#pragma unroll
            for (int i = 0; i < 4; ++i)
#pragma unroll
                for (int j = 0; j < 4; ++j) mix[(size_t)(r0 + i) * D + nn0 + tx + 16 * j] = acc[i][j];
        };
        ngemm_tile(sA, sB, m0, n0, D, al, bl, ep);
    }
}
__device__ void p4c_post(const Params& p, int gw, int ngw, int lane) {
    const float* mod = (const float*)(p.ws + WS_MOD); const float* mix = (const float*)(p.ws + WS_MIX);
    bf16_t* hb = (bf16_t*)(p.ws + WS_HB);
    unsigned* counts = (unsigned*)(p.ws + WS_CTL);
    int* tope = (int*)(p.ws + WS_TOPE); int* topr = (int*)(p.ws + WS_TOPR); float* topw = (float*)(p.ws + WS_TOPW);
    for (int m = gw; m < NTOK; m += ngw) {
        const int b = m / L; const float* mb = mod + b * 6144;
        f32x4 v[4], xv[4]; float s = 0.f;
#pragma unroll
        for (int j = 0; j < 4; ++j) { v[j] = ((const f32x4*)(mix + (size_t)m * D))[lane + 64 * j]; s += v[j].x * v[j].x + v[j].y * v[j].y + v[j].z * v[j].z + v[j].w * v[j].w; }
        float rstd = rsqrtf(wave_sum(s) * (1.f / D) + EPS);
        s = 0.f;
#pragma unroll
        for (int j = 0; j < 4; ++j) { const int c0 = 4 * (lane + 64 * j);
            const f32x4 g = *(const f32x4*)(p.g_post_mix + c0), ga = *(const f32x4*)(mb + 2048 + c0), xx = ((const f32x4*)(p.x + (size_t)m * D))[lane + 64 * j];
            xv[j] = xx + ga * (v[j] * rstd * g);
            ((f32x4*)(p.out + (size_t)m * D))[lane + 64 * j] = xv[j];
            s += xv[j].x * xv[j].x + xv[j].y * xv[j].y + xv[j].z * xv[j].z + xv[j].w * xv[j].w; }
        rstd = rsqrtf(wave_sum(s) * (1.f / D) + EPS);
        float lg[NE];
#pragma unroll
        for (int e = 0; e < NE; ++e) lg[e] = 0.f;
#pragma unroll
        for (int j = 0; j < 4; ++j) { const int c0 = 4 * (lane + 64 * j);
            const f32x4 g = *(const f32x4*)(p.g_pre_ffn + c0), sc = *(const f32x4*)(mb + 4096 + c0), sh = *(const f32x4*)(mb + 3072 + c0);
            const f32x4 h2 = (xv[j] * rstd * g) * (sc + 1.f) + sh;
            u32x2 w; w.x = pk2(h2.x, h2.y); w.y = pk2(h2.z, h2.w);
            *(u32x2*)(hb + (size_t)m * D + c0) = w;
#pragma unroll
            for (int q = 0; q < 4; ++q) { const float hv = h2[q]; const f32x4* wr = (const f32x4*)(p.w_router + (size_t)(c0 + q) * NE);
#pragma unroll
                for (int e4 = 0; e4 < 8; ++e4) { const f32x4 ww = wr[e4]; lg[e4 * 4] = fmaf(hv, ww.x, lg[e4 * 4]); lg[e4 * 4 + 1] = fmaf(hv, ww.y, lg[e4 * 4 + 1]); lg[e4 * 4 + 2] = fmaf(hv, ww.z, lg[e4 * 4 + 2]); lg[e4 * 4 + 3] = fmaf(hv, ww.w, lg[e4 * 4 + 3]); } }
        }
#pragma unroll
        for (int e = 0; e < NE; ++e) lg[e] = wave_sum(lg[e]) + p.b_router[e];
        float tv[4]; int ti[4]; unsigned used = 0u;
#pragma unroll
        for (int k = 0; k < 4; ++k) { float best = -3.4e38f; int bi = 0;
#pragma unroll
            for (int e = 0; e < NE; ++e) { const bool ok = !((used >> e) & 1u) && lg[e] > best; best = ok ? lg[e] : best; bi = ok ? e : bi; }
            tv[k] = best; ti[k] = bi; used |= 1u << bi; }
        const float e1 = __expf(tv[1] - tv[0]), e2 = __expf(tv[2] - tv[0]), e3 = __expf(tv[3] - tv[0]); const float inv = 1.f / (1.f + e1 + e2 + e3);
        const float tw[4] = {inv, e1 * inv, e2 * inv, e3 * inv};
        if (lane < 4) {
            int myi = ti[0]; float myw = tw[0];
#pragma unroll
            for (int k = 1; k < 4; ++k) if (lane == k) { myi = ti[k]; myw = tw[k]; }
            const unsigned rank = atomicAdd(&counts[myi], 1u);
            tope[m * 4 + lane] = myi; topr[m * 4 + lane] = (int)rank; topw[m * 4 + lane] = myw;
        }
    }
}
__device__ __forceinline__ void expert_bases(const unsigned* counts, int* sbase  ) {
    if (threadIdx.x == 0) { int acc = 0; for (int e = 0; e < NE; ++e) { sbase[e] = acc; acc += ((int)counts[e] + 255) & ~255; } sbase[NE] = acc; }
    __syncthreads();
}
__device__ void p4d_rows(const Params& p, int gtid, int gsize, int* sbase) {
    const unsigned* counts = (const unsigned*)(p.ws + WS_CTL);
    const int* tope = (const int*)(p.ws + WS_TOPE); const int* topr = (const int*)(p.ws + WS_TOPR); const float* topw = (const float*)(p.ws + WS_TOPW);
    int* rtok = (int*)(p.ws + WS_ROWTOK); int* rslot = (int*)(p.ws + WS_ROWSLOT); float* rw = (float*)(p.ws + WS_ROWW);
    expert_bases(counts, sbase);
    for (int a = gtid; a < NASG; a += gsize) { const int e = tope[a], row = sbase[e] + topr[a]; rtok[row] = a >> 2; rslot[row] = a; rw[row] = topw[a]; }
    for (int i = gtid; i < NE * 256; i += gsize) { const int e = i >> 8, j = i & 255; const int row = sbase[e] + (int)counts[e] + j; if (row < sbase[e + 1]) { rtok[row] = 0; rslot[row] = -1; rw[row] = 0.f; } }
}
__device__ __forceinline__ int expert_of_row(const int* sbase, int row) { int e = 0;
#pragma unroll 1
    for (int i = 1; i < NE; ++i) e += (row >= sbase[i]) ? 1 : 0; return e; }
__device__ void p5a_gemm1_naive(const Params& p, float* sA, float* sB, int* sbase) {
    const unsigned* counts = (const unsigned*)(p.ws + WS_CTL);
    const bf16_t* hb = (const bf16_t*)(p.ws + WS_HB); const bf16_t* w1T = (const bf16_t*)(p.ws + WS_W1); bf16_t* act = (bf16_t*)(p.ws + WS_ACT);
    const int* rtok = (const int*)(p.ws + WS_ROWTOK);
    expert_bases(counts, sbase);
    const int total = sbase[NE]; constexpr int NTN = 2048 / 64; const int NT = (total / 128) * NTN;
    for (int t = blockIdx.x; t < NT; t += gridDim.x) {
        const int m0 = (t / NTN) * 128, n0 = (t % NTN) * 64; const int e = expert_of_row(sbase, m0);
        const bf16_t* wE = w1T + (size_t)e * 2048 * D; const float* b1 = p.b_mlp1 + (size_t)e * 2048;
        auto al = [&](int r, int k) { return bf2f(hb[(size_t)rtok[r] * D + k]); };
        auto bl = [&](int n, int k) { return bf2f(wE[(size_t)n * D + k]); };
        auto ep = [&](int r0, int nn0, int tx, float (&acc)[4][4]) {
#pragma unroll
            for (int i = 0; i < 4; ++i)
#pragma unroll
                for (int jj = 0; jj < 2; ++jj) { const int f = 16 * ((nn0 >> 5) + jj) + tx;
                    float gate = acc[i][2 * jj] + b1[2 * f], lin = acc[i][2 * jj + 1] + b1[2 * f + 1];
                    gate = fminf(gate, 7.f); lin = fminf(fmaxf(lin, -7.f), 7.f);
                    const float a = gate / (1.f + __expf(-1.702f * gate)) * (lin + 1.f);
                    act[(size_t)(r0 + i) * D + f] = (bf16_t)f2bf(a); }
        };
        ngemm_tile(sA, sB, m0, n0, D, al, bl, ep);
    }
}
__device__ void p5b_gemm2_naive(const Params& p, float* sA, float* sB, int* sbase) {
    const unsigned* counts = (const unsigned*)(p.ws + WS_CTL);
    const bf16_t* act = (const bf16_t*)(p.ws + WS_ACT); const bf16_t* w2T = (const bf16_t*)(p.ws + WS_W2); bf16_t* y = (bf16_t*)(p.ws + WS_Y);
    const int* rslot = (const int*)(p.ws + WS_ROWSLOT); const float* rw = (const float*)(p.ws + WS_ROWW);
    expert_bases(counts, sbase);
    const int total = sbase[NE]; constexpr int NTN = D / 64; const int NT = (total / 128) * NTN;
    for (int t = blockIdx.x; t < NT; t += gridDim.x) {
        const int m0 = (t / NTN) * 128, n0 = (t % NTN) * 64; const int e = expert_of_row(sbase, m0);
        const bf16_t* wE = w2T + (size_t)e * D * D; const float* b2 = p.b_mlp2 + (size_t)e * D;
        auto al = [&](int r, int k) { return bf2f(act[(size_t)r * D + k]); };
        auto bl = [&](int n, int k) { return bf2f(wE[(size_t)n * D + k]); };
        auto ep = [&](int r0, int nn0, int tx, float (&acc)[4][4]) {
#pragma unroll
            for (int i = 0; i < 4; ++i) { const int slot = rslot[r0 + i]; const float w = rw[r0 + i];
                if (slot >= 0) {
#pragma unroll
                    for (int j = 0; j < 4; ++j) { const int n = nn0 + tx + 16 * j; y[(size_t)slot * D + n] = (bf16_t)f2bf(w * (acc[i][j] + b2[n])); } } }
        };
        ngemm_tile(sA, sB, m0, n0, D, al, bl, ep);
    }
}
__device__ void p6_final(const Params& p, int gw, int ngw, int lane) {
    const float* mod = (const float*)(p.ws + WS_MOD); const bf16_t* y = (const bf16_t*)(p.ws + WS_Y);
    for (int m = gw; m < NTOK; m += ngw) {
        const int b = m / L; const float* ga2 = mod + b * 6144 + 5120;
        f32x4 v[4]; float s = 0.f;
#pragma unroll
        for (int j = 0; j < 4; ++j) { const int c0 = 4 * (lane + 64 * j); f32x4 a = {0.f, 0.f, 0.f, 0.f};
#pragma unroll
            for (int k = 0; k < 4; ++k) { const u32x2 w = *(const u32x2*)(y + (size_t)(m * 4 + k) * D + c0);
                a.x += __uint_as_float(w.x << 16); a.y += __uint_as_float(w.x & 0xffff0000u); a.z += __uint_as_float(w.y << 16); a.w += __uint_as_float(w.y & 0xffff0000u); }
            v[j] = a; s += a.x * a.x + a.y * a.y + a.z * a.z + a.w * a.w; }
        const float rstd = rsqrtf(wave_sum(s) * (1.f / D) + EPS);
#pragma unroll
        for (int j = 0; j < 4; ++j) { const int c0 = 4 * (lane + 64 * j);
            const f32x4 g = *(const f32x4*)(p.g_post_ffn + c0), ga = *(const f32x4*)(ga2 + c0);
            f32x4* o = (f32x4*)(p.out + (size_t)m * D) + lane + 64 * j;
            *o = *o + ga * (v[j] * rstd * g); }
    }
}

__global__ void __launch_bounds__(NTHREADS, 2) fwd_kernel(Params p) {
    cg::grid_group grid = cg::this_grid();
    extern __shared__ __attribute__((aligned(16))) unsigned char lds[];
    float* sA = (float*)lds;
    float* sB = sA + 16 * 132;
    int* sbase = (int*)(lds + 32768);
    float* sT = (float*)lds;
    const int tid = threadIdx.x, lane = tid & 63, wave = tid >> 6;
    const int gtid = blockIdx.x * NTHREADS + tid, gsize = gridDim.x * NTHREADS;
    const int gw = blockIdx.x * (NTHREADS / 64) + wave, ngw = gridDim.x * (NTHREADS / 64);

    p0_mod(p, gtid, gsize); p0_tab(p, gtid, gsize); p0_weights(p, sT);
    grid.sync();
    p1_h(p, gw, ngw, lane);
    grid.sync();
    p2_qkv_naive(p, sA, sB);
    grid.sync();
    p3_attn_naive(p, gtid, gsize);
    grid.sync();
    p4a_ostat(p, gw, ngw, lane);
    grid.sync();
    p4b_outproj_naive(p, sA, sB);
    grid.sync();
    p4c_post(p, gw, ngw, lane);
    grid.sync();
    p4d_rows(p, gtid, gsize, sbase);
    grid.sync();
    p5a_gemm1_naive(p, sA, sB, sbase);
    grid.sync();
    p5b_gemm2_naive(p, sA, sB, sbase);
    grid.sync();
    p6_final(p, gw, ngw, lane);
}

constexpr int LDS_BYTES = 36864;

extern "C" void kernel_launch(void* const* d_in, const int* in_sizes, int n_in, void* d_out, int out_size, void* d_ws, size_t ws_size, hipStream_t stream) {
    static int grid_blocks = 0;
    if (grid_blocks == 0) {
        if (n_in != 22 || ws_size < WS_END) { fprintf(stderr, "kernel_launch: unexpected n_in %d / ws_size %zu (need %zu)\n", n_in, ws_size, (size_t)WS_END); grid_blocks = -1; return; }
        int dev = 0, cus = 0, per_cu = 0;
        hipGetDevice(&dev);
        hipDeviceGetAttribute(&cus, hipDeviceAttributeMultiprocessorCount, dev);
        hipOccupancyMaxActiveBlocksPerMultiprocessor(&per_cu, (const void*)fwd_kernel, NTHREADS, LDS_BYTES);
        if (per_cu < 1) { fprintf(stderr, "kernel_launch: occupancy query returned %d\n", per_cu); grid_blocks = -1; return; }
        if (per_cu > 2) per_cu = 2;
        grid_blocks = cus * per_cu;
    }
    if (grid_blocks < 0) return;
    hipMemsetAsync((char*)d_ws + WS_CTL, 0, CTL_BYTES, stream);
    Params p{};
    const float** pp = (const float**)&p;
    for (int i = 0; i < 22; ++i) pp[i] = (const float*)d_in[i];
    p.out = (float*)d_out; p.ws = (unsigned char*)d_ws;
    void* args[] = {&p};
    hipError_t e = hipLaunchCooperativeKernel((const void*)fwd_kernel, dim3(grid_blocks), dim3(NTHREADS), args, LDS_BYTES, stream);
    if (e != hipSuccess) fprintf(stderr, "cooperative launch failed: %s (grid %d)\n", hipGetErrorString(e), grid_blocks);
}
```

```cpp
#include <hip/hip_runtime.h>
#include <hip/hip_cooperative_groups.h>
#include <cstdio>
#include <cstdint>
namespace cg = cooperative_groups;

constexpr int D = 1024, NB = 8, L = 4096, CTX = 256;
constexpr int NTOK = NB * L, NCTX = NB * CTX, MROWS = NTOK + NCTX;
constexpr int INW = 2304;
constexpr int C_QA = 0, C_KA = 512, C_VA = 640, C_QB = 768, C_KB = 1280, C_VB = 1792;
constexpr int NE = 32, TOPK = 4, NASG = NTOK * TOPK;
constexpr int PADROWS = NASG + NE * 256;
constexpr float LOG2E = 1.4426950408889634f;
constexpr float QSCALE = 0.125f * LOG2E;
constexpr float EPS = 1e-6f;
constexpr int NTHREADS = 512;

constexpr size_t MiB = 1u << 20;
constexpr size_t WS_CTL = 0;
constexpr size_t CTL_BYTES = 4096;
constexpr size_t WS_MOD = 1 * MiB;
constexpr size_t WS_TAB = 1 * MiB + 256 * 1024;
constexpr size_t WS_OSTAT = 1 * MiB + 512 * 1024;
constexpr size_t WS_WIN = 2 * MiB;
constexpr size_t WS_WOUT = 7 * MiB;
constexpr size_t WS_W2 = 9 * MiB;
constexpr size_t WS_W1 = 73 * MiB;
constexpr size_t WS_HB = 201 * MiB;
constexpr size_t WS_TOPE = 269 * MiB;
constexpr size_t WS_TOPR = WS_TOPE + NASG * 4;
constexpr size_t WS_TOPW = WS_TOPR + NASG * 4;
constexpr size_t WS_ROWTOK = 271 * MiB;
constexpr size_t WS_ROWSLOT = WS_ROWTOK + PADROWS * 4;
constexpr size_t WS_ROWW = WS_ROWSLOT + PADROWS * 4;
constexpr size_t WS_QKV = 273 * MiB;
constexpr size_t WS_O = 426 * MiB;
constexpr size_t WS_MIX = 490 * MiB;
constexpr size_t WS_ACT = 273 * MiB;
constexpr size_t WS_Y = 618 * MiB;
constexpr size_t WS_END = 874 * MiB;
static_assert(WS_ROWW + PADROWS * 4 <= WS_QKV, "map");
static_assert(WS_QKV + (size_t)MROWS * INW * 2 <= WS_O, "map");
static_assert(WS_ACT + (size_t)PADROWS * 1024 * 2 <= WS_Y, "map");

typedef unsigned short bf16_t;
typedef float f32x4 __attribute__((ext_vector_type(4)));
typedef unsigned u32x4 __attribute__((ext_vector_type(4)));
typedef unsigned u32x2 __attribute__((ext_vector_type(2)));

struct Params {
    const float *x, *c, *ctx, *c_ctx, *w_ada, *b_ada, *g_pre_mix, *g_post_mix, *g_pre_ffn, *g_post_ffn, *w_in, *g_grp_a, *g_grp_b,
        *sink_a, *rpb_b, *w_out, *w_router, *b_router, *w_mlp1, *b_mlp1, *w_mlp2, *b_mlp2;
    float* out;
    unsigned char* ws;
};

__device__ __forceinline__ float bf2f(bf16_t h) { return __uint_as_float((unsigned)h << 16); }
__device__ __forceinline__ unsigned f2bf(float f) { unsigned u = __float_as_uint(f); return (u + 0x7fffu + ((u >> 16) & 1u)) >> 16; }
__device__ __forceinline__ unsigned pk2(float lo, float hi) { return f2bf(lo) | (f2bf(hi) << 16); }
__device__ __forceinline__ float wave_sum(float v) {
#pragma unroll
    for (int o = 1; o < 64; o <<= 1) v += __shfl_xor(v, o);
    return v;
}


namespace pg8 {
#define PG8_LAS __attribute__((address_space(3)))
typedef short bf16x8 __attribute__((ext_vector_type(8)));
constexpr int BM = 256, BK = 64, HALF = 128, HTB = HALF * BK * 2  , STAGE_BYTES = 8 * HTB, NXCD = 8, WGM = 8;
__device__ __forceinline__ int lds_byte(int r, int c) { const int st = (r >> 4) * 2 + (c >> 5), rr = r & 15, cc = c & 31, ob = rr * 64 + cc * 2; return st * 1024 + (ob ^ (((ob >> 9) & 1) << 5)); }
__device__ __forceinline__ void stage_rc(int b, int& R, int& C) { const int st = b / 1024, sb = b % 1024, swz = sb ^ (((sb >> 9) & 1) << 5); R = (st >> 1) * 16 + swz / 64; C = (st & 1) * 32 + (swz % 64) / 2; }
__device__ __forceinline__ int perm32(int rho) { const int n = rho >> 4, i = rho & 15; return 8 * (i >> 2) + 4 * n + (i & 3); }

struct Unit { int pm, pn, e; };
struct Gemm { const bf16_t* A; const bf16_t* Bt; int K; size_t bstride; const int* rowidx; };

struct StaticOrder {
    int nM, nN, nwg, G, c; const PG8_LAS int* sbase;
    __device__ void init(int M, int N, int G_, int c_, const PG8_LAS int* sb) { nM = M / BM; nN = N / BM; nwg = nM * nN; G = G_; c = c_; sbase = sb; }
    __device__ bool next(int i, Unit& u) const {
        const long Lx = (long)i * G + c; if (Lx >= nwg) return false;
        int wgid = (int)Lx; { const int q = nwg / NXCD, r = nwg % NXCD, xcd = wgid % NXCD, off = wgid / NXCD; wgid = (xcd < r ? xcd * (q + 1) : r * (q + 1) + (xcd - r) * q) + off; }
        const int nig = WGM * nN, gid = wgid / nig, fm = gid * WGM, gsz = (nM - fm) < WGM ? (nM - fm) : WGM;
        u.pm = fm + ((wgid % nig) % gsz); u.pn = (wgid % nig) / gsz; u.e = 0;
        if (sbase) { const int row = u.pm * BM; int e = 0;
#pragma unroll 1
            for (int j = 1; j < 32; ++j) e += (row >= sbase[j]) ? 1 : 0;
            u.e = e; }
        return true;
    }
};

template <class Epi, class Sched, bool GATHER, bool ALIGN_EPI>
__device__ __forceinline__ void gemm_phase(PG8_LAS unsigned char* lds, const Gemm g, const Sched& S, const Epi& E) {
    const int tid = threadIdx.x, wid = __builtin_amdgcn_readfirstlane(tid >> 6), lane = tid & 63, wr = wid >> 2, wc = wid & 3, fr = lane & 15, fq = lane >> 4;
    const int K = g.K, nt = K / BK;
    unsigned voffA[2], voffB[2]; int RA[2], CA[2];
#pragma unroll
    for (int i = 0; i < 2; ++i) { int R, C; stage_rc(tid * 16 + i * 8192, R, C); const int Rb = Epi::PERM ? ((R & ~31) + perm32(R & 31)) : R;
        voffA[i] = (unsigned)(R * K + C) * 2u; voffB[i] = (unsigned)(Rb * K + C) * 2u; RA[i] = R; CA[i] = C * 2; }
    const size_t kstep = (size_t)(BK * 2);
    const size_t hstep = (size_t)HALF * K * 2;
    const size_t tstep = 2 * hstep;
    const unsigned ldsw = (unsigned)wid * 1024u;
    const int aoff = lds_byte(wr * 64 + fr, fq * 8), boff = lds_byte(wc * 32 + fr, fq * 8);
#define PG8_SA(b, h) (((b) * 2 + (h)) * HTB)
#define PG8_SB(b, h) ((4 + (b) * 2 + (h)) * HTB)
#define PG8_STAGE(bufoff, gbase, voff) do { _Pragma("unroll") for (int _i = 0; _i < 2; ++_i) \
        __builtin_amdgcn_global_load_lds((const unsigned*)((const char*)(gbase) + (voff)[_i]), (PG8_LAS unsigned*)(lds + (bufoff) + ldsw + _i * 8192), 16, 0, 0); } while (0)
#define PG8_LDA(dst, b, h) do { _Pragma("unroll") for (int m = 0; m < 4; ++m) _Pragma("unroll") for (int k = 0; k < 2; ++k) dst[m][k] = *(const PG8_LAS bf16x8*)(lds + PG8_SA(b, h) + aoff + m * 2048 + k * 1024); } while (0)
#define PG8_LDB(dst, b, h) do { _Pragma("unroll") for (int n = 0; n < 2; ++n) _Pragma("unroll") for (int k = 0; k < 2; ++k) dst[n][k] = *(const PG8_LAS bf16x8*)(lds + PG8_SB(b, h) + boff + n * 2048 + k * 1024); } while (0)
#define PG8_MMA(ai, bj, At, Bt) do { __builtin_amdgcn_s_setprio(1); _Pragma("unroll") for (int m = 0; m < 4; ++m) _Pragma("unroll") for (int n = 0; n < 2; ++n) _Pragma("unroll") for (int k = 0; k < 2; ++k) \
        acc[ai][bj][m][n] = __builtin_amdgcn_mfma_f32_16x16x32_bf16(Bt[n][k], At[m][k], acc[ai][bj][m][n], 0, 0, 0); __builtin_amdgcn_s_setprio(0); } while (0)
#define PG8_WAIT_V(n) asm volatile("s_waitcnt vmcnt(" #n ")" ::: "memory")
#define PG8_WAIT_L(n) asm volatile("s_waitcnt lgkmcnt(" #n ")" ::: "memory")
#define PG8_BAR __builtin_amdgcn_s_barrier()
#define PG8_SCHED __builtin_amdgcn_sched_barrier(0)
#define PG8_SETOFF(off, u) do { _Pragma("unroll") for (int _h = 0; _h < 2; ++_h) _Pragma("unroll") for (int _i = 0; _i < 2; ++_i) { \
        if (GATHER) off[_h][_i] = (unsigned)g.rowidx[(u).pm * BM + _h * HALF + RA[_i]] * (unsigned)(K * 2) + (unsigned)CA[_i]; \
        else off[_h][_i] = voffA[_i] + (unsigned)(_h * hstep); } } while (0)
    Unit cur, nxt; int ui = 0;
    if (!S.next(0, cur)) return;
    f32x4 acc[2][2][4][2];
#pragma unroll
    for (int a = 0; a < 2; ++a)
#pragma unroll
        for (int b = 0; b < 2; ++b)
#pragma unroll
            for (int m = 0; m < 4; ++m)
#pragma unroll
                for (int n = 0; n < 2; ++n) acc[a][b][m][n] = (f32x4){0.f, 0.f, 0.f, 0.f};
    bf16x8 At[4][2], B0[2][2], B1[2][2];
    unsigned offc[2][2], offn[2][2];
    PG8_SETOFF(offc, cur);
    const char* cA = GATHER ? (const char*)g.A : (const char*)g.A + (size_t)cur.pm * tstep;
    const char* cB = (const char*)g.Bt + (size_t)cur.e * g.bstride + (size_t)cur.pn * tstep;
    PG8_STAGE(PG8_SB(0, 0), cB, voffB); PG8_STAGE(PG8_SB(0, 1), cB + hstep, voffB); PG8_STAGE(PG8_SA(0, 0), cA, offc[0]); PG8_STAGE(PG8_SA(0, 1), cA, offc[1]);
    if (wr == 1) PG8_BAR;
    PG8_WAIT_V(2); PG8_BAR;
    PG8_STAGE(PG8_SB(1, 0), cB + kstep, voffB); PG8_STAGE(PG8_SA(1, 0), cA + kstep, offc[0]); PG8_STAGE(PG8_SB(1, 1), cB + hstep + kstep, voffB);
    PG8_WAIT_V(6); PG8_BAR;
    for (;;) {
        const bool has_next = S.next(ui + 1, nxt);
        const char* nA = GATHER ? cA : (has_next ? (const char*)g.A + (size_t)nxt.pm * tstep : cA);
        const char* nB = has_next ? (const char*)g.Bt + (size_t)nxt.e * g.bstride + (size_t)nxt.pn * tstep : cB;
        if (GATHER) { if (has_next) { PG8_SETOFF(offn, nxt); } else {
#pragma unroll
            for (int h = 0; h < 2; ++h)
#pragma unroll
                for (int i = 0; i < 2; ++i) offn[h][i] = offc[h][i]; } }
        for (int t = 0; t < nt; t += 2) {
            const bool last = (t == nt - 2);
            const char* a1 = cA + (size_t)(t + 1) * kstep;
            const char* a2 = last ? nA : cA + (size_t)(t + 2) * kstep; const char* b2 = last ? nB : cB + (size_t)(t + 2) * kstep;
            const char* a3 = a2 + kstep; const char* b3 = b2 + kstep;
            unsigned o2[2][2];
#pragma unroll
            for (int h = 0; h < 2; ++h)
#pragma unroll
                for (int i = 0; i < 2; ++i) o2[h][i] = (GATHER && last) ? offn[h][i] : offc[h][i];
            PG8_LDB(B0, 0, 0); PG8_LDB(B1, 0, 1); PG8_SCHED; PG8_LDA(At, 0, 0); PG8_STAGE(PG8_SA(1, 1), a1, offc[1]);
            PG8_WAIT_V(8); PG8_WAIT_L(0); PG8_BAR; PG8_MMA(0, 0, At, B0); PG8_MMA(0, 1, At, B1); PG8_BAR; PG8_SCHED;
            PG8_LDA(At, 0, 1); PG8_STAGE(PG8_SB(0, 0), b2, voffB); PG8_STAGE(PG8_SB(0, 1), b2 + hstep, voffB); PG8_STAGE(PG8_SA(0, 0), a2, o2[0]);
            PG8_WAIT_V(8); PG8_WAIT_L(0); PG8_BAR; PG8_MMA(1, 0, At, B0); PG8_MMA(1, 1, At, B1); PG8_BAR; PG8_SCHED;
            PG8_LDB(B0, 1, 0); PG8_LDB(B1, 1, 1); PG8_SCHED; PG8_LDA(At, 1, 0); PG8_STAGE(PG8_SA(0, 1), a2, o2[1]);
            PG8_WAIT_V(8); PG8_WAIT_L(0); PG8_BAR; PG8_MMA(0, 0, At, B0); PG8_MMA(0, 1, At, B1); PG8_BAR; PG8_SCHED;
            PG8_LDA(At, 1, 1); PG8_STAGE(PG8_SB(1, 0), b3, voffB); PG8_STAGE(PG8_SB(1, 1), b3 + hstep, voffB); PG8_STAGE(PG8_SA(1, 0), a3, o2[0]);
            PG8_WAIT_V(8); PG8_WAIT_L(0); PG8_BAR; PG8_MMA(1, 0, At, B0); PG8_MMA(1, 1, At, B1); PG8_BAR; PG8_SCHED;
        }
        if constexpr (ALIGN_EPI) { if (wr == 0) PG8_BAR; }
        E(acc, cur, wr, wc, fr, fq);
        if (!has_next) break;
#pragma unroll
        for (int a = 0; a < 2; ++a)
#pragma unroll
            for (int b = 0; b < 2; ++b)
#pragma unroll
                for (int m = 0; m < 4; ++m)
#pragma unroll
                    for (int n = 0; n < 2; ++n) acc[a][b][m][n] = (f32x4){0.f, 0.f, 0.f, 0.f};
        cur = nxt; cA = nA; cB = nB; ++ui;
#pragma unroll
        for (int h = 0; h < 2; ++h)
#pragma unroll
            for (int i = 0; i < 2; ++i) offc[h][i] = offn[h][i];
        if constexpr (ALIGN_EPI) { if (wr == 1) PG8_BAR; }
    }
    PG8_WAIT_V(0);
    if constexpr (!ALIGN_EPI) { if (wr == 0) PG8_BAR; }
    PG8_BAR;
#undef PG8_SA
#undef PG8_SB
#undef PG8_STAGE
#undef PG8_LDA
#undef PG8_LDB
#undef PG8_MMA
#undef PG8_WAIT_V
#undef PG8_WAIT_L
#undef PG8_BAR
#undef PG8_SCHED
#undef PG8_SETOFF
}

struct EpiQKV {
    static constexpr bool PERM = false;
    bf16_t* O; const float* tab;
    __device__ __forceinline__ void operator()(const f32x4 (&acc)[2][2][4][2], const Unit& u, int wr, int wc, int fr, int fq) const {
        const bool latent = u.pm < NTOK / BM;
#pragma unroll
        for (int ai = 0; ai < 2; ++ai)
#pragma unroll
            for (int m = 0; m < 4; ++m) {
                const int row = u.pm * BM + ai * HALF + wr * 64 + m * 16 + fr;
                bf16_t* rowp = O + (size_t)row * INW + u.pn * BM + wc * 32 + 4 * fq;
                const int pos = row & (L - 1), pp = (wc & 1) ? (pos & 63) : (pos >> 6);
                const f32x4* tp = (const f32x4*)(tab + (pp * 16 + 4 * fq) * 2);
#pragma unroll
                for (int bj = 0; bj < 2; ++bj) {
                    const int colbase = u.pn * BM + bj * HALF;
                    f32x4 v0 = acc[ai][bj][m][0], v1 = acc[ai][bj][m][1];
                    if (latent && colbase < C_VA) {
                        const f32x4 t0 = tp[0], t1 = tp[1];
                        const f32x4 cs = {t0.x, t0.z, t1.x, t1.z}, sn = {t0.y, t0.w, t1.y, t1.w};
                        const f32x4 a0 = v0 * cs - v1 * sn, a1 = v1 * cs + v0 * sn; v0 = a0; v1 = a1;
                    }
                    if (colbase < C_KA || (colbase >= C_QB && colbase < C_KB)) { v0 = v0 * QSCALE; v1 = v1 * QSCALE; }
                    u32x2 w0, w1; w0.x = pk2(v0.x, v0.y); w0.y = pk2(v0.z, v0.w); w1.x = pk2(v1.x, v1.y); w1.y = pk2(v1.z, v1.w);
                    *(u32x2*)(rowp + bj * HALF) = w0; *(u32x2*)(rowp + bj * HALF + 16) = w1;
                }
            }
    }
};
struct EpiF32 {
    static constexpr bool PERM = false;
    float* O; int ldc;
    __device__ __forceinline__ void operator()(const f32x4 (&acc)[2][2][4][2], const Unit& u, int wr, int wc, int fr, int fq) const {
#pragma unroll
        for (int ai = 0; ai < 2; ++ai)
#pragma unroll
            for (int m = 0; m < 4; ++m) {
                float* rowp = O + (size_t)(u.pm * BM + ai * HALF + wr * 64 + m * 16 + fr) * ldc + u.pn * BM + wc * 32 + 4 * fq;
#pragma unroll
                for (int bj = 0; bj < 2; ++bj)
#pragma unroll
                    for (int n = 0; n < 2; ++n) *(f32x4*)(rowp + bj * HALF + 16 * n) = acc[ai][bj][m][n];
            }
    }
};
struct EpiSwiglu {
    static constexpr bool PERM = false;
    bf16_t* act; const float* b1;
    __device__ __forceinline__ void operator()(const f32x4 (&acc)[2][2][4][2], const Unit& u, int wr, int wc, int fr, int fq) const {
#pragma unroll
        for (int bj = 0; bj < 2; ++bj) {
            const int f0 = 16 * (8 * u.pn + 4 * bj + wc) + 4 * fq;
            const f32x4* bp = (const f32x4*)(b1 + (size_t)u.e * 2048 + 2 * f0); const f32x4 bA = bp[0], bB = bp[1];
            const f32x4 bg = {bA.x, bA.z, bB.x, bB.z}, bl = {bA.y, bA.w, bB.y, bB.w};
#pragma unroll
            for (int ai = 0; ai < 2; ++ai)
#pragma unroll
                for (int m = 0; m < 4; ++m) {
                    const int row = u.pm * BM + ai * HALF + wr * 64 + m * 16 + fr;
                    const f32x4 gt = acc[ai][bj][m][0] + bg, ln = acc[ai][bj][m][1] + bl; float a[4];
#pragma unroll
                    for (int j = 0; j < 4; ++j) { const float gg = fminf(gt[j], 7.f), ll = fminf(fmaxf(ln[j], -7.f), 7.f);
                        a[j] = gg * __builtin_amdgcn_rcpf(1.f + __expf(-1.702f * gg)) * (ll + 1.f); }
                    u32x2 w; w.x = pk2(a[0], a[1]); w.y = pk2(a[2], a[3]);
                    *(u32x2*)(act + (size_t)row * D + f0) = w;
                }
        }
    }
};
struct EpiScatter {
    static constexpr bool PERM = true;
    bf16_t* y; const float* b2; const int* rslot; const float* rw;
    __device__ __forceinline__ void operator()(const f32x4 (&acc)[2][2][4][2], const Unit& u, int wr, int wc, int fr, int fq) const {
        const int col0 = u.pn * BM + wc * 32 + 8 * fq;
        f32x4 bv[2][2];
#pragma unroll
        for (int bj = 0; bj < 2; ++bj)
#pragma unroll
            for (int n = 0; n < 2; ++n) bv[bj][n] = *(const f32x4*)(b2 + (size_t)u.e * D + col0 + bj * HALF + 4 * n);
#pragma unroll
        for (int ai = 0; ai < 2; ++ai)
#pragma unroll
            for (int m = 0; m < 4; ++m) {
                const int row = u.pm * BM + ai * HALF + wr * 64 + m * 16 + fr;
                const int slot = rslot[row]; const float w = rw[row];
                if (slot >= 0) {
                    bf16_t* rowp = y + (size_t)slot * D + col0;
#pragma unroll
                    for (int bj = 0; bj < 2; ++bj) { const f32x4 v0 = (acc[ai][bj][m][0] + bv[bj][0]) * w, v1 = (acc[ai][bj][m][1] + bv[bj][1]) * w;
                        u32x4 o; o.x = pk2(v0.x, v0.y); o.y = pk2(v0.z, v0.w); o.z = pk2(v1.x, v1.y); o.w = pk2(v1.z, v1.w);
                        *(u32x4*)(rowp + bj * HALF) = o; }
                }
            }
    }
};
}

__device__ void p0_mod(const Params& p, int gtid, int gsize) {
    float* mod = (float*)(p.ws + WS_MOD);
    for (int idx = gtid; idx < 9 * 6144; idx += gsize) {
        const int r = idx / 6144, j = idx % 6144;
        const float* cv = r < 8 ? p.c + r * D : p.c_ctx;
        float acc = p.b_ada[j];
        for (int k = 0; k < D; ++k) { const float cc = cv[k]; acc += (cc / (1.f + __expf(-cc))) * p.w_ada[(size_t)k * 6144 + j]; }
        mod[idx] = acc;
    }
}
__device__ void p0_tab(const Params& p, int gtid, int gsize) {
    float* tab = (float*)(p.ws + WS_TAB);
    for (int idx = gtid; idx < 64 * 16; idx += gsize) {
        const int pos = idx >> 4, i = idx & 15;
        const float freq = exp2f(-(float)i * (13.287712379549449f / 16.f));
        const float ang = (float)pos * freq;
        const float n = rintf(ang * 0.15915494309189535f);
        float r = fmaf(-n, 6.28125f, ang); r = fmaf(-n, 1.9353071795864769e-3f, r);
        tab[idx * 2] = __cosf(r); tab[idx * 2 + 1] = __sinf(r);
    }
}
template <int MODE>
__device__ void transpose_tile(const float* src, int K, int N, bf16_t* dst, int tk, int tn, float* sT, const float* gA, const float* gB) {
    const int tid = threadIdx.x, k0 = tk * 64, n0 = tn * 64;
#pragma unroll
    for (int i = 0; i < 8; ++i) {
        const int e = tid + NTHREADS * i, kl = e >> 6, cc = e & 63;
        float v = src[(size_t)(k0 + kl) * N + n0 + cc];
        int nl = cc;
        if (MODE == 1) { const int f = cc >> 1, n = cc & 1; nl = 32 * (f >> 4) + 16 * n + (f & 15); }
        if (MODE == 2) { const int k = k0 + kl; v *= (k < 512 ? gA[k] : gB[k - 512]); }
        sT[nl * 65 + kl] = v;
    }
    __syncthreads();
    {
        const int nl = tid >> 3, ch = tid & 7; const float* s = sT + nl * 65 + ch * 8;
        u32x4 o; o.x = pk2(s[0], s[1]); o.y = pk2(s[2], s[3]); o.z = pk2(s[4], s[5]); o.w = pk2(s[6], s[7]);
        *(u32x4*)(dst + (size_t)(n0 + nl) * K + k0 + ch * 8) = o;
    }
    __syncthreads();
}
__device__ void p0_weights(const Params& p, float* sT) {
    constexpr int I_IN = 16 * 36, I_OUT = 16 * 16, I_W1 = 16 * 32, I_W2 = 16 * 16;
    constexpr int NITEMS = I_IN + I_OUT + NE * I_W1 + NE * I_W2;
    for (int it = blockIdx.x; it < NITEMS; it += gridDim.x) {
        int r = it;
        if (r < I_IN) { transpose_tile<0>(p.w_in, D, INW, (bf16_t*)(p.ws + WS_WIN), r / 36, r % 36, sT, nullptr, nullptr); continue; } r -= I_IN;
        if (r < I_OUT) { transpose_tile<2>(p.w_out, D, D, (bf16_t*)(p.ws + WS_WOUT), r / 16, r % 16, sT, p.g_grp_a, p.g_grp_b); continue; } r -= I_OUT;
        if (r < NE * I_W1) { const int e = r / I_W1, q = r % I_W1;
            transpose_tile<1>(p.w_mlp1 + (size_t)e * D * 2048, D, 2048, (bf16_t*)(p.ws + WS_W1) + (size_t)e * 2048 * D, q / 32, q % 32, sT, nullptr, nullptr); continue; } r -= NE * I_W1;
        { const int e = r / I_W2, q = r % I_W2;
            transpose_tile<0>(p.w_mlp2 + (size_t)e * D * D, D, D, (bf16_t*)(p.ws + WS_W2) + (size_t)e * D * D, q / 16, q % 16, sT, nullptr, nullptr); }
    }
}

__device__ void p1_h(const Params& p, int gw, int ngw, int lane) {
    const float* mod = (const float*)(p.ws + WS_MOD);
    bf16_t* hb = (bf16_t*)(p.ws + WS_HB);
    for (int m = gw; m < MROWS; m += ngw) {
        const float* xr = m < NTOK ? p.x + (size_t)m * D : p.ctx + (size_t)(m - NTOK) * D;
        const int b = m < NTOK ? m / L : 8;
        const float* sh = mod + b * 6144, * sc = sh + 1024;
        f32x4 v[4]; float s = 0.f;
#pragma unroll
        for (int j = 0; j < 4; ++j) { v[j] = ((const f32x4*)xr)[lane + 64 * j]; s += v[j].x * v[j].x + v[j].y * v[j].y + v[j].z * v[j].z + v[j].w * v[j].w; }
        const float rstd = rsqrtf(wave_sum(s) * (1.f / D) + EPS);
#pragma unroll
        for (int j = 0; j < 4; ++j) {
            const int c0 = 4 * (lane + 64 * j);
            const f32x4 g = *(const f32x4*)(p.g_pre_mix + c0), a = *(const f32x4*)(sc + c0), bsh = *(const f32x4*)(sh + c0);
            const f32x4 o = (v[j] * rstd * g) * (a + 1.f) + bsh;
            u32x2 w; w.x = pk2(o.x, o.y); w.y = pk2(o.z, o.w);
            *(u32x2*)(hb + (size_t)m * D + c0) = w;
        }
    }
}

template <class AL, class BL, class EP>
__device__ __forceinline__ void ngemm_tile(float* sA, float* sB, int m0, int n0, int K, const AL& aload, const BL& bload, const EP& epi) {
    const int tid = threadIdx.x, ty = tid >> 4, tx = tid & 15;
    float acc[4][4];
#pragma unroll
    for (int i = 0; i < 4; ++i)
#pragma unroll
        for (int j = 0; j < 4; ++j) acc[i][j] = 0.f;
    for (int k0 = 0; k0 < K; k0 += 16) {
#pragma unroll
        for (int i = 0; i < 4; ++i) { const int e = tid + NTHREADS * i, r = e >> 4, kk = e & 15; sA[kk * 132 + r] = aload(m0 + r, k0 + kk); }
#pragma unroll
        for (int i = 0; i < 2; ++i) { const int e = tid + NTHREADS * i, n = e >> 4, kk = e & 15; sB[kk * 68 + n] = bload(n0 + n, k0 + kk); }
        __syncthreads();
#pragma unroll
        for (int kk = 0; kk < 16; ++kk) {
            float a[4], b[4];
#pragma unroll
            for (int i = 0; i < 4; ++i) a[i] = sA[kk * 132 + ty * 4 + i];
#pragma unroll
            for (int j = 0; j < 4; ++j) b[j] = sB[kk * 68 + tx + 16 * j];
#pragma unroll
            for (int i = 0; i < 4; ++i)
#pragma unroll
                for (int j = 0; j < 4; ++j) acc[i][j] = fmaf(a[i], b[j], acc[i][j]);
        }
        __syncthreads();
    }
    epi(m0 + ty * 4, n0, tx, acc);
}

__device__ void p2_qkv_naive(const Params& p, float* sA, float* sB) {
    const bf16_t* hb = (const bf16_t*)(p.ws + WS_HB); const bf16_t* wT = (const bf16_t*)(p.ws + WS_WIN);
    bf16_t* qkv = (bf16_t*)(p.ws + WS_QKV); const float* tab = (const float*)(p.ws + WS_TAB);
    constexpr int NTN = INW / 64, NT = (MROWS / 128) * NTN;
    for (int t = blockIdx.x; t < NT; t += gridDim.x) {
        const int m0 = (t / NTN) * 128, n0 = (t % NTN) * 64;
        auto al = [&](int r, int k) { return bf2f(hb[(size_t)r * D + k]); };
        auto bl = [&](int n, int k) { return bf2f(wT[(size_t)n * D + k]); };
        auto ep = [&](int r0, int nn0, int tx, float (&acc)[4][4]) {
#pragma unroll
            for (int i = 0; i < 4; ++i) {
                const int r = r0 + i; float v0 = acc[i][0], v1 = acc[i][1], v2 = acc[i][2], v3 = acc[i][3];
                const bool rope = (nn0 < C_VA) && (r < NTOK);
                if (rope) { const int t = r & (L - 1), pr = t >> 6, pc = t & 63;
                    const float c0 = tab[(pr * 16 + tx) * 2], s0 = tab[(pr * 16 + tx) * 2 + 1], c1 = tab[(pc * 16 + tx) * 2], s1 = tab[(pc * 16 + tx) * 2 + 1];
                    const float a0 = v0 * c0 - v1 * s0, a1 = v1 * c0 + v0 * s0, a2 = v2 * c1 - v3 * s1, a3 = v3 * c1 + v2 * s1; v0 = a0; v1 = a1; v2 = a2; v3 = a3; }
                const bool isq = (nn0 < C_KA) || (nn0 >= C_QB && nn0 < C_KB);
                if (isq) { v0 *= QSCALE; v1 *= QSCALE; v2 *= QSCALE; v3 *= QSCALE; }
                bf16_t* o = qkv + (size_t)r * INW + nn0 + tx;
                o[0] = (bf16_t)f2bf(v0); o[16] = (bf16_t)f2bf(v1); o[32] = (bf16_t)f2bf(v2); o[48] = (bf16_t)f2bf(v3);
            }
        };
        ngemm_tile(sA, sB, m0, n0, D, al, bl, ep);
    }
}

__device__ __forceinline__ void load_row64(const bf16_t* src, float* dst) {
#pragma unroll
    for (int c = 0; c < 8; ++c) { const u32x4 w = *(const u32x4*)(src + c * 8);
        dst[c * 8 + 0] = __uint_as_float(w.x << 16); dst[c * 8 + 1] = __uint_as_float(w.x & 0xffff0000u);
        dst[c * 8 + 2] = __uint_as_float(w.y << 16); dst[c * 8 + 3] = __uint_as_float(w.y & 0xffff0000u);
        dst[c * 8 + 4] = __uint_as_float(w.z << 16); dst[c * 8 + 5] = __uint_as_float(w.z & 0xffff0000u);
        dst[c * 8 + 6] = __uint_as_float(w.w << 16); dst[c * 8 + 7] = __uint_as_float(w.w & 0xffff0000u); }
}
struct OnlineSm { float m, l; };
__device__ __forceinline__ void attn_key(const float (&q)[64], float (&o)[64], OnlineSm& st, const bf16_t* krow, const bf16_t* vrow, float bias) {
    float s = bias;
#pragma unroll
    for (int c = 0; c < 8; ++c) { const u32x4 w = *(const u32x4*)(krow + c * 8);
        s = fmaf(q[c * 8 + 0], __uint_as_float(w.x << 16), s); s = fmaf(q[c * 8 + 1], __uint_as_float(w.x & 0xffff0000u), s);
        s = fmaf(q[c * 8 + 2], __uint_as_float(w.y << 16), s); s = fmaf(q[c * 8 + 3], __uint_as_float(w.y & 0xffff0000u), s);
        s = fmaf(q[c * 8 + 4], __uint_as_float(w.z << 16), s); s = fmaf(q[c * 8 + 5], __uint_as_float(w.z & 0xffff0000u), s);
        s = fmaf(q[c * 8 + 6], __uint_as_float(w.w << 16), s); s = fmaf(q[c * 8 + 7], __uint_as_float(w.w & 0xffff0000u), s); }
    const float mn = fmaxf(st.m, s), sc = exp2f(st.m - mn), pp = exp2f(s - mn);
    st.l = st.l * sc + pp; st.m = mn;
#pragma unroll
    for (int c = 0; c < 8; ++c) { const u32x4 w = *(const u32x4*)(vrow + c * 8);
        o[c * 8 + 0] = fmaf(pp, __uint_as_float(w.x << 16), o[c * 8 + 0] * sc); o[c * 8 + 1] = fmaf(pp, __uint_as_float(w.x & 0xffff0000u), o[c * 8 + 1] * sc);
        o[c * 8 + 2] = fmaf(pp, __uint_as_float(w.y << 16), o[c * 8 + 2] * sc); o[c * 8 + 3] = fmaf(pp, __uint_as_float(w.y & 0xffff0000u), o[c * 8 + 3] * sc);
        o[c * 8 + 4] = fmaf(pp, __uint_as_float(w.z << 16), o[c * 8 + 4] * sc); o[c * 8 + 5] = fmaf(pp, __uint_as_float(w.z & 0xffff0000u), o[c * 8 + 5] * sc);
        o[c * 8 + 6] = fmaf(pp, __uint_as_float(w.w << 16), o[c * 8 + 6] * sc); o[c * 8 + 7] = fmaf(pp, __uint_as_float(w.w & 0xffff0000u), o[c * 8 + 7] * sc); }
}
__device__ __forceinline__ void store_o64(bf16_t* dst, const float (&o)[64], float inv) {
#pragma unroll
    for (int c = 0; c < 8; ++c) { u32x4 w; w.x = pk2(o[c * 8] * inv, o[c * 8 + 1] * inv); w.y = pk2(o[c * 8 + 2] * inv, o[c * 8 + 3] * inv);
        w.z = pk2(o[c * 8 + 4] * inv, o[c * 8 + 5] * inv); w.w = pk2(o[c * 8 + 6] * inv, o[c * 8 + 7] * inv); *(u32x4*)(dst + c * 8) = w; }
}
__device__ void p3_attn_naive(const Params& p, int gtid, int gsize) {
    const bf16_t* qkv = (const bf16_t*)(p.ws + WS_QKV); bf16_t* ob = (bf16_t*)(p.ws + WS_O);
    for (int it = gtid; it < NTOK * 16; it += gsize) {
        const bool isB = it >= NTOK * 8; const int w = isB ? it - NTOK * 8 : it;
        const int h = w & 7, tokg = w >> 3, b = tokg / L, t = tokg % L;
        float q[64], o[64];
#pragma unroll
        for (int d = 0; d < 64; ++d) o[d] = 0.f;
        OnlineSm st;
        if (!isB) {
            const int kvh = h >> 2;
            load_row64(qkv + (size_t)tokg * INW + C_QA + h * 64, q);
            st.m = p.sink_a[h] * LOG2E; st.l = 1.f;
            const int j0 = t - 128 < 0 ? 0 : t - 128, j1 = t + 128 > L - 1 ? L - 1 : t + 128;
            for (int j = j0; j <= j1; ++j) { const bf16_t* row = qkv + (size_t)(b * L + j) * INW; attn_key(q, o, st, row + C_KA + kvh * 64, row + C_VA + kvh * 64, 0.f); }
            for (int c = 0; c < CTX; ++c) { const bf16_t* row = qkv + (size_t)(NTOK + b * CTX + c) * INW; attn_key(q, o, st, row + C_KA + kvh * 64, row + C_VA + kvh * 64, 0.f); }
            store_o64(ob + (size_t)tokg * D + h * 64, o, 1.f / st.l);
        } else {
            load_row64(qkv + (size_t)tokg * INW + C_QB + h * 64, q);
            st.m = -1e30f; st.l = 0.f;
            const int r = t >> 6, c = t & 63;
            const int rs = r - 4 < 0 ? 0 : (r - 4 > 56 ? 56 : r - 4), cs = c - 8 < 0 ? 0 : (c - 8 > 48 ? 48 : c - 8);
            for (int a = 0; a < 8; ++a)
                for (int e = 0; e < 16; ++e) { const int kr = rs + a, kc = cs + e; const bf16_t* row = qkv + (size_t)(b * L + kr * 64 + kc) * INW;
                    const float bias = p.rpb_b[(h * 15 + (kr - r + 7)) * 31 + (kc - c + 15)] * LOG2E;
                    attn_key(q, o, st, row + C_KB + h * 64, row + C_VB + h * 64, bias); }
            for (int cc = 0; cc < CTX; ++cc) { const bf16_t* row = qkv + (size_t)(NTOK + b * CTX + cc) * INW; attn_key(q, o, st, row + C_KB + h * 64, row + C_VB + h * 64, 0.f); }
            store_o64(ob + (size_t)tokg * D + 512 + h * 64, o, 1.f / st.l);
        }
    }
}

__device__ void p4a_ostat(const Params& p, int gw, int ngw, int lane) {
    bf16_t* ob = (bf16_t*)(p.ws + WS_O); float* os = (float*)(p.ws + WS_OSTAT);
    for (int m = gw; m < NTOK; m += ngw) {
        const u32x4 wa = *(const u32x4*)(ob + (size_t)m * D + lane * 8), wb = *(const u32x4*)(ob + (size_t)m * D + 512 + lane * 8);
        float sa = 0.f, sb = 0.f;
#pragma unroll
        for (int i = 0; i < 4; ++i) { const unsigned ua = wa[i], ub = wb[i]; const float a0 = __uint_as_float(ua << 16), a1 = __uint_as_float(ua & 0xffff0000u), b0 = __uint_as_float(ub << 16), b1 = __uint_as_float(ub & 0xffff0000u);
            sa += a0 * a0 + a1 * a1; sb += b0 * b0 + b1 * b1; }
        sa = wave_sum(sa); sb = wave_sum(sb);
        const float ra = rsqrtf(sa * (1.f / 512.f) + EPS), rb = rsqrtf(sb * (1.f / 512.f) + EPS);
        if (lane == 0) { os[m * 2] = ra; os[m * 2 + 1] = rb; }
        u32x4 oa, obb;
#pragma unroll
        for (int i = 0; i < 4; ++i) { const unsigned ua = wa[i], ub = wb[i];
            oa[i] = pk2(__uint_as_float(ua << 16) * ra, __uint_as_float(ua & 0xffff0000u) * ra); obb[i] = pk2(__uint_as_float(ub << 16) * rb, __uint_as_float(ub & 0xffff0000u) * rb); }
        *(u32x4*)(ob + (size_t)m * D + lane * 8) = oa; *(u32x4*)(ob + (size_t)m * D + 512 + lane * 8) = obb;
    }
}
__device__ void p4b_outproj_naive(const Params& p, float* sA, float* sB) {
    const bf16_t* ob = (const bf16_t*)(p.ws + WS_O); const bf16_t* wT = (const bf16_t*)(p.ws + WS_WOUT);
    float* mix = (float*)(p.ws + WS_MIX);
    constexpr int NTN = D / 64, NT = (NTOK / 128) * NTN;
    for (int t = blockIdx.x; t < NT; t += gridDim.x) {
        const int m0 = (t / NTN) * 128, n0 = (t % NTN) * 64;
        auto al = [&](int r, int k) { return bf2f(ob[(size_t)r * D + k]); };
        auto bl = [&](int n, int k) { return bf2f(wT[(size_t)n * D + k]); };
        auto ep = [&](int r0, int nn0, int tx, float (&acc)[4][4]) {
#pragma unroll
            for (int i = 0; i < 4; ++i)
#pragma unroll
                for (int j = 0; j < 4; ++j) mix[(size_t)(r0 + i) * D + nn0 + tx + 16 * j] = acc[i][j];
        };
        ngemm_tile(sA, sB, m0, n0, D, al, bl, ep);
    }
}
__device__ void p4c_post(const Params& p, int gw, int ngw, int lane) {
    const float* mod = (const float*)(p.ws + WS_MOD); const float* mix = (const float*)(p.ws + WS_MIX);
    bf16_t* hb = (bf16_t*)(p.ws + WS_HB);
    unsigned* counts = (unsigned*)(p.ws + WS_CTL);
    int* tope = (int*)(p.ws + WS_TOPE); int* topr = (int*)(p.ws + WS_TOPR); float* topw = (float*)(p.ws + WS_TOPW);
    for (int m = gw; m < NTOK; m += ngw) {
        const int b = m / L; const float* mb = mod + b * 6144;
        f32x4 v[4], xv[4]; float s = 0.f;
#pragma unroll
        for (int j = 0; j < 4; ++j) { v[j] = ((const f32x4*)(mix + (size_t)m * D))[lane + 64 * j]; s += v[j].x * v[j].x + v[j].y * v[j].y + v[j].z * v[j].z + v[j].w * v[j].w; }
        float rstd = rsqrtf(wave_sum(s) * (1.f / D) + EPS);
        s = 0.f;
#pragma unroll
        for (int j = 0; j < 4; ++j) { const int c0 = 4 * (lane + 64 * j);
            const f32x4 g = *(const f32x4*)(p.g_post_mix + c0), ga = *(const f32x4*)(mb + 2048 + c0), xx = ((const f32x4*)(p.x + (size_t)m * D))[lane + 64 * j];
            xv[j] = xx + ga * (v[j] * rstd * g);
            ((f32x4*)(p.out + (size_t)m * D))[lane + 64 * j] = xv[j];
            s += xv[j].x * xv[j].x + xv[j].y * xv[j].y + xv[j].z * xv[j].z + xv[j].w * xv[j].w; }
        rstd = rsqrtf(wave_sum(s) * (1.f / D) + EPS);
        float lg[NE];
#pragma unroll
        for (int e = 0; e < NE; ++e) lg[e] = 0.f;
#pragma unroll
        for (int j = 0; j < 4; ++j) { const int c0 = 4 * (lane + 64 * j);
            const f32x4 g = *(const f32x4*)(p.g_pre_ffn + c0), sc = *(const f32x4*)(mb + 4096 + c0), sh = *(const f32x4*)(mb + 3072 + c0);
            const f32x4 h2 = (xv[j] * rstd * g) * (sc + 1.f) + sh;
            u32x2 w; w.x = pk2(h2.x, h2.y); w.y = pk2(h2.z, h2.w);
            *(u32x2*)(hb + (size_t)m * D + c0) = w;
#pragma unroll
            for (int q = 0; q < 4; ++q) { const float hv = h2[q]; const f32x4* wr = (const f32x4*)(p.w_router + (size_t)(c0 + q) * NE);
#pragma unroll
                for (int e4 = 0; e4 < 8; ++e4) { const f32x4 ww = wr[e4]; lg[e4 * 4] = fmaf(hv, ww.x, lg[e4 * 4]); lg[e4 * 4 + 1] = fmaf(hv, ww.y, lg[e4 * 4 + 1]); lg[e4 * 4 + 2] = fmaf(hv, ww.z, lg[e4 * 4 + 2]); lg[e4 * 4 + 3] = fmaf(hv, ww.w, lg[e4 * 4 + 3]); } }
        }
#pragma unroll
        for (int e = 0; e < NE; ++e) lg[e] = wave_sum(lg[e]) + p.b_router[e];
        float tv[4]; int ti[4]; unsigned used = 0u;
#pragma unroll
        for (int k = 0; k < 4; ++k) { float best = -3.4e38f; int bi = 0;
#pragma unroll
            for (int e = 0; e < NE; ++e) { const bool ok = !((used >> e) & 1u) && lg[e] > best; best = ok ? lg[e] : best; bi = ok ? e : bi; }
            tv[k] = best; ti[k] = bi; used |= 1u << bi; }
        const float e1 = __expf(tv[1] - tv[0]), e2 = __expf(tv[2] - tv[0]), e3 = __expf(tv[3] - tv[0]); const float inv = 1.f / (1.f + e1 + e2 + e3);
        const float tw[4] = {inv, e1 * inv, e2 * inv, e3 * inv};
        if (lane < 4) {
            int myi = ti[0]; float myw = tw[0];
#pragma unroll
            for (int k = 1; k < 4; ++k) if (lane == k) { myi = ti[k]; myw = tw[k]; }
            const unsigned rank = atomicAdd(&counts[myi], 1u);
            tope[m * 4 + lane] = myi; topr[m * 4 + lane] = (int)rank; topw[m * 4 + lane] = myw;
        }
    }
}
__device__ __forceinline__ void expert_bases(const unsigned* counts, int* sbase_  ) {
    __attribute__((address_space(3))) int* sbase = (__attribute__((address_space(3))) int*)sbase_;
    if (threadIdx.x < 64) {
        const int lane = threadIdx.x; const int c = lane < NE ? (((int)counts[lane] + 255) & ~255) : 0;
        int incl = c;
#pragma unroll
        for (int o = 1; o < 32; o <<= 1) { const int v = __shfl_up(incl, o); if (lane >= o) incl += v; }
        if (lane < NE) sbase[lane] = incl - c;
        if (lane == NE - 1) sbase[NE] = incl;
    }
    __syncthreads();
}
__device__ void p4d_rows(const Params& p, int gtid, int gsize, int* sbase) {
    const unsigned* counts = (const unsigned*)(p.ws + WS_CTL);
    const int* tope = (const int*)(p.ws + WS_TOPE); const int* topr = (const int*)(p.ws + WS_TOPR); const float* topw = (const float*)(p.ws + WS_TOPW);
    int* rtok = (int*)(p.ws + WS_ROWTOK); int* rslot = (int*)(p.ws + WS_ROWSLOT); float* rw = (float*)(p.ws + WS_ROWW);
    expert_bases(counts, sbase);
    for (int a = gtid; a < NASG; a += gsize) { const int e = tope[a], row = sbase[e] + topr[a]; rtok[row] = a >> 2; rslot[row] = a; rw[row] = topw[a]; }
    for (int i = gtid; i < NE * 256; i += gsize) { const int e = i >> 8, j = i & 255; const int row = sbase[e] + (int)counts[e] + j; if (row < sbase[e + 1]) { rtok[row] = 0; rslot[row] = -1; rw[row] = 0.f; } }
}
__device__ __forceinline__ int expert_of_row(const int* sbase, int row) { int e = 0;
#pragma unroll 1
    for (int i = 1; i < NE; ++i) e += (row >= sbase[i]) ? 1 : 0; return e; }
__device__ void p5a_gemm1_naive(const Params& p, float* sA, float* sB, int* sbase) {
    const unsigned* counts = (const unsigned*)(p.ws + WS_CTL);
    const bf16_t* hb = (const bf16_t*)(p.ws + WS_HB); const bf16_t* w1T = (const bf16_t*)(p.ws + WS_W1); bf16_t* act = (bf16_t*)(p.ws + WS_ACT);
    const int* rtok = (const int*)(p.ws + WS_ROWTOK);
    expert_bases(counts, sbase);
    const int total = sbase[NE]; constexpr int NTN = 2048 / 64; const int NT = (total / 128) * NTN;
    for (int t = blockIdx.x; t < NT; t += gridDim.x) {
        const int m0 = (t / NTN) * 128, n0 = (t % NTN) * 64; const int e = expert_of_row(sbase, m0);
        const bf16_t* wE = w1T + (size_t)e * 2048 * D; const float* b1 = p.b_mlp1 + (size_t)e * 2048;
        auto al = [&](int r, int k) { return bf2f(hb[(size_t)rtok[r] * D + k]); };
        auto bl = [&](int n, int k) { return bf2f(wE[(size_t)n * D + k]); };
        auto ep = [&](int r0, int nn0, int tx, float (&acc)[4][4]) {
#pragma unroll
            for (int i = 0; i < 4; ++i)
#pragma unroll
                for (int jj = 0; jj < 2; ++jj) { const int f = 16 * ((nn0 >> 5) + jj) + tx;
                    float gate = acc[i][2 * jj] + b1[2 * f], lin = acc[i][2 * jj + 1] + b1[2 * f + 1];
                    gate = fminf(gate, 7.f); lin = fminf(fmaxf(lin, -7.f), 7.f);
                    const float a = gate / (1.f + __expf(-1.702f * gate)) * (lin + 1.f);
                    act[(size_t)(r0 + i) * D + f] = (bf16_t)f2bf(a); }
        };
        ngemm_tile(sA, sB, m0, n0, D, al, bl, ep);
    }
}
__device__ void p5b_gemm2_naive(const Params& p, float* sA, float* sB, int* sbase) {
    const unsigned* counts = (const unsigned*)(p.ws + WS_CTL);
    const bf16_t* act = (const bf16_t*)(p.ws + WS_ACT); const bf16_t* w2T = (const bf16_t*)(p.ws + WS_W2); bf16_t* y = (bf16_t*)(p.ws + WS_Y);
    const int* rslot = (const int*)(p.ws + WS_ROWSLOT); const float* rw = (const float*)(p.ws + WS_ROWW);
    expert_bases(counts, sbase);
    const int total = sbase[NE]; constexpr int NTN = D / 64; const int NT = (total / 128) * NTN;
    for (int t = blockIdx.x; t < NT; t += gridDim.x) {
        const int m0 = (t / NTN) * 128, n0 = (t % NTN) * 64; const int e = expert_of_row(sbase, m0);
        const bf16_t* wE = w2T + (size_t)e * D * D; const float* b2 = p.b_mlp2 + (size_t)e * D;
        auto al = [&](int r, int k) { return bf2f(act[(size_t)r * D + k]); };
        auto bl = [&](int n, int k) { return bf2f(wE[(size_t)n * D + k]); };
        auto ep = [&](int r0, int nn0, int tx, float (&acc)[4][4]) {
#pragma unroll
            for (int i = 0; i < 4; ++i) { const int slot = rslot[r0 + i]; const float w = rw[r0 + i];
                if (slot >= 0) {
#pragma unroll
                    for (int j = 0; j < 4; ++j) { const int n = nn0 + tx + 16 * j; y[(size_t)slot * D + n] = (bf16_t)f2bf(w * (acc[i][j] + b2[n])); } } }
        };
        ngemm_tile(sA, sB, m0, n0, D, al, bl, ep);
    }
}
__device__ void p6_final(const Params& p, int gw, int ngw, int lane) {
    const float* mod = (const float*)(p.ws + WS_MOD); const bf16_t* y = (const bf16_t*)(p.ws + WS_Y);
    for (int m = gw; m < NTOK; m += ngw) {
        const int b = m / L; const float* ga2 = mod + b * 6144 + 5120;
        f32x4 v[4]; float s = 0.f;
#pragma unroll
        for (int j = 0; j < 4; ++j) { const int c0 = 4 * (lane + 64 * j); f32x4 a = {0.f, 0.f, 0.f, 0.f};
#pragma unroll
            for (int k = 0; k < 4; ++k) { const u32x2 w = *(const u32x2*)(y + (size_t)(m * 4 + k) * D + c0);
                a.x += __uint_as_float(w.x << 16); a.y += __uint_as_float(w.x & 0xffff0000u); a.z += __uint_as_float(w.y << 16); a.w += __uint_as_float(w.y & 0xffff0000u); }
            v[j] = a; s += a.x * a.x + a.y * a.y + a.z * a.z + a.w * a.w; }
        const float rstd = rsqrtf(wave_sum(s) * (1.f / D) + EPS);
#pragma unroll
        for (int j = 0; j < 4; ++j) { const int c0 = 4 * (lane + 64 * j);
            const f32x4 g = *(const f32x4*)(p.g_post_ffn + c0), ga = *(const f32x4*)(ga2 + c0);
            f32x4* o = (f32x4*)(p.out + (size_t)m * D) + lane + 64 * j;
            *o = *o + ga * (v[j] * rstd * g); }
    }
}

#ifndef USE_PG8_QKV
#define USE_PG8_QKV 1
#endif
#ifndef USE_PG8_OUT
#define USE_PG8_OUT 1
#endif
#ifndef USE_PG8_G1
#define USE_PG8_G1 1
#endif
#ifndef USE_PG8_G2
#define USE_PG8_G2 1
#endif
constexpr int LDS_SBASE = 131072;
constexpr int LDS_BYTES = 131072 + 1024;

__global__ void __launch_bounds__(NTHREADS, 2) fwd_kernel(Params p) {
    cg::grid_group grid = cg::this_grid();
    extern __shared__ __attribute__((aligned(16))) unsigned char lds[];
    float* sA = (float*)lds;
    float* sB = sA + 16 * 132;
    int* sbase = (int*)(lds + LDS_SBASE);
    float* sT = (float*)lds;
    const int tid = threadIdx.x, lane = tid & 63, wave = tid >> 6;
    const int gtid = blockIdx.x * NTHREADS + tid, gsize = gridDim.x * NTHREADS;
    const int gw = blockIdx.x * (NTHREADS / 64) + wave, ngw = gridDim.x * (NTHREADS / 64);
    PG8_LAS unsigned char* lds3 = (PG8_LAS unsigned char*)lds;
    const PG8_LAS int* sbase3 = (const PG8_LAS int*)(lds3 + LDS_SBASE);

    p0_mod(p, gtid, gsize); p0_tab(p, gtid, gsize); p0_weights(p, sT);
    grid.sync();
    p1_h(p, gw, ngw, lane);
    grid.sync();
#if USE_PG8_QKV
    { pg8::Gemm g{(const bf16_t*)(p.ws + WS_HB), (const bf16_t*)(p.ws + WS_WIN), D, 0, nullptr};
      pg8::StaticOrder S; S.init(MROWS, INW, (int)gridDim.x, (int)blockIdx.x, nullptr);
      pg8::EpiQKV E{(bf16_t*)(p.ws + WS_QKV), (const float*)(p.ws + WS_TAB)};
      pg8::gemm_phase<pg8::EpiQKV, pg8::StaticOrder, false, true>(lds3, g, S, E); }
#else
    p2_qkv_naive(p, sA, sB);
#endif
    grid.sync();
    p3_attn_naive(p, gtid, gsize);
    grid.sync();
    p4a_ostat(p, gw, ngw, lane);
    grid.sync();
#if USE_PG8_OUT
    { pg8::Gemm g{(const bf16_t*)(p.ws + WS_O), (const bf16_t*)(p.ws + WS_WOUT), D, 0, nullptr};
      pg8::StaticOrder S; S.init(NTOK, D, (int)gridDim.x, (int)blockIdx.x, nullptr);
      pg8::EpiF32 E{(float*)(p.ws + WS_MIX), D};
      pg8::gemm_phase<pg8::EpiF32, pg8::StaticOrder, false, true>(lds3, g, S, E); }
#else
    p4b_outproj_naive(p, sA, sB);
#endif
    grid.sync();
    p4c_post(p, gw, ngw, lane);
    grid.sync();
    p4d_rows(p, gtid, gsize, sbase);
    grid.sync();
#if USE_PG8_G1
    expert_bases((const unsigned*)(p.ws + WS_CTL), sbase);
    { const int total = sbase3[NE];
      pg8::Gemm g{(const bf16_t*)(p.ws + WS_HB), (const bf16_t*)(p.ws + WS_W1), D, (size_t)2048 * D * 2, (const int*)(p.ws + WS_ROWTOK)};
      pg8::StaticOrder S; S.init(total, 2048, (int)gridDim.x, (int)blockIdx.x, sbase3);
      pg8::EpiSwiglu E{(bf16_t*)(p.ws + WS_ACT), p.b_mlp1};
      pg8::gemm_phase<pg8::EpiSwiglu, pg8::StaticOrder, true, true>(lds3, g, S, E); }
#else
    p5a_gemm1_naive(p, sA, sB, sbase);
#endif
    grid.sync();
#if USE_PG8_G2
    expert_bases((const unsigned*)(p.ws + WS_CTL), sbase);
    { const int total = sbase3[NE];
      pg8::Gemm g{(const bf16_t*)(p.ws + WS_ACT), (const bf16_t*)(p.ws + WS_W2), D, (size_t)D * D * 2, nullptr};
      pg8::StaticOrder S; S.init(total, D, (int)gridDim.x, (int)blockIdx.x, sbase3);
      pg8::EpiScatter E{(bf16_t*)(p.ws + WS_Y), p.b_mlp2, (const int*)(p.ws + WS_ROWSLOT), (const float*)(p.ws + WS_ROWW)};
      pg8::gemm_phase<pg8::EpiScatter, pg8::StaticOrder, false, true>(lds3, g, S, E); }
#else
    p5b_gemm2_naive(p, sA, sB, sbase);
#endif
    grid.sync();
    p6_final(p, gw, ngw, lane);
}

extern "C" void kernel_launch(void* const* d_in, const int* in_sizes, int n_in, void* d_out, int out_size, void* d_ws, size_t ws_size, hipStream_t stream) {
    static int grid_blocks = 0;
    if (grid_blocks == 0) {
        if (n_in != 22 || ws_size < WS_END) { fprintf(stderr, "kernel_launch: unexpected n_in %d / ws_size %zu (need %zu)\n", n_in, ws_size, (size_t)WS_END); grid_blocks = -1; return; }
        int dev = 0, cus = 0, per_cu = 0;
        (void)hipGetDevice(&dev);
        (void)hipDeviceGetAttribute(&cus, hipDeviceAttributeMultiprocessorCount, dev);
        if (hipFuncSetAttribute((const void*)fwd_kernel, hipFuncAttributeMaxDynamicSharedMemorySize, LDS_BYTES) != hipSuccess) { fprintf(stderr, "kernel_launch: hipFuncSetAttribute failed\n"); grid_blocks = -1; return; }
        (void)hipOccupancyMaxActiveBlocksPerMultiprocessor(&per_cu, (const void*)fwd_kernel, NTHREADS, LDS_BYTES);
        if (per_cu < 1) { fprintf(stderr, "kernel_launch: occupancy query returned %d\n", per_cu); grid_blocks = -1; return; }
        grid_blocks = cus;
    }
    if (grid_blocks < 0) return;
    (void)hipMemsetAsync((char*)d_ws + WS_CTL, 0, CTL_BYTES, stream);
    Params p{};
    const float** pp = (const float**)&p;
    for (int i = 0; i < 22; ++i) pp[i] = (const float*)d_in[i];
    p.out = (float*)d_out; p.ws = (unsigned char*)d_ws;
    void* args[] = {&p};
    hipError_t e = hipLaunchCooperativeKernel((const void*)fwd_kernel, dim3(grid_blocks), dim3(NTHREADS), args, LDS_BYTES, stream);
    if (e != hipSuccess) fprintf(stderr, "cooperative launch failed: %s (grid %d)\n", hipGetErrorString(e), grid_blocks);
}
```

```cpp
#include <hip/hip_runtime.h>
#include <hip/hip_cooperative_groups.h>
#include <cstdio>
#include <cstdint>
namespace cg = cooperative_groups;

constexpr int D = 1024, NB = 8, L = 4096, CTX = 256;
constexpr int NTOK = NB * L, NCTX = NB * CTX, MROWS = NTOK + NCTX;
constexpr int INW = 2304;
constexpr int C_QA = 0, C_KA = 512, C_VA = 640, C_QB = 768, C_KB = 1280, C_VB = 1792;
constexpr int NE = 32, TOPK = 4, NASG = NTOK * TOPK;
constexpr int PADROWS = NASG + NE * 256;
constexpr float LOG2E = 1.4426950408889634f;
constexpr float QSCALE = 0.125f * LOG2E;
constexpr float EPS = 1e-6f;
constexpr int NTHREADS = 512;

constexpr size_t MiB = 1u << 20;
constexpr size_t WS_CTL = 0;
constexpr size_t CTL_BYTES = 4096;
constexpr size_t WS_MOD = 1 * MiB;
constexpr size_t WS_TAB = 1 * MiB + 256 * 1024;
constexpr size_t WS_OSTAT = 1 * MiB + 512 * 1024;
constexpr size_t WS_WIN = 2 * MiB;
constexpr size_t WS_WOUT = 7 * MiB;
constexpr size_t WS_W2 = 9 * MiB;
constexpr size_t WS_W1 = 73 * MiB;
constexpr size_t WS_HB = 201 * MiB;
constexpr size_t WS_TOPE = 269 * MiB;
constexpr size_t WS_TOPR = WS_TOPE + NASG * 4;
constexpr size_t WS_TOPW = WS_TOPR + NASG * 4;
constexpr size_t WS_ROWTOK = 271 * MiB;
constexpr size_t WS_ROWSLOT = WS_ROWTOK + PADROWS * 4;
constexpr size_t WS_ROWW = WS_ROWSLOT + PADROWS * 4;
constexpr size_t WS_QKV = 273 * MiB;
constexpr size_t WS_O = 426 * MiB;
constexpr size_t WS_MIX = 490 * MiB;
constexpr size_t WS_ACT = 273 * MiB;
constexpr size_t WS_Y = 618 * MiB;
constexpr size_t WS_END = 874 * MiB;
static_assert(WS_ROWW + PADROWS * 4 <= WS_QKV, "map");
static_assert(WS_QKV + (size_t)MROWS * INW * 2 <= WS_O, "map");
static_assert(WS_ACT + (size_t)PADROWS * 1024 * 2 <= WS_Y, "map");

typedef unsigned short bf16_t;
typedef float f32x4 __attribute__((ext_vector_type(4)));
typedef unsigned u32x4 __attribute__((ext_vector_type(4)));
typedef unsigned u32x2 __attribute__((ext_vector_type(2)));

struct Params {
    const float *x, *c, *ctx, *c_ctx, *w_ada, *b_ada, *g_pre_mix, *g_post_mix, *g_pre_ffn, *g_post_ffn, *w_in, *g_grp_a, *g_grp_b,
        *sink_a, *rpb_b, *w_out, *w_router, *b_router, *w_mlp1, *b_mlp1, *w_mlp2, *b_mlp2;
    float* out;
    unsigned char* ws;
};

__device__ __forceinline__ float bf2f(bf16_t h) { return __uint_as_float((unsigned)h << 16); }
__device__ __forceinline__ unsigned f2bf(float f) { unsigned u = __float_as_uint(f); return (u + 0x7fffu + ((u >> 16) & 1u)) >> 16; }
__device__ __forceinline__ unsigned pk2(float lo, float hi) { return f2bf(lo) | (f2bf(hi) << 16); }
__device__ __forceinline__ float wave_sum(float v) {
#pragma unroll
    for (int o = 1; o < 64; o <<= 1) v += __shfl_xor(v, o);
    return v;
}


namespace pg8 {
#define PG8_LAS __attribute__((address_space(3)))
typedef short bf16x8 __attribute__((ext_vector_type(8)));
constexpr int BM = 256, BK = 64, HALF = 128, HTB = HALF * BK * 2  , STAGE_BYTES = 8 * HTB, NXCD = 8, WGM = 8;
__device__ __forceinline__ int lds_byte(int r, int c) { const int st = (r >> 4) * 2 + (c >> 5), rr = r & 15, cc = c & 31, ob = rr * 64 + cc * 2; return st * 1024 + (ob ^ (((ob >> 9) & 1) << 5)); }
__device__ __forceinline__ void stage_rc(int b, int& R, int& C) { const int st = b / 1024, sb = b % 1024, swz = sb ^ (((sb >> 9) & 1) << 5); R = (st >> 1) * 16 + swz / 64; C = (st & 1) * 32 + (swz % 64) / 2; }
__device__ __forceinline__ int perm32(int rho) { const int n = rho >> 4, i = rho & 15; return 8 * (i >> 2) + 4 * n + (i & 3); }

struct Unit { int pm, pn, e; };
struct Gemm { const bf16_t* A; const bf16_t* Bt; int K; size_t bstride; const int* rowidx; };

struct StaticOrder {
    int nM, nN, nwg, G, c; const PG8_LAS int* sbase;
    __device__ void init(int M, int N, int G_, int c_, const PG8_LAS int* sb) { nM = M / BM; nN = N / BM; nwg = nM * nN; G = G_; c = c_; sbase = sb; }
    __device__ bool next(int i, Unit& u) const {
        const long Lx = (long)i * G + c; if (Lx >= nwg) return false;
        int wgid = (int)Lx; { const int q = nwg / NXCD, r = nwg % NXCD, xcd = wgid % NXCD, off = wgid / NXCD; wgid = (xcd < r ? xcd * (q + 1) : r * (q + 1) + (xcd - r) * q) + off; }
        const int nig = WGM * nN, gid = wgid / nig, fm = gid * WGM, gsz = (nM - fm) < WGM ? (nM - fm) : WGM;
        u.pm = fm + ((wgid % nig) % gsz); u.pn = (wgid % nig) / gsz; u.e = 0;
        if (sbase) { const int row = u.pm * BM; int e = 0;
#pragma unroll 1
            for (int j = 1; j < 32; ++j) e += (row >= sbase[j]) ? 1 : 0;
            u.e = e; }
        return true;
    }
};

template <class Epi, class Sched, bool GATHER, bool ALIGN_EPI>
__device__ __forceinline__ void gemm_phase(PG8_LAS unsigned char* lds, const Gemm g, const Sched& S, const Epi& E) {
    const int tid = threadIdx.x, wid = __builtin_amdgcn_readfirstlane(tid >> 6), lane = tid & 63, wr = wid >> 2, wc = wid & 3, fr = lane & 15, fq = lane >> 4;
    const int K = g.K, nt = K / BK;
    unsigned voffA[2], voffB[2]; int RA[2], CA[2];
#pragma unroll
    for (int i = 0; i < 2; ++i) { int R, C; stage_rc(tid * 16 + i * 8192, R, C); const int Rb = Epi::PERM ? ((R & ~31) + perm32(R & 31)) : R;
        voffA[i] = (unsigned)(R * K + C) * 2u; voffB[i] = (unsigned)(Rb * K + C) * 2u; RA[i] = R; CA[i] = C * 2; }
    const size_t kstep = (size_t)(BK * 2);
    const size_t hstep = (size_t)HALF * K * 2;
    const size_t tstep = 2 * hstep;
    const unsigned ldsw = (unsigned)wid * 1024u;
    const int aoff = lds_byte(wr * 64 + fr, fq * 8), boff = lds_byte(wc * 32 + fr, fq * 8);
#define PG8_SA(b, h) (((b) * 2 + (h)) * HTB)
#define PG8_SB(b, h) ((4 + (b) * 2 + (h)) * HTB)
#define PG8_STAGE(bufoff, gbase, voff) do { _Pragma("unroll") for (int _i = 0; _i < 2; ++_i) \
        __builtin_amdgcn_global_load_lds((const unsigned*)((const char*)(gbase) + (voff)[_i]), (PG8_LAS unsigned*)(lds + (bufoff) + ldsw + _i * 8192), 16, 0, 0); } while (0)
#define PG8_LDA(dst, b, h) do { _Pragma("unroll") for (int m = 0; m < 4; ++m) _Pragma("unroll") for (int k = 0; k < 2; ++k) dst[m][k] = *(const PG8_LAS bf16x8*)(lds + PG8_SA(b, h) + aoff + m * 2048 + k * 1024); } while (0)
#define PG8_LDB(dst, b, h) do { _Pragma("unroll") for (int n = 0; n < 2; ++n) _Pragma("unroll") for (int k = 0; k < 2; ++k) dst[n][k] = *(const PG8_LAS bf16x8*)(lds + PG8_SB(b, h) + boff + n * 2048 + k * 1024); } while (0)
#define PG8_MMA(ai, bj, At, Bt) do { __builtin_amdgcn_s_setprio(1); _Pragma("unroll") for (int m = 0; m < 4; ++m) _Pragma("unroll") for (int n = 0; n < 2; ++n) _Pragma("unroll") for (int k = 0; k < 2; ++k) \
        acc[ai][bj][m][n] = __builtin_amdgcn_mfma_f32_16x16x32_bf16(Bt[n][k], At[m][k], acc[ai][bj][m][n], 0, 0, 0); __builtin_amdgcn_s_setprio(0); } while (0)
#define PG8_WAIT_V(n) asm volatile("s_waitcnt vmcnt(" #n ")" ::: "memory")
#define PG8_WAIT_L(n) asm volatile("s_waitcnt lgkmcnt(" #n ")" ::: "memory")
#define PG8_BAR __builtin_amdgcn_s_barrier()
#define PG8_SCHED __builtin_amdgcn_sched_barrier(0)
#define PG8_SETOFF(off, u) do { _Pragma("unroll") for (int _h = 0; _h < 2; ++_h) _Pragma("unroll") for (int _i = 0; _i < 2; ++_i) { \
        if (GATHER) off[_h][_i] = (unsigned)g.rowidx[(u).pm * BM + _h * HALF + RA[_i]] * (unsigned)(K * 2) + (unsigned)CA[_i]; \
        else off[_h][_i] = voffA[_i] + (unsigned)(_h * hstep); } } while (0)
    Unit cur, nxt; int ui = 0;
    if (!S.next(0, cur)) return;
    f32x4 acc[2][2][4][2];
#pragma unroll
    for (int a = 0; a < 2; ++a)
#pragma unroll
        for (int b = 0; b < 2; ++b)
#pragma unroll
            for (int m = 0; m < 4; ++m)
#pragma unroll
                for (int n = 0; n < 2; ++n) acc[a][b][m][n] = (f32x4){0.f, 0.f, 0.f, 0.f};
    bf16x8 At[4][2], B0[2][2], B1[2][2];
    unsigned offc[2][2], offn[2][2];
    PG8_SETOFF(offc, cur);
    const char* cA = GATHER ? (const char*)g.A : (const char*)g.A + (size_t)cur.pm * tstep;
    const char* cB = (const char*)g.Bt + (size_t)cur.e * g.bstride + (size_t)cur.pn * tstep;
    PG8_STAGE(PG8_SB(0, 0), cB, voffB); PG8_STAGE(PG8_SB(0, 1), cB + hstep, voffB); PG8_STAGE(PG8_SA(0, 0), cA, offc[0]); PG8_STAGE(PG8_SA(0, 1), cA, offc[1]);
    if (wr == 1) PG8_BAR;
    PG8_WAIT_V(2); PG8_BAR;
    PG8_STAGE(PG8_SB(1, 0), cB + kstep, voffB); PG8_STAGE(PG8_SA(1, 0), cA + kstep, offc[0]); PG8_STAGE(PG8_SB(1, 1), cB + hstep + kstep, voffB);
    PG8_WAIT_V(6); PG8_BAR;
    for (;;) {
        const bool has_next = S.next(ui + 1, nxt);
        const char* nA = GATHER ? cA : (has_next ? (const char*)g.A + (size_t)nxt.pm * tstep : cA);
        const char* nB = has_next ? (const char*)g.Bt + (size_t)nxt.e * g.bstride + (size_t)nxt.pn * tstep : cB;
        if (GATHER) { if (has_next) { PG8_SETOFF(offn, nxt); } else {
#pragma unroll
            for (int h = 0; h < 2; ++h)
#pragma unroll
                for (int i = 0; i < 2; ++i) offn[h][i] = offc[h][i]; } }
        for (int t = 0; t < nt; t += 2) {
            const bool last = (t == nt - 2);
            const char* a1 = cA + (size_t)(t + 1) * kstep;
            const char* a2 = last ? nA : cA + (size_t)(t + 2) * kstep; const char* b2 = last ? nB : cB + (size_t)(t + 2) * kstep;
            const char* a3 = a2 + kstep; const char* b3 = b2 + kstep;
            unsigned o2[2][2];
#pragma unroll
            for (int h = 0; h < 2; ++h)
#pragma unroll
                for (int i = 0; i < 2; ++i) o2[h][i] = (GATHER && last) ? offn[h][i] : offc[h][i];
            PG8_LDB(B0, 0, 0); PG8_LDB(B1, 0, 1); PG8_SCHED; PG8_LDA(At, 0, 0); PG8_STAGE(PG8_SA(1, 1), a1, offc[1]);
            PG8_WAIT_V(8); PG8_WAIT_L(0); PG8_BAR; PG8_MMA(0, 0, At, B0); PG8_MMA(0, 1, At, B1); PG8_BAR; PG8_SCHED;
            PG8_LDA(At, 0, 1); PG8_STAGE(PG8_SB(0, 0), b2, voffB); PG8_STAGE(PG8_SB(0, 1), b2 + hstep, voffB); PG8_STAGE(PG8_SA(0, 0), a2, o2[0]);
            PG8_WAIT_V(8); PG8_WAIT_L(0); PG8_BAR; PG8_MMA(1, 0, At, B0); PG8_MMA(1, 1, At, B1); PG8_BAR; PG8_SCHED;
            PG8_LDB(B0, 1, 0); PG8_LDB(B1, 1, 1); PG8_SCHED; PG8_LDA(At, 1, 0); PG8_STAGE(PG8_SA(0, 1), a2, o2[1]);
            PG8_WAIT_V(8); PG8_WAIT_L(0); PG8_BAR; PG8_MMA(0, 0, At, B0); PG8_MMA(0, 1, At, B1); PG8_BAR; PG8_SCHED;
            PG8_LDA(At, 1, 1); PG8_STAGE(PG8_SB(1, 0), b3, voffB); PG8_STAGE(PG8_SB(1, 1), b3 + hstep, voffB); PG8_STAGE(PG8_SA(1, 0), a3, o2[0]);
            PG8_WAIT_V(8); PG8_WAIT_L(0); PG8_BAR; PG8_MMA(1, 0, At, B0); PG8_MMA(1, 1, At, B1); PG8_BAR; PG8_SCHED;
        }
        if constexpr (ALIGN_EPI) { if (wr == 0) PG8_BAR; }
        E(acc, cur, wr, wc, fr, fq);
        if (!has_next) break;
#pragma unroll
        for (int a = 0; a < 2; ++a)
#pragma unroll
            for (int b = 0; b < 2; ++b)
#pragma unroll
                for (int m = 0; m < 4; ++m)
#pragma unroll
                    for (int n = 0; n < 2; ++n) acc[a][b][m][n] = (f32x4){0.f, 0.f, 0.f, 0.f};
        cur = nxt; cA = nA; cB = nB; ++ui;
#pragma unroll
        for (int h = 0; h < 2; ++h)
#pragma unroll
            for (int i = 0; i < 2; ++i) offc[h][i] = offn[h][i];
        if constexpr (ALIGN_EPI) { if (wr == 1) PG8_BAR; }
    }
    PG8_WAIT_V(0);
    if constexpr (!ALIGN_EPI) { if (wr == 0) PG8_BAR; }
    PG8_BAR;
#undef PG8_SA
#undef PG8_SB
#undef PG8_STAGE
#undef PG8_LDA
#undef PG8_LDB
#undef PG8_MMA
#undef PG8_WAIT_V
#undef PG8_WAIT_L
#undef PG8_BAR
#undef PG8_SCHED
#undef PG8_SETOFF
}

struct EpiQKV {
    static constexpr bool PERM = false;
    bf16_t* O; const float* tab;
    __device__ __forceinline__ void operator()(const f32x4 (&acc)[2][2][4][2], const Unit& u, int wr, int wc, int fr, int fq) const {
        const bool latent = u.pm < NTOK / BM;
#pragma unroll
        for (int ai = 0; ai < 2; ++ai)
#pragma unroll
            for (int m = 0; m < 4; ++m) {
                const int row = u.pm * BM + ai * HALF + wr * 64 + m * 16 + fr;
                bf16_t* rowp = O + (size_t)row * INW + u.pn * BM + wc * 32 + 4 * fq;
                const int pos = row & (L - 1), pp = (wc & 1) ? (pos & 63) : (pos >> 6);
                const f32x4* tp = (const f32x4*)(tab + (pp * 16 + 4 * fq) * 2);
#pragma unroll
                for (int bj = 0; bj < 2; ++bj) {
                    const int colbase = u.pn * BM + bj * HALF;
                    f32x4 v0 = acc[ai][bj][m][0], v1 = acc[ai][bj][m][1];
                    if (latent && colbase < C_VA) {
                        const f32x4 t0 = tp[0], t1 = tp[1];
                        const f32x4 cs = {t0.x, t0.z, t1.x, t1.z}, sn = {t0.y, t0.w, t1.y, t1.w};
                        const f32x4 a0 = v0 * cs - v1 * sn, a1 = v1 * cs + v0 * sn; v0 = a0; v1 = a1;
                    }
                    if (colbase < C_KA || (colbase >= C_QB && colbase < C_KB)) { v0 = v0 * QSCALE; v1 = v1 * QSCALE; }
                    u32x2 w0, w1; w0.x = pk2(v0.x, v0.y); w0.y = pk2(v0.z, v0.w); w1.x = pk2(v1.x, v1.y); w1.y = pk2(v1.z, v1.w);
                    *(u32x2*)(rowp + bj * HALF) = w0; *(u32x2*)(rowp + bj * HALF + 16) = w1;
                }
            }
    }
};
struct EpiF32 {
    static constexpr bool PERM = false;
    float* O; int ldc;
    __device__ __forceinline__ void operator()(const f32x4 (&acc)[2][2][4][2], const Unit& u, int wr, int wc, int fr, int fq) const {
#pragma unroll
        for (int ai = 0; ai < 2; ++ai)
#pragma unroll
            for (int m = 0; m < 4; ++m) {
                float* rowp = O + (size_t)(u.pm * BM + ai * HALF + wr * 64 + m * 16 + fr) * ldc + u.pn * BM + wc * 32 + 4 * fq;
#pragma unroll
                for (int bj = 0; bj < 2; ++bj)
#pragma unroll
                    for (int n = 0; n < 2; ++n) *(f32x4*)(rowp + bj * HALF + 16 * n) = acc[ai][bj][m][n];
            }
    }
};
struct EpiSwiglu {
    static constexpr bool PERM = false;
    bf16_t* act; const float* b1;
    __device__ __forceinline__ void operator()(const f32x4 (&acc)[2][2][4][2], const Unit& u, int wr, int wc, int fr, int fq) const {
#pragma unroll
        for (int bj = 0; bj < 2; ++bj) {
            const int f0 = 16 * (8 * u.pn + 4 * bj + wc) + 4 * fq;
            const f32x4* bp = (const f32x4*)(b1 + (size_t)u.e * 2048 + 2 * f0); const f32x4 bA = bp[0], bB = bp[1];
            const f32x4 bg = {bA.x, bA.z, bB.x, bB.z}, bl = {bA.y, bA.w, bB.y, bB.w};
#pragma unroll
            for (int ai = 0; ai < 2; ++ai)
#pragma unroll
                for (int m = 0; m < 4; ++m) {
                    const int row = u.pm * BM + ai * HALF + wr * 64 + m * 16 + fr;
                    const f32x4 gt = acc[ai][bj][m][0] + bg, ln = acc[ai][bj][m][1] + bl; float a[4];
#pragma unroll
                    for (int j = 0; j < 4; ++j) { const float gg = fminf(gt[j], 7.f), ll = fminf(fmaxf(ln[j], -7.f), 7.f);
                        a[j] = gg * __builtin_amdgcn_rcpf(1.f + __expf(-1.702f * gg)) * (ll + 1.f); }
                    u32x2 w; w.x = pk2(a[0], a[1]); w.y = pk2(a[2], a[3]);
                    *(u32x2*)(act + (size_t)row * D + f0) = w;
                }
        }
    }
};
struct EpiScatter {
    static constexpr bool PERM = true;
    bf16_t* y; const float* b2; const int* rslot; const float* rw;
    __device__ __forceinline__ void operator()(const f32x4 (&acc)[2][2][4][2], const Unit& u, int wr, int wc, int fr, int fq) const {
        const int col0 = u.pn * BM + wc * 32 + 8 * fq;
        f32x4 bv[2][2];
#pragma unroll
        for (int bj = 0; bj < 2; ++bj)
#pragma unroll
            for (int n = 0; n < 2; ++n) bv[bj][n] = *(const f32x4*)(b2 + (size_t)u.e * D + col0 + bj * HALF + 4 * n);
#pragma unroll
        for (int ai = 0; ai < 2; ++ai)
#pragma unroll
            for (int m = 0; m < 4; ++m) {
                const int row = u.pm * BM + ai * HALF + wr * 64 + m * 16 + fr;
                const int slot = rslot[row]; const float w = rw[row];
                if (slot >= 0) {
                    bf16_t* rowp = y + (size_t)slot * D + col0;
#pragma unroll
                    for (int bj = 0; bj < 2; ++bj) { const f32x4 v0 = (acc[ai][bj][m][0] + bv[bj][0]) * w, v1 = (acc[ai][bj][m][1] + bv[bj][1]) * w;
                        u32x4 o; o.x = pk2(v0.x, v0.y); o.y = pk2(v0.z, v0.w); o.z = pk2(v1.x, v1.y); o.w = pk2(v1.z, v1.w);
                        *(u32x4*)(rowp + bj * HALF) = o; }
                }
            }
    }
};
}

__device__ void p0_mod(const Params& p, int gtid, int gsize) {
    float* mod = (float*)(p.ws + WS_MOD);
    for (int idx = gtid; idx < 9 * 6144; idx += gsize) {
        const int r = idx / 6144, j = idx % 6144;
        const float* cv = r < 8 ? p.c + r * D : p.c_ctx;
        float acc = p.b_ada[j];
        for (int k = 0; k < D; ++k) { const float cc = cv[k]; acc += (cc / (1.f + __expf(-cc))) * p.w_ada[(size_t)k * 6144 + j]; }
        mod[idx] = acc;
    }
}
__device__ void p0_tab(const Params& p, int gtid, int gsize) {
    float* tab = (float*)(p.ws + WS_TAB);
    for (int idx = gtid; idx < 64 * 16; idx += gsize) {
        const int pos = idx >> 4, i = idx & 15;
        const float freq = exp2f(-(float)i * (13.287712379549449f / 16.f));
        const float ang = (float)pos * freq;
        const float n = rintf(ang * 0.15915494309189535f);
        float r = fmaf(-n, 6.28125f, ang); r = fmaf(-n, 1.9353071795864769e-3f, r);
        tab[idx * 2] = __cosf(r); tab[idx * 2 + 1] = __sinf(r);
    }
}
template <int MODE>
__device__ void transpose_tile(const float* src, int K, int N, bf16_t* dst, int tk, int tn, float* sT, const float* gA, const float* gB) {
    const int tid = threadIdx.x, k0 = tk * 64, n0 = tn * 64;
#pragma unroll
    for (int i = 0; i < 8; ++i) {
        const int e = tid + NTHREADS * i, kl = e >> 6, cc = e & 63;
        float v = src[(size_t)(k0 + kl) * N + n0 + cc];
        int nl = cc;
        if (MODE == 1) { const int f = cc >> 1, n = cc & 1; nl = 32 * (f >> 4) + 16 * n + (f & 15); }
        if (MODE == 2) { const int k = k0 + kl; v *= (k < 512 ? gA[k] : gB[k - 512]); }
        sT[nl * 65 + kl] = v;
    }
    __syncthreads();
    {
        const int nl = tid >> 3, ch = tid & 7; const float* s = sT + nl * 65 + ch * 8;
        u32x4 o; o.x = pk2(s[0], s[1]); o.y = pk2(s[2], s[3]); o.z = pk2(s[4], s[5]); o.w = pk2(s[6], s[7]);
        *(u32x4*)(dst + (size_t)(n0 + nl) * K + k0 + ch * 8) = o;
    }
    __syncthreads();
}
__device__ void p0_weights(const Params& p, float* sT) {
    constexpr int I_IN = 16 * 36, I_OUT = 16 * 16, I_W1 = 16 * 32, I_W2 = 16 * 16;
    constexpr int NITEMS = I_IN + I_OUT + NE * I_W1 + NE * I_W2;
    for (int it = blockIdx.x; it < NITEMS; it += gridDim.x) {
        int r = it;
        if (r < I_IN) { transpose_tile<0>(p.w_in, D, INW, (bf16_t*)(p.ws + WS_WIN), r / 36, r % 36, sT, nullptr, nullptr); continue; } r -= I_IN;
        if (r < I_OUT) { transpose_tile<2>(p.w_out, D, D, (bf16_t*)(p.ws + WS_WOUT), r / 16, r % 16, sT, p.g_grp_a, p.g_grp_b); continue; } r -= I_OUT;
        if (r < NE * I_W1) { const int e = r / I_W1, q = r % I_W1;
            transpose_tile<1>(p.w_mlp1 + (size_t)e * D * 2048, D, 2048, (bf16_t*)(p.ws + WS_W1) + (size_t)e * 2048 * D, q / 32, q % 32, sT, nullptr, nullptr); continue; } r -= NE * I_W1;
        { const int e = r / I_W2, q = r % I_W2;
            transpose_tile<0>(p.w_mlp2 + (size_t)e * D * D, D, D, (bf16_t*)(p.ws + WS_W2) + (size_t)e * D * D, q / 16, q % 16, sT, nullptr, nullptr); }
    }
}

__device__ void p1_h(const Params& p, int gw, int ngw, int lane) {
    const float* mod = (const float*)(p.ws + WS_MOD);
    bf16_t* hb = (bf16_t*)(p.ws + WS_HB);
    for (int m = gw; m < MROWS; m += ngw) {
        const float* xr = m < NTOK ? p.x + (size_t)m * D : p.ctx + (size_t)(m - NTOK) * D;
        const int b = m < NTOK ? m / L : 8;
        const float* sh = mod + b * 6144, * sc = sh + 1024;
        f32x4 v[4]; float s = 0.f;
#pragma unroll
        for (int j = 0; j < 4; ++j) { v[j] = ((const f32x4*)xr)[lane + 64 * j]; s += v[j].x * v[j].x + v[j].y * v[j].y + v[j].z * v[j].z + v[j].w * v[j].w; }
        const float rstd = rsqrtf(wave_sum(s) * (1.f / D) + EPS);
#pragma unroll
        for (int j = 0; j < 4; ++j) {
            const int c0 = 4 * (lane + 64 * j);
            const f32x4 g = *(const f32x4*)(p.g_pre_mix + c0), a = *(const f32x4*)(sc + c0), bsh = *(const f32x4*)(sh + c0);
            const f32x4 o = (v[j] * rstd * g) * (a + 1.f) + bsh;
            u32x2 w; w.x = pk2(o.x, o.y); w.y = pk2(o.z, o.w);
            *(u32x2*)(hb + (size_t)m * D + c0) = w;
        }
    }
}

template <class AL, class BL, class EP>
__device__ __forceinline__ void ngemm_tile(float* sA, float* sB, int m0, int n0, int K, const AL& aload, const BL& bload, const EP& epi) {
    const int tid = threadIdx.x, ty = tid >> 4, tx = tid & 15;
    float acc[4][4];
#pragma unroll
    for (int i = 0; i < 4; ++i)
#pragma unroll
        for (int j = 0; j < 4; ++j) acc[i][j] = 0.f;
    for (int k0 = 0; k0 < K; k0 += 16) {
#pragma unroll
        for (int i = 0; i < 4; ++i) { const int e = tid + NTHREADS * i, r = e >> 4, kk = e & 15; sA[kk * 132 + r] = aload(m0 + r, k0 + kk); }
#pragma unroll
        for (int i = 0; i < 2; ++i) { const int e = tid + NTHREADS * i, n = e >> 4, kk = e & 15; sB[kk * 68 + n] = bload(n0 + n, k0 + kk); }
        __syncthreads();
#pragma unroll
        for (int kk = 0; kk < 16; ++kk) {
            float a[4], b[4];
#pragma unroll
            for (int i = 0; i < 4; ++i) a[i] = sA[kk * 132 + ty * 4 + i];
#pragma unroll
            for (int j = 0; j < 4; ++j) b[j] = sB[kk * 68 + tx + 16 * j];
#pragma unroll
            for (int i = 0; i < 4; ++i)
#pragma unroll
                for (int j = 0; j < 4; ++j) acc[i][j] = fmaf(a[i], b[j], acc[i][j]);
        }
        __syncthreads();
    }
    epi(m0 + ty * 4, n0, tx, acc);
}

__device__ void p2_qkv_naive(const Params& p, float* sA, float* sB) {
    const bf16_t* hb = (const bf16_t*)(p.ws + WS_HB); const bf16_t* wT = (const bf16_t*)(p.ws + WS_WIN);
    bf16_t* qkv = (bf16_t*)(p.ws + WS_QKV); const float* tab = (const float*)(p.ws + WS_TAB);
    constexpr int NTN = INW / 64, NT = (MROWS / 128) * NTN;
    for (int t = blockIdx.x; t < NT; t += gridDim.x) {
        const int m0 = (t / NTN) * 128, n0 = (t % NTN) * 64;
        auto al = [&](int r, int k) { return bf2f(hb[(size_t)r * D + k]); };
        auto bl = [&](int n, int k) { return bf2f(wT[(size_t)n * D + k]); };
        auto ep = [&](int r0, int nn0, int tx, float (&acc)[4][4]) {
#pragma unroll
            for (int i = 0; i < 4; ++i) {
                const int r = r0 + i; float v0 = acc[i][0], v1 = acc[i][1], v2 = acc[i][2], v3 = acc[i][3];
                const bool rope = (nn0 < C_VA) && (r < NTOK);
                if (rope) { const int t = r & (L - 1), pr = t >> 6, pc = t & 63;
                    const float c0 = tab[(pr * 16 + tx) * 2], s0 = tab[(pr * 16 + tx) * 2 + 1], c1 = tab[(pc * 16 + tx) * 2], s1 = tab[(pc * 16 + tx) * 2 + 1];
                    const float a0 = v0 * c0 - v1 * s0, a1 = v1 * c0 + v0 * s0, a2 = v2 * c1 - v3 * s1, a3 = v3 * c1 + v2 * s1; v0 = a0; v1 = a1; v2 = a2; v3 = a3; }
                const bool isq = (nn0 < C_KA) || (nn0 >= C_QB && nn0 < C_KB);
                if (isq) { v0 *= QSCALE; v1 *= QSCALE; v2 *= QSCALE; v3 *= QSCALE; }
                bf16_t* o = qkv + (size_t)r * INW + nn0 + tx;
                o[0] = (bf16_t)f2bf(v0); o[16] = (bf16_t)f2bf(v1); o[32] = (bf16_t)f2bf(v2); o[48] = (bf16_t)f2bf(v3);
            }
        };
        ngemm_tile(sA, sB, m0, n0, D, al, bl, ep);
    }
}

__device__ __forceinline__ void load_row64(const bf16_t* src, float* dst) {
#pragma unroll
    for (int c = 0; c < 8; ++c) { const u32x4 w = *(const u32x4*)(src + c * 8);
        dst[c * 8 + 0] = __uint_as_float(w.x << 16); dst[c * 8 + 1] = __uint_as_float(w.x & 0xffff0000u);
        dst[c * 8 + 2] = __uint_as_float(w.y << 16); dst[c * 8 + 3] = __uint_as_float(w.y & 0xffff0000u);
        dst[c * 8 + 4] = __uint_as_float(w.z << 16); dst[c * 8 + 5] = __uint_as_float(w.z & 0xffff0000u);
        dst[c * 8 + 6] = __uint_as_float(w.w << 16); dst[c * 8 + 7] = __uint_as_float(w.w & 0xffff0000u); }
}
struct OnlineSm { float m, l; };
__device__ __forceinline__ void attn_key(const float (&q)[64], float (&o)[64], OnlineSm& st, const bf16_t* krow, const bf16_t* vrow, float bias) {
    float s = bias;
#pragma unroll
    for (int c = 0; c < 8; ++c) { const u32x4 w = *(const u32x4*)(krow + c * 8);
        s = fmaf(q[c * 8 + 0], __uint_as_float(w.x << 16), s); s = fmaf(q[c * 8 + 1], __uint_as_float(w.x & 0xffff0000u), s);
        s = fmaf(q[c * 8 + 2], __uint_as_float(w.y << 16), s); s = fmaf(q[c * 8 + 3], __uint_as_float(w.y & 0xffff0000u), s);
        s = fmaf(q[c * 8 + 4], __uint_as_float(w.z << 16), s); s = fmaf(q[c * 8 + 5], __uint_as_float(w.z & 0xffff0000u), s);
        s = fmaf(q[c * 8 + 6], __uint_as_float(w.w << 16), s); s = fmaf(q[c * 8 + 7], __uint_as_float(w.w & 0xffff0000u), s); }
    const float mn = fmaxf(st.m, s), sc = exp2f(st.m - mn), pp = exp2f(s - mn);
    st.l = st.l * sc + pp; st.m = mn;
#pragma unroll
    for (int c = 0; c < 8; ++c) { const u32x4 w = *(const u32x4*)(vrow + c * 8);
        o[c * 8 + 0] = fmaf(pp, __uint_as_float(w.x << 16), o[c * 8 + 0] * sc); o[c * 8 + 1] = fmaf(pp, __uint_as_float(w.x & 0xffff0000u), o[c * 8 + 1] * sc);
        o[c * 8 + 2] = fmaf(pp, __uint_as_float(w.y << 16), o[c * 8 + 2] * sc); o[c * 8 + 3] = fmaf(pp, __uint_as_float(w.y & 0xffff0000u), o[c * 8 + 3] * sc);
        o[c * 8 + 4] = fmaf(pp, __uint_as_float(w.z << 16), o[c * 8 + 4] * sc); o[c * 8 + 5] = fmaf(pp, __uint_as_float(w.z & 0xffff0000u), o[c * 8 + 5] * sc);
        o[c * 8 + 6] = fmaf(pp, __uint_as_float(w.w << 16), o[c * 8 + 6] * sc); o[c * 8 + 7] = fmaf(pp, __uint_as_float(w.w & 0xffff0000u), o[c * 8 + 7] * sc); }
}
__device__ __forceinline__ void store_o64(bf16_t* dst, const float (&o)[64], float inv) {
#pragma unroll
    for (int c = 0; c < 8; ++c) { u32x4 w; w.x = pk2(o[c * 8] * inv, o[c * 8 + 1] * inv); w.y = pk2(o[c * 8 + 2] * inv, o[c * 8 + 3] * inv);
        w.z = pk2(o[c * 8 + 4] * inv, o[c * 8 + 5] * inv); w.w = pk2(o[c * 8 + 6] * inv, o[c * 8 + 7] * inv); *(u32x4*)(dst + c * 8) = w; }
}
__device__ void p3_attn_naive(const Params& p, int gtid, int gsize) {
    const bf16_t* qkv = (const bf16_t*)(p.ws + WS_QKV); bf16_t* ob = (bf16_t*)(p.ws + WS_O);
    for (int it = gtid; it < NTOK * 16; it += gsize) {
        const bool isB = it >= NTOK * 8; const int w = isB ? it - NTOK * 8 : it;
        const int h = w & 7, tokg = w >> 3, b = tokg / L, t = tokg % L;
        float q[64], o[64];
#pragma unroll
        for (int d = 0; d < 64; ++d) o[d] = 0.f;
        OnlineSm st;
        if (!isB) {
            const int kvh = h >> 2;
            load_row64(qkv + (size_t)tokg * INW + C_QA + h * 64, q);
            st.m = p.sink_a[h] * LOG2E; st.l = 1.f;
            const int j0 = t - 128 < 0 ? 0 : t - 128, j1 = t + 128 > L - 1 ? L - 1 : t + 128;
            for (int j = j0; j <= j1; ++j) { const bf16_t* row = qkv + (size_t)(b * L + j) * INW; attn_key(q, o, st, row + C_KA + kvh * 64, row + C_VA + kvh * 64, 0.f); }
            for (int c = 0; c < CTX; ++c) { const bf16_t* row = qkv + (size_t)(NTOK + b * CTX + c) * INW; attn_key(q, o, st, row + C_KA + kvh * 64, row + C_VA + kvh * 64, 0.f); }
            store_o64(ob + (size_t)tokg * D + h * 64, o, 1.f / st.l);
        } else {
            load_row64(qkv + (size_t)tokg * INW + C_QB + h * 64, q);
            st.m = -1e30f; st.l = 0.f;
            const int r = t >> 6, c = t & 63;
            const int rs = r - 4 < 0 ? 0 : (r - 4 > 56 ? 56 : r - 4), cs = c - 8 < 0 ? 0 : (c - 8 > 48 ? 48 : c - 8);
            for (int a = 0; a < 8; ++a)
                for (int e = 0; e < 16; ++e) { const int kr = rs + a, kc = cs + e; const bf16_t* row = qkv + (size_t)(b * L + kr * 64 + kc) * INW;
                    const float bias = p.rpb_b[(h * 15 + (kr - r + 7)) * 31 + (kc - c + 15)] * LOG2E;
                    attn_key(q, o, st, row + C_KB + h * 64, row + C_VB + h * 64, bias); }
            for (int cc = 0; cc < CTX; ++cc) { const bf16_t* row = qkv + (size_t)(NTOK + b * CTX + cc) * INW; attn_key(q, o, st, row + C_KB + h * 64, row + C_VB + h * 64, 0.f); }
            store_o64(ob + (size_t)tokg * D + 512 + h * 64, o, 1.f / st.l);
        }
    }
}


namespace att {
#define ATT_LAS __attribute__((address_space(3)))
typedef float f32x16 __attribute__((ext_vector_type(16)));
typedef short bf16x8 __attribute__((ext_vector_type(8)));
typedef short s16x4 __attribute__((ext_vector_type(4)));
constexpr int SLOTB = 8192;
constexpr int LDS_K = 0, LDS_V = 2 * SLOTB, LDS_WS = 4 * SLOTB, LDS_BT = LDS_WS + 8 * 256;
constexpr int BT_MARGIN = 64, BT_FLOATS = BT_MARGIN + 15 * 32 + 96;
constexpr float NEGBIG = -1e30f;
__device__ __forceinline__ int crow(int r, int hi) { return (r & 3) + 8 * (r >> 2) + 4 * hi; }
__device__ __forceinline__ unsigned cvtpk(float lo, float hi) { typedef float f2 __attribute__((ext_vector_type(2))); typedef __bf16 b2 __attribute__((ext_vector_type(2)));
    f2 v = {lo, hi}; b2 b = __builtin_convertvector(v, b2); return __builtin_bit_cast(unsigned, b); }
__device__ __forceinline__ s16x4 vtr(const ATT_LAS unsigned char* p) { typedef short v4i16 __attribute__((ext_vector_type(4)));
    return __builtin_bit_cast(s16x4, __builtin_amdgcn_ds_read_tr16_b64_v4i16((ATT_LAS v4i16*)p)); }
#define ATT_WAIT_BAR(N) asm volatile("s_waitcnt vmcnt(" #N ") lgkmcnt(0)\n\ts_barrier" ::: "memory")

__device__ __forceinline__ void dma_tile(ATT_LAS unsigned char* lds, int slot, const bf16_t* kbase, const bf16_t* vbase, int wid, int lane) {
    const bf16_t* ksrc = kbase + (size_t)lane * INW + wid * 8;
    const bf16_t* vsrc = vbase + (size_t)(16 * (wid & 3) + (lane >> 2)) * INW + (wid >> 2) * 32 + (lane & 3) * 8;
    __builtin_amdgcn_global_load_lds((const unsigned*)ksrc, (ATT_LAS unsigned*)(lds + LDS_K + slot * SLOTB + wid * 1024), 16, 0, 0);
    __builtin_amdgcn_global_load_lds((const unsigned*)vsrc, (ATT_LAS unsigned*)(lds + LDS_V + slot * SLOTB + wid * 1024), 16, 0, 0);
}

template <bool ISB>
__device__ __forceinline__ void attn_unit(const Params& p, ATT_LAS unsigned char* lds, int unit) {
    const int tid = threadIdx.x, lane = tid & 63, r32 = lane & 31, hi = lane >> 5; const int wid = __builtin_amdgcn_readfirstlane(tid >> 6);
    const bf16_t* qkv = (const bf16_t*)(p.ws + WS_QKV); bf16_t* ob = (bf16_t*)(p.ws + WS_O);
    ATT_LAS float* wsf = (ATT_LAS float*)(lds + LDS_WS) + wid * 64;
    ATT_LAS float* bt = (ATT_LAS float*)(lds + LDS_BT);
    int b, h, kcol, vcol, qcol, ocol, q0, nloc, row_lo = 0, qr = 0, half = 0, qb = 0, jlo = 0;
    if (!ISB) { b = unit >> 7; const int kvh = (unit >> 6) & 1; qb = unit & 63; h = kvh * 4 + (wid >> 1); half = wid & 1; q0 = qb * 64 + 32 * half;
        kcol = C_KA + kvh * 64; vcol = C_VA + kvh * 64; qcol = C_QA + h * 64; ocol = h * 64;
        jlo = 2 - qb > 0 ? 2 - qb : 0; const int jhi = 65 - qb < 4 ? 65 - qb : 4; nloc = jhi - jlo + 1;
    } else { b = unit >> 7; h = (unit >> 4) & 7; const int g = unit & 15; qr = 4 * g + (wid >> 1); half = wid & 1; q0 = qr * 64 + 32 * half;
        kcol = C_KB + h * 64; vcol = C_VB + h * 64; qcol = C_QB + h * 64; ocol = 512 + h * 64;
        const int r0 = 4 * g, r3 = 4 * g + 3; row_lo = r0 - 4 < 0 ? 0 : (r0 - 4 > 56 ? 56 : r0 - 4); const int rs3 = r3 - 4 < 0 ? 0 : (r3 - 4 > 56 ? 56 : r3 - 4); nloc = rs3 + 7 - row_lo + 1;
    }
    const int NT = nloc + 4;
    const bf16_t* lat = qkv + (size_t)b * L * INW; const bf16_t* cx = qkv + (size_t)(NTOK + b * CTX) * INW;
#define ATT_TILE_ROW(t) ((t) < nloc ? lat + (size_t)(ISB ? (row_lo + (t)) * 64 : (qb - 2 + jlo + (t)) * 64) * INW : cx + (size_t)((t) - nloc) * 64 * INW)
    if (ISB) {
        for (int i = tid; i < BT_FLOATS; i += NTHREADS) { const int j = i - BT_MARGIN; float v = 0.f;
            if (j >= 0 && j < 15 * 32 && (j & 31) < 31) v = p.rpb_b[(h * 15 + (j >> 5)) * 31 + (j & 31)] * LOG2E;
            bt[i] = v; }
    }
    { const bf16_t* r0p = ATT_TILE_ROW(0); dma_tile(lds, 0, r0p + kcol, r0p + vcol, wid, lane); }
    bf16x8 qf[4];
    { const bf16_t* qp = lat + (size_t)(q0 + r32) * INW + qcol + hi * 8;
#pragma unroll
      for (int d0 = 0; d0 < 4; ++d0) qf[d0] = *(const bf16x8*)(qp + d0 * 16); }
    float m_run, l_run;
    if (!ISB) { m_run = p.sink_a[h] * LOG2E; l_run = hi == 0 ? 1.f : 0.f; } else { m_run = NEGBIG; l_run = 0.f; }
    f32x16 o0, o1;
#pragma unroll
    for (int r = 0; r < 16; ++r) { o0[r] = 0.f; o1[r] = 0.f; }
    const int qc = 32 * half + r32;
    const int cs = qc - 8 < 0 ? 0 : (qc - 8 > 48 ? 48 : qc - 8);
    const int rsq = qr - 4 < 0 ? 0 : (qr - 4 > 56 ? 56 : qr - 4);
    for (int t = 0; t < NT; ++t) {
        if (t + 1 < NT) { const bf16_t* rp = ATT_TILE_ROW(t + 1); dma_tile(lds, (t + 1) & 1, rp + kcol, rp + vcol, wid, lane); ATT_WAIT_BAR(2); }
        else { ATT_WAIT_BAR(0); }
        const int slot = t & 1;
        bool active = true; int kr = 0;
        if (ISB && t < nloc) { kr = row_lo + t; active = (kr >= rsq) && (kr <= rsq + 7); }
        if (active) {
            const ATT_LAS unsigned char* kb = lds + LDS_K + slot * SLOTB + hi * 1024 + r32 * 16;
            f32x16 p0, p1;
#pragma unroll
            for (int r = 0; r < 16; ++r) { p0[r] = 0.f; p1[r] = 0.f; }
#pragma unroll
            for (int d0 = 0; d0 < 4; ++d0) {
                const bf16x8 k0 = *(const ATT_LAS bf16x8*)(kb + d0 * 2048), k1 = *(const ATT_LAS bf16x8*)(kb + d0 * 2048 + 512);
                p0 = __builtin_amdgcn_mfma_f32_32x32x16_bf16(k0, qf[d0], p0, 0, 0, 0);
                p1 = __builtin_amdgcn_mfma_f32_32x32x16_bf16(k1, qf[d0], p1, 0, 0, 0);
            }
            if (ISB) {
                if (t < nloc) {
                    const ATT_LAS float* bp = bt + BT_MARGIN + (kr - qr + 7) * 32 + 15 - qc + 4 * hi;
                    const int e0 = 4 * hi - cs;
#pragma unroll
                    for (int r = 0; r < 16; ++r) { const int c = (r & 3) + 8 * (r >> 2);
                        const float b0 = bp[c], b1 = bp[c + 32];
                        p0[r] = ((unsigned)(c + e0) < 16u) ? p0[r] + b0 : NEGBIG;
                        p1[r] = ((unsigned)(c + 32 + e0) < 16u) ? p1[r] + b1 : NEGBIG; }
                }
            } else {
                if (t < nloc) { const int j = jlo + t; const int qq = 32 * half + r32;
                    if (j == 0) {
#pragma unroll
                        for (int r = 0; r < 16; ++r) { const int c = crow(r, hi); if (c < qq) p0[r] = NEGBIG; if (c + 32 < qq) p1[r] = NEGBIG; }
                    } else if (j == 4) {
#pragma unroll
                        for (int r = 0; r < 16; ++r) { const int c = crow(r, hi); if (c > qq) p0[r] = NEGBIG; if (c + 32 > qq) p1[r] = NEGBIG; }
                    }
                }
            }
            float rm = fmaxf(p0[0], p1[0]);
#pragma unroll
            for (int r = 1; r < 16; ++r) rm = fmaxf(rm, fmaxf(p0[r], p1[r]));
            rm = fmaxf(rm, __shfl_xor(rm, 32));
            const float mnew = fmaxf(m_run, rm);
            if (__any(mnew > m_run)) {
                const float f = __builtin_amdgcn_exp2f(m_run - mnew);
                l_run *= f; m_run = mnew;
                if (hi == 0) wsf[r32] = f;
                asm volatile("s_waitcnt lgkmcnt(0)" ::: "memory");
#pragma unroll
                for (int r = 0; r < 16; ++r) { const float fr_ = wsf[crow(r, hi)]; o0[r] *= fr_; o1[r] *= fr_; }
            }
            float ls = 0.f;
#pragma unroll
            for (int r = 0; r < 16; ++r) { p0[r] = __builtin_amdgcn_exp2f(p0[r] - m_run); p1[r] = __builtin_amdgcn_exp2f(p1[r] - m_run); ls += p0[r] + p1[r]; }
            l_run += ls;
            typedef unsigned u4 __attribute__((ext_vector_type(4)));
            const u4 pw0 = {cvtpk(p0[0], p0[1]), cvtpk(p0[2], p0[3]), cvtpk(p0[4], p0[5]), cvtpk(p0[6], p0[7])};
            const u4 pw1 = {cvtpk(p0[8], p0[9]), cvtpk(p0[10], p0[11]), cvtpk(p0[12], p0[13]), cvtpk(p0[14], p0[15])};
            const u4 pw2 = {cvtpk(p1[0], p1[1]), cvtpk(p1[2], p1[3]), cvtpk(p1[4], p1[5]), cvtpk(p1[6], p1[7])};
            const u4 pw3 = {cvtpk(p1[8], p1[9]), cvtpk(p1[10], p1[11]), cvtpk(p1[12], p1[13]), cvtpk(p1[14], p1[15])};
            const ATT_LAS unsigned char* vp = lds + LDS_V + slot * SLOTB + ((lane >> 4) & 1) * 32 + (lane & 3) * 8 + (4 * hi + ((lane & 15) >> 2)) * 64;
#define ATT_PV(OACC, PW, D0, KS) do { const s16x4 lo_ = vtr(vp + (D0) * 4096 + (KS) * 1024), hi_ = vtr(vp + (D0) * 4096 + (KS) * 1024 + 512); \
                const bf16x8 vf_ = {lo_[0], lo_[1], lo_[2], lo_[3], hi_[0], hi_[1], hi_[2], hi_[3]}; \
                OACC = __builtin_amdgcn_mfma_f32_32x32x16_bf16(__builtin_bit_cast(bf16x8, PW), vf_, OACC, 0, 0, 0); } while (0)
            ATT_PV(o0, pw0, 0, 0); ATT_PV(o1, pw0, 1, 0); ATT_PV(o0, pw1, 0, 1); ATT_PV(o1, pw1, 1, 1);
            ATT_PV(o0, pw2, 0, 2); ATT_PV(o1, pw2, 1, 2); ATT_PV(o0, pw3, 0, 3); ATT_PV(o1, pw3, 1, 3);
#undef ATT_PV
        }
        ATT_WAIT_BAR(2);
    }
    l_run += __shfl_xor(l_run, 32);
    if (hi == 0) wsf[32 + r32] = l_run;
    asm volatile("s_waitcnt lgkmcnt(0)" ::: "memory");
    bf16_t* op = ob + (size_t)(b * L + q0) * D + ocol + r32;
#pragma unroll
    for (int r = 0; r < 16; ++r) { const int q = crow(r, hi); const float inv = __builtin_amdgcn_rcpf(wsf[32 + q]);
        op[(size_t)q * D] = (bf16_t)f2bf(o0[r] * inv); op[(size_t)q * D + 32] = (bf16_t)f2bf(o1[r] * inv); }
    ATT_WAIT_BAR(0);
#undef ATT_TILE_ROW
}

__device__ __forceinline__ void attn_phase(const Params& p, ATT_LAS unsigned char* lds) {
    const int G = gridDim.x, bx = blockIdx.x;
    const int vcu = (G % 8 == 0) ? (bx % 8) * (G / 8) + bx / 8 : bx;
    for (int u = vcu; u < 2048; u += G) {
        if (u < 1024) attn_unit<false>(p, lds, u); else attn_unit<true>(p, lds, u - 1024);
    }
}
}

__device__ void p4a_ostat(const Params& p, int gw, int ngw, int lane) {
    bf16_t* ob = (bf16_t*)(p.ws + WS_O); float* os = (float*)(p.ws + WS_OSTAT);
    for (int m = gw; m < NTOK; m += ngw) {
        const u32x4 wa = *(const u32x4*)(ob + (size_t)m * D + lane * 8), wb = *(const u32x4*)(ob + (size_t)m * D + 512 + lane * 8);
        float sa = 0.f, sb = 0.f;
#pragma unroll
        for (int i = 0; i < 4; ++i) { const unsigned ua = wa[i], ub = wb[i]; const float a0 = __uint_as_float(ua << 16), a1 = __uint_as_float(ua & 0xffff0000u), b0 = __uint_as_float(ub << 16), b1 = __uint_as_float(ub & 0xffff0000u);
            sa += a0 * a0 + a1 * a1; sb += b0 * b0 + b1 * b1; }
        sa = wave_sum(sa); sb = wave_sum(sb);
        const float ra = rsqrtf(sa * (1.f / 512.f) + EPS), rb = rsqrtf(sb * (1.f / 512.f) + EPS);
        if (lane == 0) { os[m * 2] = ra; os[m * 2 + 1] = rb; }
        u32x4 oa, obb;
#pragma unroll
        for (int i = 0; i < 4; ++i) { const unsigned ua = wa[i], ub = wb[i];
            oa[i] = pk2(__uint_as_float(ua << 16) * ra, __uint_as_float(ua & 0xffff0000u) * ra); obb[i] = pk2(__uint_as_float(ub << 16) * rb, __uint_as_float(ub & 0xffff0000u) * rb); }
        *(u32x4*)(ob + (size_t)m * D + lane * 8) = oa; *(u32x4*)(ob + (size_t)m * D + 512 + lane * 8) = obb;
    }
}
__device__ void p4b_outproj_naive(const Params& p, float* sA, float* sB) {
    const bf16_t* ob = (const bf16_t*)(p.ws + WS_O); const bf16_t* wT = (const bf16_t*)(p.ws + WS_WOUT);
    float* mix = (float*)(p.ws + WS_MIX);
    constexpr int NTN = D / 64, NT = (NTOK / 128) * NTN;
    for (int t = blockIdx.x; t < NT; t += gridDim.x) {
        const int m0 = (t / NTN) * 128, n0 = (t % NTN) * 64;
        auto al = [&](int r, int k) { return bf2f(ob[(size_t)r * D + k]); };
        auto bl = [&](int n, int k) { return bf2f(wT[(size_t)n * D + k]); };
        auto ep = [&](int r0, int nn0, int tx, float (&acc)[4][4]) {
#pragma unroll
            for (int i = 0; i < 4; ++i)
#pragma unroll
                for (int j = 0; j < 4; ++j) mix[(size_t)(r0 + i) * D + nn0 + tx + 16 * j] = acc[i][j];
        };
        ngemm_tile(sA, sB, m0, n0, D, al, bl, ep);
    }
}
__device__ void p4c_post(const Params& p, int gw, int ngw, int lane) {
    const float* mod = (const float*)(p.ws + WS_MOD); const float* mix = (const float*)(p.ws + WS_MIX);
    bf16_t* hb = (bf16_t*)(p.ws + WS_HB);
    unsigned* counts = (unsigned*)(p.ws + WS_CTL);
    int* tope = (int*)(p.ws + WS_TOPE); int* topr = (int*)(p.ws + WS_TOPR); float* topw = (float*)(p.ws + WS_TOPW);
    for (int m = gw; m < NTOK; m += ngw) {
        const int b = m / L; const float* mb = mod + b * 6144;
        f32x4 v[4], xv[4]; float s = 0.f;
#pragma unroll
        for (int j = 0; j < 4; ++j) { v[j] = ((const f32x4*)(mix + (size_t)m * D))[lane + 64 * j]; s += v[j].x * v[j].x + v[j].y * v[j].y + v[j].z * v[j].z + v[j].w * v[j].w; }
        float rstd = rsqrtf(wave_sum(s) * (1.f / D) + EPS);
        s = 0.f;
#pragma unroll
        for (int j = 0; j < 4; ++j) { const int c0 = 4 * (lane + 64 * j);
            const f32x4 g = *(const f32x4*)(p.g_post_mix + c0), ga = *(const f32x4*)(mb + 2048 + c0), xx = ((const f32x4*)(p.x + (size_t)m * D))[lane + 64 * j];
            xv[j] = xx + ga * (v[j] * rstd * g);
            ((f32x4*)(p.out + (size_t)m * D))[lane + 64 * j] = xv[j];
            s += xv[j].x * xv[j].x + xv[j].y * xv[j].y + xv[j].z * xv[j].z + xv[j].w * xv[j].w; }
        rstd = rsqrtf(wave_sum(s) * (1.f / D) + EPS);
        float lg[NE];
#pragma unroll
        for (int e = 0; e < NE; ++e) lg[e] = 0.f;
#pragma unroll
        for (int j = 0; j < 4; ++j) { const int c0 = 4 * (lane + 64 * j);
            const f32x4 g = *(const f32x4*)(p.g_pre_ffn + c0), sc = *(const f32x4*)(mb + 4096 + c0), sh = *(const f32x4*)(mb + 3072 + c0);
            const f32x4 h2 = (xv[j] * rstd * g) * (sc + 1.f) + sh;
            u32x2 w; w.x = pk2(h2.x, h2.y); w.y = pk2(h2.z, h2.w);
            *(u32x2*)(hb + (size_t)m * D + c0) = w;
#pragma unroll
            for (int q = 0; q < 4; ++q) { const float hv = h2[q]; const f32x4* wr = (const f32x4*)(p.w_router + (size_t)(c0 + q) * NE);
#pragma unroll
                for (int e4 = 0; e4 < 8; ++e4) { const f32x4 ww = wr[e4]; lg[e4 * 4] = fmaf(hv, ww.x, lg[e4 * 4]); lg[e4 * 4 + 1] = fmaf(hv, ww.y, lg[e4 * 4 + 1]); lg[e4 * 4 + 2] = fmaf(hv, ww.z, lg[e4 * 4 + 2]); lg[e4 * 4 + 3] = fmaf(hv, ww.w, lg[e4 * 4 + 3]); } }
        }
#pragma unroll
        for (int e = 0; e < NE; ++e) lg[e] = wave_sum(lg[e]) + p.b_router[e];
        float tv[4]; int ti[4]; unsigned used = 0u;
#pragma unroll
        for (int k = 0; k < 4; ++k) { float best = -3.4e38f; int bi = 0;
#pragma unroll
            for (int e = 0; e < NE; ++e) { const bool ok = !((used >> e) & 1u) && lg[e] > best; best = ok ? lg[e] : best; bi = ok ? e : bi; }
            tv[k] = best; ti[k] = bi; used |= 1u << bi; }
        const float e1 = __expf(tv[1] - tv[0]), e2 = __expf(tv[2] - tv[0]), e3 = __expf(tv[3] - tv[0]); const float inv = 1.f / (1.f + e1 + e2 + e3);
        const float tw[4] = {inv, e1 * inv, e2 * inv, e3 * inv};
        if (lane < 4) {
            int myi = ti[0]; float myw = tw[0];
#pragma unroll
            for (int k = 1; k < 4; ++k) if (lane == k) { myi = ti[k]; myw = tw[k]; }
            const unsigned rank = atomicAdd(&counts[myi], 1u);
            tope[m * 4 + lane] = myi; topr[m * 4 + lane] = (int)rank; topw[m * 4 + lane] = myw;
        }
    }
}
__device__ __forceinline__ void expert_bases(const unsigned* counts, int* sbase_  ) {
    __attribute__((address_space(3))) int* sbase = (__attribute__((address_space(3))) int*)sbase_;
    if (threadIdx.x < 64) {
        const int lane = threadIdx.x; const int c = lane < NE ? (((int)counts[lane] + 255) & ~255) : 0;
        int incl = c;
#pragma unroll
        for (int o = 1; o < 32; o <<= 1) { const int v = __shfl_up(incl, o); if (lane >= o) incl += v; }
        if (lane < NE) sbase[lane] = incl - c;
        if (lane == NE - 1) sbase[NE] = incl;
    }
    __syncthreads();
}
__device__ void p4d_rows(const Params& p, int gtid, int gsize, int* sbase) {
    const unsigned* counts = (const unsigned*)(p.ws + WS_CTL);
    const int* tope = (const int*)(p.ws + WS_TOPE); const int* topr = (const int*)(p.ws + WS_TOPR); const float* topw = (const float*)(p.ws + WS_TOPW);
    int* rtok = (int*)(p.ws + WS_ROWTOK); int* rslot = (int*)(p.ws + WS_ROWSLOT); float* rw = (float*)(p.ws + WS_ROWW);
    expert_bases(counts, sbase);
    for (int a = gtid; a < NASG; a += gsize) { const int e = tope[a], row = sbase[e] + topr[a]; rtok[row] = a >> 2; rslot[row] = a; rw[row] = topw[a]; }
    for (int i = gtid; i < NE * 256; i += gsize) { const int e = i >> 8, j = i & 255; const int row = sbase[e] + (int)counts[e] + j; if (row < sbase[e + 1]) { rtok[row] = 0; rslot[row] = -1; rw[row] = 0.f; } }
}
__device__ __forceinline__ int expert_of_row(const int* sbase, int row) { int e = 0;
#pragma unroll 1
    for (int i = 1; i < NE; ++i) e += (row >= sbase[i]) ? 1 : 0; return e; }
__device__ void p5a_gemm1_naive(const Params& p, float* sA, float* sB, int* sbase) {
    const unsigned* counts = (const unsigned*)(p.ws + WS_CTL);
    const bf16_t* hb = (const bf16_t*)(p.ws + WS_HB); const bf16_t* w1T = (const bf16_t*)(p.ws + WS_W1); bf16_t* act = (bf16_t*)(p.ws + WS_ACT);
    const int* rtok = (const int*)(p.ws + WS_ROWTOK);
    expert_bases(counts, sbase);
    const int total = sbase[NE]; constexpr int NTN = 2048 / 64; const int NT = (total / 128) * NTN;
    for (int t = blockIdx.x; t < NT; t += gridDim.x) {
        const int m0 = (t / NTN) * 128, n0 = (t % NTN) * 64; const int e = expert_of_row(sbase, m0);
        const bf16_t* wE = w1T + (size_t)e * 2048 * D; const float* b1 = p.b_mlp1 + (size_t)e * 2048;
        auto al = [&](int r, int k) { return bf2f(hb[(size_t)rtok[r] * D + k]); };
        auto bl = [&](int n, int k) { return bf2f(wE[(size_t)n * D + k]); };
        auto ep = [&](int r0, int nn0, int tx, float (&acc)[4][4]) {
#pragma unroll
            for (int i = 0; i < 4; ++i)
#pragma unroll
                for (int jj = 0; jj < 2; ++jj) { const int f = 16 * ((nn0 >> 5) + jj) + tx;
                    float gate = acc[i][2 * jj] + b1[2 * f], lin = acc[i][2 * jj + 1] + b1[2 * f + 1];
                    gate = fminf(gate, 7.f); lin = fminf(fmaxf(lin, -7.f), 7.f);
                    const float a = gate / (1.f + __expf(-1.702f * gate)) * (lin + 1.f);
                    act[(size_t)(r0 + i) * D + f] = (bf16_t)f2bf(a); }
        };
        ngemm_tile(sA, sB, m0, n0, D, al, bl, ep);
    }
}
__device__ void p5b_gemm2_naive(const Params& p, float* sA, float* sB, int* sbase) {
    const unsigned* counts = (const unsigned*)(p.ws + WS_CTL);
    const bf16_t* act = (const bf16_t*)(p.ws + WS_ACT); const bf16_t* w2T = (const bf16_t*)(p.ws + WS_W2); bf16_t* y = (bf16_t*)(p.ws + WS_Y);
    const int* rslot = (const int*)(p.ws + WS_ROWSLOT); const float* rw = (const float*)(p.ws + WS_ROWW);
    expert_bases(counts, sbase);
    const int total = sbase[NE]; constexpr int NTN = D / 64; const int NT = (total / 128) * NTN;
    for (int t = blockIdx.x; t < NT; t += gridDim.x) {
        const int m0 = (t / NTN) * 128, n0 = (t % NTN) * 64; const int e = expert_of_row(sbase, m0);
        const bf16_t* wE = w2T + (size_t)e * D * D; const float* b2 = p.b_mlp2 + (size_t)e * D;
        auto al = [&](int r, int k) { return bf2f(act[(size_t)r * D + k]); };
        auto bl = [&](int n, int k) { return bf2f(wE[(size_t)n * D + k]); };
        auto ep = [&](int r0, int nn0, int tx, float (&acc)[4][4]) {
#pragma unroll
            for (int i = 0; i < 4; ++i) { const int slot = rslot[r0 + i]; const float w = rw[r0 + i];
                if (slot >= 0) {
#pragma unroll
                    for (int j = 0; j < 4; ++j) { const int n = nn0 + tx + 16 * j; y[(size_t)slot * D + n] = (bf16_t)f2bf(w * (acc[i][j] + b2[n])); } } }
        };
        ngemm_tile(sA, sB, m0, n0, D, al, bl, ep);
    }
}
__device__ void p6_final(const Params& p, int gw, int ngw, int lane) {
    const float* mod = (const float*)(p.ws + WS_MOD); const bf16_t* y = (const bf16_t*)(p.ws + WS_Y);
    for (int m = gw; m < NTOK; m += ngw) {
        const int b = m / L; const float* ga2 = mod + b * 6144 + 5120;
        f32x4 v[4]; float s = 0.f;
#pragma unroll
        for (int j = 0; j < 4; ++j) { const int c0 = 4 * (lane + 64 * j); f32x4 a = {0.f, 0.f, 0.f, 0.f};
#pragma unroll
            for (int k = 0; k < 4; ++k) { const u32x2 w = *(const u32x2*)(y + (size_t)(m * 4 + k) * D + c0);
                a.x += __uint_as_float(w.x << 16); a.y += __uint_as_float(w.x & 0xffff0000u); a.z += __uint_as_float(w.y << 16); a.w += __uint_as_float(w.y & 0xffff0000u); }
            v[j] = a; s += a.x * a.x + a.y * a.y + a.z * a.z + a.w * a.w; }
        const float rstd = rsqrtf(wave_sum(s) * (1.f / D) + EPS);
#pragma unroll
        for (int j = 0; j < 4; ++j) { const int c0 = 4 * (lane + 64 * j);
            const f32x4 g = *(const f32x4*)(p.g_post_ffn + c0), ga = *(const f32x4*)(ga2 + c0);
            f32x4* o = (f32x4*)(p.out + (size_t)m * D) + lane + 64 * j;
            *o = *o + ga * (v[j] * rstd * g); }
    }
}

#ifndef USE_PG8_QKV
#define USE_PG8_QKV 1
#endif
#ifndef USE_PG8_OUT
#define USE_PG8_OUT 1
#endif
#ifndef USE_PG8_G1
#define USE_PG8_G1 1
#endif
#ifndef USE_PG8_G2
#define USE_PG8_G2 1
#endif
constexpr int LDS_SBASE = 131072;
constexpr int LDS_BYTES = 131072 + 1024;

__global__ void __launch_bounds__(NTHREADS, 2) fwd_kernel(Params p) {
    cg::grid_group grid = cg::this_grid();
    extern __shared__ __attribute__((aligned(16))) unsigned char lds[];
    float* sA = (float*)lds;
    float* sB = sA + 16 * 132;
    int* sbase = (int*)(lds + LDS_SBASE);
    float* sT = (float*)lds;
    const int tid = threadIdx.x, lane = tid & 63, wave = tid >> 6;
    const int gtid = blockIdx.x * NTHREADS + tid, gsize = gridDim.x * NTHREADS;
    const int gw = blockIdx.x * (NTHREADS / 64) + wave, ngw = gridDim.x * (NTHREADS / 64);
    PG8_LAS unsigned char* lds3 = (PG8_LAS unsigned char*)lds;
    const PG8_LAS int* sbase3 = (const PG8_LAS int*)(lds3 + LDS_SBASE);

    p0_mod(p, gtid, gsize); p0_tab(p, gtid, gsize); p0_weights(p, sT);
    grid.sync();
    p1_h(p, gw, ngw, lane);
    grid.sync();
#if USE_PG8_QKV
    { pg8::Gemm g{(const bf16_t*)(p.ws + WS_HB), (const bf16_t*)(p.ws + WS_WIN), D, 0, nullptr};
      pg8::StaticOrder S; S.init(MROWS, INW, (int)gridDim.x, (int)blockIdx.x, nullptr);
      pg8::EpiQKV E{(bf16_t*)(p.ws + WS_QKV), (const float*)(p.ws + WS_TAB)};
      pg8::gemm_phase<pg8::EpiQKV, pg8::StaticOrder, false, true>(lds3, g, S, E); }
#else
    p2_qkv_naive(p, sA, sB);
#endif
    grid.sync();
#ifndef USE_MFMA_ATTN
#define USE_MFMA_ATTN 1
#endif
#if USE_MFMA_ATTN
    att::attn_phase(p, lds3);
#else
    p3_attn_naive(p, gtid, gsize);
#endif
    grid.sync();
    p4a_ostat(p, gw, ngw, lane);
    grid.sync();
#if USE_PG8_OUT
    { pg8::Gemm g{(const bf16_t*)(p.ws + WS_O), (const bf16_t*)(p.ws + WS_WOUT), D, 0, nullptr};
      pg8::StaticOrder S; S.init(NTOK, D, (int)gridDim.x, (int)blockIdx.x, nullptr);
      pg8::EpiF32 E{(float*)(p.ws + WS_MIX), D};
      pg8::gemm_phase<pg8::EpiF32, pg8::StaticOrder, false, true>(lds3, g, S, E); }
#else
    p4b_outproj_naive(p, sA, sB);
#endif
    grid.sync();
    p4c_post(p, gw, ngw, lane);
    grid.sync();
    p4d_rows(p, gtid, gsize, sbase);
    grid.sync();
#if USE_PG8_G1
    expert_bases((const unsigned*)(p.ws + WS_CTL), sbase);
    { const int total = sbase3[NE];
      pg8::Gemm g{(const bf16_t*)(p.ws + WS_HB), (const bf16_t*)(p.ws + WS_W1), D, (size_t)2048 * D * 2, (const int*)(p.ws + WS_ROWTOK)};
      pg8::StaticOrder S; S.init(total, 2048, (int)gridDim.x, (int)blockIdx.x, sbase3);
      pg8::EpiSwiglu E{(bf16_t*)(p.ws + WS_ACT), p.b_mlp1};
      pg8::gemm_phase<pg8::EpiSwiglu, pg8::StaticOrder, true, true>(lds3, g, S, E); }
#else
    p5a_gemm1_naive(p, sA, sB, sbase);
#endif
    grid.sync();
#if USE_PG8_G2
    expert_bases((const unsigned*)(p.ws + WS_CTL), sbase);
    { const int total = sbase3[NE];
      pg8::Gemm g{(const bf16_t*)(p.ws + WS_ACT), (const bf16_t*)(p.ws + WS_W2), D, (size_t)D * D * 2, nullptr};
      pg8::StaticOrder S; S.init(total, D, (int)gridDim.x, (int)blockIdx.x, sbase3);
      pg8::EpiScatter E{(bf16_t*)(p.ws + WS_Y), p.b_mlp2, (const int*)(p.ws + WS_ROWSLOT), (const float*)(p.ws + WS_ROWW)};
      pg8::gemm_phase<pg8::EpiScatter, pg8::StaticOrder, false, true>(lds3, g, S, E); }
#else
    p5b_gemm2_naive(p, sA, sB, sbase);
#endif
    grid.sync();
    p6_final(p, gw, ngw, lane);
}

extern "C" void kernel_launch(void* const* d_in, const int* in_sizes, int n_in, void* d_out, int out_size, void* d_ws, size_t ws_size, hipStream_t stream) {
    static int grid_blocks = 0;
    if (grid_blocks == 0) {
        if (n_in != 22 || ws_size < WS_END) { fprintf(stderr, "kernel_launch: unexpected n_in %d / ws_size %zu (need %zu)\n", n_in, ws_size, (size_t)WS_END); grid_blocks = -1; return; }
        int dev = 0, cus = 0, per_cu = 0;
        (void)hipGetDevice(&dev);
        (void)hipDeviceGetAttribute(&cus, hipDeviceAttributeMultiprocessorCount, dev);
        if (hipFuncSetAttribute((const void*)fwd_kernel, hipFuncAttributeMaxDynamicSharedMemorySize, LDS_BYTES) != hipSuccess) { fprintf(stderr, "kernel_launch: hipFuncSetAttribute failed\n"); grid_blocks = -1; return; }
        (void)hipOccupancyMaxActiveBlocksPerMultiprocessor(&per_cu, (const void*)fwd_kernel, NTHREADS, LDS_BYTES);
        if (per_cu < 1) { fprintf(stderr, "kernel_launch: occupancy query returned %d\n", per_cu); grid_blocks = -1; return; }
        grid_blocks = cus;
    }
    if (grid_blocks < 0) return;
    (void)hipMemsetAsync((char*)d_ws + WS_CTL, 0, CTL_BYTES, stream);
    Params p{};
    const float** pp = (const float**)&p;
    for (int i = 0; i < 22; ++i) pp[i] = (const float*)d_in[i];
    p.out = (float*)d_out; p.ws = (unsigned char*)d_ws;
    void* args[] = {&p};
    hipError_t e = hipLaunchCooperativeKernel((const void*)fwd_kernel, dim3(grid_blocks), dim3(NTHREADS), args, LDS_BYTES, stream);
    if (e != hipSuccess) fprintf(stderr, "cooperative launch failed: %s (grid %d)\n", hipGetErrorString(e), grid_blocks);
}
```

```cpp
#include <hip/hip_runtime.h>
#include <hip/hip_cooperative_groups.h>
#include <cstdio>
#include <cstdint>
namespace cg = cooperative_groups;

constexpr int D = 1024, NB = 8, L = 4096, CTX = 256;
constexpr int NTOK = NB * L, NCTX = NB * CTX, MROWS = NTOK + NCTX;
constexpr int INW = 2304;
constexpr int C_QA = 0, C_KA = 512, C_VA = 640, C_QB = 768, C_KB = 1280, C_VB = 1792;
constexpr int NE = 32, TOPK = 4, NASG = NTOK * TOPK;
constexpr int PADROWS = NASG + NE * 256;
constexpr float LOG2E = 1.4426950408889634f;
constexpr float QSCALE = 0.125f * LOG2E;
constexpr float EPS = 1e-6f;
constexpr int NTHREADS = 512;

constexpr size_t MiB = 1u << 20;
constexpr size_t WS_CTL = 0;
constexpr size_t CTL_BYTES = 32768;
constexpr int CW_BAR = 1024;
constexpr size_t WS_MOD = 1 * MiB;
constexpr size_t WS_TAB = 1 * MiB + 256 * 1024;
constexpr size_t WS_OSTAT = 1 * MiB + 512 * 1024;
constexpr size_t WS_WIN = 2 * MiB;
constexpr size_t WS_WOUT = 7 * MiB;
constexpr size_t WS_W2 = 9 * MiB;
constexpr size_t WS_W1 = 73 * MiB;
constexpr size_t WS_HB = 201 * MiB;
constexpr int ECAP = NTOK;
constexpr size_t WS_ESLOT = 269 * MiB;
constexpr size_t WS_EW = 273 * MiB;
constexpr size_t WS_QKV = 277 * MiB;
constexpr size_t WS_O = 430 * MiB;
constexpr size_t WS_MIX = 494 * MiB;
constexpr size_t WS_ACT = 277 * MiB;
constexpr size_t WS_Y = 622 * MiB;
constexpr size_t WS_END = 878 * MiB;
static_assert(WS_W1 + (size_t)NE * 2048 * D * 2 <= WS_HB && WS_W2 + (size_t)NE * D * D * 2 <= WS_W1, "map");
static_assert(WS_HB + (size_t)MROWS * D * 2 <= WS_ESLOT && WS_ESLOT + (size_t)NE * ECAP * 4 <= WS_EW && WS_EW + (size_t)NE * ECAP * 4 <= WS_QKV, "map");
static_assert(WS_QKV + (size_t)MROWS * INW * 2 <= WS_O && WS_O + (size_t)NTOK * D * 2 <= WS_MIX && WS_MIX + (size_t)NTOK * D * 4 <= WS_Y, "map");
static_assert(WS_ACT + (size_t)PADROWS * 1024 * 2 <= WS_Y && WS_Y + (size_t)NASG * D * 2 <= WS_END, "map");

typedef unsigned short bf16_t;
typedef float f32x4 __attribute__((ext_vector_type(4)));
typedef unsigned u32x4 __attribute__((ext_vector_type(4)));
typedef unsigned u32x2 __attribute__((ext_vector_type(2)));

struct Params {
    const float *x, *c, *ctx, *c_ctx, *w_ada, *b_ada, *g_pre_mix, *g_post_mix, *g_pre_ffn, *g_post_ffn, *w_in, *g_grp_a, *g_grp_b,
        *sink_a, *rpb_b, *w_out, *w_router, *b_router, *w_mlp1, *b_mlp1, *w_mlp2, *b_mlp2;
    float* out;
    unsigned char* ws;
};

__device__ __forceinline__ float bf2f(bf16_t h) { return __uint_as_float((unsigned)h << 16); }
__device__ __forceinline__ unsigned f2bf(float f) { unsigned u = __float_as_uint(f); return (u + 0x7fffu + ((u >> 16) & 1u)) >> 16; }
__device__ __forceinline__ unsigned pk2(float lo, float hi) { return f2bf(lo) | (f2bf(hi) << 16); }
__device__ __forceinline__ float wave_sum(float v) {
#pragma unroll
    for (int o = 1; o < 64; o <<= 1) v += __shfl_xor(v, o);
    return v;
}


#define LAS3 __attribute__((address_space(3)))
#define XB_TMO      128
#define XB_XCNT(j)  (256  + 64 * (j))
#define XB_XSUB(j)  (1280 + 64 * (j))
#define XB_XGEN(j)  (2304 + 64 * (j))
#define XB_TOP      3328
#define XB_TOPGEN   3392
#define XCD_BAR_WORDS 3456
#define XB_SPIN_CAP (1u << 18)
__device__ __forceinline__ unsigned xb_ld(unsigned* p)              { return __hip_atomic_load(p, __ATOMIC_RELAXED, __HIP_MEMORY_SCOPE_AGENT); }
__device__ __forceinline__ unsigned xb_add(unsigned* p, unsigned v) { return __hip_atomic_fetch_add(p, v, __ATOMIC_RELAXED, __HIP_MEMORY_SCOPE_AGENT); }
__device__ __forceinline__ unsigned xb_xcc_id() { return (unsigned)__builtin_amdgcn_s_getreg((3 << 11) | 20) & 0xFu; }
#define XB_SPIN(cond, bar) do { unsigned _sp = 0; while (cond) { __builtin_amdgcn_s_sleep(1); \
    if ((++_sp & 255u) == 0u) { if (xb_ld(&(bar)[XB_TMO])) break; if (_sp > XB_SPIN_CAP) { atomicAdd(&(bar)[XB_TMO], 1u); break; } } } } while (0)
struct XcdBarrier { unsigned* bar; unsigned x; volatile LAS3 unsigned* st; };
__device__ __forceinline__ XcdBarrier xcd_barrier_post(unsigned* bar, volatile LAS3 unsigned* st) {
    XcdBarrier b; b.bar = bar; b.x = xb_xcc_id(); b.st = st;
    if (threadIdx.x == 0) (void)xb_add(&bar[XB_XCNT(b.x)], 1u);
    return b;
}
__device__ __forceinline__ void xcd_barrier_complete(unsigned* bar, unsigned x, unsigned& nloc, unsigned& nx) {
    const unsigned G = gridDim.x * gridDim.y * gridDim.z;
    unsigned sum, cnt, mine, sp = 0u;
    for (;;) {
        sum = 0u; cnt = 0u; mine = 0u;
#pragma unroll
        for (unsigned j = 0; j < 16; ++j) { const unsigned c = xb_ld(&bar[XB_XCNT(j)]); sum += c; cnt += (c > 0u) ? 1u : 0u; mine = (j == x) ? c : mine; }
        if (sum == G) break;
        __builtin_amdgcn_s_sleep(1);
        if ((++sp & 255u) == 0u) { if (xb_ld(&bar[XB_TMO])) break; if (sp > XB_SPIN_CAP) { atomicAdd(&bar[XB_TMO], 1u); break; } }
    }
    nloc = mine > 0u ? mine : 1u; nx = cnt > 0u ? cnt : 1u;
}
__device__ __forceinline__ void xcd_barrier(const XcdBarrier& b) {
    asm volatile("s_waitcnt vmcnt(0)" ::: "memory");
    __syncthreads();
    if (threadIdx.x == 0) {
        unsigned* bar = b.bar;
        __builtin_amdgcn_s_waitcnt(0);
        unsigned nloc = b.st[0], nx = b.st[1];
        if (nloc == 0u) { xcd_barrier_complete(bar, b.x, nloc, nx); b.st[0] = nloc; b.st[1] = nx; }
        const unsigned old = xb_add(&bar[XB_XSUB(b.x)], 1u);
        const unsigned gen = old / nloc;
        if (old + 1u == (gen + 1u) * nloc) {
            __builtin_amdgcn_fence(__ATOMIC_RELEASE, "agent");
            asm volatile("s_waitcnt vmcnt(0)" ::: "memory");
            const unsigned og = xb_add(&bar[XB_TOP], 1u);
            const unsigned tg = og / nx;
            if (og + 1u == (tg + 1u) * nx) xb_add(&bar[XB_TOPGEN], 1u);
            else XB_SPIN(xb_ld(&bar[XB_TOPGEN]) == tg, bar);
            __builtin_amdgcn_fence(__ATOMIC_ACQUIRE, "agent");
            xb_add(&bar[XB_XGEN(b.x)], 1u);
            asm volatile("s_waitcnt vmcnt(0)" ::: "memory");
        } else {
            XB_SPIN(xb_ld(&bar[XB_XGEN(b.x)]) == gen, bar);
            __builtin_amdgcn_fence(__ATOMIC_ACQUIRE, "agent");
            asm volatile("s_waitcnt vmcnt(0)" ::: "memory");
        }
    }
    __syncthreads();
}

namespace pg8 {
#define PG8_LAS __attribute__((address_space(3)))
typedef short bf16x8 __attribute__((ext_vector_type(8)));
constexpr int BM = 256, BK = 64, HALF = 128, HTB = HALF * BK * 2  , STAGE_BYTES = 8 * HTB, NXCD = 8, WGM = 8;
__device__ __forceinline__ int lds_byte(int r, int c) { const int st = (r >> 4) * 2 + (c >> 5), rr = r & 15, cc = c & 31, ob = rr * 64 + cc * 2; return st * 1024 + (ob ^ (((ob >> 9) & 1) << 5)); }
__device__ __forceinline__ void stage_rc(int b, int& R, int& C) { const int st = b / 1024, sb = b % 1024, swz = sb ^ (((sb >> 9) & 1) << 5); R = (st >> 1) * 16 + swz / 64; C = (st & 1) * 32 + (swz % 64) / 2; }
__device__ __forceinline__ int perm32(int rho) { const int n = rho >> 4, i = rho & 15; return 8 * (i >> 2) + 4 * n + (i & 3); }

struct Unit { int pm, pn, e; };
struct Gemm { const bf16_t* A; const bf16_t* Bt; int K; size_t bstride; const int* eslot; const PG8_LAS int* sb; };

struct StaticOrder {
    int nM, nN, nwg, G, c; const PG8_LAS int* sbase;
    __device__ void init(int M, int N, int G_, int c_, const PG8_LAS int* sb) { nM = M / BM; nN = N / BM; nwg = nM * nN; G = G_; c = c_; sbase = sb; }
    __device__ bool next(int i, Unit& u) const {
        const long Lx = (long)i * G + c; if (Lx >= nwg) return false;
        int wgid = (int)Lx; { const int q = nwg / NXCD, r = nwg % NXCD, xcd = wgid % NXCD, off = wgid / NXCD; wgid = (xcd < r ? xcd * (q + 1) : r * (q + 1) + (xcd - r) * q) + off; }
        const int nig = WGM * nN, gid = wgid / nig, fm = gid * WGM, gsz = (nM - fm) < WGM ? (nM - fm) : WGM;
        u.pm = fm + ((wgid % nig) % gsz); u.pn = (wgid % nig) / gsz; u.e = 0;
        if (sbase) { const int row = u.pm * BM; int e = 0;
#pragma unroll 1
            for (int j = 1; j < 32; ++j) e += (row >= sbase[j]) ? 1 : 0;
            u.e = e; }
        return true;
    }
};

template <class Epi, class Sched, bool GATHER, bool ALIGN_EPI>
__device__ __forceinline__ void gemm_phase(PG8_LAS unsigned char* lds, const Gemm g, const Sched& S, const Epi& E) {
    const int tid = threadIdx.x, wid = __builtin_amdgcn_readfirstlane(tid >> 6), lane = tid & 63, wr = wid >> 2, wc = wid & 3, fr = lane & 15, fq = lane >> 4;
    const int K = g.K, nt = K / BK;
    unsigned voffA[2], voffB[2]; int RA[2], CA[2];
#pragma unroll
    for (int i = 0; i < 2; ++i) { int R, C; stage_rc(tid * 16 + i * 8192, R, C); const int Rb = Epi::PERM ? ((R & ~31) + perm32(R & 31)) : R;
        voffA[i] = (unsigned)(R * K + C) * 2u; voffB[i] = (unsigned)(Rb * K + C) * 2u; RA[i] = R; CA[i] = C * 2; }
    const size_t kstep = (size_t)(BK * 2);
    const size_t hstep = (size_t)HALF * K * 2;
    const size_t tstep = 2 * hstep;
    const unsigned ldsw = (unsigned)wid * 1024u;
    const int aoff = lds_byte(wr * 64 + fr, fq * 8), boff = lds_byte(wc * 32 + fr, fq * 8);
#define PG8_SA(b, h) (((b) * 2 + (h)) * HTB)
#define PG8_SB(b, h) ((4 + (b) * 2 + (h)) * HTB)
#define PG8_STAGE(bufoff, gbase, voff) do { _Pragma("unroll") for (int _i = 0; _i < 2; ++_i) \
        __builtin_amdgcn_global_load_lds((const unsigned*)((const char*)(gbase) + (voff)[_i]), (PG8_LAS unsigned*)(lds + (bufoff) + ldsw + _i * 8192), 16, 0, 0); } while (0)
#define PG8_LDA(dst, b, h) do { _Pragma("unroll") for (int m = 0; m < 4; ++m) _Pragma("unroll") for (int k = 0; k < 2; ++k) dst[m][k] = *(const PG8_LAS bf16x8*)(lds + PG8_SA(b, h) + aoff + m * 2048 + k * 1024); } while (0)
#define PG8_LDB(dst, b, h) do { _Pragma("unroll") for (int n = 0; n < 2; ++n) _Pragma("unroll") for (int k = 0; k < 2; ++k) dst[n][k] = *(const PG8_LAS bf16x8*)(lds + PG8_SB(b, h) + boff + n * 2048 + k * 1024); } while (0)
#define PG8_MMA(ai, bj, At, Bt) do { __builtin_amdgcn_s_setprio(1); _Pragma("unroll") for (int m = 0; m < 4; ++m) _Pragma("unroll") for (int n = 0; n < 2; ++n) _Pragma("unroll") for (int k = 0; k < 2; ++k) \
        acc[ai][bj][m][n] = __builtin_amdgcn_mfma_f32_16x16x32_bf16(Bt[n][k], At[m][k], acc[ai][bj][m][n], 0, 0, 0); __builtin_amdgcn_s_setprio(0); } while (0)
#define PG8_WAIT_V(n) asm volatile("s_waitcnt vmcnt(" #n ")" ::: "memory")
#define PG8_WAIT_L(n) asm volatile("s_waitcnt lgkmcnt(" #n ")" ::: "memory")
#define PG8_BAR __builtin_amdgcn_s_barrier()
#define PG8_SCHED __builtin_amdgcn_sched_barrier(0)
#define PG8_SETOFF(off, u) do { _Pragma("unroll") for (int _h = 0; _h < 2; ++_h) _Pragma("unroll") for (int _i = 0; _i < 2; ++_i) { \
        if (GATHER) { int rk_ = (u).pm * BM + _h * HALF + RA[_i] - g.sb[(u).e]; const int cm_ = g.sb[40 + (u).e] - 1; rk_ = rk_ < cm_ ? rk_ : cm_; \
            off[_h][_i] = (unsigned)(g.eslot[(size_t)(u).e * ECAP + rk_] >> 2) * (unsigned)(K * 2) + (unsigned)CA[_i]; } \
        else off[_h][_i] = voffA[_i] + (unsigned)(_h * hstep); } } while (0)
    Unit cur, nxt; int ui = 0;
    if (!S.next(0, cur)) return;
    f32x4 acc[2][2][4][2];
#pragma unroll
    for (int a = 0; a < 2; ++a)
#pragma unroll
        for (int b = 0; b < 2; ++b)
#pragma unroll
            for (int m = 0; m < 4; ++m)
#pragma unroll
                for (int n = 0; n < 2; ++n) acc[a][b][m][n] = (f32x4){0.f, 0.f, 0.f, 0.f};
    bf16x8 At[4][2], B0[2][2], B1[2][2];
    unsigned offc[2][2], offn[2][2];
    PG8_SETOFF(offc, cur);
    const char* cA = GATHER ? (const char*)g.A : (const char*)g.A + (size_t)cur.pm * tstep;
    const char* cB = (const char*)g.Bt + (size_t)cur.e * g.bstride + (size_t)cur.pn * tstep;
    PG8_STAGE(PG8_SB(0, 0), cB, voffB); PG8_STAGE(PG8_SB(0, 1), cB + hstep, voffB); PG8_STAGE(PG8_SA(0, 0), cA, offc[0]); PG8_STAGE(PG8_SA(0, 1), cA, offc[1]);
    if (wr == 1) PG8_BAR;
    PG8_WAIT_V(2); PG8_BAR;
    PG8_STAGE(PG8_SB(1, 0), cB + kstep, voffB); PG8_STAGE(PG8_SA(1, 0), cA + kstep, offc[0]); PG8_STAGE(PG8_SB(1, 1), cB + hstep + kstep, voffB);
    PG8_WAIT_V(6); PG8_BAR;
    for (;;) {
        const bool has_next = S.next(ui + 1, nxt);
        const char* nA = GATHER ? cA : (has_next ? (const char*)g.A + (size_t)nxt.pm * tstep : cA);
        const char* nB = has_next ? (const char*)g.Bt + (size_t)nxt.e * g.bstride + (size_t)nxt.pn * tstep : cB;
        if (GATHER) { if (has_next) { PG8_SETOFF(offn, nxt); } else {
#pragma unroll
            for (int h = 0; h < 2; ++h)
#pragma unroll
                for (int i = 0; i < 2; ++i) offn[h][i] = offc[h][i]; } }
        for (int t = 0; t < nt; t += 2) {
            const bool last = (t == nt - 2);
            const char* a1 = cA + (size_t)(t + 1) * kstep;
            const char* a2 = last ? nA : cA + (size_t)(t + 2) * kstep; const char* b2 = last ? nB : cB + (size_t)(t + 2) * kstep;
            const char* a3 = a2 + kstep; const char* b3 = b2 + kstep;
            unsigned o2[2][2];
#pragma unroll
            for (int h = 0; h < 2; ++h)
#pragma unroll
                for (int i = 0; i < 2; ++i) o2[h][i] = (GATHER && last) ? offn[h][i] : offc[h][i];
            PG8_LDB(B0, 0, 0); PG8_LDB(B1, 0, 1); PG8_SCHED; PG8_LDA(At, 0, 0); PG8_STAGE(PG8_SA(1, 1), a1, offc[1]);
            PG8_WAIT_V(8); PG8_WAIT_L(0); PG8_BAR; PG8_MMA(0, 0, At, B0); PG8_MMA(0, 1, At, B1); PG8_BAR; PG8_SCHED;
            PG8_LDA(At, 0, 1); PG8_STAGE(PG8_SB(0, 0), b2, voffB); PG8_STAGE(PG8_SB(0, 1), b2 + hstep, voffB); PG8_STAGE(PG8_SA(0, 0), a2, o2[0]);
            PG8_WAIT_V(8); PG8_WAIT_L(0); PG8_BAR; PG8_MMA(1, 0, At, B0); PG8_MMA(1, 1, At, B1); PG8_BAR; PG8_SCHED;
            PG8_LDB(B0, 1, 0); PG8_LDB(B1, 1, 1); PG8_SCHED; PG8_LDA(At, 1, 0); PG8_STAGE(PG8_SA(0, 1), a2, o2[1]);
            PG8_WAIT_V(8); PG8_WAIT_L(0); PG8_BAR; PG8_MMA(0, 0, At, B0); PG8_MMA(0, 1, At, B1); PG8_BAR; PG8_SCHED;
            PG8_LDA(At, 1, 1); PG8_STAGE(PG8_SB(1, 0), b3, voffB); PG8_STAGE(PG8_SB(1, 1), b3 + hstep, voffB); PG8_STAGE(PG8_SA(1, 0), a3, o2[0]);
            PG8_WAIT_V(8); PG8_WAIT_L(0); PG8_BAR; PG8_MMA(1, 0, At, B0); PG8_MMA(1, 1, At, B1); PG8_BAR; PG8_SCHED;
        }
        if constexpr (ALIGN_EPI) { if (wr == 0) PG8_BAR; }
        E(acc, cur, wr, wc, fr, fq);
        if (!has_next) break;
#pragma unroll
        for (int a = 0; a < 2; ++a)
#pragma unroll
            for (int b = 0; b < 2; ++b)
#pragma unroll
                for (int m = 0; m < 4; ++m)
#pragma unroll
                    for (int n = 0; n < 2; ++n) acc[a][b][m][n] = (f32x4){0.f, 0.f, 0.f, 0.f};
        cur = nxt; cA = nA; cB = nB; ++ui;
#pragma unroll
        for (int h = 0; h < 2; ++h)
#pragma unroll
            for (int i = 0; i < 2; ++i) offc[h][i] = offn[h][i];
        if constexpr (ALIGN_EPI) { if (wr == 1) PG8_BAR; }
    }
    PG8_WAIT_V(0);
    if constexpr (!ALIGN_EPI) { if (wr == 0) PG8_BAR; }
    PG8_BAR;
#undef PG8_SA
#undef PG8_SB
#undef PG8_STAGE
#undef PG8_LDA
#undef PG8_LDB
#undef PG8_MMA
#undef PG8_WAIT_V
#undef PG8_WAIT_L
#undef PG8_BAR
#undef PG8_SCHED
#undef PG8_SETOFF
}

struct EpiQKV {
    static constexpr bool PERM = false;
    bf16_t* O; const float* tab;
    __device__ __forceinline__ void operator()(const f32x4 (&acc)[2][2][4][2], const Unit& u, int wr, int wc, int fr, int fq) const {
        const bool latent = u.pm < NTOK / BM;
#pragma unroll
        for (int ai = 0; ai < 2; ++ai)
#pragma unroll
            for (int m = 0; m < 4; ++m) {
                const int row = u.pm * BM + ai * HALF + wr * 64 + m * 16 + fr;
                bf16_t* rowp = O + (size_t)row * INW + u.pn * BM + wc * 32 + 4 * fq;
                const int pos = row & (L - 1), pp = (wc & 1) ? (pos & 63) : (pos >> 6);
                const f32x4* tp = (const f32x4*)(tab + (pp * 16 + 4 * fq) * 2);
#pragma unroll
                for (int bj = 0; bj < 2; ++bj) {
                    const int colbase = u.pn * BM + bj * HALF;
                    f32x4 v0 = acc[ai][bj][m][0], v1 = acc[ai][bj][m][1];
                    if (latent && colbase < C_VA) {
                        const f32x4 t0 = tp[0], t1 = tp[1];
                        const f32x4 cs = {t0.x, t0.z, t1.x, t1.z}, sn = {t0.y, t0.w, t1.y, t1.w};
                        const f32x4 a0 = v0 * cs - v1 * sn, a1 = v1 * cs + v0 * sn; v0 = a0; v1 = a1;
                    }
                    if (colbase < C_KA || (colbase >= C_QB && colbase < C_KB)) { v0 = v0 * QSCALE; v1 = v1 * QSCALE; }
                    u32x2 w0, w1; w0.x = pk2(v0.x, v0.y); w0.y = pk2(v0.z, v0.w); w1.x = pk2(v1.x, v1.y); w1.y = pk2(v1.z, v1.w);
                    *(u32x2*)(rowp + bj * HALF) = w0; *(u32x2*)(rowp + bj * HALF + 16) = w1;
                }
            }
    }
};
struct EpiF32 {
    static constexpr bool PERM = false;
    float* O; int ldc;
    __device__ __forceinline__ void operator()(const f32x4 (&acc)[2][2][4][2], const Unit& u, int wr, int wc, int fr, int fq) const {
#pragma unroll
        for (int ai = 0; ai < 2; ++ai)
#pragma unroll
            for (int m = 0; m < 4; ++m) {
                float* rowp = O + (size_t)(u.pm * BM + ai * HALF + wr * 64 + m * 16 + fr) * ldc + u.pn * BM + wc * 32 + 4 * fq;
#pragma unroll
                for (int bj = 0; bj < 2; ++bj)
#pragma unroll
                    for (int n = 0; n < 2; ++n) *(f32x4*)(rowp + bj * HALF + 16 * n) = acc[ai][bj][m][n];
            }
    }
};
struct EpiSwiglu {
    static constexpr bool PERM = false;
    bf16_t* act; const float* b1;
    __device__ __forceinline__ void operator()(const f32x4 (&acc)[2][2][4][2], const Unit& u, int wr, int wc, int fr, int fq) const {
#pragma unroll
        for (int bj = 0; bj < 2; ++bj) {
            const int f0 = 16 * (8 * u.pn + 4 * bj + wc) + 4 * fq;
            const f32x4* bp = (const f32x4*)(b1 + (size_t)u.e * 2048 + 2 * f0); const f32x4 bA = bp[0], bB = bp[1];
            const f32x4 bg = {bA.x, bA.z, bB.x, bB.z}, bl = {bA.y, bA.w, bB.y, bB.w};
#pragma unroll
            for (int ai = 0; ai < 2; ++ai)
#pragma unroll
                for (int m = 0; m < 4; ++m) {
                    const int row = u.pm * BM + ai * HALF + wr * 64 + m * 16 + fr;
                    const f32x4 gt = acc[ai][bj][m][0] + bg, ln = acc[ai][bj][m][1] + bl; float a[4];
#pragma unroll
                    for (int j = 0; j < 4; ++j) { const float gg = fminf(gt[j], 7.f), ll = fminf(fmaxf(ln[j], -7.f), 7.f);
                        a[j] = gg * __builtin_amdgcn_rcpf(1.f + __expf(-1.702f * gg)) * (ll + 1.f); }
                    u32x2 w; w.x = pk2(a[0], a[1]); w.y = pk2(a[2], a[3]);
                    *(u32x2*)(act + (size_t)row * D + f0) = w;
                }
        }
    }
};
struct EpiScatter {
    static constexpr bool PERM = true;
    bf16_t* y; const float* b2; const int* eslot; const float* ew; const PG8_LAS int* sb;
    __device__ __forceinline__ void operator()(const f32x4 (&acc)[2][2][4][2], const Unit& u, int wr, int wc, int fr, int fq) const {
        const int col0 = u.pn * BM + wc * 32 + 8 * fq;
        f32x4 bv[2][2];
#pragma unroll
        for (int bj = 0; bj < 2; ++bj)
#pragma unroll
            for (int n = 0; n < 2; ++n) bv[bj][n] = *(const f32x4*)(b2 + (size_t)u.e * D + col0 + bj * HALF + 4 * n);
#pragma unroll
        for (int ai = 0; ai < 2; ++ai)
#pragma unroll
            for (int m = 0; m < 4; ++m) {
                const int row = u.pm * BM + ai * HALF + wr * 64 + m * 16 + fr;
                const int rk = row - sb[u.e], cn = sb[40 + u.e]; const int rkc = rk < cn - 1 ? rk : cn - 1;
                const int slot = eslot[(size_t)u.e * ECAP + rkc]; const float w = ew[(size_t)u.e * ECAP + rkc];
                if (rk < cn) {
                    bf16_t* rowp = y + (size_t)slot * D + col0;
#pragma unroll
                    for (int bj = 0; bj < 2; ++bj) { const f32x4 v0 = (acc[ai][bj][m][0] + bv[bj][0]) * w, v1 = (acc[ai][bj][m][1] + bv[bj][1]) * w;
                        u32x4 o; o.x = pk2(v0.x, v0.y); o.y = pk2(v0.z, v0.w); o.z = pk2(v1.x, v1.y); o.w = pk2(v1.z, v1.w);
                        *(u32x4*)(rowp + bj * HALF) = o; }
                }
            }
    }
};
}

__device__ void p0_mod(const Params& p, float* sS  , float* sP  ) {
    float* mod = (float*)(p.ws + WS_MOD);
    const int tid = threadIdx.x, lane = tid & 63, wave = tid >> 6;
    if (blockIdx.x >= 96) return;
    for (int i = tid; i < 9 * D; i += NTHREADS) { const int r = i >> 10, k = i & 1023; const float cc = r < 8 ? p.c[r * D + k] : p.c_ctx[k]; sS[i] = cc / (1.f + __expf(-cc)); }
    __syncthreads();
    const int j = blockIdx.x * 64 + lane;
    float acc[9];
#pragma unroll
    for (int r = 0; r < 9; ++r) acc[r] = 0.f;
    const float* wp = p.w_ada + (size_t)(wave * 128) * 6144 + j;
#pragma unroll 1
    for (int k0 = 0; k0 < 128; k0 += 16) {
        float w[16];
#pragma unroll
        for (int kk = 0; kk < 16; ++kk) w[kk] = wp[(size_t)(k0 + kk) * 6144];
#pragma unroll
        for (int kk = 0; kk < 16; ++kk)
#pragma unroll
            for (int r = 0; r < 9; ++r) acc[r] = fmaf(sS[r * D + wave * 128 + k0 + kk], w[kk], acc[r]);
    }
#pragma unroll
    for (int r = 0; r < 9; ++r) sP[(wave * 9 + r) * 64 + lane] = acc[r];
    __syncthreads();
    for (int i = tid; i < 9 * 64; i += NTHREADS) { const int r = i >> 6, jj = i & 63; float s = p.b_ada[blockIdx.x * 64 + jj];
#pragma unroll
        for (int w = 0; w < 8; ++w) s += sP[(w * 9 + r) * 64 + jj];
        mod[r * 6144 + blockIdx.x * 64 + jj] = s; }
    __syncthreads();
}
__device__ void p0_tab(const Params& p, int gtid, int gsize) {
    float* tab = (float*)(p.ws + WS_TAB);
    for (int idx = gtid; idx < 64 * 16; idx += gsize) {
        const int pos = idx >> 4, i = idx & 15;
        const float freq = exp2f(-(float)i * (13.287712379549449f / 16.f));
        const float ang = (float)pos * freq;
        const float n = rintf(ang * 0.15915494309189535f);
        float r = fmaf(-n, 6.28125f, ang); r = fmaf(-n, 1.9353071795864769e-3f, r);
        tab[idx * 2] = __cosf(r); tab[idx * 2 + 1] = __sinf(r);
    }
}
template <int MODE>
__device__ __forceinline__ void conv_item(const float* src, int K, int N, bf16_t* dst, int item, float* scr, int lane, const float* gA, const float* gB) {
    const int nblk = N / 32, kb = item / nblk, nb = item % nblk, k0 = 64 * kb, n0 = 32 * nb;
    const int c = lane & 31, kh = lane >> 5;
    const int nl = MODE == 1 ? 16 * (c & 1) + (c >> 1) : c;
    float v[32];
    const float* sp = src + (size_t)(k0 + kh) * N + n0 + c;
#pragma unroll
    for (int i = 0; i < 32; ++i) v[i] = sp[(size_t)(2 * i) * N];
#pragma unroll
    for (int i = 0; i < 32; ++i) { float x = v[i]; if (MODE == 2) { const int k = k0 + 2 * i + kh; x *= (k < 512 ? gA[k] : gB[k - 512]); } scr[(2 * i + kh) * 33 + nl] = x; }
    asm volatile("s_waitcnt lgkmcnt(0)" ::: "memory");
    const int ch = lane & 7;
#pragma unroll
    for (int j = 0; j < 4; ++j) { const int n = (lane >> 3) + 8 * j; const float* s = scr + (8 * ch) * 33 + n;
        u32x4 o; o.x = pk2(s[0 * 33], s[1 * 33]); o.y = pk2(s[2 * 33], s[3 * 33]); o.z = pk2(s[4 * 33], s[5 * 33]); o.w = pk2(s[6 * 33], s[7 * 33]);
        *(u32x4*)(dst + (size_t)(n0 + n) * K + k0 + 8 * ch) = o; }
    asm volatile("s_waitcnt lgkmcnt(0)" ::: "memory");
}
__device__ void p0_weights(const Params& p, float* scr, int gw, int ngw, int lane) {
    constexpr int I_IN = 16 * 72, I_OUT = 16 * 32, I_W1 = 16 * 64, I_W2 = 16 * 32;
    constexpr int NITEMS = I_IN + I_OUT + NE * I_W1 + NE * I_W2;
    for (int it = gw; it < NITEMS; it += ngw) {
        int r = it;
        if (r < I_IN) { conv_item<0>(p.w_in, D, INW, (bf16_t*)(p.ws + WS_WIN), r, scr, lane, nullptr, nullptr); continue; } r -= I_IN;
        if (r < I_OUT) { conv_item<2>(p.w_out, D, D, (bf16_t*)(p.ws + WS_WOUT), r, scr, lane, p.g_grp_a, p.g_grp_b); continue; } r -= I_OUT;
        if (r < NE * I_W1) { const int e = r / I_W1, q = r % I_W1;
            conv_item<1>(p.w_mlp1 + (size_t)e * D * 2048, D, 2048, (bf16_t*)(p.ws + WS_W1) + (size_t)e * 2048 * D, q, scr, lane, nullptr, nullptr); continue; } r -= NE * I_W1;
        { const int e = r / I_W2, q = r % I_W2;
            conv_item<0>(p.w_mlp2 + (size_t)e * D * D, D, D, (bf16_t*)(p.ws + WS_W2) + (size_t)e * D * D, q, scr, lane, nullptr, nullptr); }
    }
}

__device__ __forceinline__ void p1_row(const Params& p, const float* mod, bf16_t* hb, int m, const f32x4 (&v)[4], int lane) {
    const int b = m < NTOK ? m / L : 8;
    const float* sh = mod + b * 6144, * sc = sh + 1024;
    float s = 0.f;
#pragma unroll
    for (int j = 0; j < 4; ++j) s += v[j].x * v[j].x + v[j].y * v[j].y + v[j].z * v[j].z + v[j].w * v[j].w;
    const float rstd = rsqrtf(wave_sum(s) * (1.f / D) + EPS);
#pragma unroll
    for (int j = 0; j < 4; ++j) {
        const int c0 = 4 * (lane + 64 * j);
        const f32x4 g = *(const f32x4*)(p.g_pre_mix + c0), a = *(const f32x4*)(sc + c0), bsh = *(const f32x4*)(sh + c0);
        const f32x4 o = (v[j] * rstd * g) * (a + 1.f) + bsh;
        u32x2 w; w.x = pk2(o.x, o.y); w.y = pk2(o.z, o.w);
        *(u32x2*)(hb + (size_t)m * D + c0) = w;
    }
}
__device__ void p1_h(const Params& p, int gw, int ngw, int lane) {
    const float* mod = (const float*)(p.ws + WS_MOD);
    bf16_t* hb = (bf16_t*)(p.ws + WS_HB);
    for (int m = gw; m < MROWS; m += 2 * ngw) {
        const int m2 = m + ngw; const bool has2 = m2 < MROWS;
        const float* xr = m < NTOK ? p.x + (size_t)m * D : p.ctx + (size_t)(m - NTOK) * D;
        const float* xr2 = m2 < NTOK ? p.x + (size_t)m2 * D : p.ctx + (size_t)(m2 - NTOK) * D;
        f32x4 v[4], v2[4];
#pragma unroll
        for (int j = 0; j < 4; ++j) v[j] = ((const f32x4*)xr)[lane + 64 * j];
        if (has2) {
#pragma unroll
            for (int j = 0; j < 4; ++j) v2[j] = ((const f32x4*)xr2)[lane + 64 * j];
        }
        p1_row(p, mod, hb, m, v, lane);
        if (has2) p1_row(p, mod, hb, m2, v2, lane);
    }
}

template <class AL, class BL, class EP>
__device__ __forceinline__ void ngemm_tile(float* sA, float* sB, int m0, int n0, int K, const AL& aload, const BL& bload, const EP& epi) {
    const int tid = threadIdx.x, ty = tid >> 4, tx = tid & 15;
    float acc[4][4];
#pragma unroll
    for (int i = 0; i < 4; ++i)
#pragma unroll
        for (int j = 0; j < 4; ++j) acc[i][j] = 0.f;
    for (int k0 = 0; k0 < K; k0 += 16) {
#pragma unroll
        for (int i = 0; i < 4; ++i) { const int e = tid + NTHREADS * i, r = e >> 4, kk = e & 15; sA[kk * 132 + r] = aload(m0 + r, k0 + kk); }
#pragma unroll
        for (int i = 0; i < 2; ++i) { const int e = tid + NTHREADS * i, n = e >> 4, kk = e & 15; sB[kk * 68 + n] = bload(n0 + n, k0 + kk); }
        __syncthreads();
#pragma unroll
        for (int kk = 0; kk < 16; ++kk) {
            float a[4], b[4];
#pragma unroll
            for (int i = 0; i < 4; ++i) a[i] = sA[kk * 132 + ty * 4 + i];
#pragma unroll
            for (int j = 0; j < 4; ++j) b[j] = sB[kk * 68 + tx + 16 * j];
#pragma unroll
            for (int i = 0; i < 4; ++i)
#pragma unroll
                for (int j = 0; j < 4; ++j) acc[i][j] = fmaf(a[i], b[j], acc[i][j]);
        }
        __syncthreads();
    }
    epi(m0 + ty * 4, n0, tx, acc);
}

__device__ void p2_qkv_naive(const Params& p, float* sA, float* sB) {
    const bf16_t* hb = (const bf16_t*)(p.ws + WS_HB); const bf16_t* wT = (const bf16_t*)(p.ws + WS_WIN);
    bf16_t* qkv = (bf16_t*)(p.ws + WS_QKV); const float* tab = (const float*)(p.ws + WS_TAB);
    constexpr int NTN = INW / 64, NT = (MROWS / 128) * NTN;
    for (int t = blockIdx.x; t < NT; t += gridDim.x) {
        const int m0 = (t / NTN) * 128, n0 = (t % NTN) * 64;
        auto al = [&](int r, int k) { return bf2f(hb[(size_t)r * D + k]); };
        auto bl = [&](int n, int k) { return bf2f(wT[(size_t)n * D + k]); };
        auto ep = [&](int r0, int nn0, int tx, float (&acc)[4][4]) {
#pragma unroll
            for (int i = 0; i < 4; ++i) {
                const int r = r0 + i; float v0 = acc[i][0], v1 = acc[i][1], v2 = acc[i][2], v3 = acc[i][3];
                const bool rope = (nn0 < C_VA) && (r < NTOK);
                if (rope) { const int t = r & (L - 1), pr = t >> 6, pc = t & 63;
                    const float c0 = tab[(pr * 16 + tx) * 2], s0 = tab[(pr * 16 + tx) * 2 + 1], c1 = tab[(pc * 16 + tx) * 2], s1 = tab[(pc * 16 + tx) * 2 + 1];
                    const float a0 = v0 * c0 - v1 * s0, a1 = v1 * c0 + v0 * s0, a2 = v2 * c1 - v3 * s1, a3 = v3 * c1 + v2 * s1; v0 = a0; v1 = a1; v2 = a2; v3 = a3; }
                const bool isq = (nn0 < C_KA) || (nn0 >= C_QB && nn0 < C_KB);
                if (isq) { v0 *= QSCALE; v1 *= QSCALE; v2 *= QSCALE; v3 *= QSCALE; }
                bf16_t* o = qkv + (size_t)r * INW + nn0 + tx;
                o[0] = (bf16_t)f2bf(v0); o[16] = (bf16_t)f2bf(v1); o[32] = (bf16_t)f2bf(v2); o[48] = (bf16_t)f2bf(v3);
            }
        };
        ngemm_tile(sA, sB, m0, n0, D, al, bl, ep);
    }
}

__device__ __forceinline__ void load_row64(const bf16_t* src, float* dst) {
#pragma unroll
    for (int c = 0; c < 8; ++c) { const u32x4 w = *(const u32x4*)(src + c * 8);
        dst[c * 8 + 0] = __uint_as_float(w.x << 16); dst[c * 8 + 1] = __uint_as_float(w.x & 0xffff0000u);
        dst[c * 8 + 2] = __uint_as_float(w.y << 16); dst[c * 8 + 3] = __uint_as_float(w.y & 0xffff0000u);
        dst[c * 8 + 4] = __uint_as_float(w.z << 16); dst[c * 8 + 5] = __uint_as_float(w.z & 0xffff0000u);
        dst[c * 8 + 6] = __uint_as_float(w.w << 16); dst[c * 8 + 7] = __uint_as_float(w.w & 0xffff0000u); }
}
struct OnlineSm { float m, l; };
__device__ __forceinline__ void attn_key(const float (&q)[64], float (&o)[64], OnlineSm& st, const bf16_t* krow, const bf16_t* vrow, float bias) {
    float s = bias;
#pragma unroll
    for (int c = 0; c < 8; ++c) { const u32x4 w = *(const u32x4*)(krow + c * 8);
        s = fmaf(q[c * 8 + 0], __uint_as_float(w.x << 16), s); s = fmaf(q[c * 8 + 1], __uint_as_float(w.x & 0xffff0000u), s);
        s = fmaf(q[c * 8 + 2], __uint_as_float(w.y << 16), s); s = fmaf(q[c * 8 + 3], __uint_as_float(w.y & 0xffff0000u), s);
        s = fmaf(q[c * 8 + 4], __uint_as_float(w.z << 16), s); s = fmaf(q[c * 8 + 5], __uint_as_float(w.z & 0xffff0000u), s);
        s = fmaf(q[c * 8 + 6], __uint_as_float(w.w << 16), s); s = fmaf(q[c * 8 + 7], __uint_as_float(w.w & 0xffff0000u), s); }
    const float mn = fmaxf(st.m, s), sc = exp2f(st.m - mn), pp = exp2f(s - mn);
    st.l = st.l * sc + pp; st.m = mn;
#pragma unroll
    for (int c = 0; c < 8; ++c) { const u32x4 w = *(const u32x4*)(vrow + c * 8);
        o[c * 8 + 0] = fmaf(pp, __uint_as_float(w.x << 16), o[c * 8 + 0] * sc); o[c * 8 + 1] = fmaf(pp, __uint_as_float(w.x & 0xffff0000u), o[c * 8 + 1] * sc);
        o[c * 8 + 2] = fmaf(pp, __uint_as_float(w.y << 16), o[c * 8 + 2] * sc); o[c * 8 + 3] = fmaf(pp, __uint_as_float(w.y & 0xffff0000u), o[c * 8 + 3] * sc);
        o[c * 8 + 4] = fmaf(pp, __uint_as_float(w.z << 16), o[c * 8 + 4] * sc); o[c * 8 + 5] = fmaf(pp, __uint_as_float(w.z & 0xffff0000u), o[c * 8 + 5] * sc);
        o[c * 8 + 6] = fmaf(pp, __uint_as_float(w.w << 16), o[c * 8 + 6] * sc); o[c * 8 + 7] = fmaf(pp, __uint_as_float(w.w & 0xffff0000u), o[c * 8 + 7] * sc); }
}
__device__ __forceinline__ void store_o64(bf16_t* dst, const float (&o)[64], float inv) {
#pragma unroll
    for (int c = 0; c < 8; ++c) { u32x4 w; w.x = pk2(o[c * 8] * inv, o[c * 8 + 1] * inv); w.y = pk2(o[c * 8 + 2] * inv, o[c * 8 + 3] * inv);
        w.z = pk2(o[c * 8 + 4] * inv, o[c * 8 + 5] * inv); w.w = pk2(o[c * 8 + 6] * inv, o[c * 8 + 7] * inv); *(u32x4*)(dst + c * 8) = w; }
}
__device__ void p3_attn_naive(const Params& p, int gtid, int gsize) {
    const bf16_t* qkv = (const bf16_t*)(p.ws + WS_QKV); bf16_t* ob = (bf16_t*)(p.ws + WS_O);
    for (int it = gtid; it < NTOK * 16; it += gsize) {
        const bool isB = it >= NTOK * 8; const int w = isB ? it - NTOK * 8 : it;
        const int h = w & 7, tokg = w >> 3, b = tokg / L, t = tokg % L;
        float q[64], o[64];
#pragma unroll
        for (int d = 0; d < 64; ++d) o[d] = 0.f;
        OnlineSm st;
        if (!isB) {
            const int kvh = h >> 2;
            load_row64(qkv + (size_t)tokg * INW + C_QA + h * 64, q);
            st.m = p.sink_a[h] * LOG2E; st.l = 1.f;
            const int j0 = t - 128 < 0 ? 0 : t - 128, j1 = t + 128 > L - 1 ? L - 1 : t + 128;
            for (int j = j0; j <= j1; ++j) { const bf16_t* row = qkv + (size_t)(b * L + j) * INW; attn_key(q, o, st, row + C_KA + kvh * 64, row + C_VA + kvh * 64, 0.f); }
            for (int c = 0; c < CTX; ++c) { const bf16_t* row = qkv + (size_t)(NTOK + b * CTX + c) * INW; attn_key(q, o, st, row + C_KA + kvh * 64, row + C_VA + kvh * 64, 0.f); }
            store_o64(ob + (size_t)tokg * D + h * 64, o, 1.f / st.l);
        } else {
            load_row64(qkv + (size_t)tokg * INW + C_QB + h * 64, q);
            st.m = -1e30f; st.l = 0.f;
            const int r = t >> 6, c = t & 63;
            const int rs = r - 4 < 0 ? 0 : (r - 4 > 56 ? 56 : r - 4), cs = c - 8 < 0 ? 0 : (c - 8 > 48 ? 48 : c - 8);
            for (int a = 0; a < 8; ++a)
                for (int e = 0; e < 16; ++e) { const int kr = rs + a, kc = cs + e; const bf16_t* row = qkv + (size_t)(b * L + kr * 64 + kc) * INW;
                    const float bias = p.rpb_b[(h * 15 + (kr - r + 7)) * 31 + (kc - c + 15)] * LOG2E;
                    attn_key(q, o, st, row + C_KB + h * 64, row + C_VB + h * 64, bias); }
            for (int cc = 0; cc < CTX; ++cc) { const bf16_t* row = qkv + (size_t)(NTOK + b * CTX + cc) * INW; attn_key(q, o, st, row + C_KB + h * 64, row + C_VB + h * 64, 0.f); }
            store_o64(ob + (size_t)tokg * D + 512 + h * 64, o, 1.f / st.l);
        }
    }
}


namespace att {
#define ATT_LAS __attribute__((address_space(3)))
typedef float f32x16 __attribute__((ext_vector_type(16)));
typedef short bf16x8 __attribute__((ext_vector_type(8)));
typedef short s16x4 __attribute__((ext_vector_type(4)));
constexpr int SLOTB = 8192;
constexpr int LDS_K = 0, LDS_V = 2 * SLOTB, LDS_WS = 4 * SLOTB, LDS_BT = LDS_WS + 8 * 256;
constexpr int BT_MARGIN = 64, BT_FLOATS = BT_MARGIN + 15 * 32 + 96;
constexpr float NEGBIG = -1e30f;
__device__ __forceinline__ int crow(int r, int hi) { return (r & 3) + 8 * (r >> 2) + 4 * hi; }
__device__ __forceinline__ unsigned cvtpk(float lo, float hi) { typedef float f2 __attribute__((ext_vector_type(2))); typedef __bf16 b2 __attribute__((ext_vector_type(2)));
    f2 v = {lo, hi}; b2 b = __builtin_convertvector(v, b2); return __builtin_bit_cast(unsigned, b); }
__device__ __forceinline__ s16x4 vtr(const ATT_LAS unsigned char* p) { typedef short v4i16 __attribute__((ext_vector_type(4)));
    return __builtin_bit_cast(s16x4, __builtin_amdgcn_ds_read_tr16_b64_v4i16((ATT_LAS v4i16*)p)); }
#define ATT_WAIT_BAR(N) asm volatile("s_waitcnt vmcnt(" #N ") lgkmcnt(0)\n\ts_barrier" ::: "memory")

__device__ __forceinline__ void dma_tile(ATT_LAS unsigned char* lds, int slot, const bf16_t* kbase, const bf16_t* vbase, int wid, int lane) {
    const bf16_t* ksrc = kbase + (size_t)lane * INW + wid * 8;
    const bf16_t* vsrc = vbase + (size_t)(16 * (wid & 3) + (lane >> 2)) * INW + (wid >> 2) * 32 + (lane & 3) * 8;
    __builtin_amdgcn_global_load_lds((const unsigned*)ksrc, (ATT_LAS unsigned*)(lds + LDS_K + slot * SLOTB + wid * 1024), 16, 0, 0);
    __builtin_amdgcn_global_load_lds((const unsigned*)vsrc, (ATT_LAS unsigned*)(lds + LDS_V + slot * SLOTB + wid * 1024), 16, 0, 0);
}

template <bool ISB>
__device__ __forceinline__ void attn_unit(const Params& p, ATT_LAS unsigned char* lds, int unit) {
    const int tid = threadIdx.x, lane = tid & 63, r32 = lane & 31, hi = lane >> 5; const int wid = __builtin_amdgcn_readfirstlane(tid >> 6);
    const bf16_t* qkv = (const bf16_t*)(p.ws + WS_QKV); bf16_t* ob = (bf16_t*)(p.ws + WS_O);
    ATT_LAS float* wsf = (ATT_LAS float*)(lds + LDS_WS) + wid * 64;
    ATT_LAS float* bt = (ATT_LAS float*)(lds + LDS_BT);
    int b, h, kcol, vcol, qcol, ocol, q0, nloc, row_lo = 0, qr = 0, half = 0, qb = 0, jlo = 0;
    if (!ISB) { b = unit >> 7; const int kvh = (unit >> 6) & 1; qb = unit & 63; h = kvh * 4 + (wid >> 1); half = wid & 1; q0 = qb * 64 + 32 * half;
        kcol = C_KA + kvh * 64; vcol = C_VA + kvh * 64; qcol = C_QA + h * 64; ocol = h * 64;
        jlo = 2 - qb > 0 ? 2 - qb : 0; const int jhi = 65 - qb < 4 ? 65 - qb : 4; nloc = jhi - jlo + 1;
    } else { b = unit >> 7; h = (unit >> 4) & 7; const int g = unit & 15; qr = 4 * g + (wid >> 1); half = wid & 1; q0 = qr * 64 + 32 * half;
        kcol = C_KB + h * 64; vcol = C_VB + h * 64; qcol = C_QB + h * 64; ocol = 512 + h * 64;
        const int r0 = 4 * g, r3 = 4 * g + 3; row_lo = r0 - 4 < 0 ? 0 : (r0 - 4 > 56 ? 56 : r0 - 4); const int rs3 = r3 - 4 < 0 ? 0 : (r3 - 4 > 56 ? 56 : r3 - 4); nloc = rs3 + 7 - row_lo + 1;
    }
    const int NT = nloc + 4;
    const bf16_t* lat = qkv + (size_t)b * L * INW; const bf16_t* cx = qkv + (size_t)(NTOK + b * CTX) * INW;
#define ATT_TILE_ROW(t) ((t) < nloc ? lat + (size_t)(ISB ? (row_lo + (t)) * 64 : (qb - 2 + jlo + (t)) * 64) * INW : cx + (size_t)((t) - nloc) * 64 * INW)
    if (ISB) {
        for (int i = tid; i < BT_FLOATS; i += NTHREADS) { const int j = i - BT_MARGIN; float v = 0.f;
            if (j >= 0 && j < 15 * 32 && (j & 31) < 31) v = p.rpb_b[(h * 15 + (j >> 5)) * 31 + (j & 31)] * LOG2E;
            bt[i] = v; }
    }
    { const bf16_t* r0p = ATT_TILE_ROW(0); dma_tile(lds, 0, r0p + kcol, r0p + vcol, wid, lane); }
    bf16x8 qf[4];
    { const bf16_t* qp = lat + (size_t)(q0 + r32) * INW + qcol + hi * 8;
#pragma unroll
      for (int d0 = 0; d0 < 4; ++d0) qf[d0] = *(const bf16x8*)(qp + d0 * 16); }
    float m_run, l_run;
    if (!ISB) { m_run = p.sink_a[h] * LOG2E; l_run = hi == 0 ? 1.f : 0.f; } else { m_run = NEGBIG; l_run = 0.f; }
    f32x16 o0, o1;
#pragma unroll
    for (int r = 0; r < 16; ++r) { o0[r] = 0.f; o1[r] = 0.f; }
    const int qc = 32 * half + r32;
    const int cs = qc - 8 < 0 ? 0 : (qc - 8 > 48 ? 48 : qc - 8);
    const int rsq = qr - 4 < 0 ? 0 : (qr - 4 > 56 ? 56 : qr - 4);
    for (int t = 0; t < NT; ++t) {
        if (t + 1 < NT) { const bf16_t* rp = ATT_TILE_ROW(t + 1); dma_tile(lds, (t + 1) & 1, rp + kcol, rp + vcol, wid, lane); ATT_WAIT_BAR(2); }
        else { ATT_WAIT_BAR(0); }
        const int slot = t & 1;
        bool active = true; int kr = 0;
        if (ISB && t < nloc) { kr = row_lo + t; active = (kr >= rsq) && (kr <= rsq + 7); }
        if (active) {
            const ATT_LAS unsigned char* kb = lds + LDS_K + slot * SLOTB + hi * 1024 + r32 * 16;
            f32x16 p0, p1;
#pragma unroll
            for (int r = 0; r < 16; ++r) { p0[r] = 0.f; p1[r] = 0.f; }
#pragma unroll
            for (int d0 = 0; d0 < 4; ++d0) {
                const bf16x8 k0 = *(const ATT_LAS bf16x8*)(kb + d0 * 2048), k1 = *(const ATT_LAS bf16x8*)(kb + d0 * 2048 + 512);
                p0 = __builtin_amdgcn_mfma_f32_32x32x16_bf16(k0, qf[d0], p0, 0, 0, 0);
                p1 = __builtin_amdgcn_mfma_f32_32x32x16_bf16(k1, qf[d0], p1, 0, 0, 0);
            }
            if (ISB) {
                if (t < nloc) {
                    const ATT_LAS float* bp = bt + BT_MARGIN + (kr - qr + 7) * 32 + 15 - qc + 4 * hi;
                    const int e0 = 4 * hi - cs;
#pragma unroll
                    for (int r = 0; r < 16; ++r) { const int c = (r & 3) + 8 * (r >> 2);
                        const float b0 = bp[c], b1 = bp[c + 32];
                        p0[r] = ((unsigned)(c + e0) < 16u) ? p0[r] + b0 : NEGBIG;
                        p1[r] = ((unsigned)(c + 32 + e0) < 16u) ? p1[r] + b1 : NEGBIG; }
                }
            } else {
                if (t < nloc) { const int j = jlo + t; const int qq = 32 * half + r32;
                    if (j == 0) {
#pragma unroll
                        for (int r = 0; r < 16; ++r) { const int c = crow(r, hi); if (c < qq) p0[r] = NEGBIG; if (c + 32 < qq) p1[r] = NEGBIG; }
                    } else if (j == 4) {
#pragma unroll
                        for (int r = 0; r < 16; ++r) { const int c = crow(r, hi); if (c > qq) p0[r] = NEGBIG; if (c + 32 > qq) p1[r] = NEGBIG; }
                    }
                }
            }
            float rm = fmaxf(p0[0], p1[0]);
#pragma unroll
            for (int r = 1; r < 16; ++r) rm = fmaxf(rm, fmaxf(p0[r], p1[r]));
            rm = fmaxf(rm, __shfl_xor(rm, 32));
            const float mnew = fmaxf(m_run, rm);
            if (__any(mnew > m_run)) {
                const float f = __builtin_amdgcn_exp2f(m_run - mnew);
                l_run *= f; m_run = mnew;
                if (hi == 0) wsf[r32] = f;
                asm volatile("s_waitcnt lgkmcnt(0)" ::: "memory");
#pragma unroll
                for (int r = 0; r < 16; ++r) { const float fr_ = wsf[crow(r, hi)]; o0[r] *= fr_; o1[r] *= fr_; }
            }
            float ls = 0.f;
#pragma unroll
            for (int r = 0; r < 16; ++r) { p0[r] = __builtin_amdgcn_exp2f(p0[r] - m_run); p1[r] = __builtin_amdgcn_exp2f(p1[r] - m_run); ls += p0[r] + p1[r]; }
            l_run += ls;
            typedef unsigned u4 __attribute__((ext_vector_type(4)));
            const u4 pw0 = {cvtpk(p0[0], p0[1]), cvtpk(p0[2], p0[3]), cvtpk(p0[4], p0[5]), cvtpk(p0[6], p0[7])};
            const u4 pw1 = {cvtpk(p0[8], p0[9]), cvtpk(p0[10], p0[11]), cvtpk(p0[12], p0[13]), cvtpk(p0[14], p0[15])};
            const u4 pw2 = {cvtpk(p1[0], p1[1]), cvtpk(p1[2], p1[3]), cvtpk(p1[4], p1[5]), cvtpk(p1[6], p1[7])};
            const u4 pw3 = {cvtpk(p1[8], p1[9]), cvtpk(p1[10], p1[11]), cvtpk(p1[12], p1[13]), cvtpk(p1[14], p1[15])};
            const ATT_LAS unsigned char* vp = lds + LDS_V + slot * SLOTB + ((lane >> 4) & 1) * 32 + (lane & 3) * 8 + (4 * hi + ((lane & 15) >> 2)) * 64;
#define ATT_PV(OACC, PW, D0, KS) do { const s16x4 lo_ = vtr(vp + (D0) * 4096 + (KS) * 1024), hi_ = vtr(vp + (D0) * 4096 + (KS) * 1024 + 512); \
                const bf16x8 vf_ = {lo_[0], lo_[1], lo_[2], lo_[3], hi_[0], hi_[1], hi_[2], hi_[3]}; \
                OACC = __builtin_amdgcn_mfma_f32_32x32x16_bf16(__builtin_bit_cast(bf16x8, PW), vf_, OACC, 0, 0, 0); } while (0)
            ATT_PV(o0, pw0, 0, 0); ATT_PV(o1, pw0, 1, 0); ATT_PV(o0, pw1, 0, 1); ATT_PV(o1, pw1, 1, 1);
            ATT_PV(o0, pw2, 0, 2); ATT_PV(o1, pw2, 1, 2); ATT_PV(o0, pw3, 0, 3); ATT_PV(o1, pw3, 1, 3);
#undef ATT_PV
        }
        ATT_WAIT_BAR(2);
    }
    l_run += __shfl_xor(l_run, 32);
    if (hi == 0) wsf[32 + r32] = l_run;
    asm volatile("s_waitcnt lgkmcnt(0)" ::: "memory");
    bf16_t* op = ob + (size_t)(b * L + q0) * D + ocol + r32;
#pragma unroll
    for (int r = 0; r < 16; ++r) { const int q = crow(r, hi); const float inv = __builtin_amdgcn_rcpf(wsf[32 + q]);
        op[(size_t)q * D] = (bf16_t)f2bf(o0[r] * inv); op[(size_t)q * D + 32] = (bf16_t)f2bf(o1[r] * inv); }
    ATT_WAIT_BAR(0);
#undef ATT_TILE_ROW
}

__device__ __forceinline__ void attn_phase(const Params& p, ATT_LAS unsigned char* lds) {
    const int G = gridDim.x, bx = blockIdx.x;
    const int vcu = (G % 8 == 0) ? (bx % 8) * (G / 8) + bx / 8 : bx;
    for (int u = vcu; u < 2048; u += G) {
        if (u < 1024) attn_unit<false>(p, lds, u); else attn_unit<true>(p, lds, u - 1024);
    }
}
}

__device__ void p4a_ostat(const Params& p, int gw, int ngw, int lane) {
    bf16_t* ob = (bf16_t*)(p.ws + WS_O); float* os = (float*)(p.ws + WS_OSTAT);
    for (int m = gw; m < NTOK; m += ngw) {
        const u32x4 wa = *(const u32x4*)(ob + (size_t)m * D + lane * 8), wb = *(const u32x4*)(ob + (size_t)m * D + 512 + lane * 8);
        float sa = 0.f, sb = 0.f;
#pragma unroll
        for (int i = 0; i < 4; ++i) { const unsigned ua = wa[i], ub = wb[i]; const float a0 = __uint_as_float(ua << 16), a1 = __uint_as_float(ua & 0xffff0000u), b0 = __uint_as_float(ub << 16), b1 = __uint_as_float(ub & 0xffff0000u);
            sa += a0 * a0 + a1 * a1; sb += b0 * b0 + b1 * b1; }
        sa = wave_sum(sa); sb = wave_sum(sb);
        const float ra = rsqrtf(sa * (1.f / 512.f) + EPS), rb = rsqrtf(sb * (1.f / 512.f) + EPS);
        if (lane == 0) { os[m * 2] = ra; os[m * 2 + 1] = rb; }
        u32x4 oa, obb;
#pragma unroll
        for (int i = 0; i < 4; ++i) { const unsigned ua = wa[i], ub = wb[i];
            oa[i] = pk2(__uint_as_float(ua << 16) * ra, __uint_as_float(ua & 0xffff0000u) * ra); obb[i] = pk2(__uint_as_float(ub << 16) * rb, __uint_as_float(ub & 0xffff0000u) * rb); }
        *(u32x4*)(ob + (size_t)m * D + lane * 8) = oa; *(u32x4*)(ob + (size_t)m * D + 512 + lane * 8) = obb;
    }
}
__device__ void p4b_outproj_naive(const Params& p, float* sA, float* sB) {
    const bf16_t* ob = (const bf16_t*)(p.ws + WS_O); const bf16_t* wT = (const bf16_t*)(p.ws + WS_WOUT);
    float* mix = (float*)(p.ws + WS_MIX);
    constexpr int NTN = D / 64, NT = (NTOK / 128) * NTN;
    for (int t = blockIdx.x; t < NT; t += gridDim.x) {
        const int m0 = (t / NTN) * 128, n0 = (t % NTN) * 64;
        auto al = [&](int r, int k) { return bf2f(ob[(size_t)r * D + k]); };
        auto bl = [&](int n, int k) { return bf2f(wT[(size_t)n * D + k]); };
        auto ep = [&](int r0, int nn0, int tx, float (&acc)[4][4]) {
#pragma unroll
            for (int i = 0; i < 4; ++i)
#pragma unroll
                for (int j = 0; j < 4; ++j) mix[(size_t)(r0 + i) * D + nn0 + tx + 16 * j] = acc[i][j];
        };
        ngemm_tile(sA, sB, m0, n0, D, al, bl, ep);
    }
}
constexpr int SW_STRIDE = 36;
__device__ void p4c_post(const Params& p, LAS3 float* sW, int gw, int ngw, int lane) {
    const float* mod = (const float*)(p.ws + WS_MOD); const float* mix = (const float*)(p.ws + WS_MIX);
    bf16_t* hb = (bf16_t*)(p.ws + WS_HB);
    unsigned* counts = (unsigned*)(p.ws + WS_CTL);
    int* eslot = (int*)(p.ws + WS_ESLOT); float* ew = (float*)(p.ws + WS_EW);
    for (int i = threadIdx.x; i < D * 8; i += NTHREADS) { const int k = i >> 3, e4 = i & 7; const f32x4 w = ((const f32x4*)p.w_router)[i];
        LAS3 float* d = sW + ((k & 3) * 256 + (k >> 2)) * SW_STRIDE + e4 * 4; *(LAS3 f32x4*)d = w; }
    __syncthreads();
    f32x4 v[4], xx[4], nv[4], nx[4];
    if (gw < NTOK) {
#pragma unroll
        for (int j = 0; j < 4; ++j) { nv[j] = ((const f32x4*)(mix + (size_t)gw * D))[lane + 64 * j]; nx[j] = ((const f32x4*)(p.x + (size_t)gw * D))[lane + 64 * j]; }
    }
    for (int m = gw; m < NTOK; m += ngw) {
        const int b = m / L; const float* mb = mod + b * 6144;
#pragma unroll
        for (int j = 0; j < 4; ++j) { v[j] = nv[j]; xx[j] = nx[j]; }
        const int mn = m + ngw;
        if (mn < NTOK) {
#pragma unroll
            for (int j = 0; j < 4; ++j) { nv[j] = ((const f32x4*)(mix + (size_t)mn * D))[lane + 64 * j]; nx[j] = ((const f32x4*)(p.x + (size_t)mn * D))[lane + 64 * j]; }
        }
        float s = 0.f;
#pragma unroll
        for (int j = 0; j < 4; ++j) s += v[j].x * v[j].x + v[j].y * v[j].y + v[j].z * v[j].z + v[j].w * v[j].w;
        float rstd = rsqrtf(wave_sum(s) * (1.f / D) + EPS);
        s = 0.f;
        f32x4 xv[4];
#pragma unroll
        for (int j = 0; j < 4; ++j) { const int c0 = 4 * (lane + 64 * j);
            const f32x4 g = *(const f32x4*)(p.g_post_mix + c0), ga = *(const f32x4*)(mb + 2048 + c0);
            xv[j] = xx[j] + ga * (v[j] * rstd * g);
            ((f32x4*)(p.out + (size_t)m * D))[lane + 64 * j] = xv[j];
            s += xv[j].x * xv[j].x + xv[j].y * xv[j].y + xv[j].z * xv[j].z + xv[j].w * xv[j].w; }
        rstd = rsqrtf(wave_sum(s) * (1.f / D) + EPS);
        float lg[NE];
#pragma unroll
        for (int e = 0; e < NE; ++e) lg[e] = 0.f;
#pragma unroll
        for (int j = 0; j < 4; ++j) { const int c0 = 4 * (lane + 64 * j);
            const f32x4 g = *(const f32x4*)(p.g_pre_ffn + c0), sc = *(const f32x4*)(mb + 4096 + c0), sh = *(const f32x4*)(mb + 3072 + c0);
            const f32x4 h2 = (xv[j] * rstd * g) * (sc + 1.f) + sh;
            u32x2 w; w.x = pk2(h2.x, h2.y); w.y = pk2(h2.z, h2.w);
            *(u32x2*)(hb + (size_t)m * D + c0) = w;
#pragma unroll
            for (int q = 0; q < 4; ++q) { const float hv = h2[q]; const LAS3 f32x4* wr = (const LAS3 f32x4*)(sW + (q * 256 + lane + 64 * j) * SW_STRIDE);
#pragma unroll
                for (int e4 = 0; e4 < 8; ++e4) { const f32x4 ww = wr[e4]; lg[e4 * 4] = fmaf(hv, ww.x, lg[e4 * 4]); lg[e4 * 4 + 1] = fmaf(hv, ww.y, lg[e4 * 4 + 1]); lg[e4 * 4 + 2] = fmaf(hv, ww.z, lg[e4 * 4 + 2]); lg[e4 * 4 + 3] = fmaf(hv, ww.w, lg[e4 * 4 + 3]); }
                asm volatile("" ::: "memory"); }
        }
#pragma unroll
        for (int e = 0; e < NE; ++e) lg[e] = wave_sum(lg[e]) + p.b_router[e];
        float tv[4]; int ti[4]; unsigned used = 0u;
#pragma unroll
        for (int k = 0; k < 4; ++k) { float best = -3.4e38f; int bi = 0;
#pragma unroll
            for (int e = 0; e < NE; ++e) { const bool ok = !((used >> e) & 1u) && lg[e] > best; best = ok ? lg[e] : best; bi = ok ? e : bi; }
            tv[k] = best; ti[k] = bi; used |= 1u << bi; }
        const float e1 = __expf(tv[1] - tv[0]), e2 = __expf(tv[2] - tv[0]), e3 = __expf(tv[3] - tv[0]); const float inv = 1.f / (1.f + e1 + e2 + e3);
        const float tw[4] = {inv, e1 * inv, e2 * inv, e3 * inv};
        if (lane < 4) {
            int myi = ti[0]; float myw = tw[0];
#pragma unroll
            for (int k = 1; k < 4; ++k) if (lane == k) { myi = ti[k]; myw = tw[k]; }
            const unsigned rank = atomicAdd(&counts[myi], 1u);
            eslot[(size_t)myi * ECAP + rank] = m * 4 + lane; ew[(size_t)myi * ECAP + rank] = myw;
        }
    }
}
__device__ __forceinline__ void expert_bases(const unsigned* counts, int* sbase_  ) {
    LAS3 int* sbase = (LAS3 int*)sbase_;
    if (threadIdx.x < 64) {
        const int lane = threadIdx.x; const int cn = lane < NE ? (int)counts[lane] : 0; const int c = (cn + 255) & ~255;
        int incl = c;
#pragma unroll
        for (int o = 1; o < 32; o <<= 1) { const int v = __shfl_up(incl, o); if (lane >= o) incl += v; }
        if (lane < NE) { sbase[lane] = incl - c; sbase[40 + lane] = cn; }
        if (lane == NE - 1) sbase[NE] = incl;
    }
    __syncthreads();
}
__device__ __forceinline__ void p6_load(const bf16_t* y, const float* out, int m, int lane, u32x4 (&yv)[2][4], f32x4 (&xv)[2][2]) {
#pragma unroll
    for (int j = 0; j < 2; ++j) { const int c0 = 8 * (lane + 64 * j);
#pragma unroll
        for (int k = 0; k < 4; ++k) yv[j][k] = *(const u32x4*)(y + (size_t)(m * 4 + k) * D + c0);
        xv[j][0] = *(const f32x4*)(out + (size_t)m * D + c0); xv[j][1] = *(const f32x4*)(out + (size_t)m * D + c0 + 4); }
}
__device__ __forceinline__ void p6_row(const Params& p, const float* mod, int m, int lane, const u32x4 (&yv)[2][4], const f32x4 (&xv)[2][2]) {
    const int b = m / L; const float* ga2 = mod + b * 6144 + 5120;
    f32x4 a[2][2]; float s = 0.f;
#pragma unroll
    for (int j = 0; j < 2; ++j) { a[j][0] = (f32x4){0.f, 0.f, 0.f, 0.f}; a[j][1] = (f32x4){0.f, 0.f, 0.f, 0.f};
#pragma unroll
        for (int k = 0; k < 4; ++k) { const u32x4 w = yv[j][k];
            a[j][0].x += __uint_as_float(w.x << 16); a[j][0].y += __uint_as_float(w.x & 0xffff0000u); a[j][0].z += __uint_as_float(w.y << 16); a[j][0].w += __uint_as_float(w.y & 0xffff0000u);
            a[j][1].x += __uint_as_float(w.z << 16); a[j][1].y += __uint_as_float(w.z & 0xffff0000u); a[j][1].z += __uint_as_float(w.w << 16); a[j][1].w += __uint_as_float(w.w & 0xffff0000u); }
#pragma unroll
        for (int q = 0; q < 2; ++q) s += a[j][q].x * a[j][q].x + a[j][q].y * a[j][q].y + a[j][q].z * a[j][q].z + a[j][q].w * a[j][q].w; }
    const float rstd = rsqrtf(wave_sum(s) * (1.f / D) + EPS);
#pragma unroll
    for (int j = 0; j < 2; ++j)
#pragma unroll
        for (int q = 0; q < 2; ++q) { const int c0 = 8 * (lane + 64 * j) + 4 * q;
            const f32x4 g = *(const f32x4*)(p.g_post_ffn + c0), ga = *(const f32x4*)(ga2 + c0);
            *(f32x4*)(p.out + (size_t)m * D + c0) = xv[j][q] + ga * (a[j][q] * rstd * g); }
}
__device__ void p6_final(const Params& p, int gw, int ngw, int lane) {
    const float* mod = (const float*)(p.ws + WS_MOD); const bf16_t* y = (const bf16_t*)(p.ws + WS_Y);
    for (int m = gw; m < NTOK; m += 2 * ngw) {
        const int m2 = m + ngw; const bool has2 = m2 < NTOK;
        u32x4 yv[2][4], yv2[2][4]; f32x4 xv[2][2], xv2[2][2];
        p6_load(y, p.out, m, lane, yv, xv);
        if (has2) p6_load(y, p.out, m2, lane, yv2, xv2);
        p6_row(p, mod, m, lane, yv, xv);
        if (has2) p6_row(p, mod, m2, lane, yv2, xv2);
    }
}

constexpr int LDS_SBASE = 147456;
constexpr int LDS_BYTES = LDS_SBASE + 1024;

__global__ void __launch_bounds__(NTHREADS, 2) fwd_kernel(Params p) {
    cg::grid_group grid = cg::this_grid();
    extern __shared__ __attribute__((aligned(16))) unsigned char lds[];
    int* sbase = (int*)(lds + LDS_SBASE);
    const int tid = threadIdx.x, lane = tid & 63, wave = tid >> 6;
    const int gtid = blockIdx.x * NTHREADS + tid, gsize = gridDim.x * NTHREADS;
    const int gw = blockIdx.x * (NTHREADS / 64) + wave, ngw = gridDim.x * (NTHREADS / 64);
    PG8_LAS unsigned char* lds3 = (PG8_LAS unsigned char*)lds;
    const PG8_LAS int* sbase3 = (const PG8_LAS int*)(lds3 + LDS_SBASE);
    volatile LAS3 unsigned* bst = (volatile LAS3 unsigned*)(lds3 + LDS_SBASE + 512);
    if (tid < 2) bst[tid] = 0u;
    __syncthreads();
    XcdBarrier xb = xcd_barrier_post((unsigned*)(p.ws + WS_CTL) + CW_BAR, bst);

    p0_mod(p, (float*)lds, (float*)(lds + 36864));
    p0_tab(p, gtid, gsize);
    p0_weights(p, (float*)(lds + 57344 + wave * 8448), gw, ngw, lane);
    grid.sync();
    p1_h(p, gw, ngw, lane);
    xcd_barrier(xb);
    { pg8::Gemm g{(const bf16_t*)(p.ws + WS_HB), (const bf16_t*)(p.ws + WS_WIN), D, 0, nullptr, sbase3};
      pg8::StaticOrder S; S.init(MROWS, INW, (int)gridDim.x, (int)blockIdx.x, nullptr);
      pg8::EpiQKV E{(bf16_t*)(p.ws + WS_QKV), (const float*)(p.ws + WS_TAB)};
      pg8::gemm_phase<pg8::EpiQKV, pg8::StaticOrder, false, true>(lds3, g, S, E); }
    xcd_barrier(xb);
    att::attn_phase(p, lds3);
    xcd_barrier(xb);
    p4a_ostat(p, gw, ngw, lane);
    xcd_barrier(xb);
    { pg8::Gemm g{(const bf16_t*)(p.ws + WS_O), (const bf16_t*)(p.ws + WS_WOUT), D, 0, nullptr, sbase3};
      pg8::StaticOrder S; S.init(NTOK, D, (int)gridDim.x, (int)blockIdx.x, nullptr);
      pg8::EpiF32 E{(float*)(p.ws + WS_MIX), D};
      pg8::gemm_phase<pg8::EpiF32, pg8::StaticOrder, false, true>(lds3, g, S, E); }
    xcd_barrier(xb);
    p4c_post(p, (LAS3 float*)lds3, gw, ngw, lane);
    xcd_barrier(xb);
    expert_bases((const unsigned*)(p.ws + WS_CTL), sbase);
    { const int total = sbase3[NE];
      pg8::Gemm g{(const bf16_t*)(p.ws + WS_HB), (const bf16_t*)(p.ws + WS_W1), D, (size_t)2048 * D * 2, (const int*)(p.ws + WS_ESLOT), sbase3};
      pg8::StaticOrder S; S.init(total, 2048, (int)gridDim.x, (int)blockIdx.x, sbase3);
      pg8::EpiSwiglu E{(bf16_t*)(p.ws + WS_ACT), p.b_mlp1};
      pg8::gemm_phase<pg8::EpiSwiglu, pg8::StaticOrder, true, true>(lds3, g, S, E); }
    xcd_barrier(xb);
    { const int total = sbase3[NE];
      pg8::Gemm g{(const bf16_t*)(p.ws + WS_ACT), (const bf16_t*)(p.ws + WS_W2), D, (size_t)D * D * 2, nullptr, sbase3};
      pg8::StaticOrder S; S.init(total, D, (int)gridDim.x, (int)blockIdx.x, sbase3);
      pg8::EpiScatter E{(bf16_t*)(p.ws + WS_Y), p.b_mlp2, (const int*)(p.ws + WS_ESLOT), (const float*)(p.ws + WS_EW), sbase3};
      pg8::gemm_phase<pg8::EpiScatter, pg8::StaticOrder, false, true>(lds3, g, S, E); }
    xcd_barrier(xb);
    p6_final(p, gw, ngw, lane);
}

extern "C" void kernel_launch(void* const* d_in, const int* in_sizes, int n_in, void* d_out, int out_size, void* d_ws, size_t ws_size, hipStream_t stream) {
    static int grid_blocks = 0;
    if (grid_blocks == 0) {
        if (n_in != 22 || ws_size < WS_END) { fprintf(stderr, "kernel_launch: unexpected n_in %d / ws_size %zu (need %zu)\n", n_in, ws_size, (size_t)WS_END); grid_blocks = -1; return; }
        int dev = 0, cus = 0, per_cu = 0;
        (void)hipGetDevice(&dev);
        (void)hipDeviceGetAttribute(&cus, hipDeviceAttributeMultiprocessorCount, dev);
        if (hipFuncSetAttribute((const void*)fwd_kernel, hipFuncAttributeMaxDynamicSharedMemorySize, LDS_BYTES) != hipSuccess) { fprintf(stderr, "kernel_launch: hipFuncSetAttribute failed\n"); grid_blocks = -1; return; }
        (void)hipOccupancyMaxActiveBlocksPerMultiprocessor(&per_cu, (const void*)fwd_kernel, NTHREADS, LDS_BYTES);
        if (per_cu < 1) { fprintf(stderr, "kernel_launch: occupancy query returned %d\n", per_cu); grid_blocks = -1; return; }
        grid_blocks = cus;
    }
    if (grid_blocks < 0) return;
    (void)hipMemsetAsync((char*)d_ws + WS_CTL, 0, CTL_BYTES, stream);
    Params p{};
    const float** pp = (const float**)&p;
    for (int i = 0; i < 22; ++i) pp[i] = (const float*)d_in[i];
    p.out = (float*)d_out; p.ws = (unsigned char*)d_ws;
    void* args[] = {&p};
    hipError_t e = hipLaunchCooperativeKernel((const void*)fwd_kernel, dim3(grid_blocks), dim3(NTHREADS), args, LDS_BYTES, stream);
    if (e != hipSuccess) fprintf(stderr, "cooperative launch failed: %s (grid %d)\n", hipGetErrorString(e), grid_blocks);
}
```

```cpp
#include <hip/hip_runtime.h>
#include <hip/hip_cooperative_groups.h>
#include <cstdio>
#include <cstdint>
namespace cg = cooperative_groups;

constexpr int D = 1024, NB = 8, L = 4096, CTX = 256;
constexpr int NTOK = NB * L, NCTX = NB * CTX, MROWS = NTOK + NCTX;
constexpr int INW = 2304;
constexpr int C_QA = 0, C_KA = 512, C_VA = 640, C_QB = 768, C_KB = 1280, C_VB = 1792;
constexpr int NE = 32, TOPK = 4, NASG = NTOK * TOPK;
constexpr int PADROWS = NASG + NE * 256;
constexpr float LOG2E = 1.4426950408889634f;
constexpr float QSCALE = 0.125f * LOG2E;
constexpr float EPS = 1e-6f;
constexpr int NTHREADS = 512;

constexpr size_t MiB = 1u << 20;
constexpr size_t WS_CTL = 0;
constexpr size_t CTL_BYTES = 32768;
constexpr int CW_BAR = 2048;
constexpr size_t WS_MOD = 1 * MiB;
constexpr size_t WS_TAB = 1 * MiB + 256 * 1024;
constexpr size_t WS_OSTAT = 1 * MiB + 512 * 1024;
constexpr size_t WS_WIN = 2 * MiB;
constexpr size_t WS_WOUT = 7 * MiB;
constexpr size_t WS_W2 = 9 * MiB;
constexpr size_t WS_W1 = 73 * MiB;
constexpr size_t WS_HB = 201 * MiB;
constexpr int ECAP = NTOK;
constexpr size_t WS_ESLOT = 269 * MiB;
constexpr size_t WS_EW = 273 * MiB;
constexpr size_t WS_QKV = 277 * MiB;
constexpr size_t WS_O = 430 * MiB;
constexpr size_t WS_MIX = 494 * MiB;
constexpr size_t WS_ACT = 277 * MiB;
constexpr size_t WS_Y = 622 * MiB;
constexpr size_t WS_END = 878 * MiB;
static_assert(WS_W1 + (size_t)NE * 2048 * D * 2 <= WS_HB && WS_W2 + (size_t)NE * D * D * 2 <= WS_W1, "map");
static_assert(WS_HB + (size_t)MROWS * D * 2 <= WS_ESLOT && WS_ESLOT + (size_t)NE * ECAP * 4 <= WS_EW && WS_EW + (size_t)NE * ECAP * 4 <= WS_QKV, "map");
static_assert(WS_QKV + (size_t)MROWS * INW * 2 <= WS_O && WS_O + (size_t)NTOK * D * 2 <= WS_MIX && WS_MIX + (size_t)NTOK * D * 4 <= WS_Y, "map");
static_assert(WS_ACT + (size_t)PADROWS * 1024 * 2 <= WS_Y && WS_Y + (size_t)NASG * D * 2 <= WS_END, "map");

typedef unsigned short bf16_t;
typedef float f32x4 __attribute__((ext_vector_type(4)));
typedef unsigned u32x4 __attribute__((ext_vector_type(4)));
typedef unsigned u32x2 __attribute__((ext_vector_type(2)));

struct Params {
    const float *x, *c, *ctx, *c_ctx, *w_ada, *b_ada, *g_pre_mix, *g_post_mix, *g_pre_ffn, *g_post_ffn, *w_in, *g_grp_a, *g_grp_b,
        *sink_a, *rpb_b, *w_out, *w_router, *b_router, *w_mlp1, *b_mlp1, *w_mlp2, *b_mlp2;
    float* out;
    unsigned char* ws;
};

__device__ __forceinline__ float bf2f(bf16_t h) { return __uint_as_float((unsigned)h << 16); }
__device__ __forceinline__ unsigned f2bf(float f) { unsigned u = __float_as_uint(f); return (u + 0x7fffu + ((u >> 16) & 1u)) >> 16; }
__device__ __forceinline__ unsigned pk2(float lo, float hi) { return f2bf(lo) | (f2bf(hi) << 16); }
__device__ __forceinline__ float wave_sum(float v) {
#pragma unroll
    for (int o = 1; o < 64; o <<= 1) v += __shfl_xor(v, o);
    return v;
}


#define LAS3 __attribute__((address_space(3)))
#define XB_TMO      128
#define XB_XCNT(j)  (256  + 64 * (j))
#define XB_XSUB(j)  (1280 + 64 * (j))
#define XB_XGEN(j)  (2304 + 64 * (j))
#define XB_TOP      3328
#define XB_TOPGEN   3392
#define XCD_BAR_WORDS 3456
#define XB_SPIN_CAP (1u << 18)
__device__ __forceinline__ unsigned xb_ld(unsigned* p)              { return __hip_atomic_load(p, __ATOMIC_RELAXED, __HIP_MEMORY_SCOPE_AGENT); }
__device__ __forceinline__ unsigned xb_add(unsigned* p, unsigned v) { return __hip_atomic_fetch_add(p, v, __ATOMIC_RELAXED, __HIP_MEMORY_SCOPE_AGENT); }
__device__ __forceinline__ unsigned xb_xcc_id() { return (unsigned)__builtin_amdgcn_s_getreg((3 << 11) | 20) & 0xFu; }
#define XB_SPIN(cond, bar) do { unsigned _sp = 0; while (cond) { __builtin_amdgcn_s_sleep(1); \
    if ((++_sp & 255u) == 0u) { if (xb_ld(&(bar)[XB_TMO])) break; if (_sp > XB_SPIN_CAP) { atomicAdd(&(bar)[XB_TMO], 1u); break; } } } } while (0)
struct XcdBarrier { unsigned* bar; unsigned x; volatile LAS3 unsigned* st; };
__device__ __forceinline__ XcdBarrier xcd_barrier_post(unsigned* bar, volatile LAS3 unsigned* st) {
    XcdBarrier b; b.bar = bar; b.x = xb_xcc_id(); b.st = st;
    if (threadIdx.x == 0) (void)xb_add(&bar[XB_XCNT(b.x)], 1u);
    return b;
}
__device__ __forceinline__ void xcd_barrier_complete(unsigned* bar, unsigned x, unsigned& nloc, unsigned& nx) {
    const unsigned G = gridDim.x * gridDim.y * gridDim.z;
    unsigned sum, cnt, mine, sp = 0u;
    for (;;) {
        sum = 0u; cnt = 0u; mine = 0u;
#pragma unroll
        for (unsigned j = 0; j < 16; ++j) { const unsigned c = xb_ld(&bar[XB_XCNT(j)]); sum += c; cnt += (c > 0u) ? 1u : 0u; mine = (j == x) ? c : mine; }
        if (sum == G) break;
        __builtin_amdgcn_s_sleep(1);
        if ((++sp & 255u) == 0u) { if (xb_ld(&bar[XB_TMO])) break; if (sp > XB_SPIN_CAP) { atomicAdd(&bar[XB_TMO], 1u); break; } }
    }
    nloc = mine > 0u ? mine : 1u; nx = cnt > 0u ? cnt : 1u;
}
__device__ __forceinline__ void xcd_barrier(const XcdBarrier& b) {
    asm volatile("s_waitcnt vmcnt(0)" ::: "memory");
    __syncthreads();
    if (threadIdx.x == 0) {
        unsigned* bar = b.bar;
        __builtin_amdgcn_s_waitcnt(0);
        unsigned nloc = b.st[0], nx = b.st[1];
        if (nloc == 0u) { xcd_barrier_complete(bar, b.x, nloc, nx); b.st[0] = nloc; b.st[1] = nx; }
        const unsigned old = xb_add(&bar[XB_XSUB(b.x)], 1u);
        const unsigned gen = old / nloc;
        if (old + 1u == (gen + 1u) * nloc) {
            __builtin_amdgcn_fence(__ATOMIC_RELEASE, "agent");
            asm volatile("s_waitcnt vmcnt(0)" ::: "memory");
            const unsigned og = xb_add(&bar[XB_TOP], 1u);
            const unsigned tg = og / nx;
            if (og + 1u == (tg + 1u) * nx) xb_add(&bar[XB_TOPGEN], 1u);
            else XB_SPIN(xb_ld(&bar[XB_TOPGEN]) == tg, bar);
            __builtin_amdgcn_fence(__ATOMIC_ACQUIRE, "agent");
            xb_add(&bar[XB_XGEN(b.x)], 1u);
            asm volatile("s_waitcnt vmcnt(0)" ::: "memory");
        } else {
            XB_SPIN(xb_ld(&bar[XB_XGEN(b.x)]) == gen, bar);
            __builtin_amdgcn_fence(__ATOMIC_ACQUIRE, "agent");
            asm volatile("s_waitcnt vmcnt(0)" ::: "memory");
        }
    }
    __syncthreads();
}

namespace pg8 {
#define PG8_LAS __attribute__((address_space(3)))
typedef short bf16x8 __attribute__((ext_vector_type(8)));
constexpr int BM = 256, BK = 64, HALF = 128, HTB = HALF * BK * 2  , STAGE_BYTES = 8 * HTB, NXCD = 8, WGM = 8;
__device__ __forceinline__ int lds_byte(int r, int c) { const int st = (r >> 4) * 2 + (c >> 5), rr = r & 15, cc = c & 31, ob = rr * 64 + cc * 2; return st * 1024 + (ob ^ (((ob >> 9) & 1) << 5)); }
__device__ __forceinline__ void stage_rc(int b, int& R, int& C) { const int st = b / 1024, sb = b % 1024, swz = sb ^ (((sb >> 9) & 1) << 5); R = (st >> 1) * 16 + swz / 64; C = (st & 1) * 32 + (swz % 64) / 2; }
__device__ __forceinline__ int perm32(int rho) { const int n = rho >> 4, i = rho & 15; return 8 * (i >> 2) + 4 * n + (i & 3); }

struct Unit { int pm, pn, e; };
struct Gemm { const bf16_t* A; const bf16_t* Bt; int K; size_t bstride; const int* eslot; const PG8_LAS int* sb; };

struct StaticOrder {
    int nM, nN, nwg, G, c; const PG8_LAS int* sbase;
    __device__ void init(int M, int N, int G_, int c_, const PG8_LAS int* sb) { nM = M / BM; nN = N / BM; nwg = nM * nN; G = G_; c = c_; sbase = sb; }
    __device__ bool next(int i, Unit& u) const {
        const long Lx = (long)i * G + c; if (Lx >= nwg) return false;
        int wgid = (int)Lx; { const int q = nwg / NXCD, r = nwg % NXCD, xcd = wgid % NXCD, off = wgid / NXCD; wgid = (xcd < r ? xcd * (q + 1) : r * (q + 1) + (xcd - r) * q) + off; }
        const int nig = WGM * nN, gid = wgid / nig, fm = gid * WGM, gsz = (nM - fm) < WGM ? (nM - fm) : WGM;
        u.pm = fm + ((wgid % nig) % gsz); u.pn = (wgid % nig) / gsz; u.e = 0;
        if (sbase) { const int row = u.pm * BM; int e = 0;
#pragma unroll 1
            for (int j = 1; j < 32; ++j) e += (row >= sbase[j]) ? 1 : 0;
            u.e = e; }
        return true;
    }
};

template <class Epi, class Sched, bool GATHER, bool ALIGN_EPI>
__device__ __forceinline__ void gemm_phase(PG8_LAS unsigned char* lds, const Gemm g, const Sched& S, const Epi& E) {
    int tid_ = threadIdx.x; asm volatile("" : "+v"(tid_));
    const int tid = tid_, wid = __builtin_amdgcn_readfirstlane(tid >> 6), lane = tid & 63, wr = wid >> 2, wc = wid & 3, fr = lane & 15, fq = lane >> 4;
    const int K = g.K, nt = K / BK;
    unsigned voffA[2], voffB[2];
#pragma unroll
    for (int i = 0; i < 2; ++i) { int R, C; stage_rc(tid * 16 + i * 8192, R, C); const int Rb = Epi::PERM ? ((R & ~31) + perm32(R & 31)) : R;
        voffA[i] = (unsigned)(R * K + C) * 2u; voffB[i] = (unsigned)(Rb * K + C) * 2u; }
    const size_t kstep = (size_t)(BK * 2);
    const size_t hstep = (size_t)HALF * K * 2;
    const size_t tstep = 2 * hstep;
    const unsigned ldsw = (unsigned)wid * 1024u;
    const int aoff = lds_byte(wr * 64 + fr, fq * 8), boff = lds_byte(wc * 32 + fr, fq * 8);
#define PG8_SA(b, h) (((b) * 2 + (h)) * HTB)
#define PG8_SB(b, h) ((4 + (b) * 2 + (h)) * HTB)
#define PG8_STAGE(bufoff, gbase, voff) do { _Pragma("unroll") for (int _i = 0; _i < 2; ++_i) \
        __builtin_amdgcn_global_load_lds((const unsigned*)((const char*)(gbase) + (voff)[_i]), (PG8_LAS unsigned*)(lds + (bufoff) + ldsw + _i * 8192), 16, 0, 0); } while (0)
#define PG8_LDA(dst, b, h) do { _Pragma("unroll") for (int m = 0; m < 4; ++m) _Pragma("unroll") for (int k = 0; k < 2; ++k) dst[m][k] = *(const PG8_LAS bf16x8*)(lds + PG8_SA(b, h) + aoff + m * 2048 + k * 1024); } while (0)
#define PG8_LDB(dst, b, h) do { _Pragma("unroll") for (int n = 0; n < 2; ++n) _Pragma("unroll") for (int k = 0; k < 2; ++k) dst[n][k] = *(const PG8_LAS bf16x8*)(lds + PG8_SB(b, h) + boff + n * 2048 + k * 1024); } while (0)
#define PG8_MMA(ai, bj, At, Bt) do { __builtin_amdgcn_s_setprio(1); _Pragma("unroll") for (int m = 0; m < 4; ++m) _Pragma("unroll") for (int n = 0; n < 2; ++n) _Pragma("unroll") for (int k = 0; k < 2; ++k) \
        acc[ai][bj][m][n] = __builtin_amdgcn_mfma_f32_16x16x32_bf16(Bt[n][k], At[m][k], acc[ai][bj][m][n], 0, 0, 0); __builtin_amdgcn_s_setprio(0); } while (0)
#define PG8_WAIT_V(n) asm volatile("s_waitcnt vmcnt(" #n ")" ::: "memory")
#define PG8_WAIT_L(n) asm volatile("s_waitcnt lgkmcnt(" #n ")" ::: "memory")
#define PG8_BAR __builtin_amdgcn_s_barrier()
#define PG8_SCHED __builtin_amdgcn_sched_barrier(0)
#define PG8_SETOFF(off, u) do { _Pragma("unroll") for (int _h = 0; _h < 2; ++_h) _Pragma("unroll") for (int _i = 0; _i < 2; ++_i) { \
        if (GATHER) { int R_, C_; stage_rc(tid * 16 + _i * 8192, R_, C_); int rk_ = (u).pm * BM + _h * HALF + R_ - g.sb[(u).e]; const int cm_ = g.sb[40 + (u).e] - 1; rk_ = rk_ < cm_ ? rk_ : cm_; \
            off[_h][_i] = (unsigned)(g.eslot[(size_t)(u).e * ECAP + rk_] >> 2) * (unsigned)(K * 2) + (unsigned)(C_ * 2); } \
        else off[_h][_i] = voffA[_i] + (unsigned)(_h * hstep); } } while (0)
    Unit cur, nxt; int ui = 0;
    if (!S.next(0, cur)) return;
    f32x4 acc[2][2][4][2];
#pragma unroll
    for (int a = 0; a < 2; ++a)
#pragma unroll
        for (int b = 0; b < 2; ++b)
#pragma unroll
            for (int m = 0; m < 4; ++m)
#pragma unroll
                for (int n = 0; n < 2; ++n) acc[a][b][m][n] = (f32x4){0.f, 0.f, 0.f, 0.f};
    bf16x8 At[4][2], B0[2][2], B1[2][2];
    unsigned offc[2][2], offn[2][2];
    PG8_SETOFF(offc, cur);
    const char* cA = GATHER ? (const char*)g.A : (const char*)g.A + (size_t)cur.pm * tstep;
    const char* cB = (const char*)g.Bt + (size_t)cur.e * g.bstride + (size_t)cur.pn * tstep;
    PG8_STAGE(PG8_SB(0, 0), cB, voffB); PG8_STAGE(PG8_SB(0, 1), cB + hstep, voffB); PG8_STAGE(PG8_SA(0, 0), cA, offc[0]); PG8_STAGE(PG8_SA(0, 1), cA, offc[1]);
    if (wr == 1) PG8_BAR;
    PG8_WAIT_V(2); PG8_BAR;
    PG8_STAGE(PG8_SB(1, 0), cB + kstep, voffB); PG8_STAGE(PG8_SA(1, 0), cA + kstep, offc[0]); PG8_STAGE(PG8_SB(1, 1), cB + hstep + kstep, voffB);
    PG8_WAIT_V(6); PG8_BAR;
    for (;;) {
        const bool has_next = S.next(ui + 1, nxt);
        const char* nA = GATHER ? cA : (has_next ? (const char*)g.A + (size_t)nxt.pm * tstep : cA);
        const char* nB = has_next ? (const char*)g.Bt + (size_t)nxt.e * g.bstride + (size_t)nxt.pn * tstep : cB;
        if (GATHER) { if (has_next) { PG8_SETOFF(offn, nxt); } else {
#pragma unroll
            for (int h = 0; h < 2; ++h)
#pragma unroll
                for (int i = 0; i < 2; ++i) offn[h][i] = offc[h][i]; } }
        for (int t = 0; t < nt; t += 2) {
            const bool last = (t == nt - 2);
            const char* a1 = cA + (size_t)(t + 1) * kstep;
            const char* a2 = last ? nA : cA + (size_t)(t + 2) * kstep; const char* b2 = last ? nB : cB + (size_t)(t + 2) * kstep;
            const char* a3 = a2 + kstep; const char* b3 = b2 + kstep;
            unsigned o2[2][2];
#pragma unroll
            for (int h = 0; h < 2; ++h)
#pragma unroll
                for (int i = 0; i < 2; ++i) o2[h][i] = (GATHER && last) ? offn[h][i] : offc[h][i];
            PG8_LDB(B0, 0, 0); PG8_LDB(B1, 0, 1); PG8_SCHED; PG8_LDA(At, 0, 0); PG8_STAGE(PG8_SA(1, 1), a1, offc[1]);
            PG8_WAIT_V(8); PG8_WAIT_L(0); PG8_BAR; PG8_MMA(0, 0, At, B0); PG8_MMA(0, 1, At, B1); PG8_BAR; PG8_SCHED;
            PG8_LDA(At, 0, 1); PG8_STAGE(PG8_SB(0, 0), b2, voffB); PG8_STAGE(PG8_SB(0, 1), b2 + hstep, voffB); PG8_STAGE(PG8_SA(0, 0), a2, o2[0]);
            PG8_WAIT_V(8); PG8_WAIT_L(0); PG8_BAR; PG8_MMA(1, 0, At, B0); PG8_MMA(1, 1, At, B1); PG8_BAR; PG8_SCHED;
            PG8_LDB(B0, 1, 0); PG8_LDB(B1, 1, 1); PG8_SCHED; PG8_LDA(At, 1, 0); PG8_STAGE(PG8_SA(0, 1), a2, o2[1]);
            PG8_WAIT_V(8); PG8_WAIT_L(0); PG8_BAR; PG8_MMA(0, 0, At, B0); PG8_MMA(0, 1, At, B1); PG8_BAR; PG8_SCHED;
            PG8_LDA(At, 1, 1); PG8_STAGE(PG8_SB(1, 0), b3, voffB); PG8_STAGE(PG8_SB(1, 1), b3 + hstep, voffB); PG8_STAGE(PG8_SA(1, 0), a3, o2[0]);
            PG8_WAIT_V(8); PG8_WAIT_L(0); PG8_BAR; PG8_MMA(1, 0, At, B0); PG8_MMA(1, 1, At, B1); PG8_BAR; PG8_SCHED;
        }
        if constexpr (ALIGN_EPI) { if (wr == 0) PG8_BAR; }
        E(acc, cur, wr, wc, fr, fq);
        if (!has_next) break;
#pragma unroll
        for (int a = 0; a < 2; ++a)
#pragma unroll
            for (int b = 0; b < 2; ++b)
#pragma unroll
                for (int m = 0; m < 4; ++m)
#pragma unroll
                    for (int n = 0; n < 2; ++n) acc[a][b][m][n] = (f32x4){0.f, 0.f, 0.f, 0.f};
        cur = nxt; cA = nA; cB = nB; ++ui;
#pragma unroll
        for (int h = 0; h < 2; ++h)
#pragma unroll
            for (int i = 0; i < 2; ++i) offc[h][i] = offn[h][i];
        if constexpr (ALIGN_EPI) { if (wr == 1) PG8_BAR; }
    }
    PG8_WAIT_V(0);
    if constexpr (!ALIGN_EPI) { if (wr == 0) PG8_BAR; }
    PG8_BAR;
#undef PG8_SA
#undef PG8_SB
#undef PG8_STAGE
#undef PG8_LDA
#undef PG8_LDB
#undef PG8_MMA
#undef PG8_WAIT_V
#undef PG8_WAIT_L
#undef PG8_BAR
#undef PG8_SCHED
#undef PG8_SETOFF
}

struct EpiQKV {
    static constexpr bool PERM = false;
    bf16_t* O; const float* tab;
    __device__ __forceinline__ void operator()(const f32x4 (&acc)[2][2][4][2], const Unit& u, int wr, int wc, int fr, int fq) const {
        const bool latent = u.pm < NTOK / BM;
#pragma unroll
        for (int ai = 0; ai < 2; ++ai)
#pragma unroll
            for (int m = 0; m < 4; ++m) {
                const int row = u.pm * BM + ai * HALF + wr * 64 + m * 16 + fr;
                bf16_t* rowp = O + (size_t)row * INW + u.pn * BM + wc * 32 + 4 * fq;
                const int pos = row & (L - 1), pp = (wc & 1) ? (pos & 63) : (pos >> 6);
                const f32x4* tp = (const f32x4*)(tab + (pp * 16 + 4 * fq) * 2);
#pragma unroll
                for (int bj = 0; bj < 2; ++bj) {
                    const int colbase = u.pn * BM + bj * HALF;
                    f32x4 v0 = acc[ai][bj][m][0], v1 = acc[ai][bj][m][1];
                    if (latent && colbase < C_VA) {
                        const f32x4 t0 = tp[0], t1 = tp[1];
                        const f32x4 cs = {t0.x, t0.z, t1.x, t1.z}, sn = {t0.y, t0.w, t1.y, t1.w};
                        const f32x4 a0 = v0 * cs - v1 * sn, a1 = v1 * cs + v0 * sn; v0 = a0; v1 = a1;
                    }
                    if (colbase < C_KA || (colbase >= C_QB && colbase < C_KB)) { v0 = v0 * QSCALE; v1 = v1 * QSCALE; }
                    u32x2 w0, w1; w0.x = pk2(v0.x, v0.y); w0.y = pk2(v0.z, v0.w); w1.x = pk2(v1.x, v1.y); w1.y = pk2(v1.z, v1.w);
                    *(u32x2*)(rowp + bj * HALF) = w0; *(u32x2*)(rowp + bj * HALF + 16) = w1;
                }
            }
    }
};
struct EpiF32 {
    static constexpr bool PERM = false;
    float* O; int ldc;
    __device__ __forceinline__ void operator()(const f32x4 (&acc)[2][2][4][2], const Unit& u, int wr, int wc, int fr, int fq) const {
#pragma unroll
        for (int ai = 0; ai < 2; ++ai)
#pragma unroll
            for (int m = 0; m < 4; ++m) {
                float* rowp = O + (size_t)(u.pm * BM + ai * HALF + wr * 64 + m * 16 + fr) * ldc + u.pn * BM + wc * 32 + 4 * fq;
#pragma unroll
                for (int bj = 0; bj < 2; ++bj)
#pragma unroll
                    for (int n = 0; n < 2; ++n) *(f32x4*)(rowp + bj * HALF + 16 * n) = acc[ai][bj][m][n];
            }
    }
};
struct EpiSwiglu {
    static constexpr bool PERM = false;
    bf16_t* act; const float* b1;
    __device__ __forceinline__ void operator()(const f32x4 (&acc)[2][2][4][2], const Unit& u, int wr, int wc, int fr, int fq) const {
#pragma unroll
        for (int bj = 0; bj < 2; ++bj) {
            const int f0 = 16 * (8 * u.pn + 4 * bj + wc) + 4 * fq;
            const f32x4* bp = (const f32x4*)(b1 + (size_t)u.e * 2048 + 2 * f0); const f32x4 bA = bp[0], bB = bp[1];
            const f32x4 bg = {bA.x, bA.z, bB.x, bB.z}, bl = {bA.y, bA.w, bB.y, bB.w};
#pragma unroll
            for (int ai = 0; ai < 2; ++ai)
#pragma unroll
                for (int m = 0; m < 4; ++m) {
                    const int row = u.pm * BM + ai * HALF + wr * 64 + m * 16 + fr;
                    const f32x4 gt = acc[ai][bj][m][0] + bg, ln = acc[ai][bj][m][1] + bl; float a[4];
#pragma unroll
                    for (int j = 0; j < 4; ++j) { const float gg = fminf(gt[j], 7.f), ll = fminf(fmaxf(ln[j], -7.f), 7.f);
                        a[j] = gg * __builtin_amdgcn_rcpf(1.f + __expf(-1.702f * gg)) * (ll + 1.f); }
                    u32x2 w; w.x = pk2(a[0], a[1]); w.y = pk2(a[2], a[3]);
                    *(u32x2*)(act + (size_t)row * D + f0) = w;
                }
        }
    }
};
struct EpiScatter {
    static constexpr bool PERM = true;
    bf16_t* y; const float* b2; const int* eslot; const float* ew; const PG8_LAS int* sb;
    __device__ __forceinline__ void operator()(const f32x4 (&acc)[2][2][4][2], const Unit& u, int wr, int wc, int fr, int fq) const {
        const int col0 = u.pn * BM + wc * 32 + 8 * fq;
        f32x4 bv[2][2];
#pragma unroll
        for (int bj = 0; bj < 2; ++bj)
#pragma unroll
            for (int n = 0; n < 2; ++n) bv[bj][n] = *(const f32x4*)(b2 + (size_t)u.e * D + col0 + bj * HALF + 4 * n);
#pragma unroll
        for (int ai = 0; ai < 2; ++ai)
#pragma unroll
            for (int m = 0; m < 4; ++m) {
                const int row = u.pm * BM + ai * HALF + wr * 64 + m * 16 + fr;
                const int rk = row - sb[u.e], cn = sb[40 + u.e]; const int rkc = rk < cn - 1 ? rk : cn - 1;
                const int slot = eslot[(size_t)u.e * ECAP + rkc]; const float w = ew[(size_t)u.e * ECAP + rkc];
                if (rk < cn) {
                    bf16_t* rowp = y + (size_t)slot * D + col0;
#pragma unroll
                    for (int bj = 0; bj < 2; ++bj) { const f32x4 v0 = (acc[ai][bj][m][0] + bv[bj][0]) * w, v1 = (acc[ai][bj][m][1] + bv[bj][1]) * w;
                        u32x4 o; o.x = pk2(v0.x, v0.y); o.y = pk2(v0.z, v0.w); o.z = pk2(v1.x, v1.y); o.w = pk2(v1.z, v1.w);
                        *(u32x4*)(rowp + bj * HALF) = o; }
                }
            }
    }
};
}

__device__ void p0_mod(const Params& p, float* sS  , float* sP  ) {
    float* mod = (float*)(p.ws + WS_MOD);
    const int tid = threadIdx.x, lane = tid & 63, wave = tid >> 6;
    if (blockIdx.x >= 96) return;
    for (int i = tid; i < 9 * D; i += NTHREADS) { const int r = i >> 10, k = i & 1023; const float cc = r < 8 ? p.c[r * D + k] : p.c_ctx[k]; sS[i] = cc / (1.f + __expf(-cc)); }
    __syncthreads();
    const int j = blockIdx.x * 64 + lane;
    float acc[9];
#pragma unroll
    for (int r = 0; r < 9; ++r) acc[r] = 0.f;
    const float* wp = p.w_ada + (size_t)(wave * 128) * 6144 + j;
#pragma unroll 1
    for (int k0 = 0; k0 < 128; k0 += 16) {
        float w[16];
#pragma unroll
        for (int kk = 0; kk < 16; ++kk) w[kk] = wp[(size_t)(k0 + kk) * 6144];
#pragma unroll
        for (int kk = 0; kk < 16; ++kk)
#pragma unroll
            for (int r = 0; r < 9; ++r) acc[r] = fmaf(sS[r * D + wave * 128 + k0 + kk], w[kk], acc[r]);
    }
#pragma unroll
    for (int r = 0; r < 9; ++r) sP[(wave * 9 + r) * 64 + lane] = acc[r];
    __syncthreads();
    for (int i = tid; i < 9 * 64; i += NTHREADS) { const int r = i >> 6, jj = i & 63; float s = p.b_ada[blockIdx.x * 64 + jj];
#pragma unroll
        for (int w = 0; w < 8; ++w) s += sP[(w * 9 + r) * 64 + jj];
        mod[r * 6144 + blockIdx.x * 64 + jj] = s; }
    __syncthreads();
}
__device__ void p0_tab(const Params& p, int gtid, int gsize) {
    float* tab = (float*)(p.ws + WS_TAB);
    for (int idx = gtid; idx < 64 * 16; idx += gsize) {
        const int pos = idx >> 4, i = idx & 15;
        const float freq = exp2f(-(float)i * (13.287712379549449f / 16.f));
        const float ang = (float)pos * freq;
        const float n = rintf(ang * 0.15915494309189535f);
        float r = fmaf(-n, 6.28125f, ang); r = fmaf(-n, 1.9353071795864769e-3f, r);
        tab[idx * 2] = __cosf(r); tab[idx * 2 + 1] = __sinf(r);
    }
}
template <int MODE>
__device__ __forceinline__ void conv_item(const float* src, int K, int N, bf16_t* dst, int item, float* scr, int lane, const float* gA, const float* gB) {
    const int nblk = N / 32, kb = item / nblk, nb = item % nblk, k0 = 64 * kb, n0 = 32 * nb;
    const int c = lane & 31, kh = lane >> 5;
    const int nl = MODE == 1 ? 16 * (c & 1) + (c >> 1) : c;
    float v[32];
    const float* sp = src + (size_t)(k0 + kh) * N + n0 + c;
#pragma unroll
    for (int i = 0; i < 32; ++i) v[i] = sp[(size_t)(2 * i) * N];
#pragma unroll
    for (int i = 0; i < 32; ++i) { float x = v[i]; if (MODE == 2) { const int k = k0 + 2 * i + kh; x *= (k < 512 ? gA[k] : gB[k - 512]); } scr[(2 * i + kh) * 33 + nl] = x; }
    asm volatile("s_waitcnt lgkmcnt(0)" ::: "memory");
    const int ch = lane & 7;
#pragma unroll
    for (int j = 0; j < 4; ++j) { const int n = (lane >> 3) + 8 * j; const float* s = scr + (8 * ch) * 33 + n;
        u32x4 o; o.x = pk2(s[0 * 33], s[1 * 33]); o.y = pk2(s[2 * 33], s[3 * 33]); o.z = pk2(s[4 * 33], s[5 * 33]); o.w = pk2(s[6 * 33], s[7 * 33]);
        *(u32x4*)(dst + (size_t)(n0 + n) * K + k0 + 8 * ch) = o; }
    asm volatile("s_waitcnt lgkmcnt(0)" ::: "memory");
}
__device__ void p0_weights(const Params& p, float* scr, int gw, int ngw, int lane) {
    constexpr int I_IN = 16 * 72, I_OUT = 16 * 32, I_W1 = 16 * 64, I_W2 = 16 * 32;
    constexpr int NITEMS = I_IN + I_OUT + NE * I_W1 + NE * I_W2;
    for (int it = gw; it < NITEMS; it += ngw) {
        int r = it;
        if (r < I_IN) { conv_item<0>(p.w_in, D, INW, (bf16_t*)(p.ws + WS_WIN), r, scr, lane, nullptr, nullptr); continue; } r -= I_IN;
        if (r < I_OUT) { conv_item<2>(p.w_out, D, D, (bf16_t*)(p.ws + WS_WOUT), r, scr, lane, p.g_grp_a, p.g_grp_b); continue; } r -= I_OUT;
        if (r < NE * I_W1) { const int e = r / I_W1, q = r % I_W1;
            conv_item<1>(p.w_mlp1 + (size_t)e * D * 2048, D, 2048, (bf16_t*)(p.ws + WS_W1) + (size_t)e * 2048 * D, q, scr, lane, nullptr, nullptr); continue; } r -= NE * I_W1;
        { const int e = r / I_W2, q = r % I_W2;
            conv_item<0>(p.w_mlp2 + (size_t)e * D * D, D, D, (bf16_t*)(p.ws + WS_W2) + (size_t)e * D * D, q, scr, lane, nullptr, nullptr); }
    }
}

__device__ __forceinline__ void p1_row(const Params& p, const float* mod, bf16_t* hb, int m, const f32x4 (&v)[4], int lane) {
    const int b = m < NTOK ? m / L : 8;
    const float* sh = mod + b * 6144, * sc = sh + 1024;
    float s = 0.f;
#pragma unroll
    for (int j = 0; j < 4; ++j) s += v[j].x * v[j].x + v[j].y * v[j].y + v[j].z * v[j].z + v[j].w * v[j].w;
    const float rstd = rsqrtf(wave_sum(s) * (1.f / D) + EPS);
#pragma unroll
    for (int j = 0; j < 4; ++j) {
        const int c0 = 4 * (lane + 64 * j);
        const f32x4 g = *(const f32x4*)(p.g_pre_mix + c0), a = *(const f32x4*)(sc + c0), bsh = *(const f32x4*)(sh + c0);
        const f32x4 o = (v[j] * rstd * g) * (a + 1.f) + bsh;
        u32x2 w; w.x = pk2(o.x, o.y); w.y = pk2(o.z, o.w);
        *(u32x2*)(hb + (size_t)m * D + c0) = w;
    }
}
__device__ void p1_h(const Params& p, int gw, int ngw, int lane) {
    const float* mod = (const float*)(p.ws + WS_MOD);
    bf16_t* hb = (bf16_t*)(p.ws + WS_HB);
    for (int m = gw; m < MROWS; m += 2 * ngw) {
        const int m2 = m + ngw; const bool has2 = m2 < MROWS;
        const float* xr = m < NTOK ? p.x + (size_t)m * D : p.ctx + (size_t)(m - NTOK) * D;
        const float* xr2 = m2 < NTOK ? p.x + (size_t)m2 * D : p.ctx + (size_t)(m2 - NTOK) * D;
        f32x4 v[4], v2[4];
#pragma unroll
        for (int j = 0; j < 4; ++j) v[j] = ((const f32x4*)xr)[lane + 64 * j];
        if (has2) {
#pragma unroll
            for (int j = 0; j < 4; ++j) v2[j] = ((const f32x4*)xr2)[lane + 64 * j];
        }
        p1_row(p, mod, hb, m, v, lane);
        if (has2) p1_row(p, mod, hb, m2, v2, lane);
    }
}

template <class AL, class BL, class EP>
__device__ __forceinline__ void ngemm_tile(float* sA, float* sB, int m0, int n0, int K, const AL& aload, const BL& bload, const EP& epi) {
    const int tid = threadIdx.x, ty = tid >> 4, tx = tid & 15;
    float acc[4][4];
#pragma unroll
    for (int i = 0; i < 4; ++i)
#pragma unroll
        for (int j = 0; j < 4; ++j) acc[i][j] = 0.f;
    for (int k0 = 0; k0 < K; k0 += 16) {
#pragma unroll
        for (int i = 0; i < 4; ++i) { const int e = tid + NTHREADS * i, r = e >> 4, kk = e & 15; sA[kk * 132 + r] = aload(m0 + r, k0 + kk); }
#pragma unroll
        for (int i = 0; i < 2; ++i) { const int e = tid + NTHREADS * i, n = e >> 4, kk = e & 15; sB[kk * 68 + n] = bload(n0 + n, k0 + kk); }
        __syncthreads();
#pragma unroll
        for (int kk = 0; kk < 16; ++kk) {
            float a[4], b[4];
#pragma unroll
            for (int i = 0; i < 4; ++i) a[i] = sA[kk * 132 + ty * 4 + i];
#pragma unroll
            for (int j = 0; j < 4; ++j) b[j] = sB[kk * 68 + tx + 16 * j];
#pragma unroll
            for (int i = 0; i < 4; ++i)
#pragma unroll
                for (int j = 0; j < 4; ++j) acc[i][j] = fmaf(a[i], b[j], acc[i][j]);
        }
        __syncthreads();
    }
    epi(m0 + ty * 4, n0, tx, acc);
}

__device__ void p2_qkv_naive(const Params& p, float* sA, float* sB) {
    const bf16_t* hb = (const bf16_t*)(p.ws + WS_HB); const bf16_t* wT = (const bf16_t*)(p.ws + WS_WIN);
    bf16_t* qkv = (bf16_t*)(p.ws + WS_QKV); const float* tab = (const float*)(p.ws + WS_TAB);
    constexpr int NTN = INW / 64, NT = (MROWS / 128) * NTN;
    for (int t = blockIdx.x; t < NT; t += gridDim.x) {
        const int m0 = (t / NTN) * 128, n0 = (t % NTN) * 64;
        auto al = [&](int r, int k) { return bf2f(hb[(size_t)r * D + k]); };
        auto bl = [&](int n, int k) { return bf2f(wT[(size_t)n * D + k]); };
        auto ep = [&](int r0, int nn0, int tx, float (&acc)[4][4]) {
#pragma unroll
            for (int i = 0; i < 4; ++i) {
                const int r = r0 + i; float v0 = acc[i][0], v1 = acc[i][1], v2 = acc[i][2], v3 = acc[i][3];
                const bool rope = (nn0 < C_VA) && (r < NTOK);
                if (rope) { const int t = r & (L - 1), pr = t >> 6, pc = t & 63;
                    const float c0 = tab[(pr * 16 + tx) * 2], s0 = tab[(pr * 16 + tx) * 2 + 1], c1 = tab[(pc * 16 + tx) * 2], s1 = tab[(pc * 16 + tx) * 2 + 1];
                    const float a0 = v0 * c0 - v1 * s0, a1 = v1 * c0 + v0 * s0, a2 = v2 * c1 - v3 * s1, a3 = v3 * c1 + v2 * s1; v0 = a0; v1 = a1; v2 = a2; v3 = a3; }
                const bool isq = (nn0 < C_KA) || (nn0 >= C_QB && nn0 < C_KB);
                if (isq) { v0 *= QSCALE; v1 *= QSCALE; v2 *= QSCALE; v3 *= QSCALE; }
                bf16_t* o = qkv + (size_t)r * INW + nn0 + tx;
                o[0] = (bf16_t)f2bf(v0); o[16] = (bf16_t)f2bf(v1); o[32] = (bf16_t)f2bf(v2); o[48] = (bf16_t)f2bf(v3);
            }
        };
        ngemm_tile(sA, sB, m0, n0, D, al, bl, ep);
    }
}

__device__ __forceinline__ void load_row64(const bf16_t* src, float* dst) {
#pragma unroll
    for (int c = 0; c < 8; ++c) { const u32x4 w = *(const u32x4*)(src + c * 8);
        dst[c * 8 + 0] = __uint_as_float(w.x << 16); dst[c * 8 + 1] = __uint_as_float(w.x & 0xffff0000u);
        dst[c * 8 + 2] = __uint_as_float(w.y << 16); dst[c * 8 + 3] = __uint_as_float(w.y & 0xffff0000u);
        dst[c * 8 + 4] = __uint_as_float(w.z << 16); dst[c * 8 + 5] = __uint_as_float(w.z & 0xffff0000u);
        dst[c * 8 + 6] = __uint_as_float(w.w << 16); dst[c * 8 + 7] = __uint_as_float(w.w & 0xffff0000u); }
}
struct OnlineSm { float m, l; };
__device__ __forceinline__ void attn_key(const float (&q)[64], float (&o)[64], OnlineSm& st, const bf16_t* krow, const bf16_t* vrow, float bias) {
    float s = bias;
#pragma unroll
    for (int c = 0; c < 8; ++c) { const u32x4 w = *(const u32x4*)(krow + c * 8);
        s = fmaf(q[c * 8 + 0], __uint_as_float(w.x << 16), s); s = fmaf(q[c * 8 + 1], __uint_as_float(w.x & 0xffff0000u), s);
        s = fmaf(q[c * 8 + 2], __uint_as_float(w.y << 16), s); s = fmaf(q[c * 8 + 3], __uint_as_float(w.y & 0xffff0000u), s);
        s = fmaf(q[c * 8 + 4], __uint_as_float(w.z << 16), s); s = fmaf(q[c * 8 + 5], __uint_as_float(w.z & 0xffff0000u), s);
        s = fmaf(q[c * 8 + 6], __uint_as_float(w.w << 16), s); s = fmaf(q[c * 8 + 7], __uint_as_float(w.w & 0xffff0000u), s); }
    const float mn = fmaxf(st.m, s), sc = exp2f(st.m - mn), pp = exp2f(s - mn);
    st.l = st.l * sc + pp; st.m = mn;
#pragma unroll
    for (int c = 0; c < 8; ++c) { const u32x4 w = *(const u32x4*)(vrow + c * 8);
        o[c * 8 + 0] = fmaf(pp, __uint_as_float(w.x << 16), o[c * 8 + 0] * sc); o[c * 8 + 1] = fmaf(pp, __uint_as_float(w.x & 0xffff0000u), o[c * 8 + 1] * sc);
        o[c * 8 + 2] = fmaf(pp, __uint_as_float(w.y << 16), o[c * 8 + 2] * sc); o[c * 8 + 3] = fmaf(pp, __uint_as_float(w.y & 0xffff0000u), o[c * 8 + 3] * sc);
        o[c * 8 + 4] = fmaf(pp, __uint_as_float(w.z << 16), o[c * 8 + 4] * sc); o[c * 8 + 5] = fmaf(pp, __uint_as_float(w.z & 0xffff0000u), o[c * 8 + 5] * sc);
        o[c * 8 + 6] = fmaf(pp, __uint_as_float(w.w << 16), o[c * 8 + 6] * sc); o[c * 8 + 7] = fmaf(pp, __uint_as_float(w.w & 0xffff0000u), o[c * 8 + 7] * sc); }
}
__device__ __forceinline__ void store_o64(bf16_t* dst, const float (&o)[64], float inv) {
#pragma unroll
    for (int c = 0; c < 8; ++c) { u32x4 w; w.x = pk2(o[c * 8] * inv, o[c * 8 + 1] * inv); w.y = pk2(o[c * 8 + 2] * inv, o[c * 8 + 3] * inv);
        w.z = pk2(o[c * 8 + 4] * inv, o[c * 8 + 5] * inv); w.w = pk2(o[c * 8 + 6] * inv, o[c * 8 + 7] * inv); *(u32x4*)(dst + c * 8) = w; }
}
__device__ void p3_attn_naive(const Params& p, int gtid, int gsize) {
    const bf16_t* qkv = (const bf16_t*)(p.ws + WS_QKV); bf16_t* ob = (bf16_t*)(p.ws + WS_O);
    for (int it = gtid; it < NTOK * 16; it += gsize) {
        const bool isB = it >= NTOK * 8; const int w = isB ? it - NTOK * 8 : it;
        const int h = w & 7, tokg = w >> 3, b = tokg / L, t = tokg % L;
        float q[64], o[64];
#pragma unroll
        for (int d = 0; d < 64; ++d) o[d] = 0.f;
        OnlineSm st;
        if (!isB) {
            const int kvh = h >> 2;
            load_row64(qkv + (size_t)tokg * INW + C_QA + h * 64, q);
            st.m = p.sink_a[h] * LOG2E; st.l = 1.f;
            const int j0 = t - 128 < 0 ? 0 : t - 128, j1 = t + 128 > L - 1 ? L - 1 : t + 128;
            for (int j = j0; j <= j1; ++j) { const bf16_t* row = qkv + (size_t)(b * L + j) * INW; attn_key(q, o, st, row + C_KA + kvh * 64, row + C_VA + kvh * 64, 0.f); }
            for (int c = 0; c < CTX; ++c) { const bf16_t* row = qkv + (size_t)(NTOK + b * CTX + c) * INW; attn_key(q, o, st, row + C_KA + kvh * 64, row + C_VA + kvh * 64, 0.f); }
            store_o64(ob + (size_t)tokg * D + h * 64, o, 1.f / st.l);
        } else {
            load_row64(qkv + (size_t)tokg * INW + C_QB + h * 64, q);
            st.m = -1e30f; st.l = 0.f;
            const int r = t >> 6, c = t & 63;
            const int rs = r - 4 < 0 ? 0 : (r - 4 > 56 ? 56 : r - 4), cs = c - 8 < 0 ? 0 : (c - 8 > 48 ? 48 : c - 8);
            for (int a = 0; a < 8; ++a)
                for (int e = 0; e < 16; ++e) { const int kr = rs + a, kc = cs + e; const bf16_t* row = qkv + (size_t)(b * L + kr * 64 + kc) * INW;
                    const float bias = p.rpb_b[(h * 15 + (kr - r + 7)) * 31 + (kc - c + 15)] * LOG2E;
                    attn_key(q, o, st, row + C_KB + h * 64, row + C_VB + h * 64, bias); }
            for (int cc = 0; cc < CTX; ++cc) { const bf16_t* row = qkv + (size_t)(NTOK + b * CTX + cc) * INW; attn_key(q, o, st, row + C_KB + h * 64, row + C_VB + h * 64, 0.f); }
            store_o64(ob + (size_t)tokg * D + 512 + h * 64, o, 1.f / st.l);
        }
    }
}


namespace att {
#define ATT_LAS __attribute__((address_space(3)))
typedef float f32x16 __attribute__((ext_vector_type(16)));
typedef short bf16x8 __attribute__((ext_vector_type(8)));
typedef short s16x4 __attribute__((ext_vector_type(4)));
constexpr int SLOTB = 8192;
constexpr int LDS_K = 0, LDS_V = 2 * SLOTB, LDS_WS = 4 * SLOTB, LDS_BT = LDS_WS + 8 * 256;
constexpr int BT_MARGIN = 64, BT_FLOATS = BT_MARGIN + 15 * 32 + 96;
constexpr float NEGBIG = -1e30f;
__device__ __forceinline__ int crow(int r, int hi) { return (r & 3) + 8 * (r >> 2) + 4 * hi; }
__device__ __forceinline__ unsigned cvtpk(float lo, float hi) { typedef float f2 __attribute__((ext_vector_type(2))); typedef __bf16 b2 __attribute__((ext_vector_type(2)));
    f2 v = {lo, hi}; b2 b = __builtin_convertvector(v, b2); return __builtin_bit_cast(unsigned, b); }
__device__ __forceinline__ s16x4 vtr(const ATT_LAS unsigned char* p) { typedef short v4i16 __attribute__((ext_vector_type(4)));
    return __builtin_bit_cast(s16x4, __builtin_amdgcn_ds_read_tr16_b64_v4i16((ATT_LAS v4i16*)p)); }
#define ATT_WAIT_BAR(N) asm volatile("s_waitcnt vmcnt(" #N ") lgkmcnt(0)\n\ts_barrier" ::: "memory")

__device__ __forceinline__ void dma_tile(ATT_LAS unsigned char* lds, int slot, const bf16_t* kbase, const bf16_t* vbase, int wid, int lane) {
    const bf16_t* ksrc = kbase + (size_t)lane * INW + wid * 8;
    const bf16_t* vsrc = vbase + (size_t)(16 * (wid & 3) + (lane >> 2)) * INW + (wid >> 2) * 32 + (lane & 3) * 8;
    __builtin_amdgcn_global_load_lds((const unsigned*)ksrc, (ATT_LAS unsigned*)(lds + LDS_K + slot * SLOTB + wid * 1024), 16, 0, 0);
    __builtin_amdgcn_global_load_lds((const unsigned*)vsrc, (ATT_LAS unsigned*)(lds + LDS_V + slot * SLOTB + wid * 1024), 16, 0, 0);
}

template <bool ISB>
__device__ __forceinline__ void attn_unit(const Params& p, ATT_LAS unsigned char* lds, int unit) {
    int tid_ = threadIdx.x; asm volatile("" : "+v"(tid_));
    const int tid = tid_, lane = tid & 63, r32 = lane & 31, hi = lane >> 5; const int wid = __builtin_amdgcn_readfirstlane(tid >> 6);
    const bf16_t* qkv = (const bf16_t*)(p.ws + WS_QKV); bf16_t* ob = (bf16_t*)(p.ws + WS_O);
    ATT_LAS float* wsf = (ATT_LAS float*)(lds + LDS_WS) + wid * 64;
    ATT_LAS float* bt = (ATT_LAS float*)(lds + LDS_BT);
    int b, h, kcol, vcol, qcol, ocol, q0, nloc, row_lo = 0, qr = 0, half = 0, qb = 0, jlo = 0;
    if (!ISB) { b = unit >> 7; const int kvh = (unit >> 6) & 1; qb = unit & 63; h = kvh * 4 + (wid >> 1); half = wid & 1; q0 = qb * 64 + 32 * half;
        kcol = C_KA + kvh * 64; vcol = C_VA + kvh * 64; qcol = C_QA + h * 64; ocol = h * 64;
        jlo = 2 - qb > 0 ? 2 - qb : 0; const int jhi = 65 - qb < 4 ? 65 - qb : 4; nloc = jhi - jlo + 1;
    } else { b = unit >> 7; h = (unit >> 4) & 7; const int g = unit & 15; qr = 4 * g + (wid >> 1); half = wid & 1; q0 = qr * 64 + 32 * half;
        kcol = C_KB + h * 64; vcol = C_VB + h * 64; qcol = C_QB + h * 64; ocol = 512 + h * 64;
        const int r0 = 4 * g, r3 = 4 * g + 3; row_lo = r0 - 4 < 0 ? 0 : (r0 - 4 > 56 ? 56 : r0 - 4); const int rs3 = r3 - 4 < 0 ? 0 : (r3 - 4 > 56 ? 56 : r3 - 4); nloc = rs3 + 7 - row_lo + 1;
    }
    const int NT = nloc + 4;
    const bf16_t* lat = qkv + (size_t)b * L * INW; const bf16_t* cx = qkv + (size_t)(NTOK + b * CTX) * INW;
#define ATT_TILE_ROW(t) ((t) < nloc ? lat + (size_t)(ISB ? (row_lo + (t)) * 64 : (qb - 2 + jlo + (t)) * 64) * INW : cx + (size_t)((t) - nloc) * 64 * INW)
    if (ISB) {
        for (int i = tid; i < BT_FLOATS; i += NTHREADS) { const int j = i - BT_MARGIN; float v = 0.f;
            if (j >= 0 && j < 15 * 32 && (j & 31) < 31) v = p.rpb_b[(h * 15 + (j >> 5)) * 31 + (j & 31)] * LOG2E;
            bt[i] = v; }
    }
    { const bf16_t* r0p = ATT_TILE_ROW(0); dma_tile(lds, 0, r0p + kcol, r0p + vcol, wid, lane); }
    bf16x8 qf[4];
    { const bf16_t* qp = lat + (size_t)(q0 + r32) * INW + qcol + hi * 8;
#pragma unroll
      for (int d0 = 0; d0 < 4; ++d0) qf[d0] = *(const bf16x8*)(qp + d0 * 16); }
    float m_run, l_run;
    if (!ISB) { m_run = p.sink_a[h] * LOG2E; l_run = hi == 0 ? 1.f : 0.f; } else { m_run = NEGBIG; l_run = 0.f; }
    f32x16 o0, o1;
#pragma unroll
    for (int r = 0; r < 16; ++r) { o0[r] = 0.f; o1[r] = 0.f; }
    const int qc = 32 * half + r32;
    const int cs = qc - 8 < 0 ? 0 : (qc - 8 > 48 ? 48 : qc - 8);
    const int rsq = qr - 4 < 0 ? 0 : (qr - 4 > 56 ? 56 : qr - 4);
    for (int t = 0; t < NT; ++t) {
        if (t + 1 < NT) { const bf16_t* rp = ATT_TILE_ROW(t + 1); dma_tile(lds, (t + 1) & 1, rp + kcol, rp + vcol, wid, lane); ATT_WAIT_BAR(2); }
        else { ATT_WAIT_BAR(0); }
        const int slot = t & 1;
        bool active = true; int kr = 0;
        if (ISB && t < nloc) { kr = row_lo + t; active = (kr >= rsq) && (kr <= rsq + 7); }
        if (active) {
            const ATT_LAS unsigned char* kb = lds + LDS_K + slot * SLOTB + hi * 1024 + r32 * 16;
            f32x16 p0, p1;
#pragma unroll
            for (int r = 0; r < 16; ++r) { p0[r] = 0.f; p1[r] = 0.f; }
#pragma unroll
            for (int d0 = 0; d0 < 4; ++d0) {
                const bf16x8 k0 = *(const ATT_LAS bf16x8*)(kb + d0 * 2048), k1 = *(const ATT_LAS bf16x8*)(kb + d0 * 2048 + 512);
                p0 = __builtin_amdgcn_mfma_f32_32x32x16_bf16(k0, qf[d0], p0, 0, 0, 0);
                p1 = __builtin_amdgcn_mfma_f32_32x32x16_bf16(k1, qf[d0], p1, 0, 0, 0);
            }
            if (ISB) {
                if (t < nloc) {
                    const ATT_LAS float* bp = bt + BT_MARGIN + (kr - qr + 7) * 32 + 15 - qc + 4 * hi;
                    const int e0 = 4 * hi - cs;
#pragma unroll
                    for (int r = 0; r < 16; ++r) { const int c = (r & 3) + 8 * (r >> 2);
                        const float b0 = bp[c], b1 = bp[c + 32];
                        p0[r] = ((unsigned)(c + e0) < 16u) ? p0[r] + b0 : NEGBIG;
                        p1[r] = ((unsigned)(c + 32 + e0) < 16u) ? p1[r] + b1 : NEGBIG; }
                }
            } else {
                if (t < nloc) { const int j = jlo + t; const int qq = 32 * half + r32;
                    if (j == 0) {
#pragma unroll
                        for (int r = 0; r < 16; ++r) { const int c = crow(r, hi); if (c < qq) p0[r] = NEGBIG; if (c + 32 < qq) p1[r] = NEGBIG; }
                    } else if (j == 4) {
#pragma unroll
                        for (int r = 0; r < 16; ++r) { const int c = crow(r, hi); if (c > qq) p0[r] = NEGBIG; if (c + 32 > qq) p1[r] = NEGBIG; }
                    }
                }
            }
            float rm = fmaxf(p0[0], p1[0]);
#pragma unroll
            for (int r = 1; r < 16; ++r) rm = fmaxf(rm, fmaxf(p0[r], p1[r]));
            rm = fmaxf(rm, __shfl_xor(rm, 32));
            const float mnew = fmaxf(m_run, rm);
            if (__any(mnew > m_run)) {
                const float f = __builtin_amdgcn_exp2f(m_run - mnew);
                l_run *= f; m_run = mnew;
                if (hi == 0) wsf[r32] = f;
                asm volatile("s_waitcnt lgkmcnt(0)" ::: "memory");
#pragma unroll
                for (int r = 0; r < 16; ++r) { const float fr_ = wsf[crow(r, hi)]; o0[r] *= fr_; o1[r] *= fr_; }
            }
            float ls = 0.f;
#pragma unroll
            for (int r = 0; r < 16; ++r) { p0[r] = __builtin_amdgcn_exp2f(p0[r] - m_run); p1[r] = __builtin_amdgcn_exp2f(p1[r] - m_run); ls += p0[r] + p1[r]; }
            l_run += ls;
            typedef unsigned u4 __attribute__((ext_vector_type(4)));
            const u4 pw0 = {cvtpk(p0[0], p0[1]), cvtpk(p0[2], p0[3]), cvtpk(p0[4], p0[5]), cvtpk(p0[6], p0[7])};
            const u4 pw1 = {cvtpk(p0[8], p0[9]), cvtpk(p0[10], p0[11]), cvtpk(p0[12], p0[13]), cvtpk(p0[14], p0[15])};
            const u4 pw2 = {cvtpk(p1[0], p1[1]), cvtpk(p1[2], p1[3]), cvtpk(p1[4], p1[5]), cvtpk(p1[6], p1[7])};
            const u4 pw3 = {cvtpk(p1[8], p1[9]), cvtpk(p1[10], p1[11]), cvtpk(p1[12], p1[13]), cvtpk(p1[14], p1[15])};
            const ATT_LAS unsigned char* vp = lds + LDS_V + slot * SLOTB + ((lane >> 4) & 1) * 32 + (lane & 3) * 8 + (4 * hi + ((lane & 15) >> 2)) * 64;
#define ATT_PV(OACC, PW, D0, KS) do { const s16x4 lo_ = vtr(vp + (D0) * 4096 + (KS) * 1024), hi_ = vtr(vp + (D0) * 4096 + (KS) * 1024 + 512); \
                const bf16x8 vf_ = {lo_[0], lo_[1], lo_[2], lo_[3], hi_[0], hi_[1], hi_[2], hi_[3]}; \
                OACC = __builtin_amdgcn_mfma_f32_32x32x16_bf16(__builtin_bit_cast(bf16x8, PW), vf_, OACC, 0, 0, 0); } while (0)
            ATT_PV(o0, pw0, 0, 0); ATT_PV(o1, pw0, 1, 0); ATT_PV(o0, pw1, 0, 1); ATT_PV(o1, pw1, 1, 1);
            ATT_PV(o0, pw2, 0, 2); ATT_PV(o1, pw2, 1, 2); ATT_PV(o0, pw3, 0, 3); ATT_PV(o1, pw3, 1, 3);
#undef ATT_PV
        }
        ATT_WAIT_BAR(2);
    }
    l_run += __shfl_xor(l_run, 32);
    if (hi == 0) wsf[32 + r32] = l_run;
    asm volatile("s_waitcnt lgkmcnt(0)" ::: "memory");
    bf16_t* op = ob + (size_t)(b * L + q0) * D + ocol + r32;
#pragma unroll
    for (int r = 0; r < 16; ++r) { const int q = crow(r, hi); const float inv = __builtin_amdgcn_rcpf(wsf[32 + q]);
        op[(size_t)q * D] = (bf16_t)f2bf(o0[r] * inv); op[(size_t)q * D + 32] = (bf16_t)f2bf(o1[r] * inv); }
    ATT_WAIT_BAR(0);
#undef ATT_TILE_ROW
}

__device__ __forceinline__ void attn_phase(const Params& p, ATT_LAS unsigned char* lds) {
    const int G = gridDim.x, bx = blockIdx.x;
    const int vcu = (G % 8 == 0) ? (bx % 8) * (G / 8) + bx / 8 : bx;
    for (int u = vcu; u < 2048; u += G) {
        if (u < 1024) attn_unit<false>(p, lds, u); else attn_unit<true>(p, lds, u - 1024);
    }
}
}

__device__ void p4a_ostat(const Params& p, int gw, int ngw, int lane) {
    bf16_t* ob = (bf16_t*)(p.ws + WS_O); float* os = (float*)(p.ws + WS_OSTAT);
    for (int m = gw; m < NTOK; m += ngw) {
        const u32x4 wa = *(const u32x4*)(ob + (size_t)m * D + lane * 8), wb = *(const u32x4*)(ob + (size_t)m * D + 512 + lane * 8);
        float sa = 0.f, sb = 0.f;
#pragma unroll
        for (int i = 0; i < 4; ++i) { const unsigned ua = wa[i], ub = wb[i]; const float a0 = __uint_as_float(ua << 16), a1 = __uint_as_float(ua & 0xffff0000u), b0 = __uint_as_float(ub << 16), b1 = __uint_as_float(ub & 0xffff0000u);
            sa += a0 * a0 + a1 * a1; sb += b0 * b0 + b1 * b1; }
        sa = wave_sum(sa); sb = wave_sum(sb);
        const float ra = rsqrtf(sa * (1.f / 512.f) + EPS), rb = rsqrtf(sb * (1.f / 512.f) + EPS);
        if (lane == 0) { os[m * 2] = ra; os[m * 2 + 1] = rb; }
        u32x4 oa, obb;
#pragma unroll
        for (int i = 0; i < 4; ++i) { const unsigned ua = wa[i], ub = wb[i];
            oa[i] = pk2(__uint_as_float(ua << 16) * ra, __uint_as_float(ua & 0xffff0000u) * ra); obb[i] = pk2(__uint_as_float(ub << 16) * rb, __uint_as_float(ub & 0xffff0000u) * rb); }
        *(u32x4*)(ob + (size_t)m * D + lane * 8) = oa; *(u32x4*)(ob + (size_t)m * D + 512 + lane * 8) = obb;
    }
}
__device__ void p4b_outproj_naive(const Params& p, float* sA, float* sB) {
    const bf16_t* ob = (const bf16_t*)(p.ws + WS_O); const bf16_t* wT = (const bf16_t*)(p.ws + WS_WOUT);
    float* mix = (float*)(p.ws + WS_MIX);
    constexpr int NTN = D / 64, NT = (NTOK / 128) * NTN;
    for (int t = blockIdx.x; t < NT; t += gridDim.x) {
        const int m0 = (t / NTN) * 128, n0 = (t % NTN) * 64;
        auto al = [&](int r, int k) { return bf2f(ob[(size_t)r * D + k]); };
        auto bl = [&](int n, int k) { return bf2f(wT[(size_t)n * D + k]); };
        auto ep = [&](int r0, int nn0, int tx, float (&acc)[4][4]) {
#pragma unroll
            for (int i = 0; i < 4; ++i)
#pragma unroll
                for (int j = 0; j < 4; ++j) mix[(size_t)(r0 + i) * D + nn0 + tx + 16 * j] = acc[i][j];
        };
        ngemm_tile(sA, sB, m0, n0, D, al, bl, ep);
    }
}
constexpr int SW_STRIDE = 36;
__device__ __forceinline__ int nrows_w(int gwv, int ngw) { return gwv < NTOK ? (NTOK - 1 - gwv) / ngw + 1 : 0; }
__device__ void p4c_post(const Params& p, LAS3 float* sW, int gw, int ngw, int lane) {
    const float* mod = (const float*)(p.ws + WS_MOD); const float* mix = (const float*)(p.ws + WS_MIX);
    bf16_t* hb = (bf16_t*)(p.ws + WS_HB);
    unsigned* counts = (unsigned*)(p.ws + WS_CTL);
    int* eslot = (int*)(p.ws + WS_ESLOT); float* ew = (float*)(p.ws + WS_EW);
    const int wave = threadIdx.x >> 6;
    LAS3 int* lcnt = (LAS3 int*)(sW + 1024 * SW_STRIDE) + 128;
    LAS3 int* lbase = lcnt + 32;
    LAS3 int* stg_slot = lbase + 32; LAS3 int* stg_e = stg_slot + 512; LAS3 float* stg_w = (LAS3 float*)(stg_e + 512);
    if (threadIdx.x < NE) lcnt[threadIdx.x] = 0;
    for (int i = threadIdx.x; i < D * 8; i += NTHREADS) { const int k = i >> 3, e4 = i & 7; const f32x4 w = ((const f32x4*)p.w_router)[i];
        LAS3 float* d = sW + ((k & 3) * 256 + (k >> 2)) * SW_STRIDE + e4 * 4; *(LAS3 f32x4*)d = w; }
    __syncthreads();
    f32x4 v[4], xx[4], nv[4], nx[4];
    if (gw < NTOK) {
#pragma unroll
        for (int j = 0; j < 4; ++j) { nv[j] = ((const f32x4*)(mix + (size_t)gw * D))[lane + 64 * j]; nx[j] = ((const f32x4*)(p.x + (size_t)gw * D))[lane + 64 * j]; }
    }
    int it = -1;
    for (int m = gw; m < NTOK; m += ngw) {
        ++it;
        const int b = m / L; const float* mb = mod + b * 6144;
#pragma unroll
        for (int j = 0; j < 4; ++j) { v[j] = nv[j]; xx[j] = nx[j]; }
        const int mn = m + ngw;
        if (mn < NTOK) {
#pragma unroll
            for (int j = 0; j < 4; ++j) { nv[j] = ((const f32x4*)(mix + (size_t)mn * D))[lane + 64 * j]; nx[j] = ((const f32x4*)(p.x + (size_t)mn * D))[lane + 64 * j]; }
        }
        float s = 0.f;
#pragma unroll
        for (int j = 0; j < 4; ++j) s += v[j].x * v[j].x + v[j].y * v[j].y + v[j].z * v[j].z + v[j].w * v[j].w;
        float rstd = rsqrtf(wave_sum(s) * (1.f / D) + EPS);
        s = 0.f;
        f32x4 xv[4];
#pragma unroll
        for (int j = 0; j < 4; ++j) { const int c0 = 4 * (lane + 64 * j);
            const f32x4 g = *(const f32x4*)(p.g_post_mix + c0), ga = *(const f32x4*)(mb + 2048 + c0);
            xv[j] = xx[j] + ga * (v[j] * rstd * g);
            ((f32x4*)(p.out + (size_t)m * D))[lane + 64 * j] = xv[j];
            s += xv[j].x * xv[j].x + xv[j].y * xv[j].y + xv[j].z * xv[j].z + xv[j].w * xv[j].w; }
        rstd = rsqrtf(wave_sum(s) * (1.f / D) + EPS);
        float lg[NE];
#pragma unroll
        for (int e = 0; e < NE; ++e) lg[e] = 0.f;
#pragma unroll
        for (int j = 0; j < 4; ++j) { const int c0 = 4 * (lane + 64 * j);
            const f32x4 g = *(const f32x4*)(p.g_pre_ffn + c0), sc = *(const f32x4*)(mb + 4096 + c0), sh = *(const f32x4*)(mb + 3072 + c0);
            const f32x4 h2 = (xv[j] * rstd * g) * (sc + 1.f) + sh;
            u32x2 w; w.x = pk2(h2.x, h2.y); w.y = pk2(h2.z, h2.w);
            *(u32x2*)(hb + (size_t)m * D + c0) = w;
#pragma unroll
            for (int q = 0; q < 4; ++q) { const float hv = h2[q]; const LAS3 f32x4* wr = (const LAS3 f32x4*)(sW + (q * 256 + lane + 64 * j) * SW_STRIDE);
#pragma unroll
                for (int e4 = 0; e4 < 8; ++e4) { const f32x4 ww = wr[e4]; lg[e4 * 4] = fmaf(hv, ww.x, lg[e4 * 4]); lg[e4 * 4 + 1] = fmaf(hv, ww.y, lg[e4 * 4 + 1]); lg[e4 * 4 + 2] = fmaf(hv, ww.z, lg[e4 * 4 + 2]); lg[e4 * 4 + 3] = fmaf(hv, ww.w, lg[e4 * 4 + 3]); }
                asm volatile("" ::: "memory"); }
        }
#pragma unroll
        for (int e = 0; e < NE; ++e) lg[e] = wave_sum(lg[e]) + p.b_router[e];
        float tv[4]; int ti[4]; unsigned used = 0u;
#pragma unroll
        for (int k = 0; k < 4; ++k) { float best = -3.4e38f; int bi = 0;
#pragma unroll
            for (int e = 0; e < NE; ++e) { const bool ok = !((used >> e) & 1u) && lg[e] > best; best = ok ? lg[e] : best; bi = ok ? e : bi; }
            tv[k] = best; ti[k] = bi; used |= 1u << bi; }
        const float e1 = __expf(tv[1] - tv[0]), e2 = __expf(tv[2] - tv[0]), e3 = __expf(tv[3] - tv[0]); const float inv = 1.f / (1.f + e1 + e2 + e3);
        const float tw[4] = {inv, e1 * inv, e2 * inv, e3 * inv};
        if (lane < 4) {
            int myi = ti[0]; float myw = tw[0];
#pragma unroll
            for (int k = 1; k < 4; ++k) if (lane == k) { myi = ti[k]; myw = tw[k]; }
            const int lr = __hip_atomic_fetch_add((LAS3 int*)&lcnt[myi], 1, __ATOMIC_RELAXED, __HIP_MEMORY_SCOPE_WORKGROUP);
            const int si = (wave * 16 + it) * 4 + lane;
            stg_slot[si] = m * 4 + lane; stg_e[si] = myi | (lr << 8); stg_w[si] = myw;
        }
    }
    __syncthreads();
    if (threadIdx.x < NE) { const int c = lcnt[threadIdx.x]; lbase[threadIdx.x] = c ? (int)atomicAdd(&counts[threadIdx.x * 64], (unsigned)c) : 0; }
    __syncthreads();
    { const int si = threadIdx.x, w = si >> 6, itx = (si >> 2) & 15;
      if (itx < nrows_w((int)blockIdx.x * (NTHREADS / 64) + w, ngw)) {
        const int ee = stg_e[si], e = ee & 255, lr = ee >> 8; const int rank = lbase[e] + lr;
        eslot[(size_t)e * ECAP + rank] = stg_slot[si]; ew[(size_t)e * ECAP + rank] = stg_w[si]; } }
    __syncthreads();
}
__device__ __forceinline__ void expert_bases(const unsigned* counts, int* sbase_  ) {
    LAS3 int* sbase = (LAS3 int*)sbase_;
    if (threadIdx.x < 64) {
        const int lane = threadIdx.x; const int cn = lane < NE ? (int)counts[lane * 64] : 0; const int c = (cn + 255) & ~255;
        int incl = c;
#pragma unroll
        for (int o = 1; o < 32; o <<= 1) { const int v = __shfl_up(incl, o); if (lane >= o) incl += v; }
        if (lane < NE) { sbase[lane] = incl - c; sbase[40 + lane] = cn; }
        if (lane == NE - 1) sbase[NE] = incl;
    }
    __syncthreads();
}
__device__ __forceinline__ void p6_load(const bf16_t* y, const float* out, int m, int lane, u32x4 (&yv)[2][4], f32x4 (&xv)[2][2]) {
#pragma unroll
    for (int j = 0; j < 2; ++j) { const int c0 = 8 * (lane + 64 * j);
#pragma unroll
        for (int k = 0; k < 4; ++k) yv[j][k] = *(const u32x4*)(y + (size_t)(m * 4 + k) * D + c0);
        xv[j][0] = *(const f32x4*)(out + (size_t)m * D + c0); xv[j][1] = *(const f32x4*)(out + (size_t)m * D + c0 + 4); }
}
__device__ __forceinline__ void p6_row(const Params& p, const float* mod, int m, int lane, const u32x4 (&yv)[2][4], const f32x4 (&xv)[2][2]) {
    const int b = m / L; const float* ga2 = mod + b * 6144 + 5120;
    f32x4 a[2][2]; float s = 0.f;
#pragma unroll
    for (int j = 0; j < 2; ++j) { a[j][0] = (f32x4){0.f, 0.f, 0.f, 0.f}; a[j][1] = (f32x4){0.f, 0.f, 0.f, 0.f};
#pragma unroll
        for (int k = 0; k < 4; ++k) { const u32x4 w = yv[j][k];
            a[j][0].x += __uint_as_float(w.x << 16); a[j][0].y += __uint_as_float(w.x & 0xffff0000u); a[j][0].z += __uint_as_float(w.y << 16); a[j][0].w += __uint_as_float(w.y & 0xffff0000u);
            a[j][1].x += __uint_as_float(w.z << 16); a[j][1].y += __uint_as_float(w.z & 0xffff0000u); a[j][1].z += __uint_as_float(w.w << 16); a[j][1].w += __uint_as_float(w.w & 0xffff0000u); }
#pragma unroll
        for (int q = 0; q < 2; ++q) s += a[j][q].x * a[j][q].x + a[j][q].y * a[j][q].y + a[j][q].z * a[j][q].z + a[j][q].w * a[j][q].w; }
    const float rstd = rsqrtf(wave_sum(s) * (1.f / D) + EPS);
#pragma unroll
    for (int j = 0; j < 2; ++j)
#pragma unroll
        for (int q = 0; q < 2; ++q) { const int c0 = 8 * (lane + 64 * j) + 4 * q;
            const f32x4 g = *(const f32x4*)(p.g_post_ffn + c0), ga = *(const f32x4*)(ga2 + c0);
            *(f32x4*)(p.out + (size_t)m * D + c0) = xv[j][q] + ga * (a[j][q] * rstd * g); }
}
__device__ void p6_final(const Params& p, int gw, int ngw, int lane) {
    const float* mod = (const float*)(p.ws + WS_MOD); const bf16_t* y = (const bf16_t*)(p.ws + WS_Y);
    for (int m = gw; m < NTOK; m += 2 * ngw) {
        const int m2 = m + ngw; const bool has2 = m2 < NTOK;
        u32x4 yv[2][4], yv2[2][4]; f32x4 xv[2][2], xv2[2][2];
        p6_load(y, p.out, m, lane, yv, xv);
        if (has2) p6_load(y, p.out, m2, lane, yv2, xv2);
        p6_row(p, mod, m, lane, yv, xv);
        if (has2) p6_row(p, mod, m2, lane, yv2, xv2);
    }
}

constexpr int LDS_SBASE = 147456;
constexpr int LDS_BYTES = LDS_SBASE + 512 + (64 + 3 * 512) * 4 + 256;

__global__ void __launch_bounds__(NTHREADS, 2) fwd_kernel(Params p) {
    cg::grid_group grid = cg::this_grid();
    extern __shared__ __attribute__((aligned(16))) unsigned char lds[];
    int* sbase = (int*)(lds + LDS_SBASE);
    const int tid = threadIdx.x, lane = tid & 63, wave = tid >> 6;
    const int gtid = blockIdx.x * NTHREADS + tid, gsize = gridDim.x * NTHREADS;
    const int gw = blockIdx.x * (NTHREADS / 64) + wave, ngw = gridDim.x * (NTHREADS / 64);
    PG8_LAS unsigned char* lds3 = (PG8_LAS unsigned char*)lds;
    const PG8_LAS int* sbase3 = (const PG8_LAS int*)(lds3 + LDS_SBASE);
    volatile LAS3 unsigned* bst = (volatile LAS3 unsigned*)(lds3 + LDS_SBASE + 384);
    if (tid < 2) bst[tid] = 0u;
    __syncthreads();
    XcdBarrier xb = xcd_barrier_post((unsigned*)(p.ws + WS_CTL) + CW_BAR, bst);

    p0_mod(p, (float*)lds, (float*)(lds + 36864));
    p0_tab(p, gtid, gsize);
    p0_weights(p, (float*)(lds + 57344 + wave * 8448), gw, ngw, lane);
    grid.sync();
    p1_h(p, gw, ngw, lane);
    xcd_barrier(xb);
    { pg8::Gemm g{(const bf16_t*)(p.ws + WS_HB), (const bf16_t*)(p.ws + WS_WIN), D, 0, nullptr, sbase3};
      pg8::StaticOrder S; S.init(MROWS, INW, (int)gridDim.x, (int)blockIdx.x, nullptr);
      pg8::EpiQKV E{(bf16_t*)(p.ws + WS_QKV), (const float*)(p.ws + WS_TAB)};
      pg8::gemm_phase<pg8::EpiQKV, pg8::StaticOrder, false, true>(lds3, g, S, E); }
    xcd_barrier(xb);
    att::attn_phase(p, lds3);
    xcd_barrier(xb);
    p4a_ostat(p, gw, ngw, lane);
    xcd_barrier(xb);
    { pg8::Gemm g{(const bf16_t*)(p.ws + WS_O), (const bf16_t*)(p.ws + WS_WOUT), D, 0, nullptr, sbase3};
      pg8::StaticOrder S; S.init(NTOK, D, (int)gridDim.x, (int)blockIdx.x, nullptr);
      pg8::EpiF32 E{(float*)(p.ws + WS_MIX), D};
      pg8::gemm_phase<pg8::EpiF32, pg8::StaticOrder, false, true>(lds3, g, S, E); }
    xcd_barrier(xb);
    p4c_post(p, (LAS3 float*)lds3, gw, ngw, lane);
    xcd_barrier(xb);
    expert_bases((const unsigned*)(p.ws + WS_CTL), sbase);
    { const int total = sbase3[NE];
      pg8::Gemm g{(const bf16_t*)(p.ws + WS_HB), (const bf16_t*)(p.ws + WS_W1), D, (size_t)2048 * D * 2, (const int*)(p.ws + WS_ESLOT), sbase3};
      pg8::StaticOrder S; S.init(total, 2048, (int)gridDim.x, (int)blockIdx.x, sbase3);
      pg8::EpiSwiglu E{(bf16_t*)(p.ws + WS_ACT), p.b_mlp1};
      pg8::gemm_phase<pg8::EpiSwiglu, pg8::StaticOrder, true, true>(lds3, g, S, E); }
    xcd_barrier(xb);
    { const int total = sbase3[NE];
      pg8::Gemm g{(const bf16_t*)(p.ws + WS_ACT), (const bf16_t*)(p.ws + WS_W2), D, (size_t)D * D * 2, nullptr, sbase3};
      pg8::StaticOrder S; S.init(total, D, (int)gridDim.x, (int)blockIdx.x, sbase3);
      pg8::EpiScatter E{(bf16_t*)(p.ws + WS_Y), p.b_mlp2, (const int*)(p.ws + WS_ESLOT), (const float*)(p.ws + WS_EW), sbase3};
      pg8::gemm_phase<pg8::EpiScatter, pg8::StaticOrder, false, true>(lds3, g, S, E); }
    xcd_barrier(xb);
    p6_final(p, gw, ngw, lane);
}

extern "C" void kernel_launch(void* const* d_in, const int* in_sizes, int n_in, void* d_out, int out_size, void* d_ws, size_t ws_size, hipStream_t stream) {
    static int grid_blocks = 0;
    if (grid_blocks == 0) {
        if (n_in != 22 || ws_size < WS_END) { fprintf(stderr, "kernel_launch: unexpected n_in %d / ws_size %zu (need %zu)\n", n_in, ws_size, (size_t)WS_END); grid_blocks = -1; return; }
        int dev = 0, cus = 0, per_cu = 0;
        (void)hipGetDevice(&dev);
        (void)hipDeviceGetAttribute(&cus, hipDeviceAttributeMultiprocessorCount, dev);
        if (hipFuncSetAttribute((const void*)fwd_kernel, hipFuncAttributeMaxDynamicSharedMemorySize, LDS_BYTES) != hipSuccess) { fprintf(stderr, "kernel_launch: hipFuncSetAttribute failed\n"); grid_blocks = -1; return; }
        (void)hipOccupancyMaxActiveBlocksPerMultiprocessor(&per_cu, (const void*)fwd_kernel, NTHREADS, LDS_BYTES);
        if (per_cu < 1) { fprintf(stderr, "kernel_launch: occupancy query returned %d\n", per_cu); grid_blocks = -1; return; }
        grid_blocks = cus;
        if (grid_blocks * (NTHREADS / 64) * 16 < NTOK) { fprintf(stderr, "kernel_launch: needs >= 256 CUs (got %d)\n", cus); grid_blocks = -1; return; }
    }
    if (grid_blocks < 0) return;
    (void)hipMemsetAsync((char*)d_ws + WS_CTL, 0, CTL_BYTES, stream);
    Params p{};
    const float** pp = (const float**)&p;
    for (int i = 0; i < 22; ++i) pp[i] = (const float*)d_in[i];
    p.out = (float*)d_out; p.ws = (unsigned char*)d_ws;
    void* args[] = {&p};
    hipError_t e = hipLaunchCooperativeKernel((const void*)fwd_kernel, dim3(grid_blocks), dim3(NTHREADS), args, LDS_BYTES, stream);
    if (e != hipSuccess) fprintf(stderr, "cooperative launch failed: %s (grid %d)\n", hipGetErrorString(e), grid_blocks);
}
```

```cpp
#include <hip/hip_runtime.h>
#include <hip/hip_cooperative_groups.h>
#include <cstdio>
#include <cstdint>
namespace cg = cooperative_groups;

constexpr int D = 1024, NB = 8, L = 4096, CTX = 256;
constexpr int NTOK = NB * L, NCTX = NB * CTX, MROWS = NTOK + NCTX;
constexpr int INW = 2304;
constexpr int C_QA = 0, C_KA = 512, C_VA = 640, C_QB = 768, C_KB = 1280, C_VB = 1792;
constexpr int NE = 32, TOPK = 4, NASG = NTOK * TOPK;
constexpr int PADROWS = NASG + NE * 256;
constexpr float LOG2E = 1.4426950408889634f;
constexpr float QSCALE = 0.125f * LOG2E;
constexpr float EPS = 1e-6f;
constexpr int NTHREADS = 512;

constexpr size_t MiB = 1u << 20;
constexpr size_t WS_CTL = 0;
constexpr size_t CTL_BYTES = 32768;
constexpr int CW_BAR = 2048;
constexpr size_t WS_MOD = 1 * MiB;
constexpr size_t WS_TAB = 1 * MiB + 256 * 1024;
constexpr size_t WS_OSTAT = 1 * MiB + 512 * 1024;
constexpr size_t WS_WIN = 2 * MiB;
constexpr size_t WS_WOUT = 7 * MiB;
constexpr size_t WS_W2 = 9 * MiB;
constexpr size_t WS_W1 = 73 * MiB;
constexpr size_t WS_HB = 201 * MiB;
constexpr int ECAP = NTOK;
constexpr size_t WS_ESLOT = 269 * MiB;
constexpr size_t WS_EW = 273 * MiB;
constexpr size_t WS_QKV = 277 * MiB;
constexpr size_t WS_O = 430 * MiB;
constexpr size_t WS_MIX = 494 * MiB;
constexpr size_t WS_ACT = 277 * MiB;
constexpr size_t WS_Y = 622 * MiB;
constexpr size_t WS_END = 878 * MiB;
static_assert(WS_W1 + (size_t)NE * 2048 * D * 2 <= WS_HB && WS_W2 + (size_t)NE * D * D * 2 <= WS_W1, "map");
static_assert(WS_HB + (size_t)MROWS * D * 2 <= WS_ESLOT && WS_ESLOT + (size_t)NE * ECAP * 4 <= WS_EW && WS_EW + (size_t)NE * ECAP * 4 <= WS_QKV, "map");
static_assert(WS_QKV + (size_t)MROWS * INW * 2 <= WS_O && WS_O + (size_t)NTOK * D * 2 <= WS_MIX && WS_MIX + (size_t)NTOK * D * 4 <= WS_Y, "map");
static_assert(WS_ACT + (size_t)PADROWS * 1024 * 2 <= WS_Y && WS_Y + (size_t)NASG * D * 2 <= WS_END, "map");

typedef unsigned short bf16_t;
typedef float f32x4 __attribute__((ext_vector_type(4)));
typedef unsigned u32x4 __attribute__((ext_vector_type(4)));
typedef unsigned u32x2 __attribute__((ext_vector_type(2)));

struct Params {
    const float *x, *c, *ctx, *c_ctx, *w_ada, *b_ada, *g_pre_mix, *g_post_mix, *g_pre_ffn, *g_post_ffn, *w_in, *g_grp_a, *g_grp_b,
        *sink_a, *rpb_b, *w_out, *w_router, *b_router, *w_mlp1, *b_mlp1, *w_mlp2, *b_mlp2;
    float* out;
    unsigned char* ws;
};

__device__ __forceinline__ float bf2f(bf16_t h) { return __uint_as_float((unsigned)h << 16); }
__device__ __forceinline__ unsigned f2bf(float f) { unsigned u = __float_as_uint(f); return (u + 0x7fffu + ((u >> 16) & 1u)) >> 16; }
__device__ __forceinline__ unsigned pk2(float lo, float hi) { return f2bf(lo) | (f2bf(hi) << 16); }
__device__ __forceinline__ float wave_sum(float v) {
#pragma unroll
    for (int o = 1; o < 64; o <<= 1) v += __shfl_xor(v, o);
    return v;
}


#define LAS3 __attribute__((address_space(3)))
#define XB_TMO      128
#define XB_XCNT(j)  (256  + 64 * (j))
#define XB_XSUB(j)  (1280 + 64 * (j))
#define XB_XGEN(j)  (2304 + 64 * (j))
#define XB_TOP      3328
#define XB_TOPGEN   3392
#define XCD_BAR_WORDS 3456
#define XB_SPIN_CAP (1u << 18)
__device__ __forceinline__ unsigned xb_ld(unsigned* p)              { return __hip_atomic_load(p, __ATOMIC_RELAXED, __HIP_MEMORY_SCOPE_AGENT); }
__device__ __forceinline__ unsigned xb_add(unsigned* p, unsigned v) { return __hip_atomic_fetch_add(p, v, __ATOMIC_RELAXED, __HIP_MEMORY_SCOPE_AGENT); }
__device__ __forceinline__ unsigned xb_xcc_id() { return (unsigned)__builtin_amdgcn_s_getreg((3 << 11) | 20) & 0xFu; }
#define XB_SPIN(cond, bar) do { unsigned _sp = 0; while (cond) { __builtin_amdgcn_s_sleep(1); \
    if ((++_sp & 255u) == 0u) { if (xb_ld(&(bar)[XB_TMO])) break; if (_sp > XB_SPIN_CAP) { atomicAdd(&(bar)[XB_TMO], 1u); break; } } } } while (0)
struct XcdBarrier { unsigned* bar; unsigned x; volatile LAS3 unsigned* st; };
__device__ __forceinline__ XcdBarrier xcd_barrier_post(unsigned* bar, volatile LAS3 unsigned* st) {
    XcdBarrier b; b.bar = bar; b.x = xb_xcc_id(); b.st = st;
    if (threadIdx.x == 0) (void)xb_add(&bar[XB_XCNT(b.x)], 1u);
    return b;
}
__device__ __forceinline__ void xcd_barrier_complete(unsigned* bar, unsigned x, unsigned& nloc, unsigned& nx) {
    const unsigned G = gridDim.x * gridDim.y * gridDim.z;
    unsigned sum, cnt, mine, sp = 0u;
    for (;;) {
        sum = 0u; cnt = 0u; mine = 0u;
#pragma unroll
        for (unsigned j = 0; j < 16; ++j) { const unsigned c = xb_ld(&bar[XB_XCNT(j)]); sum += c; cnt += (c > 0u) ? 1u : 0u; mine = (j == x) ? c : mine; }
        if (sum == G) break;
        __builtin_amdgcn_s_sleep(1);
        if ((++sp & 255u) == 0u) { if (xb_ld(&bar[XB_TMO])) break; if (sp > XB_SPIN_CAP) { atomicAdd(&bar[XB_TMO], 1u); break; } }
    }
    nloc = mine > 0u ? mine : 1u; nx = cnt > 0u ? cnt : 1u;
}
__device__ __forceinline__ void xcd_barrier(const XcdBarrier& b) {
    asm volatile("s_waitcnt vmcnt(0)" ::: "memory");
    __syncthreads();
    if (threadIdx.x == 0) {
        unsigned* bar = b.bar;
        __builtin_amdgcn_s_waitcnt(0);
        unsigned nloc = b.st[0], nx = b.st[1];
        if (nloc == 0u) { xcd_barrier_complete(bar, b.x, nloc, nx); b.st[0] = nloc; b.st[1] = nx; }
        const unsigned old = xb_add(&bar[XB_XSUB(b.x)], 1u);
        const unsigned gen = old / nloc;
        if (old + 1u == (gen + 1u) * nloc) {
            __builtin_amdgcn_fence(__ATOMIC_RELEASE, "agent");
            asm volatile("s_waitcnt vmcnt(0)" ::: "memory");
            const unsigned og = xb_add(&bar[XB_TOP], 1u);
            const unsigned tg = og / nx;
            if (og + 1u == (tg + 1u) * nx) xb_add(&bar[XB_TOPGEN], 1u);
            else XB_SPIN(xb_ld(&bar[XB_TOPGEN]) == tg, bar);
            __builtin_amdgcn_fence(__ATOMIC_ACQUIRE, "agent");
            xb_add(&bar[XB_XGEN(b.x)], 1u);
            asm volatile("s_waitcnt vmcnt(0)" ::: "memory");
        } else {
            XB_SPIN(xb_ld(&bar[XB_XGEN(b.x)]) == gen, bar);
            __builtin_amdgcn_fence(__ATOMIC_ACQUIRE, "agent");
            asm volatile("s_waitcnt vmcnt(0)" ::: "memory");
        }
    }
    __syncthreads();
}

namespace pg8 {
#define PG8_LAS __attribute__((address_space(3)))
typedef short bf16x8 __attribute__((ext_vector_type(8)));
constexpr int BM = 256, BK = 64, HALF = 128, HTB = HALF * BK * 2  , STAGE_BYTES = 8 * HTB, NXCD = 8, WGM = 8;
__device__ __forceinline__ int lds_byte(int r, int c) { const int st = (r >> 4) * 2 + (c >> 5), rr = r & 15, cc = c & 31, ob = rr * 64 + cc * 2; return st * 1024 + (ob ^ (((ob >> 9) & 1) << 5)); }
__device__ __forceinline__ void stage_rc(int b, int& R, int& C) { const int st = b / 1024, sb = b % 1024, swz = sb ^ (((sb >> 9) & 1) << 5); R = (st >> 1) * 16 + swz / 64; C = (st & 1) * 32 + (swz % 64) / 2; }
__device__ __forceinline__ int perm32(int rho) { const int n = rho >> 4, i = rho & 15; return 8 * (i >> 2) + 4 * n + (i & 3); }

struct Unit { int pm, pn, e; };
struct Gemm { const bf16_t* A; const bf16_t* Bt; int K; size_t bstride; const int* eslot; const PG8_LAS int* sb; };

struct StaticOrder {
    int nM, nN, nwg, G, c; const PG8_LAS int* sbase;
    __device__ void init(int M, int N, int G_, int c_, const PG8_LAS int* sb) { nM = M / BM; nN = N / BM; nwg = nM * nN; G = G_; c = c_; sbase = sb; }
    __device__ bool next(int i, Unit& u) const {
        const long Lx = (long)i * G + c; if (Lx >= nwg) return false;
        int wgid = (int)Lx; { const int q = nwg / NXCD, r = nwg % NXCD, xcd = wgid % NXCD, off = wgid / NXCD; wgid = (xcd < r ? xcd * (q + 1) : r * (q + 1) + (xcd - r) * q) + off; }
        const int nig = WGM * nN, gid = wgid / nig, fm = gid * WGM, gsz = (nM - fm) < WGM ? (nM - fm) : WGM;
        u.pm = fm + ((wgid % nig) % gsz); u.pn = (wgid % nig) / gsz; u.e = 0;
        if (sbase) { const int row = u.pm * BM; int e = 0;
#pragma unroll 1
            for (int j = 1; j < 32; ++j) e += (row >= sbase[j]) ? 1 : 0;
            u.e = e; }
        return true;
    }
};

template <class Epi, class Sched, bool GATHER, bool ALIGN_EPI>
__device__ __forceinline__ void gemm_phase(PG8_LAS unsigned char* lds, const Gemm g, const Sched& S, const Epi& E) {
    int tid_ = threadIdx.x; asm volatile("" : "+v"(tid_));
    const int tid = tid_, wid = __builtin_amdgcn_readfirstlane(tid >> 6), lane = tid & 63, wr = wid >> 2, wc = wid & 3, fr = lane & 15, fq = lane >> 4;
    const int K = g.K, nt = K / BK;
    unsigned voffA[2], voffB[2];
#pragma unroll
    for (int i = 0; i < 2; ++i) { int R, C; stage_rc(tid * 16 + i * 8192, R, C); const int Rb = Epi::PERM ? ((R & ~31) + perm32(R & 31)) : R;
        voffA[i] = (unsigned)(R * K + C) * 2u; voffB[i] = (unsigned)(Rb * K + C) * 2u; }
    const size_t kstep = (size_t)(BK * 2);
    const size_t hstep = (size_t)HALF * K * 2;
    const size_t tstep = 2 * hstep;
    const unsigned ldsw = (unsigned)wid * 1024u;
    const int aoff = lds_byte(wr * 64 + fr, fq * 8), boff = lds_byte(wc * 32 + fr, fq * 8);
#define PG8_SA(b, h) (((b) * 2 + (h)) * HTB)
#define PG8_SB(b, h) ((4 + (b) * 2 + (h)) * HTB)
#define PG8_STAGE(bufoff, gbase, voff) do { _Pragma("unroll") for (int _i = 0; _i < 2; ++_i) \
        __builtin_amdgcn_global_load_lds((const unsigned*)((const char*)(gbase) + (voff)[_i]), (PG8_LAS unsigned*)(lds + (bufoff) + ldsw + _i * 8192), 16, 0, 0); } while (0)
#define PG8_LDA(dst, b, h) do { _Pragma("unroll") for (int m = 0; m < 4; ++m) _Pragma("unroll") for (int k = 0; k < 2; ++k) dst[m][k] = *(const PG8_LAS bf16x8*)(lds + PG8_SA(b, h) + aoff + m * 2048 + k * 1024); } while (0)
#define PG8_LDB(dst, b, h) do { _Pragma("unroll") for (int n = 0; n < 2; ++n) _Pragma("unroll") for (int k = 0; k < 2; ++k) dst[n][k] = *(const PG8_LAS bf16x8*)(lds + PG8_SB(b, h) + boff + n * 2048 + k * 1024); } while (0)
#define PG8_MMA(ai, bj, At, Bt) do { __builtin_amdgcn_s_setprio(1); _Pragma("unroll") for (int m = 0; m < 4; ++m) _Pragma("unroll") for (int n = 0; n < 2; ++n) _Pragma("unroll") for (int k = 0; k < 2; ++k) \
        acc[ai][bj][m][n] = __builtin_amdgcn_mfma_f32_16x16x32_bf16(Bt[n][k], At[m][k], acc[ai][bj][m][n], 0, 0, 0); __builtin_amdgcn_s_setprio(0); } while (0)
#define PG8_WAIT_V(n) asm volatile("s_waitcnt vmcnt(" #n ")" ::: "memory")
#define PG8_WAIT_L(n) asm volatile("s_waitcnt lgkmcnt(" #n ")" ::: "memory")
#define PG8_BAR __builtin_amdgcn_s_barrier()
#define PG8_SCHED __builtin_amdgcn_sched_barrier(0)
#define PG8_SETOFF(off, u) do { _Pragma("unroll") for (int _h = 0; _h < 2; ++_h) _Pragma("unroll") for (int _i = 0; _i < 2; ++_i) { \
        if (GATHER) { int R_, C_; stage_rc(tid * 16 + _i * 8192, R_, C_); int rk_ = (u).pm * BM + _h * HALF + R_ - g.sb[(u).e]; const int cm_ = g.sb[40 + (u).e] - 1; rk_ = rk_ < cm_ ? rk_ : cm_; \
            off[_h][_i] = (unsigned)(g.eslot[(size_t)(u).e * ECAP + rk_] >> 2) * (unsigned)(K * 2) + (unsigned)(C_ * 2); } \
        else off[_h][_i] = voffA[_i] + (unsigned)(_h * hstep); } } while (0)
    Unit cur, nxt; int ui = 0;
    if (!S.next(0, cur)) return;
    f32x4 acc[2][2][4][2];
#pragma unroll
    for (int a = 0; a < 2; ++a)
#pragma unroll
        for (int b = 0; b < 2; ++b)
#pragma unroll
            for (int m = 0; m < 4; ++m)
#pragma unroll
                for (int n = 0; n < 2; ++n) acc[a][b][m][n] = (f32x4){0.f, 0.f, 0.f, 0.f};
    bf16x8 At[4][2], B0[2][2], B1[2][2];
    unsigned offc[2][2], offn[2][2];
    PG8_SETOFF(offc, cur);
    const char* cA = GATHER ? (const char*)g.A : (const char*)g.A + (size_t)cur.pm * tstep;
    const char* cB = (const char*)g.Bt + (size_t)cur.e * g.bstride + (size_t)cur.pn * tstep;
    PG8_STAGE(PG8_SB(0, 0), cB, voffB); PG8_STAGE(PG8_SB(0, 1), cB + hstep, voffB); PG8_STAGE(PG8_SA(0, 0), cA, offc[0]); PG8_STAGE(PG8_SA(0, 1), cA, offc[1]);
    if (wr == 1) PG8_BAR;
    PG8_WAIT_V(2); PG8_BAR;
    PG8_STAGE(PG8_SB(1, 0), cB + kstep, voffB); PG8_STAGE(PG8_SA(1, 0), cA + kstep, offc[0]); PG8_STAGE(PG8_SB(1, 1), cB + hstep + kstep, voffB);
    PG8_WAIT_V(6); PG8_BAR;
    for (;;) {
        const bool has_next = S.next(ui + 1, nxt);
        const char* nA = GATHER ? cA : (has_next ? (const char*)g.A + (size_t)nxt.pm * tstep : cA);
        const char* nB = has_next ? (const char*)g.Bt + (size_t)nxt.e * g.bstride + (size_t)nxt.pn * tstep : cB;
        if (GATHER) { if (has_next) { PG8_SETOFF(offn, nxt); } else {
#pragma unroll
            for (int h = 0; h < 2; ++h)
#pragma unroll
                for (int i = 0; i < 2; ++i) offn[h][i] = offc[h][i]; } }
        for (int t = 0; t < nt; t += 2) {
            const bool last = (t == nt - 2);
            const char* a1 = cA + (size_t)(t + 1) * kstep;
            const char* a2 = last ? nA : cA + (size_t)(t + 2) * kstep; const char* b2 = last ? nB : cB + (size_t)(t + 2) * kstep;
            const char* a3 = a2 + kstep; const char* b3 = b2 + kstep;
            unsigned o2[2][2];
#pragma unroll
            for (int h = 0; h < 2; ++h)
#pragma unroll
                for (int i = 0; i < 2; ++i) o2[h][i] = (GATHER && last) ? offn[h][i] : offc[h][i];
            PG8_LDB(B0, 0, 0); PG8_LDB(B1, 0, 1); PG8_SCHED; PG8_LDA(At, 0, 0); PG8_STAGE(PG8_SA(1, 1), a1, offc[1]);
            PG8_WAIT_V(8); PG8_WAIT_L(0); PG8_BAR; PG8_MMA(0, 0, At, B0); PG8_MMA(0, 1, At, B1); PG8_BAR; PG8_SCHED;
            PG8_LDA(At, 0, 1); PG8_STAGE(PG8_SB(0, 0), b2, voffB); PG8_STAGE(PG8_SB(0, 1), b2 + hstep, voffB); PG8_STAGE(PG8_SA(0, 0), a2, o2[0]);
            PG8_WAIT_V(8); PG8_WAIT_L(0); PG8_BAR; PG8_MMA(1, 0, At, B0); PG8_MMA(1, 1, At, B1); PG8_BAR; PG8_SCHED;
            PG8_LDB(B0, 1, 0); PG8_LDB(B1, 1, 1); PG8_SCHED; PG8_LDA(At, 1, 0); PG8_STAGE(PG8_SA(0, 1), a2, o2[1]);
            PG8_WAIT_V(8); PG8_WAIT_L(0); PG8_BAR; PG8_MMA(0, 0, At, B0); PG8_MMA(0, 1, At, B1); PG8_BAR; PG8_SCHED;
            PG8_LDA(At, 1, 1); PG8_STAGE(PG8_SB(1, 0), b3, voffB); PG8_STAGE(PG8_SB(1, 1), b3 + hstep, voffB); PG8_STAGE(PG8_SA(1, 0), a3, o2[0]);
            PG8_WAIT_V(8); PG8_WAIT_L(0); PG8_BAR; PG8_MMA(1, 0, At, B0); PG8_MMA(1, 1, At, B1); PG8_BAR; PG8_SCHED;
        }
        if constexpr (ALIGN_EPI) { if (wr == 0) PG8_BAR; }
        E(acc, cur, wr, wc, fr, fq);
        if (!has_next) break;
#pragma unroll
        for (int a = 0; a < 2; ++a)
#pragma unroll
            for (int b = 0; b < 2; ++b)
#pragma unroll
                for (int m = 0; m < 4; ++m)
#pragma unroll
                    for (int n = 0; n < 2; ++n) acc[a][b][m][n] = (f32x4){0.f, 0.f, 0.f, 0.f};
        cur = nxt; cA = nA; cB = nB; ++ui;
#pragma unroll
        for (int h = 0; h < 2; ++h)
#pragma unroll
            for (int i = 0; i < 2; ++i) offc[h][i] = offn[h][i];
        if constexpr (ALIGN_EPI) { if (wr == 1) PG8_BAR; }
    }
    PG8_WAIT_V(0);
    if constexpr (!ALIGN_EPI) { if (wr == 0) PG8_BAR; }
    PG8_BAR;
#undef PG8_SA
#undef PG8_SB
#undef PG8_STAGE
#undef PG8_LDA
#undef PG8_LDB
#undef PG8_MMA
#undef PG8_WAIT_V
#undef PG8_WAIT_L
#undef PG8_BAR
#undef PG8_SCHED
#undef PG8_SETOFF
}

struct EpiQKV {
    static constexpr bool PERM = false;
    bf16_t* O; const float* tab;
    __device__ __forceinline__ void operator()(const f32x4 (&acc)[2][2][4][2], const Unit& u, int wr, int wc, int fr, int fq) const {
        const bool latent = u.pm < NTOK / BM;
#pragma unroll
        for (int ai = 0; ai < 2; ++ai)
#pragma unroll
            for (int m = 0; m < 4; ++m) {
                const int row = u.pm * BM + ai * HALF + wr * 64 + m * 16 + fr;
                bf16_t* rowp = O + (size_t)row * INW + u.pn * BM + wc * 32 + 4 * fq;
                const int pos = row & (L - 1), pp = (wc & 1) ? (pos & 63) : (pos >> 6);
                const f32x4* tp = (const f32x4*)(tab + (pp * 16 + 4 * fq) * 2);
#pragma unroll
                for (int bj = 0; bj < 2; ++bj) {
                    const int colbase = u.pn * BM + bj * HALF;
                    f32x4 v0 = acc[ai][bj][m][0], v1 = acc[ai][bj][m][1];
                    if (latent && colbase < C_VA) {
                        const f32x4 t0 = tp[0], t1 = tp[1];
                        const f32x4 cs = {t0.x, t0.z, t1.x, t1.z}, sn = {t0.y, t0.w, t1.y, t1.w};
                        const f32x4 a0 = v0 * cs - v1 * sn, a1 = v1 * cs + v0 * sn; v0 = a0; v1 = a1;
                    }
                    if (colbase < C_KA || (colbase >= C_QB && colbase < C_KB)) { v0 = v0 * QSCALE; v1 = v1 * QSCALE; }
                    u32x2 w0, w1; w0.x = pk2(v0.x, v0.y); w0.y = pk2(v0.z, v0.w); w1.x = pk2(v1.x, v1.y); w1.y = pk2(v1.z, v1.w);
                    *(u32x2*)(rowp + bj * HALF) = w0; *(u32x2*)(rowp + bj * HALF + 16) = w1;
                }
            }
    }
};
struct EpiF32 {
    static constexpr bool PERM = false;
    float* O; int ldc;
    __device__ __forceinline__ void operator()(const f32x4 (&acc)[2][2][4][2], const Unit& u, int wr, int wc, int fr, int fq) const {
#pragma unroll
        for (int ai = 0; ai < 2; ++ai)
#pragma unroll
            for (int m = 0; m < 4; ++m) {
                float* rowp = O + (size_t)(u.pm * BM + ai * HALF + wr * 64 + m * 16 + fr) * ldc + u.pn * BM + wc * 32 + 4 * fq;
#pragma unroll
                for (int bj = 0; bj < 2; ++bj)
#pragma unroll
                    for (int n = 0; n < 2; ++n) *(f32x4*)(rowp + bj * HALF + 16 * n) = acc[ai][bj][m][n];
            }
    }
};
struct EpiSwiglu {
    static constexpr bool PERM = false;
    bf16_t* act; const float* b1;
    __device__ __forceinline__ void operator()(const f32x4 (&acc)[2][2][4][2], const Unit& u, int wr, int wc, int fr, int fq) const {
#pragma unroll
        for (int bj = 0; bj < 2; ++bj) {
            const int f0 = 16 * (8 * u.pn + 4 * bj + wc) + 4 * fq;
            const f32x4* bp = (const f32x4*)(b1 + (size_t)u.e * 2048 + 2 * f0); const f32x4 bA = bp[0], bB = bp[1];
            const f32x4 bg = {bA.x, bA.z, bB.x, bB.z}, bl = {bA.y, bA.w, bB.y, bB.w};
#pragma unroll
            for (int ai = 0; ai < 2; ++ai)
#pragma unroll
                for (int m = 0; m < 4; ++m) {
                    const int row = u.pm * BM + ai * HALF + wr * 64 + m * 16 + fr;
                    const f32x4 gt = acc[ai][bj][m][0] + bg, ln = acc[ai][bj][m][1] + bl; float a[4];
#pragma unroll
                    for (int j = 0; j < 4; ++j) { const float gg = fminf(gt[j], 7.f), ll = fminf(fmaxf(ln[j], -7.f), 7.f);
                        a[j] = gg * __builtin_amdgcn_rcpf(1.f + __expf(-1.702f * gg)) * (ll + 1.f); }
                    u32x2 w; w.x = pk2(a[0], a[1]); w.y = pk2(a[2], a[3]);
                    *(u32x2*)(act + (size_t)row * D + f0) = w;
                }
        }
    }
};
struct EpiScatter {
    static constexpr bool PERM = true;
    bf16_t* y; const float* b2; const int* eslot; const float* ew; const PG8_LAS int* sb;
    __device__ __forceinline__ void operator()(const f32x4 (&acc)[2][2][4][2], const Unit& u, int wr, int wc, int fr, int fq) const {
        const int col0 = u.pn * BM + wc * 32 + 8 * fq;
        f32x4 bv[2][2];
#pragma unroll
        for (int bj = 0; bj < 2; ++bj)
#pragma unroll
            for (int n = 0; n < 2; ++n) bv[bj][n] = *(const f32x4*)(b2 + (size_t)u.e * D + col0 + bj * HALF + 4 * n);
#pragma unroll
        for (int ai = 0; ai < 2; ++ai)
#pragma unroll
            for (int m = 0; m < 4; ++m) {
                const int row = u.pm * BM + ai * HALF + wr * 64 + m * 16 + fr;
                const int rk = row - sb[u.e], cn = sb[40 + u.e]; const int rkc = rk < cn - 1 ? rk : cn - 1;
                const int slot = eslot[(size_t)u.e * ECAP + rkc]; const float w = ew[(size_t)u.e * ECAP + rkc];
                if (rk < cn) {
                    bf16_t* rowp = y + (size_t)slot * D + col0;
#pragma unroll
                    for (int bj = 0; bj < 2; ++bj) { const f32x4 v0 = (acc[ai][bj][m][0] + bv[bj][0]) * w, v1 = (acc[ai][bj][m][1] + bv[bj][1]) * w;
                        u32x4 o; o.x = pk2(v0.x, v0.y); o.y = pk2(v0.z, v0.w); o.z = pk2(v1.x, v1.y); o.w = pk2(v1.z, v1.w);
                        *(u32x4*)(rowp + bj * HALF) = o; }
                }
            }
    }
};
}

__device__ void p0_mod(const Params& p, float* sS  , float* sP  ) {
    float* mod = (float*)(p.ws + WS_MOD);
    const int tid = threadIdx.x, lane = tid & 63, wave = tid >> 6;
    if (blockIdx.x >= 96) return;
    for (int i = tid; i < 9 * D; i += NTHREADS) { const int r = i >> 10, k = i & 1023; const float cc = r < 8 ? p.c[r * D + k] : p.c_ctx[k]; sS[i] = cc / (1.f + __expf(-cc)); }
    __syncthreads();
    const int j = blockIdx.x * 64 + lane;
    float acc[9];
#pragma unroll
    for (int r = 0; r < 9; ++r) acc[r] = 0.f;
    const float* wp = p.w_ada + (size_t)(wave * 128) * 6144 + j;
#pragma unroll 1
    for (int k0 = 0; k0 < 128; k0 += 16) {
        float w[16];
#pragma unroll
        for (int kk = 0; kk < 16; ++kk) w[kk] = wp[(size_t)(k0 + kk) * 6144];
#pragma unroll
        for (int kk = 0; kk < 16; ++kk)
#pragma unroll
            for (int r = 0; r < 9; ++r) acc[r] = fmaf(sS[r * D + wave * 128 + k0 + kk], w[kk], acc[r]);
    }
#pragma unroll
    for (int r = 0; r < 9; ++r) sP[(wave * 9 + r) * 64 + lane] = acc[r];
    __syncthreads();
    for (int i = tid; i < 9 * 64; i += NTHREADS) { const int r = i >> 6, jj = i & 63; float s = p.b_ada[blockIdx.x * 64 + jj];
#pragma unroll
        for (int w = 0; w < 8; ++w) s += sP[(w * 9 + r) * 64 + jj];
        mod[r * 6144 + blockIdx.x * 64 + jj] = s; }
    __syncthreads();
}
__device__ void p0_tab(const Params& p, int gtid, int gsize) {
    float* tab = (float*)(p.ws + WS_TAB);
    for (int idx = gtid; idx < 64 * 16; idx += gsize) {
        const int pos = idx >> 4, i = idx & 15;
        const float freq = exp2f(-(float)i * (13.287712379549449f / 16.f));
        const float ang = (float)pos * freq;
        const float n = rintf(ang * 0.15915494309189535f);
        float r = fmaf(-n, 6.28125f, ang); r = fmaf(-n, 1.9353071795864769e-3f, r);
        tab[idx * 2] = __cosf(r); tab[idx * 2 + 1] = __sinf(r);
    }
}
template <int MODE>
__device__ __forceinline__ void conv_item(const float* src, int K, int N, bf16_t* dst, int item, float* scr, int lane, const float* gA, const float* gB) {
    const int nblk = N / 32, kb = item / nblk, nb = item % nblk, k0 = 64 * kb, n0 = 32 * nb;
    const int c = lane & 31, kh = lane >> 5;
    const int nl = MODE == 1 ? 16 * (c & 1) + (c >> 1) : c;
    float v[32];
    const float* sp = src + (size_t)(k0 + kh) * N + n0 + c;
#pragma unroll
    for (int i = 0; i < 32; ++i) v[i] = sp[(size_t)(2 * i) * N];
#pragma unroll
    for (int i = 0; i < 32; ++i) { float x = v[i]; if (MODE == 2) { const int k = k0 + 2 * i + kh; x *= (k < 512 ? gA[k] : gB[k - 512]); } scr[(2 * i + kh) * 33 + nl] = x; }
    asm volatile("s_waitcnt lgkmcnt(0)" ::: "memory");
    const int ch = lane & 7;
#pragma unroll
    for (int j = 0; j < 4; ++j) { const int n = (lane >> 3) + 8 * j; const float* s = scr + (8 * ch) * 33 + n;
        u32x4 o; o.x = pk2(s[0 * 33], s[1 * 33]); o.y = pk2(s[2 * 33], s[3 * 33]); o.z = pk2(s[4 * 33], s[5 * 33]); o.w = pk2(s[6 * 33], s[7 * 33]);
        *(u32x4*)(dst + (size_t)(n0 + n) * K + k0 + 8 * ch) = o; }
    asm volatile("s_waitcnt lgkmcnt(0)" ::: "memory");
}
__device__ void p0_weights(const Params& p, float* scr, int gw, int ngw, int lane) {
    constexpr int I_IN = 16 * 72, I_OUT = 16 * 32, I_W1 = 16 * 64, I_W2 = 16 * 32;
    constexpr int NITEMS = I_IN + I_OUT + NE * I_W1 + NE * I_W2;
    for (int it = gw; it < NITEMS; it += ngw) {
        int r = it;
        if (r < I_IN) { conv_item<0>(p.w_in, D, INW, (bf16_t*)(p.ws + WS_WIN), r, scr, lane, nullptr, nullptr); continue; } r -= I_IN;
        if (r < I_OUT) { conv_item<2>(p.w_out, D, D, (bf16_t*)(p.ws + WS_WOUT), r, scr, lane, p.g_grp_a, p.g_grp_b); continue; } r -= I_OUT;
        if (r < NE * I_W1) { const int e = r / I_W1, q = r % I_W1;
            conv_item<1>(p.w_mlp1 + (size_t)e * D * 2048, D, 2048, (bf16_t*)(p.ws + WS_W1) + (size_t)e * 2048 * D, q, scr, lane, nullptr, nullptr); continue; } r -= NE * I_W1;
        { const int e = r / I_W2, q = r % I_W2;
            conv_item<0>(p.w_mlp2 + (size_t)e * D * D, D, D, (bf16_t*)(p.ws + WS_W2) + (size_t)e * D * D, q, scr, lane, nullptr, nullptr); }
    }
}

__device__ void p1_h(const Params& p, int lane) {
    const float* mod = (const float*)(p.ws + WS_MOD);
    bf16_t* hb = (bf16_t*)(p.ws + WS_HB);
    constexpr int R = 17;
    const int gwv = blockIdx.x * (NTHREADS / 64) + (threadIdx.x >> 6);
    const int m0 = gwv * R; if (m0 >= MROWS) return;
    const int m1 = m0 + R < MROWS ? m0 + R : MROWS;
    f32x4 pB[4], pC[4], v[4], nv[4]; int curb = -1;
#define P1_ROWPTR(m) ((m) < NTOK ? p.x + (size_t)(m) * D : p.ctx + (size_t)((m) - NTOK) * D)
    { const float* xr = P1_ROWPTR(m0);
#pragma unroll
      for (int j = 0; j < 4; ++j) nv[j] = ((const f32x4*)xr)[lane + 64 * j]; }
    for (int m = m0; m < m1; ++m) {
#pragma unroll
        for (int j = 0; j < 4; ++j) v[j] = nv[j];
        if (m + 1 < m1) { const float* xr = P1_ROWPTR(m + 1);
#pragma unroll
            for (int j = 0; j < 4; ++j) nv[j] = ((const f32x4*)xr)[lane + 64 * j]; }
        const int b = m < NTOK ? m / L : 8;
        if (b != curb) { curb = b; const float* sh = mod + b * 6144, * sc = sh + 1024;
#pragma unroll
            for (int j = 0; j < 4; ++j) { const int c0 = 4 * (lane + 64 * j); pB[j] = *(const f32x4*)(p.g_pre_mix + c0) * (*(const f32x4*)(sc + c0) + 1.f); pC[j] = *(const f32x4*)(sh + c0); } }
        float s = 0.f;
#pragma unroll
        for (int j = 0; j < 4; ++j) s += v[j].x * v[j].x + v[j].y * v[j].y + v[j].z * v[j].z + v[j].w * v[j].w;
        const float rstd = rsqrtf(wave_sum(s) * (1.f / D) + EPS);
#pragma unroll
        for (int j = 0; j < 4; ++j) { const int c0 = 4 * (lane + 64 * j);
            const f32x4 o = (v[j] * rstd) * pB[j] + pC[j];
            u32x2 w; w.x = pk2(o.x, o.y); w.y = pk2(o.z, o.w);
            *(u32x2*)(hb + (size_t)m * D + c0) = w; }
    }
#undef P1_ROWPTR
}

template <class AL, class BL, class EP>
__device__ __forceinline__ void ngemm_tile(float* sA, float* sB, int m0, int n0, int K, const AL& aload, const BL& bload, const EP& epi) {
    const int tid = threadIdx.x, ty = tid >> 4, tx = tid & 15;
    float acc[4][4];
#pragma unroll
    for (int i = 0; i < 4; ++i)
#pragma unroll
        for (int j = 0; j < 4; ++j) acc[i][j] = 0.f;
    for (int k0 = 0; k0 < K; k0 += 16) {
#pragma unroll
        for (int i = 0; i < 4; ++i) { const int e = tid + NTHREADS * i, r = e >> 4, kk = e & 15; sA[kk * 132 + r] = aload(m0 + r, k0 + kk); }
#pragma unroll
        for (int i = 0; i < 2; ++i) { const int e = tid + NTHREADS * i, n = e >> 4, kk = e & 15; sB[kk * 68 + n] = bload(n0 + n, k0 + kk); }
        __syncthreads();
#pragma unroll
        for (int kk = 0; kk < 16; ++kk) {
            float a[4], b[4];
#pragma unroll
            for (int i = 0; i < 4; ++i) a[i] = sA[kk * 132 + ty * 4 + i];
#pragma unroll
            for (int j = 0; j < 4; ++j) b[j] = sB[kk * 68 + tx + 16 * j];
#pragma unroll
            for (int i = 0; i < 4; ++i)
#pragma unroll
                for (int j = 0; j < 4; ++j) acc[i][j] = fmaf(a[i], b[j], acc[i][j]);
        }
        __syncthreads();
    }
    epi(m0 + ty * 4, n0, tx, acc);
}

__device__ void p2_qkv_naive(const Params& p, float* sA, float* sB) {
    const bf16_t* hb = (const bf16_t*)(p.ws + WS_HB); const bf16_t* wT = (const bf16_t*)(p.ws + WS_WIN);
    bf16_t* qkv = (bf16_t*)(p.ws + WS_QKV); const float* tab = (const float*)(p.ws + WS_TAB);
    constexpr int NTN = INW / 64, NT = (MROWS / 128) * NTN;
    for (int t = blockIdx.x; t < NT; t += gridDim.x) {
        const int m0 = (t / NTN) * 128, n0 = (t % NTN) * 64;
        auto al = [&](int r, int k) { return bf2f(hb[(size_t)r * D + k]); };
        auto bl = [&](int n, int k) { return bf2f(wT[(size_t)n * D + k]); };
        auto ep = [&](int r0, int nn0, int tx, float (&acc)[4][4]) {
#pragma unroll
            for (int i = 0; i < 4; ++i) {
                const int r = r0 + i; float v0 = acc[i][0], v1 = acc[i][1], v2 = acc[i][2], v3 = acc[i][3];
                const bool rope = (nn0 < C_VA) && (r < NTOK);
                if (rope) { const int t = r & (L - 1), pr = t >> 6, pc = t & 63;
                    const float c0 = tab[(pr * 16 + tx) * 2], s0 = tab[(pr * 16 + tx) * 2 + 1], c1 = tab[(pc * 16 + tx) * 2], s1 = tab[(pc * 16 + tx) * 2 + 1];
                    const float a0 = v0 * c0 - v1 * s0, a1 = v1 * c0 + v0 * s0, a2 = v2 * c1 - v3 * s1, a3 = v3 * c1 + v2 * s1; v0 = a0; v1 = a1; v2 = a2; v3 = a3; }
                const bool isq = (nn0 < C_KA) || (nn0 >= C_QB && nn0 < C_KB);
                if (isq) { v0 *= QSCALE; v1 *= QSCALE; v2 *= QSCALE; v3 *= QSCALE; }
                bf16_t* o = qkv + (size_t)r * INW + nn0 + tx;
                o[0] = (bf16_t)f2bf(v0); o[16] = (bf16_t)f2bf(v1); o[32] = (bf16_t)f2bf(v2); o[48] = (bf16_t)f2bf(v3);
            }
        };
        ngemm_tile(sA, sB, m0, n0, D, al, bl, ep);
    }
}

__device__ __forceinline__ void load_row64(const bf16_t* src, float* dst) {
#pragma unroll
    for (int c = 0; c < 8; ++c) { const u32x4 w = *(const u32x4*)(src + c * 8);
        dst[c * 8 + 0] = __uint_as_float(w.x << 16); dst[c * 8 + 1] = __uint_as_float(w.x & 0xffff0000u);
        dst[c * 8 + 2] = __uint_as_float(w.y << 16); dst[c * 8 + 3] = __uint_as_float(w.y & 0xffff0000u);
        dst[c * 8 + 4] = __uint_as_float(w.z << 16); dst[c * 8 + 5] = __uint_as_float(w.z & 0xffff0000u);
        dst[c * 8 + 6] = __uint_as_float(w.w << 16); dst[c * 8 + 7] = __uint_as_float(w.w & 0xffff0000u); }
}
struct OnlineSm { float m, l; };
__device__ __forceinline__ void attn_key(const float (&q)[64], float (&o)[64], OnlineSm& st, const bf16_t* krow, const bf16_t* vrow, float bias) {
    float s = bias;
#pragma unroll
    for (int c = 0; c < 8; ++c) { const u32x4 w = *(const u32x4*)(krow + c * 8);
        s = fmaf(q[c * 8 + 0], __uint_as_float(w.x << 16), s); s = fmaf(q[c * 8 + 1], __uint_as_float(w.x & 0xffff0000u), s);
        s = fmaf(q[c * 8 + 2], __uint_as_float(w.y << 16), s); s = fmaf(q[c * 8 + 3], __uint_as_float(w.y & 0xffff0000u), s);
        s = fmaf(q[c * 8 + 4], __uint_as_float(w.z << 16), s); s = fmaf(q[c * 8 + 5], __uint_as_float(w.z & 0xffff0000u), s);
        s = fmaf(q[c * 8 + 6], __uint_as_float(w.w << 16), s); s = fmaf(q[c * 8 + 7], __uint_as_float(w.w & 0xffff0000u), s); }
    const float mn = fmaxf(st.m, s), sc = exp2f(st.m - mn), pp = exp2f(s - mn);
    st.l = st.l * sc + pp; st.m = mn;
#pragma unroll
    for (int c = 0; c < 8; ++c) { const u32x4 w = *(const u32x4*)(vrow + c * 8);
        o[c * 8 + 0] = fmaf(pp, __uint_as_float(w.x << 16), o[c * 8 + 0] * sc); o[c * 8 + 1] = fmaf(pp, __uint_as_float(w.x & 0xffff0000u), o[c * 8 + 1] * sc);
        o[c * 8 + 2] = fmaf(pp, __uint_as_float(w.y << 16), o[c * 8 + 2] * sc); o[c * 8 + 3] = fmaf(pp, __uint_as_float(w.y & 0xffff0000u), o[c * 8 + 3] * sc);
        o[c * 8 + 4] = fmaf(pp, __uint_as_float(w.z << 16), o[c * 8 + 4] * sc); o[c * 8 + 5] = fmaf(pp, __uint_as_float(w.z & 0xffff0000u), o[c * 8 + 5] * sc);
        o[c * 8 + 6] = fmaf(pp, __uint_as_float(w.w << 16), o[c * 8 + 6] * sc); o[c * 8 + 7] = fmaf(pp, __uint_as_float(w.w & 0xffff0000u), o[c * 8 + 7] * sc); }
}
__device__ __forceinline__ void store_o64(bf16_t* dst, const float (&o)[64], float inv) {
#pragma unroll
    for (int c = 0; c < 8; ++c) { u32x4 w; w.x = pk2(o[c * 8] * inv, o[c * 8 + 1] * inv); w.y = pk2(o[c * 8 + 2] * inv, o[c * 8 + 3] * inv);
        w.z = pk2(o[c * 8 + 4] * inv, o[c * 8 + 5] * inv); w.w = pk2(o[c * 8 + 6] * inv, o[c * 8 + 7] * inv); *(u32x4*)(dst + c * 8) = w; }
}
__device__ void p3_attn_naive(const Params& p, int gtid, int gsize) {
    const bf16_t* qkv = (const bf16_t*)(p.ws + WS_QKV); bf16_t* ob = (bf16_t*)(p.ws + WS_O);
    for (int it = gtid; it < NTOK * 16; it += gsize) {
        const bool isB = it >= NTOK * 8; const int w = isB ? it - NTOK * 8 : it;
        const int h = w & 7, tokg = w >> 3, b = tokg / L, t = tokg % L;
        float q[64], o[64];
#pragma unroll
        for (int d = 0; d < 64; ++d) o[d] = 0.f;
        OnlineSm st;
        if (!isB) {
            const int kvh = h >> 2;
            load_row64(qkv + (size_t)tokg * INW + C_QA + h * 64, q);
            st.m = p.sink_a[h] * LOG2E; st.l = 1.f;
            const int j0 = t - 128 < 0 ? 0 : t - 128, j1 = t + 128 > L - 1 ? L - 1 : t + 128;
            for (int j = j0; j <= j1; ++j) { const bf16_t* row = qkv + (size_t)(b * L + j) * INW; attn_key(q, o, st, row + C_KA + kvh * 64, row + C_VA + kvh * 64, 0.f); }
            for (int c = 0; c < CTX; ++c) { const bf16_t* row = qkv + (size_t)(NTOK + b * CTX + c) * INW; attn_key(q, o, st, row + C_KA + kvh * 64, row + C_VA + kvh * 64, 0.f); }
            store_o64(ob + (size_t)tokg * D + h * 64, o, 1.f / st.l);
        } else {
            load_row64(qkv + (size_t)tokg * INW + C_QB + h * 64, q);
            st.m = -1e30f; st.l = 0.f;
            const int r = t >> 6, c = t & 63;
            const int rs = r - 4 < 0 ? 0 : (r - 4 > 56 ? 56 : r - 4), cs = c - 8 < 0 ? 0 : (c - 8 > 48 ? 48 : c - 8);
            for (int a = 0; a < 8; ++a)
                for (int e = 0; e < 16; ++e) { const int kr = rs + a, kc = cs + e; const bf16_t* row = qkv + (size_t)(b * L + kr * 64 + kc) * INW;
                    const float bias = p.rpb_b[(h * 15 + (kr - r + 7)) * 31 + (kc - c + 15)] * LOG2E;
                    attn_key(q, o, st, row + C_KB + h * 64, row + C_VB + h * 64, bias); }
            for (int cc = 0; cc < CTX; ++cc) { const bf16_t* row = qkv + (size_t)(NTOK + b * CTX + cc) * INW; attn_key(q, o, st, row + C_KB + h * 64, row + C_VB + h * 64, 0.f); }
            store_o64(ob + (size_t)tokg * D + 512 + h * 64, o, 1.f / st.l);
        }
    }
}


namespace att {
#define ATT_LAS __attribute__((address_space(3)))
typedef float f32x16 __attribute__((ext_vector_type(16)));
typedef short bf16x8 __attribute__((ext_vector_type(8)));
typedef short s16x4 __attribute__((ext_vector_type(4)));
constexpr int SLOTB = 8192;
constexpr int LDS_K = 0, LDS_V = 2 * SLOTB, LDS_WS = 4 * SLOTB, LDS_BT = LDS_WS + 8 * 256;
constexpr int BT_MARGIN = 64, BT_FLOATS = BT_MARGIN + 15 * 32 + 96;
constexpr float NEGBIG = -1e30f;
__device__ __forceinline__ int crow(int r, int hi) { return (r & 3) + 8 * (r >> 2) + 4 * hi; }
__device__ __forceinline__ unsigned cvtpk(float lo, float hi) { typedef float f2 __attribute__((ext_vector_type(2))); typedef __bf16 b2 __attribute__((ext_vector_type(2)));
    f2 v = {lo, hi}; b2 b = __builtin_convertvector(v, b2); return __builtin_bit_cast(unsigned, b); }
__device__ __forceinline__ s16x4 vtr(const ATT_LAS unsigned char* p) { typedef short v4i16 __attribute__((ext_vector_type(4)));
    return __builtin_bit_cast(s16x4, __builtin_amdgcn_ds_read_tr16_b64_v4i16((ATT_LAS v4i16*)p)); }
#define ATT_WAIT_BAR(N) asm volatile("s_waitcnt vmcnt(" #N ") lgkmcnt(0)\n\ts_barrier" ::: "memory")

__device__ __forceinline__ void dma_tile(ATT_LAS unsigned char* lds, int slot, const bf16_t* kbase, const bf16_t* vbase, int wid, int lane) {
    const bf16_t* ksrc = kbase + (size_t)lane * INW + wid * 8;
    const bf16_t* vsrc = vbase + (size_t)(16 * (wid & 3) + (lane >> 2)) * INW + (wid >> 2) * 32 + (lane & 3) * 8;
    __builtin_amdgcn_global_load_lds((const unsigned*)ksrc, (ATT_LAS unsigned*)(lds + LDS_K + slot * SLOTB + wid * 1024), 16, 0, 0);
    __builtin_amdgcn_global_load_lds((const unsigned*)vsrc, (ATT_LAS unsigned*)(lds + LDS_V + slot * SLOTB + wid * 1024), 16, 0, 0);
}

template <bool ISB>
__device__ __forceinline__ void attn_unit(const Params& p, ATT_LAS unsigned char* lds, int unit) {
    int tid_ = threadIdx.x; asm volatile("" : "+v"(tid_));
    const int tid = tid_, lane = tid & 63, r32 = lane & 31, hi = lane >> 5; const int wid = __builtin_amdgcn_readfirstlane(tid >> 6);
    const bf16_t* qkv = (const bf16_t*)(p.ws + WS_QKV); bf16_t* ob = (bf16_t*)(p.ws + WS_O);
    ATT_LAS float* wsf = (ATT_LAS float*)(lds + LDS_WS) + wid * 64;
    ATT_LAS float* bt = (ATT_LAS float*)(lds + LDS_BT);
    int b, h, kcol, vcol, qcol, ocol, q0, nloc, row_lo = 0, qr = 0, half = 0, qb = 0, jlo = 0;
    if (!ISB) { b = unit >> 7; const int kvh = (unit >> 6) & 1; qb = unit & 63; h = kvh * 4 + (wid >> 1); half = wid & 1; q0 = qb * 64 + 32 * half;
        kcol = C_KA + kvh * 64; vcol = C_VA + kvh * 64; qcol = C_QA + h * 64; ocol = h * 64;
        jlo = 2 - qb > 0 ? 2 - qb : 0; const int jhi = 65 - qb < 4 ? 65 - qb : 4; nloc = jhi - jlo + 1;
    } else { b = unit >> 7; h = (unit >> 4) & 7; const int g = unit & 15; qr = 4 * g + (wid >> 1); half = wid & 1; q0 = qr * 64 + 32 * half;
        kcol = C_KB + h * 64; vcol = C_VB + h * 64; qcol = C_QB + h * 64; ocol = 512 + h * 64;
        const int r0 = 4 * g, r3 = 4 * g + 3; row_lo = r0 - 4 < 0 ? 0 : (r0 - 4 > 56 ? 56 : r0 - 4); const int rs3 = r3 - 4 < 0 ? 0 : (r3 - 4 > 56 ? 56 : r3 - 4); nloc = rs3 + 7 - row_lo + 1;
    }
    const int NT = nloc + 4;
    const bf16_t* lat = qkv + (size_t)b * L * INW; const bf16_t* cx = qkv + (size_t)(NTOK + b * CTX) * INW;
#define ATT_TILE_ROW(t) ((t) < nloc ? lat + (size_t)(ISB ? (row_lo + (t)) * 64 : (qb - 2 + jlo + (t)) * 64) * INW : cx + (size_t)((t) - nloc) * 64 * INW)
    if (ISB) {
        for (int i = tid; i < BT_FLOATS; i += NTHREADS) { const int j = i - BT_MARGIN; float v = 0.f;
            if (j >= 0 && j < 15 * 32 && (j & 31) < 31) v = p.rpb_b[(h * 15 + (j >> 5)) * 31 + (j & 31)] * LOG2E;
            bt[i] = v; }
    }
    { const bf16_t* r0p = ATT_TILE_ROW(0); dma_tile(lds, 0, r0p + kcol, r0p + vcol, wid, lane); }
    bf16x8 qf[4];
    { const bf16_t* qp = lat + (size_t)(q0 + r32) * INW + qcol + hi * 8;
#pragma unroll
      for (int d0 = 0; d0 < 4; ++d0) qf[d0] = *(const bf16x8*)(qp + d0 * 16); }
    float m_run, l_run;
    if (!ISB) { m_run = p.sink_a[h] * LOG2E; l_run = hi == 0 ? 1.f : 0.f; } else { m_run = NEGBIG; l_run = 0.f; }
    f32x16 o0, o1;
#pragma unroll
    for (int r = 0; r < 16; ++r) { o0[r] = 0.f; o1[r] = 0.f; }
    const int qc = 32 * half + r32;
    const int cs = qc - 8 < 0 ? 0 : (qc - 8 > 48 ? 48 : qc - 8);
    const int rsq = qr - 4 < 0 ? 0 : (qr - 4 > 56 ? 56 : qr - 4);
    for (int t = 0; t < NT; ++t) {
        if (t + 1 < NT) { const bf16_t* rp = ATT_TILE_ROW(t + 1); dma_tile(lds, (t + 1) & 1, rp + kcol, rp + vcol, wid, lane); ATT_WAIT_BAR(2); }
        else { ATT_WAIT_BAR(0); }
        const int slot = t & 1;
        bool active = true; int kr = 0;
        if (ISB && t < nloc) { kr = row_lo + t; active = (kr >= rsq) && (kr <= rsq + 7); }
        if (active) {
            const ATT_LAS unsigned char* kb = lds + LDS_K + slot * SLOTB + hi * 1024 + r32 * 16;
            f32x16 p0, p1;
#pragma unroll
            for (int r = 0; r < 16; ++r) { p0[r] = 0.f; p1[r] = 0.f; }
#pragma unroll
            for (int d0 = 0; d0 < 4; ++d0) {
                const bf16x8 k0 = *(const ATT_LAS bf16x8*)(kb + d0 * 2048), k1 = *(const ATT_LAS bf16x8*)(kb + d0 * 2048 + 512);
                p0 = __builtin_amdgcn_mfma_f32_32x32x16_bf16(k0, qf[d0], p0, 0, 0, 0);
                p1 = __builtin_amdgcn_mfma_f32_32x32x16_bf16(k1, qf[d0], p1, 0, 0, 0);
            }
            if (ISB) {
                if (t < nloc) {
                    const ATT_LAS float* bp = bt + BT_MARGIN + (kr - qr + 7) * 32 + 15 - qc + 4 * hi;
                    const int e0 = 4 * hi - cs;
#pragma unroll
                    for (int r = 0; r < 16; ++r) { const int c = (r & 3) + 8 * (r >> 2);
                        const float b0 = bp[c], b1 = bp[c + 32];
                        p0[r] = ((unsigned)(c + e0) < 16u) ? p0[r] + b0 : NEGBIG;
                        p1[r] = ((unsigned)(c + 32 + e0) < 16u) ? p1[r] + b1 : NEGBIG; }
                }
            } else {
                if (t < nloc) { const int j = jlo + t; const int qq = 32 * half + r32;
                    if (j == 0) {
#pragma unroll
                        for (int r = 0; r < 16; ++r) { const int c = crow(r, hi); if (c < qq) p0[r] = NEGBIG; if (c + 32 < qq) p1[r] = NEGBIG; }
                    } else if (j == 4) {
#pragma unroll
                        for (int r = 0; r < 16; ++r) { const int c = crow(r, hi); if (c > qq) p0[r] = NEGBIG; if (c + 32 > qq) p1[r] = NEGBIG; }
                    }
                }
            }
            float rm = fmaxf(p0[0], p1[0]);
#pragma unroll
            for (int r = 1; r < 16; ++r) rm = fmaxf(rm, fmaxf(p0[r], p1[r]));
            rm = fmaxf(rm, __shfl_xor(rm, 32));
            const float mnew = fmaxf(m_run, rm);
            if (__any(mnew > m_run)) {
                const float f = __builtin_amdgcn_exp2f(m_run - mnew);
                l_run *= f; m_run = mnew;
                if (hi == 0) wsf[r32] = f;
                asm volatile("s_waitcnt lgkmcnt(0)" ::: "memory");
#pragma unroll
                for (int r = 0; r < 16; ++r) { const float fr_ = wsf[crow(r, hi)]; o0[r] *= fr_; o1[r] *= fr_; }
            }
            float ls = 0.f;
#pragma unroll
            for (int r = 0; r < 16; ++r) { p0[r] = __builtin_amdgcn_exp2f(p0[r] - m_run); p1[r] = __builtin_amdgcn_exp2f(p1[r] - m_run); ls += p0[r] + p1[r]; }
            l_run += ls;
            typedef unsigned u4 __attribute__((ext_vector_type(4)));
            const u4 pw0 = {cvtpk(p0[0], p0[1]), cvtpk(p0[2], p0[3]), cvtpk(p0[4], p0[5]), cvtpk(p0[6], p0[7])};
            const u4 pw1 = {cvtpk(p0[8], p0[9]), cvtpk(p0[10], p0[11]), cvtpk(p0[12], p0[13]), cvtpk(p0[14], p0[15])};
            const u4 pw2 = {cvtpk(p1[0], p1[1]), cvtpk(p1[2], p1[3]), cvtpk(p1[4], p1[5]), cvtpk(p1[6], p1[7])};
            const u4 pw3 = {cvtpk(p1[8], p1[9]), cvtpk(p1[10], p1[11]), cvtpk(p1[12], p1[13]), cvtpk(p1[14], p1[15])};
            const ATT_LAS unsigned char* vp = lds + LDS_V + slot * SLOTB + ((lane >> 4) & 1) * 32 + (lane & 3) * 8 + (4 * hi + ((lane & 15) >> 2)) * 64;
#define ATT_PV(OACC, PW, D0, KS) do { const s16x4 lo_ = vtr(vp + (D0) * 4096 + (KS) * 1024), hi_ = vtr(vp + (D0) * 4096 + (KS) * 1024 + 512); \
                const bf16x8 vf_ = {lo_[0], lo_[1], lo_[2], lo_[3], hi_[0], hi_[1], hi_[2], hi_[3]}; \
                OACC = __builtin_amdgcn_mfma_f32_32x32x16_bf16(__builtin_bit_cast(bf16x8, PW), vf_, OACC, 0, 0, 0); } while (0)
            ATT_PV(o0, pw0, 0, 0); ATT_PV(o1, pw0, 1, 0); ATT_PV(o0, pw1, 0, 1); ATT_PV(o1, pw1, 1, 1);
            ATT_PV(o0, pw2, 0, 2); ATT_PV(o1, pw2, 1, 2); ATT_PV(o0, pw3, 0, 3); ATT_PV(o1, pw3, 1, 3);
#undef ATT_PV
        }
        ATT_WAIT_BAR(2);
    }
    l_run += __shfl_xor(l_run, 32);
    if (hi == 0) wsf[32 + r32] = l_run;
    asm volatile("s_waitcnt lgkmcnt(0)" ::: "memory");
    bf16_t* op = ob + (size_t)(b * L + q0) * D + ocol + r32;
#pragma unroll
    for (int r = 0; r < 16; ++r) { const int q = crow(r, hi); const float inv = __builtin_amdgcn_rcpf(wsf[32 + q]);
        op[(size_t)q * D] = (bf16_t)f2bf(o0[r] * inv); op[(size_t)q * D + 32] = (bf16_t)f2bf(o1[r] * inv); }
    ATT_WAIT_BAR(0);
#undef ATT_TILE_ROW
}

__device__ __forceinline__ void attn_phase(const Params& p, ATT_LAS unsigned char* lds) {
    const int G = gridDim.x, bx = blockIdx.x;
    const int vcu = (G % 8 == 0) ? (bx % 8) * (G / 8) + bx / 8 : bx;
    for (int u = vcu; u < 2048; u += G) {
        if (u < 1024) attn_unit<false>(p, lds, u); else attn_unit<true>(p, lds, u - 1024);
    }
}
}

__device__ void p4a_ostat(const Params& p, int gw, int ngw, int lane) {
    bf16_t* ob = (bf16_t*)(p.ws + WS_O); float* os = (float*)(p.ws + WS_OSTAT);
    for (int m = gw; m < NTOK; m += ngw) {
        const u32x4 wa = *(const u32x4*)(ob + (size_t)m * D + lane * 8), wb = *(const u32x4*)(ob + (size_t)m * D + 512 + lane * 8);
        float sa = 0.f, sb = 0.f;
#pragma unroll
        for (int i = 0; i < 4; ++i) { const unsigned ua = wa[i], ub = wb[i]; const float a0 = __uint_as_float(ua << 16), a1 = __uint_as_float(ua & 0xffff0000u), b0 = __uint_as_float(ub << 16), b1 = __uint_as_float(ub & 0xffff0000u);
            sa += a0 * a0 + a1 * a1; sb += b0 * b0 + b1 * b1; }
        sa = wave_sum(sa); sb = wave_sum(sb);
        const float ra = rsqrtf(sa * (1.f / 512.f) + EPS), rb = rsqrtf(sb * (1.f / 512.f) + EPS);
        if (lane == 0) { os[m * 2] = ra; os[m * 2 + 1] = rb; }
        u32x4 oa, obb;
#pragma unroll
        for (int i = 0; i < 4; ++i) { const unsigned ua = wa[i], ub = wb[i];
            oa[i] = pk2(__uint_as_float(ua << 16) * ra, __uint_as_float(ua & 0xffff0000u) * ra); obb[i] = pk2(__uint_as_float(ub << 16) * rb, __uint_as_float(ub & 0xffff0000u) * rb); }
        *(u32x4*)(ob + (size_t)m * D + lane * 8) = oa; *(u32x4*)(ob + (size_t)m * D + 512 + lane * 8) = obb;
    }
}
__device__ void p4b_outproj_naive(const Params& p, float* sA, float* sB) {
    const bf16_t* ob = (const bf16_t*)(p.ws + WS_O); const bf16_t* wT = (const bf16_t*)(p.ws + WS_WOUT);
    float* mix = (float*)(p.ws + WS_MIX);
    constexpr int NTN = D / 64, NT = (NTOK / 128) * NTN;
    for (int t = blockIdx.x; t < NT; t += gridDim.x) {
        const int m0 = (t / NTN) * 128, n0 = (t % NTN) * 64;
        auto al = [&](int r, int k) { return bf2f(ob[(size_t)r * D + k]); };
        auto bl = [&](int n, int k) { return bf2f(wT[(size_t)n * D + k]); };
        auto ep = [&](int r0, int nn0, int tx, float (&acc)[4][4]) {
#pragma unroll
            for (int i = 0; i < 4; ++i)
#pragma unroll
                for (int j = 0; j < 4; ++j) mix[(size_t)(r0 + i) * D + nn0 + tx + 16 * j] = acc[i][j];
        };
        ngemm_tile(sA, sB, m0, n0, D, al, bl, ep);
    }
}
constexpr int SW_STRIDE = 36;

__device__ void p4c_post(const Params& p, LAS3 float* sW, int lane) {
    const float* mod = (const float*)(p.ws + WS_MOD); const float* mix = (const float*)(p.ws + WS_MIX);
    bf16_t* hb = (bf16_t*)(p.ws + WS_HB);
    unsigned* counts = (unsigned*)(p.ws + WS_CTL);
    int* eslot = (int*)(p.ws + WS_ESLOT); float* ew = (float*)(p.ws + WS_EW);
    const int wave = threadIdx.x >> 6;
    LAS3 int* lcnt = (LAS3 int*)(sW + 1024 * SW_STRIDE) + 128;
    LAS3 int* lbase = lcnt + 32;
    LAS3 int* stg_slot = lbase + 32; LAS3 int* stg_e = stg_slot + 512; LAS3 float* stg_w = (LAS3 float*)(stg_e + 512);
    if (threadIdx.x < NE) lcnt[threadIdx.x] = 0;
    for (int i = threadIdx.x; i < D * 8; i += NTHREADS) { const int k = i >> 3, e4 = i & 7; const f32x4 w = ((const f32x4*)p.w_router)[i];
        LAS3 float* d = sW + ((k & 3) * 256 + (k >> 2)) * SW_STRIDE + e4 * 4; *(LAS3 f32x4*)d = w; }
    __syncthreads();
    constexpr int R = 16;
    const int m0 = ((int)blockIdx.x * (NTHREADS / 64) + wave) * R;
    if (m0 < NTOK) {
        const int b = m0 / L; const float* mb = mod + b * 6144;
        f32x4 pA[4], pB[4], pC[4], v[4], xx[4], nv[4], nx[4];
#pragma unroll
        for (int j = 0; j < 4; ++j) { const int c0 = 4 * (lane + 64 * j);
            pA[j] = *(const f32x4*)(p.g_post_mix + c0) * *(const f32x4*)(mb + 2048 + c0);
            pB[j] = *(const f32x4*)(p.g_pre_ffn + c0) * (*(const f32x4*)(mb + 4096 + c0) + 1.f);
            pC[j] = *(const f32x4*)(mb + 3072 + c0);
            nv[j] = ((const f32x4*)(mix + (size_t)m0 * D))[lane + 64 * j]; nx[j] = ((const f32x4*)(p.x + (size_t)m0 * D))[lane + 64 * j]; }
        for (int it = 0; it < R; ++it) {
            const int m = m0 + it;
#pragma unroll
            for (int j = 0; j < 4; ++j) { v[j] = nv[j]; xx[j] = nx[j]; }
            if (it + 1 < R) {
#pragma unroll
                for (int j = 0; j < 4; ++j) { nv[j] = ((const f32x4*)(mix + (size_t)(m + 1) * D))[lane + 64 * j]; nx[j] = ((const f32x4*)(p.x + (size_t)(m + 1) * D))[lane + 64 * j]; }
            }
            float s = 0.f;
#pragma unroll
            for (int j = 0; j < 4; ++j) s += v[j].x * v[j].x + v[j].y * v[j].y + v[j].z * v[j].z + v[j].w * v[j].w;
            float rstd = rsqrtf(wave_sum(s) * (1.f / D) + EPS);
            s = 0.f;
            f32x4 xv[4];
#pragma unroll
            for (int j = 0; j < 4; ++j) {
                xv[j] = xx[j] + pA[j] * (v[j] * rstd);
                ((f32x4*)(p.out + (size_t)m * D))[lane + 64 * j] = xv[j];
                s += xv[j].x * xv[j].x + xv[j].y * xv[j].y + xv[j].z * xv[j].z + xv[j].w * xv[j].w; }
            rstd = rsqrtf(wave_sum(s) * (1.f / D) + EPS);
            float lg[NE];
#pragma unroll
            for (int e = 0; e < NE; ++e) lg[e] = 0.f;
#pragma unroll
            for (int j = 0; j < 4; ++j) { const int c0 = 4 * (lane + 64 * j);
                const f32x4 h2 = (xv[j] * rstd) * pB[j] + pC[j];
                u32x2 w; w.x = pk2(h2.x, h2.y); w.y = pk2(h2.z, h2.w);
                *(u32x2*)(hb + (size_t)m * D + c0) = w;
#pragma unroll
                for (int q = 0; q < 4; ++q) { const float hv = h2[q]; const LAS3 f32x4* wr = (const LAS3 f32x4*)(sW + (q * 256 + lane + 64 * j) * SW_STRIDE);
#pragma unroll
                    for (int e4 = 0; e4 < 8; ++e4) { const f32x4 ww = wr[e4]; lg[e4 * 4] = fmaf(hv, ww.x, lg[e4 * 4]); lg[e4 * 4 + 1] = fmaf(hv, ww.y, lg[e4 * 4 + 1]); lg[e4 * 4 + 2] = fmaf(hv, ww.z, lg[e4 * 4 + 2]); lg[e4 * 4 + 3] = fmaf(hv, ww.w, lg[e4 * 4 + 3]); }
                    asm volatile("" ::: "memory"); }
            }
#pragma unroll
            for (int e = 0; e < NE; ++e) lg[e] = wave_sum(lg[e]) + p.b_router[e];
            float tv[4]; int ti[4]; unsigned used = 0u;
#pragma unroll
            for (int k = 0; k < 4; ++k) { float best = -3.4e38f; int bi = 0;
#pragma unroll
                for (int e = 0; e < NE; ++e) { const bool ok = !((used >> e) & 1u) && lg[e] > best; best = ok ? lg[e] : best; bi = ok ? e : bi; }
                tv[k] = best; ti[k] = bi; used |= 1u << bi; }
            const float e1 = __expf(tv[1] - tv[0]), e2 = __expf(tv[2] - tv[0]), e3 = __expf(tv[3] - tv[0]); const float inv = 1.f / (1.f + e1 + e2 + e3);
            const float tw[4] = {inv, e1 * inv, e2 * inv, e3 * inv};
            if (lane < 4) {
                int myi = ti[0]; float myw = tw[0];
#pragma unroll
                for (int k = 1; k < 4; ++k) if (lane == k) { myi = ti[k]; myw = tw[k]; }
                const int lr = __hip_atomic_fetch_add((LAS3 int*)&lcnt[myi], 1, __ATOMIC_RELAXED, __HIP_MEMORY_SCOPE_WORKGROUP);
                const int si = (wave * 16 + it) * 4 + lane;
                stg_slot[si] = m * 4 + lane; stg_e[si] = myi | (lr << 8); stg_w[si] = myw;
            }
        }
    }
    __syncthreads();
    if (threadIdx.x < NE) { const int c = lcnt[threadIdx.x]; lbase[threadIdx.x] = c ? (int)atomicAdd(&counts[threadIdx.x * 64], (unsigned)c) : 0; }
    __syncthreads();
    { const int si = threadIdx.x, w = si >> 6;
      if (((int)blockIdx.x * (NTHREADS / 64) + w) * R < NTOK) {
        const int ee = stg_e[si], e = ee & 255, lr = ee >> 8; const int rank = lbase[e] + lr;
        eslot[(size_t)e * ECAP + rank] = stg_slot[si]; ew[(size_t)e * ECAP + rank] = stg_w[si]; } }
    __syncthreads();
}
__device__ __forceinline__ void expert_bases(const unsigned* counts, int* sbase_  ) {
    LAS3 int* sbase = (LAS3 int*)sbase_;
    if (threadIdx.x < 64) {
        const int lane = threadIdx.x; const int cn = lane < NE ? (int)counts[lane * 64] : 0; const int c = (cn + 255) & ~255;
        int incl = c;
#pragma unroll
        for (int o = 1; o < 32; o <<= 1) { const int v = __shfl_up(incl, o); if (lane >= o) incl += v; }
        if (lane < NE) { sbase[lane] = incl - c; sbase[40 + lane] = cn; }
        if (lane == NE - 1) sbase[NE] = incl;
    }
    __syncthreads();
}
__device__ __forceinline__ void p6_load(const bf16_t* y, const float* out, int m, int lane, u32x4 (&yv)[2][4], f32x4 (&xv)[2][2]) {
#pragma unroll
    for (int j = 0; j < 2; ++j) { const int c0 = 8 * (lane + 64 * j);
#pragma unroll
        for (int k = 0; k < 4; ++k) yv[j][k] = *(const u32x4*)(y + (size_t)(m * 4 + k) * D + c0);
        xv[j][0] = *(const f32x4*)(out + (size_t)m * D + c0); xv[j][1] = *(const f32x4*)(out + (size_t)m * D + c0 + 4); }
}
__device__ void p6_final(const Params& p, int lane) {
    const float* mod = (const float*)(p.ws + WS_MOD); const bf16_t* y = (const bf16_t*)(p.ws + WS_Y);
    constexpr int R = 16;
    const int m0 = ((int)blockIdx.x * (NTHREADS / 64) + (threadIdx.x >> 6)) * R;
    if (m0 >= NTOK) return;
    const int b = m0 / L; const float* ga2 = mod + b * 6144 + 5120;
    f32x4 pA[2][2];
#pragma unroll
    for (int j = 0; j < 2; ++j)
#pragma unroll
        for (int q = 0; q < 2; ++q) { const int c0 = 8 * (lane + 64 * j) + 4 * q; pA[j][q] = *(const f32x4*)(p.g_post_ffn + c0) * *(const f32x4*)(ga2 + c0); }
    u32x4 yv[2][4], ny[2][4]; f32x4 xv[2][2], nx[2][2];
    p6_load(y, p.out, m0, lane, ny, nx);
    for (int it = 0; it < R; ++it) {
        const int m = m0 + it;
#pragma unroll
        for (int j = 0; j < 2; ++j) {
#pragma unroll
            for (int k = 0; k < 4; ++k) yv[j][k] = ny[j][k];
            xv[j][0] = nx[j][0]; xv[j][1] = nx[j][1]; }
        if (it + 1 < R) p6_load(y, p.out, m + 1, lane, ny, nx);
        f32x4 a[2][2]; float s = 0.f;
#pragma unroll
        for (int j = 0; j < 2; ++j) { a[j][0] = (f32x4){0.f, 0.f, 0.f, 0.f}; a[j][1] = (f32x4){0.f, 0.f, 0.f, 0.f};
#pragma unroll
            for (int k = 0; k < 4; ++k) { const u32x4 w = yv[j][k];
                a[j][0].x += __uint_as_float(w.x << 16); a[j][0].y += __uint_as_float(w.x & 0xffff0000u); a[j][0].z += __uint_as_float(w.y << 16); a[j][0].w += __uint_as_float(w.y & 0xffff0000u);
                a[j][1].x += __uint_as_float(w.z << 16); a[j][1].y += __uint_as_float(w.z & 0xffff0000u); a[j][1].z += __uint_as_float(w.w << 16); a[j][1].w += __uint_as_float(w.w & 0xffff0000u); }
#pragma unroll
            for (int q = 0; q < 2; ++q) s += a[j][q].x * a[j][q].x + a[j][q].y * a[j][q].y + a[j][q].z * a[j][q].z + a[j][q].w * a[j][q].w; }
        const float rstd = rsqrtf(wave_sum(s) * (1.f / D) + EPS);
#pragma unroll
        for (int j = 0; j < 2; ++j)
#pragma unroll
            for (int q = 0; q < 2; ++q) { const int c0 = 8 * (lane + 64 * j) + 4 * q;
                *(f32x4*)(p.out + (size_t)m * D + c0) = xv[j][q] + pA[j][q] * (a[j][q] * rstd); }
    }
}

constexpr int LDS_SBASE = 147456;
constexpr int LDS_BYTES = LDS_SBASE + 512 + (64 + 3 * 512) * 4 + 256;

__global__ void __launch_bounds__(NTHREADS, 2) fwd_kernel(Params p) {
    cg::grid_group grid = cg::this_grid();
    extern __shared__ __attribute__((aligned(16))) unsigned char lds[];
    int* sbase = (int*)(lds + LDS_SBASE);
    const int tid = threadIdx.x, lane = tid & 63, wave = tid >> 6;
    const int gtid = blockIdx.x * NTHREADS + tid, gsize = gridDim.x * NTHREADS;
    const int gw = blockIdx.x * (NTHREADS / 64) + wave, ngw = gridDim.x * (NTHREADS / 64);
    PG8_LAS unsigned char* lds3 = (PG8_LAS unsigned char*)lds;
    const PG8_LAS int* sbase3 = (const PG8_LAS int*)(lds3 + LDS_SBASE);
    volatile LAS3 unsigned* bst = (volatile LAS3 unsigned*)(lds3 + LDS_SBASE + 384);
    if (tid < 2) bst[tid] = 0u;
    __syncthreads();
    XcdBarrier xb = xcd_barrier_post((unsigned*)(p.ws + WS_CTL) + CW_BAR, bst);

    p0_mod(p, (float*)lds, (float*)(lds + 36864));
    p0_tab(p, gtid, gsize);
    p0_weights(p, (float*)(lds + 57344 + wave * 8448), gw, ngw, lane);
    grid.sync();
    p1_h(p, lane);
    xcd_barrier(xb);
    { pg8::Gemm g{(const bf16_t*)(p.ws + WS_HB), (const bf16_t*)(p.ws + WS_WIN), D, 0, nullptr, sbase3};
      pg8::StaticOrder S; S.init(MROWS, INW, (int)gridDim.x, (int)blockIdx.x, nullptr);
      pg8::EpiQKV E{(bf16_t*)(p.ws + WS_QKV), (const float*)(p.ws + WS_TAB)};
      pg8::gemm_phase<pg8::EpiQKV, pg8::StaticOrder, false, true>(lds3, g, S, E); }
    xcd_barrier(xb);
    att::attn_phase(p, lds3);
    xcd_barrier(xb);
    p4a_ostat(p, gw, ngw, lane);
    xcd_barrier(xb);
    { pg8::Gemm g{(const bf16_t*)(p.ws + WS_O), (const bf16_t*)(p.ws + WS_WOUT), D, 0, nullptr, sbase3};
      pg8::StaticOrder S; S.init(NTOK, D, (int)gridDim.x, (int)blockIdx.x, nullptr);
      pg8::EpiF32 E{(float*)(p.ws + WS_MIX), D};
      pg8::gemm_phase<pg8::EpiF32, pg8::StaticOrder, false, true>(lds3, g, S, E); }
    xcd_barrier(xb);
    p4c_post(p, (LAS3 float*)lds3, lane);
    xcd_barrier(xb);
    expert_bases((const unsigned*)(p.ws + WS_CTL), sbase);
    { const int total = sbase3[NE];
      pg8::Gemm g{(const bf16_t*)(p.ws + WS_HB), (const bf16_t*)(p.ws + WS_W1), D, (size_t)2048 * D * 2, (const int*)(p.ws + WS_ESLOT), sbase3};
      pg8::StaticOrder S; S.init(total, 2048, (int)gridDim.x, (int)blockIdx.x, sbase3);
      pg8::EpiSwiglu E{(bf16_t*)(p.ws + WS_ACT), p.b_mlp1};
      pg8::gemm_phase<pg8::EpiSwiglu, pg8::StaticOrder, true, true>(lds3, g, S, E); }
    xcd_barrier(xb);
    { const int total = sbase3[NE];
      pg8::Gemm g{(const bf16_t*)(p.ws + WS_ACT), (const bf16_t*)(p.ws + WS_W2), D, (size_t)D * D * 2, nullptr, sbase3};
      pg8::StaticOrder S; S.init(total, D, (int)gridDim.x, (int)blockIdx.x, sbase3);
      pg8::EpiScatter E{(bf16_t*)(p.ws + WS_Y), p.b_mlp2, (const int*)(p.ws + WS_ESLOT), (const float*)(p.ws + WS_EW), sbase3};
      pg8::gemm_phase<pg8::EpiScatter, pg8::StaticOrder, false, true>(lds3, g, S, E); }
    xcd_barrier(xb);
    p6_final(p, lane);
}

extern "C" void kernel_launch(void* const* d_in, const int* in_sizes, int n_in, void* d_out, int out_size, void* d_ws, size_t ws_size, hipStream_t stream) {
    static int grid_blocks = 0;
    if (grid_blocks == 0) {
        if (n_in != 22 || ws_size < WS_END) { fprintf(stderr, "kernel_launch: unexpected n_in %d / ws_size %zu (need %zu)\n", n_in, ws_size, (size_t)WS_END); grid_blocks = -1; return; }
        int dev = 0, cus = 0, per_cu = 0;
        (void)hipGetDevice(&dev);
        (void)hipDeviceGetAttribute(&cus, hipDeviceAttributeMultiprocessorCount, dev);
        if (hipFuncSetAttribute((const void*)fwd_kernel, hipFuncAttributeMaxDynamicSharedMemorySize, LDS_BYTES) != hipSuccess) { fprintf(stderr, "kernel_launch: hipFuncSetAttribute failed\n"); grid_blocks = -1; return; }
        (void)hipOccupancyMaxActiveBlocksPerMultiprocessor(&per_cu, (const void*)fwd_kernel, NTHREADS, LDS_BYTES);
        if (per_cu < 1) { fprintf(stderr, "kernel_launch: occupancy query returned %d\n", per_cu); grid_blocks = -1; return; }
        grid_blocks = cus;
        if (grid_blocks * (NTHREADS / 64) * 16 < NTOK) { fprintf(stderr, "kernel_launch: needs >= 256 CUs (got %d)\n", cus); grid_blocks = -1; return; }
    }
    if (grid_blocks < 0) return;
    (void)hipMemsetAsync((char*)d_ws + WS_CTL, 0, CTL_BYTES, stream);
    Params p{};
    const float** pp = (const float**)&p;
    for (int i = 0; i < 22; ++i) pp[i] = (const float*)d_in[i];
    p.out = (float*)d_out; p.ws = (unsigned char*)d_ws;
    void* args[] = {&p};
    hipError_t e = hipLaunchCooperativeKernel((const void*)fwd_kernel, dim3(grid_blocks), dim3(NTHREADS), args, LDS_BYTES, stream);
    if (e != hipSuccess) fprintf(stderr, "cooperative launch failed: %s (grid %d)\n", hipGetErrorString(e), grid_blocks);
}
```

```cpp
#include <hip/hip_runtime.h>
#include <hip/hip_cooperative_groups.h>
#include <cstdio>
#include <cstdint>
namespace cg = cooperative_groups;

constexpr int D = 1024, NB = 8, L = 4096, CTX = 256;
constexpr int NTOK = NB * L, NCTX = NB * CTX, MROWS = NTOK + NCTX;
constexpr int INW = 2304;
constexpr int C_QA = 0, C_KA = 512, C_VA = 640, C_QB = 768, C_KB = 1280, C_VB = 1792;
constexpr int NE = 32, TOPK = 4, NASG = NTOK * TOPK;
constexpr int PADROWS = NASG + NE * 256;
constexpr float LOG2E = 1.4426950408889634f;
constexpr float QSCALE = 0.125f * LOG2E;
constexpr float EPS = 1e-6f;
constexpr int NTHREADS = 512;

constexpr size_t MiB = 1u << 20;
constexpr size_t WS_CTL = 0;
constexpr size_t CTL_BYTES = 32768;
constexpr int CW_BAR = 2048;
constexpr size_t WS_MOD = 1 * MiB;
constexpr size_t WS_TAB = 1 * MiB + 256 * 1024;
constexpr size_t WS_OSTAT = 1 * MiB + 512 * 1024;
constexpr size_t WS_WIN = 2 * MiB;
constexpr size_t WS_WOUT = 7 * MiB;
constexpr size_t WS_W2 = 9 * MiB;
constexpr size_t WS_W1 = 73 * MiB;
constexpr size_t WS_HB = 201 * MiB;
constexpr int ECAP = NTOK;
constexpr size_t WS_ESLOT = 269 * MiB;
constexpr size_t WS_EW = 273 * MiB;
constexpr size_t WS_QKV = 277 * MiB;
constexpr size_t WS_O = 430 * MiB;
constexpr size_t WS_MIX = 494 * MiB;
constexpr size_t WS_ACT = 277 * MiB;
constexpr size_t WS_Y = 622 * MiB;
constexpr size_t WS_END = 878 * MiB;
static_assert(WS_W1 + (size_t)NE * 2048 * D * 2 <= WS_HB && WS_W2 + (size_t)NE * D * D * 2 <= WS_W1, "map");
static_assert(WS_HB + (size_t)MROWS * D * 2 <= WS_ESLOT && WS_ESLOT + (size_t)NE * ECAP * 4 <= WS_EW && WS_EW + (size_t)NE * ECAP * 4 <= WS_QKV, "map");
static_assert(WS_QKV + (size_t)MROWS * INW * 2 <= WS_O && WS_O + (size_t)NTOK * D * 2 <= WS_MIX && WS_MIX + (size_t)NTOK * D * 4 <= WS_Y, "map");
static_assert(WS_ACT + (size_t)PADROWS * 1024 * 2 <= WS_Y && WS_Y + (size_t)NASG * D * 2 <= WS_END, "map");

typedef unsigned short bf16_t;
typedef float f32x4 __attribute__((ext_vector_type(4)));
typedef unsigned u32x4 __attribute__((ext_vector_type(4)));
typedef unsigned u32x2 __attribute__((ext_vector_type(2)));

struct Params {
    const float *x, *c, *ctx, *c_ctx, *w_ada, *b_ada, *g_pre_mix, *g_post_mix, *g_pre_ffn, *g_post_ffn, *w_in, *g_grp_a, *g_grp_b,
        *sink_a, *rpb_b, *w_out, *w_router, *b_router, *w_mlp1, *b_mlp1, *w_mlp2, *b_mlp2;
    float* out;
    unsigned char* ws;
};

__device__ __forceinline__ float bf2f(bf16_t h) { return __uint_as_float((unsigned)h << 16); }
__device__ __forceinline__ unsigned f2bf(float f) { unsigned u = __float_as_uint(f); return (u + 0x7fffu + ((u >> 16) & 1u)) >> 16; }
__device__ __forceinline__ unsigned pk2(float lo, float hi) { return f2bf(lo) | (f2bf(hi) << 16); }
__device__ __forceinline__ unsigned pk4_fp8(float v0, float v1, float v2, float v3) {
    int w = 0; w = __builtin_amdgcn_cvt_pk_fp8_f32(v0, v1, w, false); w = __builtin_amdgcn_cvt_pk_fp8_f32(v2, v3, w, true); return (unsigned)w; }
constexpr float W8_SCALE = 64.f, W8_INV = 1.f / 64.f;
__device__ __forceinline__ float wave_sum(float v) {
#pragma unroll
    for (int o = 1; o < 64; o <<= 1) v += __shfl_xor(v, o);
    return v;
}


#define LAS3 __attribute__((address_space(3)))
#define XB_TMO      128
#define XB_XCNT(j)  (256  + 64 * (j))
#define XB_XSUB(j)  (1280 + 64 * (j))
#define XB_XGEN(j)  (2304 + 64 * (j))
#define XB_TOP      3328
#define XB_TOPGEN   3392
#define XCD_BAR_WORDS 3456
#define XB_SPIN_CAP (1u << 18)
__device__ __forceinline__ unsigned xb_ld(unsigned* p)              { return __hip_atomic_load(p, __ATOMIC_RELAXED, __HIP_MEMORY_SCOPE_AGENT); }
__device__ __forceinline__ unsigned xb_add(unsigned* p, unsigned v) { return __hip_atomic_fetch_add(p, v, __ATOMIC_RELAXED, __HIP_MEMORY_SCOPE_AGENT); }
__device__ __forceinline__ unsigned xb_xcc_id() { return (unsigned)__builtin_amdgcn_s_getreg((3 << 11) | 20) & 0xFu; }
#define XB_SPIN(cond, bar) do { unsigned _sp = 0; while (cond) { __builtin_amdgcn_s_sleep(1); \
    if ((++_sp & 255u) == 0u) { if (xb_ld(&(bar)[XB_TMO])) break; if (_sp > XB_SPIN_CAP) { atomicAdd(&(bar)[XB_TMO], 1u); break; } } } } while (0)
struct XcdBarrier { unsigned* bar; unsigned x; volatile LAS3 unsigned* st; };
__device__ __forceinline__ XcdBarrier xcd_barrier_post(unsigned* bar, volatile LAS3 unsigned* st) {
    XcdBarrier b; b.bar = bar; b.x = xb_xcc_id(); b.st = st;
    if (threadIdx.x == 0) (void)xb_add(&bar[XB_XCNT(b.x)], 1u);
    return b;
}
__device__ __forceinline__ void xcd_barrier_complete(unsigned* bar, unsigned x, unsigned& nloc, unsigned& nx) {
    const unsigned G = gridDim.x * gridDim.y * gridDim.z;
    unsigned sum, cnt, mine, sp = 0u;
    for (;;) {
        sum = 0u; cnt = 0u; mine = 0u;
#pragma unroll
        for (unsigned j = 0; j < 16; ++j) { const unsigned c = xb_ld(&bar[XB_XCNT(j)]); sum += c; cnt += (c > 0u) ? 1u : 0u; mine = (j == x) ? c : mine; }
        if (sum == G) break;
        __builtin_amdgcn_s_sleep(1);
        if ((++sp & 255u) == 0u) { if (xb_ld(&bar[XB_TMO])) break; if (sp > XB_SPIN_CAP) { atomicAdd(&bar[XB_TMO], 1u); break; } }
    }
    nloc = mine > 0u ? mine : 1u; nx = cnt > 0u ? cnt : 1u;
}
__device__ __forceinline__ void xcd_barrier(const XcdBarrier& b) {
    asm volatile("s_waitcnt vmcnt(0)" ::: "memory");
    __syncthreads();
    if (threadIdx.x == 0) {
        unsigned* bar = b.bar;
        __builtin_amdgcn_s_waitcnt(0);
        unsigned nloc = b.st[0], nx = b.st[1];
        if (nloc == 0u) { xcd_barrier_complete(bar, b.x, nloc, nx); b.st[0] = nloc; b.st[1] = nx; }
        const unsigned old = xb_add(&bar[XB_XSUB(b.x)], 1u);
        const unsigned gen = old / nloc;
        if (old + 1u == (gen + 1u) * nloc) {
            __builtin_amdgcn_fence(__ATOMIC_RELEASE, "agent");
            asm volatile("s_waitcnt vmcnt(0)" ::: "memory");
            const unsigned og = xb_add(&bar[XB_TOP], 1u);
            const unsigned tg = og / nx;
            if (og + 1u == (tg + 1u) * nx) xb_add(&bar[XB_TOPGEN], 1u);
            else XB_SPIN(xb_ld(&bar[XB_TOPGEN]) == tg, bar);
            __builtin_amdgcn_fence(__ATOMIC_ACQUIRE, "agent");
            xb_add(&bar[XB_XGEN(b.x)], 1u);
            asm volatile("s_waitcnt vmcnt(0)" ::: "memory");
        } else {
            XB_SPIN(xb_ld(&bar[XB_XGEN(b.x)]) == gen, bar);
            __builtin_amdgcn_fence(__ATOMIC_ACQUIRE, "agent");
            asm volatile("s_waitcnt vmcnt(0)" ::: "memory");
        }
    }
    __syncthreads();
}

namespace pg8 {
#define PG8_LAS __attribute__((address_space(3)))
typedef short bf16x8 __attribute__((ext_vector_type(8)));
typedef int v8i __attribute__((ext_vector_type(8)));
typedef int v4i __attribute__((ext_vector_type(4)));
typedef short s16x16 __attribute__((ext_vector_type(16)));
constexpr int BM = 256, BK = 64, HALF = 128, HTB = HALF * BK * 2  , STAGE_BYTES = 8 * HTB, NXCD = 8, WGM = 8;
__device__ __forceinline__ int lds_byte(int r, int c) { const int st = (r >> 4) * 2 + (c >> 5), rr = r & 15, cc = c & 31, ob = rr * 64 + cc * 2; return st * 1024 + (ob ^ (((ob >> 9) & 1) << 5)); }
__device__ __forceinline__ void stage_rc(int b, int& R, int& C) { const int st = b / 1024, sb = b % 1024, swz = sb ^ (((sb >> 9) & 1) << 5); R = (st >> 1) * 16 + swz / 64; C = (st & 1) * 32 + (swz % 64) / 2; }
__device__ __forceinline__ int perm32(int rho) { const int n = rho >> 4, i = rho & 15; return 8 * (i >> 2) + 4 * n + (i & 3); }

struct Unit { int pm, pn, e; };
struct Gemm { const bf16_t* A; const bf16_t* Bt; int K; size_t bstride; const int* eslot; const PG8_LAS int* sb; };

struct StaticOrder {
    int nM, nN, nwg, G, c; const PG8_LAS int* sbase;
    __device__ void init(int M, int N, int G_, int c_, const PG8_LAS int* sb) { nM = M / BM; nN = N / BM; nwg = nM * nN; G = G_; c = c_; sbase = sb; }
    __device__ bool next(int i, Unit& u) const {
        const long Lx = (long)i * G + c; if (Lx >= nwg) return false;
        int wgid = (int)Lx; { const int q = nwg / NXCD, r = nwg % NXCD, xcd = wgid % NXCD, off = wgid / NXCD; wgid = (xcd < r ? xcd * (q + 1) : r * (q + 1) + (xcd - r) * q) + off; }
        const int nig = WGM * nN, gid = wgid / nig, fm = gid * WGM, gsz = (nM - fm) < WGM ? (nM - fm) : WGM;
        u.pm = fm + ((wgid % nig) % gsz); u.pn = (wgid % nig) / gsz; u.e = 0;
        if (sbase) { const int row = u.pm * BM; int e = 0;
#pragma unroll 1
            for (int j = 1; j < 32; ++j) e += (row >= sbase[j]) ? 1 : 0;
            u.e = e; }
        return true;
    }
};

template <class Epi, class Sched, bool GATHER, bool ALIGN_EPI, bool FP8 = false>
__device__ __forceinline__ void gemm_phase(PG8_LAS unsigned char* lds, const Gemm g, const Sched& S, const Epi& E) {
    int tid_ = threadIdx.x; asm volatile("" : "+v"(tid_));
    const int tid = tid_, wid = __builtin_amdgcn_readfirstlane(tid >> 6), lane = tid & 63, wr = wid >> 2, wc = wid & 3, fr = lane & 15, fq = lane >> 4;
    const int K = g.K, nt = K / BK;
    unsigned voffA[2], voffB[2];
#pragma unroll
    for (int i = 0; i < 2; ++i) { int R, C; stage_rc(tid * 16 + i * 8192, R, C); const int Rb = Epi::PERM ? ((R & ~31) + perm32(R & 31)) : R;
        voffA[i] = (unsigned)(R * K + C) * 2u; voffB[i] = (unsigned)(Rb * K + C) * 2u; }
    const size_t kstep = (size_t)(BK * 2);
    const size_t hstep = (size_t)HALF * K * 2;
    const size_t tstep = 2 * hstep;
    const unsigned ldsw = (unsigned)wid * 1024u;
    const int aoff = FP8 ? lds_byte(wr * 64 + fr, fq * 16) : lds_byte(wr * 64 + fr, fq * 8), boff = FP8 ? lds_byte(wc * 32 + fr, fq * 16) : lds_byte(wc * 32 + fr, fq * 8);
#define PG8_SA(b, h) (((b) * 2 + (h)) * HTB)
#define PG8_SB(b, h) ((4 + (b) * 2 + (h)) * HTB)
#define PG8_STAGE(bufoff, gbase, voff) do { _Pragma("unroll") for (int _i = 0; _i < 2; ++_i) \
        __builtin_amdgcn_global_load_lds((const unsigned*)((const char*)(gbase) + (voff)[_i]), (PG8_LAS unsigned*)(lds + (bufoff) + ldsw + _i * 8192), 16, 0, 0); } while (0)
#define PG8_CAT(lo_, hi_) __builtin_bit_cast(v8i, __builtin_shufflevector((lo_), (hi_), 0, 1, 2, 3, 4, 5, 6, 7, 8, 9, 10, 11, 12, 13, 14, 15))
#define PG8_LDA(dst, b, h) do { _Pragma("unroll") for (int m = 0; m < 4; ++m) { \
        if constexpr (FP8) dst##8[m] = PG8_CAT(*(const PG8_LAS bf16x8*)(lds + PG8_SA(b, h) + aoff + m * 2048), *(const PG8_LAS bf16x8*)(lds + PG8_SA(b, h) + aoff + m * 2048 + 16)); \
        else { _Pragma("unroll") for (int k = 0; k < 2; ++k) dst[m][k] = *(const PG8_LAS bf16x8*)(lds + PG8_SA(b, h) + aoff + m * 2048 + k * 1024); } } } while (0)
#define PG8_LDB(dst, b, h) do { _Pragma("unroll") for (int n = 0; n < 2; ++n) { \
        if constexpr (FP8) dst##8[n] = PG8_CAT(*(const PG8_LAS bf16x8*)(lds + PG8_SB(b, h) + boff + n * 2048), *(const PG8_LAS bf16x8*)(lds + PG8_SB(b, h) + boff + n * 2048 + 16)); \
        else { _Pragma("unroll") for (int k = 0; k < 2; ++k) dst[n][k] = *(const PG8_LAS bf16x8*)(lds + PG8_SB(b, h) + boff + n * 2048 + k * 1024); } } } while (0)
#define PG8_MMA(ai, bj, At, Bt) do { __builtin_amdgcn_s_setprio(1); _Pragma("unroll") for (int m = 0; m < 4; ++m) _Pragma("unroll") for (int n = 0; n < 2; ++n) { \
        if constexpr (FP8) asm volatile("v_mfma_scale_f32_16x16x128_f8f6f4 %0, %1, %2, %0, %3, %3 op_sel_hi:[0,0,0]" : "+v"(acc[ai][bj][m][n]) : "v"(Bt##8[n]), "v"(At##8[m]), "v"(one_scale)); \
        else { _Pragma("unroll") for (int k = 0; k < 2; ++k) acc[ai][bj][m][n] = __builtin_amdgcn_mfma_f32_16x16x32_bf16(Bt[n][k], At[m][k], acc[ai][bj][m][n], 0, 0, 0); } } \
        __builtin_amdgcn_s_setprio(0); } while (0)
#define PG8_WAIT_V(n) asm volatile("s_waitcnt vmcnt(" #n ")" ::: "memory")
#define PG8_WAIT_L(n) asm volatile("s_waitcnt lgkmcnt(" #n ")" ::: "memory")
#define PG8_BAR __builtin_amdgcn_s_barrier()
#define PG8_SCHED __builtin_amdgcn_sched_barrier(0)
#define PG8_SETOFF(off, u) do { _Pragma("unroll") for (int _h = 0; _h < 2; ++_h) _Pragma("unroll") for (int _i = 0; _i < 2; ++_i) { \
        if (GATHER) { int R_, C_; stage_rc(tid * 16 + _i * 8192, R_, C_); int rk_ = (u).pm * BM + _h * HALF + R_ - g.sb[(u).e]; const int cm_ = g.sb[40 + (u).e] - 1; rk_ = rk_ < cm_ ? rk_ : cm_; \
            off[_h][_i] = (unsigned)(g.eslot[(size_t)(u).e * ECAP + rk_] >> 2) * (unsigned)(K * 2) + (unsigned)(C_ * 2); } \
        else off[_h][_i] = voffA[_i] + (unsigned)(_h * hstep); } } while (0)
    Unit cur, nxt; int ui = 0;
    if (!S.next(0, cur)) return;
    f32x4 acc[2][2][4][2];
#pragma unroll
    for (int a = 0; a < 2; ++a)
#pragma unroll
        for (int b = 0; b < 2; ++b)
#pragma unroll
            for (int m = 0; m < 4; ++m)
#pragma unroll
                for (int n = 0; n < 2; ++n) acc[a][b][m][n] = (f32x4){0.f, 0.f, 0.f, 0.f};
    bf16x8 At[4][2], B0[2][2], B1[2][2];
    v8i At8[4], B08[2], B18[2];
    const int one_scale = 0x7f7f7f7f;
    unsigned offc[2][2], offn[2][2];
    PG8_SETOFF(offc, cur);
    const char* cA = GATHER ? (const char*)g.A : (const char*)g.A + (size_t)cur.pm * tstep;
    const char* cB = (const char*)g.Bt + (size_t)cur.e * g.bstride + (size_t)cur.pn * tstep;
    PG8_STAGE(PG8_SB(0, 0), cB, voffB); PG8_STAGE(PG8_SB(0, 1), cB + hstep, voffB); PG8_STAGE(PG8_SA(0, 0), cA, offc[0]); PG8_STAGE(PG8_SA(0, 1), cA, offc[1]);
    if (wr == 1) PG8_BAR;
    PG8_WAIT_V(2); PG8_BAR;
    PG8_STAGE(PG8_SB(1, 0), cB + kstep, voffB); PG8_STAGE(PG8_SA(1, 0), cA + kstep, offc[0]); PG8_STAGE(PG8_SB(1, 1), cB + hstep + kstep, voffB);
    PG8_WAIT_V(6); PG8_BAR;
    for (;;) {
        const bool has_next = S.next(ui + 1, nxt);
        const char* nA = GATHER ? cA : (has_next ? (const char*)g.A + (size_t)nxt.pm * tstep : cA);
        const char* nB = has_next ? (const char*)g.Bt + (size_t)nxt.e * g.bstride + (size_t)nxt.pn * tstep : cB;
        if (GATHER) { if (has_next) { PG8_SETOFF(offn, nxt); } else {
#pragma unroll
            for (int h = 0; h < 2; ++h)
#pragma unroll
                for (int i = 0; i < 2; ++i) offn[h][i] = offc[h][i]; } }
#pragma unroll 1
        for (int t = 0; t < nt; t += 2) {
            const bool last = (t == nt - 2);
            const char* a1 = cA + (size_t)(t + 1) * kstep;
            const char* a2 = last ? nA : cA + (size_t)(t + 2) * kstep; const char* b2 = last ? nB : cB + (size_t)(t + 2) * kstep;
            const char* a3 = a2 + kstep; const char* b3 = b2 + kstep;
            unsigned o2[2][2];
#pragma unroll
            for (int h = 0; h < 2; ++h)
#pragma unroll
                for (int i = 0; i < 2; ++i) o2[h][i] = (GATHER && last) ? offn[h][i] : offc[h][i];
            PG8_LDB(B0, 0, 0); PG8_LDB(B1, 0, 1); PG8_SCHED; PG8_LDA(At, 0, 0); PG8_STAGE(PG8_SA(1, 1), a1, offc[1]);
            PG8_WAIT_V(8); PG8_WAIT_L(0); PG8_BAR; PG8_MMA(0, 0, At, B0); PG8_MMA(0, 1, At, B1); PG8_BAR; PG8_SCHED;
            PG8_LDA(At, 0, 1); PG8_STAGE(PG8_SB(0, 0), b2, voffB); PG8_STAGE(PG8_SB(0, 1), b2 + hstep, voffB); PG8_STAGE(PG8_SA(0, 0), a2, o2[0]);
            PG8_WAIT_V(8); PG8_WAIT_L(0); PG8_BAR; PG8_MMA(1, 0, At, B0); PG8_MMA(1, 1, At, B1); PG8_BAR; PG8_SCHED;
            PG8_LDB(B0, 1, 0); PG8_LDB(B1, 1, 1); PG8_SCHED; PG8_LDA(At, 1, 0); PG8_STAGE(PG8_SA(0, 1), a2, o2[1]);
            PG8_WAIT_V(8); PG8_WAIT_L(0); PG8_BAR; PG8_MMA(0, 0, At, B0); PG8_MMA(0, 1, At, B1); PG8_BAR; PG8_SCHED;
            PG8_LDA(At, 1, 1); PG8_STAGE(PG8_SB(1, 0), b3, voffB); PG8_STAGE(PG8_SB(1, 1), b3 + hstep, voffB); PG8_STAGE(PG8_SA(1, 0), a3, o2[0]);
            PG8_WAIT_V(8); PG8_WAIT_L(0); PG8_BAR; PG8_MMA(1, 0, At, B0); PG8_MMA(1, 1, At, B1); PG8_BAR; PG8_SCHED;
        }
        if constexpr (ALIGN_EPI) { if (wr == 0) PG8_BAR; }
        if constexpr (FP8) asm volatile("s_nop 15\n\ts_nop 15" ::: "memory");
        E(acc, cur, wr, wc, fr, fq);
        if (!has_next) break;
#pragma unroll
        for (int a = 0; a < 2; ++a)
#pragma unroll
            for (int b = 0; b < 2; ++b)
#pragma unroll
                for (int m = 0; m < 4; ++m)
#pragma unroll
                    for (int n = 0; n < 2; ++n) acc[a][b][m][n] = (f32x4){0.f, 0.f, 0.f, 0.f};
        cur = nxt; cA = nA; cB = nB; ++ui;
#pragma unroll
        for (int h = 0; h < 2; ++h)
#pragma unroll
            for (int i = 0; i < 2; ++i) offc[h][i] = offn[h][i];
        if constexpr (ALIGN_EPI) { if (wr == 1) PG8_BAR; }
    }
    PG8_WAIT_V(0);
    if constexpr (!ALIGN_EPI) { if (wr == 0) PG8_BAR; }
    PG8_BAR;
#undef PG8_SA
#undef PG8_SB
#undef PG8_STAGE
#undef PG8_LDA
#undef PG8_LDB
#undef PG8_MMA
#undef PG8_WAIT_V
#undef PG8_WAIT_L
#undef PG8_BAR
#undef PG8_SCHED
#undef PG8_SETOFF
#undef PG8_CAT
}

struct EpiQKV {
    static constexpr bool PERM = false;
    bf16_t* O; const float* tab;
    __device__ __forceinline__ void operator()(const f32x4 (&acc)[2][2][4][2], const Unit& u, int wr, int wc, int fr, int fq) const {
        const bool latent = u.pm < NTOK / BM;
#pragma unroll
        for (int ai = 0; ai < 2; ++ai)
#pragma unroll
            for (int m = 0; m < 4; ++m) {
                const int row = u.pm * BM + ai * HALF + wr * 64 + m * 16 + fr;
                bf16_t* rowp = O + (size_t)row * INW + u.pn * BM + wc * 32 + 4 * fq;
                const int pos = row & (L - 1), pp = (wc & 1) ? (pos & 63) : (pos >> 6);
                const f32x4* tp = (const f32x4*)(tab + (pp * 16 + 4 * fq) * 2);
#pragma unroll
                for (int bj = 0; bj < 2; ++bj) {
                    const int colbase = u.pn * BM + bj * HALF;
                    f32x4 v0 = acc[ai][bj][m][0], v1 = acc[ai][bj][m][1];
                    if (latent && colbase < C_VA) {
                        const f32x4 t0 = tp[0], t1 = tp[1];
                        const f32x4 cs = {t0.x, t0.z, t1.x, t1.z}, sn = {t0.y, t0.w, t1.y, t1.w};
                        const f32x4 a0 = v0 * cs - v1 * sn, a1 = v1 * cs + v0 * sn; v0 = a0; v1 = a1;
                    }
                    if (colbase < C_KA || (colbase >= C_QB && colbase < C_KB)) { v0 = v0 * QSCALE; v1 = v1 * QSCALE; }
                    u32x2 w0, w1; w0.x = pk2(v0.x, v0.y); w0.y = pk2(v0.z, v0.w); w1.x = pk2(v1.x, v1.y); w1.y = pk2(v1.z, v1.w);
                    *(u32x2*)(rowp + bj * HALF) = w0; *(u32x2*)(rowp + bj * HALF + 16) = w1;
                }
            }
    }
};
struct EpiF32 {
    static constexpr bool PERM = false;
    float* O; int ldc;
    __device__ __forceinline__ void operator()(const f32x4 (&acc)[2][2][4][2], const Unit& u, int wr, int wc, int fr, int fq) const {
#pragma unroll
        for (int ai = 0; ai < 2; ++ai)
#pragma unroll
            for (int m = 0; m < 4; ++m) {
                float* rowp = O + (size_t)(u.pm * BM + ai * HALF + wr * 64 + m * 16 + fr) * ldc + u.pn * BM + wc * 32 + 4 * fq;
#pragma unroll
                for (int bj = 0; bj < 2; ++bj)
#pragma unroll
                    for (int n = 0; n < 2; ++n) *(f32x4*)(rowp + bj * HALF + 16 * n) = acc[ai][bj][m][n];
            }
    }
};
struct EpiSwiglu {
    static constexpr bool PERM = false;
    unsigned char* act; const float* b1;
    __device__ __forceinline__ void operator()(const f32x4 (&acc)[2][2][4][2], const Unit& u, int wr, int wc, int fr, int fq) const {
#pragma unroll
        for (int bj = 0; bj < 2; ++bj) {
            const int f0 = 16 * (8 * u.pn + 4 * bj + wc) + 4 * fq;
            const f32x4* bp = (const f32x4*)(b1 + (size_t)u.e * 2048 + 2 * f0); const f32x4 bA = bp[0], bB = bp[1];
            const f32x4 bg = {bA.x, bA.z, bB.x, bB.z}, bl = {bA.y, bA.w, bB.y, bB.w};
#pragma unroll
            for (int ai = 0; ai < 2; ++ai)
#pragma unroll
                for (int m = 0; m < 4; ++m) {
                    const int row = u.pm * BM + ai * HALF + wr * 64 + m * 16 + fr;
                    const f32x4 gt = acc[ai][bj][m][0] * W8_INV + bg, ln = acc[ai][bj][m][1] * W8_INV + bl; float a[4];
#pragma unroll
                    for (int j = 0; j < 4; ++j) { const float gg = fminf(gt[j], 7.f), ll = fminf(fmaxf(ln[j], -7.f), 7.f);
                        a[j] = gg * __builtin_amdgcn_rcpf(1.f + __expf(-1.702f * gg)) * (ll + 1.f); }
                    *(unsigned*)(act + (size_t)row * D + f0) = pk4_fp8(a[0], a[1], a[2], a[3]);
                }
        }
    }
};
struct EpiScatter {
    static constexpr bool PERM = true;
    bf16_t* y; const float* b2; const int* eslot; const float* ew; const PG8_LAS int* sb;
    __device__ __forceinline__ void operator()(const f32x4 (&acc)[2][2][4][2], const Unit& u, int wr, int wc, int fr, int fq) const {
        const int col0 = u.pn * BM + wc * 32 + 8 * fq;
        f32x4 bv[2][2];
#pragma unroll
        for (int bj = 0; bj < 2; ++bj)
#pragma unroll
            for (int n = 0; n < 2; ++n) bv[bj][n] = *(const f32x4*)(b2 + (size_t)u.e * D + col0 + bj * HALF + 4 * n);
#pragma unroll
        for (int ai = 0; ai < 2; ++ai)
#pragma unroll
            for (int m = 0; m < 4; ++m) {
                const int row = u.pm * BM + ai * HALF + wr * 64 + m * 16 + fr;
                const int rk = row - sb[u.e], cn = sb[40 + u.e]; const int rkc = rk < cn - 1 ? rk : cn - 1;
                const int slot = eslot[(size_t)u.e * ECAP + rkc]; const float w = ew[(size_t)u.e * ECAP + rkc];
                if (rk < cn) {
                    bf16_t* rowp = y + (size_t)slot * D + col0;
#pragma unroll
                    for (int bj = 0; bj < 2; ++bj) { const f32x4 v0 = (acc[ai][bj][m][0] * W8_INV + bv[bj][0]) * w, v1 = (acc[ai][bj][m][1] * W8_INV + bv[bj][1]) * w;
                        u32x4 o; o.x = pk2(v0.x, v0.y); o.y = pk2(v0.z, v0.w); o.z = pk2(v1.x, v1.y); o.w = pk2(v1.z, v1.w);
                        *(u32x4*)(rowp + bj * HALF) = o; }
                }
            }
    }
};
}

__device__ void p0_mod(const Params& p, float* sS  , float* sP  ) {
    float* mod = (float*)(p.ws + WS_MOD);
    const int tid = threadIdx.x, lane = tid & 63, wave = tid >> 6;
    if (blockIdx.x >= 96) return;
    for (int i = tid; i < 9 * D; i += NTHREADS) { const int r = i >> 10, k = i & 1023; const float cc = r < 8 ? p.c[r * D + k] : p.c_ctx[k]; sS[i] = cc / (1.f + __expf(-cc)); }
    __syncthreads();
    const int j = blockIdx.x * 64 + lane;
    float acc[9];
#pragma unroll
    for (int r = 0; r < 9; ++r) acc[r] = 0.f;
    const float* wp = p.w_ada + (size_t)(wave * 128) * 6144 + j;
#pragma unroll 1
    for (int k0 = 0; k0 < 128; k0 += 16) {
        float w[16];
#pragma unroll
        for (int kk = 0; kk < 16; ++kk) w[kk] = wp[(size_t)(k0 + kk) * 6144];
#pragma unroll
        for (int kk = 0; kk < 16; ++kk)
#pragma unroll
            for (int r = 0; r < 9; ++r) acc[r] = fmaf(sS[r * D + wave * 128 + k0 + kk], w[kk], acc[r]);
    }
#pragma unroll
    for (int r = 0; r < 9; ++r) sP[(wave * 9 + r) * 64 + lane] = acc[r];
    __syncthreads();
    for (int i = tid; i < 9 * 64; i += NTHREADS) { const int r = i >> 6, jj = i & 63; float s = p.b_ada[blockIdx.x * 64 + jj];
#pragma unroll
        for (int w = 0; w < 8; ++w) s += sP[(w * 9 + r) * 64 + jj];
        mod[r * 6144 + blockIdx.x * 64 + jj] = s; }
    __syncthreads();
}
__device__ void p0_tab(const Params& p, int gtid, int gsize) {
    float* tab = (float*)(p.ws + WS_TAB);
    for (int idx = gtid; idx < 64 * 16; idx += gsize) {
        const int pos = idx >> 4, i = idx & 15;
        const float freq = exp2f(-(float)i * (13.287712379549449f / 16.f));
        const float ang = (float)pos * freq;
        const float n = rintf(ang * 0.15915494309189535f);
        float r = fmaf(-n, 6.28125f, ang); r = fmaf(-n, 1.9353071795864769e-3f, r);
        tab[idx * 2] = __cosf(r); tab[idx * 2 + 1] = __sinf(r);
    }
}
template <int MODE>
__device__ __forceinline__ void conv_item(const float* src, int K, int N, bf16_t* dst, int item, float* scr, int lane, const float* gA, const float* gB) {
    const int nblk = N / 32, kb = item / nblk, nb = item % nblk, k0 = 64 * kb, n0 = 32 * nb;
    const int c = lane & 31, kh = lane >> 5;
    const int nl = MODE == 1 ? 16 * (c & 1) + (c >> 1) : c;
    float v[32];
    const float* sp = src + (size_t)(k0 + kh) * N + n0 + c;
#pragma unroll
    for (int i = 0; i < 32; ++i) v[i] = sp[(size_t)(2 * i) * N];
#pragma unroll
    for (int i = 0; i < 32; ++i) { float x = v[i]; if (MODE == 2) { const int k = k0 + 2 * i + kh; x *= (k < 512 ? gA[k] : gB[k - 512]); } scr[(2 * i + kh) * 33 + nl] = x; }
    asm volatile("s_waitcnt lgkmcnt(0)" ::: "memory");
    const int ch = lane & 7;
#pragma unroll
    for (int j = 0; j < 4; ++j) { const int n = (lane >> 3) + 8 * j; const float* s = scr + (8 * ch) * 33 + n;
        u32x4 o; o.x = pk2(s[0 * 33], s[1 * 33]); o.y = pk2(s[2 * 33], s[3 * 33]); o.z = pk2(s[4 * 33], s[5 * 33]); o.w = pk2(s[6 * 33], s[7 * 33]);
        *(u32x4*)(dst + (size_t)(n0 + n) * K + k0 + 8 * ch) = o; }
    asm volatile("s_waitcnt lgkmcnt(0)" ::: "memory");
}
template <bool PERM1>
__device__ __forceinline__ void conv_item8(const float* src, int K, int N, unsigned char* dst, int item, float* scr, int lane) {
    const int nblk = N / 32, kb = item / nblk, nb = item % nblk, k0 = 64 * kb, n0 = 32 * nb;
    const int c = lane & 31, kh = lane >> 5;
    const int nl = PERM1 ? 16 * (c & 1) + (c >> 1) : c;
    float v[32];
    const float* sp = src + (size_t)(k0 + kh) * N + n0 + c;
#pragma unroll
    for (int i = 0; i < 32; ++i) v[i] = sp[(size_t)(2 * i) * N];
#pragma unroll
    for (int i = 0; i < 32; ++i) scr[(2 * i + kh) * 33 + nl] = v[i] * W8_SCALE;
    asm volatile("s_waitcnt lgkmcnt(0)" ::: "memory");
    const int ch = lane & 3;
#pragma unroll
    for (int j = 0; j < 2; ++j) { const int n = (lane >> 2) + 16 * j; const float* s = scr + (16 * ch) * 33 + n;
        u32x4 o; o.x = pk4_fp8(s[0 * 33], s[1 * 33], s[2 * 33], s[3 * 33]); o.y = pk4_fp8(s[4 * 33], s[5 * 33], s[6 * 33], s[7 * 33]);
        o.z = pk4_fp8(s[8 * 33], s[9 * 33], s[10 * 33], s[11 * 33]); o.w = pk4_fp8(s[12 * 33], s[13 * 33], s[14 * 33], s[15 * 33]);
        *(u32x4*)(dst + (size_t)(n0 + n) * K + k0 + 16 * ch) = o; }
    asm volatile("s_waitcnt lgkmcnt(0)" ::: "memory");
}
__device__ void p0_weights(const Params& p, float* scr, int gw, int ngw, int lane) {
    constexpr int I_IN = 16 * 72, I_OUT = 16 * 32, I_W1 = 16 * 64, I_W2 = 16 * 32;
    constexpr int NITEMS = I_IN + I_OUT + NE * I_W1 + NE * I_W2;
    for (int it = gw; it < NITEMS; it += ngw) {
        int r = it;
        if (r < I_IN) { conv_item<0>(p.w_in, D, INW, (bf16_t*)(p.ws + WS_WIN), r, scr, lane, nullptr, nullptr); continue; } r -= I_IN;
        if (r < I_OUT) { conv_item<2>(p.w_out, D, D, (bf16_t*)(p.ws + WS_WOUT), r, scr, lane, p.g_grp_a, p.g_grp_b); continue; } r -= I_OUT;
        if (r < NE * I_W1) { const int e = r / I_W1, q = r % I_W1;
            conv_item8<true>(p.w_mlp1 + (size_t)e * D * 2048, D, 2048, p.ws + WS_W1 + (size_t)e * 2048 * D, q, scr, lane); continue; } r -= NE * I_W1;
        { const int e = r / I_W2, q = r % I_W2;
            conv_item8<false>(p.w_mlp2 + (size_t)e * D * D, D, D, p.ws + WS_W2 + (size_t)e * D * D, q, scr, lane); }
    }
}

__device__ void p1_h(const Params& p, int lane) {
    const float* mod = (const float*)(p.ws + WS_MOD);
    bf16_t* hb = (bf16_t*)(p.ws + WS_HB);
    constexpr int R = 17;
    const int gwv = blockIdx.x * (NTHREADS / 64) + (threadIdx.x >> 6);
    const int m0 = gwv * R; if (m0 >= MROWS) return;
    const int m1 = m0 + R < MROWS ? m0 + R : MROWS;
    f32x4 pB[4], pC[4], v[4], nv[4]; int curb = -1;
#define P1_ROWPTR(m) ((m) < NTOK ? p.x + (size_t)(m) * D : p.ctx + (size_t)((m) - NTOK) * D)
    { const float* xr = P1_ROWPTR(m0);
#pragma unroll
      for (int j = 0; j < 4; ++j) nv[j] = ((const f32x4*)xr)[lane + 64 * j]; }
    for (int m = m0; m < m1; ++m) {
#pragma unroll
        for (int j = 0; j < 4; ++j) v[j] = nv[j];
        if (m + 1 < m1) { const float* xr = P1_ROWPTR(m + 1);
#pragma unroll
            for (int j = 0; j < 4; ++j) nv[j] = ((const f32x4*)xr)[lane + 64 * j]; }
        const int b = m < NTOK ? m / L : 8;
        if (b != curb) { curb = b; const float* sh = mod + b * 6144, * sc = sh + 1024;
#pragma unroll
            for (int j = 0; j < 4; ++j) { const int c0 = 4 * (lane + 64 * j); pB[j] = *(const f32x4*)(p.g_pre_mix + c0) * (*(const f32x4*)(sc + c0) + 1.f); pC[j] = *(const f32x4*)(sh + c0); } }
        float s = 0.f;
#pragma unroll
        for (int j = 0; j < 4; ++j) s += v[j].x * v[j].x + v[j].y * v[j].y + v[j].z * v[j].z + v[j].w * v[j].w;
        const float rstd = rsqrtf(wave_sum(s) * (1.f / D) + EPS);
#pragma unroll
        for (int j = 0; j < 4; ++j) { const int c0 = 4 * (lane + 64 * j);
            const f32x4 o = (v[j] * rstd) * pB[j] + pC[j];
            u32x2 w; w.x = pk2(o.x, o.y); w.y = pk2(o.z, o.w);
            *(u32x2*)(hb + (size_t)m * D + c0) = w; }
    }
#undef P1_ROWPTR
}

template <class AL, class BL, class EP>
__device__ __forceinline__ void ngemm_tile(float* sA, float* sB, int m0, int n0, int K, const AL& aload, const BL& bload, const EP& epi) {
    const int tid = threadIdx.x, ty = tid >> 4, tx = tid & 15;
    float acc[4][4];
#pragma unroll
    for (int i = 0; i < 4; ++i)
#pragma unroll
        for (int j = 0; j < 4; ++j) acc[i][j] = 0.f;
    for (int k0 = 0; k0 < K; k0 += 16) {
#pragma unroll
        for (int i = 0; i < 4; ++i) { const int e = tid + NTHREADS * i, r = e >> 4, kk = e & 15; sA[kk * 132 + r] = aload(m0 + r, k0 + kk); }
#pragma unroll
        for (int i = 0; i < 2; ++i) { const int e = tid + NTHREADS * i, n = e >> 4, kk = e & 15; sB[kk * 68 + n] = bload(n0 + n, k0 + kk); }
        __syncthreads();
#pragma unroll
        for (int kk = 0; kk < 16; ++kk) {
            float a[4], b[4];
#pragma unroll
            for (int i = 0; i < 4; ++i) a[i] = sA[kk * 132 + ty * 4 + i];
#pragma unroll
            for (int j = 0; j < 4; ++j) b[j] = sB[kk * 68 + tx + 16 * j];
#pragma unroll
            for (int i = 0; i < 4; ++i)
#pragma unroll
                for (int j = 0; j < 4; ++j) acc[i][j] = fmaf(a[i], b[j], acc[i][j]);
        }
        __syncthreads();
    }
    epi(m0 + ty * 4, n0, tx, acc);
}

__device__ void p2_qkv_naive(const Params& p, float* sA, float* sB) {
    const bf16_t* hb = (const bf16_t*)(p.ws + WS_HB); const bf16_t* wT = (const bf16_t*)(p.ws + WS_WIN);
    bf16_t* qkv = (bf16_t*)(p.ws + WS_QKV); const float* tab = (const float*)(p.ws + WS_TAB);
    constexpr int NTN = INW / 64, NT = (MROWS / 128) * NTN;
    for (int t = blockIdx.x; t < NT; t += gridDim.x) {
        const int m0 = (t / NTN) * 128, n0 = (t % NTN) * 64;
        auto al = [&](int r, int k) { return bf2f(hb[(size_t)r * D + k]); };
        auto bl = [&](int n, int k) { return bf2f(wT[(size_t)n * D + k]); };
        auto ep = [&](int r0, int nn0, int tx, float (&acc)[4][4]) {
#pragma unroll
            for (int i = 0; i < 4; ++i) {
                const int r = r0 + i; float v0 = acc[i][0], v1 = acc[i][1], v2 = acc[i][2], v3 = acc[i][3];
                const bool rope = (nn0 < C_VA) && (r < NTOK);
                if (rope) { const int t = r & (L - 1), pr = t >> 6, pc = t & 63;
                    const float c0 = tab[(pr * 16 + tx) * 2], s0 = tab[(pr * 16 + tx) * 2 + 1], c1 = tab[(pc * 16 + tx) * 2], s1 = tab[(pc * 16 + tx) * 2 + 1];
                    const float a0 = v0 * c0 - v1 * s0, a1 = v1 * c0 + v0 * s0, a2 = v2 * c1 - v3 * s1, a3 = v3 * c1 + v2 * s1; v0 = a0; v1 = a1; v2 = a2; v3 = a3; }
                const bool isq = (nn0 < C_KA) || (nn0 >= C_QB && nn0 < C_KB);
                if (isq) { v0 *= QSCALE; v1 *= QSCALE; v2 *= QSCALE; v3 *= QSCALE; }
                bf16_t* o = qkv + (size_t)r * INW + nn0 + tx;
                o[0] = (bf16_t)f2bf(v0); o[16] = (bf16_t)f2bf(v1); o[32] = (bf16_t)f2bf(v2); o[48] = (bf16_t)f2bf(v3);
            }
        };
        ngemm_tile(sA, sB, m0, n0, D, al, bl, ep);
    }
}

__device__ __forceinline__ void load_row64(const bf16_t* src, float* dst) {
#pragma unroll
    for (int c = 0; c < 8; ++c) { const u32x4 w = *(const u32x4*)(src + c * 8);
        dst[c * 8 + 0] = __uint_as_float(w.x << 16); dst[c * 8 + 1] = __uint_as_float(w.x & 0xffff0000u);
        dst[c * 8 + 2] = __uint_as_float(w.y << 16); dst[c * 8 + 3] = __uint_as_float(w.y & 0xffff0000u);
        dst[c * 8 + 4] = __uint_as_float(w.z << 16); dst[c * 8 + 5] = __uint_as_float(w.z & 0xffff0000u);
        dst[c * 8 + 6] = __uint_as_float(w.w << 16); dst[c * 8 + 7] = __uint_as_float(w.w & 0xffff0000u); }
}
struct OnlineSm { float m, l; };
__device__ __forceinline__ void attn_key(const float (&q)[64], float (&o)[64], OnlineSm& st, const bf16_t* krow, const bf16_t* vrow, float bias) {
    float s = bias;
#pragma unroll
    for (int c = 0; c < 8; ++c) { const u32x4 w = *(const u32x4*)(krow + c * 8);
        s = fmaf(q[c * 8 + 0], __uint_as_float(w.x << 16), s); s = fmaf(q[c * 8 + 1], __uint_as_float(w.x & 0xffff0000u), s);
        s = fmaf(q[c * 8 + 2], __uint_as_float(w.y << 16), s); s = fmaf(q[c * 8 + 3], __uint_as_float(w.y & 0xffff0000u), s);
        s = fmaf(q[c * 8 + 4], __uint_as_float(w.z << 16), s); s = fmaf(q[c * 8 + 5], __uint_as_float(w.z & 0xffff0000u), s);
        s = fmaf(q[c * 8 + 6], __uint_as_float(w.w << 16), s); s = fmaf(q[c * 8 + 7], __uint_as_float(w.w & 0xffff0000u), s); }
    const float mn = fmaxf(st.m, s), sc = exp2f(st.m - mn), pp = exp2f(s - mn);
    st.l = st.l * sc + pp; st.m = mn;
#pragma unroll
    for (int c = 0; c < 8; ++c) { const u32x4 w = *(const u32x4*)(vrow + c * 8);
        o[c * 8 + 0] = fmaf(pp, __uint_as_float(w.x << 16), o[c * 8 + 0] * sc); o[c * 8 + 1] = fmaf(pp, __uint_as_float(w.x & 0xffff0000u), o[c * 8 + 1] * sc);
        o[c * 8 + 2] = fmaf(pp, __uint_as_float(w.y << 16), o[c * 8 + 2] * sc); o[c * 8 + 3] = fmaf(pp, __uint_as_float(w.y & 0xffff0000u), o[c * 8 + 3] * sc);
        o[c * 8 + 4] = fmaf(pp, __uint_as_float(w.z << 16), o[c * 8 + 4] * sc); o[c * 8 + 5] = fmaf(pp, __uint_as_float(w.z & 0xffff0000u), o[c * 8 + 5] * sc);
        o[c * 8 + 6] = fmaf(pp, __uint_as_float(w.w << 16), o[c * 8 + 6] * sc); o[c * 8 + 7] = fmaf(pp, __uint_as_float(w.w & 0xffff0000u), o[c * 8 + 7] * sc); }
}
__device__ __forceinline__ void store_o64(bf16_t* dst, const float (&o)[64], float inv) {
#pragma unroll
    for (int c = 0; c < 8; ++c) { u32x4 w; w.x = pk2(o[c * 8] * inv, o[c * 8 + 1] * inv); w.y = pk2(o[c * 8 + 2] * inv, o[c * 8 + 3] * inv);
        w.z = pk2(o[c * 8 + 4] * inv, o[c * 8 + 5] * inv); w.w = pk2(o[c * 8 + 6] * inv, o[c * 8 + 7] * inv); *(u32x4*)(dst + c * 8) = w; }
}
__device__ void p3_attn_naive(const Params& p, int gtid, int gsize) {
    const bf16_t* qkv = (const bf16_t*)(p.ws + WS_QKV); bf16_t* ob = (bf16_t*)(p.ws + WS_O);
    for (int it = gtid; it < NTOK * 16; it += gsize) {
        const bool isB = it >= NTOK * 8; const int w = isB ? it - NTOK * 8 : it;
        const int h = w & 7, tokg = w >> 3, b = tokg / L, t = tokg % L;
        float q[64], o[64];
#pragma unroll
        for (int d = 0; d < 64; ++d) o[d] = 0.f;
        OnlineSm st;
        if (!isB) {
            const int kvh = h >> 2;
            load_row64(qkv + (size_t)tokg * INW + C_QA + h * 64, q);
            st.m = p.sink_a[h] * LOG2E; st.l = 1.f;
            const int j0 = t - 128 < 0 ? 0 : t - 128, j1 = t + 128 > L - 1 ? L - 1 : t + 128;
            for (int j = j0; j <= j1; ++j) { const bf16_t* row = qkv + (size_t)(b * L + j) * INW; attn_key(q, o, st, row + C_KA + kvh * 64, row + C_VA + kvh * 64, 0.f); }
            for (int c = 0; c < CTX; ++c) { const bf16_t* row = qkv + (size_t)(NTOK + b * CTX + c) * INW; attn_key(q, o, st, row + C_KA + kvh * 64, row + C_VA + kvh * 64, 0.f); }
            store_o64(ob + (size_t)tokg * D + h * 64, o, 1.f / st.l);
        } else {
            load_row64(qkv + (size_t)tokg * INW + C_QB + h * 64, q);
            st.m = -1e30f; st.l = 0.f;
            const int r = t >> 6, c = t & 63;
            const int rs = r - 4 < 0 ? 0 : (r - 4 > 56 ? 56 : r - 4), cs = c - 8 < 0 ? 0 : (c - 8 > 48 ? 48 : c - 8);
            for (int a = 0; a < 8; ++a)
                for (int e = 0; e < 16; ++e) { const int kr = rs + a, kc = cs + e; const bf16_t* row = qkv + (size_t)(b * L + kr * 64 + kc) * INW;
                    const float bias = p.rpb_b[(h * 15 + (kr - r + 7)) * 31 + (kc - c + 15)] * LOG2E;
                    attn_key(q, o, st, row + C_KB + h * 64, row + C_VB + h * 64, bias); }
            for (int cc = 0; cc < CTX; ++cc) { const bf16_t* row = qkv + (size_t)(NTOK + b * CTX + cc) * INW; attn_key(q, o, st, row + C_KB + h * 64, row + C_VB + h * 64, 0.f); }
            store_o64(ob + (size_t)tokg * D + 512 + h * 64, o, 1.f / st.l);
        }
    }
}


namespace att {
#define ATT_LAS __attribute__((address_space(3)))
typedef float f32x16 __attribute__((ext_vector_type(16)));
typedef short bf16x8 __attribute__((ext_vector_type(8)));
typedef short s16x4 __attribute__((ext_vector_type(4)));
constexpr int SLOTB = 8192;
constexpr int LDS_K = 0, LDS_V = 2 * SLOTB, LDS_WS = 4 * SLOTB, LDS_BT = LDS_WS + 8 * 256;
constexpr int BT_MARGIN = 64, BT_FLOATS = BT_MARGIN + 15 * 32 + 96;
constexpr float NEGBIG = -1e30f;
__device__ __forceinline__ int crow(int r, int hi) { return (r & 3) + 8 * (r >> 2) + 4 * hi; }
__device__ __forceinline__ unsigned cvtpk(float lo, float hi) { typedef float f2 __attribute__((ext_vector_type(2))); typedef __bf16 b2 __attribute__((ext_vector_type(2)));
    f2 v = {lo, hi}; b2 b = __builtin_convertvector(v, b2); return __builtin_bit_cast(unsigned, b); }
__device__ __forceinline__ s16x4 vtr(const ATT_LAS unsigned char* p) { typedef short v4i16 __attribute__((ext_vector_type(4)));
    return __builtin_bit_cast(s16x4, __builtin_amdgcn_ds_read_tr16_b64_v4i16((ATT_LAS v4i16*)p)); }
#define ATT_WAIT_BAR(N) asm volatile("s_waitcnt vmcnt(" #N ") lgkmcnt(0)\n\ts_barrier" ::: "memory")

__device__ __forceinline__ void dma_tile(ATT_LAS unsigned char* lds, int slot, const bf16_t* kbase, const bf16_t* vbase, int wid, int lane) {
    const bf16_t* ksrc = kbase + (size_t)lane * INW + wid * 8;
    const bf16_t* vsrc = vbase + (size_t)(16 * (wid & 3) + (lane >> 2)) * INW + (wid >> 2) * 32 + (lane & 3) * 8;
    __builtin_amdgcn_global_load_lds((const unsigned*)ksrc, (ATT_LAS unsigned*)(lds + LDS_K + slot * SLOTB + wid * 1024), 16, 0, 0);
    __builtin_amdgcn_global_load_lds((const unsigned*)vsrc, (ATT_LAS unsigned*)(lds + LDS_V + slot * SLOTB + wid * 1024), 16, 0, 0);
}

template <bool ISB>
__device__ __forceinline__ void attn_unit(const Params& p, ATT_LAS unsigned char* lds, int unit) {
    int tid_ = threadIdx.x; asm volatile("" : "+v"(tid_));
    const int tid = tid_, lane = tid & 63, r32 = lane & 31, hi = lane >> 5; const int wid = __builtin_amdgcn_readfirstlane(tid >> 6);
    const bf16_t* qkv = (const bf16_t*)(p.ws + WS_QKV); bf16_t* ob = (bf16_t*)(p.ws + WS_O);
    ATT_LAS float* wsf = (ATT_LAS float*)(lds + LDS_WS) + wid * 64;
    ATT_LAS float* bt = (ATT_LAS float*)(lds + LDS_BT);
    int b, h, kcol, vcol, qcol, ocol, q0, nloc, row_lo = 0, qr = 0, half = 0, qb = 0, jlo = 0;
    if (!ISB) { b = unit >> 7; const int kvh = (unit >> 6) & 1; qb = unit & 63; h = kvh * 4 + (wid >> 1); half = wid & 1; q0 = qb * 64 + 32 * half;
        kcol = C_KA + kvh * 64; vcol = C_VA + kvh * 64; qcol = C_QA + h * 64; ocol = h * 64;
        jlo = 2 - qb > 0 ? 2 - qb : 0; const int jhi = 65 - qb < 4 ? 65 - qb : 4; nloc = jhi - jlo + 1;
    } else { b = unit >> 7; h = (unit >> 4) & 7; const int g = unit & 15; qr = 4 * g + (wid >> 1); half = wid & 1; q0 = qr * 64 + 32 * half;
        kcol = C_KB + h * 64; vcol = C_VB + h * 64; qcol = C_QB + h * 64; ocol = 512 + h * 64;
        const int r0 = 4 * g, r3 = 4 * g + 3; row_lo = r0 - 4 < 0 ? 0 : (r0 - 4 > 56 ? 56 : r0 - 4); const int rs3 = r3 - 4 < 0 ? 0 : (r3 - 4 > 56 ? 56 : r3 - 4); nloc = rs3 + 7 - row_lo + 1;
    }
    const int NT = nloc + 4;
    const bf16_t* lat = qkv + (size_t)b * L * INW; const bf16_t* cx = qkv + (size_t)(NTOK + b * CTX) * INW;
#define ATT_TILE_ROW(t) ((t) < nloc ? lat + (size_t)(ISB ? (row_lo + (t)) * 64 : (qb - 2 + jlo + (t)) * 64) * INW : cx + (size_t)((t) - nloc) * 64 * INW)
    if (ISB) {
        for (int i = tid; i < BT_FLOATS; i += NTHREADS) { const int j = i - BT_MARGIN; float v = 0.f;
            if (j >= 0 && j < 15 * 32 && (j & 31) < 31) v = p.rpb_b[(h * 15 + (j >> 5)) * 31 + (j & 31)] * LOG2E;
            bt[i] = v; }
    }
    { const bf16_t* r0p = ATT_TILE_ROW(0); dma_tile(lds, 0, r0p + kcol, r0p + vcol, wid, lane); }
    bf16x8 qf[4];
    { const bf16_t* qp = lat + (size_t)(q0 + r32) * INW + qcol + hi * 8;
#pragma unroll
      for (int d0 = 0; d0 < 4; ++d0) qf[d0] = *(const bf16x8*)(qp + d0 * 16); }
    float m_run, l_run;
    if (!ISB) { m_run = p.sink_a[h] * LOG2E; l_run = hi == 0 ? 1.f : 0.f; } else { m_run = NEGBIG; l_run = 0.f; }
    f32x16 o0, o1;
#pragma unroll
    for (int r = 0; r < 16; ++r) { o0[r] = 0.f; o1[r] = 0.f; }
    const int qc = 32 * half + r32;
    const int cs = qc - 8 < 0 ? 0 : (qc - 8 > 48 ? 48 : qc - 8);
    const int rsq = qr - 4 < 0 ? 0 : (qr - 4 > 56 ? 56 : qr - 4);
    for (int t = 0; t < NT; ++t) {
        if (t + 1 < NT) { const bf16_t* rp = ATT_TILE_ROW(t + 1); dma_tile(lds, (t + 1) & 1, rp + kcol, rp + vcol, wid, lane); ATT_WAIT_BAR(2); }
        else { ATT_WAIT_BAR(0); }
        const int slot = t & 1;
        bool active = true; int kr = 0;
        if (ISB && t < nloc) { kr = row_lo + t; active = (kr >= rsq) && (kr <= rsq + 7); }
        if (active) {
            const ATT_LAS unsigned char* kb = lds + LDS_K + slot * SLOTB + hi * 1024 + r32 * 16;
            f32x16 p0, p1;
#pragma unroll
            for (int r = 0; r < 16; ++r) { p0[r] = 0.f; p1[r] = 0.f; }
#pragma unroll
            for (int d0 = 0; d0 < 4; ++d0) {
                const bf16x8 k0 = *(const ATT_LAS bf16x8*)(kb + d0 * 2048), k1 = *(const ATT_LAS bf16x8*)(kb + d0 * 2048 + 512);
                p0 = __builtin_amdgcn_mfma_f32_32x32x16_bf16(k0, qf[d0], p0, 0, 0, 0);
                p1 = __builtin_amdgcn_mfma_f32_32x32x16_bf16(k1, qf[d0], p1, 0, 0, 0);
            }
            if (ISB) {
                if (t < nloc) {
                    const ATT_LAS float* bp = bt + BT_MARGIN + (kr - qr + 7) * 32 + 15 - qc + 4 * hi;
                    const int e0 = 4 * hi - cs;
#pragma unroll
                    for (int r = 0; r < 16; ++r) { const int c = (r & 3) + 8 * (r >> 2);
                        const float b0 = bp[c], b1 = bp[c + 32];
                        p0[r] = ((unsigned)(c + e0) < 16u) ? p0[r] + b0 : NEGBIG;
                        p1[r] = ((unsigned)(c + 32 + e0) < 16u) ? p1[r] + b1 : NEGBIG; }
                }
            } else {
                if (t < nloc) { const int j = jlo + t; const int qq = 32 * half + r32;
                    if (j == 0) {
#pragma unroll
                        for (int r = 0; r < 16; ++r) { const int c = crow(r, hi); if (c < qq) p0[r] = NEGBIG; if (c + 32 < qq) p1[r] = NEGBIG; }
                    } else if (j == 4) {
#pragma unroll
                        for (int r = 0; r < 16; ++r) { const int c = crow(r, hi); if (c > qq) p0[r] = NEGBIG; if (c + 32 > qq) p1[r] = NEGBIG; }
                    }
                }
            }
            float rm = fmaxf(p0[0], p1[0]);
#pragma unroll
            for (int r = 1; r < 16; ++r) rm = fmaxf(rm, fmaxf(p0[r], p1[r]));
            rm = fmaxf(rm, __shfl_xor(rm, 32));
            const float mnew = fmaxf(m_run, rm);
            if (__any(mnew > m_run)) {
                const float f = __builtin_amdgcn_exp2f(m_run - mnew);
                l_run *= f; m_run = mnew;
                if (hi == 0) wsf[r32] = f;
                asm volatile("s_waitcnt lgkmcnt(0)" ::: "memory");
#pragma unroll
                for (int r = 0; r < 16; ++r) { const float fr_ = wsf[crow(r, hi)]; o0[r] *= fr_; o1[r] *= fr_; }
            }
            float ls = 0.f;
#pragma unroll
            for (int r = 0; r < 16; ++r) { p0[r] = __builtin_amdgcn_exp2f(p0[r] - m_run); p1[r] = __builtin_amdgcn_exp2f(p1[r] - m_run); ls += p0[r] + p1[r]; }
            l_run += ls;
            typedef unsigned u4 __attribute__((ext_vector_type(4)));
            const u4 pw0 = {cvtpk(p0[0], p0[1]), cvtpk(p0[2], p0[3]), cvtpk(p0[4], p0[5]), cvtpk(p0[6], p0[7])};
            const u4 pw1 = {cvtpk(p0[8], p0[9]), cvtpk(p0[10], p0[11]), cvtpk(p0[12], p0[13]), cvtpk(p0[14], p0[15])};
            const u4 pw2 = {cvtpk(p1[0], p1[1]), cvtpk(p1[2], p1[3]), cvtpk(p1[4], p1[5]), cvtpk(p1[6], p1[7])};
            const u4 pw3 = {cvtpk(p1[8], p1[9]), cvtpk(p1[10], p1[11]), cvtpk(p1[12], p1[13]), cvtpk(p1[14], p1[15])};
            const ATT_LAS unsigned char* vp = lds + LDS_V + slot * SLOTB + ((lane >> 4) & 1) * 32 + (lane & 3) * 8 + (4 * hi + ((lane & 15) >> 2)) * 64;
#define ATT_PV(OACC, PW, D0, KS) do { const s16x4 lo_ = vtr(vp + (D0) * 4096 + (KS) * 1024), hi_ = vtr(vp + (D0) * 4096 + (KS) * 1024 + 512); \
                const bf16x8 vf_ = {lo_[0], lo_[1], lo_[2], lo_[3], hi_[0], hi_[1], hi_[2], hi_[3]}; \
                OACC = __builtin_amdgcn_mfma_f32_32x32x16_bf16(__builtin_bit_cast(bf16x8, PW), vf_, OACC, 0, 0, 0); } while (0)
            ATT_PV(o0, pw0, 0, 0); ATT_PV(o1, pw0, 1, 0); ATT_PV(o0, pw1, 0, 1); ATT_PV(o1, pw1, 1, 1);
            ATT_PV(o0, pw2, 0, 2); ATT_PV(o1, pw2, 1, 2); ATT_PV(o0, pw3, 0, 3); ATT_PV(o1, pw3, 1, 3);
#undef ATT_PV
        }
        ATT_WAIT_BAR(2);
    }
    l_run += __shfl_xor(l_run, 32);
    if (hi == 0) wsf[32 + r32] = l_run;
    asm volatile("s_waitcnt lgkmcnt(0)" ::: "memory");
    bf16_t* op = ob + (size_t)(b * L + q0) * D + ocol + r32;
#pragma unroll
    for (int r = 0; r < 16; ++r) { const int q = crow(r, hi); const float inv = __builtin_amdgcn_rcpf(wsf[32 + q]);
        op[(size_t)q * D] = (bf16_t)f2bf(o0[r] * inv); op[(size_t)q * D + 32] = (bf16_t)f2bf(o1[r] * inv); }
    ATT_WAIT_BAR(0);
#undef ATT_TILE_ROW
}

__device__ __forceinline__ void attn_phase(const Params& p, ATT_LAS unsigned char* lds) {
    const int G = gridDim.x, bx = blockIdx.x;
    const int vcu = (G % 8 == 0) ? (bx % 8) * (G / 8) + bx / 8 : bx;
    for (int u = vcu; u < 2048; u += G) {
        if (u < 1024) attn_unit<false>(p, lds, u); else attn_unit<true>(p, lds, u - 1024);
    }
}
}

__device__ void p4a_ostat(const Params& p, int gw, int ngw, int lane) {
    bf16_t* ob = (bf16_t*)(p.ws + WS_O); float* os = (float*)(p.ws + WS_OSTAT);
    for (int m = gw; m < NTOK; m += ngw) {
        const u32x4 wa = *(const u32x4*)(ob + (size_t)m * D + lane * 8), wb = *(const u32x4*)(ob + (size_t)m * D + 512 + lane * 8);
        float sa = 0.f, sb = 0.f;
#pragma unroll
        for (int i = 0; i < 4; ++i) { const unsigned ua = wa[i], ub = wb[i]; const float a0 = __uint_as_float(ua << 16), a1 = __uint_as_float(ua & 0xffff0000u), b0 = __uint_as_float(ub << 16), b1 = __uint_as_float(ub & 0xffff0000u);
            sa += a0 * a0 + a1 * a1; sb += b0 * b0 + b1 * b1; }
        sa = wave_sum(sa); sb = wave_sum(sb);
        const float ra = rsqrtf(sa * (1.f / 512.f) + EPS), rb = rsqrtf(sb * (1.f / 512.f) + EPS);
        if (lane == 0) { os[m * 2] = ra; os[m * 2 + 1] = rb; }
        u32x4 oa, obb;
#pragma unroll
        for (int i = 0; i < 4; ++i) { const unsigned ua = wa[i], ub = wb[i];
            oa[i] = pk2(__uint_as_float(ua << 16) * ra, __uint_as_float(ua & 0xffff0000u) * ra); obb[i] = pk2(__uint_as_float(ub << 16) * rb, __uint_as_float(ub & 0xffff0000u) * rb); }
        *(u32x4*)(ob + (size_t)m * D + lane * 8) = oa; *(u32x4*)(ob + (size_t)m * D + 512 + lane * 8) = obb;
    }
}
__device__ void p4b_outproj_naive(const Params& p, float* sA, float* sB) {
    const bf16_t* ob = (const bf16_t*)(p.ws + WS_O); const bf16_t* wT = (const bf16_t*)(p.ws + WS_WOUT);
    float* mix = (float*)(p.ws + WS_MIX);
    constexpr int NTN = D / 64, NT = (NTOK / 128) * NTN;
    for (int t = blockIdx.x; t < NT; t += gridDim.x) {
        const int m0 = (t / NTN) * 128, n0 = (t % NTN) * 64;
        auto al = [&](int r, int k) { return bf2f(ob[(size_t)r * D + k]); };
        auto bl = [&](int n, int k) { return bf2f(wT[(size_t)n * D + k]); };
        auto ep = [&](int r0, int nn0, int tx, float (&acc)[4][4]) {
#pragma unroll
            for (int i = 0; i < 4; ++i)
#pragma unroll
                for (int j = 0; j < 4; ++j) mix[(size_t)(r0 + i) * D + nn0 + tx + 16 * j] = acc[i][j];
        };
        ngemm_tile(sA, sB, m0, n0, D, al, bl, ep);
    }
}
constexpr int SW_STRIDE = 36;

__device__ void p4c_post(const Params& p, LAS3 float* sW, int lane) {
    const float* mod = (const float*)(p.ws + WS_MOD); const float* mix = (const float*)(p.ws + WS_MIX);
    unsigned char* h8 = p.ws + WS_HB;
    unsigned* counts = (unsigned*)(p.ws + WS_CTL);
    int* eslot = (int*)(p.ws + WS_ESLOT); float* ew = (float*)(p.ws + WS_EW);
    const int wave = threadIdx.x >> 6;
    LAS3 int* lcnt = (LAS3 int*)(sW + 1024 * SW_STRIDE) + 128;
    LAS3 int* lbase = lcnt + 32;
    LAS3 int* stg_slot = lbase + 32; LAS3 int* stg_e = stg_slot + 512; LAS3 float* stg_w = (LAS3 float*)(stg_e + 512);
    if (threadIdx.x < NE) lcnt[threadIdx.x] = 0;
    for (int i = threadIdx.x; i < D * 8; i += NTHREADS) { const int k = i >> 3, e4 = i & 7; const f32x4 w = ((const f32x4*)p.w_router)[i];
        LAS3 float* d = sW + ((k & 3) * 256 + (k >> 2)) * SW_STRIDE + e4 * 4; *(LAS3 f32x4*)d = w; }
    __syncthreads();
    constexpr int R = 16;
    const int m0 = ((int)blockIdx.x * (NTHREADS / 64) + wave) * R;
    if (m0 < NTOK) {
        const int b = m0 / L; const float* mb = mod + b * 6144;
        f32x4 pA[4], pB[4], pC[4], v[4], xx[4], nv[4], nx[4];
#pragma unroll
        for (int j = 0; j < 4; ++j) { const int c0 = 4 * (lane + 64 * j);
            pA[j] = *(const f32x4*)(p.g_post_mix + c0) * *(const f32x4*)(mb + 2048 + c0);
            pB[j] = *(const f32x4*)(p.g_pre_ffn + c0) * (*(const f32x4*)(mb + 4096 + c0) + 1.f);
            pC[j] = *(const f32x4*)(mb + 3072 + c0);
            nv[j] = ((const f32x4*)(mix + (size_t)m0 * D))[lane + 64 * j]; nx[j] = ((const f32x4*)(p.x + (size_t)m0 * D))[lane + 64 * j]; }
        for (int it = 0; it < R; ++it) {
            const int m = m0 + it;
#pragma unroll
            for (int j = 0; j < 4; ++j) { v[j] = nv[j]; xx[j] = nx[j]; }
            if (it + 1 < R) {
#pragma unroll
                for (int j = 0; j < 4; ++j) { nv[j] = ((const f32x4*)(mix + (size_t)(m + 1) * D))[lane + 64 * j]; nx[j] = ((const f32x4*)(p.x + (size_t)(m + 1) * D))[lane + 64 * j]; }
            }
            float s = 0.f;
#pragma unroll
            for (int j = 0; j < 4; ++j) s += v[j].x * v[j].x + v[j].y * v[j].y + v[j].z * v[j].z + v[j].w * v[j].w;
            float rstd = rsqrtf(wave_sum(s) * (1.f / D) + EPS);
            s = 0.f;
            f32x4 xv[4];
#pragma unroll
            for (int j = 0; j < 4; ++j) {
                xv[j] = xx[j] + pA[j] * (v[j] * rstd);
                ((f32x4*)(p.out + (size_t)m * D))[lane + 64 * j] = xv[j];
                s += xv[j].x * xv[j].x + xv[j].y * xv[j].y + xv[j].z * xv[j].z + xv[j].w * xv[j].w; }
            rstd = rsqrtf(wave_sum(s) * (1.f / D) + EPS);
            float lg[NE];
#pragma unroll
            for (int e = 0; e < NE; ++e) lg[e] = 0.f;
#pragma unroll
            for (int j = 0; j < 4; ++j) { const int c0 = 4 * (lane + 64 * j);
                const f32x4 h2 = (xv[j] * rstd) * pB[j] + pC[j];
                *(unsigned*)(h8 + (size_t)m * D + c0) = pk4_fp8(h2.x, h2.y, h2.z, h2.w);
#pragma unroll
                for (int q = 0; q < 4; ++q) { const float hv = h2[q]; const LAS3 f32x4* wr = (const LAS3 f32x4*)(sW + (q * 256 + lane + 64 * j) * SW_STRIDE);
#pragma unroll
                    for (int e4 = 0; e4 < 8; ++e4) { const f32x4 ww = wr[e4]; lg[e4 * 4] = fmaf(hv, ww.x, lg[e4 * 4]); lg[e4 * 4 + 1] = fmaf(hv, ww.y, lg[e4 * 4 + 1]); lg[e4 * 4 + 2] = fmaf(hv, ww.z, lg[e4 * 4 + 2]); lg[e4 * 4 + 3] = fmaf(hv, ww.w, lg[e4 * 4 + 3]); }
                    asm volatile("" ::: "memory"); }
            }
#pragma unroll
            for (int e = 0; e < NE; ++e) lg[e] = wave_sum(lg[e]) + p.b_router[e];
            float tv[4]; int ti[4]; unsigned used = 0u;
#pragma unroll
            for (int k = 0; k < 4; ++k) { float best = -3.4e38f; int bi = 0;
#pragma unroll
                for (int e = 0; e < NE; ++e) { const bool ok = !((used >> e) & 1u) && lg[e] > best; best = ok ? lg[e] : best; bi = ok ? e : bi; }
                tv[k] = best; ti[k] = bi; used |= 1u << bi; }
            const float e1 = __expf(tv[1] - tv[0]), e2 = __expf(tv[2] - tv[0]), e3 = __expf(tv[3] - tv[0]); const float inv = 1.f / (1.f + e1 + e2 + e3);
            const float tw[4] = {inv, e1 * inv, e2 * inv, e3 * inv};
            if (lane < 4) {
                int myi = ti[0]; float myw = tw[0];
#pragma unroll
                for (int k = 1; k < 4; ++k) if (lane == k) { myi = ti[k]; myw = tw[k]; }
                const int lr = __hip_atomic_fetch_add((LAS3 int*)&lcnt[myi], 1, __ATOMIC_RELAXED, __HIP_MEMORY_SCOPE_WORKGROUP);
                const int si = (wave * 16 + it) * 4 + lane;
                stg_slot[si] = m * 4 + lane; stg_e[si] = myi | (lr << 8); stg_w[si] = myw;
            }
        }
    }
    __syncthreads();
    if (threadIdx.x < NE) { const int c = lcnt[threadIdx.x]; lbase[threadIdx.x] = c ? (int)atomicAdd(&counts[threadIdx.x * 64], (unsigned)c) : 0; }
    __syncthreads();
    { const int si = threadIdx.x, w = si >> 6;
      if (((int)blockIdx.x * (NTHREADS / 64) + w) * R < NTOK) {
        const int ee = stg_e[si], e = ee & 255, lr = ee >> 8; const int rank = lbase[e] + lr;
        eslot[(size_t)e * ECAP + rank] = stg_slot[si]; ew[(size_t)e * ECAP + rank] = stg_w[si]; } }
    __syncthreads();
}
__device__ __forceinline__ void expert_bases(const unsigned* counts, int* sbase_  ) {
    LAS3 int* sbase = (LAS3 int*)sbase_;
    if (threadIdx.x < 64) {
        const int lane = threadIdx.x; const int cn = lane < NE ? (int)counts[lane * 64] : 0; const int c = (cn + 255) & ~255;
        int incl = c;
#pragma unroll
        for (int o = 1; o < 32; o <<= 1) { const int v = __shfl_up(incl, o); if (lane >= o) incl += v; }
        if (lane < NE) { sbase[lane] = incl - c; sbase[40 + lane] = cn; }
        if (lane == NE - 1) sbase[NE] = incl;
    }
    __syncthreads();
}
__device__ __forceinline__ void p6_load(const bf16_t* y, const float* out, int m, int lane, u32x4 (&yv)[2][4], f32x4 (&xv)[2][2]) {
#pragma unroll
    for (int j = 0; j < 2; ++j) { const int c0 = 8 * (lane + 64 * j);
#pragma unroll
        for (int k = 0; k < 4; ++k) yv[j][k] = *(const u32x4*)(y + (size_t)(m * 4 + k) * D + c0);
        xv[j][0] = *(const f32x4*)(out + (size_t)m * D + c0); xv[j][1] = *(const f32x4*)(out + (size_t)m * D + c0 + 4); }
}
__device__ void p6_final(const Params& p, int lane) {
    const float* mod = (const float*)(p.ws + WS_MOD); const bf16_t* y = (const bf16_t*)(p.ws + WS_Y);
    constexpr int R = 16;
    const int m0 = ((int)blockIdx.x * (NTHREADS / 64) + (threadIdx.x >> 6)) * R;
    if (m0 >= NTOK) return;
    const int b = m0 / L; const float* ga2 = mod + b * 6144 + 5120;
    f32x4 pA[2][2];
#pragma unroll
    for (int j = 0; j < 2; ++j)
#pragma unroll
        for (int q = 0; q < 2; ++q) { const int c0 = 8 * (lane + 64 * j) + 4 * q; pA[j][q] = *(const f32x4*)(p.g_post_ffn + c0) * *(const f32x4*)(ga2 + c0); }
    u32x4 yv[2][4], ny[2][4]; f32x4 xv[2][2], nx[2][2];
    p6_load(y, p.out, m0, lane, ny, nx);
    for (int it = 0; it < R; ++it) {
        const int m = m0 + it;
#pragma unroll
        for (int j = 0; j < 2; ++j) {
#pragma unroll
            for (int k = 0; k < 4; ++k) yv[j][k] = ny[j][k];
            xv[j][0] = nx[j][0]; xv[j][1] = nx[j][1]; }
        if (it + 1 < R) p6_load(y, p.out, m + 1, lane, ny, nx);
        f32x4 a[2][2]; float s = 0.f;
#pragma unroll
        for (int j = 0; j < 2; ++j) { a[j][0] = (f32x4){0.f, 0.f, 0.f, 0.f}; a[j][1] = (f32x4){0.f, 0.f, 0.f, 0.f};
#pragma unroll
            for (int k = 0; k < 4; ++k) { const u32x4 w = yv[j][k];
                a[j][0].x += __uint_as_float(w.x << 16); a[j][0].y += __uint_as_float(w.x & 0xffff0000u); a[j][0].z += __uint_as_float(w.y << 16); a[j][0].w += __uint_as_float(w.y & 0xffff0000u);
                a[j][1].x += __uint_as_float(w.z << 16); a[j][1].y += __uint_as_float(w.z & 0xffff0000u); a[j][1].z += __uint_as_float(w.w << 16); a[j][1].w += __uint_as_float(w.w & 0xffff0000u); }
#pragma unroll
            for (int q = 0; q < 2; ++q) s += a[j][q].x * a[j][q].x + a[j][q].y * a[j][q].y + a[j][q].z * a[j][q].z + a[j][q].w * a[j][q].w; }
        const float rstd = rsqrtf(wave_sum(s) * (1.f / D) + EPS);
#pragma unroll
        for (int j = 0; j < 2; ++j)
#pragma unroll
            for (int q = 0; q < 2; ++q) { const int c0 = 8 * (lane + 64 * j) + 4 * q;
                *(f32x4*)(p.out + (size_t)m * D + c0) = xv[j][q] + pA[j][q] * (a[j][q] * rstd); }
    }
}

constexpr int LDS_SBASE = 147456;
constexpr int LDS_BYTES = LDS_SBASE + 512 + (64 + 3 * 512) * 4 + 256;

__global__ void __launch_bounds__(NTHREADS, 2) fwd_kernel(Params p) {
    cg::grid_group grid = cg::this_grid();
    extern __shared__ __attribute__((aligned(16))) unsigned char lds[];
    int* sbase = (int*)(lds + LDS_SBASE);
    const int tid = threadIdx.x, lane = tid & 63, wave = tid >> 6;
    const int gtid = blockIdx.x * NTHREADS + tid, gsize = gridDim.x * NTHREADS;
    const int gw = blockIdx.x * (NTHREADS / 64) + wave, ngw = gridDim.x * (NTHREADS / 64);
    PG8_LAS unsigned char* lds3 = (PG8_LAS unsigned char*)lds;
    const PG8_LAS int* sbase3 = (const PG8_LAS int*)(lds3 + LDS_SBASE);
    volatile LAS3 unsigned* bst = (volatile LAS3 unsigned*)(lds3 + LDS_SBASE + 384);
    if (tid < 2) bst[tid] = 0u;
    __syncthreads();
    XcdBarrier xb = xcd_barrier_post((unsigned*)(p.ws + WS_CTL) + CW_BAR, bst);

    p0_mod(p, (float*)lds, (float*)(lds + 36864));
    p0_tab(p, gtid, gsize);
    p0_weights(p, (float*)(lds + 57344 + wave * 8448), gw, ngw, lane);
    grid.sync();
    p1_h(p, lane);
    xcd_barrier(xb);
    { pg8::Gemm g{(const bf16_t*)(p.ws + WS_HB), (const bf16_t*)(p.ws + WS_WIN), D, 0, nullptr, sbase3};
      pg8::StaticOrder S; S.init(MROWS, INW, (int)gridDim.x, (int)blockIdx.x, nullptr);
      pg8::EpiQKV E{(bf16_t*)(p.ws + WS_QKV), (const float*)(p.ws + WS_TAB)};
      pg8::gemm_phase<pg8::EpiQKV, pg8::StaticOrder, false, true>(lds3, g, S, E); }
    xcd_barrier(xb);
    att::attn_phase(p, lds3);
    xcd_barrier(xb);
    p4a_ostat(p, gw, ngw, lane);
    xcd_barrier(xb);
    { pg8::Gemm g{(const bf16_t*)(p.ws + WS_O), (const bf16_t*)(p.ws + WS_WOUT), D, 0, nullptr, sbase3};
      pg8::StaticOrder S; S.init(NTOK, D, (int)gridDim.x, (int)blockIdx.x, nullptr);
      pg8::EpiF32 E{(float*)(p.ws + WS_MIX), D};
      pg8::gemm_phase<pg8::EpiF32, pg8::StaticOrder, false, true>(lds3, g, S, E); }
    xcd_barrier(xb);
    p4c_post(p, (LAS3 float*)lds3, lane);
    xcd_barrier(xb);
    expert_bases((const unsigned*)(p.ws + WS_CTL), sbase);
    { const int total = sbase3[NE];
      pg8::Gemm g{(const bf16_t*)(p.ws + WS_HB), (const bf16_t*)(p.ws + WS_W1), D / 2, (size_t)2048 * D, (const int*)(p.ws + WS_ESLOT), sbase3};
      pg8::StaticOrder S; S.init(total, 2048, (int)gridDim.x, (int)blockIdx.x, sbase3);
      pg8::EpiSwiglu E{p.ws + WS_ACT, p.b_mlp1};
      pg8::gemm_phase<pg8::EpiSwiglu, pg8::StaticOrder, true, true, true>(lds3, g, S, E); }
    xcd_barrier(xb);
    { const int total = sbase3[NE];
      pg8::Gemm g{(const bf16_t*)(p.ws + WS_ACT), (const bf16_t*)(p.ws + WS_W2), D / 2, (size_t)D * D, nullptr, sbase3};
      pg8::StaticOrder S; S.init(total, D, (int)gridDim.x, (int)blockIdx.x, sbase3);
      pg8::EpiScatter E{(bf16_t*)(p.ws + WS_Y), p.b_mlp2, (const int*)(p.ws + WS_ESLOT), (const float*)(p.ws + WS_EW), sbase3};
      pg8::gemm_phase<pg8::EpiScatter, pg8::StaticOrder, false, true, true>(lds3, g, S, E); }
    xcd_barrier(xb);
    p6_final(p, lane);
}

extern "C" void kernel_launch(void* const* d_in, const int* in_sizes, int n_in, void* d_out, int out_size, void* d_ws, size_t ws_size, hipStream_t stream) {
    static int grid_blocks = 0;
    if (grid_blocks == 0) {
        if (n_in != 22 || ws_size < WS_END) { fprintf(stderr, "kernel_launch: unexpected n_in %d / ws_size %zu (need %zu)\n", n_in, ws_size, (size_t)WS_END); grid_blocks = -1; return; }
        int dev = 0, cus = 0, per_cu = 0;
        (void)hipGetDevice(&dev);
        (void)hipDeviceGetAttribute(&cus, hipDeviceAttributeMultiprocessorCount, dev);
        if (hipFuncSetAttribute((const void*)fwd_kernel, hipFuncAttributeMaxDynamicSharedMemorySize, LDS_BYTES) != hipSuccess) { fprintf(stderr, "kernel_launch: hipFuncSetAttribute failed\n"); grid_blocks = -1; return; }
        (void)hipOccupancyMaxActiveBlocksPerMultiprocessor(&per_cu, (const void*)fwd_kernel, NTHREADS, LDS_BYTES);
        if (per_cu < 1) { fprintf(stderr, "kernel_launch: occupancy query returned %d\n", per_cu); grid_blocks = -1; return; }
        grid_blocks = cus;
        if (grid_blocks * (NTHREADS / 64) * 16 < NTOK) { fprintf(stderr, "kernel_launch: needs >= 256 CUs (got %d)\n", cus); grid_blocks = -1; return; }
    }
    if (grid_blocks < 0) return;
    (void)hipMemsetAsync((char*)d_ws + WS_CTL, 0, CTL_BYTES, stream);
    Params p{};
    const float** pp = (const float**)&p;
    for (int i = 0; i < 22; ++i) pp[i] = (const float*)d_in[i];
    p.out = (float*)d_out; p.ws = (unsigned char*)d_ws;
    void* args[] = {&p};
    hipError_t e = hipLaunchCooperativeKernel((const void*)fwd_kernel, dim3(grid_blocks), dim3(NTHREADS), args, LDS_BYTES, stream);
    if (e != hipSuccess) fprintf(stderr, "cooperative launch failed: %s (grid %d)\n", hipGetErrorString(e), grid_blocks);
}
```

```cpp
#include <hip/hip_runtime.h>
#include <hip/hip_cooperative_groups.h>
#include <cstdio>
#include <cstdint>
namespace cg = cooperative_groups;

constexpr int D = 1024, NB = 8, L = 4096, CTX = 256;
constexpr int NTOK = NB * L, NCTX = NB * CTX, MROWS = NTOK + NCTX;
constexpr int INW = 2304;
constexpr int C_QA = 0, C_KA = 512, C_VA = 640, C_QB = 768, C_KB = 1280, C_VB = 1792;
constexpr int NE = 32, TOPK = 4, NASG = NTOK * TOPK;
constexpr int PADROWS = NASG + NE * 256;
constexpr float LOG2E = 1.4426950408889634f;
constexpr float QSCALE = 0.125f * LOG2E;
constexpr float EPS = 1e-6f;
constexpr int NTHREADS = 512;

constexpr size_t MiB = 1u << 20;
constexpr size_t WS_CTL = 0;
constexpr size_t CTL_BYTES = 32768;
constexpr int CW_BAR = 2048;
constexpr size_t WS_MOD = 1 * MiB;
constexpr size_t WS_TAB = 1 * MiB + 256 * 1024;
constexpr size_t WS_OSTAT = 1 * MiB + 512 * 1024;
constexpr size_t WS_WIN = 2 * MiB;
constexpr size_t WS_WOUT = 7 * MiB;
constexpr size_t WS_W2 = 9 * MiB;
constexpr size_t WS_OSS = 41 * MiB;
constexpr size_t WS_W1 = 73 * MiB;
constexpr size_t WS_HB = 201 * MiB;
constexpr int ECAP = NTOK;
constexpr size_t WS_ESLOT = 269 * MiB;
constexpr size_t WS_EW = 273 * MiB;
constexpr size_t WS_QKV = 277 * MiB;
constexpr size_t WS_O = 430 * MiB;
constexpr size_t WS_MIX = 494 * MiB;
constexpr size_t WS_ACT = 277 * MiB;
constexpr size_t WS_Y = 622 * MiB;
constexpr size_t WS_END = 878 * MiB;
static_assert(WS_W1 + (size_t)NE * 2048 * D * 2 <= WS_HB && WS_W2 + (size_t)NE * D * D * 2 <= WS_W1, "map");
static_assert(WS_HB + (size_t)MROWS * D * 2 <= WS_ESLOT && WS_ESLOT + (size_t)NE * ECAP * 4 <= WS_EW && WS_EW + (size_t)NE * ECAP * 4 <= WS_QKV, "map");
static_assert(WS_QKV + (size_t)MROWS * INW * 2 <= WS_O && WS_O + (size_t)NTOK * D * 2 <= WS_MIX && WS_MIX + (size_t)NTOK * D * 4 <= WS_Y, "map");
static_assert(WS_ACT + (size_t)PADROWS * 1024 * 2 <= WS_Y && WS_Y + (size_t)NASG * D * 2 <= WS_END, "map");

typedef unsigned short bf16_t;
typedef float f32x4 __attribute__((ext_vector_type(4)));
typedef unsigned u32x4 __attribute__((ext_vector_type(4)));
typedef unsigned u32x2 __attribute__((ext_vector_type(2)));

struct Params {
    const float *x, *c, *ctx, *c_ctx, *w_ada, *b_ada, *g_pre_mix, *g_post_mix, *g_pre_ffn, *g_post_ffn, *w_in, *g_grp_a, *g_grp_b,
        *sink_a, *rpb_b, *w_out, *w_router, *b_router, *w_mlp1, *b_mlp1, *w_mlp2, *b_mlp2;
    float* out;
    unsigned char* ws;
};

__device__ __forceinline__ float bf2f(bf16_t h) { return __uint_as_float((unsigned)h << 16); }
__device__ __forceinline__ unsigned f2bf(float f) { unsigned u = __float_as_uint(f); return (u + 0x7fffu + ((u >> 16) & 1u)) >> 16; }
__device__ __forceinline__ unsigned pk2(float lo, float hi) { return f2bf(lo) | (f2bf(hi) << 16); }
__device__ __forceinline__ unsigned pk4_fp8(float v0, float v1, float v2, float v3) {
    int w = 0; w = __builtin_amdgcn_cvt_pk_fp8_f32(v0, v1, w, false); w = __builtin_amdgcn_cvt_pk_fp8_f32(v2, v3, w, true); return (unsigned)w; }
constexpr float W8_SCALE = 64.f, W8_INV = 1.f / 64.f;
__device__ __forceinline__ int tid_opaque() { int t = threadIdx.x; asm volatile("" : "+v"(t)); return t; }
template <int CTRL> __device__ __forceinline__ float dppmov(float v) { return __builtin_bit_cast(float, __builtin_amdgcn_update_dpp(0, __builtin_bit_cast(int, v), CTRL, 0xf, 0xf, true)); }
__device__ __forceinline__ float row_sum16(float v) { v += dppmov<0xB1>(v); v += dppmov<0x4E>(v); v += dppmov<0x141>(v); v += dppmov<0x140>(v); return v; }
__device__ __forceinline__ float rdlane(float v, int l) { return __builtin_bit_cast(float, __builtin_amdgcn_readlane(__builtin_bit_cast(int, v), l)); }
__device__ __forceinline__ float wave_sum(float v) { v = row_sum16(v); return (rdlane(v, 0) + rdlane(v, 16)) + (rdlane(v, 32) + rdlane(v, 48)); }

#define LAS3 __attribute__((address_space(3)))
#define XB_TMO      128
#define XB_XCNT(j)  (256  + 64 * (j))
#define XB_XSUB(j)  (1280 + 64 * (j))
#define XB_XGEN(j)  (2304 + 64 * (j))
#define XB_TOP      3328
#define XB_TOPGEN   3392
#define XCD_BAR_WORDS 3456
#define XB_SPIN_CAP (1u << 18)
__device__ __forceinline__ unsigned xb_ld(unsigned* p)              { return __hip_atomic_load(p, __ATOMIC_RELAXED, __HIP_MEMORY_SCOPE_AGENT); }
__device__ __forceinline__ unsigned xb_add(unsigned* p, unsigned v) { return __hip_atomic_fetch_add(p, v, __ATOMIC_RELAXED, __HIP_MEMORY_SCOPE_AGENT); }
__device__ __forceinline__ unsigned xb_xcc_id() { return (unsigned)__builtin_amdgcn_s_getreg((3 << 11) | 20) & 0xFu; }
#define XB_SPIN(cond, bar) do { unsigned _sp = 0; while (cond) { __builtin_amdgcn_s_sleep(1); \
    if ((++_sp & 255u) == 0u) { if (xb_ld(&(bar)[XB_TMO])) break; if (_sp > XB_SPIN_CAP) { atomicAdd(&(bar)[XB_TMO], 1u); break; } } } } while (0)
struct XcdBarrier { unsigned* bar; unsigned x; volatile LAS3 unsigned* st; };
__device__ __forceinline__ XcdBarrier xcd_barrier_post(unsigned* bar, volatile LAS3 unsigned* st) {
    XcdBarrier b; b.bar = bar; b.x = xb_xcc_id(); b.st = st;
    if (threadIdx.x == 0) (void)xb_add(&bar[XB_XCNT(b.x)], 1u);
    return b;
}
__device__ __forceinline__ void xcd_barrier_complete(unsigned* bar, unsigned x, unsigned& nloc, unsigned& nx) {
    const unsigned G = gridDim.x * gridDim.y * gridDim.z;
    unsigned sum, cnt, mine, sp = 0u;
    for (;;) {
        sum = 0u; cnt = 0u; mine = 0u;
#pragma unroll
        for (unsigned j = 0; j < 16; ++j) { const unsigned c = xb_ld(&bar[XB_XCNT(j)]); sum += c; cnt += (c > 0u) ? 1u : 0u; mine = (j == x) ? c : mine; }
        if (sum == G) break;
        __builtin_amdgcn_s_sleep(1);
        if ((++sp & 255u) == 0u) { if (xb_ld(&bar[XB_TMO])) break; if (sp > XB_SPIN_CAP) { atomicAdd(&bar[XB_TMO], 1u); break; } }
    }
    nloc = mine > 0u ? mine : 1u; nx = cnt > 0u ? cnt : 1u;
}
__device__ __forceinline__ void xcd_barrier(const XcdBarrier& b) {
    asm volatile("s_waitcnt vmcnt(0)" ::: "memory");
    __syncthreads();
    if (threadIdx.x == 0) {
        unsigned* bar = b.bar;
        __builtin_amdgcn_s_waitcnt(0);
        unsigned nloc = b.st[0], nx = b.st[1];
        if (nloc == 0u) { xcd_barrier_complete(bar, b.x, nloc, nx); b.st[0] = nloc; b.st[1] = nx; }
        const unsigned old = xb_add(&bar[XB_XSUB(b.x)], 1u);
        const unsigned gen = old / nloc;
        if (old + 1u == (gen + 1u) * nloc) {
            __builtin_amdgcn_fence(__ATOMIC_RELEASE, "agent");
            asm volatile("s_waitcnt vmcnt(0)" ::: "memory");
            const unsigned og = xb_add(&bar[XB_TOP], 1u);
            const unsigned tg = og / nx;
            if (og + 1u == (tg + 1u) * nx) xb_add(&bar[XB_TOPGEN], 1u);
            else XB_SPIN(xb_ld(&bar[XB_TOPGEN]) == tg, bar);
            __builtin_amdgcn_fence(__ATOMIC_ACQUIRE, "agent");
            xb_add(&bar[XB_XGEN(b.x)], 1u);
            asm volatile("s_waitcnt vmcnt(0)" ::: "memory");
        } else {
            XB_SPIN(xb_ld(&bar[XB_XGEN(b.x)]) == gen, bar);
            __builtin_amdgcn_fence(__ATOMIC_ACQUIRE, "agent");
            asm volatile("s_waitcnt vmcnt(0)" ::: "memory");
        }
    }
    __syncthreads();
}

namespace pg8 {
#define PG8_LAS __attribute__((address_space(3)))
typedef short bf16x8 __attribute__((ext_vector_type(8)));
typedef int v8i __attribute__((ext_vector_type(8)));
typedef int v4i __attribute__((ext_vector_type(4)));
typedef short s16x16 __attribute__((ext_vector_type(16)));
constexpr int BM = 256, BK = 64, HALF = 128, HTB = HALF * BK * 2  , STAGE_BYTES = 8 * HTB, NXCD = 8, WGM = 8;
__device__ __forceinline__ int lds_byte(int r, int c) { const int st = (r >> 4) * 2 + (c >> 5), rr = r & 15, cc = c & 31, ob = rr * 64 + cc * 2; return st * 1024 + (ob ^ (((ob >> 9) & 1) << 5)); }
__device__ __forceinline__ void stage_rc(int b, int& R, int& C) { const int st = b / 1024, sb = b % 1024, swz = sb ^ (((sb >> 9) & 1) << 5); R = (st >> 1) * 16 + swz / 64; C = (st & 1) * 32 + (swz % 64) / 2; }
__device__ __forceinline__ int perm32(int rho) { const int n = rho >> 4, i = rho & 15; return 8 * (i >> 2) + 4 * n + (i & 3); }

struct Unit { int pm, pn, e; };
struct Gemm { const bf16_t* A; const bf16_t* Bt; int K; size_t bstride; const int* eslot; const PG8_LAS int* sb; };

struct StaticOrder {
    int nM, nN, nwg, G, c; const PG8_LAS int* sbase;
    __device__ void init(int M, int N, int G_, int c_, const PG8_LAS int* sb) { nM = M / BM; nN = N / BM; nwg = nM * nN; G = G_; c = c_; sbase = sb; }
    __device__ bool next(int i, Unit& u) const {
        const long Lx = (long)i * G + c; if (Lx >= nwg) return false;
        int wgid = (int)Lx; { const int q = nwg / NXCD, r = nwg % NXCD, xcd = wgid % NXCD, off = wgid / NXCD; wgid = (xcd < r ? xcd * (q + 1) : r * (q + 1) + (xcd - r) * q) + off; }
        const int nig = WGM * nN, gid = wgid / nig, fm = gid * WGM, gsz = (nM - fm) < WGM ? (nM - fm) : WGM;
        u.pm = fm + ((wgid % nig) % gsz); u.pn = (wgid % nig) / gsz; u.e = 0;
        if (sbase) { const int row = u.pm * BM; int e = 0;
#pragma unroll 1
            for (int j = 1; j < 32; ++j) e += (row >= sbase[j]) ? 1 : 0;
            u.e = e; }
        return true;
    }
};

template <class Epi, class Sched, bool GATHER, bool ALIGN_EPI, bool FP8 = false>
__device__ __forceinline__ void gemm_phase(PG8_LAS unsigned char* lds, const Gemm g, const Sched& S, const Epi& E) {
    int tid_ = threadIdx.x; asm volatile("" : "+v"(tid_));
    const int tid = tid_, wid = __builtin_amdgcn_readfirstlane(tid >> 6), lane = tid & 63, wr = wid >> 2, wc = wid & 3, fr = lane & 15, fq = lane >> 4;
    const int K = g.K, nt = K / BK;
    unsigned voffA[2], voffB[2];
#pragma unroll
    for (int i = 0; i < 2; ++i) { int R, C; stage_rc(tid * 16 + i * 8192, R, C); const int Rb = Epi::PERM ? ((R & ~31) + perm32(R & 31)) : R;
        voffA[i] = (unsigned)(R * K + C) * 2u; voffB[i] = (unsigned)(Rb * K + C) * 2u; }
    const size_t kstep = (size_t)(BK * 2);
    const size_t hstep = (size_t)HALF * K * 2;
    const size_t tstep = 2 * hstep;
    const unsigned ldsw = (unsigned)wid * 1024u;
    const int aoff = FP8 ? lds_byte(wr * 64 + fr, fq * 16) : lds_byte(wr * 64 + fr, fq * 8), boff = FP8 ? lds_byte(wc * 32 + fr, fq * 16) : lds_byte(wc * 32 + fr, fq * 8);
#define PG8_SA(b, h) (((b) * 2 + (h)) * HTB)
#define PG8_SB(b, h) ((4 + (b) * 2 + (h)) * HTB)
#define PG8_STAGE(bufoff, gbase, voff) do { _Pragma("unroll") for (int _i = 0; _i < 2; ++_i) \
        __builtin_amdgcn_global_load_lds((const unsigned*)((const char*)(gbase) + (voff)[_i]), (PG8_LAS unsigned*)(lds + (bufoff) + ldsw + _i * 8192), 16, 0, 0); } while (0)
#define PG8_CAT(lo_, hi_) __builtin_bit_cast(v8i, __builtin_shufflevector((lo_), (hi_), 0, 1, 2, 3, 4, 5, 6, 7, 8, 9, 10, 11, 12, 13, 14, 15))
#define PG8_LDA(dst, b, h) do { _Pragma("unroll") for (int m = 0; m < 4; ++m) { \
        if constexpr (FP8) dst##8[m] = PG8_CAT(*(const PG8_LAS bf16x8*)(lds + PG8_SA(b, h) + aoff + m * 2048), *(const PG8_LAS bf16x8*)(lds + PG8_SA(b, h) + aoff + m * 2048 + 16)); \
        else { _Pragma("unroll") for (int k = 0; k < 2; ++k) dst[m][k] = *(const PG8_LAS bf16x8*)(lds + PG8_SA(b, h) + aoff + m * 2048 + k * 1024); } } } while (0)
#define PG8_LDB(dst, b, h) do { _Pragma("unroll") for (int n = 0; n < 2; ++n) { \
        if constexpr (FP8) dst##8[n] = PG8_CAT(*(const PG8_LAS bf16x8*)(lds + PG8_SB(b, h) + boff + n * 2048), *(const PG8_LAS bf16x8*)(lds + PG8_SB(b, h) + boff + n * 2048 + 16)); \
        else { _Pragma("unroll") for (int k = 0; k < 2; ++k) dst[n][k] = *(const PG8_LAS bf16x8*)(lds + PG8_SB(b, h) + boff + n * 2048 + k * 1024); } } } while (0)
#define PG8_MMA(ai, bj, At, Bt) do { __builtin_amdgcn_s_setprio(1); _Pragma("unroll") for (int m = 0; m < 4; ++m) _Pragma("unroll") for (int n = 0; n < 2; ++n) { \
        if constexpr (FP8) asm volatile("v_mfma_scale_f32_16x16x128_f8f6f4 %0, %1, %2, %0, %3, %3 op_sel_hi:[0,0,0]" : "+v"(acc[ai][bj][m][n]) : "v"(Bt##8[n]), "v"(At##8[m]), "v"(one_scale)); \
        else { _Pragma("unroll") for (int k = 0; k < 2; ++k) acc[ai][bj][m][n] = __builtin_amdgcn_mfma_f32_16x16x32_bf16(Bt[n][k], At[m][k], acc[ai][bj][m][n], 0, 0, 0); } } \
        __builtin_amdgcn_s_setprio(0); } while (0)
#define PG8_WAIT_V(n) asm volatile("s_waitcnt vmcnt(" #n ")" ::: "memory")
#define PG8_WAIT_L(n) asm volatile("s_waitcnt lgkmcnt(" #n ")" ::: "memory")
#define PG8_BAR __builtin_amdgcn_s_barrier()
#define PG8_SCHED __builtin_amdgcn_sched_barrier(0)
#define PG8_SETOFF(off, u) do { _Pragma("unroll") for (int _h = 0; _h < 2; ++_h) _Pragma("unroll") for (int _i = 0; _i < 2; ++_i) { \
        if (GATHER) { int R_, C_; stage_rc(tid * 16 + _i * 8192, R_, C_); int rk_ = (u).pm * BM + _h * HALF + R_ - g.sb[(u).e]; const int cm_ = g.sb[40 + (u).e] - 1; rk_ = rk_ < cm_ ? rk_ : cm_; \
            off[_h][_i] = (unsigned)(g.eslot[(size_t)(u).e * ECAP + rk_] >> 2) * (unsigned)(K * 2) + (unsigned)(C_ * 2); } \
        else off[_h][_i] = voffA[_i] + (unsigned)(_h * hstep); } } while (0)
    Unit cur, nxt; int ui = 0;
    if (!S.next(0, cur)) return;
    f32x4 acc[2][2][4][2];
#pragma unroll
    for (int a = 0; a < 2; ++a)
#pragma unroll
        for (int b = 0; b < 2; ++b)
#pragma unroll
            for (int m = 0; m < 4; ++m)
#pragma unroll
                for (int n = 0; n < 2; ++n) acc[a][b][m][n] = (f32x4){0.f, 0.f, 0.f, 0.f};
    bf16x8 At[4][2], B0[2][2], B1[2][2];
    v8i At8[4], B08[2], B18[2];
    const int one_scale = 0x7f7f7f7f;
    unsigned offc[2][2], offn[2][2];
    PG8_SETOFF(offc, cur);
    const char* cA = GATHER ? (const char*)g.A : (const char*)g.A + (size_t)cur.pm * tstep;
    const char* cB = (const char*)g.Bt + (size_t)cur.e * g.bstride + (size_t)cur.pn * tstep;
    PG8_STAGE(PG8_SB(0, 0), cB, voffB); PG8_STAGE(PG8_SB(0, 1), cB + hstep, voffB); PG8_STAGE(PG8_SA(0, 0), cA, offc[0]); PG8_STAGE(PG8_SA(0, 1), cA, offc[1]);
    if (wr == 1) PG8_BAR;
    PG8_WAIT_V(2); PG8_BAR;
    PG8_STAGE(PG8_SB(1, 0), cB + kstep, voffB); PG8_STAGE(PG8_SA(1, 0), cA + kstep, offc[0]); PG8_STAGE(PG8_SB(1, 1), cB + hstep + kstep, voffB);
    PG8_WAIT_V(6); PG8_BAR;
    for (;;) {
        const bool has_next = S.next(ui + 1, nxt);
        const char* nA = GATHER ? cA : (has_next ? (const char*)g.A + (size_t)nxt.pm * tstep : cA);
        const char* nB = has_next ? (const char*)g.Bt + (size_t)nxt.e * g.bstride + (size_t)nxt.pn * tstep : cB;
        if (GATHER) { if (has_next) { PG8_SETOFF(offn, nxt); } else {
#pragma unroll
            for (int h = 0; h < 2; ++h)
#pragma unroll
                for (int i = 0; i < 2; ++i) offn[h][i] = offc[h][i]; } }
        if constexpr (Epi::MIDSCALE) E.begin(cur, ui, lds, tid);
#pragma unroll 1
        for (int t = 0; t < nt; t += 2) {
            const bool last = (t == nt - 2);
            if constexpr (Epi::MIDSCALE) { if (t == nt / 2) E.mid(acc, ui, wr, fr, lds); }
            const char* a1 = cA + (size_t)(t + 1) * kstep;
            const char* a2 = last ? nA : cA + (size_t)(t + 2) * kstep; const char* b2 = last ? nB : cB + (size_t)(t + 2) * kstep;
            const char* a3 = a2 + kstep; const char* b3 = b2 + kstep;
            unsigned o2[2][2];
#pragma unroll
            for (int h = 0; h < 2; ++h)
#pragma unroll
                for (int i = 0; i < 2; ++i) o2[h][i] = (GATHER && last) ? offn[h][i] : offc[h][i];
            PG8_LDB(B0, 0, 0); PG8_LDB(B1, 0, 1); PG8_SCHED; PG8_LDA(At, 0, 0); PG8_STAGE(PG8_SA(1, 1), a1, offc[1]);
            PG8_WAIT_V(8); PG8_WAIT_L(0); PG8_BAR; PG8_MMA(0, 0, At, B0); PG8_MMA(0, 1, At, B1); PG8_BAR; PG8_SCHED;
            PG8_LDA(At, 0, 1); PG8_STAGE(PG8_SB(0, 0), b2, voffB); PG8_STAGE(PG8_SB(0, 1), b2 + hstep, voffB); PG8_STAGE(PG8_SA(0, 0), a2, o2[0]);
            PG8_WAIT_V(8); PG8_WAIT_L(0); PG8_BAR; PG8_MMA(1, 0, At, B0); PG8_MMA(1, 1, At, B1); PG8_BAR; PG8_SCHED;
            PG8_LDB(B0, 1, 0); PG8_LDB(B1, 1, 1); PG8_SCHED; PG8_LDA(At, 1, 0); PG8_STAGE(PG8_SA(0, 1), a2, o2[1]);
            PG8_WAIT_V(8); PG8_WAIT_L(0); PG8_BAR; PG8_MMA(0, 0, At, B0); PG8_MMA(0, 1, At, B1); PG8_BAR; PG8_SCHED;
            PG8_LDA(At, 1, 1); PG8_STAGE(PG8_SB(1, 0), b3, voffB); PG8_STAGE(PG8_SB(1, 1), b3 + hstep, voffB); PG8_STAGE(PG8_SA(1, 0), a3, o2[0]);
            PG8_WAIT_V(8); PG8_WAIT_L(0); PG8_BAR; PG8_MMA(1, 0, At, B0); PG8_MMA(1, 1, At, B1); PG8_BAR; PG8_SCHED;
        }
        if constexpr (ALIGN_EPI) { if (wr == 0) PG8_BAR; }
        if constexpr (FP8) asm volatile("s_nop 15\n\ts_nop 15" ::: "memory");
        if constexpr (Epi::MIDSCALE) E(acc, cur, ui, wr, wc, fr, fq, lds); else E(acc, cur, wr, wc, fr, fq);
        if (!has_next) break;
#pragma unroll
        for (int a = 0; a < 2; ++a)
#pragma unroll
            for (int b = 0; b < 2; ++b)
#pragma unroll
                for (int m = 0; m < 4; ++m)
#pragma unroll
                    for (int n = 0; n < 2; ++n) acc[a][b][m][n] = (f32x4){0.f, 0.f, 0.f, 0.f};
        cur = nxt; cA = nA; cB = nB; ++ui;
#pragma unroll
        for (int h = 0; h < 2; ++h)
#pragma unroll
            for (int i = 0; i < 2; ++i) offc[h][i] = offn[h][i];
        if constexpr (ALIGN_EPI) { if (wr == 1) PG8_BAR; }
    }
    PG8_WAIT_V(0);
    if constexpr (!ALIGN_EPI) { if (wr == 0) PG8_BAR; }
    PG8_BAR;
#undef PG8_SA
#undef PG8_SB
#undef PG8_STAGE
#undef PG8_LDA
#undef PG8_LDB
#undef PG8_MMA
#undef PG8_WAIT_V
#undef PG8_WAIT_L
#undef PG8_BAR
#undef PG8_SCHED
#undef PG8_SETOFF
#undef PG8_CAT
}

struct EpiQKV {
    static constexpr bool MIDSCALE = false, PERM = false;
    bf16_t* O; const float* tab;
    __device__ __forceinline__ void operator()(const f32x4 (&acc)[2][2][4][2], const Unit& u, int wr, int wc, int fr, int fq) const {
        const bool latent = u.pm < NTOK / BM;
#pragma unroll
        for (int ai = 0; ai < 2; ++ai)
#pragma unroll
            for (int m = 0; m < 4; ++m) {
                const int row = u.pm * BM + ai * HALF + wr * 64 + m * 16 + fr;
                bf16_t* rowp = O + (size_t)row * INW + u.pn * BM + wc * 32 + 4 * fq;
                const int pos = row & (L - 1), pp = (wc & 1) ? (pos & 63) : (pos >> 6);
                const f32x4* tp = (const f32x4*)(tab + (pp * 16 + 4 * fq) * 2);
#pragma unroll
                for (int bj = 0; bj < 2; ++bj) {
                    const int colbase = u.pn * BM + bj * HALF;
                    f32x4 v0 = acc[ai][bj][m][0], v1 = acc[ai][bj][m][1];
                    if (latent && colbase < C_VA) {
                        const f32x4 t0 = tp[0], t1 = tp[1];
                        const f32x4 cs = {t0.x, t0.z, t1.x, t1.z}, sn = {t0.y, t0.w, t1.y, t1.w};
                        const f32x4 a0 = v0 * cs - v1 * sn, a1 = v1 * cs + v0 * sn; v0 = a0; v1 = a1;
                    }
                    if (colbase < C_KA || (colbase >= C_QB && colbase < C_KB)) { v0 = v0 * QSCALE; v1 = v1 * QSCALE; }
                    u32x2 w0, w1; w0.x = pk2(v0.x, v0.y); w0.y = pk2(v0.z, v0.w); w1.x = pk2(v1.x, v1.y); w1.y = pk2(v1.z, v1.w);
                    *(u32x2*)(rowp + bj * HALF) = w0; *(u32x2*)(rowp + bj * HALF + 16) = w1;
                }
            }
    }
};
struct EpiF32 {
    static constexpr bool MIDSCALE = false, PERM = false;
    float* O; int ldc;
    __device__ __forceinline__ void operator()(const f32x4 (&acc)[2][2][4][2], const Unit& u, int wr, int wc, int fr, int fq) const {
#pragma unroll
        for (int ai = 0; ai < 2; ++ai)
#pragma unroll
            for (int m = 0; m < 4; ++m) {
                float* rowp = O + (size_t)(u.pm * BM + ai * HALF + wr * 64 + m * 16 + fr) * ldc + u.pn * BM + wc * 32 + 4 * fq;
#pragma unroll
                for (int bj = 0; bj < 2; ++bj)
#pragma unroll
                    for (int n = 0; n < 2; ++n) *(f32x4*)(rowp + bj * HALF + 16 * n) = acc[ai][bj][m][n];
            }
    }
};
struct EpiOutProj {
    static constexpr bool PERM = false, MIDSCALE = true;
    float* O; const float* oss;
    __device__ __forceinline__ void begin(const Unit& u, int ui, PG8_LAS unsigned char* lds, int tid) const {
        if (tid < 256) { const f32x4* sp = (const f32x4*)(oss + (size_t)(u.pm * BM + tid) * 16); const f32x4 a0 = sp[0], a1 = sp[1], b0 = sp[2], b1 = sp[3];
            const float sa = ((a0.x + a0.y) + (a0.z + a0.w)) + ((a1.x + a1.y) + (a1.z + a1.w)), sb = ((b0.x + b0.y) + (b0.z + b0.w)) + ((b1.x + b1.y) + (b1.z + b1.w));
            const float ra = rsqrtf(sa * (1.f / 512.f) + EPS), rb = rsqrtf(sb * (1.f / 512.f) + EPS);
            typedef float f2 __attribute__((ext_vector_type(2)));
            *(PG8_LAS f2*)(lds + 131072 + (ui & 1) * 2048 + tid * 8) = (f2){ra / rb, rb}; }
    }
    __device__ __forceinline__ void mid(f32x4 (&acc)[2][2][4][2], int ui, int wr, int fr, PG8_LAS unsigned char* lds) const {
#pragma unroll
        for (int ai = 0; ai < 2; ++ai)
#pragma unroll
            for (int m = 0; m < 4; ++m) { const float r = *(const PG8_LAS float*)(lds + 131072 + (ui & 1) * 2048 + (ai * HALF + wr * 64 + m * 16 + fr) * 8);
#pragma unroll
                for (int bj = 0; bj < 2; ++bj)
#pragma unroll
                    for (int n = 0; n < 2; ++n) acc[ai][bj][m][n] = acc[ai][bj][m][n] * r; }
    }
    __device__ __forceinline__ void operator()(const f32x4 (&acc)[2][2][4][2], const Unit& u, int ui, int wr, int wc, int fr, int fq, PG8_LAS unsigned char* lds) const {
#pragma unroll
        for (int ai = 0; ai < 2; ++ai)
#pragma unroll
            for (int m = 0; m < 4; ++m) {
                const int rl = ai * HALF + wr * 64 + m * 16 + fr;
                const float rb = *(const PG8_LAS float*)(lds + 131072 + (ui & 1) * 2048 + rl * 8 + 4);
                float* rowp = O + (size_t)(u.pm * BM + rl) * D + u.pn * BM + wc * 32 + 4 * fq;
#pragma unroll
                for (int bj = 0; bj < 2; ++bj)
#pragma unroll
                    for (int n = 0; n < 2; ++n) *(f32x4*)(rowp + bj * HALF + 16 * n) = acc[ai][bj][m][n] * rb;
            }
    }
};
struct EpiSwiglu {
    static constexpr bool MIDSCALE = false, PERM = false;
    unsigned char* act; const float* b1;
    __device__ __forceinline__ void operator()(const f32x4 (&acc)[2][2][4][2], const Unit& u, int wr, int wc, int fr, int fq) const {
#pragma unroll
        for (int bj = 0; bj < 2; ++bj) {
            const int f0 = 16 * (8 * u.pn + 4 * bj + wc) + 4 * fq;
            const f32x4* bp = (const f32x4*)(b1 + (size_t)u.e * 2048 + 2 * f0); const f32x4 bA = bp[0], bB = bp[1];
            const f32x4 bg = {bA.x, bA.z, bB.x, bB.z}, bl = {bA.y, bA.w, bB.y, bB.w};
#pragma unroll
            for (int ai = 0; ai < 2; ++ai)
#pragma unroll
                for (int m = 0; m < 4; ++m) {
                    const int row = u.pm * BM + ai * HALF + wr * 64 + m * 16 + fr;
                    const f32x4 gt = acc[ai][bj][m][0] * W8_INV + bg, ln = acc[ai][bj][m][1] * W8_INV + bl; float a[4];
#pragma unroll
                    for (int j = 0; j < 4; ++j) { const float gg = fminf(gt[j], 7.f), ll = fminf(fmaxf(ln[j], -7.f), 7.f);
                        a[j] = gg * __builtin_amdgcn_rcpf(1.f + __expf(-1.702f * gg)) * (ll + 1.f); }
                    *(unsigned*)(act + (size_t)row * D + f0) = pk4_fp8(a[0], a[1], a[2], a[3]);
                }
        }
    }
};
struct EpiScatter {
    static constexpr bool MIDSCALE = false, PERM = true;
    bf16_t* y; const float* b2; const int* eslot; const float* ew; const PG8_LAS int* sb;
    __device__ __forceinline__ void operator()(const f32x4 (&acc)[2][2][4][2], const Unit& u, int wr, int wc, int fr, int fq) const {
        const int col0 = u.pn * BM + wc * 32 + 8 * fq;
        f32x4 bv[2][2];
#pragma unroll
        for (int bj = 0; bj < 2; ++bj)
#pragma unroll
            for (int n = 0; n < 2; ++n) bv[bj][n] = *(const f32x4*)(b2 + (size_t)u.e * D + col0 + bj * HALF + 4 * n);
#pragma unroll
        for (int ai = 0; ai < 2; ++ai)
#pragma unroll
            for (int m = 0; m < 4; ++m) {
                const int row = u.pm * BM + ai * HALF + wr * 64 + m * 16 + fr;
                const int rk = row - sb[u.e], cn = sb[40 + u.e]; const int rkc = rk < cn - 1 ? rk : cn - 1;
                const int slot = eslot[(size_t)u.e * ECAP + rkc]; const float w = ew[(size_t)u.e * ECAP + rkc];
                if (rk < cn) {
                    bf16_t* rowp = y + (size_t)slot * D + col0;
#pragma unroll
                    for (int bj = 0; bj < 2; ++bj) { const f32x4 v0 = (acc[ai][bj][m][0] * W8_INV + bv[bj][0]) * w, v1 = (acc[ai][bj][m][1] * W8_INV + bv[bj][1]) * w;
                        u32x4 o; o.x = pk2(v0.x, v0.y); o.y = pk2(v0.z, v0.w); o.z = pk2(v1.x, v1.y); o.w = pk2(v1.z, v1.w);
                        *(u32x4*)(rowp + bj * HALF) = o; }
                }
            }
    }
};
}

__device__ void p0_mod(const Params& p, float* sS  , float* sP  ) {
    float* mod = (float*)(p.ws + WS_MOD);
    const int tid = tid_opaque(), lane = tid & 63, wave = tid >> 6;
    if (blockIdx.x >= 96) return;
    for (int i = tid; i < 9 * D; i += NTHREADS) { const int r = i >> 10, k = i & 1023; const float cc = r < 8 ? p.c[r * D + k] : p.c_ctx[k]; sS[i] = cc / (1.f + __expf(-cc)); }
    __syncthreads();
    const int j = blockIdx.x * 64 + lane;
    float acc[9];
#pragma unroll
    for (int r = 0; r < 9; ++r) acc[r] = 0.f;
    const float* wp = p.w_ada + (size_t)(wave * 128) * 6144 + j;
#pragma unroll 1
    for (int k0 = 0; k0 < 128; k0 += 16) {
        float w[16];
#pragma unroll
        for (int kk = 0; kk < 16; ++kk) w[kk] = wp[(size_t)(k0 + kk) * 6144];
#pragma unroll
        for (int kk = 0; kk < 16; ++kk)
#pragma unroll
            for (int r = 0; r < 9; ++r) acc[r] = fmaf(sS[r * D + wave * 128 + k0 + kk], w[kk], acc[r]);
    }
#pragma unroll
    for (int r = 0; r < 9; ++r) sP[(wave * 9 + r) * 64 + lane] = acc[r];
    __syncthreads();
    for (int i = tid; i < 9 * 64; i += NTHREADS) { const int r = i >> 6, jj = i & 63; float s = p.b_ada[blockIdx.x * 64 + jj];
#pragma unroll
        for (int w = 0; w < 8; ++w) s += sP[(w * 9 + r) * 64 + jj];
        mod[r * 6144 + blockIdx.x * 64 + jj] = s; }
    __syncthreads();
}
__device__ void p0_tab(const Params& p) {
    float* tab = (float*)(p.ws + WS_TAB);
    const int gtid = blockIdx.x * NTHREADS + tid_opaque(), gsize = gridDim.x * NTHREADS;
    for (int idx = gtid; idx < 64 * 16; idx += gsize) {
        const int pos = idx >> 4, i = idx & 15;
        const float freq = exp2f(-(float)i * (13.287712379549449f / 16.f));
        const float ang = (float)pos * freq;
        const float n = rintf(ang * 0.15915494309189535f);
        float r = fmaf(-n, 6.28125f, ang); r = fmaf(-n, 1.9353071795864769e-3f, r);
        tab[idx * 2] = __cosf(r); tab[idx * 2 + 1] = __sinf(r);
    }
}
template <int MODE>
__device__ __forceinline__ void conv_item(const float* src, int K, int N, bf16_t* dst, int item, float* scr, int lane, const float* gA, const float* gB) {
    const int nblk = N / 32, kb = item / nblk, nb = item % nblk, k0 = 64 * kb, n0 = 32 * nb;
    const int c = lane & 31, kh = lane >> 5;
    const int nl = MODE == 1 ? 16 * (c & 1) + (c >> 1) : c;
    float v[32];
    const float* sp = src + (size_t)(k0 + kh) * N + n0 + c;
#pragma unroll
    for (int i = 0; i < 32; ++i) v[i] = sp[(size_t)(2 * i) * N];
#pragma unroll
    for (int i = 0; i < 32; ++i) { float x = v[i]; if (MODE == 2) { const int k = k0 + 2 * i + kh; x *= (k < 512 ? gA[k] : gB[k - 512]); } scr[(2 * i + kh) * 33 + nl] = x; }
    asm volatile("s_waitcnt lgkmcnt(0)" ::: "memory");
    const int ch = lane & 7;
#pragma unroll
    for (int j = 0; j < 4; ++j) { const int n = (lane >> 3) + 8 * j; const float* s = scr + (8 * ch) * 33 + n;
        u32x4 o; o.x = pk2(s[0 * 33], s[1 * 33]); o.y = pk2(s[2 * 33], s[3 * 33]); o.z = pk2(s[4 * 33], s[5 * 33]); o.w = pk2(s[6 * 33], s[7 * 33]);
        *(u32x4*)(dst + (size_t)(n0 + n) * K + k0 + 8 * ch) = o; }
    asm volatile("s_waitcnt lgkmcnt(0)" ::: "memory");
}
template <bool PERM1>
__device__ __forceinline__ void conv_item8(const float* src, int K, int N, unsigned char* dst, int item, float* scr, int lane) {
    const int nblk = N / 32, kb = item / nblk, nb = item % nblk, k0 = 64 * kb, n0 = 32 * nb;
    const int c = lane & 31, kh = lane >> 5;
    const int nl = PERM1 ? 16 * (c & 1) + (c >> 1) : c;
    float v[32];
    const float* sp = src + (size_t)(k0 + kh) * N + n0 + c;
#pragma unroll
    for (int i = 0; i < 32; ++i) v[i] = sp[(size_t)(2 * i) * N];
#pragma unroll
    for (int i = 0; i < 32; ++i) scr[(2 * i + kh) * 33 + nl] = v[i] * W8_SCALE;
    asm volatile("s_waitcnt lgkmcnt(0)" ::: "memory");
    const int ch = lane & 3;
#pragma unroll
    for (int j = 0; j < 2; ++j) { const int n = (lane >> 2) + 16 * j; const float* s = scr + (16 * ch) * 33 + n;
        u32x4 o; o.x = pk4_fp8(s[0 * 33], s[1 * 33], s[2 * 33], s[3 * 33]); o.y = pk4_fp8(s[4 * 33], s[5 * 33], s[6 * 33], s[7 * 33]);
        o.z = pk4_fp8(s[8 * 33], s[9 * 33], s[10 * 33], s[11 * 33]); o.w = pk4_fp8(s[12 * 33], s[13 * 33], s[14 * 33], s[15 * 33]);
        *(u32x4*)(dst + (size_t)(n0 + n) * K + k0 + 16 * ch) = o; }
    asm volatile("s_waitcnt lgkmcnt(0)" ::: "memory");
}
__device__ void p0_weights(const Params& p, unsigned char* ldsb) {
    const int tid = tid_opaque(), lane = tid & 63, wave = tid >> 6; float* scr = (float*)(ldsb + 57344 + wave * 8448);
    const int gw = blockIdx.x * (NTHREADS / 64) + wave, ngw = gridDim.x * (NTHREADS / 64);
    constexpr int I_IN = 16 * 72, I_OUT = 16 * 32, I_W1 = 16 * 64, I_W2 = 16 * 32;
    constexpr int NITEMS = I_IN + I_OUT + NE * I_W1 + NE * I_W2;
    for (int it = gw; it < NITEMS; it += ngw) {
        int r = it;
        if (r < I_IN) { conv_item<0>(p.w_in, D, INW, (bf16_t*)(p.ws + WS_WIN), r, scr, lane, nullptr, nullptr); continue; } r -= I_IN;
        if (r < I_OUT) { conv_item<2>(p.w_out, D, D, (bf16_t*)(p.ws + WS_WOUT), r, scr, lane, p.g_grp_a, p.g_grp_b); continue; } r -= I_OUT;
        if (r < NE * I_W1) { const int e = r / I_W1, q = r % I_W1;
            conv_item8<true>(p.w_mlp1 + (size_t)e * D * 2048, D, 2048, p.ws + WS_W1 + (size_t)e * 2048 * D, q, scr, lane); continue; } r -= NE * I_W1;
        { const int e = r / I_W2, q = r % I_W2;
            conv_item8<false>(p.w_mlp2 + (size_t)e * D * D, D, D, p.ws + WS_W2 + (size_t)e * D * D, q, scr, lane); }
    }
}

__device__ void p1_h(const Params& p) {
    const int tid = tid_opaque(), lane = tid & 63;
    const float* mod = (const float*)(p.ws + WS_MOD);
    bf16_t* hb = (bf16_t*)(p.ws + WS_HB);
    constexpr int R = 17;
    const int gwv = blockIdx.x * (NTHREADS / 64) + (tid >> 6);
    const int m0 = gwv * R; if (m0 >= MROWS) return;
    const int m1 = m0 + R < MROWS ? m0 + R : MROWS;
    f32x4 pB[4], pC[4], v[4], nv[4]; int curb = -1;
#define P1_ROWPTR(m) ((m) < NTOK ? p.x + (size_t)(m) * D : p.ctx + (size_t)((m) - NTOK) * D)
    { const float* xr = P1_ROWPTR(m0);
#pragma unroll
      for (int j = 0; j < 4; ++j) nv[j] = ((const f32x4*)xr)[lane + 64 * j]; }
    for (int m = m0; m < m1; ++m) {
#pragma unroll
        for (int j = 0; j < 4; ++j) v[j] = nv[j];
        if (m + 1 < m1) { const float* xr = P1_ROWPTR(m + 1);
#pragma unroll
            for (int j = 0; j < 4; ++j) nv[j] = ((const f32x4*)xr)[lane + 64 * j]; }
        const int b = m < NTOK ? m / L : 8;
        if (b != curb) { curb = b; const float* sh = mod + b * 6144, * sc = sh + 1024;
#pragma unroll
            for (int j = 0; j < 4; ++j) { const int c0 = 4 * (lane + 64 * j); pB[j] = *(const f32x4*)(p.g_pre_mix + c0) * (*(const f32x4*)(sc + c0) + 1.f); pC[j] = *(const f32x4*)(sh + c0); } }
        float s = 0.f;
#pragma unroll
        for (int j = 0; j < 4; ++j) s += v[j].x * v[j].x + v[j].y * v[j].y + v[j].z * v[j].z + v[j].w * v[j].w;
        const float rstd = rsqrtf(wave_sum(s) * (1.f / D) + EPS);
#pragma unroll
        for (int j = 0; j < 4; ++j) { const int c0 = 4 * (lane + 64 * j);
            const f32x4 o = (v[j] * rstd) * pB[j] + pC[j];
            u32x2 w; w.x = pk2(o.x, o.y); w.y = pk2(o.z, o.w);
            *(u32x2*)(hb + (size_t)m * D + c0) = w; }
    }
#undef P1_ROWPTR
}

template <class AL, class BL, class EP>
__device__ __forceinline__ void ngemm_tile(float* sA, float* sB, int m0, int n0, int K, const AL& aload, const BL& bload, const EP& epi) {
    const int tid = threadIdx.x, ty = tid >> 4, tx = tid & 15;
    float acc[4][4];
#pragma unroll
    for (int i = 0; i < 4; ++i)
#pragma unroll
        for (int j = 0; j < 4; ++j) acc[i][j] = 0.f;
    for (int k0 = 0; k0 < K; k0 += 16) {
#pragma unroll
        for (int i = 0; i < 4; ++i) { const int e = tid + NTHREADS * i, r = e >> 4, kk = e & 15; sA[kk * 132 + r] = aload(m0 + r, k0 + kk); }
#pragma unroll
        for (int i = 0; i < 2; ++i) { const int e = tid + NTHREADS * i, n = e >> 4, kk = e & 15; sB[kk * 68 + n] = bload(n0 + n, k0 + kk); }
        __syncthreads();
#pragma unroll
        for (int kk = 0; kk < 16; ++kk) {
            float a[4], b[4];
#pragma unroll
            for (int i = 0; i < 4; ++i) a[i] = sA[kk * 132 + ty * 4 + i];
#pragma unroll
            for (int j = 0; j < 4; ++j) b[j] = sB[kk * 68 + tx + 16 * j];
#pragma unroll
            for (int i = 0; i < 4; ++i)
#pragma unroll
                for (int j = 0; j < 4; ++j) acc[i][j] = fmaf(a[i], b[j], acc[i][j]);
        }
        __syncthreads();
    }
    epi(m0 + ty * 4, n0, tx, acc);
}

__device__ void p2_qkv_naive(const Params& p, float* sA, float* sB) {
    const bf16_t* hb = (const bf16_t*)(p.ws + WS_HB); const bf16_t* wT = (const bf16_t*)(p.ws + WS_WIN);
    bf16_t* qkv = (bf16_t*)(p.ws + WS_QKV); const float* tab = (const float*)(p.ws + WS_TAB);
    constexpr int NTN = INW / 64, NT = (MROWS / 128) * NTN;
    for (int t = blockIdx.x; t < NT; t += gridDim.x) {
        const int m0 = (t / NTN) * 128, n0 = (t % NTN) * 64;
        auto al = [&](int r, int k) { return bf2f(hb[(size_t)r * D + k]); };
        auto bl = [&](int n, int k) { return bf2f(wT[(size_t)n * D + k]); };
        auto ep = [&](int r0, int nn0, int tx, float (&acc)[4][4]) {
#pragma unroll
            for (int i = 0; i < 4; ++i) {
                const int r = r0 + i; float v0 = acc[i][0], v1 = acc[i][1], v2 = acc[i][2], v3 = acc[i][3];
                const bool rope = (nn0 < C_VA) && (r < NTOK);
                if (rope) { const int t = r & (L - 1), pr = t >> 6, pc = t & 63;
                    const float c0 = tab[(pr * 16 + tx) * 2], s0 = tab[(pr * 16 + tx) * 2 + 1], c1 = tab[(pc * 16 + tx) * 2], s1 = tab[(pc * 16 + tx) * 2 + 1];
                    const float a0 = v0 * c0 - v1 * s0, a1 = v1 * c0 + v0 * s0, a2 = v2 * c1 - v3 * s1, a3 = v3 * c1 + v2 * s1; v0 = a0; v1 = a1; v2 = a2; v3 = a3; }
                const bool isq = (nn0 < C_KA) || (nn0 >= C_QB && nn0 < C_KB);
                if (isq) { v0 *= QSCALE; v1 *= QSCALE; v2 *= QSCALE; v3 *= QSCALE; }
                bf16_t* o = qkv + (size_t)r * INW + nn0 + tx;
                o[0] = (bf16_t)f2bf(v0); o[16] = (bf16_t)f2bf(v1); o[32] = (bf16_t)f2bf(v2); o[48] = (bf16_t)f2bf(v3);
            }
        };
        ngemm_tile(sA, sB, m0, n0, D, al, bl, ep);
    }
}

__device__ __forceinline__ void load_row64(const bf16_t* src, float* dst) {
#pragma unroll
    for (int c = 0; c < 8; ++c) { const u32x4 w = *(const u32x4*)(src + c * 8);
        dst[c * 8 + 0] = __uint_as_float(w.x << 16); dst[c * 8 + 1] = __uint_as_float(w.x & 0xffff0000u);
        dst[c * 8 + 2] = __uint_as_float(w.y << 16); dst[c * 8 + 3] = __uint_as_float(w.y & 0xffff0000u);
        dst[c * 8 + 4] = __uint_as_float(w.z << 16); dst[c * 8 + 5] = __uint_as_float(w.z & 0xffff0000u);
        dst[c * 8 + 6] = __uint_as_float(w.w << 16); dst[c * 8 + 7] = __uint_as_float(w.w & 0xffff0000u); }
}
struct OnlineSm { float m, l; };
__device__ __forceinline__ void attn_key(const float (&q)[64], float (&o)[64], OnlineSm& st, const bf16_t* krow, const bf16_t* vrow, float bias) {
    float s = bias;
#pragma unroll
    for (int c = 0; c < 8; ++c) { const u32x4 w = *(const u32x4*)(krow + c * 8);
        s = fmaf(q[c * 8 + 0], __uint_as_float(w.x << 16), s); s = fmaf(q[c * 8 + 1], __uint_as_float(w.x & 0xffff0000u), s);
        s = fmaf(q[c * 8 + 2], __uint_as_float(w.y << 16), s); s = fmaf(q[c * 8 + 3], __uint_as_float(w.y & 0xffff0000u), s);
        s = fmaf(q[c * 8 + 4], __uint_as_float(w.z << 16), s); s = fmaf(q[c * 8 + 5], __uint_as_float(w.z & 0xffff0000u), s);
        s = fmaf(q[c * 8 + 6], __uint_as_float(w.w << 16), s); s = fmaf(q[c * 8 + 7], __uint_as_float(w.w & 0xffff0000u), s); }
    const float mn = fmaxf(st.m, s), sc = exp2f(st.m - mn), pp = exp2f(s - mn);
    st.l = st.l * sc + pp; st.m = mn;
#pragma unroll
    for (int c = 0; c < 8; ++c) { const u32x4 w = *(const u32x4*)(vrow + c * 8);
        o[c * 8 + 0] = fmaf(pp, __uint_as_float(w.x << 16), o[c * 8 + 0] * sc); o[c * 8 + 1] = fmaf(pp, __uint_as_float(w.x & 0xffff0000u), o[c * 8 + 1] * sc);
        o[c * 8 + 2] = fmaf(pp, __uint_as_float(w.y << 16), o[c * 8 + 2] * sc); o[c * 8 + 3] = fmaf(pp, __uint_as_float(w.y & 0xffff0000u), o[c * 8 + 3] * sc);
        o[c * 8 + 4] = fmaf(pp, __uint_as_float(w.z << 16), o[c * 8 + 4] * sc); o[c * 8 + 5] = fmaf(pp, __uint_as_float(w.z & 0xffff0000u), o[c * 8 + 5] * sc);
        o[c * 8 + 6] = fmaf(pp, __uint_as_float(w.w << 16), o[c * 8 + 6] * sc); o[c * 8 + 7] = fmaf(pp, __uint_as_float(w.w & 0xffff0000u), o[c * 8 + 7] * sc); }
}
__device__ __forceinline__ void store_o64(bf16_t* dst, const float (&o)[64], float inv) {
#pragma unroll
    for (int c = 0; c < 8; ++c) { u32x4 w; w.x = pk2(o[c * 8] * inv, o[c * 8 + 1] * inv); w.y = pk2(o[c * 8 + 2] * inv, o[c * 8 + 3] * inv);
        w.z = pk2(o[c * 8 + 4] * inv, o[c * 8 + 5] * inv); w.w = pk2(o[c * 8 + 6] * inv, o[c * 8 + 7] * inv); *(u32x4*)(dst + c * 8) = w; }
}
__device__ void p3_attn_naive(const Params& p, int gtid, int gsize) {
    const bf16_t* qkv = (const bf16_t*)(p.ws + WS_QKV); bf16_t* ob = (bf16_t*)(p.ws + WS_O);
    for (int it = gtid; it < NTOK * 16; it += gsize) {
        const bool isB = it >= NTOK * 8; const int w = isB ? it - NTOK * 8 : it;
        const int h = w & 7, tokg = w >> 3, b = tokg / L, t = tokg % L;
        float q[64], o[64];
#pragma unroll
        for (int d = 0; d < 64; ++d) o[d] = 0.f;
        OnlineSm st;
        if (!isB) {
            const int kvh = h >> 2;
            load_row64(qkv + (size_t)tokg * INW + C_QA + h * 64, q);
            st.m = p.sink_a[h] * LOG2E; st.l = 1.f;
            const int j0 = t - 128 < 0 ? 0 : t - 128, j1 = t + 128 > L - 1 ? L - 1 : t + 128;
            for (int j = j0; j <= j1; ++j) { const bf16_t* row = qkv + (size_t)(b * L + j) * INW; attn_key(q, o, st, row + C_KA + kvh * 64, row + C_VA + kvh * 64, 0.f); }
            for (int c = 0; c < CTX; ++c) { const bf16_t* row = qkv + (size_t)(NTOK + b * CTX + c) * INW; attn_key(q, o, st, row + C_KA + kvh * 64, row + C_VA + kvh * 64, 0.f); }
            store_o64(ob + (size_t)tokg * D + h * 64, o, 1.f / st.l);
        } else {
            load_row64(qkv + (size_t)tokg * INW + C_QB + h * 64, q);
            st.m = -1e30f; st.l = 0.f;
            const int r = t >> 6, c = t & 63;
            const int rs = r - 4 < 0 ? 0 : (r - 4 > 56 ? 56 : r - 4), cs = c - 8 < 0 ? 0 : (c - 8 > 48 ? 48 : c - 8);
            for (int a = 0; a < 8; ++a)
                for (int e = 0; e < 16; ++e) { const int kr = rs + a, kc = cs + e; const bf16_t* row = qkv + (size_t)(b * L + kr * 64 + kc) * INW;
                    const float bias = p.rpb_b[(h * 15 + (kr - r + 7)) * 31 + (kc - c + 15)] * LOG2E;
                    attn_key(q, o, st, row + C_KB + h * 64, row + C_VB + h * 64, bias); }
            for (int cc = 0; cc < CTX; ++cc) { const bf16_t* row = qkv + (size_t)(NTOK + b * CTX + cc) * INW; attn_key(q, o, st, row + C_KB + h * 64, row + C_VB + h * 64, 0.f); }
            store_o64(ob + (size_t)tokg * D + 512 + h * 64, o, 1.f / st.l);
        }
    }
}


namespace att {
#define ATT_LAS __attribute__((address_space(3)))
typedef float f32x16 __attribute__((ext_vector_type(16)));
typedef short bf16x8 __attribute__((ext_vector_type(8)));
typedef short s16x4 __attribute__((ext_vector_type(4)));
constexpr int SLOTB = 8192, NSLOT = 4;
constexpr int LDS_K = 0, LDS_V = NSLOT * SLOTB, LDS_WS = 2 * NSLOT * SLOTB, LDS_BT = LDS_WS + 8 * 256;
constexpr int BT_MARGIN = 64, BT_FLOATS = BT_MARGIN + 15 * 32 + 96;
constexpr float NEGBIG = -1e30f;
__device__ __forceinline__ int crow(int r, int hi) { return (r & 3) + 8 * (r >> 2) + 4 * hi; }
__device__ __forceinline__ unsigned cvtpk(float lo, float hi) { typedef float f2 __attribute__((ext_vector_type(2))); typedef __bf16 b2 __attribute__((ext_vector_type(2)));
    f2 v = {lo, hi}; b2 b = __builtin_convertvector(v, b2); return __builtin_bit_cast(unsigned, b); }
__device__ __forceinline__ s16x4 vtr(const ATT_LAS unsigned char* p) { typedef short v4i16 __attribute__((ext_vector_type(4)));
    return __builtin_bit_cast(s16x4, __builtin_amdgcn_ds_read_tr16_b64_v4i16((ATT_LAS v4i16*)p)); }
#define ATT_WAIT_BAR(N) asm volatile("s_waitcnt vmcnt(" #N ") lgkmcnt(0)\n\ts_barrier" ::: "memory")

__device__ __forceinline__ void dma_tile(ATT_LAS unsigned char* lds, int slot, const bf16_t* kbase, const bf16_t* vbase, int wid, int lane) {
    const bf16_t* ksrc = kbase + (size_t)lane * INW + wid * 8;
    const bf16_t* vsrc = vbase + (size_t)(16 * (wid & 3) + (lane >> 2)) * INW + (wid >> 2) * 32 + (lane & 3) * 8;
    __builtin_amdgcn_global_load_lds((const unsigned*)ksrc, (ATT_LAS unsigned*)(lds + LDS_K + slot * SLOTB + wid * 1024), 16, 0, 0);
    __builtin_amdgcn_global_load_lds((const unsigned*)vsrc, (ATT_LAS unsigned*)(lds + LDS_V + slot * SLOTB + wid * 1024), 16, 0, 0);
}

template <bool ISB>
__device__ __forceinline__ void attn_unit(const Params& p, ATT_LAS unsigned char* lds, int unit) {
    int tid_ = threadIdx.x; asm volatile("" : "+v"(tid_));
    const int tid = tid_, lane = tid & 63, r32 = lane & 31, hi = lane >> 5; const int wid = __builtin_amdgcn_readfirstlane(tid >> 6);
    const bf16_t* qkv = (const bf16_t*)(p.ws + WS_QKV); bf16_t* ob = (bf16_t*)(p.ws + WS_O);
    ATT_LAS float* wsf = (ATT_LAS float*)(lds + LDS_WS) + wid * 64;
    ATT_LAS float* bt = (ATT_LAS float*)(lds + LDS_BT);
    int b, h, kcol, vcol, qcol, ocol, q0, nloc, row_lo = 0, qr = 0, half = 0, qb = 0, jlo = 0;
    if (!ISB) { b = unit >> 7; const int kvh = (unit >> 6) & 1; qb = unit & 63; h = kvh * 4 + (wid >> 1); half = wid & 1; q0 = qb * 64 + 32 * half;
        kcol = C_KA + kvh * 64; vcol = C_VA + kvh * 64; qcol = C_QA + h * 64; ocol = h * 64;
        jlo = 2 - qb > 0 ? 2 - qb : 0; const int jhi = 65 - qb < 4 ? 65 - qb : 4; nloc = jhi - jlo + 1;
    } else { b = unit >> 7; h = (unit >> 4) & 7; const int g = unit & 15; qr = 4 * g + (wid >> 1); half = wid & 1; q0 = qr * 64 + 32 * half;
        kcol = C_KB + h * 64; vcol = C_VB + h * 64; qcol = C_QB + h * 64; ocol = 512 + h * 64;
        const int r0 = 4 * g, r3 = 4 * g + 3; row_lo = r0 - 4 < 0 ? 0 : (r0 - 4 > 56 ? 56 : r0 - 4); const int rs3 = r3 - 4 < 0 ? 0 : (r3 - 4 > 56 ? 56 : r3 - 4); nloc = rs3 + 7 - row_lo + 1;
    }
    const int NT = nloc + 4;
    const bf16_t* lat = qkv + (size_t)b * L * INW; const bf16_t* cx = qkv + (size_t)(NTOK + b * CTX) * INW;
#define ATT_TILE_ROW(t) ((t) < nloc ? lat + (size_t)(ISB ? (row_lo + (t)) * 64 : (qb - 2 + jlo + (t)) * 64) * INW : cx + (size_t)((t) - nloc) * 64 * INW)
    if (ISB) {
        for (int i = tid; i < BT_FLOATS; i += NTHREADS) { const int j = i - BT_MARGIN; float v = 0.f;
            if (j >= 0 && j < 15 * 32 && (j & 31) < 31) v = p.rpb_b[(h * 15 + (j >> 5)) * 31 + (j & 31)] * LOG2E;
            bt[i] = v; }
    }
#pragma unroll
    for (int t0 = 0; t0 < NSLOT - 1; ++t0) { const bf16_t* r0p = ATT_TILE_ROW(t0); dma_tile(lds, t0, r0p + kcol, r0p + vcol, wid, lane); }
    bf16x8 qf[4];
    { const bf16_t* qp = lat + (size_t)(q0 + r32) * INW + qcol + hi * 8;
#pragma unroll
      for (int d0 = 0; d0 < 4; ++d0) qf[d0] = *(const bf16x8*)(qp + d0 * 16); }
    float m_run, l_run;
    if (!ISB) { m_run = p.sink_a[h] * LOG2E; l_run = hi == 0 ? 1.f : 0.f; } else { m_run = NEGBIG; l_run = 0.f; }
    f32x16 o0, o1;
#pragma unroll
    for (int r = 0; r < 16; ++r) { o0[r] = 0.f; o1[r] = 0.f; }
    const int qc = 32 * half + r32;
    const int cs = qc - 8 < 0 ? 0 : (qc - 8 > 48 ? 48 : qc - 8);
    const int rsq = qr - 4 < 0 ? 0 : (qr - 4 > 56 ? 56 : qr - 4);
    for (int t = 0; t < NT; ++t) {
        const int ahead = NT - 1 - t < NSLOT - 2 ? NT - 1 - t : NSLOT - 2;
        if (ahead == 2) ATT_WAIT_BAR(4); else if (ahead == 1) ATT_WAIT_BAR(2); else ATT_WAIT_BAR(0);
        if (t + NSLOT - 1 < NT) { const bf16_t* rp = ATT_TILE_ROW(t + NSLOT - 1); dma_tile(lds, (t + NSLOT - 1) & (NSLOT - 1), rp + kcol, rp + vcol, wid, lane); }
        const int slot = t & (NSLOT - 1);
        bool active = true; int kr = 0;
        if (ISB && t < nloc) { kr = row_lo + t; active = (kr >= rsq) && (kr <= rsq + 7); }
        if (active) {
            const ATT_LAS unsigned char* kb = lds + LDS_K + slot * SLOTB + hi * 1024 + r32 * 16;
            f32x16 p0, p1;
#pragma unroll
            for (int r = 0; r < 16; ++r) { p0[r] = 0.f; p1[r] = 0.f; }
#pragma unroll
            for (int d0 = 0; d0 < 4; ++d0) {
                const bf16x8 k0 = *(const ATT_LAS bf16x8*)(kb + d0 * 2048), k1 = *(const ATT_LAS bf16x8*)(kb + d0 * 2048 + 512);
                p0 = __builtin_amdgcn_mfma_f32_32x32x16_bf16(k0, qf[d0], p0, 0, 0, 0);
                p1 = __builtin_amdgcn_mfma_f32_32x32x16_bf16(k1, qf[d0], p1, 0, 0, 0);
            }
            if (ISB) {
                if (t < nloc) {
                    const ATT_LAS float* bp = bt + BT_MARGIN + (kr - qr + 7) * 32 + 15 - qc + 4 * hi;
                    const int e0 = 4 * hi - cs;
#pragma unroll
                    for (int r = 0; r < 16; ++r) { const int c = (r & 3) + 8 * (r >> 2);
                        const float b0 = bp[c], b1 = bp[c + 32];
                        p0[r] = ((unsigned)(c + e0) < 16u) ? p0[r] + b0 : NEGBIG;
                        p1[r] = ((unsigned)(c + 32 + e0) < 16u) ? p1[r] + b1 : NEGBIG; }
                }
            } else {
                if (t < nloc) { const int j = jlo + t; const int qq = 32 * half + r32;
                    if (j == 0) {
#pragma unroll
                        for (int r = 0; r < 16; ++r) { const int c = crow(r, hi); if (c < qq) p0[r] = NEGBIG; if (c + 32 < qq) p1[r] = NEGBIG; }
                    } else if (j == 4) {
#pragma unroll
                        for (int r = 0; r < 16; ++r) { const int c = crow(r, hi); if (c > qq) p0[r] = NEGBIG; if (c + 32 > qq) p1[r] = NEGBIG; }
                    }
                }
            }
            float rm = fmaxf(p0[0], p1[0]);
#pragma unroll
            for (int r = 1; r < 16; ++r) rm = fmaxf(rm, fmaxf(p0[r], p1[r]));
            rm = fmaxf(rm, __shfl_xor(rm, 32));
            const float mnew = fmaxf(m_run, rm);
            if (__any(mnew > m_run)) {
                const float f = __builtin_amdgcn_exp2f(m_run - mnew);
                l_run *= f; m_run = mnew;
                if (hi == 0) wsf[r32] = f;
                asm volatile("s_waitcnt lgkmcnt(0)" ::: "memory");
#pragma unroll
                for (int r = 0; r < 16; ++r) { const float fr_ = wsf[crow(r, hi)]; o0[r] *= fr_; o1[r] *= fr_; }
            }
            float ls = 0.f;
#pragma unroll
            for (int r = 0; r < 16; ++r) { p0[r] = __builtin_amdgcn_exp2f(p0[r] - m_run); p1[r] = __builtin_amdgcn_exp2f(p1[r] - m_run); ls += p0[r] + p1[r]; }
            l_run += ls;
            typedef unsigned u4 __attribute__((ext_vector_type(4)));
            const u4 pw0 = {cvtpk(p0[0], p0[1]), cvtpk(p0[2], p0[3]), cvtpk(p0[4], p0[5]), cvtpk(p0[6], p0[7])};
            const u4 pw1 = {cvtpk(p0[8], p0[9]), cvtpk(p0[10], p0[11]), cvtpk(p0[12], p0[13]), cvtpk(p0[14], p0[15])};
            const u4 pw2 = {cvtpk(p1[0], p1[1]), cvtpk(p1[2], p1[3]), cvtpk(p1[4], p1[5]), cvtpk(p1[6], p1[7])};
            const u4 pw3 = {cvtpk(p1[8], p1[9]), cvtpk(p1[10], p1[11]), cvtpk(p1[12], p1[13]), cvtpk(p1[14], p1[15])};
            const ATT_LAS unsigned char* vp = lds + LDS_V + slot * SLOTB + ((lane >> 4) & 1) * 32 + (lane & 3) * 8 + (4 * hi + ((lane & 15) >> 2)) * 64;
#define ATT_PV(OACC, PW, D0, KS) do { const s16x4 lo_ = vtr(vp + (D0) * 4096 + (KS) * 1024), hi_ = vtr(vp + (D0) * 4096 + (KS) * 1024 + 512); \
                const bf16x8 vf_ = {lo_[0], lo_[1], lo_[2], lo_[3], hi_[0], hi_[1], hi_[2], hi_[3]}; \
                OACC = __builtin_amdgcn_mfma_f32_32x32x16_bf16(__builtin_bit_cast(bf16x8, PW), vf_, OACC, 0, 0, 0); } while (0)
            ATT_PV(o0, pw0, 0, 0); ATT_PV(o1, pw0, 1, 0); ATT_PV(o0, pw1, 0, 1); ATT_PV(o1, pw1, 1, 1);
            ATT_PV(o0, pw2, 0, 2); ATT_PV(o1, pw2, 1, 2); ATT_PV(o0, pw3, 0, 3); ATT_PV(o1, pw3, 1, 3);
#undef ATT_PV
        }
    }
    l_run += __shfl_xor(l_run, 32);
    if (hi == 0) wsf[32 + r32] = l_run;
    asm volatile("s_waitcnt lgkmcnt(0)" ::: "memory");
    bf16_t* op = ob + (size_t)(b * L + q0) * D + ocol + r32;
    float* ossp = (float*)(p.ws + WS_OSS) + (size_t)(b * L + q0) * 16 + (ocol >> 6);
#pragma unroll
    for (int r = 0; r < 16; ++r) { const int q = crow(r, hi); const float inv = __builtin_amdgcn_rcpf(wsf[32 + q]);
        const float a0 = o0[r] * inv, a1 = o1[r] * inv;
        op[(size_t)q * D] = (bf16_t)f2bf(a0); op[(size_t)q * D + 32] = (bf16_t)f2bf(a1);
        const float ss = row_sum16(a0 * a0 + a1 * a1);
        const float s01 = rdlane(ss, 0) + rdlane(ss, 16), s23 = rdlane(ss, 32) + rdlane(ss, 48);
        if (r32 == 0) ossp[(size_t)q * 16] = hi ? s23 : s01; }
    ATT_WAIT_BAR(0);
#undef ATT_TILE_ROW
}

__device__ __forceinline__ void attn_phase(const Params& p, ATT_LAS unsigned char* lds) {
    const int G = gridDim.x, bx = blockIdx.x;
    const int vcu = (G % 8 == 0) ? (bx % 8) * (G / 8) + bx / 8 : bx;
    for (int u = vcu; u < 2048; u += G) {
        if (u < 1024) attn_unit<false>(p, lds, u); else attn_unit<true>(p, lds, u - 1024);
    }
}
}

__device__ void p4a_ostat(const Params& p, int gw, int ngw, int lane) {
    bf16_t* ob = (bf16_t*)(p.ws + WS_O); float* os = (float*)(p.ws + WS_OSTAT);
    for (int m = gw; m < NTOK; m += ngw) {
        const u32x4 wa = *(const u32x4*)(ob + (size_t)m * D + lane * 8), wb = *(const u32x4*)(ob + (size_t)m * D + 512 + lane * 8);
        float sa = 0.f, sb = 0.f;
#pragma unroll
        for (int i = 0; i < 4; ++i) { const unsigned ua = wa[i], ub = wb[i]; const float a0 = __uint_as_float(ua << 16), a1 = __uint_as_float(ua & 0xffff0000u), b0 = __uint_as_float(ub << 16), b1 = __uint_as_float(ub & 0xffff0000u);
            sa += a0 * a0 + a1 * a1; sb += b0 * b0 + b1 * b1; }
        sa = wave_sum(sa); sb = wave_sum(sb);
        const float ra = rsqrtf(sa * (1.f / 512.f) + EPS), rb = rsqrtf(sb * (1.f / 512.f) + EPS);
        if (lane == 0) { os[m * 2] = ra; os[m * 2 + 1] = rb; }
        u32x4 oa, obb;
#pragma unroll
        for (int i = 0; i < 4; ++i) { const unsigned ua = wa[i], ub = wb[i];
            oa[i] = pk2(__uint_as_float(ua << 16) * ra, __uint_as_float(ua & 0xffff0000u) * ra); obb[i] = pk2(__uint_as_float(ub << 16) * rb, __uint_as_float(ub & 0xffff0000u) * rb); }
        *(u32x4*)(ob + (size_t)m * D + lane * 8) = oa; *(u32x4*)(ob + (size_t)m * D + 512 + lane * 8) = obb;
    }
}
__device__ void p4b_outproj_naive(const Params& p, float* sA, float* sB) {
    const bf16_t* ob = (const bf16_t*)(p.ws + WS_O); const bf16_t* wT = (const bf16_t*)(p.ws + WS_WOUT);
    float* mix = (float*)(p.ws + WS_MIX);
    constexpr int NTN = D / 64, NT = (NTOK / 128) * NTN;
    for (int t = blockIdx.x; t < NT; t += gridDim.x) {
        const int m0 = (t / NTN) * 128, n0 = (t % NTN) * 64;
        auto al = [&](int r, int k) { return bf2f(ob[(size_t)r * D + k]); };
        auto bl = [&](int n, int k) { return bf2f(wT[(size_t)n * D + k]); };
        auto ep = [&](int r0, int nn0, int tx, float (&acc)[4][4]) {
#pragma unroll
            for (int i = 0; i < 4; ++i)
#pragma unroll
                for (int j = 0; j < 4; ++j) mix[(size_t)(r0 + i) * D + nn0 + tx + 16 * j] = acc[i][j];
        };
        ngemm_tile(sA, sB, m0, n0, D, al, bl, ep);
    }
}
constexpr int SW_STRIDE = 36;

__device__ void p4c_post(const Params& p, LAS3 float* sW) {
    const int tid = tid_opaque(), lane = tid & 63;
    const float* mod = (const float*)(p.ws + WS_MOD); const float* mix = (const float*)(p.ws + WS_MIX);
    unsigned char* h8 = p.ws + WS_HB;
    unsigned* counts = (unsigned*)(p.ws + WS_CTL);
    int* eslot = (int*)(p.ws + WS_ESLOT); float* ew = (float*)(p.ws + WS_EW);
    const int wave = tid >> 6;
    LAS3 int* lcnt = (LAS3 int*)(sW + 1024 * SW_STRIDE) + 128;
    LAS3 int* lbase = lcnt + 32;
    LAS3 int* stg_slot = lbase + 32; LAS3 int* stg_e = stg_slot + 512; LAS3 float* stg_w = (LAS3 float*)(stg_e + 512);
    if (threadIdx.x < NE) lcnt[threadIdx.x] = 0;
    for (int i = threadIdx.x; i < D * 8; i += NTHREADS) { const int k = i >> 3, e4 = i & 7; const f32x4 w = ((const f32x4*)p.w_router)[i];
        LAS3 float* d = sW + ((k & 3) * 256 + (k >> 2)) * SW_STRIDE + e4 * 4; *(LAS3 f32x4*)d = w; }
    __syncthreads();
    constexpr int R = 16;
    const int m0 = ((int)blockIdx.x * (NTHREADS / 64) + wave) * R;
    if (m0 < NTOK) {
        const int b = m0 / L; const float* mb = mod + b * 6144;
        f32x4 pA[4], pB[4], pC[4], v[4], xx[4], nv[4], nx[4];
#pragma unroll
        for (int j = 0; j < 4; ++j) { const int c0 = 4 * (lane + 64 * j);
            pA[j] = *(const f32x4*)(p.g_post_mix + c0) * *(const f32x4*)(mb + 2048 + c0);
            pB[j] = *(const f32x4*)(p.g_pre_ffn + c0) * (*(const f32x4*)(mb + 4096 + c0) + 1.f);
            pC[j] = *(const f32x4*)(mb + 3072 + c0);
            nv[j] = ((const f32x4*)(mix + (size_t)m0 * D))[lane + 64 * j]; nx[j] = ((const f32x4*)(p.x + (size_t)m0 * D))[lane + 64 * j]; }
        for (int it = 0; it < R; ++it) {
            const int m = m0 + it;
#pragma unroll
            for (int j = 0; j < 4; ++j) { v[j] = nv[j]; xx[j] = nx[j]; }
            if (it + 1 < R) {
#pragma unroll
                for (int j = 0; j < 4; ++j) { nv[j] = ((const f32x4*)(mix + (size_t)(m + 1) * D))[lane + 64 * j]; nx[j] = ((const f32x4*)(p.x + (size_t)(m + 1) * D))[lane + 64 * j]; }
            }
            float s = 0.f;
#pragma unroll
            for (int j = 0; j < 4; ++j) s += v[j].x * v[j].x + v[j].y * v[j].y + v[j].z * v[j].z + v[j].w * v[j].w;
            float rstd = rsqrtf(wave_sum(s) * (1.f / D) + EPS);
            s = 0.f;
            f32x4 xv[4];
#pragma unroll
            for (int j = 0; j < 4; ++j) {
                xv[j] = xx[j] + pA[j] * (v[j] * rstd);
                ((f32x4*)(p.out + (size_t)m * D))[lane + 64 * j] = xv[j];
                s += xv[j].x * xv[j].x + xv[j].y * xv[j].y + xv[j].z * xv[j].z + xv[j].w * xv[j].w; }
            rstd = rsqrtf(wave_sum(s) * (1.f / D) + EPS);
            float lg[NE];
#pragma unroll
            for (int e = 0; e < NE; ++e) lg[e] = 0.f;
#pragma unroll
            for (int j = 0; j < 4; ++j) { const int c0 = 4 * (lane + 64 * j);
                const f32x4 h2 = (xv[j] * rstd) * pB[j] + pC[j];
                *(unsigned*)(h8 + (size_t)m * D + c0) = pk4_fp8(h2.x, h2.y, h2.z, h2.w);
#pragma unroll
                for (int q = 0; q < 4; ++q) { const float hv = h2[q]; const LAS3 f32x4* wr = (const LAS3 f32x4*)(sW + (q * 256 + lane + 64 * j) * SW_STRIDE);
#pragma unroll
                    for (int e4 = 0; e4 < 8; ++e4) { const f32x4 ww = wr[e4]; lg[e4 * 4] = fmaf(hv, ww.x, lg[e4 * 4]); lg[e4 * 4 + 1] = fmaf(hv, ww.y, lg[e4 * 4 + 1]); lg[e4 * 4 + 2] = fmaf(hv, ww.z, lg[e4 * 4 + 2]); lg[e4 * 4 + 3] = fmaf(hv, ww.w, lg[e4 * 4 + 3]); }
                    asm volatile("" ::: "memory"); }
            }
#pragma unroll
            for (int e = 0; e < NE; ++e) lg[e] = wave_sum(lg[e]) + p.b_router[e];
            float tv[4]; int ti[4]; unsigned used = 0u;
#pragma unroll
            for (int k = 0; k < 4; ++k) { float best = -3.4e38f; int bi = 0;
#pragma unroll
                for (int e = 0; e < NE; ++e) { const bool ok = !((used >> e) & 1u) && lg[e] > best; best = ok ? lg[e] : best; bi = ok ? e : bi; }
                tv[k] = best; ti[k] = bi; used |= 1u << bi; }
            const float e1 = __expf(tv[1] - tv[0]), e2 = __expf(tv[2] - tv[0]), e3 = __expf(tv[3] - tv[0]); const float inv = 1.f / (1.f + e1 + e2 + e3);
            const float tw[4] = {inv, e1 * inv, e2 * inv, e3 * inv};
            if (lane < 4) {
                int myi = ti[0]; float myw = tw[0];
#pragma unroll
                for (int k = 1; k < 4; ++k) if (lane == k) { myi = ti[k]; myw = tw[k]; }
                const int lr = __hip_atomic_fetch_add((LAS3 int*)&lcnt[myi], 1, __ATOMIC_RELAXED, __HIP_MEMORY_SCOPE_WORKGROUP);
                const int si = (wave * 16 + it) * 4 + lane;
                stg_slot[si] = m * 4 + lane; stg_e[si] = myi | (lr << 8); stg_w[si] = myw;
            }
        }
    }
    __syncthreads();
    if (threadIdx.x < NE) { const int c = lcnt[threadIdx.x]; lbase[threadIdx.x] = c ? (int)atomicAdd(&counts[threadIdx.x * 64], (unsigned)c) : 0; }
    __syncthreads();
    { const int si = threadIdx.x, w = si >> 6;
      if (((int)blockIdx.x * (NTHREADS / 64) + w) * R < NTOK) {
        const int ee = stg_e[si], e = ee & 255, lr = ee >> 8; const int rank = lbase[e] + lr;
        eslot[(size_t)e * ECAP + rank] = stg_slot[si]; ew[(size_t)e * ECAP + rank] = stg_w[si]; } }
    __syncthreads();
}
__device__ __forceinline__ void expert_bases(const unsigned* counts, int* sbase_  ) {
    LAS3 int* sbase = (LAS3 int*)sbase_;
    if (threadIdx.x < 64) {
        const int lane = threadIdx.x; const int cn = lane < NE ? (int)counts[lane * 64] : 0; const int c = (cn + 255) & ~255;
        int incl = c;
#pragma unroll
        for (int o = 1; o < 32; o <<= 1) { const int v = __shfl_up(incl, o); if (lane >= o) incl += v; }
        if (lane < NE) { sbase[lane] = incl - c; sbase[40 + lane] = cn; }
        if (lane == NE - 1) sbase[NE] = incl;
    }
    __syncthreads();
}
__device__ __forceinline__ void p6_load(const bf16_t* y, const float* out, int m, int lane, u32x4 (&yv)[2][4], f32x4 (&xv)[2][2]) {
#pragma unroll
    for (int j = 0; j < 2; ++j) { const int c0 = 8 * (lane + 64 * j);
#pragma unroll
        for (int k = 0; k < 4; ++k) yv[j][k] = *(const u32x4*)(y + (size_t)(m * 4 + k) * D + c0);
        xv[j][0] = *(const f32x4*)(out + (size_t)m * D + c0); xv[j][1] = *(const f32x4*)(out + (size_t)m * D + c0 + 4); }
}
__device__ void p6_final(const Params& p) {
    const int tid = tid_opaque(), lane = tid & 63;
    const float* mod = (const float*)(p.ws + WS_MOD); const bf16_t* y = (const bf16_t*)(p.ws + WS_Y);
    constexpr int R = 16;
    const int m0 = ((int)blockIdx.x * (NTHREADS / 64) + (tid >> 6)) * R;
    if (m0 >= NTOK) return;
    const int b = m0 / L; const float* ga2 = mod + b * 6144 + 5120;
    f32x4 pA[2][2];
#pragma unroll
    for (int j = 0; j < 2; ++j)
#pragma unroll
        for (int q = 0; q < 2; ++q) { const int c0 = 8 * (lane + 64 * j) + 4 * q; pA[j][q] = *(const f32x4*)(p.g_post_ffn + c0) * *(const f32x4*)(ga2 + c0); }
    u32x4 yv[2][4], ny[2][4]; f32x4 xv[2][2], nx[2][2];
    p6_load(y, p.out, m0, lane, ny, nx);
    for (int it = 0; it < R; ++it) {
        const int m = m0 + it;
#pragma unroll
        for (int j = 0; j < 2; ++j) {
#pragma unroll
            for (int k = 0; k < 4; ++k) yv[j][k] = ny[j][k];
            xv[j][0] = nx[j][0]; xv[j][1] = nx[j][1]; }
        if (it + 1 < R) p6_load(y, p.out, m + 1, lane, ny, nx);
        f32x4 a[2][2]; float s = 0.f;
#pragma unroll
        for (int j = 0; j < 2; ++j) { a[j][0] = (f32x4){0.f, 0.f, 0.f, 0.f}; a[j][1] = (f32x4){0.f, 0.f, 0.f, 0.f};
#pragma unroll
            for (int k = 0; k < 4; ++k) { const u32x4 w = yv[j][k];
                a[j][0].x += __uint_as_float(w.x << 16); a[j][0].y += __uint_as_float(w.x & 0xffff0000u); a[j][0].z += __uint_as_float(w.y << 16); a[j][0].w += __uint_as_float(w.y & 0xffff0000u);
                a[j][1].x += __uint_as_float(w.z << 16); a[j][1].y += __uint_as_float(w.z & 0xffff0000u); a[j][1].z += __uint_as_float(w.w << 16); a[j][1].w += __uint_as_float(w.w & 0xffff0000u); }
#pragma unroll
            for (int q = 0; q < 2; ++q) s += a[j][q].x * a[j][q].x + a[j][q].y * a[j][q].y + a[j][q].z * a[j][q].z + a[j][q].w * a[j][q].w; }
        const float rstd = rsqrtf(wave_sum(s) * (1.f / D) + EPS);
#pragma unroll
        for (int j = 0; j < 2; ++j)
#pragma unroll
            for (int q = 0; q < 2; ++q) { const int c0 = 8 * (lane + 64 * j) + 4 * q;
                *(f32x4*)(p.out + (size_t)m * D + c0) = xv[j][q] + pA[j][q] * (a[j][q] * rstd); }
    }
}

constexpr int LDS_SBASE = 147456;
constexpr int LDS_BYTES = LDS_SBASE + 512 + (64 + 3 * 512) * 4 + 256;

__global__ void __launch_bounds__(NTHREADS, 2) fwd_kernel(Params p) {
    cg::grid_group grid = cg::this_grid();
    extern __shared__ __attribute__((aligned(16))) unsigned char lds[];
    int* sbase = (int*)(lds + LDS_SBASE);
    PG8_LAS unsigned char* lds3 = (PG8_LAS unsigned char*)lds;
    const PG8_LAS int* sbase3 = (const PG8_LAS int*)(lds3 + LDS_SBASE);
    volatile LAS3 unsigned* bst = (volatile LAS3 unsigned*)(lds3 + LDS_SBASE + 384);
    if (threadIdx.x < 2) bst[threadIdx.x] = 0u;
    __syncthreads();
    XcdBarrier xb = xcd_barrier_post((unsigned*)(p.ws + WS_CTL) + CW_BAR, bst);

    p0_mod(p, (float*)lds, (float*)(lds + 36864));
    p0_tab(p);
    p0_weights(p, lds);
    grid.sync();
    p1_h(p);
    xcd_barrier(xb);
    { pg8::Gemm g{(const bf16_t*)(p.ws + WS_HB), (const bf16_t*)(p.ws + WS_WIN), D, 0, nullptr, sbase3};
      pg8::StaticOrder S; S.init(MROWS, INW, (int)gridDim.x, (int)blockIdx.x, nullptr);
      pg8::EpiQKV E{(bf16_t*)(p.ws + WS_QKV), (const float*)(p.ws + WS_TAB)};
      pg8::gemm_phase<pg8::EpiQKV, pg8::StaticOrder, false, true>(lds3, g, S, E); }
    xcd_barrier(xb);
    att::attn_phase(p, lds3);
    xcd_barrier(xb);
    { pg8::Gemm g{(const bf16_t*)(p.ws + WS_O), (const bf16_t*)(p.ws + WS_WOUT), D, 0, nullptr, sbase3};
      pg8::StaticOrder S; S.init(NTOK, D, (int)gridDim.x, (int)blockIdx.x, nullptr);
      pg8::EpiOutProj E{(float*)(p.ws + WS_MIX), (const float*)(p.ws + WS_OSS)};
      pg8::gemm_phase<pg8::EpiOutProj, pg8::StaticOrder, false, true>(lds3, g, S, E); }
    xcd_barrier(xb);
    p4c_post(p, (LAS3 float*)lds3);
    xcd_barrier(xb);
    expert_bases((const unsigned*)(p.ws + WS_CTL), sbase);
    { const int total = sbase3[NE];
      pg8::Gemm g{(const bf16_t*)(p.ws + WS_HB), (const bf16_t*)(p.ws + WS_W1), D / 2, (size_t)2048 * D, (const int*)(p.ws + WS_ESLOT), sbase3};
      pg8::StaticOrder S; S.init(total, 2048, (int)gridDim.x, (int)blockIdx.x, sbase3);
      pg8::EpiSwiglu E{p.ws + WS_ACT, p.b_mlp1};
      pg8::gemm_phase<pg8::EpiSwiglu, pg8::StaticOrder, true, true, true>(lds3, g, S, E); }
    xcd_barrier(xb);
    { const int total = sbase3[NE];
      pg8::Gemm g{(const bf16_t*)(p.ws + WS_ACT), (const bf16_t*)(p.ws + WS_W2), D / 2, (size_t)D * D, nullptr, sbase3};
      pg8::StaticOrder S; S.init(total, D, (int)gridDim.x, (int)blockIdx.x, sbase3);
      pg8::EpiScatter E{(bf16_t*)(p.ws + WS_Y), p.b_mlp2, (const int*)(p.ws + WS_ESLOT), (const float*)(p.ws + WS_EW), sbase3};
      pg8::gemm_phase<pg8::EpiScatter, pg8::StaticOrder, false, true, true>(lds3, g, S, E); }
    xcd_barrier(xb);
    p6_final(p);
}

extern "C" void kernel_launch(void* const* d_in, const int* in_sizes, int n_in, void* d_out, int out_size, void* d_ws, size_t ws_size, hipStream_t stream) {
    static int grid_blocks = 0;
    if (grid_blocks == 0) {
        if (n_in != 22 || ws_size < WS_END) { fprintf(stderr, "kernel_launch: unexpected n_in %d / ws_size %zu (need %zu)\n", n_in, ws_size, (size_t)WS_END); grid_blocks = -1; return; }
        int dev = 0, cus = 0, per_cu = 0;
        (void)hipGetDevice(&dev);
        (void)hipDeviceGetAttribute(&cus, hipDeviceAttributeMultiprocessorCount, dev);
        if (hipFuncSetAttribute((const void*)fwd_kernel, hipFuncAttributeMaxDynamicSharedMemorySize, LDS_BYTES) != hipSuccess) { fprintf(stderr, "kernel_launch: hipFuncSetAttribute failed\n"); grid_blocks = -1; return; }
        (void)hipOccupancyMaxActiveBlocksPerMultiprocessor(&per_cu, (const void*)fwd_kernel, NTHREADS, LDS_BYTES);
        if (per_cu < 1) { fprintf(stderr, "kernel_launch: occupancy query returned %d\n", per_cu); grid_blocks = -1; return; }
        grid_blocks = cus;
        if (grid_blocks * (NTHREADS / 64) * 16 < NTOK) { fprintf(stderr, "kernel_launch: needs >= 256 CUs (got %d)\n", cus); grid_blocks = -1; return; }
    }
    if (grid_blocks < 0) return;
    (void)hipMemsetAsync((char*)d_ws + WS_CTL, 0, CTL_BYTES, stream);
    Params p{};
    const float** pp = (const float**)&p;
    for (int i = 0; i < 22; ++i) pp[i] = (const float*)d_in[i];
    p.out = (float*)d_out; p.ws = (unsigned char*)d_ws;
    void* args[] = {&p};
    hipError_t e = hipLaunchCooperativeKernel((const void*)fwd_kernel, dim3(grid_blocks), dim3(NTHREADS), args, LDS_BYTES, stream);
    if (e != hipSuccess) fprintf(stderr, "cooperative launch failed: %s (grid %d)\n", hipGetErrorString(e), grid_blocks);
}
```

```cpp
#include <hip/hip_runtime.h>
#include <hip/hip_cooperative_groups.h>
#include <cstdio>
#include <cstdint>
namespace cg = cooperative_groups;

constexpr int D = 1024, NB = 8, L = 4096, CTX = 256;
constexpr int NTOK = NB * L, NCTX = NB * CTX, MROWS = NTOK + NCTX;
constexpr int INW = 2304;
constexpr int C_QA = 0, C_KA = 512, C_VA = 640, C_QB = 768, C_KB = 1280, C_VB = 1792;
constexpr int NE = 32, TOPK = 4, NASG = NTOK * TOPK;
constexpr int PADROWS = NASG + NE * 256;
constexpr float LOG2E = 1.4426950408889634f;
constexpr float QSCALE = 0.125f * LOG2E;
constexpr float EPS = 1e-6f;
constexpr int NTHREADS = 512;

constexpr size_t MiB = 1u << 20;
constexpr size_t WS_CTL = 0;
constexpr size_t CTL_BYTES = 32768;
constexpr int CW_BAR = 2048;
constexpr size_t WS_MOD = 1 * MiB;
constexpr size_t WS_TAB = 1 * MiB + 256 * 1024;
constexpr size_t WS_OSTAT = 1 * MiB + 512 * 1024;
constexpr size_t WS_WIN = 2 * MiB;
constexpr size_t WS_WOUT = 7 * MiB;
constexpr size_t WS_W2 = 9 * MiB;
constexpr size_t WS_OSS = 41 * MiB;
constexpr size_t WS_W1 = 73 * MiB;
constexpr size_t WS_HB = 201 * MiB;
constexpr int ECAP = NTOK;
constexpr size_t WS_ESLOT = 269 * MiB;
constexpr size_t WS_EW = 273 * MiB;
constexpr size_t WS_QKV = 277 * MiB;
constexpr size_t WS_O = 430 * MiB;
constexpr size_t WS_MIX = 494 * MiB;
constexpr size_t WS_ACT = 277 * MiB;
constexpr size_t WS_Y = 622 * MiB;
constexpr size_t WS_END = 878 * MiB;
static_assert(WS_W1 + (size_t)NE * 2048 * D * 2 <= WS_HB && WS_W2 + (size_t)NE * D * D * 2 <= WS_W1, "map");
static_assert(WS_HB + (size_t)MROWS * D * 2 <= WS_ESLOT && WS_ESLOT + (size_t)NE * ECAP * 4 <= WS_EW && WS_EW + (size_t)NE * ECAP * 4 <= WS_QKV, "map");
static_assert(WS_QKV + (size_t)MROWS * INW * 2 <= WS_O && WS_O + (size_t)NTOK * D * 2 <= WS_MIX && WS_MIX + (size_t)NTOK * D * 4 <= WS_Y, "map");
static_assert(WS_ACT + (size_t)PADROWS * 1024 * 2 <= WS_Y && WS_Y + (size_t)NASG * D * 2 <= WS_END, "map");

typedef unsigned short bf16_t;
typedef float f32x4 __attribute__((ext_vector_type(4)));
typedef unsigned u32x4 __attribute__((ext_vector_type(4)));
typedef unsigned u32x2 __attribute__((ext_vector_type(2)));

struct Params {
    const float *x, *c, *ctx, *c_ctx, *w_ada, *b_ada, *g_pre_mix, *g_post_mix, *g_pre_ffn, *g_post_ffn, *w_in, *g_grp_a, *g_grp_b,
        *sink_a, *rpb_b, *w_out, *w_router, *b_router, *w_mlp1, *b_mlp1, *w_mlp2, *b_mlp2;
    float* out;
    unsigned char* ws;
};

__device__ __forceinline__ float bf2f(bf16_t h) { return __uint_as_float((unsigned)h << 16); }
__device__ __forceinline__ unsigned f2bf(float f) { unsigned u = __float_as_uint(f); return (u + 0x7fffu + ((u >> 16) & 1u)) >> 16; }
__device__ __forceinline__ unsigned pk2(float lo, float hi) { return f2bf(lo) | (f2bf(hi) << 16); }
__device__ __forceinline__ unsigned pk4_fp8(float v0, float v1, float v2, float v3) {
    int w = 0; w = __builtin_amdgcn_cvt_pk_fp8_f32(v0, v1, w, false); w = __builtin_amdgcn_cvt_pk_fp8_f32(v2, v3, w, true); return (unsigned)w; }
constexpr float W8_SCALE = 64.f, W8_INV = 1.f / 64.f;
__device__ __forceinline__ int tid_opaque() { int t = threadIdx.x; asm volatile("" : "+v"(t)); return t; }
template <int CTRL> __device__ __forceinline__ float dppmov(float v) { return __builtin_bit_cast(float, __builtin_amdgcn_update_dpp(0, __builtin_bit_cast(int, v), CTRL, 0xf, 0xf, true)); }
__device__ __forceinline__ float row_sum16(float v) { v += dppmov<0xB1>(v); v += dppmov<0x4E>(v); v += dppmov<0x141>(v); v += dppmov<0x140>(v); return v; }
__device__ __forceinline__ float rdlane(float v, int l) { return __builtin_bit_cast(float, __builtin_amdgcn_readlane(__builtin_bit_cast(int, v), l)); }
__device__ __forceinline__ float wave_sum(float v) { v = row_sum16(v); return (rdlane(v, 0) + rdlane(v, 16)) + (rdlane(v, 32) + rdlane(v, 48)); }

#define LAS3 __attribute__((address_space(3)))
#define XB_TMO      128
#define XB_XCNT(j)  (256  + 64 * (j))
#define XB_XSUB(j)  (1280 + 64 * (j))
#define XB_XGEN(j)  (2304 + 64 * (j))
#define XB_TOP      3328
#define XB_TOPGEN   3392
#define XCD_BAR_WORDS 3456
#define XB_SPIN_CAP (1u << 18)
__device__ __forceinline__ unsigned xb_ld(unsigned* p)              { return __hip_atomic_load(p, __ATOMIC_RELAXED, __HIP_MEMORY_SCOPE_AGENT); }
__device__ __forceinline__ unsigned xb_add(unsigned* p, unsigned v) { return __hip_atomic_fetch_add(p, v, __ATOMIC_RELAXED, __HIP_MEMORY_SCOPE_AGENT); }
__device__ __forceinline__ unsigned xb_xcc_id() { return (unsigned)__builtin_amdgcn_s_getreg((3 << 11) | 20) & 0xFu; }
#define XB_SPIN(cond, bar) do { unsigned _sp = 0; while (cond) { __builtin_amdgcn_s_sleep(1); \
    if ((++_sp & 255u) == 0u) { if (xb_ld(&(bar)[XB_TMO])) break; if (_sp > XB_SPIN_CAP) { atomicAdd(&(bar)[XB_TMO], 1u); break; } } } } while (0)
struct XcdBarrier { unsigned* bar; unsigned x; volatile LAS3 unsigned* st; };
__device__ __forceinline__ XcdBarrier xcd_barrier_post(unsigned* bar, volatile LAS3 unsigned* st) {
    XcdBarrier b; b.bar = bar; b.x = xb_xcc_id(); b.st = st;
    if (threadIdx.x == 0) (void)xb_add(&bar[XB_XCNT(b.x)], 1u);
    return b;
}
__device__ __forceinline__ void xcd_barrier_complete(unsigned* bar, unsigned x, unsigned& nloc, unsigned& nx) {
    const unsigned G = gridDim.x * gridDim.y * gridDim.z;
    unsigned sum, cnt, mine, sp = 0u;
    for (;;) {
        sum = 0u; cnt = 0u; mine = 0u;
#pragma unroll
        for (unsigned j = 0; j < 16; ++j) { const unsigned c = xb_ld(&bar[XB_XCNT(j)]); sum += c; cnt += (c > 0u) ? 1u : 0u; mine = (j == x) ? c : mine; }
        if (sum == G) break;
        __builtin_amdgcn_s_sleep(1);
        if ((++sp & 255u) == 0u) { if (xb_ld(&bar[XB_TMO])) break; if (sp > XB_SPIN_CAP) { atomicAdd(&bar[XB_TMO], 1u); break; } }
    }
    nloc = mine > 0u ? mine : 1u; nx = cnt > 0u ? cnt : 1u;
}
__device__ __forceinline__ void xcd_barrier(const XcdBarrier& b) {
    asm volatile("s_waitcnt vmcnt(0)" ::: "memory");
    __syncthreads();
    if (threadIdx.x == 0) {
        unsigned* bar = b.bar;
        __builtin_amdgcn_s_waitcnt(0);
        unsigned nloc = b.st[0], nx = b.st[1];
        if (nloc == 0u) { xcd_barrier_complete(bar, b.x, nloc, nx); b.st[0] = nloc; b.st[1] = nx; }
        const unsigned old = xb_add(&bar[XB_XSUB(b.x)], 1u);
        const unsigned gen = old / nloc;
        if (old + 1u == (gen + 1u) * nloc) {
            __builtin_amdgcn_fence(__ATOMIC_RELEASE, "agent");
            asm volatile("s_waitcnt vmcnt(0)" ::: "memory");
            const unsigned og = xb_add(&bar[XB_TOP], 1u);
            const unsigned tg = og / nx;
            if (og + 1u == (tg + 1u) * nx) xb_add(&bar[XB_TOPGEN], 1u);
            else XB_SPIN(xb_ld(&bar[XB_TOPGEN]) == tg, bar);
            __builtin_amdgcn_fence(__ATOMIC_ACQUIRE, "agent");
            xb_add(&bar[XB_XGEN(b.x)], 1u);
            asm volatile("s_waitcnt vmcnt(0)" ::: "memory");
        } else {
            XB_SPIN(xb_ld(&bar[XB_XGEN(b.x)]) == gen, bar);
            __builtin_amdgcn_fence(__ATOMIC_ACQUIRE, "agent");
            asm volatile("s_waitcnt vmcnt(0)" ::: "memory");
        }
    }
    __syncthreads();
}

namespace pg8 {
#define PG8_LAS __attribute__((address_space(3)))
typedef short bf16x8 __attribute__((ext_vector_type(8)));
typedef int v8i __attribute__((ext_vector_type(8)));
typedef int v4i __attribute__((ext_vector_type(4)));
typedef short s16x16 __attribute__((ext_vector_type(16)));
constexpr int BM = 256, BK = 64, HALF = 128, HTB = HALF * BK * 2  , STAGE_BYTES = 8 * HTB, NXCD = 8, WGM = 8;
__device__ __forceinline__ int lds_byte(int r, int c) { const int st = (r >> 4) * 2 + (c >> 5), rr = r & 15, cc = c & 31, ob = rr * 64 + cc * 2; return st * 1024 + (ob ^ (((ob >> 9) & 1) << 5)); }
__device__ __forceinline__ void stage_rc(int b, int& R, int& C) { const int st = b / 1024, sb = b % 1024, swz = sb ^ (((sb >> 9) & 1) << 5); R = (st >> 1) * 16 + swz / 64; C = (st & 1) * 32 + (swz % 64) / 2; }
__device__ __forceinline__ int perm32(int rho) { const int n = rho >> 4, i = rho & 15; return 8 * (i >> 2) + 4 * n + (i & 3); }

constexpr int PAR_BASE = 131072, PAR_BUF = 4096, PAR_IDX = 0, PAR_W = 1024, PAR_BIAS = 2048, PAR_TAB = PAR_BASE + 2 * PAR_BUF;
typedef short s16x2 __attribute__((ext_vector_type(2)));
__device__ __forceinline__ int par_i32(PG8_LAS unsigned char* p) { return __builtin_bit_cast(int, *(const PG8_LAS s16x2*)p); }
__device__ __forceinline__ float par_f32(PG8_LAS unsigned char* p) { return __builtin_bit_cast(float, *(const PG8_LAS s16x2*)p); }
__device__ __forceinline__ f32x4 par_f32x4(PG8_LAS unsigned char* p) { return __builtin_bit_cast(f32x4, *(const PG8_LAS bf16x8*)p); }
struct Unit { int pm, pn, e; };
struct Gemm { const bf16_t* A; const bf16_t* Bt; int K; size_t bstride; const int* eslot; const PG8_LAS int* sb; };

struct StaticOrder {
    int nM, nN, nwg, G, c; const PG8_LAS int* sbase;
    __device__ void init(int M, int N, int G_, int c_, const PG8_LAS int* sb) { nM = M / BM; nN = N / BM; nwg = nM * nN; G = G_; c = c_; sbase = sb; }
    __device__ bool next(int i, Unit& u) const {
        const long Lx = (long)i * G + c; if (Lx >= nwg) return false;
        int wgid = (int)Lx; { const int q = nwg / NXCD, r = nwg % NXCD, xcd = wgid % NXCD, off = wgid / NXCD; wgid = (xcd < r ? xcd * (q + 1) : r * (q + 1) + (xcd - r) * q) + off; }
        const int nig = WGM * nN, gid = wgid / nig, fm = gid * WGM, gsz = (nM - fm) < WGM ? (nM - fm) : WGM;
        u.pm = fm + ((wgid % nig) % gsz); u.pn = (wgid % nig) / gsz; u.e = 0;
        if (sbase) { const int row = u.pm * BM; const int l = (int)(threadIdx.x & 63);
            const bool ge = (l >= 1) && (l < 32) && (row >= sbase[l & 31]);
            u.e = __builtin_popcountll(__ballot(ge)); }
        return true;
    }
};

template <class Epi, class Sched, bool GATHER, bool ALIGN_EPI, bool FP8 = false>
__device__ __forceinline__ void gemm_phase(PG8_LAS unsigned char* lds, const Gemm g, const Sched& S, const Epi& E) {
    int tid_ = threadIdx.x; asm volatile("" : "+v"(tid_));
    const int tid = tid_, wid = __builtin_amdgcn_readfirstlane(tid >> 6), lane = tid & 63, wr = wid >> 2, wc = wid & 3, fr = lane & 15, fq = lane >> 4;
    const int K = g.K, nt = K / BK;
    unsigned voffA[2], voffB[2];
#pragma unroll
    for (int i = 0; i < 2; ++i) { int R, C; stage_rc(tid * 16 + i * 8192, R, C); const int Rb = Epi::PERM ? ((R & ~31) + perm32(R & 31)) : R;
        voffA[i] = (unsigned)(R * K + C) * 2u; voffB[i] = (unsigned)(Rb * K + C) * 2u; }
    const size_t kstep = (size_t)(BK * 2);
    const size_t hstep = (size_t)HALF * K * 2;
    const size_t tstep = 2 * hstep;
    const unsigned ldsw = (unsigned)wid * 1024u;
    const int aoff = FP8 ? lds_byte(wr * 64 + fr, fq * 16) : lds_byte(wr * 64 + fr, fq * 8), boff = FP8 ? lds_byte(wc * 32 + fr, fq * 16) : lds_byte(wc * 32 + fr, fq * 8);
#define PG8_SA(b, h) (((b) * 2 + (h)) * HTB)
#define PG8_SB(b, h) ((4 + (b) * 2 + (h)) * HTB)
#define PG8_STAGE(bufoff, gbase, voff) do { _Pragma("unroll") for (int _i = 0; _i < 2; ++_i) \
        __builtin_amdgcn_global_load_lds((const unsigned*)((const char*)(gbase) + (voff)[_i]), (PG8_LAS unsigned*)(lds + (bufoff) + ldsw + _i * 8192), 16, 0, 0); } while (0)
#define PG8_CAT(lo_, hi_) __builtin_bit_cast(v8i, __builtin_shufflevector((lo_), (hi_), 0, 1, 2, 3, 4, 5, 6, 7, 8, 9, 10, 11, 12, 13, 14, 15))
#define PG8_LDA(dst, b, h) do { _Pragma("unroll") for (int m = 0; m < 4; ++m) { \
        if constexpr (FP8) dst##8[m] = PG8_CAT(*(const PG8_LAS bf16x8*)(lds + PG8_SA(b, h) + aoff + m * 2048), *(const PG8_LAS bf16x8*)(lds + PG8_SA(b, h) + aoff + m * 2048 + 16)); \
        else { _Pragma("unroll") for (int k = 0; k < 2; ++k) dst[m][k] = *(const PG8_LAS bf16x8*)(lds + PG8_SA(b, h) + aoff + m * 2048 + k * 1024); } } } while (0)
#define PG8_LDB(dst, b, h) do { _Pragma("unroll") for (int n = 0; n < 2; ++n) { \
        if constexpr (FP8) dst##8[n] = PG8_CAT(*(const PG8_LAS bf16x8*)(lds + PG8_SB(b, h) + boff + n * 2048), *(const PG8_LAS bf16x8*)(lds + PG8_SB(b, h) + boff + n * 2048 + 16)); \
        else { _Pragma("unroll") for (int k = 0; k < 2; ++k) dst[n][k] = *(const PG8_LAS bf16x8*)(lds + PG8_SB(b, h) + boff + n * 2048 + k * 1024); } } } while (0)
#define PG8_MMA(ai, bj, At, Bt) do { __builtin_amdgcn_s_setprio(1); _Pragma("unroll") for (int m = 0; m < 4; ++m) _Pragma("unroll") for (int n = 0; n < 2; ++n) { \
        if constexpr (FP8) asm volatile("v_mfma_scale_f32_16x16x128_f8f6f4 %0, %1, %2, %0, %3, %3 op_sel_hi:[0,0,0]" : "+v"(acc[ai][bj][m][n]) : "v"(Bt##8[n]), "v"(At##8[m]), "v"(one_scale)); \
        else { _Pragma("unroll") for (int k = 0; k < 2; ++k) acc[ai][bj][m][n] = __builtin_amdgcn_mfma_f32_16x16x32_bf16(Bt[n][k], At[m][k], acc[ai][bj][m][n], 0, 0, 0); } } \
        __builtin_amdgcn_s_setprio(0); } while (0)
#define PG8_WAIT_V(n) asm volatile("s_waitcnt vmcnt(" #n ")" ::: "memory")
#define PG8_WAIT_L(n) asm volatile("s_waitcnt lgkmcnt(" #n ")" ::: "memory")
#define PG8_BAR __builtin_amdgcn_s_barrier()
#define PG8_SCHED __builtin_amdgcn_sched_barrier(0)
#define PG8_SETOFF(off, pbuf_) do { _Pragma("unroll") for (int _h = 0; _h < 2; ++_h) _Pragma("unroll") for (int _i = 0; _i < 2; ++_i) { \
        if (GATHER) { int R_, C_; stage_rc(tid * 16 + _i * 8192, R_, C_); \
            off[_h][_i] = (unsigned)(par_i32(lds + PAR_BASE + (pbuf_) * PAR_BUF + PAR_IDX + (_h * HALF + R_) * 4) >> 2) * (unsigned)(K * 2) + (unsigned)(C_ * 2); } \
        else off[_h][_i] = voffA[_i] + (unsigned)(_h * hstep); } } while (0)
#define PG8_IDXDMA(u, pbuf_) do { if (GATHER && wid < 4) { int rk_ = (u).pm * BM + wid * 64 + lane - g.sb[(u).e]; const int cm_ = g.sb[40 + (u).e] - 1; rk_ = rk_ < cm_ ? rk_ : cm_; \
        __builtin_amdgcn_global_load_lds((const unsigned*)(g.eslot + (size_t)(u).e * ECAP + rk_), (PG8_LAS unsigned*)(lds + PAR_BASE + (pbuf_) * PAR_BUF + PAR_IDX + wid * 256), 4, 0, 0); } } while (0)
    Unit cur, nxt; int ui = 0;
    if (!S.next(0, cur)) return;
    PG8_IDXDMA(cur, 0); E.prefetch(cur, 0, lds, wid, lane);
    PG8_WAIT_V(0); PG8_BAR;
    f32x4 acc[2][2][4][2];
#pragma unroll
    for (int a = 0; a < 2; ++a)
#pragma unroll
        for (int b = 0; b < 2; ++b)
#pragma unroll
            for (int m = 0; m < 4; ++m)
#pragma unroll
                for (int n = 0; n < 2; ++n) acc[a][b][m][n] = (f32x4){0.f, 0.f, 0.f, 0.f};
    bf16x8 At[4][2], B0[2][2], B1[2][2];
    v8i At8[4], B08[2], B18[2];
    const int one_scale = 0x7f7f7f7f;
    unsigned offc[2][2], offn[2][2];
    PG8_SETOFF(offc, 0);
    const char* cA = GATHER ? (const char*)g.A : (const char*)g.A + (size_t)cur.pm * tstep;
    const char* cB = (const char*)g.Bt + (size_t)cur.e * g.bstride + (size_t)cur.pn * tstep;
    PG8_STAGE(PG8_SB(0, 0), cB, voffB); PG8_STAGE(PG8_SB(0, 1), cB + hstep, voffB); PG8_STAGE(PG8_SA(0, 0), cA, offc[0]); PG8_STAGE(PG8_SA(0, 1), cA, offc[1]);
    if (wr == 1) PG8_BAR;
    PG8_WAIT_V(2); PG8_BAR;
    PG8_STAGE(PG8_SB(1, 0), cB + kstep, voffB); PG8_STAGE(PG8_SA(1, 0), cA + kstep, offc[0]); PG8_STAGE(PG8_SB(1, 1), cB + hstep + kstep, voffB);
    PG8_WAIT_V(6); PG8_BAR;
    for (;;) {
        const bool has_next = S.next(ui + 1, nxt);
        const char* nA = GATHER ? cA : (has_next ? (const char*)g.A + (size_t)nxt.pm * tstep : cA);
        const char* nB = has_next ? (const char*)g.Bt + (size_t)nxt.e * g.bstride + (size_t)nxt.pn * tstep : cB;

        if constexpr (Epi::MIDSCALE) E.begin(cur, ui, lds, tid);
#pragma unroll 1
        for (int t = 0; t < nt; t += 2) {
            const bool last = (t == nt - 2);
            if constexpr (Epi::MIDSCALE) { if (t == nt / 2) E.mid(acc, ui, wr, fr, lds); }
            if (t == 2 && has_next) { PG8_IDXDMA(nxt, (ui + 1) & 1); E.prefetch(nxt, (ui + 1) & 1, lds, wid, lane); }
            if (GATHER && last) { if (has_next) { PG8_SETOFF(offn, (ui + 1) & 1); } else {
#pragma unroll
                for (int h = 0; h < 2; ++h)
#pragma unroll
                    for (int i = 0; i < 2; ++i) offn[h][i] = offc[h][i]; } }
            const char* a1 = cA + (size_t)(t + 1) * kstep;
            const char* a2 = last ? nA : cA + (size_t)(t + 2) * kstep; const char* b2 = last ? nB : cB + (size_t)(t + 2) * kstep;
            const char* a3 = a2 + kstep; const char* b3 = b2 + kstep;
            unsigned o2[2][2];
#pragma unroll
            for (int h = 0; h < 2; ++h)
#pragma unroll
                for (int i = 0; i < 2; ++i) o2[h][i] = (GATHER && last) ? offn[h][i] : offc[h][i];
            PG8_LDB(B0, 0, 0); PG8_LDB(B1, 0, 1); PG8_SCHED; PG8_LDA(At, 0, 0); PG8_STAGE(PG8_SA(1, 1), a1, offc[1]);
            PG8_WAIT_V(8); PG8_WAIT_L(0); PG8_BAR; PG8_MMA(0, 0, At, B0); PG8_MMA(0, 1, At, B1); PG8_BAR; PG8_SCHED;
            PG8_LDA(At, 0, 1); PG8_STAGE(PG8_SB(0, 0), b2, voffB); PG8_STAGE(PG8_SB(0, 1), b2 + hstep, voffB); PG8_STAGE(PG8_SA(0, 0), a2, o2[0]);
            PG8_WAIT_V(8); PG8_WAIT_L(0); PG8_BAR; PG8_MMA(1, 0, At, B0); PG8_MMA(1, 1, At, B1); PG8_BAR; PG8_SCHED;
            PG8_LDB(B0, 1, 0); PG8_LDB(B1, 1, 1); PG8_SCHED; PG8_LDA(At, 1, 0); PG8_STAGE(PG8_SA(0, 1), a2, o2[1]);
            PG8_WAIT_V(8); PG8_WAIT_L(0); PG8_BAR; PG8_MMA(0, 0, At, B0); PG8_MMA(0, 1, At, B1); PG8_BAR; PG8_SCHED;
            PG8_LDA(At, 1, 1); PG8_STAGE(PG8_SB(1, 0), b3, voffB); PG8_STAGE(PG8_SB(1, 1), b3 + hstep, voffB); PG8_STAGE(PG8_SA(1, 0), a3, o2[0]);
            PG8_WAIT_V(8); PG8_WAIT_L(0); PG8_BAR; PG8_MMA(1, 0, At, B0); PG8_MMA(1, 1, At, B1); PG8_BAR; PG8_SCHED;
        }
        if constexpr (ALIGN_EPI) { if (wr == 0) PG8_BAR; }
        if constexpr (FP8) asm volatile("s_nop 15\n\ts_nop 15" ::: "memory");
        E(acc, cur, ui, wr, wc, fr, fq, lds);
        if (!has_next) break;
#pragma unroll
        for (int a = 0; a < 2; ++a)
#pragma unroll
            for (int b = 0; b < 2; ++b)
#pragma unroll
                for (int m = 0; m < 4; ++m)
#pragma unroll
                    for (int n = 0; n < 2; ++n) acc[a][b][m][n] = (f32x4){0.f, 0.f, 0.f, 0.f};
        cur = nxt; cA = nA; cB = nB; ++ui;
#pragma unroll
        for (int h = 0; h < 2; ++h)
#pragma unroll
            for (int i = 0; i < 2; ++i) offc[h][i] = offn[h][i];
        if constexpr (ALIGN_EPI) { if (wr == 1) PG8_BAR; }
    }
    PG8_WAIT_V(0);
    if constexpr (!ALIGN_EPI) { if (wr == 0) PG8_BAR; }
    PG8_BAR;
#undef PG8_SA
#undef PG8_SB
#undef PG8_STAGE
#undef PG8_LDA
#undef PG8_LDB
#undef PG8_MMA
#undef PG8_WAIT_V
#undef PG8_WAIT_L
#undef PG8_BAR
#undef PG8_SCHED
#undef PG8_SETOFF
#undef PG8_IDXDMA
#undef PG8_CAT
}

struct EpiQKV {
    static constexpr bool MIDSCALE = false, PERM = false;
    bf16_t* O;
    __device__ __forceinline__ void prefetch(const Unit&, int, PG8_LAS unsigned char*, int, int) const {}
    __device__ __forceinline__ void operator()(const f32x4 (&acc)[2][2][4][2], const Unit& u, int ui, int wr, int wc, int fr, int fq, PG8_LAS unsigned char* lds) const {
        const bool latent = u.pm < NTOK / BM;
#pragma unroll
        for (int ai = 0; ai < 2; ++ai)
#pragma unroll
            for (int m = 0; m < 4; ++m) {
                const int row = u.pm * BM + ai * HALF + wr * 64 + m * 16 + fr;
                bf16_t* rowp = O + (size_t)row * INW + u.pn * BM + wc * 32 + 4 * fq;
                const int pos = row & (L - 1), pp = (wc & 1) ? (pos & 63) : (pos >> 6);
                PG8_LAS unsigned char* tp = lds + PAR_TAB + (pp * 16 + 4 * fq) * 8;
#pragma unroll
                for (int bj = 0; bj < 2; ++bj) {
                    const int colbase = u.pn * BM + bj * HALF;
                    f32x4 v0 = acc[ai][bj][m][0], v1 = acc[ai][bj][m][1];
                    if (latent && colbase < C_VA) {
                        const f32x4 t0 = par_f32x4(tp), t1 = par_f32x4(tp + 16);
                        const f32x4 cs = {t0.x, t0.z, t1.x, t1.z}, sn = {t0.y, t0.w, t1.y, t1.w};
                        const f32x4 a0 = v0 * cs - v1 * sn, a1 = v1 * cs + v0 * sn; v0 = a0; v1 = a1;
                    }
                    if (colbase < C_KA || (colbase >= C_QB && colbase < C_KB)) { v0 = v0 * QSCALE; v1 = v1 * QSCALE; }
                    u32x2 w0, w1; w0.x = pk2(v0.x, v0.y); w0.y = pk2(v0.z, v0.w); w1.x = pk2(v1.x, v1.y); w1.y = pk2(v1.z, v1.w);
                    *(u32x2*)(rowp + bj * HALF) = w0; *(u32x2*)(rowp + bj * HALF + 16) = w1;
                }
            }
    }
};
struct EpiOutProj {
    static constexpr bool PERM = false, MIDSCALE = true;
    float* O; const float* oss;
    __device__ __forceinline__ void prefetch(const Unit&, int, PG8_LAS unsigned char*, int, int) const {}
    __device__ __forceinline__ void begin(const Unit& u, int ui, PG8_LAS unsigned char* lds, int tid) const {
        if (tid < 256) { const f32x4* sp = (const f32x4*)(oss + (size_t)(u.pm * BM + tid) * 16); const f32x4 a0 = sp[0], a1 = sp[1], b0 = sp[2], b1 = sp[3];
            const float sa = ((a0.x + a0.y) + (a0.z + a0.w)) + ((a1.x + a1.y) + (a1.z + a1.w)), sb = ((b0.x + b0.y) + (b0.z + b0.w)) + ((b1.x + b1.y) + (b1.z + b1.w));
            const float ra = rsqrtf(sa * (1.f / 512.f) + EPS), rb = rsqrtf(sb * (1.f / 512.f) + EPS);
            typedef float f2 __attribute__((ext_vector_type(2)));
            *(PG8_LAS f2*)(lds + 131072 + (ui & 1) * 2048 + tid * 8) = (f2){ra / rb, rb}; }
    }
    __device__ __forceinline__ void mid(f32x4 (&acc)[2][2][4][2], int ui, int wr, int fr, PG8_LAS unsigned char* lds) const {
#pragma unroll
        for (int ai = 0; ai < 2; ++ai)
#pragma unroll
            for (int m = 0; m < 4; ++m) { const float r = *(const PG8_LAS float*)(lds + 131072 + (ui & 1) * 2048 + (ai * HALF + wr * 64 + m * 16 + fr) * 8);
#pragma unroll
                for (int bj = 0; bj < 2; ++bj)
#pragma unroll
                    for (int n = 0; n < 2; ++n) acc[ai][bj][m][n] = acc[ai][bj][m][n] * r; }
    }
    __device__ __forceinline__ void operator()(const f32x4 (&acc)[2][2][4][2], const Unit& u, int ui, int wr, int wc, int fr, int fq, PG8_LAS unsigned char* lds) const {
#pragma unroll
        for (int ai = 0; ai < 2; ++ai)
#pragma unroll
            for (int m = 0; m < 4; ++m) {
                const int rl = ai * HALF + wr * 64 + m * 16 + fr;
                const float rb = *(const PG8_LAS float*)(lds + 131072 + (ui & 1) * 2048 + rl * 8 + 4);
                float* rowp = O + (size_t)(u.pm * BM + rl) * D + u.pn * BM + wc * 32 + 4 * fq;
#pragma unroll
                for (int bj = 0; bj < 2; ++bj)
#pragma unroll
                    for (int n = 0; n < 2; ++n) *(f32x4*)(rowp + bj * HALF + 16 * n) = acc[ai][bj][m][n] * rb;
            }
    }
};
struct EpiSwiglu {
    static constexpr bool MIDSCALE = false, PERM = false;
    unsigned char* act; const float* b1;
    __device__ __forceinline__ void prefetch(const Unit& u, int pb, PG8_LAS unsigned char* lds, int wid, int lane) const {
        if (wid == 4) __builtin_amdgcn_global_load_lds((const unsigned*)(b1 + (size_t)u.e * 2048 + u.pn * BM + lane * 4), (PG8_LAS unsigned*)(lds + PAR_BASE + pb * PAR_BUF + PAR_BIAS), 16, 0, 0);
    }
    __device__ __forceinline__ void operator()(const f32x4 (&acc)[2][2][4][2], const Unit& u, int ui, int wr, int wc, int fr, int fq, PG8_LAS unsigned char* lds) const {
#pragma unroll
        for (int bj = 0; bj < 2; ++bj) {
            const int f0 = 16 * (8 * u.pn + 4 * bj + wc) + 4 * fq;
            PG8_LAS unsigned char* bp = lds + PAR_BASE + (ui & 1) * PAR_BUF + PAR_BIAS + (128 * bj + 32 * wc + 8 * fq) * 4; const f32x4 bA = par_f32x4(bp), bB = par_f32x4(bp + 16);
            const f32x4 bg = {bA.x, bA.z, bB.x, bB.z}, bl = {bA.y, bA.w, bB.y, bB.w};
#pragma unroll
            for (int ai = 0; ai < 2; ++ai)
#pragma unroll
                for (int m = 0; m < 4; ++m) {
                    const int row = u.pm * BM + ai * HALF + wr * 64 + m * 16 + fr;
                    const f32x4 gt = acc[ai][bj][m][0] * W8_INV + bg, ln = acc[ai][bj][m][1] * W8_INV + bl; float a[4];
#pragma unroll
                    for (int j = 0; j < 4; ++j) { const float gg = fminf(gt[j], 7.f), ll = fminf(fmaxf(ln[j], -7.f), 7.f);
                        a[j] = gg * __builtin_amdgcn_rcpf(1.f + __expf(-1.702f * gg)) * (ll + 1.f); }
                    *(unsigned*)(act + (size_t)row * D + f0) = pk4_fp8(a[0], a[1], a[2], a[3]);
                }
        }
    }
};
struct EpiScatter {
    static constexpr bool MIDSCALE = false, PERM = true;
    bf16_t* y; const float* b2; const int* eslot; const float* ew; const PG8_LAS int* sb;
    __device__ __forceinline__ void prefetch(const Unit& u, int pb, PG8_LAS unsigned char* lds, int wid, int lane) const {
        const int w4 = wid & 3; int rk = u.pm * BM + w4 * 64 + lane - sb[u.e]; const int cm = sb[40 + u.e] - 1; rk = rk < cm ? rk : cm;
        const size_t gi = (size_t)u.e * ECAP + rk;
        if (wid < 4) __builtin_amdgcn_global_load_lds((const unsigned*)(eslot + gi), (PG8_LAS unsigned*)(lds + PAR_BASE + pb * PAR_BUF + PAR_IDX + w4 * 256), 4, 0, 0);
        else         __builtin_amdgcn_global_load_lds((const unsigned*)(ew + gi), (PG8_LAS unsigned*)(lds + PAR_BASE + pb * PAR_BUF + PAR_W + w4 * 256), 4, 0, 0);
        if (wid == 0) __builtin_amdgcn_global_load_lds((const unsigned*)(b2 + (size_t)u.e * D + u.pn * BM + lane * 4), (PG8_LAS unsigned*)(lds + PAR_BASE + pb * PAR_BUF + PAR_BIAS), 16, 0, 0);
    }
    __device__ __forceinline__ void operator()(const f32x4 (&acc)[2][2][4][2], const Unit& u, int ui, int wr, int wc, int fr, int fq, PG8_LAS unsigned char* lds) const {
        PG8_LAS unsigned char* par = lds + PAR_BASE + (ui & 1) * PAR_BUF;
        const int col0 = u.pn * BM + wc * 32 + 8 * fq;
        f32x4 bv[2][2];
#pragma unroll
        for (int bj = 0; bj < 2; ++bj)
#pragma unroll
            for (int n = 0; n < 2; ++n) bv[bj][n] = par_f32x4(par + PAR_BIAS + (wc * 32 + 8 * fq + bj * HALF + 4 * n) * 4);
        const int rbase = u.pm * BM - sb[u.e], cn = sb[40 + u.e];
#pragma unroll
        for (int ai = 0; ai < 2; ++ai)
#pragma unroll
            for (int m = 0; m < 4; ++m) {
                const int rl = ai * HALF + wr * 64 + m * 16 + fr;
                const int slot = par_i32(par + PAR_IDX + rl * 4); const float w = par_f32(par + PAR_W + rl * 4);
                if (rbase + rl < cn) {
                    bf16_t* rowp = y + (size_t)slot * D + col0;
#pragma unroll
                    for (int bj = 0; bj < 2; ++bj) { const f32x4 v0 = (acc[ai][bj][m][0] * W8_INV + bv[bj][0]) * w, v1 = (acc[ai][bj][m][1] * W8_INV + bv[bj][1]) * w;
                        u32x4 o; o.x = pk2(v0.x, v0.y); o.y = pk2(v0.z, v0.w); o.z = pk2(v1.x, v1.y); o.w = pk2(v1.z, v1.w);
                        *(u32x4*)(rowp + bj * HALF) = o; }
                }
            }
    }
};
}

__device__ void p0_mod(const Params& p, float* sS  , float* sP  ) {
    float* mod = (float*)(p.ws + WS_MOD);
    const int tid = tid_opaque(), lane = tid & 63, wave = tid >> 6;
    if (blockIdx.x >= 96) return;
    for (int i = tid; i < 9 * D; i += NTHREADS) { const int r = i >> 10, k = i & 1023; const float cc = r < 8 ? p.c[r * D + k] : p.c_ctx[k]; sS[i] = cc / (1.f + __expf(-cc)); }
    __syncthreads();
    const int j = blockIdx.x * 64 + lane;
    float acc[9];
#pragma unroll
    for (int r = 0; r < 9; ++r) acc[r] = 0.f;
    const float* wp = p.w_ada + (size_t)(wave * 128) * 6144 + j;
#pragma unroll 1
    for (int k0 = 0; k0 < 128; k0 += 16) {
        float w[16];
#pragma unroll
        for (int kk = 0; kk < 16; ++kk) w[kk] = wp[(size_t)(k0 + kk) * 6144];
#pragma unroll
        for (int kk = 0; kk < 16; ++kk)
#pragma unroll
            for (int r = 0; r < 9; ++r) acc[r] = fmaf(sS[r * D + wave * 128 + k0 + kk], w[kk], acc[r]);
    }
#pragma unroll
    for (int r = 0; r < 9; ++r) sP[(wave * 9 + r) * 64 + lane] = acc[r];
    __syncthreads();
    for (int i = tid; i < 9 * 64; i += NTHREADS) { const int r = i >> 6, jj = i & 63; float s = p.b_ada[blockIdx.x * 64 + jj];
#pragma unroll
        for (int w = 0; w < 8; ++w) s += sP[(w * 9 + r) * 64 + jj];
        mod[r * 6144 + blockIdx.x * 64 + jj] = s; }
    __syncthreads();
}
__device__ void p0_tab(const Params& p) {
    float* tab = (float*)(p.ws + WS_TAB);
    const int gtid = blockIdx.x * NTHREADS + tid_opaque(), gsize = gridDim.x * NTHREADS;
    for (int idx = gtid; idx < 64 * 16; idx += gsize) {
        const int pos = idx >> 4, i = idx & 15;
        const float freq = exp2f(-(float)i * (13.287712379549449f / 16.f));
        const float ang = (float)pos * freq;
        const float n = rintf(ang * 0.15915494309189535f);
        float r = fmaf(-n, 6.28125f, ang); r = fmaf(-n, 1.9353071795864769e-3f, r);
        tab[idx * 2] = __cosf(r); tab[idx * 2 + 1] = __sinf(r);
    }
}
template <int MODE>
__device__ __forceinline__ void conv_item(const float* src, int K, int N, bf16_t* dst, int item, float* scr, int lane, const float* gA, const float* gB) {
    const int nblk = N / 32, kb = item / nblk, nb = item % nblk, k0 = 64 * kb, n0 = 32 * nb;
    const int c = lane & 31, kh = lane >> 5;
    const int nl = MODE == 1 ? 16 * (c & 1) + (c >> 1) : c;
    float v[32];
    const float* sp = src + (size_t)(k0 + kh) * N + n0 + c;
#pragma unroll
    for (int i = 0; i < 32; ++i) v[i] = sp[(size_t)(2 * i) * N];
#pragma unroll
    for (int i = 0; i < 32; ++i) { float x = v[i]; if (MODE == 2) { const int k = k0 + 2 * i + kh; x *= (k < 512 ? gA[k] : gB[k - 512]); } scr[(2 * i + kh) * 33 + nl] = x; }
    asm volatile("s_waitcnt lgkmcnt(0)" ::: "memory");
    const int ch = lane & 7;
#pragma unroll
    for (int j = 0; j < 4; ++j) { const int n = (lane >> 3) + 8 * j; const float* s = scr + (8 * ch) * 33 + n;
        u32x4 o; o.x = pk2(s[0 * 33], s[1 * 33]); o.y = pk2(s[2 * 33], s[3 * 33]); o.z = pk2(s[4 * 33], s[5 * 33]); o.w = pk2(s[6 * 33], s[7 * 33]);
        *(u32x4*)(dst + (size_t)(n0 + n) * K + k0 + 8 * ch) = o; }
    asm volatile("s_waitcnt lgkmcnt(0)" ::: "memory");
}
template <bool PERM1>
__device__ __forceinline__ void conv_item8(const float* src, int K, int N, unsigned char* dst, int item, float* scr, int lane) {
    const int nblk = N / 32, kb = item / nblk, nb = item % nblk, k0 = 64 * kb, n0 = 32 * nb;
    const int c = lane & 31, kh = lane >> 5;
    const int nl = PERM1 ? 16 * (c & 1) + (c >> 1) : c;
    float v[32];
    const float* sp = src + (size_t)(k0 + kh) * N + n0 + c;
#pragma unroll
    for (int i = 0; i < 32; ++i) v[i] = sp[(size_t)(2 * i) * N];
#pragma unroll
    for (int i = 0; i < 32; ++i) scr[(2 * i + kh) * 33 + nl] = v[i] * W8_SCALE;
    asm volatile("s_waitcnt lgkmcnt(0)" ::: "memory");
    const int ch = lane & 3;
#pragma unroll
    for (int j = 0; j < 2; ++j) { const int n = (lane >> 2) + 16 * j; const float* s = scr + (16 * ch) * 33 + n;
        u32x4 o; o.x = pk4_fp8(s[0 * 33], s[1 * 33], s[2 * 33], s[3 * 33]); o.y = pk4_fp8(s[4 * 33], s[5 * 33], s[6 * 33], s[7 * 33]);
        o.z = pk4_fp8(s[8 * 33], s[9 * 33], s[10 * 33], s[11 * 33]); o.w = pk4_fp8(s[12 * 33], s[13 * 33], s[14 * 33], s[15 * 33]);
        *(u32x4*)(dst + (size_t)(n0 + n) * K + k0 + 16 * ch) = o; }
    asm volatile("s_waitcnt lgkmcnt(0)" ::: "memory");
}
__device__ void p0_weights(const Params& p, unsigned char* ldsb) {
    const int tid = tid_opaque(), lane = tid & 63, wave = tid >> 6; float* scr = (float*)(ldsb + 57344 + wave * 8448);
    const int gw = blockIdx.x * (NTHREADS / 64) + wave, ngw = gridDim.x * (NTHREADS / 64);
    constexpr int I_IN = 16 * 72, I_OUT = 16 * 32, I_W1 = 16 * 64, I_W2 = 16 * 32;
    constexpr int NITEMS = I_IN + I_OUT + NE * I_W1 + NE * I_W2;
    for (int it = gw; it < NITEMS; it += ngw) {
        int r = it;
        if (r < I_IN) { conv_item<0>(p.w_in, D, INW, (bf16_t*)(p.ws + WS_WIN), r, scr, lane, nullptr, nullptr); continue; } r -= I_IN;
        if (r < I_OUT) { conv_item<2>(p.w_out, D, D, (bf16_t*)(p.ws + WS_WOUT), r, scr, lane, p.g_grp_a, p.g_grp_b); continue; } r -= I_OUT;
        if (r < NE * I_W1) { const int e = r / I_W1, q = r % I_W1;
            conv_item8<true>(p.w_mlp1 + (size_t)e * D * 2048, D, 2048, p.ws + WS_W1 + (size_t)e * 2048 * D, q, scr, lane); continue; } r -= NE * I_W1;
        { const int e = r / I_W2, q = r % I_W2;
            conv_item8<false>(p.w_mlp2 + (size_t)e * D * D, D, D, p.ws + WS_W2 + (size_t)e * D * D, q, scr, lane); }
    }
}

__device__ void p1_h(const Params& p) {
    const int tid = tid_opaque(), lane = tid & 63;
    const float* mod = (const float*)(p.ws + WS_MOD);
    bf16_t* hb = (bf16_t*)(p.ws + WS_HB);
    constexpr int R = 17;
    const int gwv = blockIdx.x * (NTHREADS / 64) + (tid >> 6);
    const int m0 = gwv * R; if (m0 >= MROWS) return;
    const int m1 = m0 + R < MROWS ? m0 + R : MROWS;
    f32x4 pB[4], pC[4], v[4], nv[4]; int curb = -1;
#define P1_ROWPTR(m) ((m) < NTOK ? p.x + (size_t)(m) * D : p.ctx + (size_t)((m) - NTOK) * D)
    { const float* xr = P1_ROWPTR(m0);
#pragma unroll
      for (int j = 0; j < 4; ++j) nv[j] = ((const f32x4*)xr)[lane + 64 * j]; }
    for (int m = m0; m < m1; ++m) {
#pragma unroll
        for (int j = 0; j < 4; ++j) v[j] = nv[j];
        if (m + 1 < m1) { const float* xr = P1_ROWPTR(m + 1);
#pragma unroll
            for (int j = 0; j < 4; ++j) nv[j] = ((const f32x4*)xr)[lane + 64 * j]; }
        const int b = m < NTOK ? m / L : 8;
        if (b != curb) { curb = b; const float* sh = mod + b * 6144, * sc = sh + 1024;
#pragma unroll
            for (int j = 0; j < 4; ++j) { const int c0 = 4 * (lane + 64 * j); pB[j] = *(const f32x4*)(p.g_pre_mix + c0) * (*(const f32x4*)(sc + c0) + 1.f); pC[j] = *(const f32x4*)(sh + c0); } }
        float s = 0.f;
#pragma unroll
        for (int j = 0; j < 4; ++j) s += v[j].x * v[j].x + v[j].y * v[j].y + v[j].z * v[j].z + v[j].w * v[j].w;
        const float rstd = rsqrtf(wave_sum(s) * (1.f / D) + EPS);
#pragma unroll
        for (int j = 0; j < 4; ++j) { const int c0 = 4 * (lane + 64 * j);
            const f32x4 o = (v[j] * rstd) * pB[j] + pC[j];
            u32x2 w; w.x = pk2(o.x, o.y); w.y = pk2(o.z, o.w);
            *(u32x2*)(hb + (size_t)m * D + c0) = w; }
    }
#undef P1_ROWPTR
}

template <class AL, class BL, class EP>
__device__ __forceinline__ void ngemm_tile(float* sA, float* sB, int m0, int n0, int K, const AL& aload, const BL& bload, const EP& epi) {
    const int tid = threadIdx.x, ty = tid >> 4, tx = tid & 15;
    float acc[4][4];
#pragma unroll
    for (int i = 0; i < 4; ++i)
#pragma unroll
        for (int j = 0; j < 4; ++j) acc[i][j] = 0.f;
    for (int k0 = 0; k0 < K; k0 += 16) {
#pragma unroll
        for (int i = 0; i < 4; ++i) { const int e = tid + NTHREADS * i, r = e >> 4, kk = e & 15; sA[kk * 132 + r] = aload(m0 + r, k0 + kk); }
#pragma unroll
        for (int i = 0; i < 2; ++i) { const int e = tid + NTHREADS * i, n = e >> 4, kk = e & 15; sB[kk * 68 + n] = bload(n0 + n, k0 + kk); }
        __syncthreads();
#pragma unroll
        for (int kk = 0; kk < 16; ++kk) {
            float a[4], b[4];
#pragma unroll
            for (int i = 0; i < 4; ++i) a[i] = sA[kk * 132 + ty * 4 + i];
#pragma unroll
            for (int j = 0; j < 4; ++j) b[j] = sB[kk * 68 + tx + 16 * j];
#pragma unroll
            for (int i = 0; i < 4; ++i)
#pragma unroll
                for (int j = 0; j < 4; ++j) acc[i][j] = fmaf(a[i], b[j], acc[i][j]);
        }
        __syncthreads();
    }
    epi(m0 + ty * 4, n0, tx, acc);
}

__device__ void p2_qkv_naive(const Params& p, float* sA, float* sB) {
    const bf16_t* hb = (const bf16_t*)(p.ws + WS_HB); const bf16_t* wT = (const bf16_t*)(p.ws + WS_WIN);
    bf16_t* qkv = (bf16_t*)(p.ws + WS_QKV); const float* tab = (const float*)(p.ws + WS_TAB);
    constexpr int NTN = INW / 64, NT = (MROWS / 128) * NTN;
    for (int t = blockIdx.x; t < NT; t += gridDim.x) {
        const int m0 = (t / NTN) * 128, n0 = (t % NTN) * 64;
        auto al = [&](int r, int k) { return bf2f(hb[(size_t)r * D + k]); };
        auto bl = [&](int n, int k) { return bf2f(wT[(size_t)n * D + k]); };
        auto ep = [&](int r0, int nn0, int tx, float (&acc)[4][4]) {
#pragma unroll
            for (int i = 0; i < 4; ++i) {
                const int r = r0 + i; float v0 = acc[i][0], v1 = acc[i][1], v2 = acc[i][2], v3 = acc[i][3];
                const bool rope = (nn0 < C_VA) && (r < NTOK);
                if (rope) { const int t = r & (L - 1), pr = t >> 6, pc = t & 63;
                    const float c0 = tab[(pr * 16 + tx) * 2], s0 = tab[(pr * 16 + tx) * 2 + 1], c1 = tab[(pc * 16 + tx) * 2], s1 = tab[(pc * 16 + tx) * 2 + 1];
                    const float a0 = v0 * c0 - v1 * s0, a1 = v1 * c0 + v0 * s0, a2 = v2 * c1 - v3 * s1, a3 = v3 * c1 + v2 * s1; v0 = a0; v1 = a1; v2 = a2; v3 = a3; }
                const bool isq = (nn0 < C_KA) || (nn0 >= C_QB && nn0 < C_KB);
                if (isq) { v0 *= QSCALE; v1 *= QSCALE; v2 *= QSCALE; v3 *= QSCALE; }
                bf16_t* o = qkv + (size_t)r * INW + nn0 + tx;
                o[0] = (bf16_t)f2bf(v0); o[16] = (bf16_t)f2bf(v1); o[32] = (bf16_t)f2bf(v2); o[48] = (bf16_t)f2bf(v3);
            }
        };
        ngemm_tile(sA, sB, m0, n0, D, al, bl, ep);
    }
}

__device__ __forceinline__ void load_row64(const bf16_t* src, float* dst) {
#pragma unroll
    for (int c = 0; c < 8; ++c) { const u32x4 w = *(const u32x4*)(src + c * 8);
        dst[c * 8 + 0] = __uint_as_float(w.x << 16); dst[c * 8 + 1] = __uint_as_float(w.x & 0xffff0000u);
        dst[c * 8 + 2] = __uint_as_float(w.y << 16); dst[c * 8 + 3] = __uint_as_float(w.y & 0xffff0000u);
        dst[c * 8 + 4] = __uint_as_float(w.z << 16); dst[c * 8 + 5] = __uint_as_float(w.z & 0xffff0000u);
        dst[c * 8 + 6] = __uint_as_float(w.w << 16); dst[c * 8 + 7] = __uint_as_float(w.w & 0xffff0000u); }
}
struct OnlineSm { float m, l; };
__device__ __forceinline__ void attn_key(const float (&q)[64], float (&o)[64], OnlineSm& st, const bf16_t* krow, const bf16_t* vrow, float bias) {
    float s = bias;
#pragma unroll
    for (int c = 0; c < 8; ++c) { const u32x4 w = *(const u32x4*)(krow + c * 8);
        s = fmaf(q[c * 8 + 0], __uint_as_float(w.x << 16), s); s = fmaf(q[c * 8 + 1], __uint_as_float(w.x & 0xffff0000u), s);
        s = fmaf(q[c * 8 + 2], __uint_as_float(w.y << 16), s); s = fmaf(q[c * 8 + 3], __uint_as_float(w.y & 0xffff0000u), s);
        s = fmaf(q[c * 8 + 4], __uint_as_float(w.z << 16), s); s = fmaf(q[c * 8 + 5], __uint_as_float(w.z & 0xffff0000u), s);
        s = fmaf(q[c * 8 + 6], __uint_as_float(w.w << 16), s); s = fmaf(q[c * 8 + 7], __uint_as_float(w.w & 0xffff0000u), s); }
    const float mn = fmaxf(st.m, s), sc = exp2f(st.m - mn), pp = exp2f(s - mn);
    st.l = st.l * sc + pp; st.m = mn;
#pragma unroll
    for (int c = 0; c < 8; ++c) { const u32x4 w = *(const u32x4*)(vrow + c * 8);
        o[c * 8 + 0] = fmaf(pp, __uint_as_float(w.x << 16), o[c * 8 + 0] * sc); o[c * 8 + 1] = fmaf(pp, __uint_as_float(w.x & 0xffff0000u), o[c * 8 + 1] * sc);
        o[c * 8 + 2] = fmaf(pp, __uint_as_float(w.y << 16), o[c * 8 + 2] * sc); o[c * 8 + 3] = fmaf(pp, __uint_as_float(w.y & 0xffff0000u), o[c * 8 + 3] * sc);
        o[c * 8 + 4] = fmaf(pp, __uint_as_float(w.z << 16), o[c * 8 + 4] * sc); o[c * 8 + 5] = fmaf(pp, __uint_as_float(w.z & 0xffff0000u), o[c * 8 + 5] * sc);
        o[c * 8 + 6] = fmaf(pp, __uint_as_float(w.w << 16), o[c * 8 + 6] * sc); o[c * 8 + 7] = fmaf(pp, __uint_as_float(w.w & 0xffff0000u), o[c * 8 + 7] * sc); }
}
__device__ __forceinline__ void store_o64(bf16_t* dst, const float (&o)[64], float inv) {
#pragma unroll
    for (int c = 0; c < 8; ++c) { u32x4 w; w.x = pk2(o[c * 8] * inv, o[c * 8 + 1] * inv); w.y = pk2(o[c * 8 + 2] * inv, o[c * 8 + 3] * inv);
        w.z = pk2(o[c * 8 + 4] * inv, o[c * 8 + 5] * inv); w.w = pk2(o[c * 8 + 6] * inv, o[c * 8 + 7] * inv); *(u32x4*)(dst + c * 8) = w; }
}
__device__ void p3_attn_naive(const Params& p, int gtid, int gsize) {
    const bf16_t* qkv = (const bf16_t*)(p.ws + WS_QKV); bf16_t* ob = (bf16_t*)(p.ws + WS_O);
    for (int it = gtid; it < NTOK * 16; it += gsize) {
        const bool isB = it >= NTOK * 8; const int w = isB ? it - NTOK * 8 : it;
        const int h = w & 7, tokg = w >> 3, b = tokg / L, t = tokg % L;
        float q[64], o[64];
#pragma unroll
        for (int d = 0; d < 64; ++d) o[d] = 0.f;
        OnlineSm st;
        if (!isB) {
            const int kvh = h >> 2;
            load_row64(qkv + (size_t)tokg * INW + C_QA + h * 64, q);
            st.m = p.sink_a[h] * LOG2E; st.l = 1.f;
            const int j0 = t - 128 < 0 ? 0 : t - 128, j1 = t + 128 > L - 1 ? L - 1 : t + 128;
            for (int j = j0; j <= j1; ++j) { const bf16_t* row = qkv + (size_t)(b * L + j) * INW; attn_key(q, o, st, row + C_KA + kvh * 64, row + C_VA + kvh * 64, 0.f); }
            for (int c = 0; c < CTX; ++c) { const bf16_t* row = qkv + (size_t)(NTOK + b * CTX + c) * INW; attn_key(q, o, st, row + C_KA + kvh * 64, row + C_VA + kvh * 64, 0.f); }
            store_o64(ob + (size_t)tokg * D + h * 64, o, 1.f / st.l);
        } else {
            load_row64(qkv + (size_t)tokg * INW + C_QB + h * 64, q);
            st.m = -1e30f; st.l = 0.f;
            const int r = t >> 6, c = t & 63;
            const int rs = r - 4 < 0 ? 0 : (r - 4 > 56 ? 56 : r - 4), cs = c - 8 < 0 ? 0 : (c - 8 > 48 ? 48 : c - 8);
            for (int a = 0; a < 8; ++a)
                for (int e = 0; e < 16; ++e) { const int kr = rs + a, kc = cs + e; const bf16_t* row = qkv + (size_t)(b * L + kr * 64 + kc) * INW;
                    const float bias = p.rpb_b[(h * 15 + (kr - r + 7)) * 31 + (kc - c + 15)] * LOG2E;
                    attn_key(q, o, st, row + C_KB + h * 64, row + C_VB + h * 64, bias); }
            for (int cc = 0; cc < CTX; ++cc) { const bf16_t* row = qkv + (size_t)(NTOK + b * CTX + cc) * INW; attn_key(q, o, st, row + C_KB + h * 64, row + C_VB + h * 64, 0.f); }
            store_o64(ob + (size_t)tokg * D + 512 + h * 64, o, 1.f / st.l);
        }
    }
}


namespace att {
#define ATT_LAS __attribute__((address_space(3)))
typedef float f32x16 __attribute__((ext_vector_type(16)));
typedef short bf16x8 __attribute__((ext_vector_type(8)));
typedef short s16x4 __attribute__((ext_vector_type(4)));
constexpr int SLOTB = 8192, NSLOT = 4;
constexpr int LDS_K = 0, LDS_V = NSLOT * SLOTB, LDS_WS = 2 * NSLOT * SLOTB, LDS_BT = LDS_WS + 8 * 256;
constexpr int BT_MARGIN = 64, BT_FLOATS = BT_MARGIN + 15 * 32 + 96;
constexpr float NEGBIG = -1e30f;
__device__ __forceinline__ int crow(int r, int hi) { return (r & 3) + 8 * (r >> 2) + 4 * hi; }
__device__ __forceinline__ unsigned cvtpk(float lo, float hi) { typedef float f2 __attribute__((ext_vector_type(2))); typedef __bf16 b2 __attribute__((ext_vector_type(2)));
    f2 v = {lo, hi}; b2 b = __builtin_convertvector(v, b2); return __builtin_bit_cast(unsigned, b); }
__device__ __forceinline__ s16x4 vtr(const ATT_LAS unsigned char* p) { typedef short v4i16 __attribute__((ext_vector_type(4)));
    return __builtin_bit_cast(s16x4, __builtin_amdgcn_ds_read_tr16_b64_v4i16((ATT_LAS v4i16*)p)); }
#define ATT_WAIT_BAR(N) asm volatile("s_waitcnt vmcnt(" #N ") lgkmcnt(0)\n\ts_barrier" ::: "memory")

__device__ __forceinline__ void dma_tile(ATT_LAS unsigned char* lds, int slot, const bf16_t* kbase, const bf16_t* vbase, int wid, int lane) {
    const bf16_t* ksrc = kbase + (size_t)lane * INW + wid * 8;
    const bf16_t* vsrc = vbase + (size_t)(16 * (wid & 3) + (lane >> 2)) * INW + (wid >> 2) * 32 + (lane & 3) * 8;
    __builtin_amdgcn_global_load_lds((const unsigned*)ksrc, (ATT_LAS unsigned*)(lds + LDS_K + slot * SLOTB + wid * 1024), 16, 0, 0);
    __builtin_amdgcn_global_load_lds((const unsigned*)vsrc, (ATT_LAS unsigned*)(lds + LDS_V + slot * SLOTB + wid * 1024), 16, 0, 0);
}

template <bool ISB>
__device__ __forceinline__ void attn_unit(const Params& p, ATT_LAS unsigned char* lds, int unit) {
    int tid_ = threadIdx.x; asm volatile("" : "+v"(tid_));
    const int tid = tid_, lane = tid & 63, r32 = lane & 31, hi = lane >> 5; const int wid = __builtin_amdgcn_readfirstlane(tid >> 6);
    const bf16_t* qkv = (const bf16_t*)(p.ws + WS_QKV); bf16_t* ob = (bf16_t*)(p.ws + WS_O);
    ATT_LAS float* wsf = (ATT_LAS float*)(lds + LDS_WS) + wid * 64;
    ATT_LAS float* bt = (ATT_LAS float*)(lds + LDS_BT);
    int b, h, kcol, vcol, qcol, ocol, q0, nloc, row_lo = 0, qr = 0, half = 0, qb = 0, jlo = 0;
    if (!ISB) { b = unit >> 7; const int kvh = (unit >> 6) & 1; qb = unit & 63; h = kvh * 4 + (wid >> 1); half = wid & 1; q0 = qb * 64 + 32 * half;
        kcol = C_KA + kvh * 64; vcol = C_VA + kvh * 64; qcol = C_QA + h * 64; ocol = h * 64;
        jlo = 2 - qb > 0 ? 2 - qb : 0; const int jhi = 65 - qb < 4 ? 65 - qb : 4; nloc = jhi - jlo + 1;
    } else { b = unit >> 7; h = (unit >> 4) & 7; const int g = unit & 15; qr = 4 * g + (wid >> 1); half = wid & 1; q0 = qr * 64 + 32 * half;
        kcol = C_KB + h * 64; vcol = C_VB + h * 64; qcol = C_QB + h * 64; ocol = 512 + h * 64;
        const int r0 = 4 * g, r3 = 4 * g + 3; row_lo = r0 - 4 < 0 ? 0 : (r0 - 4 > 56 ? 56 : r0 - 4); const int rs3 = r3 - 4 < 0 ? 0 : (r3 - 4 > 56 ? 56 : r3 - 4); nloc = rs3 + 7 - row_lo + 1;
    }
    const int NT = nloc + 4;
    const bf16_t* lat = qkv + (size_t)b * L * INW; const bf16_t* cx = qkv + (size_t)(NTOK + b * CTX) * INW;
#define ATT_TILE_ROW(t) ((t) < nloc ? lat + (size_t)(ISB ? (row_lo + (t)) * 64 : (qb - 2 + jlo + (t)) * 64) * INW : cx + (size_t)((t) - nloc) * 64 * INW)
    if (ISB) {
        for (int i = tid; i < BT_FLOATS; i += NTHREADS) { const int j = i - BT_MARGIN; float v = 0.f;
            if (j >= 0 && j < 15 * 32 && (j & 31) < 31) v = p.rpb_b[(h * 15 + (j >> 5)) * 31 + (j & 31)] * LOG2E;
            bt[i] = v; }
    }
#pragma unroll
    for (int t0 = 0; t0 < NSLOT - 1; ++t0) { const bf16_t* r0p = ATT_TILE_ROW(t0); dma_tile(lds, t0, r0p + kcol, r0p + vcol, wid, lane); }
    bf16x8 qf[4];
    { const bf16_t* qp = lat + (size_t)(q0 + r32) * INW + qcol + hi * 8;
#pragma unroll
      for (int d0 = 0; d0 < 4; ++d0) qf[d0] = *(const bf16x8*)(qp + d0 * 16); }
    float m_run, l_run;
    if (!ISB) { m_run = p.sink_a[h] * LOG2E; l_run = hi == 0 ? 1.f : 0.f; } else { m_run = NEGBIG; l_run = 0.f; }
    f32x16 o0, o1;
#pragma unroll
    for (int r = 0; r < 16; ++r) { o0[r] = 0.f; o1[r] = 0.f; }
    const int qc = 32 * half + r32;
    const int cs = qc - 8 < 0 ? 0 : (qc - 8 > 48 ? 48 : qc - 8);
    const int rsq = qr - 4 < 0 ? 0 : (qr - 4 > 56 ? 56 : qr - 4);
    for (int t = 0; t < NT; ++t) {
        const int ahead = NT - 1 - t < NSLOT - 2 ? NT - 1 - t : NSLOT - 2;
        if (ahead == 2) ATT_WAIT_BAR(4); else if (ahead == 1) ATT_WAIT_BAR(2); else ATT_WAIT_BAR(0);
        if (t + NSLOT - 1 < NT) { const bf16_t* rp = ATT_TILE_ROW(t + NSLOT - 1); dma_tile(lds, (t + NSLOT - 1) & (NSLOT - 1), rp + kcol, rp + vcol, wid, lane); }
        const int slot = t & (NSLOT - 1);
        bool active = true; int kr = 0;
        if (ISB && t < nloc) { kr = row_lo + t; active = (kr >= rsq) && (kr <= rsq + 7); }
        if (active) {
            const ATT_LAS unsigned char* kb = lds + LDS_K + slot * SLOTB + hi * 1024 + r32 * 16;
            f32x16 p0, p1;
#pragma unroll
            for (int r = 0; r < 16; ++r) { p0[r] = 0.f; p1[r] = 0.f; }
#pragma unroll
            for (int d0 = 0; d0 < 4; ++d0) {
                const bf16x8 k0 = *(const ATT_LAS bf16x8*)(kb + d0 * 2048), k1 = *(const ATT_LAS bf16x8*)(kb + d0 * 2048 + 512);
                p0 = __builtin_amdgcn_mfma_f32_32x32x16_bf16(k0, qf[d0], p0, 0, 0, 0);
                p1 = __builtin_amdgcn_mfma_f32_32x32x16_bf16(k1, qf[d0], p1, 0, 0, 0);
            }
            if (ISB) {
                if (t < nloc) {
                    const ATT_LAS float* bp = bt + BT_MARGIN + (kr - qr + 7) * 32 + 15 - qc + 4 * hi;
                    const int e0 = 4 * hi - cs;
#pragma unroll
                    for (int r = 0; r < 16; ++r) { const int c = (r & 3) + 8 * (r >> 2);
                        const float b0 = bp[c], b1 = bp[c + 32];
                        p0[r] = ((unsigned)(c + e0) < 16u) ? p0[r] + b0 : NEGBIG;
                        p1[r] = ((unsigned)(c + 32 + e0) < 16u) ? p1[r] + b1 : NEGBIG; }
                }
            } else {
                if (t < nloc) { const int j = jlo + t; const int qq = 32 * half + r32;
                    if (j == 0) {
#pragma unroll
                        for (int r = 0; r < 16; ++r) { const int c = crow(r, hi); if (c < qq) p0[r] = NEGBIG; if (c + 32 < qq) p1[r] = NEGBIG; }
                    } else if (j == 4) {
#pragma unroll
                        for (int r = 0; r < 16; ++r) { const int c = crow(r, hi); if (c > qq) p0[r] = NEGBIG; if (c + 32 > qq) p1[r] = NEGBIG; }
                    }
                }
            }
            float rm = fmaxf(p0[0], p1[0]);
#pragma unroll
            for (int r = 1; r < 16; ++r) rm = fmaxf(rm, fmaxf(p0[r], p1[r]));
            rm = fmaxf(rm, __shfl_xor(rm, 32));
            const float mnew = fmaxf(m_run, rm);
            if (__any(mnew > m_run)) {
                const float f = __builtin_amdgcn_exp2f(m_run - mnew);
                l_run *= f; m_run = mnew;
                if (hi == 0) wsf[r32] = f;
                asm volatile("s_waitcnt lgkmcnt(0)" ::: "memory");
#pragma unroll
                for (int r = 0; r < 16; ++r) { const float fr_ = wsf[crow(r, hi)]; o0[r] *= fr_; o1[r] *= fr_; }
            }
            float ls = 0.f;
#pragma unroll
            for (int r = 0; r < 16; ++r) { p0[r] = __builtin_amdgcn_exp2f(p0[r] - m_run); p1[r] = __builtin_amdgcn_exp2f(p1[r] - m_run); ls += p0[r] + p1[r]; }
            l_run += ls;
            typedef unsigned u4 __attribute__((ext_vector_type(4)));
            const u4 pw0 = {cvtpk(p0[0], p0[1]), cvtpk(p0[2], p0[3]), cvtpk(p0[4], p0[5]), cvtpk(p0[6], p0[7])};
            const u4 pw1 = {cvtpk(p0[8], p0[9]), cvtpk(p0[10], p0[11]), cvtpk(p0[12], p0[13]), cvtpk(p0[14], p0[15])};
            const u4 pw2 = {cvtpk(p1[0], p1[1]), cvtpk(p1[2], p1[3]), cvtpk(p1[4], p1[5]), cvtpk(p1[6], p1[7])};
            const u4 pw3 = {cvtpk(p1[8], p1[9]), cvtpk(p1[10], p1[11]), cvtpk(p1[12], p1[13]), cvtpk(p1[14], p1[15])};
            const ATT_LAS unsigned char* vp = lds + LDS_V + slot * SLOTB + ((lane >> 4) & 1) * 32 + (lane & 3) * 8 + (4 * hi + ((lane & 15) >> 2)) * 64;
#define ATT_PV(OACC, PW, D0, KS) do { const s16x4 lo_ = vtr(vp + (D0) * 4096 + (KS) * 1024), hi_ = vtr(vp + (D0) * 4096 + (KS) * 1024 + 512); \
                const bf16x8 vf_ = {lo_[0], lo_[1], lo_[2], lo_[3], hi_[0], hi_[1], hi_[2], hi_[3]}; \
                OACC = __builtin_amdgcn_mfma_f32_32x32x16_bf16(__builtin_bit_cast(bf16x8, PW), vf_, OACC, 0, 0, 0); } while (0)
            ATT_PV(o0, pw0, 0, 0); ATT_PV(o1, pw0, 1, 0); ATT_PV(o0, pw1, 0, 1); ATT_PV(o1, pw1, 1, 1);
            ATT_PV(o0, pw2, 0, 2); ATT_PV(o1, pw2, 1, 2); ATT_PV(o0, pw3, 0, 3); ATT_PV(o1, pw3, 1, 3);
#undef ATT_PV
        }
    }
    l_run += __shfl_xor(l_run, 32);
    if (hi == 0) wsf[32 + r32] = l_run;
    asm volatile("s_waitcnt lgkmcnt(0)" ::: "memory");
    bf16_t* op = ob + (size_t)(b * L + q0) * D + ocol + r32;
    float* ossp = (float*)(p.ws + WS_OSS) + (size_t)(b * L + q0) * 16 + (ocol >> 6);
#pragma unroll
    for (int r = 0; r < 16; ++r) { const int q = crow(r, hi); const float inv = __builtin_amdgcn_rcpf(wsf[32 + q]);
        const float a0 = o0[r] * inv, a1 = o1[r] * inv;
        op[(size_t)q * D] = (bf16_t)f2bf(a0); op[(size_t)q * D + 32] = (bf16_t)f2bf(a1);
        const float ss = row_sum16(a0 * a0 + a1 * a1);
        const float s01 = rdlane(ss, 0) + rdlane(ss, 16), s23 = rdlane(ss, 32) + rdlane(ss, 48);
        if (r32 == 0) ossp[(size_t)q * 16] = hi ? s23 : s01; }
    ATT_WAIT_BAR(0);
#undef ATT_TILE_ROW
}

__device__ __forceinline__ void attn_phase(const Params& p, ATT_LAS unsigned char* lds) {
    const int G = gridDim.x, bx = blockIdx.x;
    const int vcu = (G % 8 == 0) ? (bx % 8) * (G / 8) + bx / 8 : bx;
    for (int u = vcu; u < 2048; u += G) {
        if (u < 1024) attn_unit<false>(p, lds, u); else attn_unit<true>(p, lds, u - 1024);
    }
}
}

__device__ void p4a_ostat(const Params& p, int gw, int ngw, int lane) {
    bf16_t* ob = (bf16_t*)(p.ws + WS_O); float* os = (float*)(p.ws + WS_OSTAT);
    for (int m = gw; m < NTOK; m += ngw) {
        const u32x4 wa = *(const u32x4*)(ob + (size_t)m * D + lane * 8), wb = *(const u32x4*)(ob + (size_t)m * D + 512 + lane * 8);
        float sa = 0.f, sb = 0.f;
#pragma unroll
        for (int i = 0; i < 4; ++i) { const unsigned ua = wa[i], ub = wb[i]; const float a0 = __uint_as_float(ua << 16), a1 = __uint_as_float(ua & 0xffff0000u), b0 = __uint_as_float(ub << 16), b1 = __uint_as_float(ub & 0xffff0000u);
            sa += a0 * a0 + a1 * a1; sb += b0 * b0 + b1 * b1; }
        sa = wave_sum(sa); sb = wave_sum(sb);
        const float ra = rsqrtf(sa * (1.f / 512.f) + EPS), rb = rsqrtf(sb * (1.f / 512.f) + EPS);
        if (lane == 0) { os[m * 2] = ra; os[m * 2 + 1] = rb; }
        u32x4 oa, obb;
#pragma unroll
        for (int i = 0; i < 4; ++i) { const unsigned ua = wa[i], ub = wb[i];
            oa[i] = pk2(__uint_as_float(ua << 16) * ra, __uint_as_float(ua & 0xffff0000u) * ra); obb[i] = pk2(__uint_as_float(ub << 16) * rb, __uint_as_float(ub & 0xffff0000u) * rb); }
        *(u32x4*)(ob + (size_t)m * D + lane * 8) = oa; *(u32x4*)(ob + (size_t)m * D + 512 + lane * 8) = obb;
    }
}
__device__ void p4b_outproj_naive(const Params& p, float* sA, float* sB) {
    const bf16_t* ob = (const bf16_t*)(p.ws + WS_O); const bf16_t* wT = (const bf16_t*)(p.ws + WS_WOUT);
    float* mix = (float*)(p.ws + WS_MIX);
    constexpr int NTN = D / 64, NT = (NTOK / 128) * NTN;
    for (int t = blockIdx.x; t < NT; t += gridDim.x) {
        const int m0 = (t / NTN) * 128, n0 = (t % NTN) * 64;
        auto al = [&](int r, int k) { return bf2f(ob[(size_t)r * D + k]); };
        auto bl = [&](int n, int k) { return bf2f(wT[(size_t)n * D + k]); };
        auto ep = [&](int r0, int nn0, int tx, float (&acc)[4][4]) {
#pragma unroll
            for (int i = 0; i < 4; ++i)
#pragma unroll
                for (int j = 0; j < 4; ++j) mix[(size_t)(r0 + i) * D + nn0 + tx + 16 * j] = acc[i][j];
        };
        ngemm_tile(sA, sB, m0, n0, D, al, bl, ep);
    }
}
constexpr int SW_STRIDE = 36;

__device__ void p4c_post(const Params& p, LAS3 float* sW) {
    const int tid = tid_opaque(), lane = tid & 63;
    const float* mod = (const float*)(p.ws + WS_MOD); const float* mix = (const float*)(p.ws + WS_MIX);
    unsigned char* h8 = p.ws + WS_HB;
    unsigned* counts = (unsigned*)(p.ws + WS_CTL);
    int* eslot = (int*)(p.ws + WS_ESLOT); float* ew = (float*)(p.ws + WS_EW);
    const int wave = tid >> 6;
    LAS3 int* lcnt = (LAS3 int*)(sW + 1024 * SW_STRIDE) + 128;
    LAS3 int* lbase = lcnt + 32;
    LAS3 int* stg_slot = lbase + 32; LAS3 int* stg_e = stg_slot + 512; LAS3 float* stg_w = (LAS3 float*)(stg_e + 512);
    if (threadIdx.x < NE) lcnt[threadIdx.x] = 0;
    for (int i = threadIdx.x; i < D * 8; i += NTHREADS) { const int k = i >> 3, e4 = i & 7; const f32x4 w = ((const f32x4*)p.w_router)[i];
        LAS3 float* d = sW + ((k & 3) * 256 + (k >> 2)) * SW_STRIDE + e4 * 4; *(LAS3 f32x4*)d = w; }
    __syncthreads();
    constexpr int R = 16;
    const int m0 = ((int)blockIdx.x * (NTHREADS / 64) + wave) * R;
    if (m0 < NTOK) {
        const int b = m0 / L; const float* mb = mod + b * 6144;
        f32x4 pA[4], pB[4], pC[4], v[4], xx[4], nv[4], nx[4];
#pragma unroll
        for (int j = 0; j < 4; ++j) { const int c0 = 4 * (lane + 64 * j);
            pA[j] = *(const f32x4*)(p.g_post_mix + c0) * *(const f32x4*)(mb + 2048 + c0);
            pB[j] = *(const f32x4*)(p.g_pre_ffn + c0) * (*(const f32x4*)(mb + 4096 + c0) + 1.f);
            pC[j] = *(const f32x4*)(mb + 3072 + c0);
            nv[j] = ((const f32x4*)(mix + (size_t)m0 * D))[lane + 64 * j]; nx[j] = ((const f32x4*)(p.x + (size_t)m0 * D))[lane + 64 * j]; }
        for (int it = 0; it < R; ++it) {
            const int m = m0 + it;
#pragma unroll
            for (int j = 0; j < 4; ++j) { v[j] = nv[j]; xx[j] = nx[j]; }
            if (it + 1 < R) {
#pragma unroll
                for (int j = 0; j < 4; ++j) { nv[j] = ((const f32x4*)(mix + (size_t)(m + 1) * D))[lane + 64 * j]; nx[j] = ((const f32x4*)(p.x + (size_t)(m + 1) * D))[lane + 64 * j]; }
            }
            float s = 0.f;
#pragma unroll
            for (int j = 0; j < 4; ++j) s += v[j].x * v[j].x + v[j].y * v[j].y + v[j].z * v[j].z + v[j].w * v[j].w;
            float rstd = rsqrtf(wave_sum(s) * (1.f / D) + EPS);
            s = 0.f;
            f32x4 xv[4];
#pragma unroll
            for (int j = 0; j < 4; ++j) {
                xv[j] = xx[j] + pA[j] * (v[j] * rstd);
                ((f32x4*)(p.out + (size_t)m * D))[lane + 64 * j] = xv[j];
                s += xv[j].x * xv[j].x + xv[j].y * xv[j].y + xv[j].z * xv[j].z + xv[j].w * xv[j].w; }
            rstd = rsqrtf(wave_sum(s) * (1.f / D) + EPS);
            float lg[NE];
#pragma unroll
            for (int e = 0; e < NE; ++e) lg[e] = 0.f;
#pragma unroll
            for (int j = 0; j < 4; ++j) { const int c0 = 4 * (lane + 64 * j);
                const f32x4 h2 = (xv[j] * rstd) * pB[j] + pC[j];
                *(unsigned*)(h8 + (size_t)m * D + c0) = pk4_fp8(h2.x, h2.y, h2.z, h2.w);
#pragma unroll
                for (int q = 0; q < 4; ++q) { const float hv = h2[q]; const LAS3 f32x4* wr = (const LAS3 f32x4*)(sW + (q * 256 + lane + 64 * j) * SW_STRIDE);
#pragma unroll
                    for (int e4 = 0; e4 < 8; ++e4) { const f32x4 ww = wr[e4]; lg[e4 * 4] = fmaf(hv, ww.x, lg[e4 * 4]); lg[e4 * 4 + 1] = fmaf(hv, ww.y, lg[e4 * 4 + 1]); lg[e4 * 4 + 2] = fmaf(hv, ww.z, lg[e4 * 4 + 2]); lg[e4 * 4 + 3] = fmaf(hv, ww.w, lg[e4 * 4 + 3]); }
                    asm volatile("" ::: "memory"); }
            }
#pragma unroll
            for (int e = 0; e < NE; ++e) lg[e] = wave_sum(lg[e]) + p.b_router[e];
            float tv[4]; int ti[4]; unsigned used = 0u;
#pragma unroll
            for (int k = 0; k < 4; ++k) { float best = -3.4e38f; int bi = 0;
#pragma unroll
                for (int e = 0; e < NE; ++e) { const bool ok = !((used >> e) & 1u) && lg[e] > best; best = ok ? lg[e] : best; bi = ok ? e : bi; }
                tv[k] = best; ti[k] = bi; used |= 1u << bi; }
            const float e1 = __expf(tv[1] - tv[0]), e2 = __expf(tv[2] - tv[0]), e3 = __expf(tv[3] - tv[0]); const float inv = 1.f / (1.f + e1 + e2 + e3);
            const float tw[4] = {inv, e1 * inv, e2 * inv, e3 * inv};
            if (lane < 4) {
                int myi = ti[0]; float myw = tw[0];
#pragma unroll
                for (int k = 1; k < 4; ++k) if (lane == k) { myi = ti[k]; myw = tw[k]; }
                const int lr = __hip_atomic_fetch_add((LAS3 int*)&lcnt[myi], 1, __ATOMIC_RELAXED, __HIP_MEMORY_SCOPE_WORKGROUP);
                const int si = (wave * 16 + it) * 4 + lane;
                stg_slot[si] = m * 4 + lane; stg_e[si] = myi | (lr << 8); stg_w[si] = myw;
            }
        }
    }
    __syncthreads();
    if (threadIdx.x < NE) { const int c = lcnt[threadIdx.x]; lbase[threadIdx.x] = c ? (int)atomicAdd(&counts[threadIdx.x * 64], (unsigned)c) : 0; }
    __syncthreads();
    { const int si = threadIdx.x, w = si >> 6;
      if (((int)blockIdx.x * (NTHREADS / 64) + w) * R < NTOK) {
        const int ee = stg_e[si], e = ee & 255, lr = ee >> 8; const int rank = lbase[e] + lr;
        eslot[(size_t)e * ECAP + rank] = stg_slot[si]; ew[(size_t)e * ECAP + rank] = stg_w[si]; } }
    __syncthreads();
}
__device__ __forceinline__ void expert_bases(const unsigned* counts, int* sbase_  ) {
    LAS3 int* sbase = (LAS3 int*)sbase_;
    if (threadIdx.x < 64) {
        const int lane = threadIdx.x; const int cn = lane < NE ? (int)counts[lane * 64] : 0; const int c = (cn + 255) & ~255;
        int incl = c;
#pragma unroll
        for (int o = 1; o < 32; o <<= 1) { const int v = __shfl_up(incl, o); if (lane >= o) incl += v; }
        if (lane < NE) { sbase[lane] = incl - c; sbase[40 + lane] = cn; }
        if (lane == NE - 1) sbase[NE] = incl;
    }
    __syncthreads();
}
__device__ __forceinline__ void p6_load(const bf16_t* y, const float* out, int m, int lane, u32x4 (&yv)[2][4], f32x4 (&xv)[2][2]) {
#pragma unroll
    for (int j = 0; j < 2; ++j) { const int c0 = 8 * (lane + 64 * j);
#pragma unroll
        for (int k = 0; k < 4; ++k) yv[j][k] = *(const u32x4*)(y + (size_t)(m * 4 + k) * D + c0);
        xv[j][0] = *(const f32x4*)(out + (size_t)m * D + c0); xv[j][1] = *(const f32x4*)(out + (size_t)m * D + c0 + 4); }
}
__device__ void p6_final(const Params& p) {
    const int tid = tid_opaque(), lane = tid & 63;
    const float* mod = (const float*)(p.ws + WS_MOD); const bf16_t* y = (const bf16_t*)(p.ws + WS_Y);
    constexpr int R = 16;
    const int m0 = ((int)blockIdx.x * (NTHREADS / 64) + (tid >> 6)) * R;
    if (m0 >= NTOK) return;
    const int b = m0 / L; const float* ga2 = mod + b * 6144 + 5120;
    f32x4 pA[2][2];
#pragma unroll
    for (int j = 0; j < 2; ++j)
#pragma unroll
        for (int q = 0; q < 2; ++q) { const int c0 = 8 * (lane + 64 * j) + 4 * q; pA[j][q] = *(const f32x4*)(p.g_post_ffn + c0) * *(const f32x4*)(ga2 + c0); }
    u32x4 yv[2][4], ny[2][4]; f32x4 xv[2][2], nx[2][2];
    p6_load(y, p.out, m0, lane, ny, nx);
    for (int it = 0; it < R; ++it) {
        const int m = m0 + it;
#pragma unroll
        for (int j = 0; j < 2; ++j) {
#pragma unroll
            for (int k = 0; k < 4; ++k) yv[j][k] = ny[j][k];
            xv[j][0] = nx[j][0]; xv[j][1] = nx[j][1]; }
        if (it + 1 < R) p6_load(y, p.out, m + 1, lane, ny, nx);
        f32x4 a[2][2]; float s = 0.f;
#pragma unroll
        for (int j = 0; j < 2; ++j) { a[j][0] = (f32x4){0.f, 0.f, 0.f, 0.f}; a[j][1] = (f32x4){0.f, 0.f, 0.f, 0.f};
#pragma unroll
            for (int k = 0; k < 4; ++k) { const u32x4 w = yv[j][k];
                a[j][0].x += __uint_as_float(w.x << 16); a[j][0].y += __uint_as_float(w.x & 0xffff0000u); a[j][0].z += __uint_as_float(w.y << 16); a[j][0].w += __uint_as_float(w.y & 0xffff0000u);
                a[j][1].x += __uint_as_float(w.z << 16); a[j][1].y += __uint_as_float(w.z & 0xffff0000u); a[j][1].z += __uint_as_float(w.w << 16); a[j][1].w += __uint_as_float(w.w & 0xffff0000u); }
#pragma unroll
            for (int q = 0; q < 2; ++q) s += a[j][q].x * a[j][q].x + a[j][q].y * a[j][q].y + a[j][q].z * a[j][q].z + a[j][q].w * a[j][q].w; }
        const float rstd = rsqrtf(wave_sum(s) * (1.f / D) + EPS);
#pragma unroll
        for (int j = 0; j < 2; ++j)
#pragma unroll
            for (int q = 0; q < 2; ++q) { const int c0 = 8 * (lane + 64 * j) + 4 * q;
                *(f32x4*)(p.out + (size_t)m * D + c0) = xv[j][q] + pA[j][q] * (a[j][q] * rstd); }
    }
}

constexpr int LDS_SBASE = 147456;
constexpr int LDS_BYTES = LDS_SBASE + 512 + (64 + 3 * 512) * 4 + 256;

__global__ void __launch_bounds__(NTHREADS, 2) fwd_kernel(Params p) {
    cg::grid_group grid = cg::this_grid();
    extern __shared__ __attribute__((aligned(16))) unsigned char lds[];
    int* sbase = (int*)(lds + LDS_SBASE);
    PG8_LAS unsigned char* lds3 = (PG8_LAS unsigned char*)lds;
    const PG8_LAS int* sbase3 = (const PG8_LAS int*)(lds3 + LDS_SBASE);
    volatile LAS3 unsigned* bst = (volatile LAS3 unsigned*)(lds3 + LDS_SBASE + 384);
    if (threadIdx.x < 2) bst[threadIdx.x] = 0u;
    __syncthreads();
    XcdBarrier xb = xcd_barrier_post((unsigned*)(p.ws + WS_CTL) + CW_BAR, bst);

    p0_mod(p, (float*)lds, (float*)(lds + 36864));
    p0_tab(p);
    p0_weights(p, lds);
    grid.sync();
    p1_h(p);
    xcd_barrier(xb);
    { pg8::Gemm g{(const bf16_t*)(p.ws + WS_HB), (const bf16_t*)(p.ws + WS_WIN), D, 0, nullptr, sbase3};
      pg8::StaticOrder S; S.init(MROWS, INW, (int)gridDim.x, (int)blockIdx.x, nullptr);
      { const int t_ = tid_opaque(); *(PG8_LAS f32x4*)(lds3 + pg8::PAR_TAB + t_ * 16) = ((const f32x4*)(p.ws + WS_TAB))[t_]; }
      __syncthreads();
      pg8::EpiQKV E{(bf16_t*)(p.ws + WS_QKV)};
      pg8::gemm_phase<pg8::EpiQKV, pg8::StaticOrder, false, true>(lds3, g, S, E); }
    xcd_barrier(xb);
    att::attn_phase(p, lds3);
    xcd_barrier(xb);
    { pg8::Gemm g{(const bf16_t*)(p.ws + WS_O), (const bf16_t*)(p.ws + WS_WOUT), D, 0, nullptr, sbase3};
      pg8::StaticOrder S; S.init(NTOK, D, (int)gridDim.x, (int)blockIdx.x, nullptr);
      pg8::EpiOutProj E{(float*)(p.ws + WS_MIX), (const float*)(p.ws + WS_OSS)};
      pg8::gemm_phase<pg8::EpiOutProj, pg8::StaticOrder, false, true>(lds3, g, S, E); }
    xcd_barrier(xb);
    p4c_post(p, (LAS3 float*)lds3);
    xcd_barrier(xb);
    expert_bases((const unsigned*)(p.ws + WS_CTL), sbase);
    { const int total = sbase3[NE];
      pg8::Gemm g{(const bf16_t*)(p.ws + WS_HB), (const bf16_t*)(p.ws + WS_W1), D / 2, (size_t)2048 * D, (const int*)(p.ws + WS_ESLOT), sbase3};
      pg8::StaticOrder S; S.init(total, 2048, (int)gridDim.x, (int)blockIdx.x, sbase3);
      pg8::EpiSwiglu E{p.ws + WS_ACT, p.b_mlp1};
      pg8::gemm_phase<pg8::EpiSwiglu, pg8::StaticOrder, true, true, true>(lds3, g, S, E); }
    xcd_barrier(xb);
    { const int total = sbase3[NE];
      pg8::Gemm g{(const bf16_t*)(p.ws + WS_ACT), (const bf16_t*)(p.ws + WS_W2), D / 2, (size_t)D * D, nullptr, sbase3};
      pg8::StaticOrder S; S.init(total, D, (int)gridDim.x, (int)blockIdx.x, sbase3);
      pg8::EpiScatter E{(bf16_t*)(p.ws + WS_Y), p.b_mlp2, (const int*)(p.ws + WS_ESLOT), (const float*)(p.ws + WS_EW), sbase3};
      pg8::gemm_phase<pg8::EpiScatter, pg8::StaticOrder, false, true, true>(lds3, g, S, E); }
    xcd_barrier(xb);
    p6_final(p);
}

extern "C" void kernel_launch(void* const* d_in, const int* in_sizes, int n_in, void* d_out, int out_size, void* d_ws, size_t ws_size, hipStream_t stream) {
    static int grid_blocks = 0;
    if (grid_blocks == 0) {
        if (n_in != 22 || ws_size < WS_END) { fprintf(stderr, "kernel_launch: unexpected n_in %d / ws_size %zu (need %zu)\n", n_in, ws_size, (size_t)WS_END); grid_blocks = -1; return; }
        int dev = 0, cus = 0, per_cu = 0;
        (void)hipGetDevice(&dev);
        (void)hipDeviceGetAttribute(&cus, hipDeviceAttributeMultiprocessorCount, dev);
        if (hipFuncSetAttribute((const void*)fwd_kernel, hipFuncAttributeMaxDynamicSharedMemorySize, LDS_BYTES) != hipSuccess) { fprintf(stderr, "kernel_launch: hipFuncSetAttribute failed\n"); grid_blocks = -1; return; }
        (void)hipOccupancyMaxActiveBlocksPerMultiprocessor(&per_cu, (const void*)fwd_kernel, NTHREADS, LDS_BYTES);
        if (per_cu < 1) { fprintf(stderr, "kernel_launch: occupancy query returned %d\n", per_cu); grid_blocks = -1; return; }
        grid_blocks = cus;
        if (grid_blocks * (NTHREADS / 64) * 16 < NTOK) { fprintf(stderr, "kernel_launch: needs >= 256 CUs (got %d)\n", cus); grid_blocks = -1; return; }
    }
    if (grid_blocks < 0) return;
    (void)hipMemsetAsync((char*)d_ws + WS_CTL, 0, CTL_BYTES, stream);
    Params p{};
    const float** pp = (const float**)&p;
    for (int i = 0; i < 22; ++i) pp[i] = (const float*)d_in[i];
    p.out = (float*)d_out; p.ws = (unsigned char*)d_ws;
    void* args[] = {&p};
    hipError_t e = hipLaunchCooperativeKernel((const void*)fwd_kernel, dim3(grid_blocks), dim3(NTHREADS), args, LDS_BYTES, stream);
    if (e != hipSuccess) fprintf(stderr, "cooperative launch failed: %s (grid %d)\n", hipGetErrorString(e), grid_blocks);
}
```

```cpp
#include <hip/hip_runtime.h>
#include <hip/hip_cooperative_groups.h>
#include <cstdio>
#include <cstdint>
namespace cg = cooperative_groups;

constexpr int D = 1024, NB = 8, L = 4096, CTX = 256;
constexpr int NTOK = NB * L, NCTX = NB * CTX, MROWS = NTOK + NCTX;
constexpr int INW = 2304;
constexpr int C_QA = 0, C_KA = 512, C_VA = 640, C_QB = 768, C_KB = 1280, C_VB = 1792;
constexpr int NE = 32, TOPK = 4, NASG = NTOK * TOPK;
constexpr int PADROWS = NASG + NE * 256;
constexpr float LOG2E = 1.4426950408889634f;
constexpr float QSCALE = 0.125f * LOG2E;
constexpr float EPS = 1e-6f;
constexpr int NTHREADS = 512;

constexpr size_t MiB = 1u << 20;
constexpr size_t WS_CTL = 0;
constexpr size_t CTL_BYTES = 32768;
constexpr int CW_BAR = 2048;
constexpr size_t WS_MOD = 1 * MiB;
constexpr size_t WS_TAB = 1 * MiB + 256 * 1024;
constexpr size_t WS_OSTAT = 1 * MiB + 512 * 1024;
constexpr size_t WS_WIN = 2 * MiB;
constexpr size_t WS_WOUT = 7 * MiB;
constexpr size_t WS_W2 = 9 * MiB;
constexpr size_t WS_OSS = 41 * MiB;
constexpr size_t WS_W1 = 73 * MiB;
constexpr size_t WS_HB = 201 * MiB;
constexpr int ECAP = NTOK;
constexpr size_t WS_ESLOT = 269 * MiB;
constexpr size_t WS_EW = 273 * MiB;
constexpr size_t WS_QKV = 277 * MiB;
constexpr size_t WS_O = 430 * MiB;
constexpr size_t WS_MIX = 494 * MiB;
constexpr size_t WS_ACT = 277 * MiB;
constexpr size_t WS_Y = 622 * MiB;
constexpr size_t WS_END = 878 * MiB;
static_assert(WS_W1 + (size_t)NE * 2048 * D * 2 <= WS_HB && WS_W2 + (size_t)NE * D * D * 2 <= WS_W1, "map");
static_assert(WS_HB + (size_t)MROWS * D * 2 <= WS_ESLOT && WS_ESLOT + (size_t)NE * ECAP * 4 <= WS_EW && WS_EW + (size_t)NE * ECAP * 4 <= WS_QKV, "map");
static_assert(WS_QKV + (size_t)MROWS * INW * 2 <= WS_O && WS_O + (size_t)NTOK * D * 2 <= WS_MIX && WS_MIX + (size_t)NTOK * D * 4 <= WS_Y, "map");
static_assert(WS_ACT + (size_t)PADROWS * 1024 * 2 <= WS_Y && WS_Y + (size_t)NASG * D * 2 <= WS_END, "map");

typedef unsigned short bf16_t;
typedef float f32x4 __attribute__((ext_vector_type(4)));
typedef unsigned u32x4 __attribute__((ext_vector_type(4)));
typedef unsigned u32x2 __attribute__((ext_vector_type(2)));

struct Params {
    const float *x, *c, *ctx, *c_ctx, *w_ada, *b_ada, *g_pre_mix, *g_post_mix, *g_pre_ffn, *g_post_ffn, *w_in, *g_grp_a, *g_grp_b,
        *sink_a, *rpb_b, *w_out, *w_router, *b_router, *w_mlp1, *b_mlp1, *w_mlp2, *b_mlp2;
    float* out;
    unsigned char* ws;
};

__device__ __forceinline__ float bf2f(bf16_t h) { return __uint_as_float((unsigned)h << 16); }
__device__ __forceinline__ unsigned f2bf(float f) { unsigned u = __float_as_uint(f); return (u + 0x7fffu + ((u >> 16) & 1u)) >> 16; }
__device__ __forceinline__ unsigned pk2(float lo, float hi) { return f2bf(lo) | (f2bf(hi) << 16); }
__device__ __forceinline__ unsigned pk4_fp8(float v0, float v1, float v2, float v3) {
    int w = 0; w = __builtin_amdgcn_cvt_pk_fp8_f32(v0, v1, w, false); w = __builtin_amdgcn_cvt_pk_fp8_f32(v2, v3, w, true); return (unsigned)w; }
constexpr float Y8_SCALE = 16.f, Y8_INV = 1.f / 16.f;
constexpr float W8_SCALE = 64.f, W8_INV = 1.f / 64.f;
__device__ __forceinline__ int tid_opaque() { int t = threadIdx.x; asm volatile("" : "+v"(t)); return t; }
template <int CTRL> __device__ __forceinline__ float dppmov(float v) { return __builtin_bit_cast(float, __builtin_amdgcn_update_dpp(0, __builtin_bit_cast(int, v), CTRL, 0xf, 0xf, true)); }
__device__ __forceinline__ float row_sum16(float v) { v += dppmov<0xB1>(v); v += dppmov<0x4E>(v); v += dppmov<0x141>(v); v += dppmov<0x140>(v); return v; }
__device__ __forceinline__ float rdlane(float v, int l) { return __builtin_bit_cast(float, __builtin_amdgcn_readlane(__builtin_bit_cast(int, v), l)); }
__device__ __forceinline__ float wave_sum(float v) { v = row_sum16(v); return (rdlane(v, 0) + rdlane(v, 16)) + (rdlane(v, 32) + rdlane(v, 48)); }

#define LAS3 __attribute__((address_space(3)))
#define XB_TMO      128
#define XB_XCNT(j)  (256  + 64 * (j))
#define XB_XSUB(j)  (1280 + 64 * (j))
#define XB_XGEN(j)  (2304 + 64 * (j))
#define XB_TOP      3328
#define XB_TOPGEN   3392
#define XCD_BAR_WORDS 3456
#define XB_SPIN_CAP (1u << 18)
__device__ __forceinline__ unsigned xb_ld(unsigned* p)              { return __hip_atomic_load(p, __ATOMIC_RELAXED, __HIP_MEMORY_SCOPE_AGENT); }
__device__ __forceinline__ unsigned xb_add(unsigned* p, unsigned v) { return __hip_atomic_fetch_add(p, v, __ATOMIC_RELAXED, __HIP_MEMORY_SCOPE_AGENT); }
__device__ __forceinline__ unsigned xb_xcc_id() { return (unsigned)__builtin_amdgcn_s_getreg((3 << 11) | 20) & 0xFu; }
#define XB_SPIN(cond, bar) do { unsigned _sp = 0; while (cond) { __builtin_amdgcn_s_sleep(1); \
    if ((++_sp & 255u) == 0u) { if (xb_ld(&(bar)[XB_TMO])) break; if (_sp > XB_SPIN_CAP) { atomicAdd(&(bar)[XB_TMO], 1u); break; } } } } while (0)
struct XcdBarrier { unsigned* bar; unsigned x; volatile LAS3 unsigned* st; };
__device__ __forceinline__ XcdBarrier xcd_barrier_post(unsigned* bar, volatile LAS3 unsigned* st) {
    XcdBarrier b; b.bar = bar; b.x = xb_xcc_id(); b.st = st;
    if (threadIdx.x == 0) (void)xb_add(&bar[XB_XCNT(b.x)], 1u);
    return b;
}
__device__ __forceinline__ void xcd_barrier_complete(unsigned* bar, unsigned x, unsigned& nloc, unsigned& nx) {
    const unsigned G = gridDim.x * gridDim.y * gridDim.z;
    unsigned sum, cnt, mine, sp = 0u;
    for (;;) {
        sum = 0u; cnt = 0u; mine = 0u;
#pragma unroll
        for (unsigned j = 0; j < 16; ++j) { const unsigned c = xb_ld(&bar[XB_XCNT(j)]); sum += c; cnt += (c > 0u) ? 1u : 0u; mine = (j == x) ? c : mine; }
        if (sum == G) break;
        __builtin_amdgcn_s_sleep(1);
        if ((++sp & 255u) == 0u) { if (xb_ld(&bar[XB_TMO])) break; if (sp > XB_SPIN_CAP) { atomicAdd(&bar[XB_TMO], 1u); break; } }
    }
    nloc = mine > 0u ? mine : 1u; nx = cnt > 0u ? cnt : 1u;
}
__device__ __forceinline__ void xcd_barrier(const XcdBarrier& b) {
    asm volatile("s_waitcnt vmcnt(0)" ::: "memory");
    __syncthreads();
    if (threadIdx.x == 0) {
        unsigned* bar = b.bar;
        __builtin_amdgcn_s_waitcnt(0);
        unsigned nloc = b.st[0], nx = b.st[1];
        if (nloc == 0u) { xcd_barrier_complete(bar, b.x, nloc, nx); b.st[0] = nloc; b.st[1] = nx; }
        const unsigned old = xb_add(&bar[XB_XSUB(b.x)], 1u);
        const unsigned gen = old / nloc;
        if (old + 1u == (gen + 1u) * nloc) {
            __builtin_amdgcn_fence(__ATOMIC_RELEASE, "agent");
            asm volatile("s_waitcnt vmcnt(0)" ::: "memory");
            const unsigned og = xb_add(&bar[XB_TOP], 1u);
            const unsigned tg = og / nx;
            if (og + 1u == (tg + 1u) * nx) xb_add(&bar[XB_TOPGEN], 1u);
            else XB_SPIN(xb_ld(&bar[XB_TOPGEN]) == tg, bar);
            __builtin_amdgcn_fence(__ATOMIC_ACQUIRE, "agent");
            xb_add(&bar[XB_XGEN(b.x)], 1u);
            asm volatile("s_waitcnt vmcnt(0)" ::: "memory");
        } else {
            XB_SPIN(xb_ld(&bar[XB_XGEN(b.x)]) == gen, bar);
            __builtin_amdgcn_fence(__ATOMIC_ACQUIRE, "agent");
            asm volatile("s_waitcnt vmcnt(0)" ::: "memory");
        }
    }
    __syncthreads();
}

namespace pg8 {
#define PG8_LAS __attribute__((address_space(3)))
typedef short bf16x8 __attribute__((ext_vector_type(8)));
typedef int v8i __attribute__((ext_vector_type(8)));
typedef int v4i __attribute__((ext_vector_type(4)));
typedef short s16x16 __attribute__((ext_vector_type(16)));
constexpr int BM = 256, BK = 64, HALF = 128, HTB = HALF * BK * 2  , STAGE_BYTES = 8 * HTB, NXCD = 8, WGM = 8;
__device__ __forceinline__ int lds_byte(int r, int c) { const int st = (r >> 4) * 2 + (c >> 5), rr = r & 15, cc = c & 31, ob = rr * 64 + cc * 2; return st * 1024 + (ob ^ (((ob >> 9) & 1) << 5)); }
__device__ __forceinline__ void stage_rc(int b, int& R, int& C) { const int st = b / 1024, sb = b % 1024, swz = sb ^ (((sb >> 9) & 1) << 5); R = (st >> 1) * 16 + swz / 64; C = (st & 1) * 32 + (swz % 64) / 2; }
__device__ __forceinline__ int perm32(int rho) { const int n = rho >> 4, i = rho & 15; return 8 * (i >> 2) + 4 * n + (i & 3); }

constexpr int PAR_BASE = 131072, PAR_BUF = 4096, PAR_IDX = 0, PAR_W = 1024, PAR_BIAS = 2048, PAR_TAB = PAR_BASE + 2 * PAR_BUF;
typedef short s16x2 __attribute__((ext_vector_type(2)));
__device__ __forceinline__ int par_i32(PG8_LAS unsigned char* p) { return __builtin_bit_cast(int, *(const PG8_LAS s16x2*)p); }
__device__ __forceinline__ float par_f32(PG8_LAS unsigned char* p) { return __builtin_bit_cast(float, *(const PG8_LAS s16x2*)p); }
__device__ __forceinline__ f32x4 par_f32x4(PG8_LAS unsigned char* p) { return __builtin_bit_cast(f32x4, *(const PG8_LAS bf16x8*)p); }
struct Unit { int pm, pn, e; };
struct Gemm { const bf16_t* A; const bf16_t* Bt; int K; size_t bstride; const int* eslot; const PG8_LAS int* sb; };

struct StaticOrder {
    int nM, nN, nwg, G, c; const PG8_LAS int* sbase;
    __device__ void init(int M, int N, int G_, int c_, const PG8_LAS int* sb) { nM = M / BM; nN = N / BM; nwg = nM * nN; G = G_; c = c_; sbase = sb; }
    __device__ bool next(int i, Unit& u) const {
        const long Lx = (long)i * G + c; if (Lx >= nwg) return false;
        int wgid = (int)Lx; { const int q = nwg / NXCD, r = nwg % NXCD, xcd = wgid % NXCD, off = wgid / NXCD; wgid = (xcd < r ? xcd * (q + 1) : r * (q + 1) + (xcd - r) * q) + off; }
        const int nig = WGM * nN, gid = wgid / nig, fm = gid * WGM, gsz = (nM - fm) < WGM ? (nM - fm) : WGM;
        u.pm = fm + ((wgid % nig) % gsz); u.pn = (wgid % nig) / gsz; u.e = 0;
        if (sbase) { const int row = u.pm * BM; const int l = (int)(threadIdx.x & 63);
            const bool ge = (l >= 1) && (l < 32) && (row >= sbase[l & 31]);
            u.e = __builtin_popcountll(__ballot(ge)); }
        return true;
    }
};

template <class Epi, class Sched, bool GATHER, bool ALIGN_EPI, bool FP8 = false>
__device__ __forceinline__ void gemm_phase(PG8_LAS unsigned char* lds, const Gemm g, const Sched& S, const Epi& E) {
    int tid_ = threadIdx.x; asm volatile("" : "+v"(tid_));
    const int tid = tid_, wid = __builtin_amdgcn_readfirstlane(tid >> 6), lane = tid & 63, wr = wid >> 2, wc = wid & 3, fr = lane & 15, fq = lane >> 4;
    const int K = g.K, nt = K / BK;
    unsigned voffA[2], voffB[2];
#pragma unroll
    for (int i = 0; i < 2; ++i) { int R, C; stage_rc(tid * 16 + i * 8192, R, C); const int Rb = Epi::PERM ? ((R & ~31) + perm32(R & 31)) : R;
        voffA[i] = (unsigned)(R * K + C) * 2u; voffB[i] = (unsigned)(Rb * K + C) * 2u; }
    const size_t kstep = (size_t)(BK * 2);
    const size_t hstep = (size_t)HALF * K * 2;
    const size_t tstep = 2 * hstep;
    const unsigned ldsw = (unsigned)wid * 1024u;
    const int aoff = FP8 ? lds_byte(wr * 64 + fr, fq * 16) : lds_byte(wr * 64 + fr, fq * 8), boff = FP8 ? lds_byte(wc * 32 + fr, fq * 16) : lds_byte(wc * 32 + fr, fq * 8);
#define PG8_SA(b, h) (((b) * 2 + (h)) * HTB)
#define PG8_SB(b, h) ((4 + (b) * 2 + (h)) * HTB)
#define PG8_STAGE(bufoff, gbase, voff) do { _Pragma("unroll") for (int _i = 0; _i < 2; ++_i) \
        __builtin_amdgcn_global_load_lds((const unsigned*)((const char*)(gbase) + (voff)[_i]), (PG8_LAS unsigned*)(lds + (bufoff) + ldsw + _i * 8192), 16, 0, 0); } while (0)
#define PG8_CAT(lo_, hi_) __builtin_bit_cast(v8i, __builtin_shufflevector((lo_), (hi_), 0, 1, 2, 3, 4, 5, 6, 7, 8, 9, 10, 11, 12, 13, 14, 15))
#define PG8_LDA(dst, b, h) do { _Pragma("unroll") for (int m = 0; m < 4; ++m) { \
        if constexpr (FP8) dst##8[m] = PG8_CAT(*(const PG8_LAS bf16x8*)(lds + PG8_SA(b, h) + aoff + m * 2048), *(const PG8_LAS bf16x8*)(lds + PG8_SA(b, h) + aoff + m * 2048 + 16)); \
        else { _Pragma("unroll") for (int k = 0; k < 2; ++k) dst[m][k] = *(const PG8_LAS bf16x8*)(lds + PG8_SA(b, h) + aoff + m * 2048 + k * 1024); } } } while (0)
#define PG8_LDB(dst, b, h) do { _Pragma("unroll") for (int n = 0; n < 2; ++n) { \
        if constexpr (FP8) dst##8[n] = PG8_CAT(*(const PG8_LAS bf16x8*)(lds + PG8_SB(b, h) + boff + n * 2048), *(const PG8_LAS bf16x8*)(lds + PG8_SB(b, h) + boff + n * 2048 + 16)); \
        else { _Pragma("unroll") for (int k = 0; k < 2; ++k) dst[n][k] = *(const PG8_LAS bf16x8*)(lds + PG8_SB(b, h) + boff + n * 2048 + k * 1024); } } } while (0)
#define PG8_MMA(ai, bj, At, Bt) do { __builtin_amdgcn_s_setprio(1); _Pragma("unroll") for (int m = 0; m < 4; ++m) _Pragma("unroll") for (int n = 0; n < 2; ++n) { \
        if constexpr (FP8) asm volatile("v_mfma_scale_f32_16x16x128_f8f6f4 %0, %1, %2, %0, %3, %3 op_sel_hi:[0,0,0]" : "+v"(acc[ai][bj][m][n]) : "v"(Bt##8[n]), "v"(At##8[m]), "v"(one_scale)); \
        else { _Pragma("unroll") for (int k = 0; k < 2; ++k) acc[ai][bj][m][n] = __builtin_amdgcn_mfma_f32_16x16x32_bf16(Bt[n][k], At[m][k], acc[ai][bj][m][n], 0, 0, 0); } } \
        __builtin_amdgcn_s_setprio(0); } while (0)
#define PG8_WAIT_V(n) asm volatile("s_waitcnt vmcnt(" #n ")" ::: "memory")
#define PG8_WAIT_L(n) asm volatile("s_waitcnt lgkmcnt(" #n ")" ::: "memory")
#define PG8_BAR __builtin_amdgcn_s_barrier()
#define PG8_SCHED __builtin_amdgcn_sched_barrier(0)
#define PG8_SETOFF(off, pbuf_) do { _Pragma("unroll") for (int _h = 0; _h < 2; ++_h) _Pragma("unroll") for (int _i = 0; _i < 2; ++_i) { \
        if (GATHER) { int R_, C_; stage_rc(tid * 16 + _i * 8192, R_, C_); \
            off[_h][_i] = (unsigned)(par_i32(lds + PAR_BASE + (pbuf_) * PAR_BUF + PAR_IDX + (_h * HALF + R_) * 4) >> 2) * (unsigned)(K * 2) + (unsigned)(C_ * 2); } \
        else off[_h][_i] = voffA[_i] + (unsigned)(_h * hstep); } } while (0)
#define PG8_IDXDMA(u, pbuf_) do { if (GATHER && wid < 4) { int rk_ = (u).pm * BM + wid * 64 + lane - g.sb[(u).e]; const int cm_ = g.sb[40 + (u).e] - 1; rk_ = rk_ < cm_ ? rk_ : cm_; \
        __builtin_amdgcn_global_load_lds((const unsigned*)(g.eslot + (size_t)(u).e * ECAP + rk_), (PG8_LAS unsigned*)(lds + PAR_BASE + (pbuf_) * PAR_BUF + PAR_IDX + wid * 256), 4, 0, 0); } } while (0)
    Unit cur, nxt; int ui = 0;
    if (!S.next(0, cur)) return;
    PG8_IDXDMA(cur, 0); E.prefetch(cur, 0, lds, wid, lane);
    PG8_WAIT_V(0); PG8_BAR;
    f32x4 acc[2][2][4][2];
#pragma unroll
    for (int a = 0; a < 2; ++a)
#pragma unroll
        for (int b = 0; b < 2; ++b)
#pragma unroll
            for (int m = 0; m < 4; ++m)
#pragma unroll
                for (int n = 0; n < 2; ++n) acc[a][b][m][n] = (f32x4){0.f, 0.f, 0.f, 0.f};
    bf16x8 At[4][2], B0[2][2], B1[2][2];
    v8i At8[4], B08[2], B18[2];
    const int one_scale = 0x7f7f7f7f;
    unsigned offc[2][2], offn[2][2];
    PG8_SETOFF(offc, 0);
    const char* cA = GATHER ? (const char*)g.A : (const char*)g.A + (size_t)cur.pm * tstep;
    const char* cB = (const char*)g.Bt + (size_t)cur.e * g.bstride + (size_t)cur.pn * tstep;
    PG8_STAGE(PG8_SB(0, 0), cB, voffB); PG8_STAGE(PG8_SB(0, 1), cB + hstep, voffB); PG8_STAGE(PG8_SA(0, 0), cA, offc[0]); PG8_STAGE(PG8_SA(0, 1), cA, offc[1]);
    if (wr == 1) PG8_BAR;
    PG8_WAIT_V(2); PG8_BAR;
    PG8_STAGE(PG8_SB(1, 0), cB + kstep, voffB); PG8_STAGE(PG8_SA(1, 0), cA + kstep, offc[0]); PG8_STAGE(PG8_SB(1, 1), cB + hstep + kstep, voffB);
    PG8_WAIT_V(6); PG8_BAR;
    for (;;) {
        const bool has_next = S.next(ui + 1, nxt);
        const char* nA = GATHER ? cA : (has_next ? (const char*)g.A + (size_t)nxt.pm * tstep : cA);
        const char* nB = has_next ? (const char*)g.Bt + (size_t)nxt.e * g.bstride + (size_t)nxt.pn * tstep : cB;

        if constexpr (Epi::MIDSCALE) E.begin(cur, ui, lds, tid);
#pragma unroll 1
        for (int t = 0; t < nt; t += 2) {
            const bool last = (t == nt - 2);
            if constexpr (Epi::MIDSCALE) { if (t == nt / 2) E.mid(acc, ui, wr, fr, lds); }
            if (t == 2 && has_next) { PG8_IDXDMA(nxt, (ui + 1) & 1); E.prefetch(nxt, (ui + 1) & 1, lds, wid, lane); }
            if (GATHER && last) { if (has_next) { PG8_SETOFF(offn, (ui + 1) & 1); } else {
#pragma unroll
                for (int h = 0; h < 2; ++h)
#pragma unroll
                    for (int i = 0; i < 2; ++i) offn[h][i] = offc[h][i]; } }
            const char* a1 = cA + (size_t)(t + 1) * kstep;
            const char* a2 = last ? nA : cA + (size_t)(t + 2) * kstep; const char* b2 = last ? nB : cB + (size_t)(t + 2) * kstep;
            const char* a3 = a2 + kstep; const char* b3 = b2 + kstep;
            unsigned o2[2][2];
#pragma unroll
            for (int h = 0; h < 2; ++h)
#pragma unroll
                for (int i = 0; i < 2; ++i) o2[h][i] = (GATHER && last) ? offn[h][i] : offc[h][i];
            PG8_LDB(B0, 0, 0); PG8_LDB(B1, 0, 1); PG8_SCHED; PG8_LDA(At, 0, 0); PG8_STAGE(PG8_SA(1, 1), a1, offc[1]);
            PG8_WAIT_V(8); PG8_WAIT_L(0); PG8_BAR; PG8_MMA(0, 0, At, B0); PG8_MMA(0, 1, At, B1); PG8_BAR; PG8_SCHED;
            PG8_LDA(At, 0, 1); PG8_STAGE(PG8_SB(0, 0), b2, voffB); PG8_STAGE(PG8_SB(0, 1), b2 + hstep, voffB); PG8_STAGE(PG8_SA(0, 0), a2, o2[0]);
            PG8_WAIT_V(8); PG8_WAIT_L(0); PG8_BAR; PG8_MMA(1, 0, At, B0); PG8_MMA(1, 1, At, B1); PG8_BAR; PG8_SCHED;
            PG8_LDB(B0, 1, 0); PG8_LDB(B1, 1, 1); PG8_SCHED; PG8_LDA(At, 1, 0); PG8_STAGE(PG8_SA(0, 1), a2, o2[1]);
            PG8_WAIT_V(8); PG8_WAIT_L(0); PG8_BAR; PG8_MMA(0, 0, At, B0); PG8_MMA(0, 1, At, B1); PG8_BAR; PG8_SCHED;
            PG8_LDA(At, 1, 1); PG8_STAGE(PG8_SB(1, 0), b3, voffB); PG8_STAGE(PG8_SB(1, 1), b3 + hstep, voffB); PG8_STAGE(PG8_SA(1, 0), a3, o2[0]);
            PG8_WAIT_V(8); PG8_WAIT_L(0); PG8_BAR; PG8_MMA(1, 0, At, B0); PG8_MMA(1, 1, At, B1); PG8_BAR; PG8_SCHED;
        }
        if constexpr (ALIGN_EPI) { if (wr == 0) PG8_BAR; }
        if constexpr (FP8) asm volatile("s_nop 15\n\ts_nop 15" ::: "memory");
        E(acc, cur, ui, wr, wc, fr, fq, lds);
        if (!has_next) break;
#pragma unroll
        for (int a = 0; a < 2; ++a)
#pragma unroll
            for (int b = 0; b < 2; ++b)
#pragma unroll
                for (int m = 0; m < 4; ++m)
#pragma unroll
                    for (int n = 0; n < 2; ++n) acc[a][b][m][n] = (f32x4){0.f, 0.f, 0.f, 0.f};
        cur = nxt; cA = nA; cB = nB; ++ui;
#pragma unroll
        for (int h = 0; h < 2; ++h)
#pragma unroll
            for (int i = 0; i < 2; ++i) offc[h][i] = offn[h][i];
        if constexpr (ALIGN_EPI) { if (wr == 1) PG8_BAR; }
    }
    PG8_WAIT_V(0);
    if constexpr (!ALIGN_EPI) { if (wr == 0) PG8_BAR; }
    PG8_BAR;
#undef PG8_SA
#undef PG8_SB
#undef PG8_STAGE
#undef PG8_LDA
#undef PG8_LDB
#undef PG8_MMA
#undef PG8_WAIT_V
#undef PG8_WAIT_L
#undef PG8_BAR
#undef PG8_SCHED
#undef PG8_SETOFF
#undef PG8_IDXDMA
#undef PG8_CAT
}

struct EpiQKV {
    static constexpr bool MIDSCALE = false, PERM = false;
    bf16_t* O;
    __device__ __forceinline__ void prefetch(const Unit&, int, PG8_LAS unsigned char*, int, int) const {}
    __device__ __forceinline__ void operator()(const f32x4 (&acc)[2][2][4][2], const Unit& u, int ui, int wr, int wc, int fr, int fq, PG8_LAS unsigned char* lds) const {
        const bool latent = u.pm < NTOK / BM;
#pragma unroll
        for (int ai = 0; ai < 2; ++ai)
#pragma unroll
            for (int m = 0; m < 4; ++m) {
                const int row = u.pm * BM + ai * HALF + wr * 64 + m * 16 + fr;
                bf16_t* rowp = O + (size_t)row * INW + u.pn * BM + wc * 32 + 4 * fq;
                const int pos = row & (L - 1), pp = (wc & 1) ? (pos & 63) : (pos >> 6);
                PG8_LAS unsigned char* tp = lds + PAR_TAB + (pp * 16 + 4 * fq) * 8;
#pragma unroll
                for (int bj = 0; bj < 2; ++bj) {
                    const int colbase = u.pn * BM + bj * HALF;
                    f32x4 v0 = acc[ai][bj][m][0], v1 = acc[ai][bj][m][1];
                    if (latent && colbase < C_VA) {
                        const f32x4 t0 = par_f32x4(tp), t1 = par_f32x4(tp + 16);
                        const f32x4 cs = {t0.x, t0.z, t1.x, t1.z}, sn = {t0.y, t0.w, t1.y, t1.w};
                        const f32x4 a0 = v0 * cs - v1 * sn, a1 = v1 * cs + v0 * sn; v0 = a0; v1 = a1;
                    }
                    if (colbase < C_KA || (colbase >= C_QB && colbase < C_KB)) { v0 = v0 * QSCALE; v1 = v1 * QSCALE; }
                    u32x2 w0, w1; w0.x = pk2(v0.x, v0.y); w0.y = pk2(v0.z, v0.w); w1.x = pk2(v1.x, v1.y); w1.y = pk2(v1.z, v1.w);
                    *(u32x2*)(rowp + bj * HALF) = w0; *(u32x2*)(rowp + bj * HALF + 16) = w1;
                }
            }
    }
};
struct EpiOutProj {
    static constexpr bool PERM = true, MIDSCALE = true;
    bf16_t* O; const float* oss;
    __device__ __forceinline__ void prefetch(const Unit&, int, PG8_LAS unsigned char*, int, int) const {}
    __device__ __forceinline__ void begin(const Unit& u, int ui, PG8_LAS unsigned char* lds, int tid) const {
        if (tid < 256) { const f32x4* sp = (const f32x4*)(oss + (size_t)(u.pm * BM + tid) * 16); const f32x4 a0 = sp[0], a1 = sp[1], b0 = sp[2], b1 = sp[3];
            const float sa = ((a0.x + a0.y) + (a0.z + a0.w)) + ((a1.x + a1.y) + (a1.z + a1.w)), sb = ((b0.x + b0.y) + (b0.z + b0.w)) + ((b1.x + b1.y) + (b1.z + b1.w));
            const float ra = rsqrtf(sa * (1.f / 512.f) + EPS), rb = rsqrtf(sb * (1.f / 512.f) + EPS);
            typedef float f2 __attribute__((ext_vector_type(2)));
            *(PG8_LAS f2*)(lds + 131072 + (ui & 1) * 2048 + tid * 8) = (f2){ra / rb, rb}; }
    }
    __device__ __forceinline__ void mid(f32x4 (&acc)[2][2][4][2], int ui, int wr, int fr, PG8_LAS unsigned char* lds) const {
#pragma unroll
        for (int ai = 0; ai < 2; ++ai)
#pragma unroll
            for (int m = 0; m < 4; ++m) { const float r = *(const PG8_LAS float*)(lds + 131072 + (ui & 1) * 2048 + (ai * HALF + wr * 64 + m * 16 + fr) * 8);
#pragma unroll
                for (int bj = 0; bj < 2; ++bj)
#pragma unroll
                    for (int n = 0; n < 2; ++n) acc[ai][bj][m][n] = acc[ai][bj][m][n] * r; }
    }
    __device__ __forceinline__ void operator()(const f32x4 (&acc)[2][2][4][2], const Unit& u, int ui, int wr, int wc, int fr, int fq, PG8_LAS unsigned char* lds) const {
#pragma unroll
        for (int ai = 0; ai < 2; ++ai)
#pragma unroll
            for (int m = 0; m < 4; ++m) {
                const int rl = ai * HALF + wr * 64 + m * 16 + fr;
                const float rb = *(const PG8_LAS float*)(lds + 131072 + (ui & 1) * 2048 + rl * 8 + 4);
                bf16_t* rowp = O + (size_t)(u.pm * BM + rl) * D + u.pn * BM + wc * 32 + 8 * fq;
#pragma unroll
                for (int bj = 0; bj < 2; ++bj) { const f32x4 v0 = acc[ai][bj][m][0] * rb, v1 = acc[ai][bj][m][1] * rb;
                    u32x4 o; o.x = pk2(v0.x, v0.y); o.y = pk2(v0.z, v0.w); o.z = pk2(v1.x, v1.y); o.w = pk2(v1.z, v1.w);
                    *(u32x4*)(rowp + bj * HALF) = o; }
            }
    }
};
struct EpiSwiglu {
    static constexpr bool MIDSCALE = false, PERM = false;
    unsigned char* act; const float* b1;
    __device__ __forceinline__ void prefetch(const Unit& u, int pb, PG8_LAS unsigned char* lds, int wid, int lane) const {
        if (wid == 4) __builtin_amdgcn_global_load_lds((const unsigned*)(b1 + (size_t)u.e * 2048 + u.pn * BM + lane * 4), (PG8_LAS unsigned*)(lds + PAR_BASE + pb * PAR_BUF + PAR_BIAS), 16, 0, 0);
    }
    __device__ __forceinline__ void operator()(const f32x4 (&acc)[2][2][4][2], const Unit& u, int ui, int wr, int wc, int fr, int fq, PG8_LAS unsigned char* lds) const {
#pragma unroll
        for (int bj = 0; bj < 2; ++bj) {
            const int f0 = 16 * (8 * u.pn + 4 * bj + wc) + 4 * fq;
            PG8_LAS unsigned char* bp = lds + PAR_BASE + (ui & 1) * PAR_BUF + PAR_BIAS + (128 * bj + 32 * wc + 8 * fq) * 4; const f32x4 bA = par_f32x4(bp), bB = par_f32x4(bp + 16);
            const f32x4 bg = {bA.x, bA.z, bB.x, bB.z}, bl = {bA.y, bA.w, bB.y, bB.w};
#pragma unroll
            for (int ai = 0; ai < 2; ++ai)
#pragma unroll
                for (int m = 0; m < 4; ++m) {
                    const int row = u.pm * BM + ai * HALF + wr * 64 + m * 16 + fr;
                    const f32x4 gt = acc[ai][bj][m][0] * W8_INV + bg, ln = acc[ai][bj][m][1] * W8_INV + bl; float a[4];
#pragma unroll
                    for (int j = 0; j < 4; ++j) { const float gg = fminf(gt[j], 7.f), ll = fminf(fmaxf(ln[j], -7.f), 7.f);
                        a[j] = gg * __builtin_amdgcn_rcpf(1.f + __expf(-1.702f * gg)) * (ll + 1.f); }
                    *(unsigned*)(act + (size_t)row * D + f0) = pk4_fp8(a[0], a[1], a[2], a[3]);
                }
        }
    }
};
struct EpiScatter {
    static constexpr bool MIDSCALE = false, PERM = true;
    unsigned char* y; const float* b2; const int* eslot; const float* ew; const PG8_LAS int* sb;
    __device__ __forceinline__ void prefetch(const Unit& u, int pb, PG8_LAS unsigned char* lds, int wid, int lane) const {
        const int w4 = wid & 3; int rk = u.pm * BM + w4 * 64 + lane - sb[u.e]; const int cm = sb[40 + u.e] - 1; rk = rk < cm ? rk : cm;
        const size_t gi = (size_t)u.e * ECAP + rk;
        if (wid < 4) __builtin_amdgcn_global_load_lds((const unsigned*)(eslot + gi), (PG8_LAS unsigned*)(lds + PAR_BASE + pb * PAR_BUF + PAR_IDX + w4 * 256), 4, 0, 0);
        else         __builtin_amdgcn_global_load_lds((const unsigned*)(ew + gi), (PG8_LAS unsigned*)(lds + PAR_BASE + pb * PAR_BUF + PAR_W + w4 * 256), 4, 0, 0);
        if (wid == 0) __builtin_amdgcn_global_load_lds((const unsigned*)(b2 + (size_t)u.e * D + u.pn * BM + lane * 4), (PG8_LAS unsigned*)(lds + PAR_BASE + pb * PAR_BUF + PAR_BIAS), 16, 0, 0);
    }
    __device__ __forceinline__ void operator()(const f32x4 (&acc)[2][2][4][2], const Unit& u, int ui, int wr, int wc, int fr, int fq, PG8_LAS unsigned char* lds) const {
        PG8_LAS unsigned char* par = lds + PAR_BASE + (ui & 1) * PAR_BUF;
        const int col0 = u.pn * BM + wc * 32 + 8 * fq;
        f32x4 bv[2][2];
#pragma unroll
        for (int bj = 0; bj < 2; ++bj)
#pragma unroll
            for (int n = 0; n < 2; ++n) bv[bj][n] = par_f32x4(par + PAR_BIAS + (wc * 32 + 8 * fq + bj * HALF + 4 * n) * 4);
        const int rbase = u.pm * BM - sb[u.e], cn = sb[40 + u.e];
#pragma unroll
        for (int ai = 0; ai < 2; ++ai)
#pragma unroll
            for (int m = 0; m < 4; ++m) {
                const int rl = ai * HALF + wr * 64 + m * 16 + fr;
                const int slot = par_i32(par + PAR_IDX + rl * 4); const float w = par_f32(par + PAR_W + rl * 4) * Y8_SCALE;
                if (rbase + rl < cn) {
                    unsigned char* rowp = y + (size_t)slot * D + col0;
#pragma unroll
                    for (int bj = 0; bj < 2; ++bj) { const f32x4 v0 = (acc[ai][bj][m][0] * W8_INV + bv[bj][0]) * w, v1 = (acc[ai][bj][m][1] * W8_INV + bv[bj][1]) * w;
                        u32x2 o; o.x = pk4_fp8(v0.x, v0.y, v0.z, v0.w); o.y = pk4_fp8(v1.x, v1.y, v1.z, v1.w);
                        *(u32x2*)(rowp + bj * HALF) = o; }
                }
            }
    }
};
}

__device__ void p0_mod(const Params& p, float* sS  , float* sP  ) {
    float* mod = (float*)(p.ws + WS_MOD);
    const int tid = tid_opaque(), lane = tid & 63, wave = tid >> 6;
    if (blockIdx.x >= 96) return;
    for (int i = tid; i < 9 * D; i += NTHREADS) { const int r = i >> 10, k = i & 1023; const float cc = r < 8 ? p.c[r * D + k] : p.c_ctx[k]; sS[i] = cc / (1.f + __expf(-cc)); }
    __syncthreads();
    const int j = blockIdx.x * 64 + lane;
    float acc[9];
#pragma unroll
    for (int r = 0; r < 9; ++r) acc[r] = 0.f;
    const float* wp = p.w_ada + (size_t)(wave * 128) * 6144 + j;
#pragma unroll 1
    for (int k0 = 0; k0 < 128; k0 += 16) {
        float w[16];
#pragma unroll
        for (int kk = 0; kk < 16; ++kk) w[kk] = wp[(size_t)(k0 + kk) * 6144];
#pragma unroll
        for (int kk = 0; kk < 16; ++kk)
#pragma unroll
            for (int r = 0; r < 9; ++r) acc[r] = fmaf(sS[r * D + wave * 128 + k0 + kk], w[kk], acc[r]);
    }
#pragma unroll
    for (int r = 0; r < 9; ++r) sP[(wave * 9 + r) * 64 + lane] = acc[r];
    __syncthreads();
    for (int i = tid; i < 9 * 64; i += NTHREADS) { const int r = i >> 6, jj = i & 63; float s = p.b_ada[blockIdx.x * 64 + jj];
#pragma unroll
        for (int w = 0; w < 8; ++w) s += sP[(w * 9 + r) * 64 + jj];
        mod[r * 6144 + blockIdx.x * 64 + jj] = s; }
    __syncthreads();
}
__device__ void p0_tab(const Params& p) {
    float* tab = (float*)(p.ws + WS_TAB);
    const int gtid = blockIdx.x * NTHREADS + tid_opaque(), gsize = gridDim.x * NTHREADS;
    for (int idx = gtid; idx < 64 * 16; idx += gsize) {
        const int pos = idx >> 4, i = idx & 15;
        const float freq = exp2f(-(float)i * (13.287712379549449f / 16.f));
        const float ang = (float)pos * freq;
        const float n = rintf(ang * 0.15915494309189535f);
        float r = fmaf(-n, 6.28125f, ang); r = fmaf(-n, 1.9353071795864769e-3f, r);
        tab[idx * 2] = __cosf(r); tab[idx * 2 + 1] = __sinf(r);
    }
}
template <int MODE>
__device__ __forceinline__ void conv_item(const float* src, int K, int N, bf16_t* dst, int item, float* scr, int lane, const float* gA, const float* gB) {
    const int nblk = N / 32, kb = item / nblk, nb = item % nblk, k0 = 64 * kb, n0 = 32 * nb;
    const int c = lane & 31, kh = lane >> 5;
    const int nl = MODE == 1 ? 16 * (c & 1) + (c >> 1) : c;
    float v[32];
    const float* sp = src + (size_t)(k0 + kh) * N + n0 + c;
#pragma unroll
    for (int i = 0; i < 32; ++i) v[i] = sp[(size_t)(2 * i) * N];
#pragma unroll
    for (int i = 0; i < 32; ++i) { float x = v[i]; if (MODE == 2) { const int k = k0 + 2 * i + kh; x *= (k < 512 ? gA[k] : gB[k - 512]); } scr[(2 * i + kh) * 33 + nl] = x; }
    asm volatile("s_waitcnt lgkmcnt(0)" ::: "memory");
    const int ch = lane & 7;
#pragma unroll
    for (int j = 0; j < 4; ++j) { const int n = (lane >> 3) + 8 * j; const float* s = scr + (8 * ch) * 33 + n;
        u32x4 o; o.x = pk2(s[0 * 33], s[1 * 33]); o.y = pk2(s[2 * 33], s[3 * 33]); o.z = pk2(s[4 * 33], s[5 * 33]); o.w = pk2(s[6 * 33], s[7 * 33]);
        *(u32x4*)(dst + (size_t)(n0 + n) * K + k0 + 8 * ch) = o; }
    asm volatile("s_waitcnt lgkmcnt(0)" ::: "memory");
}
template <bool PERM1>
__device__ __forceinline__ void conv_item8(const float* src, int K, int N, unsigned char* dst, int item, float* scr, int lane) {
    const int nblk = N / 32, kb = item / nblk, nb = item % nblk, k0 = 64 * kb, n0 = 32 * nb;
    const int c = lane & 31, kh = lane >> 5;
    const int nl = PERM1 ? 16 * (c & 1) + (c >> 1) : c;
    float v[32];
    const float* sp = src + (size_t)(k0 + kh) * N + n0 + c;
#pragma unroll
    for (int i = 0; i < 32; ++i) v[i] = sp[(size_t)(2 * i) * N];
#pragma unroll
    for (int i = 0; i < 32; ++i) scr[(2 * i + kh) * 33 + nl] = v[i] * W8_SCALE;
    asm volatile("s_waitcnt lgkmcnt(0)" ::: "memory");
    const int ch = lane & 3;
#pragma unroll
    for (int j = 0; j < 2; ++j) { const int n = (lane >> 2) + 16 * j; const float* s = scr + (16 * ch) * 33 + n;
        u32x4 o; o.x = pk4_fp8(s[0 * 33], s[1 * 33], s[2 * 33], s[3 * 33]); o.y = pk4_fp8(s[4 * 33], s[5 * 33], s[6 * 33], s[7 * 33]);
        o.z = pk4_fp8(s[8 * 33], s[9 * 33], s[10 * 33], s[11 * 33]); o.w = pk4_fp8(s[12 * 33], s[13 * 33], s[14 * 33], s[15 * 33]);
        *(u32x4*)(dst + (size_t)(n0 + n) * K + k0 + 16 * ch) = o; }
    asm volatile("s_waitcnt lgkmcnt(0)" ::: "memory");
}
__device__ void p0_weights(const Params& p, unsigned char* ldsb) {
    const int tid = tid_opaque(), lane = tid & 63, wave = tid >> 6; float* scr = (float*)(ldsb + 57344 + wave * 8448);
    const int gw = blockIdx.x * (NTHREADS / 64) + wave, ngw = gridDim.x * (NTHREADS / 64);
    constexpr int I_IN = 16 * 72, I_OUT = 16 * 32, I_W1 = 16 * 64, I_W2 = 16 * 32;
    constexpr int NITEMS = I_IN + I_OUT + NE * I_W1 + NE * I_W2;
    for (int it = gw; it < NITEMS; it += ngw) {
        int r = it;
        if (r < I_IN) { conv_item<0>(p.w_in, D, INW, (bf16_t*)(p.ws + WS_WIN), r, scr, lane, nullptr, nullptr); continue; } r -= I_IN;
        if (r < I_OUT) { conv_item<2>(p.w_out, D, D, (bf16_t*)(p.ws + WS_WOUT), r, scr, lane, p.g_grp_a, p.g_grp_b); continue; } r -= I_OUT;
        if (r < NE * I_W1) { const int e = r / I_W1, q = r % I_W1;
            conv_item8<true>(p.w_mlp1 + (size_t)e * D * 2048, D, 2048, p.ws + WS_W1 + (size_t)e * 2048 * D, q, scr, lane); continue; } r -= NE * I_W1;
        { const int e = r / I_W2, q = r % I_W2;
            conv_item8<false>(p.w_mlp2 + (size_t)e * D * D, D, D, p.ws + WS_W2 + (size_t)e * D * D, q, scr, lane); }
    }
}

__device__ void p1_h(const Params& p) {
    const int tid = tid_opaque(), lane = tid & 63;
    const float* mod = (const float*)(p.ws + WS_MOD);
    bf16_t* hb = (bf16_t*)(p.ws + WS_HB);
    constexpr int R = 17;
    const int gwv = blockIdx.x * (NTHREADS / 64) + (tid >> 6);
    const int m0 = gwv * R; if (m0 >= MROWS) return;
    const int m1 = m0 + R < MROWS ? m0 + R : MROWS;
    f32x4 pB[4], pC[4], v[4], nv[4]; int curb = -1;
#define P1_ROWPTR(m) ((m) < NTOK ? p.x + (size_t)(m) * D : p.ctx + (size_t)((m) - NTOK) * D)
    { const float* xr = P1_ROWPTR(m0);
#pragma unroll
      for (int j = 0; j < 4; ++j) nv[j] = ((const f32x4*)xr)[lane + 64 * j]; }
    for (int m = m0; m < m1; ++m) {
#pragma unroll
        for (int j = 0; j < 4; ++j) v[j] = nv[j];
        if (m + 1 < m1) { const float* xr = P1_ROWPTR(m + 1);
#pragma unroll
            for (int j = 0; j < 4; ++j) nv[j] = ((const f32x4*)xr)[lane + 64 * j]; }
        const int b = m < NTOK ? m / L : 8;
        if (b != curb) { curb = b; const float* sh = mod + b * 6144, * sc = sh + 1024;
#pragma unroll
            for (int j = 0; j < 4; ++j) { const int c0 = 4 * (lane + 64 * j); pB[j] = *(const f32x4*)(p.g_pre_mix + c0) * (*(const f32x4*)(sc + c0) + 1.f); pC[j] = *(const f32x4*)(sh + c0); } }
        float s = 0.f;
#pragma unroll
        for (int j = 0; j < 4; ++j) s += v[j].x * v[j].x + v[j].y * v[j].y + v[j].z * v[j].z + v[j].w * v[j].w;
        const float rstd = rsqrtf(wave_sum(s) * (1.f / D) + EPS);
#pragma unroll
        for (int j = 0; j < 4; ++j) { const int c0 = 4 * (lane + 64 * j);
            const f32x4 o = (v[j] * rstd) * pB[j] + pC[j];
            u32x2 w; w.x = pk2(o.x, o.y); w.y = pk2(o.z, o.w);
            *(u32x2*)(hb + (size_t)m * D + c0) = w; }
    }
#undef P1_ROWPTR
}

template <class AL, class BL, class EP>
__device__ __forceinline__ void ngemm_tile(float* sA, float* sB, int m0, int n0, int K, const AL& aload, const BL& bload, const EP& epi) {
    const int tid = threadIdx.x, ty = tid >> 4, tx = tid & 15;
    float acc[4][4];
#pragma unroll
    for (int i = 0; i < 4; ++i)
#pragma unroll
        for (int j = 0; j < 4; ++j) acc[i][j] = 0.f;
    for (int k0 = 0; k0 < K; k0 += 16) {
#pragma unroll
        for (int i = 0; i < 4; ++i) { const int e = tid + NTHREADS * i, r = e >> 4, kk = e & 15; sA[kk * 132 + r] = aload(m0 + r, k0 + kk); }
#pragma unroll
        for (int i = 0; i < 2; ++i) { const int e = tid + NTHREADS * i, n = e >> 4, kk = e & 15; sB[kk * 68 + n] = bload(n0 + n, k0 + kk); }
        __syncthreads();
#pragma unroll
        for (int kk = 0; kk < 16; ++kk) {
            float a[4], b[4];
#pragma unroll
            for (int i = 0; i < 4; ++i) a[i] = sA[kk * 132 + ty * 4 + i];
#pragma unroll
            for (int j = 0; j < 4; ++j) b[j] = sB[kk * 68 + tx + 16 * j];
#pragma unroll
            for (int i = 0; i < 4; ++i)
#pragma unroll
                for (int j = 0; j < 4; ++j) acc[i][j] = fmaf(a[i], b[j], acc[i][j]);
        }
        __syncthreads();
    }
    epi(m0 + ty * 4, n0, tx, acc);
}

__device__ void p2_qkv_naive(const Params& p, float* sA, float* sB) {
    const bf16_t* hb = (const bf16_t*)(p.ws + WS_HB); const bf16_t* wT = (const bf16_t*)(p.ws + WS_WIN);
    bf16_t* qkv = (bf16_t*)(p.ws + WS_QKV); const float* tab = (const float*)(p.ws + WS_TAB);
    constexpr int NTN = INW / 64, NT = (MROWS / 128) * NTN;
    for (int t = blockIdx.x; t < NT; t += gridDim.x) {
        const int m0 = (t / NTN) * 128, n0 = (t % NTN) * 64;
        auto al = [&](int r, int k) { return bf2f(hb[(size_t)r * D + k]); };
        auto bl = [&](int n, int k) { return bf2f(wT[(size_t)n * D + k]); };
        auto ep = [&](int r0, int nn0, int tx, float (&acc)[4][4]) {
#pragma unroll
            for (int i = 0; i < 4; ++i) {
                const int r = r0 + i; float v0 = acc[i][0], v1 = acc[i][1], v2 = acc[i][2], v3 = acc[i][3];
                const bool rope = (nn0 < C_VA) && (r < NTOK);
                if (rope) { const int t = r & (L - 1), pr = t >> 6, pc = t & 63;
                    const float c0 = tab[(pr * 16 + tx) * 2], s0 = tab[(pr * 16 + tx) * 2 + 1], c1 = tab[(pc * 16 + tx) * 2], s1 = tab[(pc * 16 + tx) * 2 + 1];
                    const float a0 = v0 * c0 - v1 * s0, a1 = v1 * c0 + v0 * s0, a2 = v2 * c1 - v3 * s1, a3 = v3 * c1 + v2 * s1; v0 = a0; v1 = a1; v2 = a2; v3 = a3; }
                const bool isq = (nn0 < C_KA) || (nn0 >= C_QB && nn0 < C_KB);
                if (isq) { v0 *= QSCALE; v1 *= QSCALE; v2 *= QSCALE; v3 *= QSCALE; }
                bf16_t* o = qkv + (size_t)r * INW + nn0 + tx;
                o[0] = (bf16_t)f2bf(v0); o[16] = (bf16_t)f2bf(v1); o[32] = (bf16_t)f2bf(v2); o[48] = (bf16_t)f2bf(v3);
            }
        };
        ngemm_tile(sA, sB, m0, n0, D, al, bl, ep);
    }
}

__device__ __forceinline__ void load_row64(const bf16_t* src, float* dst) {
#pragma unroll
    for (int c = 0; c < 8; ++c) { const u32x4 w = *(const u32x4*)(src + c * 8);
        dst[c * 8 + 0] = __uint_as_float(w.x << 16); dst[c * 8 + 1] = __uint_as_float(w.x & 0xffff0000u);
        dst[c * 8 + 2] = __uint_as_float(w.y << 16); dst[c * 8 + 3] = __uint_as_float(w.y & 0xffff0000u);
        dst[c * 8 + 4] = __uint_as_float(w.z << 16); dst[c * 8 + 5] = __uint_as_float(w.z & 0xffff0000u);
        dst[c * 8 + 6] = __uint_as_float(w.w << 16); dst[c * 8 + 7] = __uint_as_float(w.w & 0xffff0000u); }
}
struct OnlineSm { float m, l; };
__device__ __forceinline__ void attn_key(const float (&q)[64], float (&o)[64], OnlineSm& st, const bf16_t* krow, const bf16_t* vrow, float bias) {
    float s = bias;
#pragma unroll
    for (int c = 0; c < 8; ++c) { const u32x4 w = *(const u32x4*)(krow + c * 8);
        s = fmaf(q[c * 8 + 0], __uint_as_float(w.x << 16), s); s = fmaf(q[c * 8 + 1], __uint_as_float(w.x & 0xffff0000u), s);
        s = fmaf(q[c * 8 + 2], __uint_as_float(w.y << 16), s); s = fmaf(q[c * 8 + 3], __uint_as_float(w.y & 0xffff0000u), s);
        s = fmaf(q[c * 8 + 4], __uint_as_float(w.z << 16), s); s = fmaf(q[c * 8 + 5], __uint_as_float(w.z & 0xffff0000u), s);
        s = fmaf(q[c * 8 + 6], __uint_as_float(w.w << 16), s); s = fmaf(q[c * 8 + 7], __uint_as_float(w.w & 0xffff0000u), s); }
    const float mn = fmaxf(st.m, s), sc = exp2f(st.m - mn), pp = exp2f(s - mn);
    st.l = st.l * sc + pp; st.m = mn;
#pragma unroll
    for (int c = 0; c < 8; ++c) { const u32x4 w = *(const u32x4*)(vrow + c * 8);
        o[c * 8 + 0] = fmaf(pp, __uint_as_float(w.x << 16), o[c * 8 + 0] * sc); o[c * 8 + 1] = fmaf(pp, __uint_as_float(w.x & 0xffff0000u), o[c * 8 + 1] * sc);
        o[c * 8 + 2] = fmaf(pp, __uint_as_float(w.y << 16), o[c * 8 + 2] * sc); o[c * 8 + 3] = fmaf(pp, __uint_as_float(w.y & 0xffff0000u), o[c * 8 + 3] * sc);
        o[c * 8 + 4] = fmaf(pp, __uint_as_float(w.z << 16), o[c * 8 + 4] * sc); o[c * 8 + 5] = fmaf(pp, __uint_as_float(w.z & 0xffff0000u), o[c * 8 + 5] * sc);
        o[c * 8 + 6] = fmaf(pp, __uint_as_float(w.w << 16), o[c * 8 + 6] * sc); o[c * 8 + 7] = fmaf(pp, __uint_as_float(w.w & 0xffff0000u), o[c * 8 + 7] * sc); }
}
__device__ __forceinline__ void store_o64(bf16_t* dst, const float (&o)[64], float inv) {
#pragma unroll
    for (int c = 0; c < 8; ++c) { u32x4 w; w.x = pk2(o[c * 8] * inv, o[c * 8 + 1] * inv); w.y = pk2(o[c * 8 + 2] * inv, o[c * 8 + 3] * inv);
        w.z = pk2(o[c * 8 + 4] * inv, o[c * 8 + 5] * inv); w.w = pk2(o[c * 8 + 6] * inv, o[c * 8 + 7] * inv); *(u32x4*)(dst + c * 8) = w; }
}
__device__ void p3_attn_naive(const Params& p, int gtid, int gsize) {
    const bf16_t* qkv = (const bf16_t*)(p.ws + WS_QKV); bf16_t* ob = (bf16_t*)(p.ws + WS_O);
    for (int it = gtid; it < NTOK * 16; it += gsize) {
        const bool isB = it >= NTOK * 8; const int w = isB ? it - NTOK * 8 : it;
        const int h = w & 7, tokg = w >> 3, b = tokg / L, t = tokg % L;
        float q[64], o[64];
#pragma unroll
        for (int d = 0; d < 64; ++d) o[d] = 0.f;
        OnlineSm st;
        if (!isB) {
            const int kvh = h >> 2;
            load_row64(qkv + (size_t)tokg * INW + C_QA + h * 64, q);
            st.m = p.sink_a[h] * LOG2E; st.l = 1.f;
            const int j0 = t - 128 < 0 ? 0 : t - 128, j1 = t + 128 > L - 1 ? L - 1 : t + 128;
            for (int j = j0; j <= j1; ++j) { const bf16_t* row = qkv + (size_t)(b * L + j) * INW; attn_key(q, o, st, row + C_KA + kvh * 64, row + C_VA + kvh * 64, 0.f); }
            for (int c = 0; c < CTX; ++c) { const bf16_t* row = qkv + (size_t)(NTOK + b * CTX + c) * INW; attn_key(q, o, st, row + C_KA + kvh * 64, row + C_VA + kvh * 64, 0.f); }
            store_o64(ob + (size_t)tokg * D + h * 64, o, 1.f / st.l);
        } else {
            load_row64(qkv + (size_t)tokg * INW + C_QB + h * 64, q);
            st.m = -1e30f; st.l = 0.f;
            const int r = t >> 6, c = t & 63;
            const int rs = r - 4 < 0 ? 0 : (r - 4 > 56 ? 56 : r - 4), cs = c - 8 < 0 ? 0 : (c - 8 > 48 ? 48 : c - 8);
            for (int a = 0; a < 8; ++a)
                for (int e = 0; e < 16; ++e) { const int kr = rs + a, kc = cs + e; const bf16_t* row = qkv + (size_t)(b * L + kr * 64 + kc) * INW;
                    const float bias = p.rpb_b[(h * 15 + (kr - r + 7)) * 31 + (kc - c + 15)] * LOG2E;
                    attn_key(q, o, st, row + C_KB + h * 64, row + C_VB + h * 64, bias); }
            for (int cc = 0; cc < CTX; ++cc) { const bf16_t* row = qkv + (size_t)(NTOK + b * CTX + cc) * INW; attn_key(q, o, st, row + C_KB + h * 64, row + C_VB + h * 64, 0.f); }
            store_o64(ob + (size_t)tokg * D + 512 + h * 64, o, 1.f / st.l);
        }
    }
}


namespace att {
#define ATT_LAS __attribute__((address_space(3)))
typedef float f32x16 __attribute__((ext_vector_type(16)));
typedef short bf16x8 __attribute__((ext_vector_type(8)));
typedef short s16x4 __attribute__((ext_vector_type(4)));
constexpr int SLOTB = 8192, NSLOT = 4;
constexpr int LDS_K = 0, LDS_V = NSLOT * SLOTB, LDS_WS = 2 * NSLOT * SLOTB, LDS_BT = LDS_WS + 8 * 256;
constexpr int BT_MARGIN = 64, BT_FLOATS = BT_MARGIN + 15 * 32 + 96;
constexpr float NEGBIG = -1e30f;
__device__ __forceinline__ int crow(int r, int hi) { return (r & 3) + 8 * (r >> 2) + 4 * hi; }
__device__ __forceinline__ unsigned cvtpk(float lo, float hi) { typedef float f2 __attribute__((ext_vector_type(2))); typedef __bf16 b2 __attribute__((ext_vector_type(2)));
    f2 v = {lo, hi}; b2 b = __builtin_convertvector(v, b2); return __builtin_bit_cast(unsigned, b); }
__device__ __forceinline__ s16x4 vtr(const ATT_LAS unsigned char* p) { typedef short v4i16 __attribute__((ext_vector_type(4)));
    return __builtin_bit_cast(s16x4, __builtin_amdgcn_ds_read_tr16_b64_v4i16((ATT_LAS v4i16*)p)); }
#define ATT_WAIT_BAR(N) asm volatile("s_waitcnt vmcnt(" #N ") lgkmcnt(0)\n\ts_barrier" ::: "memory")

__device__ __forceinline__ void dma_tile(ATT_LAS unsigned char* lds, int slot, const bf16_t* kbase, const bf16_t* vbase, int wid, int lane) {
    const bf16_t* ksrc = kbase + (size_t)lane * INW + wid * 8;
    const bf16_t* vsrc = vbase + (size_t)(16 * (wid & 3) + (lane >> 2)) * INW + (wid >> 2) * 32 + (lane & 3) * 8;
    __builtin_amdgcn_global_load_lds((const unsigned*)ksrc, (ATT_LAS unsigned*)(lds + LDS_K + slot * SLOTB + wid * 1024), 16, 0, 0);
    __builtin_amdgcn_global_load_lds((const unsigned*)vsrc, (ATT_LAS unsigned*)(lds + LDS_V + slot * SLOTB + wid * 1024), 16, 0, 0);
}

template <bool ISB>
__device__ __forceinline__ void attn_unit(const Params& p, ATT_LAS unsigned char* lds, int unit) {
    int tid_ = threadIdx.x; asm volatile("" : "+v"(tid_));
    const int tid = tid_, lane = tid & 63, r32 = lane & 31, hi = lane >> 5; const int wid = __builtin_amdgcn_readfirstlane(tid >> 6);
    const bf16_t* qkv = (const bf16_t*)(p.ws + WS_QKV); bf16_t* ob = (bf16_t*)(p.ws + WS_O);
    ATT_LAS float* wsf = (ATT_LAS float*)(lds + LDS_WS) + wid * 64;
    ATT_LAS float* bt = (ATT_LAS float*)(lds + LDS_BT);
    int b, h, kcol, vcol, qcol, ocol, q0, nloc, row_lo = 0, qr = 0, half = 0, qb = 0, jlo = 0;
    if (!ISB) { b = unit >> 7; const int kvh = (unit >> 6) & 1; qb = unit & 63; h = kvh * 4 + (wid >> 1); half = wid & 1; q0 = qb * 64 + 32 * half;
        kcol = C_KA + kvh * 64; vcol = C_VA + kvh * 64; qcol = C_QA + h * 64; ocol = h * 64;
        jlo = 2 - qb > 0 ? 2 - qb : 0; const int jhi = 65 - qb < 4 ? 65 - qb : 4; nloc = jhi - jlo + 1;
    } else { b = unit >> 7; h = (unit >> 4) & 7; const int g = unit & 15; qr = 4 * g + (wid >> 1); half = wid & 1; q0 = qr * 64 + 32 * half;
        kcol = C_KB + h * 64; vcol = C_VB + h * 64; qcol = C_QB + h * 64; ocol = 512 + h * 64;
        const int r0 = 4 * g, r3 = 4 * g + 3; row_lo = r0 - 4 < 0 ? 0 : (r0 - 4 > 56 ? 56 : r0 - 4); const int rs3 = r3 - 4 < 0 ? 0 : (r3 - 4 > 56 ? 56 : r3 - 4); nloc = rs3 + 7 - row_lo + 1;
    }
    const int NT = nloc + 4;
    const bf16_t* lat = qkv + (size_t)b * L * INW; const bf16_t* cx = qkv + (size_t)(NTOK + b * CTX) * INW;
#define ATT_TILE_ROW(t) ((t) < nloc ? lat + (size_t)(ISB ? (row_lo + (t)) * 64 : (qb - 2 + jlo + (t)) * 64) * INW : cx + (size_t)((t) - nloc) * 64 * INW)
    if (ISB) {
        for (int i = tid; i < BT_FLOATS; i += NTHREADS) { const int j = i - BT_MARGIN; float v = 0.f;
            if (j >= 0 && j < 15 * 32 && (j & 31) < 31) v = p.rpb_b[(h * 15 + (j >> 5)) * 31 + (j & 31)] * LOG2E;
            bt[i] = v; }
    }
#pragma unroll
    for (int t0 = 0; t0 < NSLOT - 1; ++t0) { const bf16_t* r0p = ATT_TILE_ROW(t0); dma_tile(lds, t0, r0p + kcol, r0p + vcol, wid, lane); }
    bf16x8 qf[4];
    { const bf16_t* qp = lat + (size_t)(q0 + r32) * INW + qcol + hi * 8;
#pragma unroll
      for (int d0 = 0; d0 < 4; ++d0) qf[d0] = *(const bf16x8*)(qp + d0 * 16); }
    float m_run, l_run;
    if (!ISB) { m_run = p.sink_a[h] * LOG2E; l_run = hi == 0 ? 1.f : 0.f; } else { m_run = NEGBIG; l_run = 0.f; }
    f32x16 o0, o1;
#pragma unroll
    for (int r = 0; r < 16; ++r) { o0[r] = 0.f; o1[r] = 0.f; }
    const int qc = 32 * half + r32;
    const int cs = qc - 8 < 0 ? 0 : (qc - 8 > 48 ? 48 : qc - 8);
    const int rsq = qr - 4 < 0 ? 0 : (qr - 4 > 56 ? 56 : qr - 4);
    for (int t = 0; t < NT; ++t) {
        const int ahead = NT - 1 - t < NSLOT - 2 ? NT - 1 - t : NSLOT - 2;
        if (ahead == 2) ATT_WAIT_BAR(4); else if (ahead == 1) ATT_WAIT_BAR(2); else ATT_WAIT_BAR(0);
        if (t + NSLOT - 1 < NT) { const bf16_t* rp = ATT_TILE_ROW(t + NSLOT - 1); dma_tile(lds, (t + NSLOT - 1) & (NSLOT - 1), rp + kcol, rp + vcol, wid, lane); }
        const int slot = t & (NSLOT - 1);
        bool active = true; int kr = 0;
        if (ISB && t < nloc) { kr = row_lo + t; active = (kr >= rsq) && (kr <= rsq + 7); }
        if (active) {
            const ATT_LAS unsigned char* kb = lds + LDS_K + slot * SLOTB + hi * 1024 + r32 * 16;
            f32x16 p0, p1;
#pragma unroll
            for (int r = 0; r < 16; ++r) { p0[r] = 0.f; p1[r] = 0.f; }
#pragma unroll
            for (int d0 = 0; d0 < 4; ++d0) {
                const bf16x8 k0 = *(const ATT_LAS bf16x8*)(kb + d0 * 2048), k1 = *(const ATT_LAS bf16x8*)(kb + d0 * 2048 + 512);
                p0 = __builtin_amdgcn_mfma_f32_32x32x16_bf16(k0, qf[d0], p0, 0, 0, 0);
                p1 = __builtin_amdgcn_mfma_f32_32x32x16_bf16(k1, qf[d0], p1, 0, 0, 0);
            }
            if (ISB) {
                if (t < nloc) {
                    const ATT_LAS float* bp = bt + BT_MARGIN + (kr - qr + 7) * 32 + 15 - qc + 4 * hi;
                    const int e0 = 4 * hi - cs;
#pragma unroll
                    for (int r = 0; r < 16; ++r) { const int c = (r & 3) + 8 * (r >> 2);
                        const float b0 = bp[c], b1 = bp[c + 32];
                        p0[r] = ((unsigned)(c + e0) < 16u) ? p0[r] + b0 : NEGBIG;
                        p1[r] = ((unsigned)(c + 32 + e0) < 16u) ? p1[r] + b1 : NEGBIG; }
                }
            } else {
                if (t < nloc) { const int j = jlo + t; const int qq = 32 * half + r32;
                    if (j == 0) {
#pragma unroll
                        for (int r = 0; r < 16; ++r) { const int c = crow(r, hi); if (c < qq) p0[r] = NEGBIG; if (c + 32 < qq) p1[r] = NEGBIG; }
                    } else if (j == 4) {
#pragma unroll
                        for (int r = 0; r < 16; ++r) { const int c = crow(r, hi); if (c > qq) p0[r] = NEGBIG; if (c + 32 > qq) p1[r] = NEGBIG; }
                    }
                }
            }
            float rm = fmaxf(p0[0], p1[0]);
#pragma unroll
            for (int r = 1; r < 16; ++r) rm = fmaxf(rm, fmaxf(p0[r], p1[r]));
            rm = fmaxf(rm, __shfl_xor(rm, 32));
            const float mnew = fmaxf(m_run, rm);
            if (__any(mnew > m_run)) {
                const float f = __builtin_amdgcn_exp2f(m_run - mnew);
                l_run *= f; m_run = mnew;
                if (hi == 0) wsf[r32] = f;
                asm volatile("s_waitcnt lgkmcnt(0)" ::: "memory");
#pragma unroll
                for (int r = 0; r < 16; ++r) { const float fr_ = wsf[crow(r, hi)]; o0[r] *= fr_; o1[r] *= fr_; }
            }
            float ls = 0.f;
#pragma unroll
            for (int r = 0; r < 16; ++r) { p0[r] = __builtin_amdgcn_exp2f(p0[r] - m_run); p1[r] = __builtin_amdgcn_exp2f(p1[r] - m_run); ls += p0[r] + p1[r]; }
            l_run += ls;
            typedef unsigned u4 __attribute__((ext_vector_type(4)));
            const u4 pw0 = {cvtpk(p0[0], p0[1]), cvtpk(p0[2], p0[3]), cvtpk(p0[4], p0[5]), cvtpk(p0[6], p0[7])};
            const u4 pw1 = {cvtpk(p0[8], p0[9]), cvtpk(p0[10], p0[11]), cvtpk(p0[12], p0[13]), cvtpk(p0[14], p0[15])};
            const u4 pw2 = {cvtpk(p1[0], p1[1]), cvtpk(p1[2], p1[3]), cvtpk(p1[4], p1[5]), cvtpk(p1[6], p1[7])};
            const u4 pw3 = {cvtpk(p1[8], p1[9]), cvtpk(p1[10], p1[11]), cvtpk(p1[12], p1[13]), cvtpk(p1[14], p1[15])};
            const ATT_LAS unsigned char* vp = lds + LDS_V + slot * SLOTB + ((lane >> 4) & 1) * 32 + (lane & 3) * 8 + (4 * hi + ((lane & 15) >> 2)) * 64;
#define ATT_PV(OACC, PW, D0, KS) do { const s16x4 lo_ = vtr(vp + (D0) * 4096 + (KS) * 1024), hi_ = vtr(vp + (D0) * 4096 + (KS) * 1024 + 512); \
                const bf16x8 vf_ = {lo_[0], lo_[1], lo_[2], lo_[3], hi_[0], hi_[1], hi_[2], hi_[3]}; \
                OACC = __builtin_amdgcn_mfma_f32_32x32x16_bf16(__builtin_bit_cast(bf16x8, PW), vf_, OACC, 0, 0, 0); } while (0)
            ATT_PV(o0, pw0, 0, 0); ATT_PV(o1, pw0, 1, 0); ATT_PV(o0, pw1, 0, 1); ATT_PV(o1, pw1, 1, 1);
            ATT_PV(o0, pw2, 0, 2); ATT_PV(o1, pw2, 1, 2); ATT_PV(o0, pw3, 0, 3); ATT_PV(o1, pw3, 1, 3);
#undef ATT_PV
        }
    }
    l_run += __shfl_xor(l_run, 32);
    if (hi == 0) wsf[32 + r32] = l_run;
    asm volatile("s_waitcnt lgkmcnt(0)" ::: "memory");
    bf16_t* op = ob + (size_t)(b * L + q0) * D + ocol + r32;
    float* ossp = (float*)(p.ws + WS_OSS) + (size_t)(b * L + q0) * 16 + (ocol >> 6);
#pragma unroll
    for (int r = 0; r < 16; ++r) { const int q = crow(r, hi); const float inv = __builtin_amdgcn_rcpf(wsf[32 + q]);
        const float a0 = o0[r] * inv, a1 = o1[r] * inv;
        op[(size_t)q * D] = (bf16_t)f2bf(a0); op[(size_t)q * D + 32] = (bf16_t)f2bf(a1);
        const float ss = row_sum16(a0 * a0 + a1 * a1);
        const float s01 = rdlane(ss, 0) + rdlane(ss, 16), s23 = rdlane(ss, 32) + rdlane(ss, 48);
        if (r32 == 0) ossp[(size_t)q * 16] = hi ? s23 : s01; }
    ATT_WAIT_BAR(0);
#undef ATT_TILE_ROW
}

__device__ __forceinline__ void attn_phase(const Params& p, ATT_LAS unsigned char* lds) {
    const int G = gridDim.x, bx = blockIdx.x;
    const int vcu = (G % 8 == 0) ? (bx % 8) * (G / 8) + bx / 8 : bx;
    for (int u = vcu; u < 2048; u += G) {
        if (u < 1024) attn_unit<false>(p, lds, u); else attn_unit<true>(p, lds, u - 1024);
    }
}
}

__device__ void p4a_ostat(const Params& p, int gw, int ngw, int lane) {
    bf16_t* ob = (bf16_t*)(p.ws + WS_O); float* os = (float*)(p.ws + WS_OSTAT);
    for (int m = gw; m < NTOK; m += ngw) {
        const u32x4 wa = *(const u32x4*)(ob + (size_t)m * D + lane * 8), wb = *(const u32x4*)(ob + (size_t)m * D + 512 + lane * 8);
        float sa = 0.f, sb = 0.f;
#pragma unroll
        for (int i = 0; i < 4; ++i) { const unsigned ua = wa[i], ub = wb[i]; const float a0 = __uint_as_float(ua << 16), a1 = __uint_as_float(ua & 0xffff0000u), b0 = __uint_as_float(ub << 16), b1 = __uint_as_float(ub & 0xffff0000u);
            sa += a0 * a0 + a1 * a1; sb += b0 * b0 + b1 * b1; }
        sa = wave_sum(sa); sb = wave_sum(sb);
        const float ra = rsqrtf(sa * (1.f / 512.f) + EPS), rb = rsqrtf(sb * (1.f / 512.f) + EPS);
        if (lane == 0) { os[m * 2] = ra; os[m * 2 + 1] = rb; }
        u32x4 oa, obb;
#pragma unroll
        for (int i = 0; i < 4; ++i) { const unsigned ua = wa[i], ub = wb[i];
            oa[i] = pk2(__uint_as_float(ua << 16) * ra, __uint_as_float(ua & 0xffff0000u) * ra); obb[i] = pk2(__uint_as_float(ub << 16) * rb, __uint_as_float(ub & 0xffff0000u) * rb); }
        *(u32x4*)(ob + (size_t)m * D + lane * 8) = oa; *(u32x4*)(ob + (size_t)m * D + 512 + lane * 8) = obb;
    }
}
__device__ void p4b_outproj_naive(const Params& p, float* sA, float* sB) {
    const bf16_t* ob = (const bf16_t*)(p.ws + WS_O); const bf16_t* wT = (const bf16_t*)(p.ws + WS_WOUT);
    float* mix = (float*)(p.ws + WS_MIX);
    constexpr int NTN = D / 64, NT = (NTOK / 128) * NTN;
    for (int t = blockIdx.x; t < NT; t += gridDim.x) {
        const int m0 = (t / NTN) * 128, n0 = (t % NTN) * 64;
        auto al = [&](int r, int k) { return bf2f(ob[(size_t)r * D + k]); };
        auto bl = [&](int n, int k) { return bf2f(wT[(size_t)n * D + k]); };
        auto ep = [&](int r0, int nn0, int tx, float (&acc)[4][4]) {
#pragma unroll
            for (int i = 0; i < 4; ++i)
#pragma unroll
                for (int j = 0; j < 4; ++j) mix[(size_t)(r0 + i) * D + nn0 + tx + 16 * j] = acc[i][j];
        };
        ngemm_tile(sA, sB, m0, n0, D, al, bl, ep);
    }
}
constexpr int SW_STRIDE = 36;

__device__ void p4c_post(const Params& p, LAS3 float* sW) {
    const int tid = tid_opaque(), lane = tid & 63;
    const float* mod = (const float*)(p.ws + WS_MOD); const bf16_t* mix = (const bf16_t*)(p.ws + WS_MIX);
    unsigned char* h8 = p.ws + WS_HB;
    unsigned* counts = (unsigned*)(p.ws + WS_CTL);
    int* eslot = (int*)(p.ws + WS_ESLOT); float* ew = (float*)(p.ws + WS_EW);
    const int wave = tid >> 6;
    LAS3 int* lcnt = (LAS3 int*)(sW + 1024 * SW_STRIDE) + 128;
    LAS3 int* lbase = lcnt + 32;
    LAS3 int* stg_slot = lbase + 32; LAS3 int* stg_e = stg_slot + 512; LAS3 float* stg_w = (LAS3 float*)(stg_e + 512);
    if (threadIdx.x < NE) lcnt[threadIdx.x] = 0;
    for (int i = threadIdx.x; i < D * 8; i += NTHREADS) { const int k = i >> 3, e4 = i & 7; const f32x4 w = ((const f32x4*)p.w_router)[i];
        LAS3 float* d = sW + ((k & 3) * 256 + (k >> 2)) * SW_STRIDE + e4 * 4; *(LAS3 f32x4*)d = w; }
    __syncthreads();
    constexpr int R = 16;
    const int m0 = ((int)blockIdx.x * (NTHREADS / 64) + wave) * R;
    if (m0 < NTOK) {
        const int b = m0 / L; const float* mb = mod + b * 6144;
        f32x4 pA[4], pB[4], pC[4], v[4], xx[4], nx[4]; u32x2 nv[4];
#pragma unroll
        for (int j = 0; j < 4; ++j) { const int c0 = 4 * (lane + 64 * j);
            pA[j] = *(const f32x4*)(p.g_post_mix + c0) * *(const f32x4*)(mb + 2048 + c0);
            pB[j] = *(const f32x4*)(p.g_pre_ffn + c0) * (*(const f32x4*)(mb + 4096 + c0) + 1.f);
            pC[j] = *(const f32x4*)(mb + 3072 + c0);
            nv[j] = ((const u32x2*)(mix + (size_t)m0 * D))[lane + 64 * j]; nx[j] = ((const f32x4*)(p.x + (size_t)m0 * D))[lane + 64 * j]; }
        for (int it = 0; it < R; ++it) {
            const int m = m0 + it;
#pragma unroll
            for (int j = 0; j < 4; ++j) { v[j] = (f32x4){__uint_as_float(nv[j].x << 16), __uint_as_float(nv[j].x & 0xffff0000u), __uint_as_float(nv[j].y << 16), __uint_as_float(nv[j].y & 0xffff0000u)}; xx[j] = nx[j]; }
            if (it + 1 < R) {
#pragma unroll
                for (int j = 0; j < 4; ++j) { nv[j] = ((const u32x2*)(mix + (size_t)(m + 1) * D))[lane + 64 * j]; nx[j] = ((const f32x4*)(p.x + (size_t)(m + 1) * D))[lane + 64 * j]; }
            }
            float s = 0.f;
#pragma unroll
            for (int j = 0; j < 4; ++j) s += v[j].x * v[j].x + v[j].y * v[j].y + v[j].z * v[j].z + v[j].w * v[j].w;
            float rstd = rsqrtf(wave_sum(s) * (1.f / D) + EPS);
            s = 0.f;
            f32x4 xv[4];
#pragma unroll
            for (int j = 0; j < 4; ++j) {
                xv[j] = xx[j] + pA[j] * (v[j] * rstd);
                ((f32x4*)(p.out + (size_t)m * D))[lane + 64 * j] = xv[j];
                s += xv[j].x * xv[j].x + xv[j].y * xv[j].y + xv[j].z * xv[j].z + xv[j].w * xv[j].w; }
            rstd = rsqrtf(wave_sum(s) * (1.f / D) + EPS);
            float lg[NE];
#pragma unroll
            for (int e = 0; e < NE; ++e) lg[e] = 0.f;
#pragma unroll
            for (int j = 0; j < 4; ++j) { const int c0 = 4 * (lane + 64 * j);
                const f32x4 h2 = (xv[j] * rstd) * pB[j] + pC[j];
                *(unsigned*)(h8 + (size_t)m * D + c0) = pk4_fp8(h2.x, h2.y, h2.z, h2.w);
#pragma unroll
                for (int q = 0; q < 4; ++q) { const float hv = h2[q]; const LAS3 f32x4* wr = (const LAS3 f32x4*)(sW + (q * 256 + lane + 64 * j) * SW_STRIDE);
#pragma unroll
                    for (int e4 = 0; e4 < 8; ++e4) { const f32x4 ww = wr[e4]; lg[e4 * 4] = fmaf(hv, ww.x, lg[e4 * 4]); lg[e4 * 4 + 1] = fmaf(hv, ww.y, lg[e4 * 4 + 1]); lg[e4 * 4 + 2] = fmaf(hv, ww.z, lg[e4 * 4 + 2]); lg[e4 * 4 + 3] = fmaf(hv, ww.w, lg[e4 * 4 + 3]); }
                    asm volatile("" ::: "memory"); }
            }
#pragma unroll
            for (int e = 0; e < NE; ++e) lg[e] = wave_sum(lg[e]) + p.b_router[e];
            float tv[4]; int ti[4]; unsigned used = 0u;
#pragma unroll
            for (int k = 0; k < 4; ++k) { float best = -3.4e38f; int bi = 0;
#pragma unroll
                for (int e = 0; e < NE; ++e) { const bool ok = !((used >> e) & 1u) && lg[e] > best; best = ok ? lg[e] : best; bi = ok ? e : bi; }
                tv[k] = best; ti[k] = bi; used |= 1u << bi; }
            const float e1 = __expf(tv[1] - tv[0]), e2 = __expf(tv[2] - tv[0]), e3 = __expf(tv[3] - tv[0]); const float inv = 1.f / (1.f + e1 + e2 + e3);
            const float tw[4] = {inv, e1 * inv, e2 * inv, e3 * inv};
            if (lane < 4) {
                int myi = ti[0]; float myw = tw[0];
#pragma unroll
                for (int k = 1; k < 4; ++k) if (lane == k) { myi = ti[k]; myw = tw[k]; }
                const int lr = __hip_atomic_fetch_add((LAS3 int*)&lcnt[myi], 1, __ATOMIC_RELAXED, __HIP_MEMORY_SCOPE_WORKGROUP);
                const int si = (wave * 16 + it) * 4 + lane;
                stg_slot[si] = m * 4 + lane; stg_e[si] = myi | (lr << 8); stg_w[si] = myw;
            }
        }
    }
    __syncthreads();
    if (threadIdx.x < NE) { const int c = lcnt[threadIdx.x]; lbase[threadIdx.x] = c ? (int)atomicAdd(&counts[threadIdx.x * 64], (unsigned)c) : 0; }
    __syncthreads();
    { const int si = threadIdx.x, w = si >> 6;
      if (((int)blockIdx.x * (NTHREADS / 64) + w) * R < NTOK) {
        const int ee = stg_e[si], e = ee & 255, lr = ee >> 8; const int rank = lbase[e] + lr;
        eslot[(size_t)e * ECAP + rank] = stg_slot[si]; ew[(size_t)e * ECAP + rank] = stg_w[si]; } }
    __syncthreads();
}
__device__ __forceinline__ void expert_bases(const unsigned* counts, int* sbase_  ) {
    LAS3 int* sbase = (LAS3 int*)sbase_;
    if (threadIdx.x < 64) {
        const int lane = threadIdx.x; const int cn = lane < NE ? (int)counts[lane * 64] : 0; const int c = (cn + 255) & ~255;
        int incl = c;
#pragma unroll
        for (int o = 1; o < 32; o <<= 1) { const int v = __shfl_up(incl, o); if (lane >= o) incl += v; }
        if (lane < NE) { sbase[lane] = incl - c; sbase[40 + lane] = cn; }
        if (lane == NE - 1) sbase[NE] = incl;
    }
    __syncthreads();
}
typedef float f32x2v __attribute__((ext_vector_type(2)));
__device__ __forceinline__ void p6_load(const unsigned char* y, const float* out, int m, int lane, u32x2 (&yv)[2][4], f32x4 (&xv)[2][2]) {
#pragma unroll
    for (int j = 0; j < 2; ++j) { const int c0 = 8 * (lane + 64 * j);
#pragma unroll
        for (int k = 0; k < 4; ++k) yv[j][k] = *(const u32x2*)(y + (size_t)(m * 4 + k) * D + c0);
        xv[j][0] = *(const f32x4*)(out + (size_t)m * D + c0); xv[j][1] = *(const f32x4*)(out + (size_t)m * D + c0 + 4); }
}
__device__ void p6_final(const Params& p) {
    const int tid = tid_opaque(), lane = tid & 63;
    const float* mod = (const float*)(p.ws + WS_MOD); const unsigned char* y = p.ws + WS_Y;
    constexpr int R = 16;
    const int m0 = ((int)blockIdx.x * (NTHREADS / 64) + (tid >> 6)) * R;
    if (m0 >= NTOK) return;
    const int b = m0 / L; const float* ga2 = mod + b * 6144 + 5120;
    f32x4 pA[2][2];
#pragma unroll
    for (int j = 0; j < 2; ++j)
#pragma unroll
        for (int q = 0; q < 2; ++q) { const int c0 = 8 * (lane + 64 * j) + 4 * q; pA[j][q] = *(const f32x4*)(p.g_post_ffn + c0) * *(const f32x4*)(ga2 + c0); }
    u32x2 yv[2][4], ny[2][4]; f32x4 xv[2][2], nx[2][2];
    p6_load(y, p.out, m0, lane, ny, nx);
    for (int it = 0; it < R; ++it) {
        const int m = m0 + it;
#pragma unroll
        for (int j = 0; j < 2; ++j) {
#pragma unroll
            for (int k = 0; k < 4; ++k) yv[j][k] = ny[j][k];
            xv[j][0] = nx[j][0]; xv[j][1] = nx[j][1]; }
        if (it + 1 < R) p6_load(y, p.out, m + 1, lane, ny, nx);
        f32x4 a[2][2]; float s = 0.f;
#pragma unroll
        for (int j = 0; j < 2; ++j) { a[j][0] = (f32x4){0.f, 0.f, 0.f, 0.f}; a[j][1] = (f32x4){0.f, 0.f, 0.f, 0.f};
#pragma unroll
            for (int k = 0; k < 4; ++k) { const u32x2 w = yv[j][k];
                const f32x2v l0 = __builtin_amdgcn_cvt_pk_f32_fp8((int)w.x, false), l1 = __builtin_amdgcn_cvt_pk_f32_fp8((int)w.x, true);
                const f32x2v h0 = __builtin_amdgcn_cvt_pk_f32_fp8((int)w.y, false), h1 = __builtin_amdgcn_cvt_pk_f32_fp8((int)w.y, true);
                a[j][0].x += l0.x; a[j][0].y += l0.y; a[j][0].z += l1.x; a[j][0].w += l1.y;
                a[j][1].x += h0.x; a[j][1].y += h0.y; a[j][1].z += h1.x; a[j][1].w += h1.y; }
#pragma unroll
            for (int q = 0; q < 2; ++q) { a[j][q] = a[j][q] * Y8_INV; s += a[j][q].x * a[j][q].x + a[j][q].y * a[j][q].y + a[j][q].z * a[j][q].z + a[j][q].w * a[j][q].w; } }
        const float rstd = rsqrtf(wave_sum(s) * (1.f / D) + EPS);
#pragma unroll
        for (int j = 0; j < 2; ++j)
#pragma unroll
            for (int q = 0; q < 2; ++q) { const int c0 = 8 * (lane + 64 * j) + 4 * q;
                *(f32x4*)(p.out + (size_t)m * D + c0) = xv[j][q] + pA[j][q] * (a[j][q] * rstd); }
    }
}

constexpr int LDS_SBASE = 147456;
constexpr int LDS_BYTES = LDS_SBASE + 512 + (64 + 3 * 512) * 4 + 256;

__global__ void __launch_bounds__(NTHREADS, 2) fwd_kernel(Params p) {
    cg::grid_group grid = cg::this_grid();
    extern __shared__ __attribute__((aligned(16))) unsigned char lds[];
    int* sbase = (int*)(lds + LDS_SBASE);
    PG8_LAS unsigned char* lds3 = (PG8_LAS unsigned char*)lds;
    const PG8_LAS int* sbase3 = (const PG8_LAS int*)(lds3 + LDS_SBASE);
    volatile LAS3 unsigned* bst = (volatile LAS3 unsigned*)(lds3 + LDS_SBASE + 384);
    if (threadIdx.x < 2) bst[threadIdx.x] = 0u;
    __syncthreads();
    XcdBarrier xb = xcd_barrier_post((unsigned*)(p.ws + WS_CTL) + CW_BAR, bst);

    p0_mod(p, (float*)lds, (float*)(lds + 36864));
    p0_tab(p);
    p0_weights(p, lds);
    grid.sync();
    p1_h(p);
    xcd_barrier(xb);
    { pg8::Gemm g{(const bf16_t*)(p.ws + WS_HB), (const bf16_t*)(p.ws + WS_WIN), D, 0, nullptr, sbase3};
      pg8::StaticOrder S; S.init(MROWS, INW, (int)gridDim.x, (int)blockIdx.x, nullptr);
      { const int t_ = tid_opaque(); *(PG8_LAS f32x4*)(lds3 + pg8::PAR_TAB + t_ * 16) = ((const f32x4*)(p.ws + WS_TAB))[t_]; }
      __syncthreads();
      pg8::EpiQKV E{(bf16_t*)(p.ws + WS_QKV)};
      pg8::gemm_phase<pg8::EpiQKV, pg8::StaticOrder, false, true>(lds3, g, S, E); }
    xcd_barrier(xb);
    att::attn_phase(p, lds3);
    xcd_barrier(xb);
    { pg8::Gemm g{(const bf16_t*)(p.ws + WS_O), (const bf16_t*)(p.ws + WS_WOUT), D, 0, nullptr, sbase3};
      pg8::StaticOrder S; S.init(NTOK, D, (int)gridDim.x, (int)blockIdx.x, nullptr);
      pg8::EpiOutProj E{(bf16_t*)(p.ws + WS_MIX), (const float*)(p.ws + WS_OSS)};
      pg8::gemm_phase<pg8::EpiOutProj, pg8::StaticOrder, false, true>(lds3, g, S, E); }
    xcd_barrier(xb);
    p4c_post(p, (LAS3 float*)lds3);
    xcd_barrier(xb);
    expert_bases((const unsigned*)(p.ws + WS_CTL), sbase);
    { const int total = sbase3[NE];
      pg8::Gemm g{(const bf16_t*)(p.ws + WS_HB), (const bf16_t*)(p.ws + WS_W1), D / 2, (size_t)2048 * D, (const int*)(p.ws + WS_ESLOT), sbase3};
      pg8::StaticOrder S; S.init(total, 2048, (int)gridDim.x, (int)blockIdx.x, sbase3);
      pg8::EpiSwiglu E{p.ws + WS_ACT, p.b_mlp1};
      pg8::gemm_phase<pg8::EpiSwiglu, pg8::StaticOrder, true, true, true>(lds3, g, S, E); }
    xcd_barrier(xb);
    { const int total = sbase3[NE];
      pg8::Gemm g{(const bf16_t*)(p.ws + WS_ACT), (const bf16_t*)(p.ws + WS_W2), D / 2, (size_t)D * D, nullptr, sbase3};
      pg8::StaticOrder S; S.init(total, D, (int)gridDim.x, (int)blockIdx.x, sbase3);
      pg8::EpiScatter E{p.ws + WS_Y, p.b_mlp2, (const int*)(p.ws + WS_ESLOT), (const float*)(p.ws + WS_EW), sbase3};
      pg8::gemm_phase<pg8::EpiScatter, pg8::StaticOrder, false, true, true>(lds3, g, S, E); }
    xcd_barrier(xb);
    p6_final(p);
}

extern "C" void kernel_launch(void* const* d_in, const int* in_sizes, int n_in, void* d_out, int out_size, void* d_ws, size_t ws_size, hipStream_t stream) {
    static int grid_blocks = 0;
    if (grid_blocks == 0) {
        if (n_in != 22 || ws_size < WS_END) { fprintf(stderr, "kernel_launch: unexpected n_in %d / ws_size %zu (need %zu)\n", n_in, ws_size, (size_t)WS_END); grid_blocks = -1; return; }
        int dev = 0, cus = 0, per_cu = 0;
        (void)hipGetDevice(&dev);
        (void)hipDeviceGetAttribute(&cus, hipDeviceAttributeMultiprocessorCount, dev);
        if (hipFuncSetAttribute((const void*)fwd_kernel, hipFuncAttributeMaxDynamicSharedMemorySize, LDS_BYTES) != hipSuccess) { fprintf(stderr, "kernel_launch: hipFuncSetAttribute failed\n"); grid_blocks = -1; return; }
        (void)hipOccupancyMaxActiveBlocksPerMultiprocessor(&per_cu, (const void*)fwd_kernel, NTHREADS, LDS_BYTES);
        if (per_cu < 1) { fprintf(stderr, "kernel_launch: occupancy query returned %d\n", per_cu); grid_blocks = -1; return; }
        grid_blocks = cus;
        if (grid_blocks * (NTHREADS / 64) * 16 < NTOK) { fprintf(stderr, "kernel_launch: needs >= 256 CUs (got %d)\n", cus); grid_blocks = -1; return; }
    }
    if (grid_blocks < 0) return;
    (void)hipMemsetAsync((char*)d_ws + WS_CTL, 0, CTL_BYTES, stream);
    Params p{};
    const float** pp = (const float**)&p;
    for (int i = 0; i < 22; ++i) pp[i] = (const float*)d_in[i];
    p.out = (float*)d_out; p.ws = (unsigned char*)d_ws;
    void* args[] = {&p};
    hipError_t e = hipLaunchCooperativeKernel((const void*)fwd_kernel, dim3(grid_blocks), dim3(NTHREADS), args, LDS_BYTES, stream);
    if (e != hipSuccess) fprintf(stderr, "cooperative launch failed: %s (grid %d)\n", hipGetErrorString(e), grid_blocks);
}
```

```cpp
#include <hip/hip_runtime.h>
#include <hip/hip_cooperative_groups.h>
#include <cstdio>
#include <cstdint>
namespace cg = cooperative_groups;

constexpr int D = 1024, NB = 8, L = 4096, CTX = 256;
constexpr int NTOK = NB * L, NCTX = NB * CTX, MROWS = NTOK + NCTX;
constexpr int INW = 2304;
constexpr int C_QA = 0, C_KA = 512, C_VA = 640, C_QB = 768, C_KB = 1280, C_VB = 1792;
constexpr int NE = 32, TOPK = 4, NASG = NTOK * TOPK;
constexpr int PADROWS = NASG + NE * 256;
constexpr float LOG2E = 1.4426950408889634f;
constexpr float QSCALE = 0.125f * LOG2E;
constexpr float EPS = 1e-6f;
constexpr int NTHREADS = 512;

constexpr size_t MiB = 1u << 20;
constexpr size_t WS_CTL = 0;
constexpr size_t CTL_BYTES = 32768;
constexpr int CW_BAR = 2048;
constexpr size_t WS_MOD = 1 * MiB;
constexpr size_t WS_TAB = 1 * MiB + 256 * 1024;
constexpr size_t WS_OSTAT = 1 * MiB + 512 * 1024;
constexpr size_t WS_WIN = 2 * MiB;
constexpr size_t WS_WOUT = 7 * MiB;
constexpr size_t WS_W2 = 9 * MiB;
constexpr size_t WS_OSS = 41 * MiB;
constexpr size_t WS_W1 = 73 * MiB;
constexpr size_t WS_HB = 201 * MiB;
constexpr int ECAP = NTOK;
constexpr size_t WS_ESLOT = 269 * MiB;
constexpr size_t WS_EW = 273 * MiB;
constexpr size_t WS_QKV = 277 * MiB;
constexpr size_t WS_O = 430 * MiB;
constexpr size_t WS_MIX = 494 * MiB;
constexpr size_t WS_ACT = 277 * MiB;
constexpr size_t WS_Y = 622 * MiB;
constexpr size_t WS_END = 878 * MiB;
static_assert(WS_W1 + (size_t)NE * 2048 * D * 2 <= WS_HB && WS_W2 + (size_t)NE * D * D * 2 <= WS_W1, "map");
static_assert(WS_HB + (size_t)MROWS * D * 2 <= WS_ESLOT && WS_ESLOT + (size_t)NE * ECAP * 4 <= WS_EW && WS_EW + (size_t)NE * ECAP * 4 <= WS_QKV, "map");
static_assert(WS_QKV + (size_t)MROWS * INW * 2 <= WS_O && WS_O + (size_t)NTOK * D * 2 <= WS_MIX && WS_MIX + (size_t)NTOK * D * 4 <= WS_Y, "map");
static_assert(WS_ACT + (size_t)PADROWS * 1024 * 2 <= WS_Y && WS_Y + (size_t)NASG * D * 2 <= WS_END, "map");

typedef unsigned short bf16_t;
typedef float f32x4 __attribute__((ext_vector_type(4)));
typedef unsigned u32x4 __attribute__((ext_vector_type(4)));
typedef unsigned u32x2 __attribute__((ext_vector_type(2)));

struct Params {
    const float *x, *c, *ctx, *c_ctx, *w_ada, *b_ada, *g_pre_mix, *g_post_mix, *g_pre_ffn, *g_post_ffn, *w_in, *g_grp_a, *g_grp_b,
        *sink_a, *rpb_b, *w_out, *w_router, *b_router, *w_mlp1, *b_mlp1, *w_mlp2, *b_mlp2;
    float* out;
    unsigned char* ws;
};

__device__ __forceinline__ unsigned f2bf(float f) { unsigned u = __float_as_uint(f); return (u + 0x7fffu + ((u >> 16) & 1u)) >> 16; }
__device__ __forceinline__ unsigned pk2(float lo, float hi) { return f2bf(lo) | (f2bf(hi) << 16); }
__device__ __forceinline__ unsigned pk4_fp8(float v0, float v1, float v2, float v3) {
    int w = 0; w = __builtin_amdgcn_cvt_pk_fp8_f32(v0, v1, w, false); w = __builtin_amdgcn_cvt_pk_fp8_f32(v2, v3, w, true); return (unsigned)w; }
constexpr float Y8_SCALE = 16.f, Y8_INV = 1.f / 16.f;
constexpr float W8_SCALE = 64.f, W8_INV = 1.f / 64.f;
__device__ __forceinline__ int lane_id() { int l = (int)__builtin_amdgcn_mbcnt_hi(~0u, __builtin_amdgcn_mbcnt_lo(~0u, 0u)); asm volatile("" : "+v"(l)); return l; }
__device__ __forceinline__ int tid_opaque(int wv) { return wv * 64 + lane_id(); }
template <int CTRL> __device__ __forceinline__ float dppmov(float v) { return __builtin_bit_cast(float, __builtin_amdgcn_update_dpp(0, __builtin_bit_cast(int, v), CTRL, 0xf, 0xf, true)); }
__device__ __forceinline__ float row_sum16(float v) { v += dppmov<0xB1>(v); v += dppmov<0x4E>(v); v += dppmov<0x141>(v); v += dppmov<0x140>(v); return v; }
__device__ __forceinline__ float rdlane(float v, int l) { return __builtin_bit_cast(float, __builtin_amdgcn_readlane(__builtin_bit_cast(int, v), l)); }
__device__ __forceinline__ float wave_sum(float v) { v = row_sum16(v); return (rdlane(v, 0) + rdlane(v, 16)) + (rdlane(v, 32) + rdlane(v, 48)); }

#define LAS3 __attribute__((address_space(3)))
#define XB_TMO      128
#define XB_XCNT(j)  (256  + 64 * (j))
#define XB_XSUB(j)  (1280 + 64 * (j))
#define XB_XGEN(j)  (2304 + 64 * (j))
#define XB_TOP      3328
#define XB_TOPGEN   3392
#define XCD_BAR_WORDS 3456
#define XB_SPIN_CAP (1u << 18)
__device__ __forceinline__ unsigned xb_ld(unsigned* p)              { return __hip_atomic_load(p, __ATOMIC_RELAXED, __HIP_MEMORY_SCOPE_AGENT); }
__device__ __forceinline__ unsigned xb_add(unsigned* p, unsigned v) { return __hip_atomic_fetch_add(p, v, __ATOMIC_RELAXED, __HIP_MEMORY_SCOPE_AGENT); }
__device__ __forceinline__ unsigned xb_xcc_id() { return (unsigned)__builtin_amdgcn_s_getreg((3 << 11) | 20) & 0xFu; }
#define XB_SPIN(cond, bar) do { unsigned _sp = 0; while (cond) { __builtin_amdgcn_s_sleep(1); \
    if ((++_sp & 255u) == 0u) { if (xb_ld(&(bar)[XB_TMO])) break; if (_sp > XB_SPIN_CAP) { atomicAdd(&(bar)[XB_TMO], 1u); break; } } } } while (0)
struct XcdBarrier { unsigned* bar; unsigned x; volatile LAS3 unsigned* st; int wv; };
__device__ __forceinline__ XcdBarrier xcd_barrier_post(unsigned* bar, volatile LAS3 unsigned* st, int wv) {
    XcdBarrier b; b.bar = bar; b.x = xb_xcc_id(); b.st = st; b.wv = wv;
    if (tid_opaque(wv) == 0) (void)xb_add(&bar[XB_XCNT(b.x)], 1u);
    return b;
}
__device__ __forceinline__ void xcd_barrier_complete(unsigned* bar, unsigned x, unsigned& nloc, unsigned& nx) {
    const unsigned G = gridDim.x * gridDim.y * gridDim.z;
    unsigned sum, cnt, mine, sp = 0u;
    for (;;) {
        sum = 0u; cnt = 0u; mine = 0u;
#pragma unroll
        for (unsigned j = 0; j < 16; ++j) { const unsigned c = xb_ld(&bar[XB_XCNT(j)]); sum += c; cnt += (c > 0u) ? 1u : 0u; mine = (j == x) ? c : mine; }
        if (sum == G) break;
        __builtin_amdgcn_s_sleep(1);
        if ((++sp & 255u) == 0u) { if (xb_ld(&bar[XB_TMO])) break; if (sp > XB_SPIN_CAP) { atomicAdd(&bar[XB_TMO], 1u); break; } }
    }
    nloc = mine > 0u ? mine : 1u; nx = cnt > 0u ? cnt : 1u;
}
__device__ __forceinline__ void xcd_barrier(const XcdBarrier& b) {
    asm volatile("s_waitcnt vmcnt(0)" ::: "memory");
    __syncthreads();
    if (tid_opaque(b.wv) == 0) {
        unsigned* bar = b.bar;
        __builtin_amdgcn_s_waitcnt(0);
        unsigned nloc = b.st[0], nx = b.st[1];
        if (nloc == 0u) { xcd_barrier_complete(bar, b.x, nloc, nx); b.st[0] = nloc; b.st[1] = nx; }
        const unsigned old = xb_add(&bar[XB_XSUB(b.x)], 1u);
        const unsigned gen = old / nloc;
        if (old + 1u == (gen + 1u) * nloc) {
            __builtin_amdgcn_fence(__ATOMIC_RELEASE, "agent");
            asm volatile("s_waitcnt vmcnt(0)" ::: "memory");
            const unsigned og = xb_add(&bar[XB_TOP], 1u);
            const unsigned tg = og / nx;
            if (og + 1u == (tg + 1u) * nx) xb_add(&bar[XB_TOPGEN], 1u);
            else XB_SPIN(xb_ld(&bar[XB_TOPGEN]) == tg, bar);
            __builtin_amdgcn_fence(__ATOMIC_ACQUIRE, "agent");
            xb_add(&bar[XB_XGEN(b.x)], 1u);
            asm volatile("s_waitcnt vmcnt(0)" ::: "memory");
        } else {
            XB_SPIN(xb_ld(&bar[XB_XGEN(b.x)]) == gen, bar);
            __builtin_amdgcn_fence(__ATOMIC_ACQUIRE, "agent");
            asm volatile("s_waitcnt vmcnt(0)" ::: "memory");
        }
    }
    __syncthreads();
}

namespace pg8 {
#define PG8_LAS __attribute__((address_space(3)))
typedef short bf16x8 __attribute__((ext_vector_type(8)));
typedef int v8i __attribute__((ext_vector_type(8)));
typedef int v4i __attribute__((ext_vector_type(4)));
typedef short s16x16 __attribute__((ext_vector_type(16)));
constexpr int BM = 256, BK = 64, HALF = 128, HTB = HALF * BK * 2  , STAGE_BYTES = 8 * HTB, NXCD = 8, WGM = 8;
__device__ __forceinline__ int lds_byte(int r, int c) { const int st = (r >> 4) * 2 + (c >> 5), rr = r & 15, cc = c & 31, ob = rr * 64 + cc * 2; return st * 1024 + (ob ^ (((ob >> 9) & 1) << 5)); }
__device__ __forceinline__ void stage_rc(int b, int& R, int& C) { const int st = b / 1024, sb = b % 1024, swz = sb ^ (((sb >> 9) & 1) << 5); R = (st >> 1) * 16 + swz / 64; C = (st & 1) * 32 + (swz % 64) / 2; }
__device__ __forceinline__ int perm32(int rho) { const int n = rho >> 4, i = rho & 15; return 8 * (i >> 2) + 4 * n + (i & 3); }

constexpr int PAR_BASE = 131072, PAR_BUF = 4096, PAR_IDX = 0, PAR_W = 1024, PAR_BIAS = 2048, PAR_TAB = PAR_BASE + 2 * PAR_BUF;
typedef short s16x2 __attribute__((ext_vector_type(2)));
__device__ __forceinline__ int par_i32(PG8_LAS unsigned char* p) { return __builtin_bit_cast(int, *(const PG8_LAS s16x2*)p); }
__device__ __forceinline__ float par_f32(PG8_LAS unsigned char* p) { return __builtin_bit_cast(float, *(const PG8_LAS s16x2*)p); }
__device__ __forceinline__ f32x4 par_f32x4(PG8_LAS unsigned char* p) { return __builtin_bit_cast(f32x4, *(const PG8_LAS bf16x8*)p); }
struct Unit { int pm, pn, e; };
struct Gemm { const bf16_t* A; const bf16_t* Bt; int K; size_t bstride; const int* eslot; const PG8_LAS int* sb; int wv; };

struct StaticOrder {
    int nM, nN, nwg, G, c; const PG8_LAS int* sbase;
    __device__ void init(int M, int N, int G_, int c_, const PG8_LAS int* sb) { nM = M / BM; nN = N / BM; nwg = nM * nN; G = G_; c = c_; sbase = sb; }
    __device__ bool next(int i, Unit& u) const {
        const long Lx = (long)i * G + c; if (Lx >= nwg) return false;
        int wgid = (int)Lx; { const int q = nwg / NXCD, r = nwg % NXCD, xcd = wgid % NXCD, off = wgid / NXCD; wgid = (xcd < r ? xcd * (q + 1) : r * (q + 1) + (xcd - r) * q) + off; }
        const int nig = WGM * nN, gid = wgid / nig, fm = gid * WGM, gsz = (nM - fm) < WGM ? (nM - fm) : WGM;
        u.pm = fm + ((wgid % nig) % gsz); u.pn = (wgid % nig) / gsz; u.e = 0;
        if (sbase) { const int row = u.pm * BM; const int l = lane_id();
            const bool ge = (l >= 1) && (l < 32) && (row >= sbase[l & 31]);
            u.e = __builtin_popcountll(__ballot(ge)); }
        return true;
    }
};

template <class Epi, class Sched, bool GATHER, bool ALIGN_EPI, bool FP8 = false>
__device__ __forceinline__ void gemm_phase(PG8_LAS unsigned char* lds, const Gemm g, const Sched& S, const Epi& E) {
    const int tid = tid_opaque(g.wv), wid = g.wv,
              lane = tid & 63, wr = wid >> 2, wc = wid & 3, fr = lane & 15, fq = lane >> 4;
    const int K = g.K, nt = K / BK;
    unsigned voffA[2], voffB[2];
#pragma unroll
    for (int i = 0; i < 2; ++i) { const int R = 8 * (wid + 8 * i) + (lane >> 3), Sb = (((lane & 7) ^ (lane >> 3)) * 16); const int Rb = Epi::PERM ? ((R & ~31) + perm32(R & 31)) : R;
        voffA[i] = (unsigned)(R * K * 2 + Sb); voffB[i] = (unsigned)(Rb * K * 2 + Sb); }
    const size_t kstep = (size_t)(BK * 2);
    const size_t hstep = (size_t)HALF * K * 2;
    const size_t tstep = 2 * hstep;
    const unsigned ldsw = (unsigned)wid * 1024u;
    const int fsw0 = (fr & 7) * 128 + ((fq ^ (fr & 7)) * 16), fsw1 = (fr & 7) * 128 + (((fq + 4) ^ (fr & 7)) * 16);
    const int aoff0 = (wr * 8 + (fr >> 3)) * 1024 + fsw0, aoff1 = (wr * 8 + (fr >> 3)) * 1024 + fsw1, boff0 = (wc * 4 + (fr >> 3)) * 1024 + fsw0, boff1 = (wc * 4 + (fr >> 3)) * 1024 + fsw1;
#define PG8_SA(b, h) (((b) * 2 + (h)) * HTB)
#define PG8_SB(b, h) ((4 + (b) * 2 + (h)) * HTB)
#define PG8_STAGE(bufoff, gbase, voff) do { _Pragma("unroll") for (int _i = 0; _i < 2; ++_i) \
        __builtin_amdgcn_global_load_lds((const unsigned*)((const char*)(gbase) + (voff)[_i]), (PG8_LAS unsigned*)(lds + (bufoff) + ldsw + _i * 8192), 16, 0, 0); } while (0)
#define PG8_CAT(lo_, hi_) __builtin_bit_cast(v8i, __builtin_shufflevector((lo_), (hi_), 0, 1, 2, 3, 4, 5, 6, 7, 8, 9, 10, 11, 12, 13, 14, 15))
#define PG8_LDA(dst, b, h) do { _Pragma("unroll") for (int m = 0; m < 4; ++m) { \
        const bf16x8 f0_ = *(const PG8_LAS bf16x8*)(lds + PG8_SA(b, h) + aoff0 + m * 2048), f1_ = *(const PG8_LAS bf16x8*)(lds + PG8_SA(b, h) + aoff1 + m * 2048); \
        if constexpr (FP8) dst##8[m] = PG8_CAT(f0_, f1_); else { dst[m][0] = f0_; dst[m][1] = f1_; } } } while (0)
#define PG8_LDB(dst, b, h) do { _Pragma("unroll") for (int n = 0; n < 2; ++n) { \
        const bf16x8 f0_ = *(const PG8_LAS bf16x8*)(lds + PG8_SB(b, h) + boff0 + n * 2048), f1_ = *(const PG8_LAS bf16x8*)(lds + PG8_SB(b, h) + boff1 + n * 2048); \
        if constexpr (FP8) dst##8[n] = PG8_CAT(f0_, f1_); else { dst[n][0] = f0_; dst[n][1] = f1_; } } } while (0)
#define PG8_MMA(ai, bj, At, Bt) do { __builtin_amdgcn_s_setprio(1); _Pragma("unroll") for (int m = 0; m < 4; ++m) _Pragma("unroll") for (int n = 0; n < 2; ++n) { \
        if constexpr (FP8) asm volatile("v_mfma_scale_f32_16x16x128_f8f6f4 %0, %1, %2, %0, %3, %3 op_sel_hi:[0,0,0]" : "+v"(acc[ai][bj][m][n]) : "v"(Bt##8[n]), "v"(At##8[m]), "v"(one_scale)); \
        else { _Pragma("unroll") for (int k = 0; k < 2; ++k) acc[ai][bj][m][n] = __builtin_amdgcn_mfma_f32_16x16x32_bf16(Bt[n][k], At[m][k], acc[ai][bj][m][n], 0, 0, 0); } } \
        __builtin_amdgcn_s_setprio(0); } while (0)
#define PG8_WAIT_V(n) asm volatile("s_waitcnt vmcnt(" #n ")" ::: "memory")
#define PG8_WAIT_L(n) asm volatile("s_waitcnt lgkmcnt(" #n ")" ::: "memory")
#define PG8_BAR __builtin_amdgcn_s_barrier()
#define PG8_SCHED __builtin_amdgcn_sched_barrier(0)
#define PG8_SETOFF(off, pbuf_) do { _Pragma("unroll") for (int _h = 0; _h < 2; ++_h) _Pragma("unroll") for (int _i = 0; _i < 2; ++_i) { \
        if (GATHER) { const int R_ = 8 * (wid + 8 * _i) + (lane >> 3); \
            off[_h][_i] = (unsigned)(par_i32(lds + PAR_BASE + (pbuf_) * PAR_BUF + PAR_IDX + (_h * HALF + R_) * 4) >> 2) * (unsigned)(K * 2) + (unsigned)(((lane & 7) ^ (lane >> 3)) * 16); } \
        else off[_h][_i] = voffA[_i] + (unsigned)(_h * hstep); } } while (0)
#define PG8_IDXDMA(u, pbuf_) do { if (GATHER && wid < 4) { int rk_ = (u).pm * BM + wid * 64 + lane - g.sb[(u).e]; const int cm_ = g.sb[40 + (u).e] - 1; rk_ = rk_ < cm_ ? rk_ : cm_; \
        __builtin_amdgcn_global_load_lds((const unsigned*)(g.eslot + (size_t)(u).e * ECAP + rk_), (PG8_LAS unsigned*)(lds + PAR_BASE + (pbuf_) * PAR_BUF + PAR_IDX + wid * 256), 4, 0, 0); } } while (0)
    Unit cur, nxt; int ui = 0;
    if (!S.next(0, cur)) return;
    PG8_IDXDMA(cur, 0); E.prefetch(cur, 0, lds, wid, lane);
    PG8_WAIT_V(0); PG8_BAR;
    f32x4 acc[2][2][4][2];
#pragma unroll
    for (int a = 0; a < 2; ++a)
#pragma unroll
        for (int b = 0; b < 2; ++b)
#pragma unroll
            for (int m = 0; m < 4; ++m)
#pragma unroll
                for (int n = 0; n < 2; ++n) acc[a][b][m][n] = (f32x4){0.f, 0.f, 0.f, 0.f};
    bf16x8 At[4][2], B0[2][2], B1[2][2];
    v8i At8[4], B08[2], B18[2];
    const int one_scale = 0x7f7f7f7f;
    unsigned offc[2][2], offn[2][2];
    PG8_SETOFF(offc, 0);
    const char* cA = GATHER ? (const char*)g.A : (const char*)g.A + (size_t)cur.pm * tstep;
    const char* cB = (const char*)g.Bt + (size_t)cur.e * g.bstride + (size_t)cur.pn * tstep;
    PG8_STAGE(PG8_SB(0, 0), cB, voffB); PG8_STAGE(PG8_SB(0, 1), cB + hstep, voffB); PG8_STAGE(PG8_SA(0, 0), cA, offc[0]); PG8_STAGE(PG8_SA(0, 1), cA, offc[1]);
    if (wr == 1) PG8_BAR;
    PG8_WAIT_V(2); PG8_BAR;
    PG8_STAGE(PG8_SB(1, 0), cB + kstep, voffB); PG8_STAGE(PG8_SA(1, 0), cA + kstep, offc[0]); PG8_STAGE(PG8_SB(1, 1), cB + hstep + kstep, voffB);
    PG8_WAIT_V(6); PG8_BAR;
    for (;;) {
        const bool has_next = S.next(ui + 1, nxt);
        const char* nA = GATHER ? cA : (has_next ? (const char*)g.A + (size_t)nxt.pm * tstep : cA);
        const char* nB = has_next ? (const char*)g.Bt + (size_t)nxt.e * g.bstride + (size_t)nxt.pn * tstep : cB;

        if constexpr (Epi::MIDSCALE) E.begin(cur, ui, lds, tid);
#pragma unroll 1
        for (int t = 0; t < nt; t += 2) {
            const bool last = (t == nt - 2);
            if constexpr (Epi::MIDSCALE) { if (t == nt / 2) E.mid(acc, ui, wr, fr, lds); }
            if (t == 2 && has_next) { PG8_IDXDMA(nxt, (ui + 1) & 1); E.prefetch(nxt, (ui + 1) & 1, lds, wid, lane); }
            if (GATHER && last) { if (has_next) { PG8_SETOFF(offn, (ui + 1) & 1); } else {
#pragma unroll
                for (int h = 0; h < 2; ++h)
#pragma unroll
                    for (int i = 0; i < 2; ++i) offn[h][i] = offc[h][i]; } }
            const char* a1 = cA + (size_t)(t + 1) * kstep;
            const char* a2 = last ? nA : cA + (size_t)(t + 2) * kstep; const char* b2 = last ? nB : cB + (size_t)(t + 2) * kstep;
            const char* a3 = a2 + kstep; const char* b3 = b2 + kstep;
            unsigned o2[2][2];
#pragma unroll
            for (int h = 0; h < 2; ++h)
#pragma unroll
                for (int i = 0; i < 2; ++i) o2[h][i] = (GATHER && last) ? offn[h][i] : offc[h][i];
            PG8_LDB(B0, 0, 0); PG8_LDB(B1, 0, 1); PG8_SCHED; PG8_LDA(At, 0, 0); PG8_STAGE(PG8_SA(1, 1), a1, offc[1]);
            PG8_WAIT_V(8); PG8_WAIT_L(0); PG8_BAR; PG8_MMA(0, 0, At, B0); PG8_MMA(0, 1, At, B1); PG8_BAR; PG8_SCHED;
            PG8_LDA(At, 0, 1); PG8_STAGE(PG8_SB(0, 0), b2, voffB); PG8_STAGE(PG8_SB(0, 1), b2 + hstep, voffB); PG8_STAGE(PG8_SA(0, 0), a2, o2[0]);
            PG8_WAIT_V(8); PG8_WAIT_L(0); PG8_BAR; PG8_MMA(1, 0, At, B0); PG8_MMA(1, 1, At, B1); PG8_BAR; PG8_SCHED;
            PG8_LDB(B0, 1, 0); PG8_LDB(B1, 1, 1); PG8_SCHED; PG8_LDA(At, 1, 0); PG8_STAGE(PG8_SA(0, 1), a2, o2[1]);
            PG8_WAIT_V(8); PG8_WAIT_L(0); PG8_BAR; PG8_MMA(0, 0, At, B0); PG8_MMA(0, 1, At, B1); PG8_BAR; PG8_SCHED;
            PG8_LDA(At, 1, 1); PG8_STAGE(PG8_SB(1, 0), b3, voffB); PG8_STAGE(PG8_SB(1, 1), b3 + hstep, voffB); PG8_STAGE(PG8_SA(1, 0), a3, o2[0]);
            PG8_WAIT_V(8); PG8_WAIT_L(0); PG8_BAR; PG8_MMA(1, 0, At, B0); PG8_MMA(1, 1, At, B1); PG8_BAR; PG8_SCHED;
        }
        if constexpr (ALIGN_EPI) { if (wr == 0) PG8_BAR; }
        if constexpr (FP8) asm volatile("s_nop 15\n\ts_nop 15" ::: "memory");
        E(acc, cur, ui, wr, wc, fr, fq, lds);
        if (!has_next) break;
#pragma unroll
        for (int a = 0; a < 2; ++a)
#pragma unroll
            for (int b = 0; b < 2; ++b)
#pragma unroll
                for (int m = 0; m < 4; ++m)
#pragma unroll
                    for (int n = 0; n < 2; ++n) acc[a][b][m][n] = (f32x4){0.f, 0.f, 0.f, 0.f};
        cur = nxt; cA = nA; cB = nB; ++ui;
#pragma unroll
        for (int h = 0; h < 2; ++h)
#pragma unroll
            for (int i = 0; i < 2; ++i) offc[h][i] = offn[h][i];
        if constexpr (ALIGN_EPI) { if (wr == 1) PG8_BAR; }
    }
    PG8_WAIT_V(0);
    if constexpr (!ALIGN_EPI) { if (wr == 0) PG8_BAR; }
    PG8_BAR;
#undef PG8_SA
#undef PG8_SB
#undef PG8_STAGE
#undef PG8_LDA
#undef PG8_LDB
#undef PG8_MMA
#undef PG8_WAIT_V
#undef PG8_WAIT_L
#undef PG8_BAR
#undef PG8_SCHED
#undef PG8_SETOFF
#undef PG8_IDXDMA
#undef PG8_CAT
}

struct EpiQKV {
    static constexpr bool MIDSCALE = false, PERM = false;
    bf16_t* O;
    __device__ __forceinline__ void prefetch(const Unit&, int, PG8_LAS unsigned char*, int, int) const {}
    __device__ __forceinline__ void operator()(const f32x4 (&acc)[2][2][4][2], const Unit& u, int ui, int wr, int wc, int fr, int fq, PG8_LAS unsigned char* lds) const {
        const bool latent = u.pm < NTOK / BM;
#pragma unroll
        for (int ai = 0; ai < 2; ++ai)
#pragma unroll
            for (int m = 0; m < 4; ++m) {
                const int row = u.pm * BM + ai * HALF + wr * 64 + m * 16 + fr;
                bf16_t* rowp = O + (size_t)row * INW + u.pn * BM + wc * 32 + 4 * fq;
                const int pos = row & (L - 1), pp = (wc & 1) ? (pos & 63) : (pos >> 6);
                PG8_LAS unsigned char* tp = lds + PAR_TAB + (pp * 16 + 4 * fq) * 8;
#pragma unroll
                for (int bj = 0; bj < 2; ++bj) {
                    const int colbase = u.pn * BM + bj * HALF;
                    f32x4 v0 = acc[ai][bj][m][0], v1 = acc[ai][bj][m][1];
                    if (latent && colbase < C_VA) {
                        const f32x4 t0 = par_f32x4(tp), t1 = par_f32x4(tp + 16);
                        const f32x4 cs = {t0.x, t0.z, t1.x, t1.z}, sn = {t0.y, t0.w, t1.y, t1.w};
                        const f32x4 a0 = v0 * cs - v1 * sn, a1 = v1 * cs + v0 * sn; v0 = a0; v1 = a1;
                    }
                    if (colbase < C_KA || (colbase >= C_QB && colbase < C_KB)) { v0 = v0 * QSCALE; v1 = v1 * QSCALE; }
                    u32x2 w0, w1; w0.x = pk2(v0.x, v0.y); w0.y = pk2(v0.z, v0.w); w1.x = pk2(v1.x, v1.y); w1.y = pk2(v1.z, v1.w);
                    *(u32x2*)(rowp + bj * HALF) = w0; *(u32x2*)(rowp + bj * HALF + 16) = w1;
                }
            }
    }
};
struct EpiOutProj {
    static constexpr bool PERM = true, MIDSCALE = true;
    bf16_t* O; const float* oss;
    __device__ __forceinline__ void prefetch(const Unit&, int, PG8_LAS unsigned char*, int, int) const {}
    __device__ __forceinline__ void begin(const Unit& u, int ui, PG8_LAS unsigned char* lds, int tid) const {
        if (tid < 256) { const f32x4* sp = (const f32x4*)(oss + (size_t)(u.pm * BM + tid) * 16); const f32x4 a0 = sp[0], a1 = sp[1], b0 = sp[2], b1 = sp[3];
            const float sa = ((a0.x + a0.y) + (a0.z + a0.w)) + ((a1.x + a1.y) + (a1.z + a1.w)), sb = ((b0.x + b0.y) + (b0.z + b0.w)) + ((b1.x + b1.y) + (b1.z + b1.w));
            const float ra = rsqrtf(sa * (1.f / 512.f) + EPS), rb = rsqrtf(sb * (1.f / 512.f) + EPS);
            typedef float f2 __attribute__((ext_vector_type(2)));
            *(PG8_LAS f2*)(lds + 131072 + (ui & 1) * 2048 + tid * 8) = (f2){ra / rb, rb}; }
    }
    __device__ __forceinline__ void mid(f32x4 (&acc)[2][2][4][2], int ui, int wr, int fr, PG8_LAS unsigned char* lds) const {
#pragma unroll
        for (int ai = 0; ai < 2; ++ai)
#pragma unroll
            for (int m = 0; m < 4; ++m) { const float r = *(const PG8_LAS float*)(lds + 131072 + (ui & 1) * 2048 + (ai * HALF + wr * 64 + m * 16 + fr) * 8);
#pragma unroll
                for (int bj = 0; bj < 2; ++bj)
#pragma unroll
                    for (int n = 0; n < 2; ++n) acc[ai][bj][m][n] = acc[ai][bj][m][n] * r; }
    }
    __device__ __forceinline__ void operator()(const f32x4 (&acc)[2][2][4][2], const Unit& u, int ui, int wr, int wc, int fr, int fq, PG8_LAS unsigned char* lds) const {
#pragma unroll
        for (int ai = 0; ai < 2; ++ai)
#pragma unroll
            for (int m = 0; m < 4; ++m) {
                const int rl = ai * HALF + wr * 64 + m * 16 + fr;
                const float rb = *(const PG8_LAS float*)(lds + 131072 + (ui & 1) * 2048 + rl * 8 + 4);
                bf16_t* rowp = O + (size_t)(u.pm * BM + rl) * D + u.pn * BM + wc * 32 + 8 * fq;
#pragma unroll
                for (int bj = 0; bj < 2; ++bj) { const f32x4 v0 = acc[ai][bj][m][0] * rb, v1 = acc[ai][bj][m][1] * rb;
                    u32x4 o; o.x = pk2(v0.x, v0.y); o.y = pk2(v0.z, v0.w); o.z = pk2(v1.x, v1.y); o.w = pk2(v1.z, v1.w);
                    *(u32x4*)(rowp + bj * HALF) = o; }
            }
    }
};
struct EpiSwiglu {
    static constexpr bool MIDSCALE = false, PERM = false;
    unsigned char* act; const float* b1;
    __device__ __forceinline__ void prefetch(const Unit& u, int pb, PG8_LAS unsigned char* lds, int wid, int lane) const {
        if (wid == 4) __builtin_amdgcn_global_load_lds((const unsigned*)(b1 + (size_t)u.e * 2048 + u.pn * BM + lane * 4), (PG8_LAS unsigned*)(lds + PAR_BASE + pb * PAR_BUF + PAR_BIAS), 16, 0, 0);
    }
    __device__ __forceinline__ void operator()(const f32x4 (&acc)[2][2][4][2], const Unit& u, int ui, int wr, int wc, int fr, int fq, PG8_LAS unsigned char* lds) const {
#pragma unroll
        for (int bj = 0; bj < 2; ++bj) {
            const int f0 = 16 * (8 * u.pn + 4 * bj + wc) + 4 * fq;
            PG8_LAS unsigned char* bp = lds + PAR_BASE + (ui & 1) * PAR_BUF + PAR_BIAS + (128 * bj + 32 * wc + 8 * fq) * 4; const f32x4 bA = par_f32x4(bp), bB = par_f32x4(bp + 16);
            const f32x4 bg = {bA.x, bA.z, bB.x, bB.z}, bl = {bA.y, bA.w, bB.y, bB.w};
#pragma unroll
            for (int ai = 0; ai < 2; ++ai)
#pragma unroll
                for (int m = 0; m < 4; ++m) {
                    const int row = u.pm * BM + ai * HALF + wr * 64 + m * 16 + fr;
                    const f32x4 gt = acc[ai][bj][m][0] * W8_INV + bg, ln = acc[ai][bj][m][1] * W8_INV + bl; float a[4];
#pragma unroll
                    for (int j = 0; j < 4; ++j) { const float gg = fminf(gt[j], 7.f), ll = fminf(fmaxf(ln[j], -7.f), 7.f);
                        a[j] = gg * __builtin_amdgcn_rcpf(1.f + __expf(-1.702f * gg)) * (ll + 1.f); }
                    *(unsigned*)(act + (size_t)row * D + f0) = pk4_fp8(a[0], a[1], a[2], a[3]);
                }
        }
    }
};
struct EpiScatter {
    static constexpr bool MIDSCALE = false, PERM = true;
    unsigned char* y; const float* b2; const int* eslot; const float* ew; const PG8_LAS int* sb;
    __device__ __forceinline__ void prefetch(const Unit& u, int pb, PG8_LAS unsigned char* lds, int wid, int lane) const {
        const int w4 = wid & 3; int rk = u.pm * BM + w4 * 64 + lane - sb[u.e]; const int cm = sb[40 + u.e] - 1; rk = rk < cm ? rk : cm;
        const size_t gi = (size_t)u.e * ECAP + rk;
        if (wid < 4) __builtin_amdgcn_global_load_lds((const unsigned*)(eslot + gi), (PG8_LAS unsigned*)(lds + PAR_BASE + pb * PAR_BUF + PAR_IDX + w4 * 256), 4, 0, 0);
        else         __builtin_amdgcn_global_load_lds((const unsigned*)(ew + gi), (PG8_LAS unsigned*)(lds + PAR_BASE + pb * PAR_BUF + PAR_W + w4 * 256), 4, 0, 0);
        if (wid == 0) __builtin_amdgcn_global_load_lds((const unsigned*)(b2 + (size_t)u.e * D + u.pn * BM + lane * 4), (PG8_LAS unsigned*)(lds + PAR_BASE + pb * PAR_BUF + PAR_BIAS), 16, 0, 0);
    }
    __device__ __forceinline__ void operator()(const f32x4 (&acc)[2][2][4][2], const Unit& u, int ui, int wr, int wc, int fr, int fq, PG8_LAS unsigned char* lds) const {
        PG8_LAS unsigned char* par = lds + PAR_BASE + (ui & 1) * PAR_BUF;
        const int col0 = u.pn * BM + wc * 32 + 8 * fq;
        f32x4 bv[2][2];
#pragma unroll
        for (int bj = 0; bj < 2; ++bj)
#pragma unroll
            for (int n = 0; n < 2; ++n) bv[bj][n] = par_f32x4(par + PAR_BIAS + (wc * 32 + 8 * fq + bj * HALF + 4 * n) * 4);
        const int rbase = u.pm * BM - sb[u.e], cn = sb[40 + u.e];
#pragma unroll
        for (int ai = 0; ai < 2; ++ai)
#pragma unroll
            for (int m = 0; m < 4; ++m) {
                const int rl = ai * HALF + wr * 64 + m * 16 + fr;
                const int slot = par_i32(par + PAR_IDX + rl * 4); const float w = par_f32(par + PAR_W + rl * 4) * Y8_SCALE;
                if (rbase + rl < cn) {
                    unsigned char* rowp = y + (size_t)slot * D + col0;
#pragma unroll
                    for (int bj = 0; bj < 2; ++bj) { const f32x4 v0 = (acc[ai][bj][m][0] * W8_INV + bv[bj][0]) * w, v1 = (acc[ai][bj][m][1] * W8_INV + bv[bj][1]) * w;
                        u32x2 o; o.x = pk4_fp8(v0.x, v0.y, v0.z, v0.w); o.y = pk4_fp8(v1.x, v1.y, v1.z, v1.w);
                        *(u32x2*)(rowp + bj * HALF) = o; }
                }
            }
    }
};
}

__device__ void p0_mod(const Params& p, float* sS  , float* sP  , int wv) {
    float* mod = (float*)(p.ws + WS_MOD);
    const int tid = tid_opaque(wv), lane = tid & 63, wave = wv;
    if (blockIdx.x >= 96) return;
    for (int i = tid; i < 9 * D; i += NTHREADS) { const int r = i >> 10, k = i & 1023; const float cc = r < 8 ? p.c[r * D + k] : p.c_ctx[k]; sS[i] = cc / (1.f + __expf(-cc)); }
    __syncthreads();
    const int j = blockIdx.x * 64 + lane;
    float acc[9];
#pragma unroll
    for (int r = 0; r < 9; ++r) acc[r] = 0.f;
    const float* wp = p.w_ada + (size_t)(wave * 128) * 6144 + j;
#pragma unroll 1
    for (int k0 = 0; k0 < 128; k0 += 16) {
        float w[16];
#pragma unroll
        for (int kk = 0; kk < 16; ++kk) w[kk] = wp[(size_t)(k0 + kk) * 6144];
#pragma unroll
        for (int kk = 0; kk < 16; ++kk)
#pragma unroll
            for (int r = 0; r < 9; ++r) acc[r] = fmaf(sS[r * D + wave * 128 + k0 + kk], w[kk], acc[r]);
    }
#pragma unroll
    for (int r = 0; r < 9; ++r) sP[(wave * 9 + r) * 64 + lane] = acc[r];
    __syncthreads();
    for (int i = tid; i < 9 * 64; i += NTHREADS) { const int r = i >> 6, jj = i & 63; float s = p.b_ada[blockIdx.x * 64 + jj];
#pragma unroll
        for (int w = 0; w < 8; ++w) s += sP[(w * 9 + r) * 64 + jj];
        mod[r * 6144 + blockIdx.x * 64 + jj] = s; }
    __syncthreads();
}
__device__ void p0_tab(const Params& p, int wv) {
    float* tab = (float*)(p.ws + WS_TAB);
    const int gtid = blockIdx.x * NTHREADS + tid_opaque(wv), gsize = gridDim.x * NTHREADS;
    for (int idx = gtid; idx < 64 * 16; idx += gsize) {
        const int pos = idx >> 4, i = idx & 15;
        const float freq = exp2f(-(float)i * (13.287712379549449f / 16.f));
        const float ang = (float)pos * freq;
        const float n = rintf(ang * 0.15915494309189535f);
        float r = fmaf(-n, 6.28125f, ang); r = fmaf(-n, 1.9353071795864769e-3f, r);
        tab[idx * 2] = __cosf(r); tab[idx * 2 + 1] = __sinf(r);
    }
}
template <int MODE>
__device__ __forceinline__ void conv_item(const float* src, int K, int N, bf16_t* dst, int item, float* scr, int lane, const float* gA, const float* gB) {
    const int nblk = N / 32, kb = item / nblk, nb = item % nblk, k0 = 64 * kb, n0 = 32 * nb;
    const int c = lane & 31, kh = lane >> 5;
    const int nl = MODE == 1 ? 16 * (c & 1) + (c >> 1) : c;
    float v[32];
    const float* sp = src + (size_t)(k0 + kh) * N + n0 + c;
#pragma unroll
    for (int i = 0; i < 32; ++i) v[i] = sp[(size_t)(2 * i) * N];
#pragma unroll
    for (int i = 0; i < 32; ++i) { float x = v[i]; if (MODE == 2) { const int k = k0 + 2 * i + kh; x *= (k < 512 ? gA[k] : gB[k - 512]); } scr[(2 * i + kh) * 33 + nl] = x; }
    asm volatile("s_waitcnt lgkmcnt(0)" ::: "memory");
    const int ch = lane & 7;
#pragma unroll
    for (int j = 0; j < 4; ++j) { const int n = (lane >> 3) + 8 * j; const float* s = scr + (8 * ch) * 33 + n;
        u32x4 o; o.x = pk2(s[0 * 33], s[1 * 33]); o.y = pk2(s[2 * 33], s[3 * 33]); o.z = pk2(s[4 * 33], s[5 * 33]); o.w = pk2(s[6 * 33], s[7 * 33]);
        *(u32x4*)(dst + (size_t)(n0 + n) * K + k0 + 8 * ch) = o; }
    asm volatile("s_waitcnt lgkmcnt(0)" ::: "memory");
}
template <bool PERM1>
__device__ __forceinline__ void conv_item8(const float* src, int K, int N, unsigned char* dst, int item, float* scr, int lane) {
    const int nblk = N / 32, kb = item / nblk, nb = item % nblk, k0 = 64 * kb, n0 = 32 * nb;
    const int c = lane & 31, kh = lane >> 5;
    const int nl = PERM1 ? 16 * (c & 1) + (c >> 1) : c;
    float v[32];
    const float* sp = src + (size_t)(k0 + kh) * N + n0 + c;
#pragma unroll
    for (int i = 0; i < 32; ++i) v[i] = sp[(size_t)(2 * i) * N];
#pragma unroll
    for (int i = 0; i < 32; ++i) scr[(2 * i + kh) * 33 + nl] = v[i] * W8_SCALE;
    asm volatile("s_waitcnt lgkmcnt(0)" ::: "memory");
    const int ch = lane & 3;
#pragma unroll
    for (int j = 0; j < 2; ++j) { const int n = (lane >> 2) + 16 * j; const float* s = scr + (16 * ch) * 33 + n;
        u32x4 o; o.x = pk4_fp8(s[0 * 33], s[1 * 33], s[2 * 33], s[3 * 33]); o.y = pk4_fp8(s[4 * 33], s[5 * 33], s[6 * 33], s[7 * 33]);
        o.z = pk4_fp8(s[8 * 33], s[9 * 33], s[10 * 33], s[11 * 33]); o.w = pk4_fp8(s[12 * 33], s[13 * 33], s[14 * 33], s[15 * 33]);
        *(u32x4*)(dst + (size_t)(n0 + n) * K + k0 + 16 * ch) = o; }
    asm volatile("s_waitcnt lgkmcnt(0)" ::: "memory");
}
__device__ void p0_weights(const Params& p, unsigned char* ldsb, int wv) {
    const int tid = tid_opaque(wv), lane = tid & 63, wave = wv; float* scr = (float*)(ldsb + 57344 + wave * 8448);
    const int gw = blockIdx.x * (NTHREADS / 64) + wave, ngw = gridDim.x * (NTHREADS / 64);
    constexpr int I_IN = 16 * 72, I_OUT = 16 * 32, I_W1 = 16 * 64, I_W2 = 16 * 32;
    constexpr int NITEMS = I_IN + I_OUT + NE * I_W1 + NE * I_W2;
    for (int it = gw; it < NITEMS; it += ngw) {
        int r = it;
        if (r < I_IN) { conv_item<0>(p.w_in, D, INW, (bf16_t*)(p.ws + WS_WIN), r, scr, lane, nullptr, nullptr); continue; } r -= I_IN;
        if (r < I_OUT) { conv_item<2>(p.w_out, D, D, (bf16_t*)(p.ws + WS_WOUT), r, scr, lane, p.g_grp_a, p.g_grp_b); continue; } r -= I_OUT;
        if (r < NE * I_W1) { const int e = r / I_W1, q = r % I_W1;
            conv_item8<true>(p.w_mlp1 + (size_t)e * D * 2048, D, 2048, p.ws + WS_W1 + (size_t)e * 2048 * D, q, scr, lane); continue; } r -= NE * I_W1;
        { const int e = r / I_W2, q = r % I_W2;
            conv_item8<false>(p.w_mlp2 + (size_t)e * D * D, D, D, p.ws + WS_W2 + (size_t)e * D * D, q, scr, lane); }
    }
}

__device__ void p1_h(const Params& p, int wv) {
    const int tid = tid_opaque(wv), lane = tid & 63;
    const float* mod = (const float*)(p.ws + WS_MOD);
    bf16_t* hb = (bf16_t*)(p.ws + WS_HB);
    constexpr int R = 17;
    const int gwv = blockIdx.x * (NTHREADS / 64) + (tid >> 6);
    const int m0 = gwv * R; if (m0 >= MROWS) return;
    const int m1 = m0 + R < MROWS ? m0 + R : MROWS;
    f32x4 pB[4], pC[4], v[4], nv[4]; int curb = -1;
#define P1_ROWPTR(m) ((m) < NTOK ? p.x + (size_t)(m) * D : p.ctx + (size_t)((m) - NTOK) * D)
    { const float* xr = P1_ROWPTR(m0);
#pragma unroll
      for (int j = 0; j < 4; ++j) nv[j] = ((const f32x4*)xr)[lane + 64 * j]; }
    for (int m = m0; m < m1; ++m) {
#pragma unroll
        for (int j = 0; j < 4; ++j) v[j] = nv[j];
        if (m + 1 < m1) { const float* xr = P1_ROWPTR(m + 1);
#pragma unroll
            for (int j = 0; j < 4; ++j) nv[j] = ((const f32x4*)xr)[lane + 64 * j]; }
        const int b = m < NTOK ? m / L : 8;
        if (b != curb) { curb = b; const float* sh = mod + b * 6144, * sc = sh + 1024;
#pragma unroll
            for (int j = 0; j < 4; ++j) { const int c0 = 4 * (lane + 64 * j); pB[j] = *(const f32x4*)(p.g_pre_mix + c0) * (*(const f32x4*)(sc + c0) + 1.f); pC[j] = *(const f32x4*)(sh + c0); } }
        float s = 0.f;
#pragma unroll
        for (int j = 0; j < 4; ++j) s += v[j].x * v[j].x + v[j].y * v[j].y + v[j].z * v[j].z + v[j].w * v[j].w;
        const float rstd = rsqrtf(wave_sum(s) * (1.f / D) + EPS);
#pragma unroll
        for (int j = 0; j < 4; ++j) { const int c0 = 4 * (lane + 64 * j);
            const f32x4 o = (v[j] * rstd) * pB[j] + pC[j];
            u32x2 w; w.x = pk2(o.x, o.y); w.y = pk2(o.z, o.w);
            *(u32x2*)(hb + (size_t)m * D + c0) = w; }
    }
#undef P1_ROWPTR
}

namespace att {
#define ATT_LAS __attribute__((address_space(3)))
typedef float f32x16 __attribute__((ext_vector_type(16)));
typedef short bf16x8 __attribute__((ext_vector_type(8)));
typedef short s16x4 __attribute__((ext_vector_type(4)));
constexpr int SLOTB = 8192, NSLOT = 4;
constexpr int LDS_K = 0, LDS_V = NSLOT * SLOTB, LDS_WS = 2 * NSLOT * SLOTB, LDS_BT = LDS_WS + 8 * 256;
constexpr int BT_MARGIN = 64, BT_FLOATS = BT_MARGIN + 15 * 32 + 96;
constexpr float NEGBIG = -1e30f;
__device__ __forceinline__ int crow(int r, int hi) { return (r & 3) + 8 * (r >> 2) + 4 * hi; }
__device__ __forceinline__ unsigned cvtpk(float lo, float hi) { typedef float f2 __attribute__((ext_vector_type(2))); typedef __bf16 b2 __attribute__((ext_vector_type(2)));
    f2 v = {lo, hi}; b2 b = __builtin_convertvector(v, b2); return __builtin_bit_cast(unsigned, b); }
__device__ __forceinline__ s16x4 vtr(const ATT_LAS unsigned char* p) { typedef short v4i16 __attribute__((ext_vector_type(4)));
    return __builtin_bit_cast(s16x4, __builtin_amdgcn_ds_read_tr16_b64_v4i16((ATT_LAS v4i16*)p)); }
#define ATT_WAIT_BAR(N) asm volatile("s_waitcnt vmcnt(" #N ") lgkmcnt(0)\n\ts_barrier" ::: "memory")

__device__ __forceinline__ void dma_tile(ATT_LAS unsigned char* lds, int slot, const bf16_t* kbase, const bf16_t* vbase, int wid, int lane) {
    const bf16_t* ksrc = kbase + (size_t)lane * INW + wid * 8;
    const bf16_t* vsrc = vbase + (size_t)(16 * (wid & 3) + (lane >> 2)) * INW + (wid >> 2) * 32 + (lane & 3) * 8;
    __builtin_amdgcn_global_load_lds((const unsigned*)ksrc, (ATT_LAS unsigned*)(lds + LDS_K + slot * SLOTB + wid * 1024), 16, 0, 0);
    __builtin_amdgcn_global_load_lds((const unsigned*)vsrc, (ATT_LAS unsigned*)(lds + LDS_V + slot * SLOTB + wid * 1024), 16, 0, 0);
}

template <bool ISB>
__device__ __forceinline__ void attn_unit(const Params& p, ATT_LAS unsigned char* lds, int unit, int wv) {
    const int tid = tid_opaque(wv), lane = tid & 63, r32 = lane & 31, hi = lane >> 5; const int wid = wv;
    const bf16_t* qkv = (const bf16_t*)(p.ws + WS_QKV); bf16_t* ob = (bf16_t*)(p.ws + WS_O);
    ATT_LAS float* wsf = (ATT_LAS float*)(lds + LDS_WS) + wid * 64;
    ATT_LAS float* bt = (ATT_LAS float*)(lds + LDS_BT);
    int b, h, kcol, vcol, qcol, ocol, q0, nloc, row_lo = 0, qr = 0, half = 0, qb = 0, jlo = 0;
    if (!ISB) { b = unit >> 7; const int kvh = (unit >> 6) & 1; qb = unit & 63; h = kvh * 4 + (wid >> 1); half = wid & 1; q0 = qb * 64 + 32 * half;
        kcol = C_KA + kvh * 64; vcol = C_VA + kvh * 64; qcol = C_QA + h * 64; ocol = h * 64;
        jlo = 2 - qb > 0 ? 2 - qb : 0; const int jhi = 65 - qb < 4 ? 65 - qb : 4; nloc = jhi - jlo + 1;
    } else { b = unit >> 7; h = (unit >> 4) & 7; const int g = unit & 15; qr = 4 * g + (wid >> 1); half = wid & 1; q0 = qr * 64 + 32 * half;
        kcol = C_KB + h * 64; vcol = C_VB + h * 64; qcol = C_QB + h * 64; ocol = 512 + h * 64;
        const int r0 = 4 * g, r3 = 4 * g + 3; row_lo = r0 - 4 < 0 ? 0 : (r0 - 4 > 56 ? 56 : r0 - 4); const int rs3 = r3 - 4 < 0 ? 0 : (r3 - 4 > 56 ? 56 : r3 - 4); nloc = rs3 + 7 - row_lo + 1;
    }
    const int NT = nloc + 4;
    const bf16_t* lat = qkv + (size_t)b * L * INW; const bf16_t* cx = qkv + (size_t)(NTOK + b * CTX) * INW;
#define ATT_TILE_ROW(t) ((t) < nloc ? lat + (size_t)(ISB ? (row_lo + (t)) * 64 : (qb - 2 + jlo + (t)) * 64) * INW : cx + (size_t)((t) - nloc) * 64 * INW)
    if (ISB) {
        for (int i = tid; i < BT_FLOATS; i += NTHREADS) { const int j = i - BT_MARGIN; float v = 0.f;
            if (j >= 0 && j < 15 * 32 && (j & 31) < 31) v = p.rpb_b[(h * 15 + (j >> 5)) * 31 + (j & 31)] * LOG2E;
            bt[i] = v; }
    }
#pragma unroll
    for (int t0 = 0; t0 < NSLOT - 1; ++t0) { const bf16_t* r0p = ATT_TILE_ROW(t0); dma_tile(lds, t0, r0p + kcol, r0p + vcol, wid, lane); }
    bf16x8 qf[4];
    { const bf16_t* qp = lat + (size_t)(q0 + r32) * INW + qcol + hi * 8;
#pragma unroll
      for (int d0 = 0; d0 < 4; ++d0) qf[d0] = *(const bf16x8*)(qp + d0 * 16); }
    float m_run, l_run;
    if (!ISB) { m_run = p.sink_a[h] * LOG2E; l_run = hi == 0 ? 1.f : 0.f; } else { m_run = NEGBIG; l_run = 0.f; }
    f32x16 o0, o1;
#pragma unroll
    for (int r = 0; r < 16; ++r) { o0[r] = 0.f; o1[r] = 0.f; }
    const int qc = 32 * half + r32;
    const int cs = qc - 8 < 0 ? 0 : (qc - 8 > 48 ? 48 : qc - 8);
    const int rsq = qr - 4 < 0 ? 0 : (qr - 4 > 56 ? 56 : qr - 4);
    for (int t = 0; t < NT; ++t) {
        const int ahead = NT - 1 - t < NSLOT - 2 ? NT - 1 - t : NSLOT - 2;
        if (ahead == 2) ATT_WAIT_BAR(4); else if (ahead == 1) ATT_WAIT_BAR(2); else ATT_WAIT_BAR(0);
        if (t + NSLOT - 1 < NT) { const bf16_t* rp = ATT_TILE_ROW(t + NSLOT - 1); dma_tile(lds, (t + NSLOT - 1) & (NSLOT - 1), rp + kcol, rp + vcol, wid, lane); }
        const int slot = t & (NSLOT - 1);
        bool active = true; int kr = 0;
        if (ISB && t < nloc) { kr = row_lo + t; active = (kr >= rsq) && (kr <= rsq + 7); }
        if (active) {
            const ATT_LAS unsigned char* kb = lds + LDS_K + slot * SLOTB + hi * 1024 + r32 * 16;
            f32x16 p0, p1;
#pragma unroll
            for (int r = 0; r < 16; ++r) { p0[r] = 0.f; p1[r] = 0.f; }
#pragma unroll
            for (int d0 = 0; d0 < 4; ++d0) {
                const bf16x8 k0 = *(const ATT_LAS bf16x8*)(kb + d0 * 2048), k1 = *(const ATT_LAS bf16x8*)(kb + d0 * 2048 + 512);
                p0 = __builtin_amdgcn_mfma_f32_32x32x16_bf16(k0, qf[d0], p0, 0, 0, 0);
                p1 = __builtin_amdgcn_mfma_f32_32x32x16_bf16(k1, qf[d0], p1, 0, 0, 0);
            }
            if (ISB) {
                if (t < nloc) {
                    const ATT_LAS float* bp = bt + BT_MARGIN + (kr - qr + 7) * 32 + 15 - qc + 4 * hi;
                    const int e0 = 4 * hi - cs;
#pragma unroll
                    for (int r = 0; r < 16; ++r) { const int c = (r & 3) + 8 * (r >> 2);
                        const float b0 = bp[c], b1 = bp[c + 32];
                        p0[r] = ((unsigned)(c + e0) < 16u) ? p0[r] + b0 : NEGBIG;
                        p1[r] = ((unsigned)(c + 32 + e0) < 16u) ? p1[r] + b1 : NEGBIG; }
                }
            } else {
                if (t < nloc) { const int j = jlo + t; const int qq = 32 * half + r32;
                    if (j == 0) {
#pragma unroll
                        for (int r = 0; r < 16; ++r) { const int c = crow(r, hi); if (c < qq) p0[r] = NEGBIG; if (c + 32 < qq) p1[r] = NEGBIG; }
                    } else if (j == 4) {
#pragma unroll
                        for (int r = 0; r < 16; ++r) { const int c = crow(r, hi); if (c > qq) p0[r] = NEGBIG; if (c + 32 > qq) p1[r] = NEGBIG; }
                    }
                }
            }
            float rm = fmaxf(p0[0], p1[0]);
#pragma unroll
            for (int r = 1; r < 16; ++r) rm = fmaxf(rm, fmaxf(p0[r], p1[r]));
            rm = fmaxf(rm, __shfl_xor(rm, 32));
            const float mnew = fmaxf(m_run, rm);
            if (__any(mnew > m_run)) {
                const float f = __builtin_amdgcn_exp2f(m_run - mnew);
                l_run *= f; m_run = mnew;
                if (hi == 0) wsf[r32] = f;
                asm volatile("s_waitcnt lgkmcnt(0)" ::: "memory");
#pragma unroll
                for (int r = 0; r < 16; ++r) { const float fr_ = wsf[crow(r, hi)]; o0[r] *= fr_; o1[r] *= fr_; }
            }
            float ls = 0.f;
#pragma unroll
            for (int r = 0; r < 16; ++r) { p0[r] = __builtin_amdgcn_exp2f(p0[r] - m_run); p1[r] = __builtin_amdgcn_exp2f(p1[r] - m_run); ls += p0[r] + p1[r]; }
            l_run += ls;
            typedef unsigned u4 __attribute__((ext_vector_type(4)));
            const u4 pw0 = {cvtpk(p0[0], p0[1]), cvtpk(p0[2], p0[3]), cvtpk(p0[4], p0[5]), cvtpk(p0[6], p0[7])};
            const u4 pw1 = {cvtpk(p0[8], p0[9]), cvtpk(p0[10], p0[11]), cvtpk(p0[12], p0[13]), cvtpk(p0[14], p0[15])};
            const u4 pw2 = {cvtpk(p1[0], p1[1]), cvtpk(p1[2], p1[3]), cvtpk(p1[4], p1[5]), cvtpk(p1[6], p1[7])};
            const u4 pw3 = {cvtpk(p1[8], p1[9]), cvtpk(p1[10], p1[11]), cvtpk(p1[12], p1[13]), cvtpk(p1[14], p1[15])};
            const ATT_LAS unsigned char* vp = lds + LDS_V + slot * SLOTB + ((lane >> 4) & 1) * 32 + (lane & 3) * 8 + (4 * hi + ((lane & 15) >> 2)) * 64;
#define ATT_PV(OACC, PW, D0, KS) do { const s16x4 lo_ = vtr(vp + (D0) * 4096 + (KS) * 1024), hi_ = vtr(vp + (D0) * 4096 + (KS) * 1024 + 512); \
                const bf16x8 vf_ = {lo_[0], lo_[1], lo_[2], lo_[3], hi_[0], hi_[1], hi_[2], hi_[3]}; \
                OACC = __builtin_amdgcn_mfma_f32_32x32x16_bf16(__builtin_bit_cast(bf16x8, PW), vf_, OACC, 0, 0, 0); } while (0)
            ATT_PV(o0, pw0, 0, 0); ATT_PV(o1, pw0, 1, 0); ATT_PV(o0, pw1, 0, 1); ATT_PV(o1, pw1, 1, 1);
            ATT_PV(o0, pw2, 0, 2); ATT_PV(o1, pw2, 1, 2); ATT_PV(o0, pw3, 0, 3); ATT_PV(o1, pw3, 1, 3);
#undef ATT_PV
        }
    }
    l_run += __shfl_xor(l_run, 32);
    if (hi == 0) wsf[32 + r32] = l_run;
    asm volatile("s_waitcnt lgkmcnt(0)" ::: "memory");
    bf16_t* op = ob + (size_t)(b * L + q0) * D + ocol + r32;
    float* ossp = (float*)(p.ws + WS_OSS) + (size_t)(b * L + q0) * 16 + (ocol >> 6);
#pragma unroll
    for (int r = 0; r < 16; ++r) { const int q = crow(r, hi); const float inv = __builtin_amdgcn_rcpf(wsf[32 + q]);
        const float a0 = o0[r] * inv, a1 = o1[r] * inv;
        op[(size_t)q * D] = (bf16_t)f2bf(a0); op[(size_t)q * D + 32] = (bf16_t)f2bf(a1);
        const float ss = row_sum16(a0 * a0 + a1 * a1);
        const float s01 = rdlane(ss, 0) + rdlane(ss, 16), s23 = rdlane(ss, 32) + rdlane(ss, 48);
        if (r32 == 0) ossp[(size_t)q * 16] = hi ? s23 : s01; }
    ATT_WAIT_BAR(0);
#undef ATT_TILE_ROW
}

__device__ __forceinline__ void attn_phase(const Params& p, ATT_LAS unsigned char* lds, int wv) {
    const int G = gridDim.x, bx = blockIdx.x;
    const int vcu = (G % 8 == 0) ? (bx % 8) * (G / 8) + bx / 8 : bx;
    for (int u = vcu; u < 2048; u += G) {
        if (u < 1024) attn_unit<false>(p, lds, u, wv); else attn_unit<true>(p, lds, u - 1024, wv);
    }
}
}

constexpr int SW_STRIDE = 36;

__device__ void p4c_post(const Params& p, LAS3 float* sW, int wv) {
    const int tid = tid_opaque(wv), lane = tid & 63;
    const float* mod = (const float*)(p.ws + WS_MOD); const bf16_t* mix = (const bf16_t*)(p.ws + WS_MIX);
    unsigned char* h8 = p.ws + WS_HB;
    unsigned* counts = (unsigned*)(p.ws + WS_CTL);
    int* eslot = (int*)(p.ws + WS_ESLOT); float* ew = (float*)(p.ws + WS_EW);
    const int wave = tid >> 6;
    LAS3 int* lcnt = (LAS3 int*)(sW + 1024 * SW_STRIDE) + 128;
    LAS3 int* lbase = lcnt + 32;
    LAS3 int* stg_slot = lbase + 32; LAS3 int* stg_e = stg_slot + 512; LAS3 float* stg_w = (LAS3 float*)(stg_e + 512);
    if (tid < NE) lcnt[tid] = 0;
    for (int i = tid; i < D * 8; i += NTHREADS) { const int k = i >> 3, e4 = i & 7; const f32x4 w = ((const f32x4*)p.w_router)[i];
        LAS3 float* d = sW + ((k & 3) * 256 + (k >> 2)) * SW_STRIDE + e4 * 4; *(LAS3 f32x4*)d = w; }
    __syncthreads();
    constexpr int R = 16;
    const int m0 = ((int)blockIdx.x * (NTHREADS / 64) + wave) * R;
    if (m0 < NTOK) {
        const int b = m0 / L; const float* mb = mod + b * 6144;
        f32x4 pA[4], pB[4], pC[4], v[4], xx[4], nx[4]; u32x2 nv[4];
#pragma unroll
        for (int j = 0; j < 4; ++j) { const int c0 = 4 * (lane + 64 * j);
            pA[j] = *(const f32x4*)(p.g_post_mix + c0) * *(const f32x4*)(mb + 2048 + c0);
            pB[j] = *(const f32x4*)(p.g_pre_ffn + c0) * (*(const f32x4*)(mb + 4096 + c0) + 1.f);
            pC[j] = *(const f32x4*)(mb + 3072 + c0);
            nv[j] = ((const u32x2*)(mix + (size_t)m0 * D))[lane + 64 * j]; nx[j] = ((const f32x4*)(p.x + (size_t)m0 * D))[lane + 64 * j]; }
        for (int it = 0; it < R; ++it) {
            const int m = m0 + it;
#pragma unroll
            for (int j = 0; j < 4; ++j) { v[j] = (f32x4){__uint_as_float(nv[j].x << 16), __uint_as_float(nv[j].x & 0xffff0000u), __uint_as_float(nv[j].y << 16), __uint_as_float(nv[j].y & 0xffff0000u)}; xx[j] = nx[j]; }
            if (it + 1 < R) {
#pragma unroll
                for (int j = 0; j < 4; ++j) { nv[j] = ((const u32x2*)(mix + (size_t)(m + 1) * D))[lane + 64 * j]; nx[j] = ((const f32x4*)(p.x + (size_t)(m + 1) * D))[lane + 64 * j]; }
            }
            float s = 0.f;
#pragma unroll
            for (int j = 0; j < 4; ++j) s += v[j].x * v[j].x + v[j].y * v[j].y + v[j].z * v[j].z + v[j].w * v[j].w;
            float rstd = rsqrtf(wave_sum(s) * (1.f / D) + EPS);
            s = 0.f;
            f32x4 xv[4];
#pragma unroll
            for (int j = 0; j < 4; ++j) {
                xv[j] = xx[j] + pA[j] * (v[j] * rstd);
                ((f32x4*)(p.out + (size_t)m * D))[lane + 64 * j] = xv[j];
                s += xv[j].x * xv[j].x + xv[j].y * xv[j].y + xv[j].z * xv[j].z + xv[j].w * xv[j].w; }
            rstd = rsqrtf(wave_sum(s) * (1.f / D) + EPS);
            float lg[NE];
#pragma unroll
            for (int e = 0; e < NE; ++e) lg[e] = 0.f;
#pragma unroll
            for (int j = 0; j < 4; ++j) { const int c0 = 4 * (lane + 64 * j);
                const f32x4 h2 = (xv[j] * rstd) * pB[j] + pC[j];
                *(unsigned*)(h8 + (size_t)m * D + c0) = pk4_fp8(h2.x, h2.y, h2.z, h2.w);
#pragma unroll
                for (int q = 0; q < 4; ++q) { const float hv = h2[q]; const LAS3 f32x4* wr = (const LAS3 f32x4*)(sW + (q * 256 + lane + 64 * j) * SW_STRIDE);
#pragma unroll
                    for (int e4 = 0; e4 < 8; ++e4) { const f32x4 ww = wr[e4]; lg[e4 * 4] = fmaf(hv, ww.x, lg[e4 * 4]); lg[e4 * 4 + 1] = fmaf(hv, ww.y, lg[e4 * 4 + 1]); lg[e4 * 4 + 2] = fmaf(hv, ww.z, lg[e4 * 4 + 2]); lg[e4 * 4 + 3] = fmaf(hv, ww.w, lg[e4 * 4 + 3]); }
                    asm volatile("" ::: "memory"); }
            }
#pragma unroll
            for (int e = 0; e < NE; ++e) lg[e] = wave_sum(lg[e]) + p.b_router[e];
            float tv[4]; int ti[4]; unsigned used = 0u;
#pragma unroll
            for (int k = 0; k < 4; ++k) { float best = -3.4e38f; int bi = 0;
#pragma unroll
                for (int e = 0; e < NE; ++e) { const bool ok = !((used >> e) & 1u) && lg[e] > best; best = ok ? lg[e] : best; bi = ok ? e : bi; }
                tv[k] = best; ti[k] = bi; used |= 1u << bi; }
            const float e1 = __expf(tv[1] - tv[0]), e2 = __expf(tv[2] - tv[0]), e3 = __expf(tv[3] - tv[0]); const float inv = 1.f / (1.f + e1 + e2 + e3);
            const float tw[4] = {inv, e1 * inv, e2 * inv, e3 * inv};
            if (lane < 4) {
                int myi = ti[0]; float myw = tw[0];
#pragma unroll
                for (int k = 1; k < 4; ++k) if (lane == k) { myi = ti[k]; myw = tw[k]; }
                const int lr = __hip_atomic_fetch_add((LAS3 int*)&lcnt[myi], 1, __ATOMIC_RELAXED, __HIP_MEMORY_SCOPE_WORKGROUP);
                const int si = (wave * 16 + it) * 4 + lane;
                stg_slot[si] = m * 4 + lane; stg_e[si] = myi | (lr << 8); stg_w[si] = myw;
            }
        }
    }
    __syncthreads();
    if (tid < NE) { const int c = lcnt[tid]; lbase[tid] = c ? (int)atomicAdd(&counts[tid * 64], (unsigned)c) : 0; }
    __syncthreads();
    { const int si = tid, w = si >> 6;
      if (((int)blockIdx.x * (NTHREADS / 64) + w) * R < NTOK) {
        const int ee = stg_e[si], e = ee & 255, lr = ee >> 8; const int rank = lbase[e] + lr;
        eslot[(size_t)e * ECAP + rank] = stg_slot[si]; ew[(size_t)e * ECAP + rank] = stg_w[si]; } }
    __syncthreads();
}
__device__ __forceinline__ void expert_bases(const unsigned* counts, int* sbase_  , int wv) {
    LAS3 int* sbase = (LAS3 int*)sbase_;
    if (wv == 0) {
        const int lane = lane_id(); const int cn = lane < NE ? (int)counts[lane * 64] : 0; const int c = (cn + 255) & ~255;
        int incl = c;
#pragma unroll
        for (int o = 1; o < 32; o <<= 1) { const int v = __shfl_up(incl, o); if (lane >= o) incl += v; }
        if (lane < NE) { sbase[lane] = incl - c; sbase[40 + lane] = cn; }
        if (lane == NE - 1) sbase[NE] = incl;
    }
    __syncthreads();
}
typedef float f32x2v __attribute__((ext_vector_type(2)));
__device__ __forceinline__ void p6_load(const unsigned char* y, const float* out, int m, int lane, u32x2 (&yv)[2][4], f32x4 (&xv)[2][2]) {
#pragma unroll
    for (int j = 0; j < 2; ++j) { const int c0 = 8 * (lane + 64 * j);
#pragma unroll
        for (int k = 0; k < 4; ++k) yv[j][k] = *(const u32x2*)(y + (size_t)(m * 4 + k) * D + c0);
        xv[j][0] = *(const f32x4*)(out + (size_t)m * D + c0); xv[j][1] = *(const f32x4*)(out + (size_t)m * D + c0 + 4); }
}
__device__ void p6_final(const Params& p, int wv) {
    const int tid = tid_opaque(wv), lane = tid & 63;
    const float* mod = (const float*)(p.ws + WS_MOD); const unsigned char* y = p.ws + WS_Y;
    constexpr int R = 16;
    const int m0 = ((int)blockIdx.x * (NTHREADS / 64) + (tid >> 6)) * R;
    if (m0 >= NTOK) return;
    const int b = m0 / L; const float* ga2 = mod + b * 6144 + 5120;
    f32x4 pA[2][2];
#pragma unroll
    for (int j = 0; j < 2; ++j)
#pragma unroll
        for (int q = 0; q < 2; ++q) { const int c0 = 8 * (lane + 64 * j) + 4 * q; pA[j][q] = *(const f32x4*)(p.g_post_ffn + c0) * *(const f32x4*)(ga2 + c0); }
    u32x2 yv[2][4], ny[2][4]; f32x4 xv[2][2], nx[2][2];
    p6_load(y, p.out, m0, lane, ny, nx);
    for (int it = 0; it < R; ++it) {
        const int m = m0 + it;
#pragma unroll
        for (int j = 0; j < 2; ++j) {
#pragma unroll
            for (int k = 0; k < 4; ++k) yv[j][k] = ny[j][k];
            xv[j][0] = nx[j][0]; xv[j][1] = nx[j][1]; }
        if (it + 1 < R) p6_load(y, p.out, m + 1, lane, ny, nx);
        f32x4 a[2][2]; float s = 0.f;
#pragma unroll
        for (int j = 0; j < 2; ++j) { a[j][0] = (f32x4){0.f, 0.f, 0.f, 0.f}; a[j][1] = (f32x4){0.f, 0.f, 0.f, 0.f};
#pragma unroll
            for (int k = 0; k < 4; ++k) { const u32x2 w = yv[j][k];
                const f32x2v l0 = __builtin_amdgcn_cvt_pk_f32_fp8((int)w.x, false), l1 = __builtin_amdgcn_cvt_pk_f32_fp8((int)w.x, true);
                const f32x2v h0 = __builtin_amdgcn_cvt_pk_f32_fp8((int)w.y, false), h1 = __builtin_amdgcn_cvt_pk_f32_fp8((int)w.y, true);
                a[j][0].x += l0.x; a[j][0].y += l0.y; a[j][0].z += l1.x; a[j][0].w += l1.y;
                a[j][1].x += h0.x; a[j][1].y += h0.y; a[j][1].z += h1.x; a[j][1].w += h1.y; }
#pragma unroll
            for (int q = 0; q < 2; ++q) { a[j][q] = a[j][q] * Y8_INV; s += a[j][q].x * a[j][q].x + a[j][q].y * a[j][q].y + a[j][q].z * a[j][q].z + a[j][q].w * a[j][q].w; } }
        const float rstd = rsqrtf(wave_sum(s) * (1.f / D) + EPS);
#pragma unroll
        for (int j = 0; j < 2; ++j)
#pragma unroll
            for (int q = 0; q < 2; ++q) { const int c0 = 8 * (lane + 64 * j) + 4 * q;
                *(f32x4*)(p.out + (size_t)m * D + c0) = xv[j][q] + pA[j][q] * (a[j][q] * rstd); }
    }
}

constexpr int LDS_SBASE = 147456;
constexpr int LDS_BYTES = LDS_SBASE + 512 + (64 + 3 * 512) * 4 + 256;

__global__ void __launch_bounds__(NTHREADS, 2) fwd_kernel(Params p) {
    cg::grid_group grid = cg::this_grid();
    extern __shared__ __attribute__((aligned(16))) unsigned char lds[];
    int* sbase = (int*)(lds + LDS_SBASE);
    PG8_LAS unsigned char* lds3 = (PG8_LAS unsigned char*)lds;
    const PG8_LAS int* sbase3 = (const PG8_LAS int*)(lds3 + LDS_SBASE);
    volatile LAS3 unsigned* bst = (volatile LAS3 unsigned*)(lds3 + LDS_SBASE + 384);
    const int wv = __builtin_amdgcn_readfirstlane((int)(threadIdx.x >> 6));
    if (wv == 0 && lane_id() < 2) bst[lane_id()] = 0u;
    __syncthreads();
    XcdBarrier xb = xcd_barrier_post((unsigned*)(p.ws + WS_CTL) + CW_BAR, bst, wv);

    p0_mod(p, (float*)lds, (float*)(lds + 36864), wv);
    p0_tab(p, wv);
    p0_weights(p, lds, wv);
    grid.sync();
    p1_h(p, wv);
    xcd_barrier(xb);
    { pg8::Gemm g{(const bf16_t*)(p.ws + WS_HB), (const bf16_t*)(p.ws + WS_WIN), D, 0, nullptr, sbase3, wv};
      pg8::StaticOrder S; S.init(MROWS, INW, (int)gridDim.x, (int)blockIdx.x, nullptr);
      { const int t_ = tid_opaque(wv); *(PG8_LAS f32x4*)(lds3 + pg8::PAR_TAB + t_ * 16) = ((const f32x4*)(p.ws + WS_TAB))[t_]; }
      __syncthreads();
      pg8::EpiQKV E{(bf16_t*)(p.ws + WS_QKV)};
      pg8::gemm_phase<pg8::EpiQKV, pg8::StaticOrder, false, true>(lds3, g, S, E); }
    xcd_barrier(xb);
    att::attn_phase(p, lds3, wv);
    xcd_barrier(xb);
    { pg8::Gemm g{(const bf16_t*)(p.ws + WS_O), (const bf16_t*)(p.ws + WS_WOUT), D, 0, nullptr, sbase3, wv};
      pg8::StaticOrder S; S.init(NTOK, D, (int)gridDim.x, (int)blockIdx.x, nullptr);
      pg8::EpiOutProj E{(bf16_t*)(p.ws + WS_MIX), (const float*)(p.ws + WS_OSS)};
      pg8::gemm_phase<pg8::EpiOutProj, pg8::StaticOrder, false, true>(lds3, g, S, E); }
    xcd_barrier(xb);
    p4c_post(p, (LAS3 float*)lds3, wv);
    xcd_barrier(xb);
    expert_bases((const unsigned*)(p.ws + WS_CTL), sbase, wv);
    { const int total = sbase3[NE];
      pg8::Gemm g{(const bf16_t*)(p.ws + WS_HB), (const bf16_t*)(p.ws + WS_W1), D / 2, (size_t)2048 * D, (const int*)(p.ws + WS_ESLOT), sbase3, wv};
      pg8::StaticOrder S; S.init(total, 2048, (int)gridDim.x, (int)blockIdx.x, sbase3);
      pg8::EpiSwiglu E{p.ws + WS_ACT, p.b_mlp1};
      pg8::gemm_phase<pg8::EpiSwiglu, pg8::StaticOrder, true, true, true>(lds3, g, S, E); }
    xcd_barrier(xb);
    { const int total = sbase3[NE];
      pg8::Gemm g{(const bf16_t*)(p.ws + WS_ACT), (const bf16_t*)(p.ws + WS_W2), D / 2, (size_t)D * D, nullptr, sbase3, wv};
      pg8::StaticOrder S; S.init(total, D, (int)gridDim.x, (int)blockIdx.x, sbase3);
      pg8::EpiScatter E{p.ws + WS_Y, p.b_mlp2, (const int*)(p.ws + WS_ESLOT), (const float*)(p.ws + WS_EW), sbase3};
      pg8::gemm_phase<pg8::EpiScatter, pg8::StaticOrder, false, true, true>(lds3, g, S, E); }
    xcd_barrier(xb);
    p6_final(p, wv);
}

extern "C" void kernel_launch(void* const* d_in, const int* in_sizes, int n_in, void* d_out, int out_size, void* d_ws, size_t ws_size, hipStream_t stream) {
    static int grid_blocks = 0;
    if (grid_blocks == 0) {
        if (n_in != 22 || ws_size < WS_END) { fprintf(stderr, "kernel_launch: unexpected n_in %d / ws_size %zu (need %zu)\n", n_in, ws_size, (size_t)WS_END); grid_blocks = -1; return; }
        int dev = 0, cus = 0, per_cu = 0;
        (void)hipGetDevice(&dev);
        (void)hipDeviceGetAttribute(&cus, hipDeviceAttributeMultiprocessorCount, dev);
        if (hipFuncSetAttribute((const void*)fwd_kernel, hipFuncAttributeMaxDynamicSharedMemorySize, LDS_BYTES) != hipSuccess) { fprintf(stderr, "kernel_launch: hipFuncSetAttribute failed\n"); grid_blocks = -1; return; }
        (void)hipOccupancyMaxActiveBlocksPerMultiprocessor(&per_cu, (const void*)fwd_kernel, NTHREADS, LDS_BYTES);
        if (per_cu < 1) { fprintf(stderr, "kernel_launch: occupancy query returned %d\n", per_cu); grid_blocks = -1; return; }
        grid_blocks = cus;
        if (grid_blocks * (NTHREADS / 64) * 16 < NTOK) { fprintf(stderr, "kernel_launch: needs >= 256 CUs (got %d)\n", cus); grid_blocks = -1; return; }
    }
    if (grid_blocks < 0) return;
    (void)hipMemsetAsync((char*)d_ws + WS_CTL, 0, CTL_BYTES, stream);
    Params p{};
    const float** pp = (const float**)&p;
    for (int i = 0; i < 22; ++i) pp[i] = (const float*)d_in[i];
    p.out = (float*)d_out; p.ws = (unsigned char*)d_ws;
    void* args[] = {&p};
    hipError_t e = hipLaunchCooperativeKernel((const void*)fwd_kernel, dim3(grid_blocks), dim3(NTHREADS), args, LDS_BYTES, stream);
    if (e != hipSuccess) fprintf(stderr, "cooperative launch failed: %s (grid %d)\n", hipGetErrorString(e), grid_blocks);
}
```

```cpp
#include <hip/hip_runtime.h>
#include <hip/hip_cooperative_groups.h>
#include <cstdio>
#include <cstdint>
namespace cg = cooperative_groups;

constexpr int D = 1024, NB = 8, L = 4096, CTX = 256;
constexpr int NTOK = NB * L, NCTX = NB * CTX, MROWS = NTOK + NCTX;
constexpr int INW = 2304;
constexpr int C_QA = 0, C_KA = 512, C_VA = 640, C_QB = 768, C_KB = 1280, C_VB = 1792;
constexpr int NE = 32, TOPK = 4, NASG = NTOK * TOPK;
constexpr int PADROWS = NASG + NE * 256;
constexpr float LOG2E = 1.4426950408889634f;
constexpr float QSCALE = 0.125f * LOG2E;
constexpr float EPS = 1e-6f;
constexpr int NTHREADS = 512;

constexpr size_t MiB = 1u << 20;
constexpr size_t WS_CTL = 0;
constexpr size_t CTL_BYTES = 32768;
constexpr int CW_BAR = 2048;
constexpr size_t WS_MOD = 1 * MiB;
constexpr size_t WS_TAB = 1 * MiB + 256 * 1024;
constexpr size_t WS_OSTAT = 1 * MiB + 512 * 1024;
constexpr size_t WS_WIN = 2 * MiB;
constexpr size_t WS_WOUT = 7 * MiB;
constexpr size_t WS_W2 = 9 * MiB;
constexpr size_t WS_OSS = 41 * MiB;
constexpr size_t WS_W1 = 73 * MiB;
constexpr size_t WS_HB = 201 * MiB;
constexpr int ECAP = NTOK;
constexpr size_t WS_ESLOT = 269 * MiB;
constexpr size_t WS_EW = 273 * MiB;
constexpr size_t WS_QKV = 277 * MiB;
constexpr size_t WS_O = 430 * MiB;
constexpr size_t WS_MIX = 494 * MiB;
constexpr size_t WS_ACT = 277 * MiB;
constexpr size_t WS_Y = 622 * MiB;
constexpr size_t WS_END = 878 * MiB;
static_assert(WS_W1 + (size_t)NE * 2048 * D * 2 <= WS_HB && WS_W2 + (size_t)NE * D * D * 2 <= WS_W1, "map");
static_assert(WS_HB + (size_t)MROWS * D * 2 <= WS_ESLOT && WS_ESLOT + (size_t)NE * ECAP * 4 <= WS_EW && WS_EW + (size_t)NE * ECAP * 4 <= WS_QKV, "map");
static_assert(WS_QKV + (size_t)MROWS * INW * 2 <= WS_O && WS_O + (size_t)NTOK * D * 2 <= WS_MIX && WS_MIX + (size_t)NTOK * D * 4 <= WS_Y, "map");
static_assert(WS_ACT + (size_t)PADROWS * 1024 * 2 <= WS_Y && WS_Y + (size_t)NASG * D * 2 <= WS_END, "map");

typedef unsigned short bf16_t;
typedef float f32x4 __attribute__((ext_vector_type(4)));
typedef unsigned u32x4 __attribute__((ext_vector_type(4)));
typedef unsigned u32x2 __attribute__((ext_vector_type(2)));

struct Params {
    const float *x, *c, *ctx, *c_ctx, *w_ada, *b_ada, *g_pre_mix, *g_post_mix, *g_pre_ffn, *g_post_ffn, *w_in, *g_grp_a, *g_grp_b,
        *sink_a, *rpb_b, *w_out, *w_router, *b_router, *w_mlp1, *b_mlp1, *w_mlp2, *b_mlp2;
    float* out;
    unsigned char* ws;
};

__device__ __forceinline__ unsigned f2bf(float f) { unsigned u = __float_as_uint(f); return (u + 0x7fffu + ((u >> 16) & 1u)) >> 16; }
__device__ __forceinline__ unsigned pk2(float lo, float hi) { return f2bf(lo) | (f2bf(hi) << 16); }
__device__ __forceinline__ unsigned pk4_fp8(float v0, float v1, float v2, float v3) {
    int w = 0; w = __builtin_amdgcn_cvt_pk_fp8_f32(v0, v1, w, false); w = __builtin_amdgcn_cvt_pk_fp8_f32(v2, v3, w, true); return (unsigned)w; }
constexpr float Y8_SCALE = 16.f, Y8_INV = 1.f / 16.f;
constexpr float W8_SCALE = 64.f, W8_INV = 1.f / 64.f;
__device__ __forceinline__ int lane_id() { int l = (int)__builtin_amdgcn_mbcnt_hi(~0u, __builtin_amdgcn_mbcnt_lo(~0u, 0u)); asm volatile("" : "+v"(l)); return l; }
__device__ __forceinline__ int tid_opaque(int wv) { return wv * 64 + lane_id(); }
template <int CTRL> __device__ __forceinline__ float dppmov(float v) { return __builtin_bit_cast(float, __builtin_amdgcn_update_dpp(0, __builtin_bit_cast(int, v), CTRL, 0xf, 0xf, true)); }
__device__ __forceinline__ float row_sum16(float v) { v += dppmov<0xB1>(v); v += dppmov<0x4E>(v); v += dppmov<0x141>(v); v += dppmov<0x140>(v); return v; }
__device__ __forceinline__ float rdlane(float v, int l) { return __builtin_bit_cast(float, __builtin_amdgcn_readlane(__builtin_bit_cast(int, v), l)); }
__device__ __forceinline__ float wave_sum(float v) { v = row_sum16(v); return (rdlane(v, 0) + rdlane(v, 16)) + (rdlane(v, 32) + rdlane(v, 48)); }

#define LAS3 __attribute__((address_space(3)))
#define XB_TMO      128
#define XB_XCNT(j)  (256  + 64 * (j))
#define XB_XSUB(j)  (1280 + 64 * (j))
#define XB_XGEN(j)  (2304 + 64 * (j))
#define XB_TOP      3328
#define XB_TOPGEN   3392
#define XCD_BAR_WORDS 3456
#define XB_SPIN_CAP (1u << 18)
__device__ __forceinline__ unsigned xb_ld(unsigned* p)              { return __hip_atomic_load(p, __ATOMIC_RELAXED, __HIP_MEMORY_SCOPE_AGENT); }
__device__ __forceinline__ unsigned xb_add(unsigned* p, unsigned v) { return __hip_atomic_fetch_add(p, v, __ATOMIC_RELAXED, __HIP_MEMORY_SCOPE_AGENT); }
__device__ __forceinline__ unsigned xb_xcc_id() { return (unsigned)__builtin_amdgcn_s_getreg((3 << 11) | 20) & 0xFu; }
#define XB_SPIN(cond, bar) do { unsigned _sp = 0; while (cond) { __builtin_amdgcn_s_sleep(1); \
    if ((++_sp & 255u) == 0u) { if (xb_ld(&(bar)[XB_TMO])) break; if (_sp > XB_SPIN_CAP) { atomicAdd(&(bar)[XB_TMO], 1u); break; } } } } while (0)
struct XcdBarrier { unsigned* bar; unsigned x; volatile LAS3 unsigned* st; int wv; };
__device__ __forceinline__ XcdBarrier xcd_barrier_post(unsigned* bar, volatile LAS3 unsigned* st, int wv) {
    XcdBarrier b; b.bar = bar; b.x = xb_xcc_id(); b.st = st; b.wv = wv;
    if (tid_opaque(wv) == 0) (void)xb_add(&bar[XB_XCNT(b.x)], 1u);
    return b;
}
__device__ __forceinline__ void xcd_barrier_complete(unsigned* bar, unsigned x, unsigned& nloc, unsigned& nx) {
    const unsigned G = gridDim.x * gridDim.y * gridDim.z;
    unsigned sum, cnt, mine, sp = 0u;
    for (;;) {
        sum = 0u; cnt = 0u; mine = 0u;
#pragma unroll
        for (unsigned j = 0; j < 16; ++j) { const unsigned c = xb_ld(&bar[XB_XCNT(j)]); sum += c; cnt += (c > 0u) ? 1u : 0u; mine = (j == x) ? c : mine; }
        if (sum == G) break;
        __builtin_amdgcn_s_sleep(1);
        if ((++sp & 255u) == 0u) { if (xb_ld(&bar[XB_TMO])) break; if (sp > XB_SPIN_CAP) { atomicAdd(&bar[XB_TMO], 1u); break; } }
    }
    nloc = mine > 0u ? mine : 1u; nx = cnt > 0u ? cnt : 1u;
}
__device__ __forceinline__ void xcd_barrier(const XcdBarrier& b) {
    asm volatile("s_waitcnt vmcnt(0)" ::: "memory");
    __syncthreads();
    if (tid_opaque(b.wv) == 0) {
        unsigned* bar = b.bar;
        __builtin_amdgcn_s_waitcnt(0);
        unsigned nloc = b.st[0], nx = b.st[1];
        if (nloc == 0u) { xcd_barrier_complete(bar, b.x, nloc, nx); b.st[0] = nloc; b.st[1] = nx; }
        const unsigned old = xb_add(&bar[XB_XSUB(b.x)], 1u);
        const unsigned gen = old / nloc;
        if (old + 1u == (gen + 1u) * nloc) {
            __builtin_amdgcn_fence(__ATOMIC_RELEASE, "agent");
            asm volatile("s_waitcnt vmcnt(0)" ::: "memory");
            const unsigned og = xb_add(&bar[XB_TOP], 1u);
            const unsigned tg = og / nx;
            if (og + 1u == (tg + 1u) * nx) xb_add(&bar[XB_TOPGEN], 1u);
            else XB_SPIN(xb_ld(&bar[XB_TOPGEN]) == tg, bar);
            __builtin_amdgcn_fence(__ATOMIC_ACQUIRE, "agent");
            xb_add(&bar[XB_XGEN(b.x)], 1u);
            asm volatile("s_waitcnt vmcnt(0)" ::: "memory");
        } else {
            XB_SPIN(xb_ld(&bar[XB_XGEN(b.x)]) == gen, bar);
            __builtin_amdgcn_fence(__ATOMIC_ACQUIRE, "agent");
            asm volatile("s_waitcnt vmcnt(0)" ::: "memory");
        }
    }
    __syncthreads();
}

namespace pg8 {
#define PG8_LAS __attribute__((address_space(3)))
typedef short bf16x8 __attribute__((ext_vector_type(8)));
typedef int v8i __attribute__((ext_vector_type(8)));
typedef int v4i __attribute__((ext_vector_type(4)));
typedef short s16x16 __attribute__((ext_vector_type(16)));
constexpr int BM = 256, BK = 64, HALF = 128, HTB = HALF * BK * 2  , STAGE_BYTES = 8 * HTB, NXCD = 8, WGM = 8;
__device__ __forceinline__ int lds_byte(int r, int c) { const int st = (r >> 4) * 2 + (c >> 5), rr = r & 15, cc = c & 31, ob = rr * 64 + cc * 2; return st * 1024 + (ob ^ (((ob >> 9) & 1) << 5)); }
__device__ __forceinline__ void stage_rc(int b, int& R, int& C) { const int st = b / 1024, sb = b % 1024, swz = sb ^ (((sb >> 9) & 1) << 5); R = (st >> 1) * 16 + swz / 64; C = (st & 1) * 32 + (swz % 64) / 2; }
__device__ __forceinline__ int perm32(int rho) { const int n = rho >> 4, i = rho & 15; return 8 * (i >> 2) + 4 * n + (i & 3); }

constexpr int PAR_BASE = 131072, PAR_BUF = 4096, PAR_IDX = 0, PAR_W = 1024, PAR_BIAS = 2048, PAR_TAB = PAR_BASE + 2 * PAR_BUF;
typedef short s16x2 __attribute__((ext_vector_type(2)));
__device__ __forceinline__ int par_i32(PG8_LAS unsigned char* p) { return __builtin_bit_cast(int, *(const PG8_LAS s16x2*)p); }
__device__ __forceinline__ float par_f32(PG8_LAS unsigned char* p) { return __builtin_bit_cast(float, *(const PG8_LAS s16x2*)p); }
__device__ __forceinline__ f32x4 par_f32x4(PG8_LAS unsigned char* p) { return __builtin_bit_cast(f32x4, *(const PG8_LAS bf16x8*)p); }
struct Unit { int pm, pn, e; };
struct Gemm { const bf16_t* A; const bf16_t* Bt; int K; size_t bstride; const int* eslot; const PG8_LAS int* sb; int wv; };

struct StaticOrder {
    int nM, nN, nwg, G, c; const PG8_LAS int* sbase;
    __device__ void init(int M, int N, int G_, int c_, const PG8_LAS int* sb) { nM = M / BM; nN = N / BM; nwg = nM * nN; G = G_; c = c_; sbase = sb; }
    __device__ bool next(int i, Unit& u) const {
        const long Lx = (long)i * G + c; if (Lx >= nwg) return false;
        int wgid = (int)Lx; { const int q = nwg / NXCD, r = nwg % NXCD, xcd = wgid % NXCD, off = wgid / NXCD; wgid = (xcd < r ? xcd * (q + 1) : r * (q + 1) + (xcd - r) * q) + off; }
        const int nig = WGM * nN, gid = wgid / nig, fm = gid * WGM, gsz = (nM - fm) < WGM ? (nM - fm) : WGM;
        u.pm = fm + ((wgid % nig) % gsz); u.pn = (wgid % nig) / gsz; u.e = 0;
        if (sbase) { const int row = u.pm * BM; const int l = lane_id();
            const bool ge = (l >= 1) && (l < 32) && (row >= sbase[l & 31]);
            u.e = __builtin_popcountll(__ballot(ge)); }
        return true;
    }
};

template <class Epi, class Sched, bool GATHER, bool ALIGN_EPI, bool FP8 = false>
__device__ __forceinline__ void gemm_phase(PG8_LAS unsigned char* lds, const Gemm g, const Sched& S, const Epi& E) {
    const int tid = tid_opaque(g.wv), wid = g.wv,
              lane = tid & 63, wr = wid >> 2, wc = wid & 3, fr = lane & 15, fq = lane >> 4;
    const int K = g.K, nt = K / BK;
    unsigned voffA[2], voffB[2];
#pragma unroll
    for (int i = 0; i < 2; ++i) { const int R = 8 * (wid + 8 * i) + (lane >> 3), Sb = (((lane & 7) ^ (lane >> 3)) * 16); const int Rb = Epi::PERM ? ((R & ~31) + perm32(R & 31)) : R;
        voffA[i] = (unsigned)(R * K * 2 + Sb); voffB[i] = (unsigned)(Rb * K * 2 + Sb); }
    const size_t kstep = (size_t)(BK * 2);
    const size_t hstep = (size_t)HALF * K * 2;
    const size_t tstep = 2 * hstep;
    const unsigned ldsw = (unsigned)wid * 1024u;
    const int fsw0 = (fr & 7) * 128 + ((fq ^ (fr & 7)) * 16), fsw1 = (fr & 7) * 128 + (((fq + 4) ^ (fr & 7)) * 16);
    const int aoff0 = (wr * 8 + (fr >> 3)) * 1024 + fsw0, aoff1 = (wr * 8 + (fr >> 3)) * 1024 + fsw1, boff0 = (wc * 4 + (fr >> 3)) * 1024 + fsw0, boff1 = (wc * 4 + (fr >> 3)) * 1024 + fsw1;
#define PG8_SA(b, h) (((b) * 2 + (h)) * HTB)
#define PG8_SB(b, h) ((4 + (b) * 2 + (h)) * HTB)
#define PG8_STAGE(bufoff, gbase, voff) do { _Pragma("unroll") for (int _i = 0; _i < 2; ++_i) \
        __builtin_amdgcn_global_load_lds((const unsigned*)((const char*)(gbase) + (voff)[_i]), (PG8_LAS unsigned*)(lds + (bufoff) + ldsw + _i * 8192), 16, 0, 0); } while (0)
#define PG8_CAT(lo_, hi_) __builtin_bit_cast(v8i, __builtin_shufflevector((lo_), (hi_), 0, 1, 2, 3, 4, 5, 6, 7, 8, 9, 10, 11, 12, 13, 14, 15))
#define PG8_LDA(dst, b, h) do { _Pragma("unroll") for (int m = 0; m < 4; ++m) { \
        const bf16x8 f0_ = *(const PG8_LAS bf16x8*)(lds + PG8_SA(b, h) + aoff0 + m * 2048), f1_ = *(const PG8_LAS bf16x8*)(lds + PG8_SA(b, h) + aoff1 + m * 2048); \
        if constexpr (FP8) dst##8[m] = PG8_CAT(f0_, f1_); else { dst[m][0] = f0_; dst[m][1] = f1_; } } } while (0)
#define PG8_LDB(dst, b, h) do { _Pragma("unroll") for (int n = 0; n < 2; ++n) { \
        const bf16x8 f0_ = *(const PG8_LAS bf16x8*)(lds + PG8_SB(b, h) + boff0 + n * 2048), f1_ = *(const PG8_LAS bf16x8*)(lds + PG8_SB(b, h) + boff1 + n * 2048); \
        if constexpr (FP8) dst##8[n] = PG8_CAT(f0_, f1_); else { dst[n][0] = f0_; dst[n][1] = f1_; } } } while (0)
#define PG8_MMA(ai, bj, At, Bt) do { __builtin_amdgcn_s_setprio(1); _Pragma("unroll") for (int m = 0; m < 4; ++m) _Pragma("unroll") for (int n = 0; n < 2; ++n) { \
        if constexpr (FP8) asm volatile("v_mfma_scale_f32_16x16x128_f8f6f4 %0, %1, %2, %0, %3, %3 op_sel_hi:[0,0,0]" : "+v"(acc[ai][bj][m][n]) : "v"(Bt##8[n]), "v"(At##8[m]), "v"(one_scale)); \
        else { _Pragma("unroll") for (int k = 0; k < 2; ++k) acc[ai][bj][m][n] = __builtin_amdgcn_mfma_f32_16x16x32_bf16(Bt[n][k], At[m][k], acc[ai][bj][m][n], 0, 0, 0); } } \
        __builtin_amdgcn_s_setprio(0); } while (0)
#define PG8_WAIT_V(n) asm volatile("s_waitcnt vmcnt(" #n ")" ::: "memory")
#define PG8_WAIT_L(n) asm volatile("s_waitcnt lgkmcnt(" #n ")" ::: "memory")
#define PG8_BAR __builtin_amdgcn_s_barrier()
#define PG8_SCHED __builtin_amdgcn_sched_barrier(0)
#define PG8_SETOFF(off, pbuf_) do { _Pragma("unroll") for (int _h = 0; _h < 2; ++_h) _Pragma("unroll") for (int _i = 0; _i < 2; ++_i) { \
        if (GATHER) { const int R_ = 8 * (wid + 8 * _i) + (lane >> 3); \
            off[_h][_i] = (unsigned)(par_i32(lds + PAR_BASE + (pbuf_) * PAR_BUF + PAR_IDX + (_h * HALF + R_) * 4) >> 2) * (unsigned)(K * 2) + (unsigned)(((lane & 7) ^ (lane >> 3)) * 16); } \
        else off[_h][_i] = voffA[_i] + (unsigned)(_h * hstep); } } while (0)
#define PG8_IDXDMA(u, pbuf_) do { if (GATHER && wid < 4) { int rk_ = (u).pm * BM + wid * 64 + lane - g.sb[(u).e]; const int cm_ = g.sb[40 + (u).e] - 1; rk_ = rk_ < cm_ ? rk_ : cm_; \
        __builtin_amdgcn_global_load_lds((const unsigned*)(g.eslot + (size_t)(u).e * ECAP + rk_), (PG8_LAS unsigned*)(lds + PAR_BASE + (pbuf_) * PAR_BUF + PAR_IDX + wid * 256), 4, 0, 0); } } while (0)
    Unit cur, nxt; int ui = 0;
    if (!S.next(0, cur)) return;
    PG8_IDXDMA(cur, 0); E.prefetch(cur, 0, lds, wid, lane);
    PG8_WAIT_V(0); PG8_BAR;
    f32x4 acc[2][2][4][2];
#pragma unroll
    for (int a = 0; a < 2; ++a)
#pragma unroll
        for (int b = 0; b < 2; ++b)
#pragma unroll
            for (int m = 0; m < 4; ++m)
#pragma unroll
                for (int n = 0; n < 2; ++n) acc[a][b][m][n] = (f32x4){0.f, 0.f, 0.f, 0.f};
    bf16x8 At[4][2], B0[2][2], B1[2][2];
    v8i At8[4], B08[2], B18[2];
    const int one_scale = 0x7f7f7f7f;
    unsigned offc[2][2], offn[2][2];
    PG8_SETOFF(offc, 0);
    const char* cA = GATHER ? (const char*)g.A : (const char*)g.A + (size_t)cur.pm * tstep;
    const char* cB = (const char*)g.Bt + (size_t)cur.e * g.bstride + (size_t)cur.pn * tstep;
    PG8_STAGE(PG8_SB(0, 0), cB, voffB); PG8_STAGE(PG8_SB(0, 1), cB + hstep, voffB); PG8_STAGE(PG8_SA(0, 0), cA, offc[0]); PG8_STAGE(PG8_SA(0, 1), cA, offc[1]);
    if (wr == 1) PG8_BAR;
    PG8_WAIT_V(2); PG8_BAR;
    PG8_STAGE(PG8_SB(1, 0), cB + kstep, voffB); PG8_STAGE(PG8_SA(1, 0), cA + kstep, offc[0]); PG8_STAGE(PG8_SB(1, 1), cB + hstep + kstep, voffB);
    PG8_WAIT_V(6); PG8_BAR;
    for (;;) {
        const bool has_next = S.next(ui + 1, nxt);
        const char* nA = GATHER ? cA : (has_next ? (const char*)g.A + (size_t)nxt.pm * tstep : cA);
        const char* nB = has_next ? (const char*)g.Bt + (size_t)nxt.e * g.bstride + (size_t)nxt.pn * tstep : cB;

        if constexpr (Epi::MIDSCALE) E.begin(cur, ui, lds, tid);
#pragma unroll 1
        for (int t = 0; t < nt; t += 2) {
            const bool last = (t == nt - 2);
            if constexpr (Epi::MIDSCALE) { if (t == nt / 2) E.mid(acc, ui, wr, fr, lds); }
            if (t == 2 && has_next) { PG8_IDXDMA(nxt, (ui + 1) & 1); E.prefetch(nxt, (ui + 1) & 1, lds, wid, lane); }
            if (GATHER && last) { if (has_next) { PG8_SETOFF(offn, (ui + 1) & 1); } else {
#pragma unroll
                for (int h = 0; h < 2; ++h)
#pragma unroll
                    for (int i = 0; i < 2; ++i) offn[h][i] = offc[h][i]; } }
            const char* a1 = cA + (size_t)(t + 1) * kstep;
            const char* a2 = last ? nA : cA + (size_t)(t + 2) * kstep; const char* b2 = last ? nB : cB + (size_t)(t + 2) * kstep;
            const char* a3 = a2 + kstep; const char* b3 = b2 + kstep;
            unsigned o2[2][2];
#pragma unroll
            for (int h = 0; h < 2; ++h)
#pragma unroll
                for (int i = 0; i < 2; ++i) o2[h][i] = (GATHER && last) ? offn[h][i] : offc[h][i];
            PG8_LDB(B0, 0, 0); PG8_LDB(B1, 0, 1); PG8_SCHED; PG8_LDA(At, 0, 0); PG8_STAGE(PG8_SA(1, 1), a1, offc[1]);
            PG8_WAIT_V(8); PG8_WAIT_L(0); PG8_BAR; PG8_MMA(0, 0, At, B0); PG8_MMA(0, 1, At, B1); PG8_BAR; PG8_SCHED;
            PG8_LDA(At, 0, 1); PG8_STAGE(PG8_SB(0, 0), b2, voffB); PG8_STAGE(PG8_SB(0, 1), b2 + hstep, voffB); PG8_STAGE(PG8_SA(0, 0), a2, o2[0]);
            PG8_WAIT_V(8); PG8_WAIT_L(0); PG8_BAR; PG8_MMA(1, 0, At, B0); PG8_MMA(1, 1, At, B1); PG8_BAR; PG8_SCHED;
            PG8_LDB(B0, 1, 0); PG8_LDB(B1, 1, 1); PG8_SCHED; PG8_LDA(At, 1, 0); PG8_STAGE(PG8_SA(0, 1), a2, o2[1]);
            PG8_WAIT_V(8); PG8_WAIT_L(0); PG8_BAR; PG8_MMA(0, 0, At, B0); PG8_MMA(0, 1, At, B1); PG8_BAR; PG8_SCHED;
            PG8_LDA(At, 1, 1); PG8_STAGE(PG8_SB(1, 0), b3, voffB); PG8_STAGE(PG8_SB(1, 1), b3 + hstep, voffB); PG8_STAGE(PG8_SA(1, 0), a3, o2[0]);
            PG8_WAIT_V(8); PG8_WAIT_L(0); PG8_BAR; PG8_MMA(1, 0, At, B0); PG8_MMA(1, 1, At, B1); PG8_BAR; PG8_SCHED;
        }
        if constexpr (ALIGN_EPI) { if (wr == 0) PG8_BAR; }
        if constexpr (FP8) asm volatile("s_nop 15\n\ts_nop 15" ::: "memory");
        E(acc, cur, ui, wr, wc, fr, fq, lds);
        if (!has_next) break;
#pragma unroll
        for (int a = 0; a < 2; ++a)
#pragma unroll
            for (int b = 0; b < 2; ++b)
#pragma unroll
                for (int m = 0; m < 4; ++m)
#pragma unroll
                    for (int n = 0; n < 2; ++n) acc[a][b][m][n] = (f32x4){0.f, 0.f, 0.f, 0.f};
        cur = nxt; cA = nA; cB = nB; ++ui;
#pragma unroll
        for (int h = 0; h < 2; ++h)
#pragma unroll
            for (int i = 0; i < 2; ++i) offc[h][i] = offn[h][i];
        if constexpr (ALIGN_EPI) { if (wr == 1) PG8_BAR; }
    }
    PG8_WAIT_V(0);
    if constexpr (!ALIGN_EPI) { if (wr == 0) PG8_BAR; }
    PG8_BAR;
#undef PG8_SA
#undef PG8_SB
#undef PG8_STAGE
#undef PG8_LDA
#undef PG8_LDB
#undef PG8_MMA
#undef PG8_WAIT_V
#undef PG8_WAIT_L
#undef PG8_BAR
#undef PG8_SCHED
#undef PG8_SETOFF
#undef PG8_IDXDMA
#undef PG8_CAT
}

struct EpiQKV {
    static constexpr bool MIDSCALE = false, PERM = false;
    bf16_t* O;
    __device__ __forceinline__ void prefetch(const Unit&, int, PG8_LAS unsigned char*, int, int) const {}
    __device__ __forceinline__ void operator()(const f32x4 (&acc)[2][2][4][2], const Unit& u, int ui, int wr, int wc, int fr, int fq, PG8_LAS unsigned char* lds) const {
        const bool latent = u.pm < NTOK / BM;
#pragma unroll
        for (int ai = 0; ai < 2; ++ai)
#pragma unroll
            for (int m = 0; m < 4; ++m) {
                const int row = u.pm * BM + ai * HALF + wr * 64 + m * 16 + fr;
                bf16_t* rowp = O + (size_t)row * INW + u.pn * BM + wc * 32 + 4 * fq;
                const int pos = row & (L - 1), pp = (wc & 1) ? (pos & 63) : (pos >> 6);
                PG8_LAS unsigned char* tp = lds + PAR_TAB + (pp * 16 + 4 * fq) * 8;
#pragma unroll
                for (int bj = 0; bj < 2; ++bj) {
                    const int colbase = u.pn * BM + bj * HALF;
                    f32x4 v0 = acc[ai][bj][m][0], v1 = acc[ai][bj][m][1];
                    if (latent && colbase < C_VA) {
                        const f32x4 t0 = par_f32x4(tp), t1 = par_f32x4(tp + 16);
                        const f32x4 cs = {t0.x, t0.z, t1.x, t1.z}, sn = {t0.y, t0.w, t1.y, t1.w};
                        const f32x4 a0 = v0 * cs - v1 * sn, a1 = v1 * cs + v0 * sn; v0 = a0; v1 = a1;
                    }
                    if (colbase < C_KA || (colbase >= C_QB && colbase < C_KB)) { v0 = v0 * QSCALE; v1 = v1 * QSCALE; }
                    u32x2 w0, w1; w0.x = pk2(v0.x, v0.y); w0.y = pk2(v0.z, v0.w); w1.x = pk2(v1.x, v1.y); w1.y = pk2(v1.z, v1.w);
                    *(u32x2*)(rowp + bj * HALF) = w0; *(u32x2*)(rowp + bj * HALF + 16) = w1;
                }
            }
    }
};
struct EpiOutProj {
    static constexpr bool PERM = true, MIDSCALE = true;
    bf16_t* O; const float* oss;
    __device__ __forceinline__ void prefetch(const Unit&, int, PG8_LAS unsigned char*, int, int) const {}
    __device__ __forceinline__ void begin(const Unit& u, int ui, PG8_LAS unsigned char* lds, int tid) const {
        if (tid < 256) { const f32x4* sp = (const f32x4*)(oss + (size_t)(u.pm * BM + tid) * 16); const f32x4 a0 = sp[0], a1 = sp[1], b0 = sp[2], b1 = sp[3];
            const float sa = ((a0.x + a0.y) + (a0.z + a0.w)) + ((a1.x + a1.y) + (a1.z + a1.w)), sb = ((b0.x + b0.y) + (b0.z + b0.w)) + ((b1.x + b1.y) + (b1.z + b1.w));
            const float ra = rsqrtf(sa * (1.f / 512.f) + EPS), rb = rsqrtf(sb * (1.f / 512.f) + EPS);
            typedef float f2 __attribute__((ext_vector_type(2)));
            *(PG8_LAS f2*)(lds + 131072 + (ui & 1) * 2048 + tid * 8) = (f2){ra / rb, rb}; }
    }
    __device__ __forceinline__ void mid(f32x4 (&acc)[2][2][4][2], int ui, int wr, int fr, PG8_LAS unsigned char* lds) const {
#pragma unroll
        for (int ai = 0; ai < 2; ++ai)
#pragma unroll
            for (int m = 0; m < 4; ++m) { const float r = *(const PG8_LAS float*)(lds + 131072 + (ui & 1) * 2048 + (ai * HALF + wr * 64 + m * 16 + fr) * 8);
#pragma unroll
                for (int bj = 0; bj < 2; ++bj)
#pragma unroll
                    for (int n = 0; n < 2; ++n) acc[ai][bj][m][n] = acc[ai][bj][m][n] * r; }
    }
    __device__ __forceinline__ void operator()(const f32x4 (&acc)[2][2][4][2], const Unit& u, int ui, int wr, int wc, int fr, int fq, PG8_LAS unsigned char* lds) const {
#pragma unroll
        for (int ai = 0; ai < 2; ++ai)
#pragma unroll
            for (int m = 0; m < 4; ++m) {
                const int rl = ai * HALF + wr * 64 + m * 16 + fr;
                const float rb = *(const PG8_LAS float*)(lds + 131072 + (ui & 1) * 2048 + rl * 8 + 4);
                bf16_t* rowp = O + (size_t)(u.pm * BM + rl) * D + u.pn * BM + wc * 32 + 8 * fq;
#pragma unroll
                for (int bj = 0; bj < 2; ++bj) { const f32x4 v0 = acc[ai][bj][m][0] * rb, v1 = acc[ai][bj][m][1] * rb;
                    u32x4 o; o.x = pk2(v0.x, v0.y); o.y = pk2(v0.z, v0.w); o.z = pk2(v1.x, v1.y); o.w = pk2(v1.z, v1.w);
                    *(u32x4*)(rowp + bj * HALF) = o; }
            }
    }
};
struct EpiSwiglu {
    static constexpr bool MIDSCALE = false, PERM = false;
    unsigned char* act; const float* b1;
    __device__ __forceinline__ void prefetch(const Unit& u, int pb, PG8_LAS unsigned char* lds, int wid, int lane) const {
        if (wid == 4) __builtin_amdgcn_global_load_lds((const unsigned*)(b1 + (size_t)u.e * 2048 + u.pn * BM + lane * 4), (PG8_LAS unsigned*)(lds + PAR_BASE + pb * PAR_BUF + PAR_BIAS), 16, 0, 0);
    }
    __device__ __forceinline__ void operator()(const f32x4 (&acc)[2][2][4][2], const Unit& u, int ui, int wr, int wc, int fr, int fq, PG8_LAS unsigned char* lds) const {
#pragma unroll
        for (int bj = 0; bj < 2; ++bj) {
            const int f0 = 16 * (8 * u.pn + 4 * bj + wc) + 4 * fq;
            PG8_LAS unsigned char* bp = lds + PAR_BASE + (ui & 1) * PAR_BUF + PAR_BIAS + (128 * bj + 32 * wc + 8 * fq) * 4; const f32x4 bA = par_f32x4(bp), bB = par_f32x4(bp + 16);
            const f32x4 bg = {bA.x, bA.z, bB.x, bB.z}, bl = {bA.y, bA.w, bB.y, bB.w};
#pragma unroll
            for (int ai = 0; ai < 2; ++ai)
#pragma unroll
                for (int m = 0; m < 4; ++m) {
                    const int row = u.pm * BM + ai * HALF + wr * 64 + m * 16 + fr;
                    const f32x4 gt = acc[ai][bj][m][0] * W8_INV + bg, ln = acc[ai][bj][m][1] * W8_INV + bl; float a[4];
#pragma unroll
                    for (int j = 0; j < 4; ++j) { const float gg = fminf(gt[j], 7.f), ll = fminf(fmaxf(ln[j], -7.f), 7.f);
                        a[j] = gg * __builtin_amdgcn_rcpf(1.f + __expf(-1.702f * gg)) * (ll + 1.f); }
                    *(unsigned*)(act + (size_t)row * D + f0) = pk4_fp8(a[0], a[1], a[2], a[3]);
                }
        }
    }
};
struct EpiScatter {
    static constexpr bool MIDSCALE = false, PERM = true;
    unsigned char* y; const float* b2; const int* eslot; const float* ew; const PG8_LAS int* sb;
    __device__ __forceinline__ void prefetch(const Unit& u, int pb, PG8_LAS unsigned char* lds, int wid, int lane) const {
        const int w4 = wid & 3; int rk = u.pm * BM + w4 * 64 + lane - sb[u.e]; const int cm = sb[40 + u.e] - 1; rk = rk < cm ? rk : cm;
        const size_t gi = (size_t)u.e * ECAP + rk;
        if (wid < 4) __builtin_amdgcn_global_load_lds((const unsigned*)(eslot + gi), (PG8_LAS unsigned*)(lds + PAR_BASE + pb * PAR_BUF + PAR_IDX + w4 * 256), 4, 0, 0);
        else         __builtin_amdgcn_global_load_lds((const unsigned*)(ew + gi), (PG8_LAS unsigned*)(lds + PAR_BASE + pb * PAR_BUF + PAR_W + w4 * 256), 4, 0, 0);
        if (wid == 0) __builtin_amdgcn_global_load_lds((const unsigned*)(b2 + (size_t)u.e * D + u.pn * BM + lane * 4), (PG8_LAS unsigned*)(lds + PAR_BASE + pb * PAR_BUF + PAR_BIAS), 16, 0, 0);
    }
    __device__ __forceinline__ void operator()(const f32x4 (&acc)[2][2][4][2], const Unit& u, int ui, int wr, int wc, int fr, int fq, PG8_LAS unsigned char* lds) const {
        PG8_LAS unsigned char* par = lds + PAR_BASE + (ui & 1) * PAR_BUF;
        const int col0 = u.pn * BM + wc * 32 + 8 * fq;
        f32x4 bv[2][2];
#pragma unroll
        for (int bj = 0; bj < 2; ++bj)
#pragma unroll
            for (int n = 0; n < 2; ++n) bv[bj][n] = par_f32x4(par + PAR_BIAS + (wc * 32 + 8 * fq + bj * HALF + 4 * n) * 4);
        const int rbase = u.pm * BM - sb[u.e], cn = sb[40 + u.e];
#pragma unroll
        for (int ai = 0; ai < 2; ++ai)
#pragma unroll
            for (int m = 0; m < 4; ++m) {
                const int rl = ai * HALF + wr * 64 + m * 16 + fr;
                const int slot = par_i32(par + PAR_IDX + rl * 4); const float w = par_f32(par + PAR_W + rl * 4) * Y8_SCALE;
                if (rbase + rl < cn) {
                    unsigned char* rowp = y + (size_t)slot * D + col0;
#pragma unroll
                    for (int bj = 0; bj < 2; ++bj) { const f32x4 v0 = (acc[ai][bj][m][0] * W8_INV + bv[bj][0]) * w, v1 = (acc[ai][bj][m][1] * W8_INV + bv[bj][1]) * w;
                        u32x2 o; o.x = pk4_fp8(v0.x, v0.y, v0.z, v0.w); o.y = pk4_fp8(v1.x, v1.y, v1.z, v1.w);
                        *(u32x2*)(rowp + bj * HALF) = o; }
                }
            }
    }
};
}

__device__ void p0_mod(const Params& p, float* sS  , float* sP  , int wv) {
    float* mod = (float*)(p.ws + WS_MOD);
    const int tid = tid_opaque(wv), lane = tid & 63, wave = wv;
    if (blockIdx.x >= 96) return;
    for (int i = tid; i < 9 * D; i += NTHREADS) { const int r = i >> 10, k = i & 1023; const float cc = r < 8 ? p.c[r * D + k] : p.c_ctx[k]; sS[i] = cc / (1.f + __expf(-cc)); }
    __syncthreads();
    const int j = blockIdx.x * 64 + lane;
    float acc[9];
#pragma unroll
    for (int r = 0; r < 9; ++r) acc[r] = 0.f;
    const float* wp = p.w_ada + (size_t)(wave * 128) * 6144 + j;
#pragma unroll 1
    for (int k0 = 0; k0 < 128; k0 += 16) {
        float w[16];
#pragma unroll
        for (int kk = 0; kk < 16; ++kk) w[kk] = wp[(size_t)(k0 + kk) * 6144];
#pragma unroll
        for (int kk = 0; kk < 16; ++kk)
#pragma unroll
            for (int r = 0; r < 9; ++r) acc[r] = fmaf(sS[r * D + wave * 128 + k0 + kk], w[kk], acc[r]);
    }
#pragma unroll
    for (int r = 0; r < 9; ++r) sP[(wave * 9 + r) * 64 + lane] = acc[r];
    __syncthreads();
    for (int i = tid; i < 9 * 64; i += NTHREADS) { const int r = i >> 6, jj = i & 63; float s = p.b_ada[blockIdx.x * 64 + jj];
#pragma unroll
        for (int w = 0; w < 8; ++w) s += sP[(w * 9 + r) * 64 + jj];
        mod[r * 6144 + blockIdx.x * 64 + jj] = s; }
    __syncthreads();
}
__device__ void p0_tab(const Params& p, int wv) {
    float* tab = (float*)(p.ws + WS_TAB);
    const int gtid = blockIdx.x * NTHREADS + tid_opaque(wv), gsize = gridDim.x * NTHREADS;
    for (int idx = gtid; idx < 64 * 16; idx += gsize) {
        const int pos = idx >> 4, i = idx & 15;
        const float freq = exp2f(-(float)i * (13.287712379549449f / 16.f));
        const float ang = (float)pos * freq;
        const float n = rintf(ang * 0.15915494309189535f);
        float r = fmaf(-n, 6.28125f, ang); r = fmaf(-n, 1.9353071795864769e-3f, r);
        tab[idx * 2] = __cosf(r); tab[idx * 2 + 1] = __sinf(r);
    }
}
template <int MODE>
__device__ __forceinline__ void conv_item(const float* src, int K, int N, bf16_t* dst, int item, float* scr, int lane, const float* gA, const float* gB) {
    const int nblk = N / 32, kb = item / nblk, nb = item % nblk, k0 = 64 * kb, n0 = 32 * nb;
    const int c = lane & 31, kh = lane >> 5;
    const int nl = MODE == 1 ? 16 * (c & 1) + (c >> 1) : c;
    float v[32];
    const float* sp = src + (size_t)(k0 + kh) * N + n0 + c;
#pragma unroll
    for (int i = 0; i < 32; ++i) v[i] = sp[(size_t)(2 * i) * N];
#pragma unroll
    for (int i = 0; i < 32; ++i) { float x = v[i]; if (MODE == 2) { const int k = k0 + 2 * i + kh; x *= (k < 512 ? gA[k] : gB[k - 512]); } scr[(2 * i + kh) * 33 + nl] = x; }
    asm volatile("s_waitcnt lgkmcnt(0)" ::: "memory");
    const int ch = lane & 7;
#pragma unroll
    for (int j = 0; j < 4; ++j) { const int n = (lane >> 3) + 8 * j; const float* s = scr + (8 * ch) * 33 + n;
        u32x4 o; o.x = pk2(s[0 * 33], s[1 * 33]); o.y = pk2(s[2 * 33], s[3 * 33]); o.z = pk2(s[4 * 33], s[5 * 33]); o.w = pk2(s[6 * 33], s[7 * 33]);
        *(u32x4*)(dst + (size_t)(n0 + n) * K + k0 + 8 * ch) = o; }
    asm volatile("s_waitcnt lgkmcnt(0)" ::: "memory");
}
template <bool PERM1>
__device__ __forceinline__ void conv_item8(const float* src, int K, int N, unsigned char* dst, int item, float* scr, int lane) {
    const int nblk = N / 32, kb = item / nblk, nb = item % nblk, k0 = 64 * kb, n0 = 32 * nb;
    const int c = lane & 31, kh = lane >> 5;
    const int nl = PERM1 ? 16 * (c & 1) + (c >> 1) : c;
    float v[32];
    const float* sp = src + (size_t)(k0 + kh) * N + n0 + c;
#pragma unroll
    for (int i = 0; i < 32; ++i) v[i] = sp[(size_t)(2 * i) * N];
#pragma unroll
    for (int i = 0; i < 32; ++i) scr[(2 * i + kh) * 33 + nl] = v[i] * W8_SCALE;
    asm volatile("s_waitcnt lgkmcnt(0)" ::: "memory");
    const int ch = lane & 3;
#pragma unroll
    for (int j = 0; j < 2; ++j) { const int n = (lane >> 2) + 16 * j; const float* s = scr + (16 * ch) * 33 + n;
        u32x4 o; o.x = pk4_fp8(s[0 * 33], s[1 * 33], s[2 * 33], s[3 * 33]); o.y = pk4_fp8(s[4 * 33], s[5 * 33], s[6 * 33], s[7 * 33]);
        o.z = pk4_fp8(s[8 * 33], s[9 * 33], s[10 * 33], s[11 * 33]); o.w = pk4_fp8(s[12 * 33], s[13 * 33], s[14 * 33], s[15 * 33]);
        *(u32x4*)(dst + (size_t)(n0 + n) * K + k0 + 16 * ch) = o; }
    asm volatile("s_waitcnt lgkmcnt(0)" ::: "memory");
}
__device__ void p0_weights(const Params& p, unsigned char* ldsb, int wv) {
    const int tid = tid_opaque(wv), lane = tid & 63, wave = wv; float* scr = (float*)(ldsb + 57344 + wave * 8448);
    const int gw = blockIdx.x * (NTHREADS / 64) + wave, ngw = gridDim.x * (NTHREADS / 64);
    constexpr int I_IN = 16 * 72, I_OUT = 16 * 32, I_W1 = 16 * 64, I_W2 = 16 * 32;
    constexpr int NITEMS = I_IN + I_OUT + NE * I_W1 + NE * I_W2;
    for (int it = gw; it < NITEMS; it += ngw) {
        int r = it;
        if (r < I_IN) { conv_item<0>(p.w_in, D, INW, (bf16_t*)(p.ws + WS_WIN), r, scr, lane, nullptr, nullptr); continue; } r -= I_IN;
        if (r < I_OUT) { conv_item<2>(p.w_out, D, D, (bf16_t*)(p.ws + WS_WOUT), r, scr, lane, p.g_grp_a, p.g_grp_b); continue; } r -= I_OUT;
        if (r < NE * I_W1) { const int e = r / I_W1, q = r % I_W1;
            conv_item8<true>(p.w_mlp1 + (size_t)e * D * 2048, D, 2048, p.ws + WS_W1 + (size_t)e * 2048 * D, q, scr, lane); continue; } r -= NE * I_W1;
        { const int e = r / I_W2, q = r % I_W2;
            conv_item8<false>(p.w_mlp2 + (size_t)e * D * D, D, D, p.ws + WS_W2 + (size_t)e * D * D, q, scr, lane); }
    }
}

__device__ void p1_h(const Params& p, int wv) {
    const int tid = tid_opaque(wv), lane = tid & 63;
    const float* mod = (const float*)(p.ws + WS_MOD);
    bf16_t* hb = (bf16_t*)(p.ws + WS_HB);
    constexpr int R = 17;
    const int gwv = blockIdx.x * (NTHREADS / 64) + (tid >> 6);
    const int m0 = gwv * R; if (m0 >= MROWS) return;
    const int m1 = m0 + R < MROWS ? m0 + R : MROWS;
    f32x4 pB[4], pC[4], v[4], nv[4]; int curb = -1;
#define P1_ROWPTR(m) ((m) < NTOK ? p.x + (size_t)(m) * D : p.ctx + (size_t)((m) - NTOK) * D)
    { const float* xr = P1_ROWPTR(m0);
#pragma unroll
      for (int j = 0; j < 4; ++j) nv[j] = ((const f32x4*)xr)[lane + 64 * j]; }
    for (int m = m0; m < m1; ++m) {
#pragma unroll
        for (int j = 0; j < 4; ++j) v[j] = nv[j];
        if (m + 1 < m1) { const float* xr = P1_ROWPTR(m + 1);
#pragma unroll
            for (int j = 0; j < 4; ++j) nv[j] = ((const f32x4*)xr)[lane + 64 * j]; }
        const int b = m < NTOK ? m / L : 8;
        if (b != curb) { curb = b; const float* sh = mod + b * 6144, * sc = sh + 1024;
#pragma unroll
            for (int j = 0; j < 4; ++j) { const int c0 = 4 * (lane + 64 * j); pB[j] = *(const f32x4*)(p.g_pre_mix + c0) * (*(const f32x4*)(sc + c0) + 1.f); pC[j] = *(const f32x4*)(sh + c0); } }
        float s = 0.f;
#pragma unroll
        for (int j = 0; j < 4; ++j) s += v[j].x * v[j].x + v[j].y * v[j].y + v[j].z * v[j].z + v[j].w * v[j].w;
        const float rstd = rsqrtf(wave_sum(s) * (1.f / D) + EPS);
#pragma unroll
        for (int j = 0; j < 4; ++j) { const int c0 = 4 * (lane + 64 * j);
            const f32x4 o = (v[j] * rstd) * pB[j] + pC[j];
            u32x2 w; w.x = pk2(o.x, o.y); w.y = pk2(o.z, o.w);
            *(u32x2*)(hb + (size_t)m * D + c0) = w; }
    }
#undef P1_ROWPTR
}

namespace att {
#define ATT_LAS __attribute__((address_space(3)))
typedef float f32x16 __attribute__((ext_vector_type(16)));
typedef short bf16x8 __attribute__((ext_vector_type(8)));
typedef short s16x4 __attribute__((ext_vector_type(4)));
constexpr int SLOTB = 8192, NSLOT = 5;
constexpr int LDS_K = 0, LDS_V = NSLOT * SLOTB, LDS_WS = 2 * NSLOT * SLOTB, LDS_BT = LDS_WS + 8 * 256;
constexpr int BT_MARGIN = 128, BT_FLOATS = BT_MARGIN + 15 * 32 + 128;
constexpr float NEGBIG = -1e30f;
__device__ __forceinline__ int crow(int r, int hi) { return (r & 3) + 8 * (r >> 2) + 4 * hi; }
__device__ __forceinline__ unsigned cvtpk(float lo, float hi) { typedef float f2 __attribute__((ext_vector_type(2))); typedef __bf16 b2 __attribute__((ext_vector_type(2)));
    f2 v = {lo, hi}; b2 b = __builtin_convertvector(v, b2); return __builtin_bit_cast(unsigned, b); }
__device__ __forceinline__ s16x4 vtr(const ATT_LAS unsigned char* p) { typedef short v4i16 __attribute__((ext_vector_type(4)));
    return __builtin_bit_cast(s16x4, __builtin_amdgcn_ds_read_tr16_b64_v4i16((ATT_LAS v4i16*)p)); }
#define ATT_WAIT_BAR(N) asm volatile("s_waitcnt vmcnt(" #N ") lgkmcnt(0)\n\ts_barrier" ::: "memory")

__device__ __forceinline__ void dma_tile(ATT_LAS unsigned char* lds, int slot, const bf16_t* kbase, const bf16_t* vbase, int wid, int lane) {
    const bf16_t* ksrc = kbase + (size_t)lane * INW + wid * 8;
    const bf16_t* vsrc = vbase + (size_t)(16 * (wid & 3) + (lane >> 2)) * INW + (wid >> 2) * 32 + (lane & 3) * 8;
    __builtin_amdgcn_global_load_lds((const unsigned*)ksrc, (ATT_LAS unsigned*)(lds + LDS_K + slot * SLOTB + wid * 1024), 16, 0, 0);
    __builtin_amdgcn_global_load_lds((const unsigned*)vsrc, (ATT_LAS unsigned*)(lds + LDS_V + slot * SLOTB + wid * 1024), 16, 0, 0);
}

template <bool ISB>
__device__ __forceinline__ void attn_unit(const Params& p, ATT_LAS unsigned char* lds, int unit, int wv) {
    const int tid = tid_opaque(wv), lane = tid & 63, r32 = lane & 31, hi = lane >> 5; const int wid = wv;
    const bf16_t* qkv = (const bf16_t*)(p.ws + WS_QKV); bf16_t* ob = (bf16_t*)(p.ws + WS_O);
    ATT_LAS float* wsf = (ATT_LAS float*)(lds + LDS_WS) + wid * 64;
    ATT_LAS float* bt = (ATT_LAS float*)(lds + LDS_BT);
    int b, h, kcol, vcol, qcol, ocol, q0, nloc, row_lo = 0, qr = 0, half = 0, qb = 0, jlo = 0;
    if (!ISB) { b = unit >> 7; const int kvh = (unit >> 6) & 1; qb = unit & 63; h = kvh * 4 + (wid >> 1); half = wid & 1; q0 = qb * 64 + 32 * half;
        kcol = C_KA + kvh * 64; vcol = C_VA + kvh * 64; qcol = C_QA + h * 64; ocol = h * 64;
        jlo = 2 - qb > 0 ? 2 - qb : 0; const int jhi = 65 - qb < 4 ? 65 - qb : 4; nloc = jhi - jlo + 1;
    } else { b = unit >> 7; h = (unit >> 4) & 7; const int g = unit & 15;
        qr = 4 * g + 2 * (wid >> 2) + (r32 >> 4); half = wid & 3; q0 = 0;
        kcol = C_KB + h * 64; vcol = C_VB + h * 64; qcol = C_QB + h * 64; ocol = 512 + h * 64;
        const int r0 = 4 * g, r3 = 4 * g + 3; row_lo = r0 - 4 < 0 ? 0 : (r0 - 4 > 56 ? 56 : r0 - 4); const int rs3 = r3 - 4 < 0 ? 0 : (r3 - 4 > 56 ? 56 : r3 - 4); nloc = rs3 + 7 - row_lo + 1;
    }
    const int NT = nloc + 4;
    const bf16_t* lat = qkv + (size_t)b * L * INW; const bf16_t* cx = qkv + (size_t)(NTOK + b * CTX) * INW;
#define ATT_TILE_ROW(t) ((t) < nloc ? lat + (size_t)(ISB ? (row_lo + (t)) * 64 : (qb - 2 + jlo + (t)) * 64) * INW : cx + (size_t)((t) - nloc) * 64 * INW)
    const int rsq = qr - 4 < 0 ? 0 : (qr - 4 > 56 ? 56 : qr - 4);
    const int qrw = 4 * (unit & 15) + 2 * (wid >> 2);
    const int lo_w = qrw - 4 < 0 ? 0 : (qrw - 4 > 56 ? 56 : qrw - 4), hi_w = (qrw - 3 < 0 ? 0 : (qrw - 3 > 56 ? 56 : qrw - 3)) + 7;
    const int bs = ISB ? (half == 0 ? 0 : half == 1 ? 8 : half == 2 ? 24 : 32) : 0;
#define ATT_ACTIVE(t) (!(ISB && (t) < nloc) || ((row_lo + (t) >= lo_w) && (row_lo + (t) <= hi_w)))
    if (ISB) {
        for (int i = tid; i < BT_FLOATS; i += NTHREADS) { const int j = i - BT_MARGIN; float v = 0.f;
            if (j >= 0 && j < 15 * 32 && (j & 31) < 31) v = p.rpb_b[(h * 15 + (j >> 5)) * 31 + (j & 31)] * LOG2E;
            bt[i] = v; }
    }
#pragma unroll
    for (int t0 = 0; t0 < NSLOT - 1; ++t0) { const bf16_t* r0p = ATT_TILE_ROW(t0); dma_tile(lds, t0, r0p + kcol, r0p + vcol, wid, lane); }
    bf16x8 qf[4];
    const int qc = ISB ? 16 * half + (r32 & 15) : 32 * half + r32;
    { const bf16_t* qp = lat + (size_t)(ISB ? qr * 64 + qc : q0 + r32) * INW + qcol + hi * 8;
#pragma unroll
      for (int d0 = 0; d0 < 4; ++d0) qf[d0] = *(const bf16x8*)(qp + d0 * 16); }
    float mref = 0.f, l_run = 0.f;
    if (!ISB) l_run = hi == 0 ? __builtin_amdgcn_exp2f(p.sink_a[h] * LOG2E) : 0.f;
    f32x16 o0, o1, negm;
#pragma unroll
    for (int r = 0; r < 16; ++r) { o0[r] = 0.f; o1[r] = 0.f; negm[r] = 0.f; }
    const int cs = qc - 8 < 0 ? 0 : (qc - 8 > 48 ? 48 : qc - 8);
    f32x16 pc0, pc1, pn0, pn1; float ref_cur = 0.f, ref_next = 0.f; bool act_cur = false, act_next = false;
#pragma unroll
    for (int r = 0; r < 16; ++r) { pn0[r] = 0.f; pn1[r] = 0.f; }
#define ATT_QK(SLOT, LOCB) do { const ATT_LAS unsigned char* kb_ = lds + LDS_K + (SLOT) * SLOTB + hi * 1024 + r32 * 16; \
        if (LOCB) { _Pragma("unroll") for (int d0 = 0; d0 < 4; ++d0) { \
            const bf16x8 k0_ = *(const ATT_LAS bf16x8*)(kb_ + bs * 16 + d0 * 2048); \
            pn0 = __builtin_amdgcn_mfma_f32_32x32x16_bf16(k0_, qf[d0], d0 == 0 ? negm : pn0, 0, 0, 0); } } \
        else { _Pragma("unroll") for (int d0 = 0; d0 < 4; ++d0) { \
            const bf16x8 k0_ = *(const ATT_LAS bf16x8*)(kb_ + d0 * 2048), k1_ = *(const ATT_LAS bf16x8*)(kb_ + d0 * 2048 + 512); \
            pn0 = __builtin_amdgcn_mfma_f32_32x32x16_bf16(k0_, qf[d0], d0 == 0 ? negm : pn0, 0, 0, 0); \
            pn1 = __builtin_amdgcn_mfma_f32_32x32x16_bf16(k1_, qf[d0], d0 == 0 ? negm : pn1, 0, 0, 0); } } } while (0)
    ATT_WAIT_BAR(6);
    act_next = ATT_ACTIVE(0);
    if (act_next) { ATT_QK(0, ISB); ref_next = mref; }
    int sc = 0, sn = 1, si = NSLOT - 1;
    for (int t = 0; t < NT; ++t) {
        const int ahead = NT - 2 - t < 0 ? 0 : (NT - 2 - t < 2 ? NT - 2 - t : 2);
        if (ahead == 2) ATT_WAIT_BAR(4); else if (ahead == 1) ATT_WAIT_BAR(2); else ATT_WAIT_BAR(0);
        if (t + NSLOT - 1 < NT) { const bf16_t* rp = ATT_TILE_ROW(t + NSLOT - 1); dma_tile(lds, si, rp + kcol, rp + vcol, wid, lane); }
        pc0 = pn0; pc1 = pn1; ref_cur = ref_next; act_cur = act_next;
        act_next = (t + 1 < NT) && ATT_ACTIVE(t + 1);
        if (act_next) { if (ISB && t + 1 < nloc) ATT_QK(sn, true); else ATT_QK(sn, false); ref_next = mref; }
        if (act_cur) {
            if (ISB) {
                if (t < nloc) {
                    const int kr = row_lo + t;
                    const ATT_LAS float* bp = bt + BT_MARGIN + (kr - qr + 7) * 32 + 15 - qc + bs + 4 * hi;
                    const int e0 = ((kr >= rsq) && (kr <= rsq + 7)) ? bs + 4 * hi - cs : 0x4000;
#pragma unroll
                    for (int r = 0; r < 16; ++r) { const int c = (r & 3) + 8 * (r >> 2);
                        const float b0 = bp[c];
                        pc0[r] = ((unsigned)(c + e0) < 16u) ? pc0[r] + b0 : NEGBIG; }
                }
            } else {
                if (t < nloc) { const int j = jlo + t; const int qq = 32 * half + r32;
                    if (j == 0) {
#pragma unroll
                        for (int r = 0; r < 16; ++r) { const int c = crow(r, hi); if (c < qq) pc0[r] = NEGBIG; if (c + 32 < qq) pc1[r] = NEGBIG; }
                    } else if (j == 4) {
#pragma unroll
                        for (int r = 0; r < 16; ++r) { const int c = crow(r, hi); if (c > qq) pc0[r] = NEGBIG; if (c + 32 > qq) pc1[r] = NEGBIG; }
                    }
                }
            }
            const bool locb = ISB && (t < nloc);
            float rm;
            if (locb) { rm = fmaxf(pc0[0], pc0[1]);
#pragma unroll
                for (int r = 2; r < 16; r += 2) rm = fmaxf(fmaxf(rm, pc0[r]), pc0[r + 1]); }
            else { rm = fmaxf(pc0[0], pc1[0]);
#pragma unroll
                for (int r = 1; r < 16; ++r) rm = fmaxf(fmaxf(rm, pc0[r]), pc1[r]); }
            rm = fmaxf(rm, __shfl_xor(rm, 32));
            const float delta = mref - ref_cur;
            constexpr float RESC_THR = 8.f;
            const float dl = __any(rm - delta > RESC_THR) ? fmaxf(rm - delta, 0.f) : 0.f;
            const float sh = delta + dl;
            if (__any(dl > 0.f)) {
                const float f = __builtin_amdgcn_exp2f(-dl);
                l_run *= f; mref += dl;
                if (hi == 0) wsf[r32] = f;
                asm volatile("s_waitcnt lgkmcnt(0)" ::: "memory");
#pragma unroll
                for (int r = 0; r < 16; ++r) { const float fr_ = wsf[crow(r, hi)]; o0[r] *= fr_; o1[r] *= fr_; negm[r] = -mref; }
            }
            if (__any(sh != 0.f)) {
#pragma unroll
                for (int r = 0; r < 16; ++r) { pc0[r] -= sh; pc1[r] -= sh; }
            }
            float ls = 0.f, ls2 = 0.f;
#pragma unroll
            for (int r = 0; r < 16; r += 2) { pc0[r] = __builtin_amdgcn_exp2f(pc0[r]); pc0[r + 1] = __builtin_amdgcn_exp2f(pc0[r + 1]); ls += pc0[r]; ls2 += pc0[r + 1]; }
            if (!locb) {
#pragma unroll
                for (int r = 0; r < 16; r += 2) { pc1[r] = __builtin_amdgcn_exp2f(pc1[r]); pc1[r + 1] = __builtin_amdgcn_exp2f(pc1[r + 1]); ls += pc1[r]; ls2 += pc1[r + 1]; }
            }
            l_run += ls + ls2;
            typedef unsigned u4 __attribute__((ext_vector_type(4)));
            const u4 pw0 = {cvtpk(pc0[0], pc0[1]), cvtpk(pc0[2], pc0[3]), cvtpk(pc0[4], pc0[5]), cvtpk(pc0[6], pc0[7])};
            const u4 pw1 = {cvtpk(pc0[8], pc0[9]), cvtpk(pc0[10], pc0[11]), cvtpk(pc0[12], pc0[13]), cvtpk(pc0[14], pc0[15])};
            const ATT_LAS unsigned char* vp = lds + LDS_V + sc * SLOTB + ((lane >> 4) & 1) * 32 + (lane & 3) * 8 + (4 * hi + ((lane & 15) >> 2)) * 64 + (locb ? bs * 64 : 0);
#define ATT_PV(OACC, PW, D0, KS) do { const s16x4 lo_ = vtr(vp + (D0) * 4096 + (KS) * 1024), hi_ = vtr(vp + (D0) * 4096 + (KS) * 1024 + 512); \
                const bf16x8 vf_ = {lo_[0], lo_[1], lo_[2], lo_[3], hi_[0], hi_[1], hi_[2], hi_[3]}; \
                OACC = __builtin_amdgcn_mfma_f32_32x32x16_bf16(__builtin_bit_cast(bf16x8, PW), vf_, OACC, 0, 0, 0); } while (0)
            ATT_PV(o0, pw0, 0, 0); ATT_PV(o1, pw0, 1, 0); ATT_PV(o0, pw1, 0, 1); ATT_PV(o1, pw1, 1, 1);
            if (!locb) {
                const u4 pw2 = {cvtpk(pc1[0], pc1[1]), cvtpk(pc1[2], pc1[3]), cvtpk(pc1[4], pc1[5]), cvtpk(pc1[6], pc1[7])};
                const u4 pw3 = {cvtpk(pc1[8], pc1[9]), cvtpk(pc1[10], pc1[11]), cvtpk(pc1[12], pc1[13]), cvtpk(pc1[14], pc1[15])};
                ATT_PV(o0, pw2, 0, 2); ATT_PV(o1, pw2, 1, 2); ATT_PV(o0, pw3, 0, 3); ATT_PV(o1, pw3, 1, 3);
            }
#undef ATT_PV
        }
        sc = sn; sn = sn + 1 == NSLOT ? 0 : sn + 1; si = si + 1 == NSLOT ? 0 : si + 1;
    }
    l_run += __shfl_xor(l_run, 32);
    if (hi == 0) wsf[32 + r32] = l_run;
    asm volatile("s_waitcnt lgkmcnt(0)" ::: "memory");
    bf16_t* op = ob + (size_t)(b * L) * D + ocol + r32;
    float* ossp = (float*)(p.ws + WS_OSS) + (size_t)(b * L) * 16 + (ocol >> 6);
#pragma unroll
    for (int r = 0; r < 16; ++r) { const int qi = crow(r, hi); const float inv = __builtin_amdgcn_rcpf(wsf[32 + qi]);
        const int q = ISB ? (qrw + (qi >> 4)) * 64 + 16 * half + (qi & 15) : q0 + qi;
        const float a0 = o0[r] * inv, a1 = o1[r] * inv;
        op[(size_t)q * D] = (bf16_t)f2bf(a0); op[(size_t)q * D + 32] = (bf16_t)f2bf(a1);
        const float ss = row_sum16(a0 * a0 + a1 * a1);
        const float s01 = rdlane(ss, 0) + rdlane(ss, 16), s23 = rdlane(ss, 32) + rdlane(ss, 48);
        if (r32 == 0) ossp[(size_t)q * 16] = hi ? s23 : s01; }
    ATT_WAIT_BAR(0);
#undef ATT_TILE_ROW
#undef ATT_ACTIVE
#undef ATT_QK
}

__device__ __forceinline__ void attn_phase(const Params& p, ATT_LAS unsigned char* lds, int wv) {
    const int G = gridDim.x, bx = blockIdx.x;
    const int vcu = (G % 8 == 0) ? (bx % 8) * (G / 8) + bx / 8 : bx;
    for (int u = vcu; u < 2048; u += G) {
        if (u < 1024) attn_unit<false>(p, lds, u, wv); else attn_unit<true>(p, lds, u - 1024, wv);
    }
}
}

constexpr int SW_STRIDE = 36;

__device__ void p4c_post(const Params& p, LAS3 float* sW, int wv) {
    const int tid = tid_opaque(wv), lane = tid & 63;
    const float* mod = (const float*)(p.ws + WS_MOD); const bf16_t* mix = (const bf16_t*)(p.ws + WS_MIX);
    unsigned char* h8 = p.ws + WS_HB;
    unsigned* counts = (unsigned*)(p.ws + WS_CTL);
    int* eslot = (int*)(p.ws + WS_ESLOT); float* ew = (float*)(p.ws + WS_EW);
    const int wave = tid >> 6;
    LAS3 int* lcnt = (LAS3 int*)(sW + 1024 * SW_STRIDE) + 128;
    LAS3 int* lbase = lcnt + 32;
    LAS3 int* stg_slot = lbase + 32; LAS3 int* stg_e = stg_slot + 512; LAS3 float* stg_w = (LAS3 float*)(stg_e + 512);
    if (tid < NE) lcnt[tid] = 0;
    for (int i = tid; i < D * 8; i += NTHREADS) { const int k = i >> 3, e4 = i & 7; const f32x4 w = ((const f32x4*)p.w_router)[i];
        LAS3 float* d = sW + ((k & 3) * 256 + (k >> 2)) * SW_STRIDE + e4 * 4; *(LAS3 f32x4*)d = w; }
    __syncthreads();
    constexpr int R = 16;
    const int m0 = ((int)blockIdx.x * (NTHREADS / 64) + wave) * R;
    if (m0 < NTOK) {
        const int b = m0 / L; const float* mb = mod + b * 6144;
        f32x4 pA[4], pB[4], pC[4], v[4], xx[4], nx[4]; u32x2 nv[4];
#pragma unroll
        for (int j = 0; j < 4; ++j) { const int c0 = 4 * (lane + 64 * j);
            pA[j] = *(const f32x4*)(p.g_post_mix + c0) * *(const f32x4*)(mb + 2048 + c0);
            pB[j] = *(const f32x4*)(p.g_pre_ffn + c0) * (*(const f32x4*)(mb + 4096 + c0) + 1.f);
            pC[j] = *(const f32x4*)(mb + 3072 + c0);
            nv[j] = ((const u32x2*)(mix + (size_t)m0 * D))[lane + 64 * j]; nx[j] = ((const f32x4*)(p.x + (size_t)m0 * D))[lane + 64 * j]; }
        for (int it = 0; it < R; ++it) {
            const int m = m0 + it;
#pragma unroll
            for (int j = 0; j < 4; ++j) { v[j] = (f32x4){__uint_as_float(nv[j].x << 16), __uint_as_float(nv[j].x & 0xffff0000u), __uint_as_float(nv[j].y << 16), __uint_as_float(nv[j].y & 0xffff0000u)}; xx[j] = nx[j]; }
            if (it + 1 < R) {
#pragma unroll
                for (int j = 0; j < 4; ++j) { nv[j] = ((const u32x2*)(mix + (size_t)(m + 1) * D))[lane + 64 * j]; nx[j] = ((const f32x4*)(p.x + (size_t)(m + 1) * D))[lane + 64 * j]; }
            }
            float s = 0.f;
#pragma unroll
            for (int j = 0; j < 4; ++j) s += v[j].x * v[j].x + v[j].y * v[j].y + v[j].z * v[j].z + v[j].w * v[j].w;
            float rstd = rsqrtf(wave_sum(s) * (1.f / D) + EPS);
            s = 0.f;
            f32x4 xv[4];
#pragma unroll
            for (int j = 0; j < 4; ++j) {
                xv[j] = xx[j] + pA[j] * (v[j] * rstd);
                ((f32x4*)(p.out + (size_t)m * D))[lane + 64 * j] = xv[j];
                s += xv[j].x * xv[j].x + xv[j].y * xv[j].y + xv[j].z * xv[j].z + xv[j].w * xv[j].w; }
            rstd = rsqrtf(wave_sum(s) * (1.f / D) + EPS);
            float lg[NE];
#pragma unroll
            for (int e = 0; e < NE; ++e) lg[e] = 0.f;
#pragma unroll
            for (int j = 0; j < 4; ++j) { const int c0 = 4 * (lane + 64 * j);
                const f32x4 h2 = (xv[j] * rstd) * pB[j] + pC[j];
                *(unsigned*)(h8 + (size_t)m * D + c0) = pk4_fp8(h2.x, h2.y, h2.z, h2.w);
#pragma unroll
                for (int q = 0; q < 4; ++q) { const float hv = h2[q]; const LAS3 f32x4* wr = (const LAS3 f32x4*)(sW + (q * 256 + lane + 64 * j) * SW_STRIDE);
#pragma unroll
                    for (int e4 = 0; e4 < 8; ++e4) { const f32x4 ww = wr[e4]; lg[e4 * 4] = fmaf(hv, ww.x, lg[e4 * 4]); lg[e4 * 4 + 1] = fmaf(hv, ww.y, lg[e4 * 4 + 1]); lg[e4 * 4 + 2] = fmaf(hv, ww.z, lg[e4 * 4 + 2]); lg[e4 * 4 + 3] = fmaf(hv, ww.w, lg[e4 * 4 + 3]); }
                    asm volatile("" ::: "memory"); }
            }
#pragma unroll
            for (int e = 0; e < NE; ++e) lg[e] = wave_sum(lg[e]) + p.b_router[e];
            float tv[4]; int ti[4]; unsigned used = 0u;
#pragma unroll
            for (int k = 0; k < 4; ++k) { float best = -3.4e38f; int bi = 0;
#pragma unroll
                for (int e = 0; e < NE; ++e) { const bool ok = !((used >> e) & 1u) && lg[e] > best; best = ok ? lg[e] : best; bi = ok ? e : bi; }
                tv[k] = best; ti[k] = bi; used |= 1u << bi; }
            const float e1 = __expf(tv[1] - tv[0]), e2 = __expf(tv[2] - tv[0]), e3 = __expf(tv[3] - tv[0]); const float inv = 1.f / (1.f + e1 + e2 + e3);
            const float tw[4] = {inv, e1 * inv, e2 * inv, e3 * inv};
            if (lane < 4) {
                int myi = ti[0]; float myw = tw[0];
#pragma unroll
                for (int k = 1; k < 4; ++k) if (lane == k) { myi = ti[k]; myw = tw[k]; }
                const int lr = __hip_atomic_fetch_add((LAS3 int*)&lcnt[myi], 1, __ATOMIC_RELAXED, __HIP_MEMORY_SCOPE_WORKGROUP);
                const int si = (wave * 16 + it) * 4 + lane;
                stg_slot[si] = m * 4 + lane; stg_e[si] = myi | (lr << 8); stg_w[si] = myw;
            }
        }
    }
    __syncthreads();
    if (tid < NE) { const int c = lcnt[tid]; lbase[tid] = c ? (int)atomicAdd(&counts[tid * 64], (unsigned)c) : 0; }
    __syncthreads();
    { const int si = tid, w = si >> 6;
      if (((int)blockIdx.x * (NTHREADS / 64) + w) * R < NTOK) {
        const int ee = stg_e[si], e = ee & 255, lr = ee >> 8; const int rank = lbase[e] + lr;
        eslot[(size_t)e * ECAP + rank] = stg_slot[si]; ew[(size_t)e * ECAP + rank] = stg_w[si]; } }
    __syncthreads();
}
__device__ __forceinline__ void expert_bases(const unsigned* counts, int* sbase_  , int wv) {
    LAS3 int* sbase = (LAS3 int*)sbase_;
    if (wv == 0) {
        const int lane = lane_id(); const int cn = lane < NE ? (int)counts[lane * 64] : 0; const int c = (cn + 255) & ~255;
        int incl = c;
#pragma unroll
        for (int o = 1; o < 32; o <<= 1) { const int v = __shfl_up(incl, o); if (lane >= o) incl += v; }
        if (lane < NE) { sbase[lane] = incl - c; sbase[40 + lane] = cn; }
        if (lane == NE - 1) sbase[NE] = incl;
    }
    __syncthreads();
}
typedef float f32x2v __attribute__((ext_vector_type(2)));
__device__ __forceinline__ void p6_load(const unsigned char* y, const float* out, int m, int lane, u32x2 (&yv)[2][4], f32x4 (&xv)[2][2]) {
#pragma unroll
    for (int j = 0; j < 2; ++j) { const int c0 = 8 * (lane + 64 * j);
#pragma unroll
        for (int k = 0; k < 4; ++k) yv[j][k] = *(const u32x2*)(y + (size_t)(m * 4 + k) * D + c0);
        xv[j][0] = *(const f32x4*)(out + (size_t)m * D + c0); xv[j][1] = *(const f32x4*)(out + (size_t)m * D + c0 + 4); }
}
__device__ void p6_final(const Params& p, int wv) {
    const int tid = tid_opaque(wv), lane = tid & 63;
    const float* mod = (const float*)(p.ws + WS_MOD); const unsigned char* y = p.ws + WS_Y;
    constexpr int R = 16;
    const int m0 = ((int)blockIdx.x * (NTHREADS / 64) + (tid >> 6)) * R;
    if (m0 >= NTOK) return;
    const int b = m0 / L; const float* ga2 = mod + b * 6144 + 5120;
    f32x4 pA[2][2];
#pragma unroll
    for (int j = 0; j < 2; ++j)
#pragma unroll
        for (int q = 0; q < 2; ++q) { const int c0 = 8 * (lane + 64 * j) + 4 * q; pA[j][q] = *(const f32x4*)(p.g_post_ffn + c0) * *(const f32x4*)(ga2 + c0); }
    u32x2 yv[2][4], ny[2][4]; f32x4 xv[2][2], nx[2][2];
    p6_load(y, p.out, m0, lane, ny, nx);
    for (int it = 0; it < R; ++it) {
        const int m = m0 + it;
#pragma unroll
        for (int j = 0; j < 2; ++j) {
#pragma unroll
            for (int k = 0; k < 4; ++k) yv[j][k] = ny[j][k];
            xv[j][0] = nx[j][0]; xv[j][1] = nx[j][1]; }
        if (it + 1 < R) p6_load(y, p.out, m + 1, lane, ny, nx);
        f32x4 a[2][2]; float s = 0.f;
#pragma unroll
        for (int j = 0; j < 2; ++j) { a[j][0] = (f32x4){0.f, 0.f, 0.f, 0.f}; a[j][1] = (f32x4){0.f, 0.f, 0.f, 0.f};
#pragma unroll
            for (int k = 0; k < 4; ++k) { const u32x2 w = yv[j][k];
                const f32x2v l0 = __builtin_amdgcn_cvt_pk_f32_fp8((int)w.x, false), l1 = __builtin_amdgcn_cvt_pk_f32_fp8((int)w.x, true);
                const f32x2v h0 = __builtin_amdgcn_cvt_pk_f32_fp8((int)w.y, false), h1 = __builtin_amdgcn_cvt_pk_f32_fp8((int)w.y, true);
                a[j][0].x += l0.x; a[j][0].y += l0.y; a[j][0].z += l1.x; a[j][0].w += l1.y;
                a[j][1].x += h0.x; a[j][1].y += h0.y; a[j][1].z += h1.x; a[j][1].w += h1.y; }
#pragma unroll
            for (int q = 0; q < 2; ++q) { a[j][q] = a[j][q] * Y8_INV; s += a[j][q].x * a[j][q].x + a[j][q].y * a[j][q].y + a[j][q].z * a[j][q].z + a[j][q].w * a[j][q].w; } }
        const float rstd = rsqrtf(wave_sum(s) * (1.f / D) + EPS);
#pragma unroll
        for (int j = 0; j < 2; ++j)
#pragma unroll
            for (int q = 0; q < 2; ++q) { const int c0 = 8 * (lane + 64 * j) + 4 * q;
                *(f32x4*)(p.out + (size_t)m * D + c0) = xv[j][q] + pA[j][q] * (a[j][q] * rstd); }
    }
}

constexpr int LDS_SBASE = 147456;
constexpr int LDS_BYTES = LDS_SBASE + 512 + (64 + 3 * 512) * 4 + 256;

__global__ void __launch_bounds__(NTHREADS, 2) fwd_kernel(Params p) {
    cg::grid_group grid = cg::this_grid();
    extern __shared__ __attribute__((aligned(16))) unsigned char lds[];
    int* sbase = (int*)(lds + LDS_SBASE);
    PG8_LAS unsigned char* lds3 = (PG8_LAS unsigned char*)lds;
    const PG8_LAS int* sbase3 = (const PG8_LAS int*)(lds3 + LDS_SBASE);
    volatile LAS3 unsigned* bst = (volatile LAS3 unsigned*)(lds3 + LDS_SBASE + 384);
    const int wv = __builtin_amdgcn_readfirstlane((int)(threadIdx.x >> 6));
    if (wv == 0 && lane_id() < 2) bst[lane_id()] = 0u;
    __syncthreads();
    XcdBarrier xb = xcd_barrier_post((unsigned*)(p.ws + WS_CTL) + CW_BAR, bst, wv);

    p0_mod(p, (float*)lds, (float*)(lds + 36864), wv);
    p0_tab(p, wv);
    p0_weights(p, lds, wv);
    grid.sync();
    p1_h(p, wv);
    xcd_barrier(xb);
    { pg8::Gemm g{(const bf16_t*)(p.ws + WS_HB), (const bf16_t*)(p.ws + WS_WIN), D, 0, nullptr, sbase3, wv};
      pg8::StaticOrder S; S.init(MROWS, INW, (int)gridDim.x, (int)blockIdx.x, nullptr);
      { const int t_ = tid_opaque(wv); *(PG8_LAS f32x4*)(lds3 + pg8::PAR_TAB + t_ * 16) = ((const f32x4*)(p.ws + WS_TAB))[t_]; }
      __syncthreads();
      pg8::EpiQKV E{(bf16_t*)(p.ws + WS_QKV)};
      pg8::gemm_phase<pg8::EpiQKV, pg8::StaticOrder, false, true>(lds3, g, S, E); }
    xcd_barrier(xb);
    att::attn_phase(p, lds3, wv);
    xcd_barrier(xb);
    { pg8::Gemm g{(const bf16_t*)(p.ws + WS_O), (const bf16_t*)(p.ws + WS_WOUT), D, 0, nullptr, sbase3, wv};
      pg8::StaticOrder S; S.init(NTOK, D, (int)gridDim.x, (int)blockIdx.x, nullptr);
      pg8::EpiOutProj E{(bf16_t*)(p.ws + WS_MIX), (const float*)(p.ws + WS_OSS)};
      pg8::gemm_phase<pg8::EpiOutProj, pg8::StaticOrder, false, true>(lds3, g, S, E); }
    xcd_barrier(xb);
    p4c_post(p, (LAS3 float*)lds3, wv);
    xcd_barrier(xb);
    expert_bases((const unsigned*)(p.ws + WS_CTL), sbase, wv);
    { const int total = sbase3[NE];
      pg8::Gemm g{(const bf16_t*)(p.ws + WS_HB), (const bf16_t*)(p.ws + WS_W1), D / 2, (size_t)2048 * D, (const int*)(p.ws + WS_ESLOT), sbase3, wv};
      pg8::StaticOrder S; S.init(total, 2048, (int)gridDim.x, (int)blockIdx.x, sbase3);
      pg8::EpiSwiglu E{p.ws + WS_ACT, p.b_mlp1};
      pg8::gemm_phase<pg8::EpiSwiglu, pg8::StaticOrder, true, true, true>(lds3, g, S, E); }
    xcd_barrier(xb);
    { const int total = sbase3[NE];
      pg8::Gemm g{(const bf16_t*)(p.ws + WS_ACT), (const bf16_t*)(p.ws + WS_W2), D / 2, (size_t)D * D, nullptr, sbase3, wv};
      pg8::StaticOrder S; S.init(total, D, (int)gridDim.x, (int)blockIdx.x, sbase3);
      pg8::EpiScatter E{p.ws + WS_Y, p.b_mlp2, (const int*)(p.ws + WS_ESLOT), (const float*)(p.ws + WS_EW), sbase3};
      pg8::gemm_phase<pg8::EpiScatter, pg8::StaticOrder, false, true, true>(lds3, g, S, E); }
    xcd_barrier(xb);
    p6_final(p, wv);
}

extern "C" void kernel_launch(void* const* d_in, const int* in_sizes, int n_in, void* d_out, int out_size, void* d_ws, size_t ws_size, hipStream_t stream) {
    static int grid_blocks = 0;
    if (grid_blocks == 0) {
        if (n_in != 22 || ws_size < WS_END) { fprintf(stderr, "kernel_launch: unexpected n_in %d / ws_size %zu (need %zu)\n", n_in, ws_size, (size_t)WS_END); grid_blocks = -1; return; }
        int dev = 0, cus = 0, per_cu = 0;
        (void)hipGetDevice(&dev);
        (void)hipDeviceGetAttribute(&cus, hipDeviceAttributeMultiprocessorCount, dev);
        if (hipFuncSetAttribute((const void*)fwd_kernel, hipFuncAttributeMaxDynamicSharedMemorySize, LDS_BYTES) != hipSuccess) { fprintf(stderr, "kernel_launch: hipFuncSetAttribute failed\n"); grid_blocks = -1; return; }
        (void)hipOccupancyMaxActiveBlocksPerMultiprocessor(&per_cu, (const void*)fwd_kernel, NTHREADS, LDS_BYTES);
        if (per_cu < 1) { fprintf(stderr, "kernel_launch: occupancy query returned %d\n", per_cu); grid_blocks = -1; return; }
        grid_blocks = cus;
        if (grid_blocks * (NTHREADS / 64) * 16 < NTOK) { fprintf(stderr, "kernel_launch: needs >= 256 CUs (got %d)\n", cus); grid_blocks = -1; return; }
    }
    if (grid_blocks < 0) return;
    (void)hipMemsetAsync((char*)d_ws + WS_CTL, 0, CTL_BYTES, stream);
    Params p{};
    const float** pp = (const float**)&p;
    for (int i = 0; i < 22; ++i) pp[i] = (const float*)d_in[i];
    p.out = (float*)d_out; p.ws = (unsigned char*)d_ws;
    void* args[] = {&p};
    hipError_t e = hipLaunchCooperativeKernel((const void*)fwd_kernel, dim3(grid_blocks), dim3(NTHREADS), args, LDS_BYTES, stream);
    if (e != hipSuccess) fprintf(stderr, "cooperative launch failed: %s (grid %d)\n", hipGetErrorString(e), grid_blocks);
}
```

```cpp
#include <hip/hip_runtime.h>
#include <hip/hip_cooperative_groups.h>
#include <cstdio>
#include <cstdint>
namespace cg = cooperative_groups;

constexpr int D = 1024, NB = 8, L = 4096, CTX = 256;
constexpr int NTOK = NB * L, NCTX = NB * CTX, MROWS = NTOK + NCTX;
constexpr int INW = 2304;
constexpr int C_QA = 0, C_KA = 512, C_VA = 640, C_QB = 768, C_KB = 1280, C_VB = 1792;
constexpr int NE = 32, TOPK = 4, NASG = NTOK * TOPK;
constexpr int PADROWS = NASG + NE * 256;
constexpr float LOG2E = 1.4426950408889634f;
constexpr float QSCALE = 0.125f * LOG2E;
constexpr float EPS = 1e-6f;
constexpr int NTHREADS = 512;

constexpr size_t MiB = 1u << 20;
constexpr size_t WS_CTL = 0;
constexpr size_t CTL_BYTES = 32768;
constexpr int CW_BAR = 2048;
constexpr size_t WS_MOD = 1 * MiB;
constexpr size_t WS_TAB = 1 * MiB + 256 * 1024;
constexpr size_t WS_OSTAT = 1 * MiB + 512 * 1024;
constexpr size_t WS_WIN = 2 * MiB;
constexpr size_t WS_WOUT = 7 * MiB;
constexpr size_t WS_W2 = 9 * MiB;
constexpr size_t WS_OSS = 41 * MiB;
constexpr size_t WS_W1 = 73 * MiB;
constexpr size_t WS_HB = 201 * MiB;
constexpr int ECAP = NTOK;
constexpr size_t WS_ESLOT = 269 * MiB;
constexpr size_t WS_EW = 273 * MiB;
constexpr size_t WS_QKV = 277 * MiB;
constexpr size_t WS_O = 430 * MiB;
constexpr size_t WS_MIX = 494 * MiB;
constexpr size_t WS_ACT = 277 * MiB;
constexpr size_t WS_Y = 622 * MiB;
constexpr size_t WS_END = 878 * MiB;
static_assert(WS_W1 + (size_t)NE * 2048 * D * 2 <= WS_HB && WS_W2 + (size_t)NE * D * D * 2 <= WS_W1, "map");
static_assert(WS_HB + (size_t)MROWS * D * 2 <= WS_ESLOT && WS_ESLOT + (size_t)NE * ECAP * 4 <= WS_EW && WS_EW + (size_t)NE * ECAP * 4 <= WS_QKV, "map");
static_assert(WS_QKV + (size_t)MROWS * INW * 2 <= WS_O && WS_O + (size_t)NTOK * D * 2 <= WS_MIX && WS_MIX + (size_t)NTOK * D * 4 <= WS_Y, "map");
static_assert(WS_ACT + (size_t)PADROWS * 1024 * 2 <= WS_Y && WS_Y + (size_t)NASG * D * 2 <= WS_END, "map");

typedef unsigned short bf16_t;
typedef float f32x4 __attribute__((ext_vector_type(4)));
typedef unsigned u32x4 __attribute__((ext_vector_type(4)));
typedef unsigned u32x2 __attribute__((ext_vector_type(2)));

struct Params {
    const float *x, *c, *ctx, *c_ctx, *w_ada, *b_ada, *g_pre_mix, *g_post_mix, *g_pre_ffn, *g_post_ffn, *w_in, *g_grp_a, *g_grp_b,
        *sink_a, *rpb_b, *w_out, *w_router, *b_router, *w_mlp1, *b_mlp1, *w_mlp2, *b_mlp2;
    float* out;
    unsigned char* ws;
};

__device__ __forceinline__ unsigned f2bf(float f) { unsigned u = __float_as_uint(f); return (u + 0x7fffu + ((u >> 16) & 1u)) >> 16; }
__device__ __forceinline__ unsigned pk2(float lo, float hi) { return f2bf(lo) | (f2bf(hi) << 16); }
__device__ __forceinline__ unsigned pk4_fp8(float v0, float v1, float v2, float v3) {
    int w = 0; w = __builtin_amdgcn_cvt_pk_fp8_f32(v0, v1, w, false); w = __builtin_amdgcn_cvt_pk_fp8_f32(v2, v3, w, true); return (unsigned)w; }
constexpr float Y8_SCALE = 16.f, Y8_INV = 1.f / 16.f;
constexpr float W8_SCALE = 64.f, W8_INV = 1.f / 64.f;
__device__ __forceinline__ int lane_id() { int l = (int)__builtin_amdgcn_mbcnt_hi(~0u, __builtin_amdgcn_mbcnt_lo(~0u, 0u)); asm volatile("" : "+v"(l)); return l; }
__device__ __forceinline__ int tid_opaque(int wv) { return wv * 64 + lane_id(); }
template <int CTRL> __device__ __forceinline__ float dppmov(float v) { return __builtin_bit_cast(float, __builtin_amdgcn_update_dpp(0, __builtin_bit_cast(int, v), CTRL, 0xf, 0xf, true)); }
__device__ __forceinline__ float row_sum16(float v) { v += dppmov<0xB1>(v); v += dppmov<0x4E>(v); v += dppmov<0x141>(v); v += dppmov<0x140>(v); return v; }
__device__ __forceinline__ float rdlane(float v, int l) { return __builtin_bit_cast(float, __builtin_amdgcn_readlane(__builtin_bit_cast(int, v), l)); }
__device__ __forceinline__ float wave_sum(float v) { v = row_sum16(v); return (rdlane(v, 0) + rdlane(v, 16)) + (rdlane(v, 32) + rdlane(v, 48)); }

#define LAS3 __attribute__((address_space(3)))
#define XB_TMO      128
#define XB_XCNT(j)  (256  + 64 * (j))
#define XB_XSUB(j)  (1280 + 64 * (j))
#define XB_XGEN(j)  (2304 + 64 * (j))
#define XB_TOP      3328
#define XB_TOPGEN   3392
#define XCD_BAR_WORDS 3456
#define XB_SPIN_CAP (1u << 18)
__device__ __forceinline__ unsigned xb_ld(unsigned* p)              { return __hip_atomic_load(p, __ATOMIC_RELAXED, __HIP_MEMORY_SCOPE_AGENT); }
__device__ __forceinline__ unsigned xb_add(unsigned* p, unsigned v) { return __hip_atomic_fetch_add(p, v, __ATOMIC_RELAXED, __HIP_MEMORY_SCOPE_AGENT); }
__device__ __forceinline__ unsigned xb_xcc_id() { return (unsigned)__builtin_amdgcn_s_getreg((3 << 11) | 20) & 0xFu; }
#define XB_SPIN(cond, bar) do { unsigned _sp = 0; while (cond) { __builtin_amdgcn_s_sleep(1); \
    if ((++_sp & 255u) == 0u) { if (xb_ld(&(bar)[XB_TMO])) break; if (_sp > XB_SPIN_CAP) { atomicAdd(&(bar)[XB_TMO], 1u); break; } } } } while (0)
struct XcdBarrier { unsigned* bar; unsigned x; volatile LAS3 unsigned* st; int wv; };
__device__ __forceinline__ XcdBarrier xcd_barrier_post(unsigned* bar, volatile LAS3 unsigned* st, int wv) {
    XcdBarrier b; b.bar = bar; b.x = xb_xcc_id(); b.st = st; b.wv = wv;
    if (tid_opaque(wv) == 0) (void)xb_add(&bar[XB_XCNT(b.x)], 1u);
    return b;
}
__device__ __forceinline__ void xcd_barrier_complete(unsigned* bar, unsigned x, unsigned& nloc, unsigned& nx) {
    const unsigned G = gridDim.x * gridDim.y * gridDim.z;
    unsigned sum, cnt, mine, sp = 0u;
    for (;;) {
        sum = 0u; cnt = 0u; mine = 0u;
#pragma unroll
        for (unsigned j = 0; j < 16; ++j) { const unsigned c = xb_ld(&bar[XB_XCNT(j)]); sum += c; cnt += (c > 0u) ? 1u : 0u; mine = (j == x) ? c : mine; }
        if (sum == G) break;
        __builtin_amdgcn_s_sleep(1);
        if ((++sp & 255u) == 0u) { if (xb_ld(&bar[XB_TMO])) break; if (sp > XB_SPIN_CAP) { atomicAdd(&bar[XB_TMO], 1u); break; } }
    }
    nloc = mine > 0u ? mine : 1u; nx = cnt > 0u ? cnt : 1u;
}
__device__ __forceinline__ void xcd_barrier(const XcdBarrier& b) {
    asm volatile("s_waitcnt vmcnt(0)" ::: "memory");
    __syncthreads();
    if (tid_opaque(b.wv) == 0) {
        unsigned* bar = b.bar;
        __builtin_amdgcn_s_waitcnt(0);
        unsigned nloc = b.st[0], nx = b.st[1];
        if (nloc == 0u) { xcd_barrier_complete(bar, b.x, nloc, nx); b.st[0] = nloc; b.st[1] = nx; }
        const unsigned old = xb_add(&bar[XB_XSUB(b.x)], 1u);
        const unsigned gen = old / nloc;
        if (old + 1u == (gen + 1u) * nloc) {
            __builtin_amdgcn_fence(__ATOMIC_RELEASE, "agent");
            asm volatile("s_waitcnt vmcnt(0)" ::: "memory");
            const unsigned og = xb_add(&bar[XB_TOP], 1u);
            const unsigned tg = og / nx;
            if (og + 1u == (tg + 1u) * nx) xb_add(&bar[XB_TOPGEN], 1u);
            else XB_SPIN(xb_ld(&bar[XB_TOPGEN]) == tg, bar);
            __builtin_amdgcn_fence(__ATOMIC_ACQUIRE, "agent");
            xb_add(&bar[XB_XGEN(b.x)], 1u);
            asm volatile("s_waitcnt vmcnt(0)" ::: "memory");
        } else {
            XB_SPIN(xb_ld(&bar[XB_XGEN(b.x)]) == gen, bar);
            __builtin_amdgcn_fence(__ATOMIC_ACQUIRE, "agent");
            asm volatile("s_waitcnt vmcnt(0)" ::: "memory");
        }
    }
    __syncthreads();
}

namespace pg8 {
#define PG8_LAS __attribute__((address_space(3)))
typedef short bf16x8 __attribute__((ext_vector_type(8)));
typedef int v8i __attribute__((ext_vector_type(8)));
typedef int v4i __attribute__((ext_vector_type(4)));
typedef short s16x16 __attribute__((ext_vector_type(16)));
constexpr int BM = 256, BK = 64, HALF = 128, HTB = HALF * BK * 2  , STAGE_BYTES = 8 * HTB, NXCD = 8, WGM = 8;
__device__ __forceinline__ int lds_byte(int r, int c) { const int st = (r >> 4) * 2 + (c >> 5), rr = r & 15, cc = c & 31, ob = rr * 64 + cc * 2; return st * 1024 + (ob ^ (((ob >> 9) & 1) << 5)); }
__device__ __forceinline__ void stage_rc(int b, int& R, int& C) { const int st = b / 1024, sb = b % 1024, swz = sb ^ (((sb >> 9) & 1) << 5); R = (st >> 1) * 16 + swz / 64; C = (st & 1) * 32 + (swz % 64) / 2; }
__device__ __forceinline__ int perm32(int rho) { const int n = rho >> 4, i = rho & 15; return 8 * (i >> 2) + 4 * n + (i & 3); }

constexpr int PAR_BASE = 131072, PAR_BUF = 4096, PAR_IDX = 0, PAR_W = 1024, PAR_BIAS = 2048, PAR_TAB = PAR_BASE + 2 * PAR_BUF;
typedef short s16x2 __attribute__((ext_vector_type(2)));
__device__ __forceinline__ int par_i32(PG8_LAS unsigned char* p) { return __builtin_bit_cast(int, *(const PG8_LAS s16x2*)p); }
__device__ __forceinline__ float par_f32(PG8_LAS unsigned char* p) { return __builtin_bit_cast(float, *(const PG8_LAS s16x2*)p); }
__device__ __forceinline__ f32x4 par_f32x4(PG8_LAS unsigned char* p) { return __builtin_bit_cast(f32x4, *(const PG8_LAS bf16x8*)p); }
struct Unit { int pm, pn, e; };
struct Gemm { const bf16_t* A; const bf16_t* Bt; int K; size_t bstride; const int* eslot; const PG8_LAS int* sb; int wv; };

struct StaticOrder {
    int nM, nN, nwg, G, c; const PG8_LAS int* sbase;
    __device__ void init(int M, int N, int G_, int c_, const PG8_LAS int* sb) { nM = M / BM; nN = N / BM; nwg = nM * nN; G = G_; c = c_; sbase = sb; }
    __device__ bool next(int i, Unit& u) const {
        const long Lx = (long)i * G + c; if (Lx >= nwg) return false;
        int wgid = (int)Lx; { const int q = nwg / NXCD, r = nwg % NXCD, xcd = wgid % NXCD, off = wgid / NXCD; wgid = (xcd < r ? xcd * (q + 1) : r * (q + 1) + (xcd - r) * q) + off; }
        const int nig = WGM * nN, gid = wgid / nig, fm = gid * WGM, gsz = (nM - fm) < WGM ? (nM - fm) : WGM;
        u.pm = fm + ((wgid % nig) % gsz); u.pn = (wgid % nig) / gsz; u.e = 0;
        if (sbase) { const int row = u.pm * BM; const int l = lane_id();
            const bool ge = (l >= 1) && (l < 32) && (row >= sbase[l & 31]);
            u.e = __builtin_popcountll(__ballot(ge)); }
        return true;
    }
};

template <class Epi, class Sched, bool GATHER, bool ALIGN_EPI, bool FP8 = false>
__device__ __forceinline__ void gemm_phase(PG8_LAS unsigned char* lds, const Gemm g, const Sched& S, const Epi& E) {
    const int tid = tid_opaque(g.wv), wid = g.wv,
              lane = tid & 63, wr = wid >> 2, wc = wid & 3, fr = lane & 15, fq = lane >> 4;
    const int K = g.K, nt = K / BK;
    unsigned voffA[2], voffB[2];
#pragma unroll
    for (int i = 0; i < 2; ++i) { const int R = 8 * (wid + 8 * i) + (lane >> 3), Sb = (((lane & 7) ^ (lane >> 3)) * 16); const int Rb = Epi::PERM ? ((R & ~31) + perm32(R & 31)) : R;
        voffA[i] = (unsigned)(R * K * 2 + Sb); voffB[i] = (unsigned)(Rb * K * 2 + Sb); }
    const size_t kstep = (size_t)(BK * 2);
    const size_t hstep = (size_t)HALF * K * 2;
    const size_t tstep = 2 * hstep;
    const unsigned ldsw = (unsigned)wid * 1024u;
    const int fsw0 = (fr & 7) * 128 + ((fq ^ (fr & 7)) * 16), fsw1 = (fr & 7) * 128 + (((fq + 4) ^ (fr & 7)) * 16);
    const int aoff0 = (wr * 8 + (fr >> 3)) * 1024 + fsw0, aoff1 = (wr * 8 + (fr >> 3)) * 1024 + fsw1, boff0 = (wc * 4 + (fr >> 3)) * 1024 + fsw0, boff1 = (wc * 4 + (fr >> 3)) * 1024 + fsw1;
#define PG8_SA(b, h) (((b) * 2 + (h)) * HTB)
#define PG8_SB(b, h) ((4 + (b) * 2 + (h)) * HTB)
#define PG8_STAGE(bufoff, gbase, voff) do { _Pragma("unroll") for (int _i = 0; _i < 2; ++_i) \
        __builtin_amdgcn_global_load_lds((const unsigned*)((const char*)(gbase) + (voff)[_i]), (PG8_LAS unsigned*)(lds + (bufoff) + ldsw + _i * 8192), 16, 0, 0); } while (0)
#define PG8_CAT(lo_, hi_) __builtin_bit_cast(v8i, __builtin_shufflevector((lo_), (hi_), 0, 1, 2, 3, 4, 5, 6, 7, 8, 9, 10, 11, 12, 13, 14, 15))
#define PG8_LDA(dst, b, h) do { _Pragma("unroll") for (int m = 0; m < 4; ++m) { \
        const bf16x8 f0_ = *(const PG8_LAS bf16x8*)(lds + PG8_SA(b, h) + aoff0 + m * 2048), f1_ = *(const PG8_LAS bf16x8*)(lds + PG8_SA(b, h) + aoff1 + m * 2048); \
        if constexpr (FP8) dst##8[m] = PG8_CAT(f0_, f1_); else { dst[m][0] = f0_; dst[m][1] = f1_; } } } while (0)
#define PG8_LDB(dst, b, h) do { _Pragma("unroll") for (int n = 0; n < 2; ++n) { \
        const bf16x8 f0_ = *(const PG8_LAS bf16x8*)(lds + PG8_SB(b, h) + boff0 + n * 2048), f1_ = *(const PG8_LAS bf16x8*)(lds + PG8_SB(b, h) + boff1 + n * 2048); \
        if constexpr (FP8) dst##8[n] = PG8_CAT(f0_, f1_); else { dst[n][0] = f0_; dst[n][1] = f1_; } } } while (0)
#define PG8_MMA(ai, bj, At, Bt) do { __builtin_amdgcn_s_setprio(1); _Pragma("unroll") for (int m = 0; m < 4; ++m) _Pragma("unroll") for (int n = 0; n < 2; ++n) { \
        if constexpr (FP8) asm volatile("v_mfma_scale_f32_16x16x128_f8f6f4 %0, %1, %2, %0, %3, %3 op_sel_hi:[0,0,0]" : "+v"(acc[ai][bj][m][n]) : "v"(Bt##8[n]), "v"(At##8[m]), "v"(one_scale)); \
        else { _Pragma("unroll") for (int k = 0; k < 2; ++k) acc[ai][bj][m][n] = __builtin_amdgcn_mfma_f32_16x16x32_bf16(Bt[n][k], At[m][k], acc[ai][bj][m][n], 0, 0, 0); } } \
        __builtin_amdgcn_s_setprio(0); } while (0)
#define PG8_WAIT_V(n) asm volatile("s_waitcnt vmcnt(" #n ")" ::: "memory")
#define PG8_WAIT_L(n) asm volatile("s_waitcnt lgkmcnt(" #n ")" ::: "memory")
#define PG8_BAR __builtin_amdgcn_s_barrier()
#define PG8_SCHED __builtin_amdgcn_sched_barrier(0)
#define PG8_SETOFF(off, pbuf_) do { _Pragma("unroll") for (int _h = 0; _h < 2; ++_h) _Pragma("unroll") for (int _i = 0; _i < 2; ++_i) { \
        if (GATHER) { const int R_ = 8 * (wid + 8 * _i) + (lane >> 3); \
            off[_h][_i] = (unsigned)(par_i32(lds + PAR_BASE + (pbuf_) * PAR_BUF + PAR_IDX + (_h * HALF + R_) * 4) >> 2) * (unsigned)(K * 2) + (unsigned)(((lane & 7) ^ (lane >> 3)) * 16); } \
        else off[_h][_i] = voffA[_i] + (unsigned)(_h * hstep); } } while (0)
#define PG8_IDXDMA(u, pbuf_) do { if (GATHER && wid < 4) { int rk_ = (u).pm * BM + wid * 64 + lane - g.sb[(u).e]; const int cm_ = g.sb[40 + (u).e] - 1; rk_ = rk_ < cm_ ? rk_ : cm_; \
        __builtin_amdgcn_global_load_lds((const unsigned*)(g.eslot + (size_t)(u).e * ECAP + rk_), (PG8_LAS unsigned*)(lds + PAR_BASE + (pbuf_) * PAR_BUF + PAR_IDX + wid * 256), 4, 0, 0); } } while (0)
    Unit cur, nxt; int ui = 0;
    if (!S.next(0, cur)) return;
    PG8_IDXDMA(cur, 0); E.prefetch(cur, 0, lds, wid, lane);
    PG8_WAIT_V(0); PG8_BAR;
    f32x4 acc[2][2][4][2];
#pragma unroll
    for (int a = 0; a < 2; ++a)
#pragma unroll
        for (int b = 0; b < 2; ++b)
#pragma unroll
            for (int m = 0; m < 4; ++m)
#pragma unroll
                for (int n = 0; n < 2; ++n) acc[a][b][m][n] = (f32x4){0.f, 0.f, 0.f, 0.f};
    bf16x8 At[4][2], B0[2][2], B1[2][2];
    v8i At8[4], B08[2], B18[2];
    const int one_scale = 0x7f7f7f7f;
    unsigned offc[2][2], offn[2][2];
    PG8_SETOFF(offc, 0);
    const char* cA = GATHER ? (const char*)g.A : (const char*)g.A + (size_t)cur.pm * tstep;
    const char* cB = (const char*)g.Bt + (size_t)cur.e * g.bstride + (size_t)cur.pn * tstep;
    PG8_STAGE(PG8_SB(0, 0), cB, voffB); PG8_STAGE(PG8_SB(0, 1), cB + hstep, voffB); PG8_STAGE(PG8_SA(0, 0), cA, offc[0]); PG8_STAGE(PG8_SA(0, 1), cA, offc[1]);
    if (wr == 1) PG8_BAR;
    PG8_WAIT_V(2); PG8_BAR;
    PG8_STAGE(PG8_SB(1, 0), cB + kstep, voffB); PG8_STAGE(PG8_SA(1, 0), cA + kstep, offc[0]); PG8_STAGE(PG8_SB(1, 1), cB + hstep + kstep, voffB);
    PG8_WAIT_V(6); PG8_BAR;
    for (;;) {
        const bool has_next = S.next(ui + 1, nxt);
        const char* nA = GATHER ? cA : (has_next ? (const char*)g.A + (size_t)nxt.pm * tstep : cA);
        const char* nB = has_next ? (const char*)g.Bt + (size_t)nxt.e * g.bstride + (size_t)nxt.pn * tstep : cB;

        if constexpr (Epi::MIDSCALE) E.begin(cur, ui, lds, tid);
#pragma unroll 1
        for (int t = 0; t < nt; t += 2) {
            const bool last = (t == nt - 2);
            if constexpr (Epi::MIDSCALE) { if (t == nt / 2) E.mid(acc, ui, wr, fr, lds); }
            if (t == 2 && has_next) { PG8_IDXDMA(nxt, (ui + 1) & 1); E.prefetch(nxt, (ui + 1) & 1, lds, wid, lane); }
            if (GATHER && last) { if (has_next) { PG8_SETOFF(offn, (ui + 1) & 1); } else {
#pragma unroll
                for (int h = 0; h < 2; ++h)
#pragma unroll
                    for (int i = 0; i < 2; ++i) offn[h][i] = offc[h][i]; } }
            const char* a1 = cA + (size_t)(t + 1) * kstep;
            const char* a2 = last ? nA : cA + (size_t)(t + 2) * kstep; const char* b2 = last ? nB : cB + (size_t)(t + 2) * kstep;
            const char* a3 = a2 + kstep; const char* b3 = b2 + kstep;
            unsigned o2[2][2];
#pragma unroll
            for (int h = 0; h < 2; ++h)
#pragma unroll
                for (int i = 0; i < 2; ++i) o2[h][i] = (GATHER && last) ? offn[h][i] : offc[h][i];
            PG8_LDB(B0, 0, 0); PG8_LDB(B1, 0, 1); PG8_SCHED; PG8_LDA(At, 0, 0); PG8_STAGE(PG8_SA(1, 1), a1, offc[1]);
            PG8_WAIT_V(8); PG8_WAIT_L(0); PG8_BAR; PG8_MMA(0, 0, At, B0); PG8_MMA(0, 1, At, B1); PG8_BAR; PG8_SCHED;
            PG8_LDA(At, 0, 1); PG8_STAGE(PG8_SB(0, 0), b2, voffB); PG8_STAGE(PG8_SB(0, 1), b2 + hstep, voffB); PG8_STAGE(PG8_SA(0, 0), a2, o2[0]);
            PG8_WAIT_V(8); PG8_WAIT_L(0); PG8_BAR; PG8_MMA(1, 0, At, B0); PG8_MMA(1, 1, At, B1); PG8_BAR; PG8_SCHED;
            PG8_LDB(B0, 1, 0); PG8_LDB(B1, 1, 1); PG8_SCHED; PG8_LDA(At, 1, 0); PG8_STAGE(PG8_SA(0, 1), a2, o2[1]);
            PG8_WAIT_V(8); PG8_WAIT_L(0); PG8_BAR; PG8_MMA(0, 0, At, B0); PG8_MMA(0, 1, At, B1); PG8_BAR; PG8_SCHED;
            PG8_LDA(At, 1, 1); PG8_STAGE(PG8_SB(1, 0), b3, voffB); PG8_STAGE(PG8_SB(1, 1), b3 + hstep, voffB); PG8_STAGE(PG8_SA(1, 0), a3, o2[0]);
            PG8_WAIT_V(8); PG8_WAIT_L(0); PG8_BAR; PG8_MMA(1, 0, At, B0); PG8_MMA(1, 1, At, B1); PG8_BAR; PG8_SCHED;
        }
        if constexpr (ALIGN_EPI) { if (wr == 0) PG8_BAR; }
        if constexpr (FP8) asm volatile("s_nop 15\n\ts_nop 15" ::: "memory");
        E(acc, cur, ui, wr, wc, fr, fq, lds);
        if (!has_next) break;
#pragma unroll
        for (int a = 0; a < 2; ++a)
#pragma unroll
            for (int b = 0; b < 2; ++b)
#pragma unroll
                for (int m = 0; m < 4; ++m)
#pragma unroll
                    for (int n = 0; n < 2; ++n) acc[a][b][m][n] = (f32x4){0.f, 0.f, 0.f, 0.f};
        cur = nxt; cA = nA; cB = nB; ++ui;
#pragma unroll
        for (int h = 0; h < 2; ++h)
#pragma unroll
            for (int i = 0; i < 2; ++i) offc[h][i] = offn[h][i];
        if constexpr (ALIGN_EPI) { if (wr == 1) PG8_BAR; }
    }
    PG8_WAIT_V(0);
    if constexpr (!ALIGN_EPI) { if (wr == 0) PG8_BAR; }
    PG8_BAR;
#undef PG8_SA
#undef PG8_SB
#undef PG8_STAGE
#undef PG8_LDA
#undef PG8_LDB
#undef PG8_MMA
#undef PG8_WAIT_V
#undef PG8_WAIT_L
#undef PG8_BAR
#undef PG8_SCHED
#undef PG8_SETOFF
#undef PG8_IDXDMA
#undef PG8_CAT
}

struct EpiQKV {
    static constexpr bool MIDSCALE = false, PERM = false;
    bf16_t* O;
    __device__ __forceinline__ void prefetch(const Unit&, int, PG8_LAS unsigned char*, int, int) const {}
    __device__ __forceinline__ void operator()(const f32x4 (&acc)[2][2][4][2], const Unit& u, int ui, int wr, int wc, int fr, int fq, PG8_LAS unsigned char* lds) const {
        const bool latent = u.pm < NTOK / BM;
#pragma unroll
        for (int ai = 0; ai < 2; ++ai)
#pragma unroll
            for (int m = 0; m < 4; ++m) {
                const int row = u.pm * BM + ai * HALF + wr * 64 + m * 16 + fr;
                bf16_t* rowp = O + (size_t)row * INW + u.pn * BM + wc * 32 + 4 * fq;
                const int pos = row & (L - 1), pp = (wc & 1) ? (pos & 63) : (pos >> 6);
                PG8_LAS unsigned char* tp = lds + PAR_TAB + (pp * 16 + 4 * fq) * 8;
#pragma unroll
                for (int bj = 0; bj < 2; ++bj) {
                    const int colbase = u.pn * BM + bj * HALF;
                    f32x4 v0 = acc[ai][bj][m][0], v1 = acc[ai][bj][m][1];
                    if (latent && colbase < C_VA) {
                        const f32x4 t0 = par_f32x4(tp), t1 = par_f32x4(tp + 16);
                        const f32x4 cs = {t0.x, t0.z, t1.x, t1.z}, sn = {t0.y, t0.w, t1.y, t1.w};
                        const f32x4 a0 = v0 * cs - v1 * sn, a1 = v1 * cs + v0 * sn; v0 = a0; v1 = a1;
                    }
                    if (colbase < C_KA || (colbase >= C_QB && colbase < C_KB)) { v0 = v0 * QSCALE; v1 = v1 * QSCALE; }
                    u32x2 w0, w1; w0.x = pk2(v0.x, v0.y); w0.y = pk2(v0.z, v0.w); w1.x = pk2(v1.x, v1.y); w1.y = pk2(v1.z, v1.w);
                    *(u32x2*)(rowp + bj * HALF) = w0; *(u32x2*)(rowp + bj * HALF + 16) = w1;
                }
            }
    }
};
struct EpiOutProj {
    static constexpr bool PERM = true, MIDSCALE = true;
    bf16_t* O; const float* oss;
    __device__ __forceinline__ void prefetch(const Unit&, int, PG8_LAS unsigned char*, int, int) const {}
    __device__ __forceinline__ void begin(const Unit& u, int ui, PG8_LAS unsigned char* lds, int tid) const {
        if (tid < 256) { const f32x4* sp = (const f32x4*)(oss + (size_t)(u.pm * BM + tid) * 16); const f32x4 a0 = sp[0], a1 = sp[1], b0 = sp[2], b1 = sp[3];
            const float sa = ((a0.x + a0.y) + (a0.z + a0.w)) + ((a1.x + a1.y) + (a1.z + a1.w)), sb = ((b0.x + b0.y) + (b0.z + b0.w)) + ((b1.x + b1.y) + (b1.z + b1.w));
            const float ra = rsqrtf(sa * (1.f / 512.f) + EPS), rb = rsqrtf(sb * (1.f / 512.f) + EPS);
            typedef float f2 __attribute__((ext_vector_type(2)));
            *(PG8_LAS f2*)(lds + 131072 + (ui & 1) * 2048 + tid * 8) = (f2){ra / rb, rb}; }
    }
    __device__ __forceinline__ void mid(f32x4 (&acc)[2][2][4][2], int ui, int wr, int fr, PG8_LAS unsigned char* lds) const {
#pragma unroll
        for (int ai = 0; ai < 2; ++ai)
#pragma unroll
            for (int m = 0; m < 4; ++m) { const float r = *(const PG8_LAS float*)(lds + 131072 + (ui & 1) * 2048 + (ai * HALF + wr * 64 + m * 16 + fr) * 8);
#pragma unroll
                for (int bj = 0; bj < 2; ++bj)
#pragma unroll
                    for (int n = 0; n < 2; ++n) acc[ai][bj][m][n] = acc[ai][bj][m][n] * r; }
    }
    __device__ __forceinline__ void operator()(const f32x4 (&acc)[2][2][4][2], const Unit& u, int ui, int wr, int wc, int fr, int fq, PG8_LAS unsigned char* lds) const {
#pragma unroll
        for (int ai = 0; ai < 2; ++ai)
#pragma unroll
            for (int m = 0; m < 4; ++m) {
                const int rl = ai * HALF + wr * 64 + m * 16 + fr;
                const float rb = *(const PG8_LAS float*)(lds + 131072 + (ui & 1) * 2048 + rl * 8 + 4);
                bf16_t* rowp = O + (size_t)(u.pm * BM + rl) * D + u.pn * BM + wc * 32 + 8 * fq;
#pragma unroll
                for (int bj = 0; bj < 2; ++bj) { const f32x4 v0 = acc[ai][bj][m][0] * rb, v1 = acc[ai][bj][m][1] * rb;
                    u32x4 o; o.x = pk2(v0.x, v0.y); o.y = pk2(v0.z, v0.w); o.z = pk2(v1.x, v1.y); o.w = pk2(v1.z, v1.w);
                    *(u32x4*)(rowp + bj * HALF) = o; }
            }
    }
};
struct EpiSwiglu {
    static constexpr bool MIDSCALE = false, PERM = false;
    unsigned char* act; const float* b1;
    __device__ __forceinline__ void prefetch(const Unit& u, int pb, PG8_LAS unsigned char* lds, int wid, int lane) const {
        if (wid == 4) __builtin_amdgcn_global_load_lds((const unsigned*)(b1 + (size_t)u.e * 2048 + u.pn * BM + lane * 4), (PG8_LAS unsigned*)(lds + PAR_BASE + pb * PAR_BUF + PAR_BIAS), 16, 0, 0);
    }
    __device__ __forceinline__ void operator()(const f32x4 (&acc)[2][2][4][2], const Unit& u, int ui, int wr, int wc, int fr, int fq, PG8_LAS unsigned char* lds) const {
#pragma unroll
        for (int bj = 0; bj < 2; ++bj) {
            const int f0 = 16 * (8 * u.pn + 4 * bj + wc) + 4 * fq;
            PG8_LAS unsigned char* bp = lds + PAR_BASE + (ui & 1) * PAR_BUF + PAR_BIAS + (128 * bj + 32 * wc + 8 * fq) * 4; const f32x4 bA = par_f32x4(bp), bB = par_f32x4(bp + 16);
            const f32x4 bg = {bA.x, bA.z, bB.x, bB.z}, bl = {bA.y, bA.w, bB.y, bB.w};
#pragma unroll
            for (int ai = 0; ai < 2; ++ai)
#pragma unroll
                for (int m = 0; m < 4; ++m) {
                    const int row = u.pm * BM + ai * HALF + wr * 64 + m * 16 + fr;
                    const f32x4 gt = acc[ai][bj][m][0] * W8_INV + bg, ln = acc[ai][bj][m][1] * W8_INV + bl; float a[4];
#pragma unroll
                    for (int j = 0; j < 4; ++j) { const float gg = fminf(gt[j], 7.f), ll = fminf(fmaxf(ln[j], -7.f), 7.f);
                        a[j] = gg * __builtin_amdgcn_rcpf(1.f + __expf(-1.702f * gg)) * (ll + 1.f); }
                    *(unsigned*)(act + (size_t)row * D + f0) = pk4_fp8(a[0], a[1], a[2], a[3]);
                }
        }
    }
};
struct EpiScatter {
    static constexpr bool MIDSCALE = false, PERM = true;
    unsigned char* y; const float* b2; const int* eslot; const float* ew; const PG8_LAS int* sb;
    __device__ __forceinline__ void prefetch(const Unit& u, int pb, PG8_LAS unsigned char* lds, int wid, int lane) const {
        const int w4 = wid & 3; int rk = u.pm * BM + w4 * 64 + lane - sb[u.e]; const int cm = sb[40 + u.e] - 1; rk = rk < cm ? rk : cm;
        const size_t gi = (size_t)u.e * ECAP + rk;
        if (wid < 4) __builtin_amdgcn_global_load_lds((const unsigned*)(eslot + gi), (PG8_LAS unsigned*)(lds + PAR_BASE + pb * PAR_BUF + PAR_IDX + w4 * 256), 4, 0, 0);
        else         __builtin_amdgcn_global_load_lds((const unsigned*)(ew + gi), (PG8_LAS unsigned*)(lds + PAR_BASE + pb * PAR_BUF + PAR_W + w4 * 256), 4, 0, 0);
        if (wid == 0) __builtin_amdgcn_global_load_lds((const unsigned*)(b2 + (size_t)u.e * D + u.pn * BM + lane * 4), (PG8_LAS unsigned*)(lds + PAR_BASE + pb * PAR_BUF + PAR_BIAS), 16, 0, 0);
    }
    __device__ __forceinline__ void operator()(const f32x4 (&acc)[2][2][4][2], const Unit& u, int ui, int wr, int wc, int fr, int fq, PG8_LAS unsigned char* lds) const {
        PG8_LAS unsigned char* par = lds + PAR_BASE + (ui & 1) * PAR_BUF;
        const int col0 = u.pn * BM + wc * 32 + 8 * fq;
        f32x4 bv[2][2];
#pragma unroll
        for (int bj = 0; bj < 2; ++bj)
#pragma unroll
            for (int n = 0; n < 2; ++n) bv[bj][n] = par_f32x4(par + PAR_BIAS + (wc * 32 + 8 * fq + bj * HALF + 4 * n) * 4);
        const int rbase = u.pm * BM - sb[u.e], cn = sb[40 + u.e];
#pragma unroll
        for (int ai = 0; ai < 2; ++ai)
#pragma unroll
            for (int m = 0; m < 4; ++m) {
                const int rl = ai * HALF + wr * 64 + m * 16 + fr;
                const int slot = par_i32(par + PAR_IDX + rl * 4); const float w = par_f32(par + PAR_W + rl * 4) * Y8_SCALE;
                if (rbase + rl < cn) {
                    unsigned char* rowp = y + (size_t)slot * D + col0;
#pragma unroll
                    for (int bj = 0; bj < 2; ++bj) { const f32x4 v0 = (acc[ai][bj][m][0] * W8_INV + bv[bj][0]) * w, v1 = (acc[ai][bj][m][1] * W8_INV + bv[bj][1]) * w;
                        u32x2 o; o.x = pk4_fp8(v0.x, v0.y, v0.z, v0.w); o.y = pk4_fp8(v1.x, v1.y, v1.z, v1.w);
                        *(u32x2*)(rowp + bj * HALF) = o; }
                }
            }
    }
};
}

__device__ void p0_mod(const Params& p, float* sS  , float* sP  , int wv) {
    float* mod = (float*)(p.ws + WS_MOD);
    const int tid = tid_opaque(wv), lane = tid & 63, wave = wv;
    if (blockIdx.x >= 96) return;
    for (int i = tid; i < 9 * D; i += NTHREADS) { const int r = i >> 10, k = i & 1023; const float cc = r < 8 ? p.c[r * D + k] : p.c_ctx[k]; sS[i] = cc / (1.f + __expf(-cc)); }
    __syncthreads();
    const int j = blockIdx.x * 64 + lane;
    float acc[9];
#pragma unroll
    for (int r = 0; r < 9; ++r) acc[r] = 0.f;
    const float* wp = p.w_ada + (size_t)(wave * 128) * 6144 + j;
#pragma unroll 1
    for (int k0 = 0; k0 < 128; k0 += 16) {
        float w[16];
#pragma unroll
        for (int kk = 0; kk < 16; ++kk) w[kk] = wp[(size_t)(k0 + kk) * 6144];
#pragma unroll
        for (int kk = 0; kk < 16; ++kk)
#pragma unroll
            for (int r = 0; r < 9; ++r) acc[r] = fmaf(sS[r * D + wave * 128 + k0 + kk], w[kk], acc[r]);
    }
#pragma unroll
    for (int r = 0; r < 9; ++r) sP[(wave * 9 + r) * 64 + lane] = acc[r];
    __syncthreads();
    for (int i = tid; i < 9 * 64; i += NTHREADS) { const int r = i >> 6, jj = i & 63; float s = p.b_ada[blockIdx.x * 64 + jj];
#pragma unroll
        for (int w = 0; w < 8; ++w) s += sP[(w * 9 + r) * 64 + jj];
        mod[r * 6144 + blockIdx.x * 64 + jj] = s; }
    __syncthreads();
}
__device__ void p0_tab(const Params& p, int wv) {
    float* tab = (float*)(p.ws + WS_TAB);
    const int gtid = blockIdx.x * NTHREADS + tid_opaque(wv), gsize = gridDim.x * NTHREADS;
    for (int idx = gtid; idx < 64 * 16; idx += gsize) {
        const int pos = idx >> 4, i = idx & 15;
        const float freq = exp2f(-(float)i * (13.287712379549449f / 16.f));
        const float ang = (float)pos * freq;
        const float n = rintf(ang * 0.15915494309189535f);
        float r = fmaf(-n, 6.28125f, ang); r = fmaf(-n, 1.9353071795864769e-3f, r);
        tab[idx * 2] = __cosf(r); tab[idx * 2 + 1] = __sinf(r);
    }
}
template <int MODE>
__device__ __forceinline__ void conv_item(const float* src, int K, int N, bf16_t* dst, int item, float* scr, int lane, const float* gA, const float* gB) {
    const int nblk = N / 32, kb = item / nblk, nb = item % nblk, k0 = 64 * kb, n0 = 32 * nb;
    const int c = lane & 31, kh = lane >> 5;
    const int nl = MODE == 1 ? 16 * (c & 1) + (c >> 1) : c;
    float v[32];
    const float* sp = src + (size_t)(k0 + kh) * N + n0 + c;
#pragma unroll
    for (int i = 0; i < 32; ++i) v[i] = sp[(size_t)(2 * i) * N];
#pragma unroll
    for (int i = 0; i < 32; ++i) { float x = v[i]; if (MODE == 2) { const int k = k0 + 2 * i + kh; x *= (k < 512 ? gA[k] : gB[k - 512]); } scr[(2 * i + kh) * 33 + nl] = x; }
    asm volatile("s_waitcnt lgkmcnt(0)" ::: "memory");
    const int ch = lane & 7;
#pragma unroll
    for (int j = 0; j < 4; ++j) { const int n = (lane >> 3) + 8 * j; const float* s = scr + (8 * ch) * 33 + n;
        u32x4 o; o.x = pk2(s[0 * 33], s[1 * 33]); o.y = pk2(s[2 * 33], s[3 * 33]); o.z = pk2(s[4 * 33], s[5 * 33]); o.w = pk2(s[6 * 33], s[7 * 33]);
        *(u32x4*)(dst + (size_t)(n0 + n) * K + k0 + 8 * ch) = o; }
    asm volatile("s_waitcnt lgkmcnt(0)" ::: "memory");
}
template <bool PERM1>
__device__ __forceinline__ void conv_item8(const float* src, int K, int N, unsigned char* dst, int item, float* scr, int lane) {
    const int nblk = N / 32, kb = item / nblk, nb = item % nblk, k0 = 64 * kb, n0 = 32 * nb;
    const int c = lane & 31, kh = lane >> 5;
    const int nl = PERM1 ? 16 * (c & 1) + (c >> 1) : c;
    float v[32];
    const float* sp = src + (size_t)(k0 + kh) * N + n0 + c;
#pragma unroll
    for (int i = 0; i < 32; ++i) v[i] = sp[(size_t)(2 * i) * N];
#pragma unroll
    for (int i = 0; i < 32; ++i) scr[(2 * i + kh) * 33 + nl] = v[i] * W8_SCALE;
    asm volatile("s_waitcnt lgkmcnt(0)" ::: "memory");
    const int ch = lane & 3;
#pragma unroll
    for (int j = 0; j < 2; ++j) { const int n = (lane >> 2) + 16 * j; const float* s = scr + (16 * ch) * 33 + n;
        u32x4 o; o.x = pk4_fp8(s[0 * 33], s[1 * 33], s[2 * 33], s[3 * 33]); o.y = pk4_fp8(s[4 * 33], s[5 * 33], s[6 * 33], s[7 * 33]);
        o.z = pk4_fp8(s[8 * 33], s[9 * 33], s[10 * 33], s[11 * 33]); o.w = pk4_fp8(s[12 * 33], s[13 * 33], s[14 * 33], s[15 * 33]);
        *(u32x4*)(dst + (size_t)(n0 + n) * K + k0 + 16 * ch) = o; }
    asm volatile("s_waitcnt lgkmcnt(0)" ::: "memory");
}
__device__ void p0_weights(const Params& p, unsigned char* ldsb, int wv) {
    const int tid = tid_opaque(wv), lane = tid & 63, wave = wv; float* scr = (float*)(ldsb + 57344 + wave * 8448);
    const int gw = blockIdx.x * (NTHREADS / 64) + wave, ngw = gridDim.x * (NTHREADS / 64);
    constexpr int I_IN = 16 * 72, I_OUT = 16 * 32, I_W1 = 16 * 64, I_W2 = 16 * 32;
    constexpr int NITEMS = I_IN + I_OUT + NE * I_W1 + NE * I_W2;
    for (int it = gw; it < NITEMS; it += ngw) {
        int r = it;
        if (r < I_IN) { conv_item<0>(p.w_in, D, INW, (bf16_t*)(p.ws + WS_WIN), r, scr, lane, nullptr, nullptr); continue; } r -= I_IN;
        if (r < I_OUT) { conv_item<2>(p.w_out, D, D, (bf16_t*)(p.ws + WS_WOUT), r, scr, lane, p.g_grp_a, p.g_grp_b); continue; } r -= I_OUT;
        if (r < NE * I_W1) { const int e = r / I_W1, q = r % I_W1;
            conv_item8<true>(p.w_mlp1 + (size_t)e * D * 2048, D, 2048, p.ws + WS_W1 + (size_t)e * 2048 * D, q, scr, lane); continue; } r -= NE * I_W1;
        { const int e = r / I_W2, q = r % I_W2;
            conv_item8<false>(p.w_mlp2 + (size_t)e * D * D, D, D, p.ws + WS_W2 + (size_t)e * D * D, q, scr, lane); }
    }
}

__device__ void p1_h(const Params& p, int wv) {
    const int tid = tid_opaque(wv), lane = tid & 63;
    const float* mod = (const float*)(p.ws + WS_MOD);
    bf16_t* hb = (bf16_t*)(p.ws + WS_HB);
    constexpr int R = 17;
    const int gwv = blockIdx.x * (NTHREADS / 64) + (tid >> 6);
    const int m0 = gwv * R; if (m0 >= MROWS) return;
    const int m1 = m0 + R < MROWS ? m0 + R : MROWS;
    f32x4 pB[4], pC[4], v[4], nv[4]; int curb = -1;
#define P1_ROWPTR(m) ((m) < NTOK ? p.x + (size_t)(m) * D : p.ctx + (size_t)((m) - NTOK) * D)
    { const float* xr = P1_ROWPTR(m0);
#pragma unroll
      for (int j = 0; j < 4; ++j) nv[j] = ((const f32x4*)xr)[lane + 64 * j]; }
    for (int m = m0; m < m1; ++m) {
#pragma unroll
        for (int j = 0; j < 4; ++j) v[j] = nv[j];
        if (m + 1 < m1) { const float* xr = P1_ROWPTR(m + 1);
#pragma unroll
            for (int j = 0; j < 4; ++j) nv[j] = ((const f32x4*)xr)[lane + 64 * j]; }
        const int b = m < NTOK ? m / L : 8;
        if (b != curb) { curb = b; const float* sh = mod + b * 6144, * sc = sh + 1024;
#pragma unroll
            for (int j = 0; j < 4; ++j) { const int c0 = 4 * (lane + 64 * j); pB[j] = *(const f32x4*)(p.g_pre_mix + c0) * (*(const f32x4*)(sc + c0) + 1.f); pC[j] = *(const f32x4*)(sh + c0); } }
        float s = 0.f;
#pragma unroll
        for (int j = 0; j < 4; ++j) s += v[j].x * v[j].x + v[j].y * v[j].y + v[j].z * v[j].z + v[j].w * v[j].w;
        const float rstd = rsqrtf(wave_sum(s) * (1.f / D) + EPS);
#pragma unroll
        for (int j = 0; j < 4; ++j) { const int c0 = 4 * (lane + 64 * j);
            const f32x4 o = (v[j] * rstd) * pB[j] + pC[j];
            u32x2 w; w.x = pk2(o.x, o.y); w.y = pk2(o.z, o.w);
            *(u32x2*)(hb + (size_t)m * D + c0) = w; }
    }
#undef P1_ROWPTR
}

namespace att {
#define ATT_LAS __attribute__((address_space(3)))
typedef float f32x16 __attribute__((ext_vector_type(16)));
typedef short bf16x8 __attribute__((ext_vector_type(8)));
typedef short s16x4 __attribute__((ext_vector_type(4)));
constexpr int SLOTB = 8192, NSLOT = 5;
constexpr int LDS_K = 0, LDS_V = NSLOT * SLOTB, LDS_WS = 2 * NSLOT * SLOTB, LDS_BT = LDS_WS + 8 * 256;
constexpr int BT_MARGIN = 128, BT_FLOATS = BT_MARGIN + 15 * 32 + 128;
constexpr float NEGBIG = -1e30f;
__device__ __forceinline__ int crow(int r, int hi) { return (r & 3) + 8 * (r >> 2) + 4 * hi; }
__device__ __forceinline__ unsigned cvtpk(float lo, float hi) { typedef float f2 __attribute__((ext_vector_type(2))); typedef __bf16 b2 __attribute__((ext_vector_type(2)));
    f2 v = {lo, hi}; b2 b = __builtin_convertvector(v, b2); return __builtin_bit_cast(unsigned, b); }
__device__ __forceinline__ s16x4 vtr(const ATT_LAS unsigned char* p) { typedef short v4i16 __attribute__((ext_vector_type(4)));
    return __builtin_bit_cast(s16x4, __builtin_amdgcn_ds_read_tr16_b64_v4i16((ATT_LAS v4i16*)p)); }
#define ATT_WAIT_BAR(N) asm volatile("s_waitcnt vmcnt(" #N ") lgkmcnt(0)\n\ts_barrier" ::: "memory")

__device__ __forceinline__ void dma_tile(ATT_LAS unsigned char* lds, int slot, const bf16_t* kbase, const bf16_t* vbase, int wid, int lane) {
    const bf16_t* ksrc = kbase + (size_t)lane * INW + wid * 8;
    const bf16_t* vsrc = vbase + (size_t)(16 * (wid & 3) + (lane >> 2)) * INW + (wid >> 2) * 32 + (lane & 3) * 8;
    __builtin_amdgcn_global_load_lds((const unsigned*)ksrc, (ATT_LAS unsigned*)(lds + LDS_K + slot * SLOTB + wid * 1024), 16, 0, 0);
    __builtin_amdgcn_global_load_lds((const unsigned*)vsrc, (ATT_LAS unsigned*)(lds + LDS_V + slot * SLOTB + wid * 1024), 16, 0, 0);
}

template <bool ISB>
__device__ __forceinline__ void attn_unit(const Params& p, ATT_LAS unsigned char* lds, int unit, int wv) {
    const int tid = tid_opaque(wv), lane = tid & 63, r32 = lane & 31, hi = lane >> 5; const int wid = wv;
    const bf16_t* qkv = (const bf16_t*)(p.ws + WS_QKV); bf16_t* ob = (bf16_t*)(p.ws + WS_O);
    ATT_LAS float* wsf = (ATT_LAS float*)(lds + LDS_WS) + wid * 64;
    ATT_LAS float* bt = (ATT_LAS float*)(lds + LDS_BT);
    int b, h, kcol, vcol, qcol, ocol, q0, nloc, row_lo = 0, qr = 0, half = 0, qb = 0, jlo = 0;
    if (!ISB) { b = unit >> 7; const int kvh = (unit >> 6) & 1; qb = unit & 63; h = kvh * 4 + (wid >> 1); half = wid & 1; q0 = qb * 64 + 32 * half;
        kcol = C_KA + kvh * 64; vcol = C_VA + kvh * 64; qcol = C_QA + h * 64; ocol = h * 64;
        jlo = 2 - qb > 0 ? 2 - qb : 0; const int jhi = 65 - qb < 4 ? 65 - qb : 4; nloc = jhi - jlo + 1;
    } else { b = unit >> 7; h = (unit >> 4) & 7; const int g = unit & 15;
        qr = 4 * g + 2 * (wid >> 2) + (r32 >> 4); half = wid & 3; q0 = 0;
        kcol = C_KB + h * 64; vcol = C_VB + h * 64; qcol = C_QB + h * 64; ocol = 512 + h * 64;
        const int r0 = 4 * g, r3 = 4 * g + 3; row_lo = r0 - 4 < 0 ? 0 : (r0 - 4 > 56 ? 56 : r0 - 4); const int rs3 = r3 - 4 < 0 ? 0 : (r3 - 4 > 56 ? 56 : r3 - 4); nloc = rs3 + 7 - row_lo + 1;
    }
    const int NT = nloc + 4;
    const bf16_t* lat = qkv + (size_t)b * L * INW; const bf16_t* cx = qkv + (size_t)(NTOK + b * CTX) * INW;
#define ATT_TILE_ROW(t) ((t) < nloc ? lat + (size_t)(ISB ? (row_lo + (t)) * 64 : (qb - 2 + jlo + (t)) * 64) * INW : cx + (size_t)((t) - nloc) * 64 * INW)
    const int rsq = qr - 4 < 0 ? 0 : (qr - 4 > 56 ? 56 : qr - 4);
    const int qrw = 4 * (unit & 15) + 2 * (wid >> 2);
    const int lo_w = qrw - 4 < 0 ? 0 : (qrw - 4 > 56 ? 56 : qrw - 4), hi_w = (qrw - 3 < 0 ? 0 : (qrw - 3 > 56 ? 56 : qrw - 3)) + 7;
    const int bs = ISB ? (half == 0 ? 0 : half == 1 ? 8 : half == 2 ? 24 : 32) : 0;
#define ATT_ACTIVE(t) (!(ISB && (t) < nloc) || ((row_lo + (t) >= lo_w) && (row_lo + (t) <= hi_w)))
    if (ISB) {
        for (int i = tid; i < BT_FLOATS; i += NTHREADS) { const int j = i - BT_MARGIN; float v = 0.f;
            if (j >= 0 && j < 15 * 32 && (j & 31) < 31) v = p.rpb_b[(h * 15 + (j >> 5)) * 31 + (j & 31)] * LOG2E;
            bt[i] = v; }
    }
#pragma unroll
    for (int t0 = 0; t0 < NSLOT - 1; ++t0) { const bf16_t* r0p = ATT_TILE_ROW(t0); dma_tile(lds, t0, r0p + kcol, r0p + vcol, wid, lane); }
    bf16x8 qf[4];
    const int qc = ISB ? 16 * half + (r32 & 15) : 32 * half + r32;
    { const bf16_t* qp = lat + (size_t)(ISB ? qr * 64 + qc : q0 + r32) * INW + qcol + hi * 8;
#pragma unroll
      for (int d0 = 0; d0 < 4; ++d0) qf[d0] = *(const bf16x8*)(qp + d0 * 16); }
    float mref = 0.f, l_run = 0.f;
    if (!ISB) l_run = hi == 0 ? __builtin_amdgcn_exp2f(p.sink_a[h] * LOG2E) : 0.f;
    f32x16 o0, o1, negm;
#pragma unroll
    for (int r = 0; r < 16; ++r) { o0[r] = 0.f; o1[r] = 0.f; negm[r] = 0.f; }
    const int cs = qc - 8 < 0 ? 0 : (qc - 8 > 48 ? 48 : qc - 8);
    f32x16 pc0, pc1, pn0, pn1; float ref_cur = 0.f, ref_next = 0.f; bool act_cur = false, act_next = false;
#pragma unroll
    for (int r = 0; r < 16; ++r) { pn0[r] = 0.f; pn1[r] = 0.f; }
#define ATT_QK(SLOT, LOCB) do { const ATT_LAS unsigned char* kb_ = lds + LDS_K + (SLOT) * SLOTB + hi * 1024 + r32 * 16; \
        if (LOCB) { _Pragma("unroll") for (int d0 = 0; d0 < 4; ++d0) { \
            const bf16x8 k0_ = *(const ATT_LAS bf16x8*)(kb_ + bs * 16 + d0 * 2048); \
            pn0 = __builtin_amdgcn_mfma_f32_32x32x16_bf16(k0_, qf[d0], d0 == 0 ? negm : pn0, 0, 0, 0); } } \
        else { _Pragma("unroll") for (int d0 = 0; d0 < 4; ++d0) { \
            const bf16x8 k0_ = *(const ATT_LAS bf16x8*)(kb_ + d0 * 2048), k1_ = *(const ATT_LAS bf16x8*)(kb_ + d0 * 2048 + 512); \
            pn0 = __builtin_amdgcn_mfma_f32_32x32x16_bf16(k0_, qf[d0], d0 == 0 ? negm : pn0, 0, 0, 0); \
            pn1 = __builtin_amdgcn_mfma_f32_32x32x16_bf16(k1_, qf[d0], d0 == 0 ? negm : pn1, 0, 0, 0); } } } while (0)
    ATT_WAIT_BAR(6);
    act_next = ATT_ACTIVE(0);
    if (act_next) { ATT_QK(0, ISB); ref_next = mref; }
    int sc = 0, sn = 1, si = NSLOT - 1;
    for (int t = 0; t < NT; ++t) {
        const int ahead = NT - 2 - t < 0 ? 0 : (NT - 2 - t < 2 ? NT - 2 - t : 2);
        if (ahead == 2) ATT_WAIT_BAR(4); else if (ahead == 1) ATT_WAIT_BAR(2); else ATT_WAIT_BAR(0);
        if (t + NSLOT - 1 < NT) { const bf16_t* rp = ATT_TILE_ROW(t + NSLOT - 1); dma_tile(lds, si, rp + kcol, rp + vcol, wid, lane); }
        pc0 = pn0; pc1 = pn1; ref_cur = ref_next; act_cur = act_next;
        act_next = (t + 1 < NT) && ATT_ACTIVE(t + 1);
        if (act_next) { if (ISB && t + 1 < nloc) ATT_QK(sn, true); else ATT_QK(sn, false); ref_next = mref; }
        if (act_cur) {
            if (ISB) {
                if (t < nloc) {
                    const int kr = row_lo + t;
                    const ATT_LAS float* bp = bt + BT_MARGIN + (kr - qr + 7) * 32 + 15 - qc + bs + 4 * hi;
                    const int e0 = ((kr >= rsq) && (kr <= rsq + 7)) ? bs + 4 * hi - cs : 0x4000;
#pragma unroll
                    for (int r = 0; r < 16; ++r) { const int c = (r & 3) + 8 * (r >> 2);
                        const float b0 = bp[c];
                        pc0[r] = ((unsigned)(c + e0) < 16u) ? pc0[r] + b0 : NEGBIG; }
                }
            } else {
                if (t < nloc) { const int j = jlo + t; const int qq = 32 * half + r32;
                    if (j == 0) {
#pragma unroll
                        for (int r = 0; r < 16; ++r) { const int c = crow(r, hi); if (c < qq) pc0[r] = NEGBIG; if (c + 32 < qq) pc1[r] = NEGBIG; }
                    } else if (j == 4) {
#pragma unroll
                        for (int r = 0; r < 16; ++r) { const int c = crow(r, hi); if (c > qq) pc0[r] = NEGBIG; if (c + 32 > qq) pc1[r] = NEGBIG; }
                    }
                }
            }
            const bool locb = ISB && (t < nloc);
            float rm;
            if (locb) { rm = fmaxf(pc0[0], pc0[1]);
#pragma unroll
                for (int r = 2; r < 16; r += 2) rm = fmaxf(fmaxf(rm, pc0[r]), pc0[r + 1]); }
            else { rm = fmaxf(pc0[0], pc1[0]);
#pragma unroll
                for (int r = 1; r < 16; ++r) rm = fmaxf(fmaxf(rm, pc0[r]), pc1[r]); }
            rm = fmaxf(rm, __shfl_xor(rm, 32));
            const float delta = mref - ref_cur;
            constexpr float RESC_THR = 8.f;
            const float dl = __any(rm - delta > RESC_THR) ? fmaxf(rm - delta, 0.f) : 0.f;
            const float sh = delta + dl;
            if (__any(dl > 0.f)) {
                const float f = __builtin_amdgcn_exp2f(-dl);
                l_run *= f; mref += dl;
                if (hi == 0) wsf[r32] = f;
                asm volatile("s_waitcnt lgkmcnt(0)" ::: "memory");
#pragma unroll
                for (int r = 0; r < 16; ++r) { const float fr_ = wsf[crow(r, hi)]; o0[r] *= fr_; o1[r] *= fr_; negm[r] = -mref; }
            }
            if (__any(sh != 0.f)) {
#pragma unroll
                for (int r = 0; r < 16; ++r) { pc0[r] -= sh; pc1[r] -= sh; }
            }
            float ls = 0.f, ls2 = 0.f;
#pragma unroll
            for (int r = 0; r < 16; r += 2) { pc0[r] = __builtin_amdgcn_exp2f(pc0[r]); pc0[r + 1] = __builtin_amdgcn_exp2f(pc0[r + 1]); ls += pc0[r]; ls2 += pc0[r + 1]; }
            if (!locb) {
#pragma unroll
                for (int r = 0; r < 16; r += 2) { pc1[r] = __builtin_amdgcn_exp2f(pc1[r]); pc1[r + 1] = __builtin_amdgcn_exp2f(pc1[r + 1]); ls += pc1[r]; ls2 += pc1[r + 1]; }
            }
            l_run += ls + ls2;
            typedef unsigned u4 __attribute__((ext_vector_type(4)));
            const u4 pw0 = {cvtpk(pc0[0], pc0[1]), cvtpk(pc0[2], pc0[3]), cvtpk(pc0[4], pc0[5]), cvtpk(pc0[6], pc0[7])};
            const u4 pw1 = {cvtpk(pc0[8], pc0[9]), cvtpk(pc0[10], pc0[11]), cvtpk(pc0[12], pc0[13]), cvtpk(pc0[14], pc0[15])};
            const ATT_LAS unsigned char* vp = lds + LDS_V + sc * SLOTB + ((lane >> 4) & 1) * 32 + (lane & 3) * 8 + (4 * hi + ((lane & 15) >> 2)) * 64 + (locb ? bs * 64 : 0);
#define ATT_PV(OACC, PW, D0, KS) do { const s16x4 lo_ = vtr(vp + (D0) * 4096 + (KS) * 1024), hi_ = vtr(vp + (D0) * 4096 + (KS) * 1024 + 512); \
                const bf16x8 vf_ = {lo_[0], lo_[1], lo_[2], lo_[3], hi_[0], hi_[1], hi_[2], hi_[3]}; \
                OACC = __builtin_amdgcn_mfma_f32_32x32x16_bf16(__builtin_bit_cast(bf16x8, PW), vf_, OACC, 0, 0, 0); } while (0)
            ATT_PV(o0, pw0, 0, 0); ATT_PV(o1, pw0, 1, 0); ATT_PV(o0, pw1, 0, 1); ATT_PV(o1, pw1, 1, 1);
            if (!locb) {
                const u4 pw2 = {cvtpk(pc1[0], pc1[1]), cvtpk(pc1[2], pc1[3]), cvtpk(pc1[4], pc1[5]), cvtpk(pc1[6], pc1[7])};
                const u4 pw3 = {cvtpk(pc1[8], pc1[9]), cvtpk(pc1[10], pc1[11]), cvtpk(pc1[12], pc1[13]), cvtpk(pc1[14], pc1[15])};
                ATT_PV(o0, pw2, 0, 2); ATT_PV(o1, pw2, 1, 2); ATT_PV(o0, pw3, 0, 3); ATT_PV(o1, pw3, 1, 3);
            }
#undef ATT_PV
        }
        sc = sn; sn = sn + 1 == NSLOT ? 0 : sn + 1; si = si + 1 == NSLOT ? 0 : si + 1;
    }
    l_run += __shfl_xor(l_run, 32);
    if (hi == 0) wsf[32 + r32] = l_run;
    asm volatile("s_waitcnt lgkmcnt(0)" ::: "memory");
    bf16_t* op = ob + (size_t)(b * L) * D + ocol + r32;
    float* ossp = (float*)(p.ws + WS_OSS) + (size_t)(b * L) * 16 + (ocol >> 6);
#pragma unroll
    for (int r = 0; r < 16; ++r) { const int qi = crow(r, hi); const float inv = __builtin_amdgcn_rcpf(wsf[32 + qi]);
        const int q = ISB ? (qrw + (qi >> 4)) * 64 + 16 * half + (qi & 15) : q0 + qi;
        const float a0 = o0[r] * inv, a1 = o1[r] * inv;
        op[(size_t)q * D] = (bf16_t)f2bf(a0); op[(size_t)q * D + 32] = (bf16_t)f2bf(a1);
        const float ss = row_sum16(a0 * a0 + a1 * a1);
        const float s01 = rdlane(ss, 0) + rdlane(ss, 16), s23 = rdlane(ss, 32) + rdlane(ss, 48);
        if (r32 == 0) ossp[(size_t)q * 16] = hi ? s23 : s01; }
    ATT_WAIT_BAR(0);
#undef ATT_TILE_ROW
#undef ATT_ACTIVE
#undef ATT_QK
}

__device__ __forceinline__ void attn_phase(const Params& p, ATT_LAS unsigned char* lds, int wv) {
    const int G = gridDim.x, bx = blockIdx.x;
    const int vcu = (G % 8 == 0) ? (bx % 8) * (G / 8) + bx / 8 : bx;
    for (int u = vcu; u < 2048; u += G) {
        if (u < 1024) attn_unit<false>(p, lds, u, wv); else attn_unit<true>(p, lds, u - 1024, wv);
    }
}
}

constexpr int SW_STRIDE = 36;

__device__ void p4c_post(const Params& p, LAS3 float* sW, int wv) {
    const int tid = tid_opaque(wv), lane = tid & 63;
    const float* mod = (const float*)(p.ws + WS_MOD); const bf16_t* mix = (const bf16_t*)(p.ws + WS_MIX);
    unsigned char* h8 = p.ws + WS_HB;
    unsigned* counts = (unsigned*)(p.ws + WS_CTL);
    int* eslot = (int*)(p.ws + WS_ESLOT); float* ew = (float*)(p.ws + WS_EW);
    const int wave = tid >> 6;
    LAS3 int* lcnt = (LAS3 int*)(sW + 1024 * SW_STRIDE) + 128;
    LAS3 int* lbase = lcnt + 32;
    LAS3 int* stg_slot = lbase + 32; LAS3 int* stg_e = stg_slot + 512; LAS3 float* stg_w = (LAS3 float*)(stg_e + 512);
    if (tid < NE) lcnt[tid] = 0;
    for (int i = tid; i < D * 8; i += NTHREADS) { const int k = i >> 3, e4 = i & 7; const f32x4 w = ((const f32x4*)p.w_router)[i];
        LAS3 float* d = sW + ((k & 3) * 256 + (k >> 2)) * SW_STRIDE + e4 * 4; *(LAS3 f32x4*)d = w; }
    __syncthreads();
    constexpr int R = 16;
    const int m0 = ((int)blockIdx.x * (NTHREADS / 64) + wave) * R;
    if (m0 < NTOK) {
        const int b = m0 / L; const float* mb = mod + b * 6144;
        f32x4 pA[4], pB[4], pC[4], v[4], xx[4];
#pragma unroll
        for (int j = 0; j < 4; ++j) { const int c0 = 4 * (lane + 64 * j);
            pA[j] = *(const f32x4*)(p.g_post_mix + c0) * *(const f32x4*)(mb + 2048 + c0);
            pB[j] = *(const f32x4*)(p.g_pre_ffn + c0) * (*(const f32x4*)(mb + 4096 + c0) + 1.f);
            pC[j] = *(const f32x4*)(mb + 3072 + c0);
 }
        const float brt0 = p.b_router[lane & 15], brt1 = p.b_router[16 + (lane & 15)];
#pragma unroll 1
        for (int it = 0; it < R; ++it) {
            const int m = m0 + it;
#pragma unroll
            for (int j = 0; j < 4; ++j) { const u32x2 nvj = ((const u32x2*)(mix + (size_t)m * D))[lane + 64 * j]; xx[j] = ((const f32x4*)(p.x + (size_t)m * D))[lane + 64 * j];
                v[j] = (f32x4){__uint_as_float(nvj.x << 16), __uint_as_float(nvj.x & 0xffff0000u), __uint_as_float(nvj.y << 16), __uint_as_float(nvj.y & 0xffff0000u)}; }
            float s = 0.f;
#pragma unroll
            for (int j = 0; j < 4; ++j) s += v[j].x * v[j].x + v[j].y * v[j].y + v[j].z * v[j].z + v[j].w * v[j].w;
            float rstd = rsqrtf(wave_sum(s) * (1.f / D) + EPS);
            s = 0.f;
            f32x4 xv[4];
#pragma unroll
            for (int j = 0; j < 4; ++j) {
                xv[j] = xx[j] + pA[j] * (v[j] * rstd);
                ((f32x4*)(p.out + (size_t)m * D))[lane + 64 * j] = xv[j];
                s += xv[j].x * xv[j].x + xv[j].y * xv[j].y + xv[j].z * xv[j].z + xv[j].w * xv[j].w; }
            rstd = rsqrtf(wave_sum(s) * (1.f / D) + EPS);
            f32x4 h2v[4];
#pragma unroll
            for (int j = 0; j < 4; ++j) { const int c0 = 4 * (lane + 64 * j);
                h2v[j] = (xv[j] * rstd) * pB[j] + pC[j];
                *(unsigned*)(h8 + (size_t)m * D + c0) = pk4_fp8(h2v[j].x, h2v[j].y, h2v[j].z, h2v[j].w); }
            const int li = lane & 15;
            unsigned lrow = (unsigned)lane * (SW_STRIDE * 4); asm volatile("" : "+v"(lrow));
            float zz[2];
#pragma unroll
            for (int ps = 0; ps < 2; ++ps) {
                float lg[16];
#pragma unroll
                for (int e = 0; e < 16; ++e) lg[e] = 0.f;
#pragma unroll
                for (int j = 0; j < 4; ++j)
#pragma unroll
                    for (int q = 0; q < 4; ++q) { const float hv = h2v[j][q]; const LAS3 f32x4* wr = (const LAS3 f32x4*)((LAS3 unsigned char*)sW + (lrow + (unsigned)((q * 256 + 64 * j) * SW_STRIDE * 4 + ps * 64)));
#pragma unroll
                        for (int e4 = 0; e4 < 4; ++e4) { const f32x4 ww = wr[e4]; lg[e4 * 4] = fmaf(hv, ww.x, lg[e4 * 4]); lg[e4 * 4 + 1] = fmaf(hv, ww.y, lg[e4 * 4 + 1]); lg[e4 * 4 + 2] = fmaf(hv, ww.z, lg[e4 * 4 + 2]); lg[e4 * 4 + 3] = fmaf(hv, ww.w, lg[e4 * 4 + 3]); }
                        asm volatile("" : "+v"(lg[0]), "+v"(lg[1]), "+v"(lg[2]), "+v"(lg[3]), "+v"(lg[4]), "+v"(lg[5]), "+v"(lg[6]), "+v"(lg[7]), "+v"(lg[8]), "+v"(lg[9]), "+v"(lg[10]), "+v"(lg[11]), "+v"(lg[12]), "+v"(lg[13]), "+v"(lg[14]), "+v"(lg[15]) :: "memory"); }
                float w8[8], w4[4], w2[2], z;
                { const bool up = li >= 8;
#pragma unroll
                  for (int j = 0; j < 8; ++j) { const float keep = up ? lg[8 + j] : lg[j], send = up ? lg[j] : lg[8 + j]; w8[j] = keep + dppmov<0x140>(send); } }
                { const bool up = (li & 7) >= 4;
#pragma unroll
                  for (int j = 0; j < 4; ++j) { const float keep = up ? w8[4 + j] : w8[j], send = up ? w8[j] : w8[4 + j]; w4[j] = keep + dppmov<0x141>(send); } }
                { const bool up = (li & 2) != 0;
#pragma unroll
                  for (int j = 0; j < 2; ++j) { const float keep = up ? w4[2 + j] : w4[j], send = up ? w4[j] : w4[2 + j]; w2[j] = keep + dppmov<0x4E>(send); } }
                { const bool up = (li & 1) != 0; const float keep = up ? w2[1] : w2[0], send = up ? w2[0] : w2[1]; z = keep + dppmov<0xB1>(send); }
                z += __shfl_xor(z, 16); z += __shfl_xor(z, 32);
                zz[ps] = z;
            }
            float z0 = zz[0] + brt0, z1 = zz[1] + brt1;
            float tv[4]; int ti[4];
#pragma unroll
            for (int k = 0; k < 4; ++k) {
                const bool first = z0 >= z1; const float bv = first ? z0 : z1;
                float mx = fmaxf(bv, dppmov<0xB1>(bv)); mx = fmaxf(mx, dppmov<0x4E>(mx)); mx = fmaxf(mx, dppmov<0x141>(mx)); mx = fmaxf(mx, dppmov<0x140>(mx));
                int ce = (bv == mx) ? (first ? li : 16 + li) : 99;
                { int o = __builtin_amdgcn_update_dpp(0, ce, 0xB1, 0xf, 0xf, true); ce = ce < o ? ce : o; o = __builtin_amdgcn_update_dpp(0, ce, 0x4E, 0xf, 0xf, true); ce = ce < o ? ce : o;
                  o = __builtin_amdgcn_update_dpp(0, ce, 0x141, 0xf, 0xf, true); ce = ce < o ? ce : o; o = __builtin_amdgcn_update_dpp(0, ce, 0x140, 0xf, 0xf, true); ce = ce < o ? ce : o; }
                ti[k] = __builtin_amdgcn_readfirstlane(ce); tv[k] = mx;
                { const bool mine = li == (ti[k] & 15); z0 = (mine && ti[k] < 16) ? -3.4e38f : z0; z1 = (mine && ti[k] >= 16) ? -3.4e38f : z1; }
            }
            const float e1 = __expf(tv[1] - tv[0]), e2 = __expf(tv[2] - tv[0]), e3 = __expf(tv[3] - tv[0]); const float inv = 1.f / (1.f + e1 + e2 + e3);
            const float tw[4] = {inv, e1 * inv, e2 * inv, e3 * inv};
            if (lane < 4) {
                int myi = ti[0]; float myw = tw[0];
#pragma unroll
                for (int k = 1; k < 4; ++k) if (lane == k) { myi = ti[k]; myw = tw[k]; }
                const int lr = __hip_atomic_fetch_add((LAS3 int*)&lcnt[myi], 1, __ATOMIC_RELAXED, __HIP_MEMORY_SCOPE_WORKGROUP);
                const int si = (wave * 16 + it) * 4 + lane;
                stg_slot[si] = m * 4 + lane; stg_e[si] = myi | (lr << 8); stg_w[si] = myw;
            }
        }
    }
    __syncthreads();
    if (tid < NE) { const int c = lcnt[tid]; lbase[tid] = c ? (int)atomicAdd(&counts[tid * 64], (unsigned)c) : 0; }
    __syncthreads();
    { const int si = tid, w = si >> 6;
      if (((int)blockIdx.x * (NTHREADS / 64) + w) * R < NTOK) {
        const int ee = stg_e[si], e = ee & 255, lr = ee >> 8; const int rank = lbase[e] + lr;
        eslot[(size_t)e * ECAP + rank] = stg_slot[si]; ew[(size_t)e * ECAP + rank] = stg_w[si]; } }
    __syncthreads();
}
__device__ __forceinline__ void expert_bases(const unsigned* counts, int* sbase_  , int wv) {
    LAS3 int* sbase = (LAS3 int*)sbase_;
    if (wv == 0) {
        const int lane = lane_id(); const int cn = lane < NE ? (int)counts[lane * 64] : 0; const int c = (cn + 255) & ~255;
        int incl = c;
#pragma unroll
        for (int o = 1; o < 32; o <<= 1) { const int v = __shfl_up(incl, o); if (lane >= o) incl += v; }
        if (lane < NE) { sbase[lane] = incl - c; sbase[40 + lane] = cn; }
        if (lane == NE - 1) sbase[NE] = incl;
    }
    __syncthreads();
}
typedef float f32x2v __attribute__((ext_vector_type(2)));
__device__ __forceinline__ void p6_load(const unsigned char* y, const float* out, int m, int lane, u32x2 (&yv)[2][4], f32x4 (&xv)[2][2]) {
#pragma unroll
    for (int j = 0; j < 2; ++j) { const int c0 = 8 * (lane + 64 * j);
#pragma unroll
        for (int k = 0; k < 4; ++k) yv[j][k] = *(const u32x2*)(y + (size_t)(m * 4 + k) * D + c0);
        xv[j][0] = *(const f32x4*)(out + (size_t)m * D + c0); xv[j][1] = *(const f32x4*)(out + (size_t)m * D + c0 + 4); }
}
__device__ void p6_final(const Params& p, int wv) {
    const int tid = tid_opaque(wv), lane = tid & 63;
    const float* mod = (const float*)(p.ws + WS_MOD); const unsigned char* y = p.ws + WS_Y;
    constexpr int R = 16;
    const int m0 = ((int)blockIdx.x * (NTHREADS / 64) + (tid >> 6)) * R;
    if (m0 >= NTOK) return;
    const int b = m0 / L; const float* ga2 = mod + b * 6144 + 5120;
    f32x4 pA[2][2];
#pragma unroll
    for (int j = 0; j < 2; ++j)
#pragma unroll
        for (int q = 0; q < 2; ++q) { const int c0 = 8 * (lane + 64 * j) + 4 * q; pA[j][q] = *(const f32x4*)(p.g_post_ffn + c0) * *(const f32x4*)(ga2 + c0); }
    u32x2 yv[2][4], ny[2][4]; f32x4 xv[2][2], nx[2][2];
    p6_load(y, p.out, m0, lane, ny, nx);
    for (int it = 0; it < R; ++it) {
        const int m = m0 + it;
#pragma unroll
        for (int j = 0; j < 2; ++j) {
#pragma unroll
            for (int k = 0; k < 4; ++k) yv[j][k] = ny[j][k];
            xv[j][0] = nx[j][0]; xv[j][1] = nx[j][1]; }
        if (it + 1 < R) p6_load(y, p.out, m + 1, lane, ny, nx);
        f32x4 a[2][2]; float s = 0.f;
#pragma unroll
        for (int j = 0; j < 2; ++j) { a[j][0] = (f32x4){0.f, 0.f, 0.f, 0.f}; a[j][1] = (f32x4){0.f, 0.f, 0.f, 0.f};
#pragma unroll
            for (int k = 0; k < 4; ++k) { const u32x2 w = yv[j][k];
                const f32x2v l0 = __builtin_amdgcn_cvt_pk_f32_fp8((int)w.x, false), l1 = __builtin_amdgcn_cvt_pk_f32_fp8((int)w.x, true);
                const f32x2v h0 = __builtin_amdgcn_cvt_pk_f32_fp8((int)w.y, false), h1 = __builtin_amdgcn_cvt_pk_f32_fp8((int)w.y, true);
                a[j][0].x += l0.x; a[j][0].y += l0.y; a[j][0].z += l1.x; a[j][0].w += l1.y;
                a[j][1].x += h0.x; a[j][1].y += h0.y; a[j][1].z += h1.x; a[j][1].w += h1.y; }
#pragma unroll
            for (int q = 0; q < 2; ++q) { a[j][q] = a[j][q] * Y8_INV; s += a[j][q].x * a[j][q].x + a[j][q].y * a[j][q].y + a[j][q].z * a[j][q].z + a[j][q].w * a[j][q].w; } }
        const float rstd = rsqrtf(wave_sum(s) * (1.f / D) + EPS);
#pragma unroll
        for (int j = 0; j < 2; ++j)
#pragma unroll
            for (int q = 0; q < 2; ++q) { const int c0 = 8 * (lane + 64 * j) + 4 * q;
                *(f32x4*)(p.out + (size_t)m * D + c0) = xv[j][q] + pA[j][q] * (a[j][q] * rstd); }
    }
}

constexpr int LDS_SBASE = 147456;
constexpr int LDS_BYTES = LDS_SBASE + 512 + (64 + 3 * 512) * 4 + 256;

__global__ void __launch_bounds__(NTHREADS, 2) fwd_kernel(Params p) {
    cg::grid_group grid = cg::this_grid();
    extern __shared__ __attribute__((aligned(16))) unsigned char lds[];
    int* sbase = (int*)(lds + LDS_SBASE);
    PG8_LAS unsigned char* lds3 = (PG8_LAS unsigned char*)lds;
    const PG8_LAS int* sbase3 = (const PG8_LAS int*)(lds3 + LDS_SBASE);
    volatile LAS3 unsigned* bst = (volatile LAS3 unsigned*)(lds3 + LDS_SBASE + 384);
    const int wv = __builtin_amdgcn_readfirstlane((int)(threadIdx.x >> 6));
    if (wv == 0 && lane_id() < 2) bst[lane_id()] = 0u;
    __syncthreads();
    XcdBarrier xb = xcd_barrier_post((unsigned*)(p.ws + WS_CTL) + CW_BAR, bst, wv);

    p0_mod(p, (float*)lds, (float*)(lds + 36864), wv);
    p0_tab(p, wv);
    p0_weights(p, lds, wv);
    grid.sync();
    p1_h(p, wv);
    xcd_barrier(xb);
    { pg8::Gemm g{(const bf16_t*)(p.ws + WS_HB), (const bf16_t*)(p.ws + WS_WIN), D, 0, nullptr, sbase3, wv};
      pg8::StaticOrder S; S.init(MROWS, INW, (int)gridDim.x, (int)blockIdx.x, nullptr);
      { const int t_ = tid_opaque(wv); *(PG8_LAS f32x4*)(lds3 + pg8::PAR_TAB + t_ * 16) = ((const f32x4*)(p.ws + WS_TAB))[t_]; }
      __syncthreads();
      pg8::EpiQKV E{(bf16_t*)(p.ws + WS_QKV)};
      pg8::gemm_phase<pg8::EpiQKV, pg8::StaticOrder, false, true>(lds3, g, S, E); }
    xcd_barrier(xb);
    att::attn_phase(p, lds3, wv);
    xcd_barrier(xb);
    { pg8::Gemm g{(const bf16_t*)(p.ws + WS_O), (const bf16_t*)(p.ws + WS_WOUT), D, 0, nullptr, sbase3, wv};
      pg8::StaticOrder S; S.init(NTOK, D, (int)gridDim.x, (int)blockIdx.x, nullptr);
      pg8::EpiOutProj E{(bf16_t*)(p.ws + WS_MIX), (const float*)(p.ws + WS_OSS)};
      pg8::gemm_phase<pg8::EpiOutProj, pg8::StaticOrder, false, true>(lds3, g, S, E); }
    xcd_barrier(xb);
    p4c_post(p, (LAS3 float*)lds3, wv);
    xcd_barrier(xb);
    expert_bases((const unsigned*)(p.ws + WS_CTL), sbase, wv);
    { const int total = sbase3[NE];
      pg8::Gemm g{(const bf16_t*)(p.ws + WS_HB), (const bf16_t*)(p.ws + WS_W1), D / 2, (size_t)2048 * D, (const int*)(p.ws + WS_ESLOT), sbase3, wv};
      pg8::StaticOrder S; S.init(total, 2048, (int)gridDim.x, (int)blockIdx.x, sbase3);
      pg8::EpiSwiglu E{p.ws + WS_ACT, p.b_mlp1};
      pg8::gemm_phase<pg8::EpiSwiglu, pg8::StaticOrder, true, true, true>(lds3, g, S, E); }
    xcd_barrier(xb);
    { const int total = sbase3[NE];
      pg8::Gemm g{(const bf16_t*)(p.ws + WS_ACT), (const bf16_t*)(p.ws + WS_W2), D / 2, (size_t)D * D, nullptr, sbase3, wv};
      pg8::StaticOrder S; S.init(total, D, (int)gridDim.x, (int)blockIdx.x, sbase3);
      pg8::EpiScatter E{p.ws + WS_Y, p.b_mlp2, (const int*)(p.ws + WS_ESLOT), (const float*)(p.ws + WS_EW), sbase3};
      pg8::gemm_phase<pg8::EpiScatter, pg8::StaticOrder, false, true, true>(lds3, g, S, E); }
    xcd_barrier(xb);
    p6_final(p, wv);
}

extern "C" void kernel_launch(void* const* d_in, const int* in_sizes, int n_in, void* d_out, int out_size, void* d_ws, size_t ws_size, hipStream_t stream) {
    static int grid_blocks = 0;
    if (grid_blocks == 0) {
        if (n_in != 22 || ws_size < WS_END) { fprintf(stderr, "kernel_launch: unexpected n_in %d / ws_size %zu (need %zu)\n", n_in, ws_size, (size_t)WS_END); grid_blocks = -1; return; }
        int dev = 0, cus = 0, per_cu = 0;
        (void)hipGetDevice(&dev);
        (void)hipDeviceGetAttribute(&cus, hipDeviceAttributeMultiprocessorCount, dev);
        if (hipFuncSetAttribute((const void*)fwd_kernel, hipFuncAttributeMaxDynamicSharedMemorySize, LDS_BYTES) != hipSuccess) { fprintf(stderr, "kernel_launch: hipFuncSetAttribute failed\n"); grid_blocks = -1; return; }
        (void)hipOccupancyMaxActiveBlocksPerMultiprocessor(&per_cu, (const void*)fwd_kernel, NTHREADS, LDS_BYTES);
        if (per_cu < 1) { fprintf(stderr, "kernel_launch: occupancy query returned %d\n", per_cu); grid_blocks = -1; return; }
        grid_blocks = cus;
        if (grid_blocks * (NTHREADS / 64) * 16 < NTOK) { fprintf(stderr, "kernel_launch: needs >= 256 CUs (got %d)\n", cus); grid_blocks = -1; return; }
    }
    if (grid_blocks < 0) return;
    (void)hipMemsetAsync((char*)d_ws + WS_CTL, 0, CTL_BYTES, stream);
    Params p{};
    const float** pp = (const float**)&p;
    for (int i = 0; i < 22; ++i) pp[i] = (const float*)d_in[i];
    p.out = (float*)d_out; p.ws = (unsigned char*)d_ws;
    void* args[] = {&p};
    hipError_t e = hipLaunchCooperativeKernel((const void*)fwd_kernel, dim3(grid_blocks), dim3(NTHREADS), args, LDS_BYTES, stream);
    if (e != hipSuccess) fprintf(stderr, "cooperative launch failed: %s (grid %d)\n", hipGetErrorString(e), grid_blocks);
}
```

```cpp
#include <hip/hip_runtime.h>
#include <hip/hip_cooperative_groups.h>
#include <cstdio>
#include <cstdint>
namespace cg = cooperative_groups;

constexpr int D = 1024, NB = 8, L = 4096, CTX = 256;
constexpr int NTOK = NB * L, NCTX = NB * CTX, MROWS = NTOK + NCTX;
constexpr int INW = 2304;
constexpr int C_QA = 0, C_KA = 512, C_VA = 640, C_QB = 768, C_KB = 1280, C_VB = 1792;
constexpr int NE = 32, TOPK = 4, NASG = NTOK * TOPK;
constexpr int PADROWS = NASG + NE * 256;
constexpr float LOG2E = 1.4426950408889634f;
constexpr float QSCALE = 0.125f * LOG2E;
constexpr float EPS = 1e-6f;
constexpr int NTHREADS = 512;

constexpr size_t MiB = 1u << 20;
constexpr size_t WS_CTL = 0;
constexpr size_t CTL_BYTES = 32768;
constexpr int CW_BAR = 2048;
constexpr size_t WS_MOD = 1 * MiB;
constexpr size_t WS_TAB = 1 * MiB + 256 * 1024;
constexpr size_t WS_OSTAT = 1 * MiB + 512 * 1024;
constexpr size_t WS_WIN = 2 * MiB;
constexpr size_t WS_WOUT = 7 * MiB;
constexpr size_t WS_W2 = 9 * MiB;
constexpr size_t WS_OSS = 41 * MiB;
constexpr size_t WS_W1 = 73 * MiB;
constexpr size_t WS_HB = 201 * MiB;
constexpr int ECAP = NTOK;
constexpr size_t WS_ESLOT = 269 * MiB;
constexpr size_t WS_EW = 273 * MiB;
constexpr size_t WS_QKV = 277 * MiB;
constexpr size_t WS_O = 430 * MiB;
constexpr size_t WS_MIX = 494 * MiB;
constexpr size_t WS_ACT = 277 * MiB;
constexpr size_t WS_Y = 622 * MiB;
constexpr size_t WS_END = 878 * MiB;
static_assert(WS_W1 + (size_t)NE * 2048 * D * 2 <= WS_HB && WS_W2 + (size_t)NE * D * D * 2 <= WS_W1, "map");
static_assert(WS_HB + (size_t)MROWS * D * 2 <= WS_ESLOT && WS_ESLOT + (size_t)NE * ECAP * 4 <= WS_EW && WS_EW + (size_t)NE * ECAP * 4 <= WS_QKV, "map");
static_assert(WS_QKV + (size_t)MROWS * INW * 2 <= WS_O && WS_O + (size_t)NTOK * D * 2 <= WS_MIX && WS_MIX + (size_t)NTOK * D * 4 <= WS_Y, "map");
static_assert(WS_ACT + (size_t)PADROWS * 1024 * 2 <= WS_Y && WS_Y + (size_t)NASG * D * 2 <= WS_END, "map");

typedef unsigned short bf16_t;
typedef float f32x4 __attribute__((ext_vector_type(4)));
typedef unsigned u32x4 __attribute__((ext_vector_type(4)));
typedef unsigned u32x2 __attribute__((ext_vector_type(2)));

struct Params {
    const float *x, *c, *ctx, *c_ctx, *w_ada, *b_ada, *g_pre_mix, *g_post_mix, *g_pre_ffn, *g_post_ffn, *w_in, *g_grp_a, *g_grp_b,
        *sink_a, *rpb_b, *w_out, *w_router, *b_router, *w_mlp1, *b_mlp1, *w_mlp2, *b_mlp2;
    float* out;
    unsigned char* ws;
};

__device__ __forceinline__ unsigned f2bf(float f) { unsigned u = __float_as_uint(f); return (u + 0x7fffu + ((u >> 16) & 1u)) >> 16; }
__device__ __forceinline__ unsigned pk2(float lo, float hi) { return f2bf(lo) | (f2bf(hi) << 16); }
__device__ __forceinline__ unsigned pk4_fp8(float v0, float v1, float v2, float v3) {
    int w = 0; w = __builtin_amdgcn_cvt_pk_fp8_f32(v0, v1, w, false); w = __builtin_amdgcn_cvt_pk_fp8_f32(v2, v3, w, true); return (unsigned)w; }
constexpr float Y8_SCALE = 16.f, Y8_INV = 1.f / 16.f;
constexpr float W8_SCALE = 64.f, W8_INV = 1.f / 64.f;
__device__ __forceinline__ int lane_id() { int l = (int)__builtin_amdgcn_mbcnt_hi(~0u, __builtin_amdgcn_mbcnt_lo(~0u, 0u)); asm volatile("" : "+v"(l)); return l; }
__device__ __forceinline__ int tid_opaque(int wv) { return wv * 64 + lane_id(); }
template <int CTRL> __device__ __forceinline__ float dppmov(float v) { return __builtin_bit_cast(float, __builtin_amdgcn_update_dpp(0, __builtin_bit_cast(int, v), CTRL, 0xf, 0xf, true)); }
__device__ __forceinline__ float row_sum16(float v) { v += dppmov<0xB1>(v); v += dppmov<0x4E>(v); v += dppmov<0x141>(v); v += dppmov<0x140>(v); return v; }
__device__ __forceinline__ float rdlane(float v, int l) { return __builtin_bit_cast(float, __builtin_amdgcn_readlane(__builtin_bit_cast(int, v), l)); }
__device__ __forceinline__ float wave_sum(float v) { v = row_sum16(v); return (rdlane(v, 0) + rdlane(v, 16)) + (rdlane(v, 32) + rdlane(v, 48)); }

#define LAS3 __attribute__((address_space(3)))
#define XB_TMO      128
#define XB_XCNT(j)  (256  + 64 * (j))
#define XB_XSUB(j)  (1280 + 64 * (j))
#define XB_XGEN(j)  (2304 + 64 * (j))
#define XB_TOP      3328
#define XB_TOPGEN   3392
#define XCD_BAR_WORDS 3456
#define XB_SPIN_CAP (1u << 18)
__device__ __forceinline__ unsigned xb_ld(unsigned* p)              { return __hip_atomic_load(p, __ATOMIC_RELAXED, __HIP_MEMORY_SCOPE_AGENT); }
__device__ __forceinline__ unsigned xb_add(unsigned* p, unsigned v) { return __hip_atomic_fetch_add(p, v, __ATOMIC_RELAXED, __HIP_MEMORY_SCOPE_AGENT); }
__device__ __forceinline__ unsigned xb_xcc_id() { return (unsigned)__builtin_amdgcn_s_getreg((3 << 11) | 20) & 0xFu; }
#define XB_SPIN(cond, bar) do { unsigned _sp = 0; while (cond) { __builtin_amdgcn_s_sleep(1); \
    if ((++_sp & 255u) == 0u) { if (xb_ld(&(bar)[XB_TMO])) break; if (_sp > XB_SPIN_CAP) { atomicAdd(&(bar)[XB_TMO], 1u); break; } } } } while (0)
struct XcdBarrier { unsigned* bar; unsigned x; volatile LAS3 unsigned* st; int wv; };
__device__ __forceinline__ XcdBarrier xcd_barrier_post(unsigned* bar, volatile LAS3 unsigned* st, int wv) {
    XcdBarrier b; b.bar = bar; b.x = xb_xcc_id(); b.st = st; b.wv = wv;
    if (tid_opaque(wv) == 0) (void)xb_add(&bar[XB_XCNT(b.x)], 1u);
    return b;
}
__device__ __forceinline__ void xcd_barrier_complete(unsigned* bar, unsigned x, unsigned& nloc, unsigned& nx) {
    const unsigned G = gridDim.x * gridDim.y * gridDim.z;
    unsigned sum, cnt, mine, sp = 0u;
    for (;;) {
        sum = 0u; cnt = 0u; mine = 0u;
#pragma unroll
        for (unsigned j = 0; j < 16; ++j) { const unsigned c = xb_ld(&bar[XB_XCNT(j)]); sum += c; cnt += (c > 0u) ? 1u : 0u; mine = (j == x) ? c : mine; }
        if (sum == G) break;
        __builtin_amdgcn_s_sleep(1);
        if ((++sp & 255u) == 0u) { if (xb_ld(&bar[XB_TMO])) break; if (sp > XB_SPIN_CAP) { atomicAdd(&bar[XB_TMO], 1u); break; } }
    }
    nloc = mine > 0u ? mine : 1u; nx = cnt > 0u ? cnt : 1u;
}
__device__ __forceinline__ void xcd_barrier(const XcdBarrier& b) {
    asm volatile("s_waitcnt vmcnt(0)" ::: "memory");
    __syncthreads();
    if (tid_opaque(b.wv) == 0) {
        unsigned* bar = b.bar;
        __builtin_amdgcn_s_waitcnt(0);
        unsigned nloc = b.st[0], nx = b.st[1];
        if (nloc == 0u) { xcd_barrier_complete(bar, b.x, nloc, nx); b.st[0] = nloc; b.st[1] = nx; }
        const unsigned old = xb_add(&bar[XB_XSUB(b.x)], 1u);
        const unsigned gen = old / nloc;
        if (old + 1u == (gen + 1u) * nloc) {
            __builtin_amdgcn_fence(__ATOMIC_RELEASE, "agent");
            asm volatile("s_waitcnt vmcnt(0)" ::: "memory");
            const unsigned og = xb_add(&bar[XB_TOP], 1u);
            const unsigned tg = og / nx;
            if (og + 1u == (tg + 1u) * nx) xb_add(&bar[XB_TOPGEN], 1u);
            else XB_SPIN(xb_ld(&bar[XB_TOPGEN]) == tg, bar);
            __builtin_amdgcn_fence(__ATOMIC_ACQUIRE, "agent");
            xb_add(&bar[XB_XGEN(b.x)], 1u);
            asm volatile("s_waitcnt vmcnt(0)" ::: "memory");
        } else {
            XB_SPIN(xb_ld(&bar[XB_XGEN(b.x)]) == gen, bar);
            __builtin_amdgcn_fence(__ATOMIC_ACQUIRE, "agent");
            asm volatile("s_waitcnt vmcnt(0)" ::: "memory");
        }
    }
    __syncthreads();
}

namespace pg8 {
#define PG8_LAS __attribute__((address_space(3)))
typedef short bf16x8 __attribute__((ext_vector_type(8)));
typedef int v8i __attribute__((ext_vector_type(8)));
typedef int v4i __attribute__((ext_vector_type(4)));
typedef short s16x16 __attribute__((ext_vector_type(16)));
constexpr int BM = 256, BK = 64, HALF = 128, HTB = HALF * BK * 2  , STAGE_BYTES = 8 * HTB, NXCD = 8, WGM = 8;
__device__ __forceinline__ int lds_byte(int r, int c) { const int st = (r >> 4) * 2 + (c >> 5), rr = r & 15, cc = c & 31, ob = rr * 64 + cc * 2; return st * 1024 + (ob ^ (((ob >> 9) & 1) << 5)); }
__device__ __forceinline__ void stage_rc(int b, int& R, int& C) { const int st = b / 1024, sb = b % 1024, swz = sb ^ (((sb >> 9) & 1) << 5); R = (st >> 1) * 16 + swz / 64; C = (st & 1) * 32 + (swz % 64) / 2; }
__device__ __forceinline__ int perm32(int rho) { const int n = rho >> 4, i = rho & 15; return 8 * (i >> 2) + 4 * n + (i & 3); }

constexpr int PAR_BASE = 131072, PAR_BUF = 4096, PAR_IDX = 0, PAR_W = 1024, PAR_BIAS = 2048, PAR_TAB = PAR_BASE + 2 * PAR_BUF;
typedef short s16x2 __attribute__((ext_vector_type(2)));
__device__ __forceinline__ int par_i32(PG8_LAS unsigned char* p) { return __builtin_bit_cast(int, *(const PG8_LAS s16x2*)p); }
__device__ __forceinline__ float par_f32(PG8_LAS unsigned char* p) { return __builtin_bit_cast(float, *(const PG8_LAS s16x2*)p); }
__device__ __forceinline__ f32x4 par_f32x4(PG8_LAS unsigned char* p) { return __builtin_bit_cast(f32x4, *(const PG8_LAS bf16x8*)p); }
struct Unit { int pm, pn, e; };
struct Gemm { const bf16_t* A; const bf16_t* Bt; int K; size_t bstride; const int* eslot; const PG8_LAS int* sb; int wv; };

struct StaticOrder {
    int nM, nN, nwg, G, c; const PG8_LAS int* sbase;
    __device__ void init(int M, int N, int G_, int c_, const PG8_LAS int* sb) { nM = M / BM; nN = N / BM; nwg = nM * nN; G = G_; c = c_; sbase = sb; }
    __device__ bool next(int i, Unit& u) const {
        const long Lx = (long)i * G + c; if (Lx >= nwg) return false;
        int wgid = (int)Lx; { const int q = nwg / NXCD, r = nwg % NXCD, xcd = wgid % NXCD, off = wgid / NXCD; wgid = (xcd < r ? xcd * (q + 1) : r * (q + 1) + (xcd - r) * q) + off; }
        const int nig = WGM * nN, gid = wgid / nig, fm = gid * WGM, gsz = (nM - fm) < WGM ? (nM - fm) : WGM;
        u.pm = fm + ((wgid % nig) % gsz); u.pn = (wgid % nig) / gsz; u.e = 0;
        if (sbase) { const int row = u.pm * BM; const int l = lane_id();
            const bool ge = (l >= 1) && (l < 32) && (row >= sbase[l & 31]);
            u.e = __builtin_popcountll(__ballot(ge)); }
        return true;
    }
};

template <class Epi, class Sched, bool GATHER, bool ALIGN_EPI, bool FP8 = false>
__device__ __forceinline__ void gemm_phase(PG8_LAS unsigned char* lds, const Gemm g, const Sched& S, const Epi& E) {
    const int tid = tid_opaque(g.wv), wid = g.wv,
              lane = tid & 63, wr = wid >> 2, wc = wid & 3, fr = lane & 15, fq = lane >> 4;
    const int K = g.K, nt = K / BK;
    unsigned voffA[2], voffB[2];
#pragma unroll
    for (int i = 0; i < 2; ++i) { const int R = 8 * (wid + 8 * i) + (lane >> 3), Sb = (((lane & 7) ^ (lane >> 3)) * 16); const int Rb = Epi::PERM ? ((R & ~31) + perm32(R & 31)) : R;
        voffA[i] = (unsigned)(R * K * 2 + Sb); voffB[i] = (unsigned)(Rb * K * 2 + Sb); }
    const size_t kstep = (size_t)(BK * 2);
    const size_t hstep = (size_t)HALF * K * 2;
    const size_t tstep = 2 * hstep;
    const unsigned ldsw = (unsigned)wid * 1024u;
    const int fsw0 = (fr & 7) * 128 + ((fq ^ (fr & 7)) * 16), fsw1 = (fr & 7) * 128 + (((fq + 4) ^ (fr & 7)) * 16);
    const int aoff0 = (wr * 8 + (fr >> 3)) * 1024 + fsw0, aoff1 = (wr * 8 + (fr >> 3)) * 1024 + fsw1, boff0 = (wc * 4 + (fr >> 3)) * 1024 + fsw0, boff1 = (wc * 4 + (fr >> 3)) * 1024 + fsw1;
#define PG8_SA(b, h) (((b) * 2 + (h)) * HTB)
#define PG8_SB(b, h) ((4 + (b) * 2 + (h)) * HTB)
#define PG8_STAGE(bufoff, gbase, voff) do { _Pragma("unroll") for (int _i = 0; _i < 2; ++_i) \
        __builtin_amdgcn_global_load_lds((const unsigned*)((const char*)(gbase) + (voff)[_i]), (PG8_LAS unsigned*)(lds + (bufoff) + ldsw + _i * 8192), 16, 0, 0); } while (0)
#define PG8_CAT(lo_, hi_) __builtin_bit_cast(v8i, __builtin_shufflevector((lo_), (hi_), 0, 1, 2, 3, 4, 5, 6, 7, 8, 9, 10, 11, 12, 13, 14, 15))
#define PG8_LDA(dst, b, h) do { _Pragma("unroll") for (int m = 0; m < 4; ++m) { \
        const bf16x8 f0_ = *(const PG8_LAS bf16x8*)(lds + PG8_SA(b, h) + aoff0 + m * 2048), f1_ = *(const PG8_LAS bf16x8*)(lds + PG8_SA(b, h) + aoff1 + m * 2048); \
        if constexpr (FP8) dst##8[m] = PG8_CAT(f0_, f1_); else { dst[m][0] = f0_; dst[m][1] = f1_; } } } while (0)
#define PG8_LDB(dst, b, h) do { _Pragma("unroll") for (int n = 0; n < 2; ++n) { \
        const bf16x8 f0_ = *(const PG8_LAS bf16x8*)(lds + PG8_SB(b, h) + boff0 + n * 2048), f1_ = *(const PG8_LAS bf16x8*)(lds + PG8_SB(b, h) + boff1 + n * 2048); \
        if constexpr (FP8) dst##8[n] = PG8_CAT(f0_, f1_); else { dst[n][0] = f0_; dst[n][1] = f1_; } } } while (0)
#define PG8_MMA(ai, bj, At, Bt) do { __builtin_amdgcn_s_setprio(1); _Pragma("unroll") for (int m = 0; m < 4; ++m) _Pragma("unroll") for (int n = 0; n < 2; ++n) { \
        if constexpr (FP8) asm volatile("v_mfma_scale_f32_16x16x128_f8f6f4 %0, %1, %2, %0, %3, %3 op_sel_hi:[0,0,0]" : "+v"(acc[ai][bj][m][n]) : "v"(Bt##8[n]), "v"(At##8[m]), "v"(one_scale)); \
        else { _Pragma("unroll") for (int k = 0; k < 2; ++k) acc[ai][bj][m][n] = __builtin_amdgcn_mfma_f32_16x16x32_bf16(Bt[n][k], At[m][k], acc[ai][bj][m][n], 0, 0, 0); } } \
        __builtin_amdgcn_s_setprio(0); } while (0)
#define PG8_WAIT_V(n) asm volatile("s_waitcnt vmcnt(" #n ")" ::: "memory")
#define PG8_WAIT_L(n) asm volatile("s_waitcnt lgkmcnt(" #n ")" ::: "memory")
#define PG8_BAR __builtin_amdgcn_s_barrier()
#define PG8_SCHED __builtin_amdgcn_sched_barrier(0)
#define PG8_SETOFF(off, pbuf_) do { _Pragma("unroll") for (int _h = 0; _h < 2; ++_h) _Pragma("unroll") for (int _i = 0; _i < 2; ++_i) { \
        if (GATHER) { const int R_ = 8 * (wid + 8 * _i) + (lane >> 3); \
            off[_h][_i] = (unsigned)(par_i32(lds + PAR_BASE + (pbuf_) * PAR_BUF + PAR_IDX + (_h * HALF + R_) * 4) >> 2) * (unsigned)(K * 2) + (unsigned)(((lane & 7) ^ (lane >> 3)) * 16); } \
        else off[_h][_i] = voffA[_i] + (unsigned)(_h * hstep); } } while (0)
#define PG8_IDXDMA(u, pbuf_) do { if (GATHER && wid < 4) { int rk_ = (u).pm * BM + wid * 64 + lane - g.sb[(u).e]; const int cm_ = g.sb[40 + (u).e] - 1; rk_ = rk_ < cm_ ? rk_ : cm_; \
        __builtin_amdgcn_global_load_lds((const unsigned*)(g.eslot + (size_t)(u).e * ECAP + rk_), (PG8_LAS unsigned*)(lds + PAR_BASE + (pbuf_) * PAR_BUF + PAR_IDX + wid * 256), 4, 0, 0); } } while (0)
    Unit cur, nxt; int ui = 0;
    if (!S.next(0, cur)) return;
    PG8_IDXDMA(cur, 0); E.prefetch(cur, 0, lds, wid, lane);
    PG8_WAIT_V(0); PG8_BAR;
    f32x4 acc[2][2][4][2];
#pragma unroll
    for (int a = 0; a < 2; ++a)
#pragma unroll
        for (int b = 0; b < 2; ++b)
#pragma unroll
            for (int m = 0; m < 4; ++m)
#pragma unroll
                for (int n = 0; n < 2; ++n) acc[a][b][m][n] = (f32x4){0.f, 0.f, 0.f, 0.f};
    bf16x8 At[4][2], B0[2][2], B1[2][2];
    v8i At8[4], B08[2], B18[2];
    const int one_scale = 0x7f7f7f7f;
    unsigned offc[2][2], offn[2][2];
    PG8_SETOFF(offc, 0);
    const char* cA = GATHER ? (const char*)g.A : (const char*)g.A + (size_t)cur.pm * tstep;
    const char* cB = (const char*)g.Bt + (size_t)cur.e * g.bstride + (size_t)cur.pn * tstep;
    PG8_STAGE(PG8_SB(0, 0), cB, voffB); PG8_STAGE(PG8_SB(0, 1), cB + hstep, voffB); PG8_STAGE(PG8_SA(0, 0), cA, offc[0]); PG8_STAGE(PG8_SA(0, 1), cA, offc[1]);
    if (wr == 1) PG8_BAR;
    PG8_WAIT_V(2); PG8_BAR;
    PG8_STAGE(PG8_SB(1, 0), cB + kstep, voffB); PG8_STAGE(PG8_SA(1, 0), cA + kstep, offc[0]); PG8_STAGE(PG8_SB(1, 1), cB + hstep + kstep, voffB);
    PG8_WAIT_V(6); PG8_BAR;
    for (;;) {
        const bool has_next = S.next(ui + 1, nxt);
        const char* nA = GATHER ? cA : (has_next ? (const char*)g.A + (size_t)nxt.pm * tstep : cA);
        const char* nB = has_next ? (const char*)g.Bt + (size_t)nxt.e * g.bstride + (size_t)nxt.pn * tstep : cB;

        if constexpr (Epi::MIDSCALE) E.begin(cur, ui, lds, tid);
#pragma unroll 1
        for (int t = 0; t < nt; t += 2) {
            const bool last = (t == nt - 2);
            if constexpr (Epi::MIDSCALE) { if (t == nt / 2) E.mid(acc, ui, wr, fr, lds); }
            if (t == 2 && has_next) { PG8_IDXDMA(nxt, (ui + 1) & 1); E.prefetch(nxt, (ui + 1) & 1, lds, wid, lane); }
            if (GATHER && last) { if (has_next) { PG8_SETOFF(offn, (ui + 1) & 1); } else {
#pragma unroll
                for (int h = 0; h < 2; ++h)
#pragma unroll
                    for (int i = 0; i < 2; ++i) offn[h][i] = offc[h][i]; } }
            const char* a1 = cA + (size_t)(t + 1) * kstep;
            const char* a2 = last ? nA : cA + (size_t)(t + 2) * kstep; const char* b2 = last ? nB : cB + (size_t)(t + 2) * kstep;
            const char* a3 = a2 + kstep; const char* b3 = b2 + kstep;
            unsigned o2[2][2];
#pragma unroll
            for (int h = 0; h < 2; ++h)
#pragma unroll
                for (int i = 0; i < 2; ++i) o2[h][i] = (GATHER && last) ? offn[h][i] : offc[h][i];
            PG8_LDB(B0, 0, 0); PG8_LDB(B1, 0, 1); PG8_SCHED; PG8_LDA(At, 0, 0); PG8_STAGE(PG8_SA(1, 1), a1, offc[1]);
            PG8_WAIT_V(8); PG8_WAIT_L(0); PG8_BAR; PG8_MMA(0, 0, At, B0); PG8_MMA(0, 1, At, B1); PG8_BAR; PG8_SCHED;
            PG8_LDA(At, 0, 1); PG8_STAGE(PG8_SB(0, 0), b2, voffB); PG8_STAGE(PG8_SB(0, 1), b2 + hstep, voffB); PG8_STAGE(PG8_SA(0, 0), a2, o2[0]);
            PG8_WAIT_V(8); PG8_WAIT_L(0); PG8_BAR; PG8_MMA(1, 0, At, B0); PG8_MMA(1, 1, At, B1); PG8_BAR; PG8_SCHED;
            PG8_LDB(B0, 1, 0); PG8_LDB(B1, 1, 1); PG8_SCHED; PG8_LDA(At, 1, 0); PG8_STAGE(PG8_SA(0, 1), a2, o2[1]);
            PG8_WAIT_V(8); PG8_WAIT_L(0); PG8_BAR; PG8_MMA(0, 0, At, B0); PG8_MMA(0, 1, At, B1); PG8_BAR; PG8_SCHED;
            PG8_LDA(At, 1, 1); PG8_STAGE(PG8_SB(1, 0), b3, voffB); PG8_STAGE(PG8_SB(1, 1), b3 + hstep, voffB); PG8_STAGE(PG8_SA(1, 0), a3, o2[0]);
            PG8_WAIT_V(8); PG8_WAIT_L(0); PG8_BAR; PG8_MMA(1, 0, At, B0); PG8_MMA(1, 1, At, B1); PG8_BAR; PG8_SCHED;
        }
        if constexpr (ALIGN_EPI) { if (wr == 0) PG8_BAR; }
        if constexpr (FP8) asm volatile("s_nop 15\n\ts_nop 15" ::: "memory");
        E(acc, cur, ui, wr, wc, fr, fq, lds);
        if (!has_next) break;
#pragma unroll
        for (int a = 0; a < 2; ++a)
#pragma unroll
            for (int b = 0; b < 2; ++b)
#pragma unroll
                for (int m = 0; m < 4; ++m)
#pragma unroll
                    for (int n = 0; n < 2; ++n) acc[a][b][m][n] = (f32x4){0.f, 0.f, 0.f, 0.f};
        cur = nxt; cA = nA; cB = nB; ++ui;
#pragma unroll
        for (int h = 0; h < 2; ++h)
#pragma unroll
            for (int i = 0; i < 2; ++i) offc[h][i] = offn[h][i];
        if constexpr (ALIGN_EPI) { if (wr == 1) PG8_BAR; }
    }
    PG8_WAIT_V(0);
    if constexpr (!ALIGN_EPI) { if (wr == 0) PG8_BAR; }
    PG8_BAR;
#undef PG8_SA
#undef PG8_SB
#undef PG8_STAGE
#undef PG8_LDA
#undef PG8_LDB
#undef PG8_MMA
#undef PG8_WAIT_V
#undef PG8_WAIT_L
#undef PG8_BAR
#undef PG8_SCHED
#undef PG8_SETOFF
#undef PG8_IDXDMA
#undef PG8_CAT
}

struct EpiQKV {
    static constexpr bool MIDSCALE = false, PERM = false;
    bf16_t* O;
    __device__ __forceinline__ void prefetch(const Unit&, int, PG8_LAS unsigned char*, int, int) const {}
    __device__ __forceinline__ void operator()(const f32x4 (&acc)[2][2][4][2], const Unit& u, int ui, int wr, int wc, int fr, int fq, PG8_LAS unsigned char* lds) const {
        const bool latent = u.pm < NTOK / BM;
#pragma unroll
        for (int ai = 0; ai < 2; ++ai)
#pragma unroll
            for (int m = 0; m < 4; ++m) {
                const int row = u.pm * BM + ai * HALF + wr * 64 + m * 16 + fr;
                bf16_t* rowp = O + (size_t)row * INW + u.pn * BM + wc * 32 + 4 * fq;
                const int pos = row & (L - 1), pp = (wc & 1) ? (pos & 63) : (pos >> 6);
                PG8_LAS unsigned char* tp = lds + PAR_TAB + (pp * 16 + 4 * fq) * 8;
#pragma unroll
                for (int bj = 0; bj < 2; ++bj) {
                    const int colbase = u.pn * BM + bj * HALF;
                    f32x4 v0 = acc[ai][bj][m][0], v1 = acc[ai][bj][m][1];
                    if (latent && colbase < C_VA) {
                        const f32x4 t0 = par_f32x4(tp), t1 = par_f32x4(tp + 16);
                        const f32x4 cs = {t0.x, t0.z, t1.x, t1.z}, sn = {t0.y, t0.w, t1.y, t1.w};
                        const f32x4 a0 = v0 * cs - v1 * sn, a1 = v1 * cs + v0 * sn; v0 = a0; v1 = a1;
                    }
                    if (colbase < C_KA || (colbase >= C_QB && colbase < C_KB)) { v0 = v0 * QSCALE; v1 = v1 * QSCALE; }
                    u32x2 w0, w1; w0.x = pk2(v0.x, v0.y); w0.y = pk2(v0.z, v0.w); w1.x = pk2(v1.x, v1.y); w1.y = pk2(v1.z, v1.w);
                    *(u32x2*)(rowp + bj * HALF) = w0; *(u32x2*)(rowp + bj * HALF + 16) = w1;
                }
            }
    }
};
struct EpiOutProj {
    static constexpr bool PERM = true, MIDSCALE = true;
    bf16_t* O; const float* oss;
    __device__ __forceinline__ void prefetch(const Unit&, int, PG8_LAS unsigned char*, int, int) const {}
    __device__ __forceinline__ void begin(const Unit& u, int ui, PG8_LAS unsigned char* lds, int tid) const {
        if (tid < 256) { const f32x4* sp = (const f32x4*)(oss + (size_t)(u.pm * BM + tid) * 16); const f32x4 a0 = sp[0], a1 = sp[1], b0 = sp[2], b1 = sp[3];
            const float sa = ((a0.x + a0.y) + (a0.z + a0.w)) + ((a1.x + a1.y) + (a1.z + a1.w)), sb = ((b0.x + b0.y) + (b0.z + b0.w)) + ((b1.x + b1.y) + (b1.z + b1.w));
            const float ra = rsqrtf(sa * (1.f / 512.f) + EPS), rb = rsqrtf(sb * (1.f / 512.f) + EPS);
            typedef float f2 __attribute__((ext_vector_type(2)));
            *(PG8_LAS f2*)(lds + 131072 + (ui & 1) * 2048 + tid * 8) = (f2){ra / rb, rb}; }
    }
    __device__ __forceinline__ void mid(f32x4 (&acc)[2][2][4][2], int ui, int wr, int fr, PG8_LAS unsigned char* lds) const {
#pragma unroll
        for (int ai = 0; ai < 2; ++ai)
#pragma unroll
            for (int m = 0; m < 4; ++m) { const float r = *(const PG8_LAS float*)(lds + 131072 + (ui & 1) * 2048 + (ai * HALF + wr * 64 + m * 16 + fr) * 8);
#pragma unroll
                for (int bj = 0; bj < 2; ++bj)
#pragma unroll
                    for (int n = 0; n < 2; ++n) acc[ai][bj][m][n] = acc[ai][bj][m][n] * r; }
    }
    __device__ __forceinline__ void operator()(const f32x4 (&acc)[2][2][4][2], const Unit& u, int ui, int wr, int wc, int fr, int fq, PG8_LAS unsigned char* lds) const {
#pragma unroll
        for (int ai = 0; ai < 2; ++ai)
#pragma unroll
            for (int m = 0; m < 4; ++m) {
                const int rl = ai * HALF + wr * 64 + m * 16 + fr;
                const float rb = *(const PG8_LAS float*)(lds + 131072 + (ui & 1) * 2048 + rl * 8 + 4);
                bf16_t* rowp = O + (size_t)(u.pm * BM + rl) * D + u.pn * BM + wc * 32 + 8 * fq;
#pragma unroll
                for (int bj = 0; bj < 2; ++bj) { const f32x4 v0 = acc[ai][bj][m][0] * rb, v1 = acc[ai][bj][m][1] * rb;
                    u32x4 o; o.x = pk2(v0.x, v0.y); o.y = pk2(v0.z, v0.w); o.z = pk2(v1.x, v1.y); o.w = pk2(v1.z, v1.w);
                    *(u32x4*)(rowp + bj * HALF) = o; }
            }
    }
};
struct EpiSwiglu {
    static constexpr bool MIDSCALE = false, PERM = false;
    unsigned char* act; const float* b1;
    __device__ __forceinline__ void prefetch(const Unit& u, int pb, PG8_LAS unsigned char* lds, int wid, int lane) const {
        if (wid == 4) __builtin_amdgcn_global_load_lds((const unsigned*)(b1 + (size_t)u.e * 2048 + u.pn * BM + lane * 4), (PG8_LAS unsigned*)(lds + PAR_BASE + pb * PAR_BUF + PAR_BIAS), 16, 0, 0);
    }
    __device__ __forceinline__ void operator()(const f32x4 (&acc)[2][2][4][2], const Unit& u, int ui, int wr, int wc, int fr, int fq, PG8_LAS unsigned char* lds) const {
#pragma unroll
        for (int bj = 0; bj < 2; ++bj) {
            const int f0 = 16 * (8 * u.pn + 4 * bj + wc) + 4 * fq;
            PG8_LAS unsigned char* bp = lds + PAR_BASE + (ui & 1) * PAR_BUF + PAR_BIAS + (128 * bj + 32 * wc + 8 * fq) * 4; const f32x4 bA = par_f32x4(bp), bB = par_f32x4(bp + 16);
            const f32x4 bg = {bA.x, bA.z, bB.x, bB.z}, bl = {bA.y, bA.w, bB.y, bB.w};
#pragma unroll
            for (int ai = 0; ai < 2; ++ai)
#pragma unroll
                for (int m = 0; m < 4; ++m) {
                    const int row = u.pm * BM + ai * HALF + wr * 64 + m * 16 + fr;
                    const f32x4 gt = acc[ai][bj][m][0] * W8_INV + bg, ln = acc[ai][bj][m][1] * W8_INV + bl; float a[4];
#pragma unroll
                    for (int j = 0; j < 4; ++j) { const float gg = fminf(gt[j], 7.f), ll = fminf(fmaxf(ln[j], -7.f), 7.f);
                        a[j] = gg * __builtin_amdgcn_rcpf(1.f + __expf(-1.702f * gg)) * (ll + 1.f); }
                    *(unsigned*)(act + (size_t)row * D + f0) = pk4_fp8(a[0], a[1], a[2], a[3]);
                }
        }
    }
};
struct EpiScatter {
    static constexpr bool MIDSCALE = false, PERM = true;
    unsigned char* y; const float* b2; const int* eslot; const float* ew; const PG8_LAS int* sb;
    __device__ __forceinline__ void prefetch(const Unit& u, int pb, PG8_LAS unsigned char* lds, int wid, int lane) const {
        const int w4 = wid & 3; int rk = u.pm * BM + w4 * 64 + lane - sb[u.e]; const int cm = sb[40 + u.e] - 1; rk = rk < cm ? rk : cm;
        const size_t gi = (size_t)u.e * ECAP + rk;
        if (wid < 4) __builtin_amdgcn_global_load_lds((const unsigned*)(eslot + gi), (PG8_LAS unsigned*)(lds + PAR_BASE + pb * PAR_BUF + PAR_IDX + w4 * 256), 4, 0, 0);
        else         __builtin_amdgcn_global_load_lds((const unsigned*)(ew + gi), (PG8_LAS unsigned*)(lds + PAR_BASE + pb * PAR_BUF + PAR_W + w4 * 256), 4, 0, 0);
        if (wid == 0) __builtin_amdgcn_global_load_lds((const unsigned*)(b2 + (size_t)u.e * D + u.pn * BM + lane * 4), (PG8_LAS unsigned*)(lds + PAR_BASE + pb * PAR_BUF + PAR_BIAS), 16, 0, 0);
    }
    __device__ __forceinline__ void operator()(const f32x4 (&acc)[2][2][4][2], const Unit& u, int ui, int wr, int wc, int fr, int fq, PG8_LAS unsigned char* lds) const {
        PG8_LAS unsigned char* par = lds + PAR_BASE + (ui & 1) * PAR_BUF;
        const int col0 = u.pn * BM + wc * 32 + 8 * fq;
        f32x4 bv[2][2];
#pragma unroll
        for (int bj = 0; bj < 2; ++bj)
#pragma unroll
            for (int n = 0; n < 2; ++n) bv[bj][n] = par_f32x4(par + PAR_BIAS + (wc * 32 + 8 * fq + bj * HALF + 4 * n) * 4);
        const int rbase = u.pm * BM - sb[u.e], cn = sb[40 + u.e];
#pragma unroll
        for (int ai = 0; ai < 2; ++ai)
#pragma unroll
            for (int m = 0; m < 4; ++m) {
                const int rl = ai * HALF + wr * 64 + m * 16 + fr;
                const int slot = par_i32(par + PAR_IDX + rl * 4); const float w = par_f32(par + PAR_W + rl * 4) * Y8_SCALE;
                if (rbase + rl < cn) {
                    unsigned char* rowp = y + (size_t)slot * D + col0;
#pragma unroll
                    for (int bj = 0; bj < 2; ++bj) { const f32x4 v0 = (acc[ai][bj][m][0] * W8_INV + bv[bj][0]) * w, v1 = (acc[ai][bj][m][1] * W8_INV + bv[bj][1]) * w;
                        u32x2 o; o.x = pk4_fp8(v0.x, v0.y, v0.z, v0.w); o.y = pk4_fp8(v1.x, v1.y, v1.z, v1.w);
                        *(u32x2*)(rowp + bj * HALF) = o; }
                }
            }
    }
};
}

__device__ void p0_mod(const Params& p, float* sS  , float* sP  , int wv) {
    float* mod = (float*)(p.ws + WS_MOD);
    const int tid = tid_opaque(wv), lane = tid & 63, wave = wv;
    if (blockIdx.x >= 96) return;
    for (int i = tid; i < 9 * D; i += NTHREADS) { const int r = i >> 10, k = i & 1023; const float cc = r < 8 ? p.c[r * D + k] : p.c_ctx[k]; sS[i] = cc / (1.f + __expf(-cc)); }
    __syncthreads();
    const int j = blockIdx.x * 64 + lane;
    float acc[9];
#pragma unroll
    for (int r = 0; r < 9; ++r) acc[r] = 0.f;
    const float* wp = p.w_ada + (size_t)(wave * 128) * 6144 + j;
#pragma unroll 1
    for (int k0 = 0; k0 < 128; k0 += 16) {
        float w[16];
#pragma unroll
        for (int kk = 0; kk < 16; ++kk) w[kk] = wp[(size_t)(k0 + kk) * 6144];
#pragma unroll
        for (int kk = 0; kk < 16; ++kk)
#pragma unroll
            for (int r = 0; r < 9; ++r) acc[r] = fmaf(sS[r * D + wave * 128 + k0 + kk], w[kk], acc[r]);
    }
#pragma unroll
    for (int r = 0; r < 9; ++r) sP[(wave * 9 + r) * 64 + lane] = acc[r];
    __syncthreads();
    for (int i = tid; i < 9 * 64; i += NTHREADS) { const int r = i >> 6, jj = i & 63; float s = p.b_ada[blockIdx.x * 64 + jj];
#pragma unroll
        for (int w = 0; w < 8; ++w) s += sP[(w * 9 + r) * 64 + jj];
        mod[r * 6144 + blockIdx.x * 64 + jj] = s; }
    __syncthreads();
}
__device__ void p0_tab(const Params& p, int wv) {
    float* tab = (float*)(p.ws + WS_TAB);
    const int gtid = blockIdx.x * NTHREADS + tid_opaque(wv), gsize = gridDim.x * NTHREADS;
    for (int idx = gtid; idx < 64 * 16; idx += gsize) {
        const int pos = idx >> 4, i = idx & 15;
        const float freq = exp2f(-(float)i * (13.287712379549449f / 16.f));
        const float ang = (float)pos * freq;
        const float n = rintf(ang * 0.15915494309189535f);
        float r = fmaf(-n, 6.28125f, ang); r = fmaf(-n, 1.9353071795864769e-3f, r);
        tab[idx * 2] = __cosf(r); tab[idx * 2 + 1] = __sinf(r);
    }
}
template <int MODE>
__device__ __forceinline__ void conv_item(const float* src, int K, int N, bf16_t* dst, int item, float* scr, int lane, const float* gA, const float* gB) {
    const int nblk = N / 32, kb = item / nblk, nb = item % nblk, k0 = 64 * kb, n0 = 32 * nb;
    const int c = lane & 31, kh = lane >> 5;
    const int nl = MODE == 1 ? 16 * (c & 1) + (c >> 1) : c;
    float v[32];
    const float* sp = src + (size_t)(k0 + kh) * N + n0 + c;
#pragma unroll
    for (int i = 0; i < 32; ++i) v[i] = sp[(size_t)(2 * i) * N];
#pragma unroll
    for (int i = 0; i < 32; ++i) { float x = v[i]; if (MODE == 2) { const int k = k0 + 2 * i + kh; x *= (k < 512 ? gA[k] : gB[k - 512]); } scr[(2 * i + kh) * 33 + nl] = x; }
    asm volatile("s_waitcnt lgkmcnt(0)" ::: "memory");
    const int ch = lane & 7;
#pragma unroll
    for (int j = 0; j < 4; ++j) { const int n = (lane >> 3) + 8 * j; const float* s = scr + (8 * ch) * 33 + n;
        u32x4 o; o.x = pk2(s[0 * 33], s[1 * 33]); o.y = pk2(s[2 * 33], s[3 * 33]); o.z = pk2(s[4 * 33], s[5 * 33]); o.w = pk2(s[6 * 33], s[7 * 33]);
        *(u32x4*)(dst + (size_t)(n0 + n) * K + k0 + 8 * ch) = o; }
    asm volatile("s_waitcnt lgkmcnt(0)" ::: "memory");
}
template <bool PERM1>
__device__ __forceinline__ void conv_item8(const float* src, int K, int N, unsigned char* dst, int item, float* scr, int lane) {
    const int nblk = N / 32, kb = item / nblk, nb = item % nblk, k0 = 64 * kb, n0 = 32 * nb;
    const int c = lane & 31, kh = lane >> 5;
    const int nl = PERM1 ? 16 * (c & 1) + (c >> 1) : c;
    float v[32];
    const float* sp = src + (size_t)(k0 + kh) * N + n0 + c;
#pragma unroll
    for (int i = 0; i < 32; ++i) v[i] = sp[(size_t)(2 * i) * N];
#pragma unroll
    for (int i = 0; i < 32; ++i) scr[(2 * i + kh) * 33 + nl] = v[i] * W8_SCALE;
    asm volatile("s_waitcnt lgkmcnt(0)" ::: "memory");
    const int ch = lane & 3;
#pragma unroll
    for (int j = 0; j < 2; ++j) { const int n = (lane >> 2) + 16 * j; const float* s = scr + (16 * ch) * 33 + n;
        u32x4 o; o.x = pk4_fp8(s[0 * 33], s[1 * 33], s[2 * 33], s[3 * 33]); o.y = pk4_fp8(s[4 * 33], s[5 * 33], s[6 * 33], s[7 * 33]);
        o.z = pk4_fp8(s[8 * 33], s[9 * 33], s[10 * 33], s[11 * 33]); o.w = pk4_fp8(s[12 * 33], s[13 * 33], s[14 * 33], s[15 * 33]);
        *(u32x4*)(dst + (size_t)(n0 + n) * K + k0 + 16 * ch) = o; }
    asm volatile("s_waitcnt lgkmcnt(0)" ::: "memory");
}
__device__ void p0_weights(const Params& p, unsigned char* ldsb, int wv) {
    const int tid = tid_opaque(wv), lane = tid & 63, wave = wv; float* scr = (float*)(ldsb + 57344 + wave * 8448);
    const int gw = blockIdx.x * (NTHREADS / 64) + wave, ngw = gridDim.x * (NTHREADS / 64);
    constexpr int I_IN = 16 * 72, I_OUT = 16 * 32;
    constexpr int NITEMS = I_IN + I_OUT;
    for (int it = gw; it < NITEMS; it += ngw) {
        int r = it;
        if (r < I_IN) { conv_item<0>(p.w_in, D, INW, (bf16_t*)(p.ws + WS_WIN), r, scr, lane, nullptr, nullptr); continue; } r -= I_IN;
        conv_item<2>(p.w_out, D, D, (bf16_t*)(p.ws + WS_WOUT), r, scr, lane, p.g_grp_a, p.g_grp_b);
    }
}

__device__ void p1_h(const Params& p, int wv) {
    const int tid = tid_opaque(wv), lane = tid & 63;
    const float* mod = (const float*)(p.ws + WS_MOD);
    bf16_t* hb = (bf16_t*)(p.ws + WS_HB);
    constexpr int R = 17;
    const int gwv = blockIdx.x * (NTHREADS / 64) + (tid >> 6);
    const int m0 = gwv * R; if (m0 >= MROWS) return;
    const int m1 = m0 + R < MROWS ? m0 + R : MROWS;
    f32x4 pB[4], pC[4], v[4], nv[4]; int curb = -1;
#define P1_ROWPTR(m) ((m) < NTOK ? p.x + (size_t)(m) * D : p.ctx + (size_t)((m) - NTOK) * D)
    { const float* xr = P1_ROWPTR(m0);
#pragma unroll
      for (int j = 0; j < 4; ++j) nv[j] = ((const f32x4*)xr)[lane + 64 * j]; }
    for (int m = m0; m < m1; ++m) {
#pragma unroll
        for (int j = 0; j < 4; ++j) v[j] = nv[j];
        if (m + 1 < m1) { const float* xr = P1_ROWPTR(m + 1);
#pragma unroll
            for (int j = 0; j < 4; ++j) nv[j] = ((const f32x4*)xr)[lane + 64 * j]; }
        const int b = m < NTOK ? m / L : 8;
        if (b != curb) { curb = b; const float* sh = mod + b * 6144, * sc = sh + 1024;
#pragma unroll
            for (int j = 0; j < 4; ++j) { const int c0 = 4 * (lane + 64 * j); pB[j] = *(const f32x4*)(p.g_pre_mix + c0) * (*(const f32x4*)(sc + c0) + 1.f); pC[j] = *(const f32x4*)(sh + c0); } }
        float s = 0.f;
#pragma unroll
        for (int j = 0; j < 4; ++j) s += v[j].x * v[j].x + v[j].y * v[j].y + v[j].z * v[j].z + v[j].w * v[j].w;
        const float rstd = rsqrtf(wave_sum(s) * (1.f / D) + EPS);
#pragma unroll
        for (int j = 0; j < 4; ++j) { const int c0 = 4 * (lane + 64 * j);
            const f32x4 o = (v[j] * rstd) * pB[j] + pC[j];
            u32x2 w; w.x = pk2(o.x, o.y); w.y = pk2(o.z, o.w);
            *(u32x2*)(hb + (size_t)m * D + c0) = w; }
    }
#undef P1_ROWPTR
}

namespace att {
#define ATT_LAS __attribute__((address_space(3)))
typedef float f32x16 __attribute__((ext_vector_type(16)));
typedef short bf16x8 __attribute__((ext_vector_type(8)));
typedef short s16x4 __attribute__((ext_vector_type(4)));
constexpr int SLOTB = 8192, NSLOT = 4;
constexpr int LDS_K = 0, LDS_V = NSLOT * SLOTB, LDS_WS = 2 * NSLOT * SLOTB, LDS_BT = LDS_WS + 8 * 256;
constexpr int BT_MARGIN = 128, BT_FLOATS = BT_MARGIN + 15 * 32 + 128;
constexpr float NEGBIG = -1e30f;
__device__ __forceinline__ int crow(int r, int hi) { return (r & 3) + 8 * (r >> 2) + 4 * hi; }
__device__ __forceinline__ unsigned cvtpk(float lo, float hi) { typedef float f2 __attribute__((ext_vector_type(2))); typedef __bf16 b2 __attribute__((ext_vector_type(2)));
    f2 v = {lo, hi}; b2 b = __builtin_convertvector(v, b2); return __builtin_bit_cast(unsigned, b); }
__device__ __forceinline__ s16x4 vtr(const ATT_LAS unsigned char* p) { typedef short v4i16 __attribute__((ext_vector_type(4)));
    return __builtin_bit_cast(s16x4, __builtin_amdgcn_ds_read_tr16_b64_v4i16((ATT_LAS v4i16*)p)); }
#define ATT_WAIT_BAR(N) asm volatile("s_waitcnt vmcnt(" #N ") lgkmcnt(0)\n\ts_barrier" ::: "memory")

constexpr int LDS_CV = 71680, CV_WAVE = 8448;
static_assert(LDS_BT + BT_FLOATS * 4 <= LDS_CV && LDS_CV + 8 * CV_WAVE <= 147456, "attention LDS map");
constexpr int CV_W1 = 16 * 64, CV_W2 = 16 * 32, CV_ITEMS = NE * (CV_W1 + CV_W2);
struct ConvJob { int it, end; };
__device__ __forceinline__ void cv_load(const Params& p, int it, int lane, float (&v)[32], unsigned char*& dlane, int& nl) {
    const float* src; unsigned char* dst; int N, q; bool perm;
    if (it < NE * CV_W1) { const int e = it / CV_W1; q = it % CV_W1; src = p.w_mlp1 + (size_t)e * D * 2048; dst = p.ws + WS_W1 + (size_t)e * 2048 * D; N = 2048; perm = true; }
    else { const int r = it - NE * CV_W1, e = r / CV_W2; q = r % CV_W2; src = p.w_mlp2 + (size_t)e * D * D; dst = p.ws + WS_W2 + (size_t)e * D * D; N = D; perm = false; }
    const int nblk = N / 32, k0 = 64 * (q / nblk), n0 = 32 * (q % nblk);
    const float* sp = src + (size_t)(k0 + (lane >> 5)) * N + n0 + (lane & 31);
#pragma unroll
    for (int i = 0; i < 32; ++i) v[i] = sp[(size_t)(2 * i) * N];
    const int cc = lane & 31; nl = perm ? 16 * (cc & 1) + (cc >> 1) : cc;
    dlane = dst + (size_t)(n0 + (lane >> 2)) * D + k0 + 16 * (lane & 3);
}
__device__ __forceinline__ void cv_store(int lane, float (&v)[32], unsigned char* dlane, int nl, ATT_LAS float* scr) {
    const int kh = lane >> 5;
#pragma unroll
    for (int i = 0; i < 32; ++i) asm volatile("" : "+v"(v[i]));
#pragma unroll
    for (int i = 0; i < 32; ++i) scr[(2 * i + kh) * 33 + nl] = v[i] * W8_SCALE;
    asm volatile("s_waitcnt lgkmcnt(0)" ::: "memory");
    const int ch = lane & 3;
#pragma unroll
    for (int j = 0; j < 2; ++j) { const int n = (lane >> 2) + 16 * j; const ATT_LAS float* s = scr + (16 * ch) * 33 + n;
        u32x4 o; o.x = pk4_fp8(s[0 * 33], s[1 * 33], s[2 * 33], s[3 * 33]); o.y = pk4_fp8(s[4 * 33], s[5 * 33], s[6 * 33], s[7 * 33]);
        o.z = pk4_fp8(s[8 * 33], s[9 * 33], s[10 * 33], s[11 * 33]); o.w = pk4_fp8(s[12 * 33], s[13 * 33], s[14 * 33], s[15 * 33]);
        *(u32x4*)(dlane + (size_t)j * 16 * D) = o; }
    asm volatile("s_waitcnt lgkmcnt(0)" ::: "memory");
}

__device__ __forceinline__ void dma_tile(ATT_LAS unsigned char* lds, int slot, const bf16_t* kbase, const bf16_t* vbase, int wid, int lane) {
    const bf16_t* ksrc = kbase + (size_t)lane * INW + wid * 8;
    const bf16_t* vsrc = vbase + (size_t)(16 * (wid & 3) + (lane >> 2)) * INW + (wid >> 2) * 32 + (lane & 3) * 8;
    __builtin_amdgcn_global_load_lds((const unsigned*)ksrc, (ATT_LAS unsigned*)(lds + LDS_K + slot * SLOTB + wid * 1024), 16, 0, 0);
    __builtin_amdgcn_global_load_lds((const unsigned*)vsrc, (ATT_LAS unsigned*)(lds + LDS_V + slot * SLOTB + wid * 1024), 16, 0, 0);
}

template <bool ISB>
__device__ __forceinline__ void attn_unit(const Params& p, ATT_LAS unsigned char* lds, int unit, int wv, ConvJob& cj) {
    const int tid = tid_opaque(wv), lane = tid & 63, r32 = lane & 31, hi = lane >> 5; const int wid = wv;
    const bf16_t* qkv = (const bf16_t*)(p.ws + WS_QKV); bf16_t* ob = (bf16_t*)(p.ws + WS_O);
    ATT_LAS float* wsf = (ATT_LAS float*)(lds + LDS_WS) + wid * 64;
    ATT_LAS float* bt = (ATT_LAS float*)(lds + LDS_BT);
    ATT_LAS float* cvscr = (ATT_LAS float*)(lds + LDS_CV + wid * CV_WAVE);
    int b, h, kcol, vcol, qcol, ocol, q0, nloc, row_lo = 0, qr = 0, half = 0, qb = 0, jlo = 0;
    if (!ISB) { b = unit >> 7; const int kvh = (unit >> 6) & 1; qb = unit & 63; h = kvh * 4 + (wid >> 1); half = wid & 1; q0 = qb * 64 + 32 * half;
        kcol = C_KA + kvh * 64; vcol = C_VA + kvh * 64; qcol = C_QA + h * 64; ocol = h * 64;
        jlo = 2 - qb > 0 ? 2 - qb : 0; const int jhi = 65 - qb < 4 ? 65 - qb : 4; nloc = jhi - jlo + 1;
    } else { b = unit >> 7; h = (unit >> 4) & 7; const int g = unit & 15;
        qr = 4 * g + 2 * (wid >> 2) + (r32 >> 4); half = wid & 3; q0 = 0;
        kcol = C_KB + h * 64; vcol = C_VB + h * 64; qcol = C_QB + h * 64; ocol = 512 + h * 64;
        const int r0 = 4 * g, r3 = 4 * g + 3; row_lo = r0 - 4 < 0 ? 0 : (r0 - 4 > 56 ? 56 : r0 - 4); const int rs3 = r3 - 4 < 0 ? 0 : (r3 - 4 > 56 ? 56 : r3 - 4); nloc = rs3 + 7 - row_lo + 1;
    }
    const int NT = nloc + 4;
    const bf16_t* lat = qkv + (size_t)b * L * INW; const bf16_t* cx = qkv + (size_t)(NTOK + b * CTX) * INW;
#define ATT_TILE_ROW(t) ((t) < nloc ? lat + (size_t)(ISB ? (row_lo + (t)) * 64 : (qb - 2 + jlo + (t)) * 64) * INW : cx + (size_t)((t) - nloc) * 64 * INW)
    const int rsq = qr - 4 < 0 ? 0 : (qr - 4 > 56 ? 56 : qr - 4);
    const int qrw = 4 * (unit & 15) + 2 * (wid >> 2);
    const int lo_w = qrw - 4 < 0 ? 0 : (qrw - 4 > 56 ? 56 : qrw - 4), hi_w = (qrw - 3 < 0 ? 0 : (qrw - 3 > 56 ? 56 : qrw - 3)) + 7;
    const int bs = ISB ? (half == 0 ? 0 : half == 1 ? 8 : half == 2 ? 24 : 32) : 0;
#define ATT_ACTIVE(t) (!(ISB && (t) < nloc) || ((row_lo + (t) >= lo_w) && (row_lo + (t) <= hi_w)))
    if (ISB) {
        for (int i = tid; i < BT_FLOATS; i += NTHREADS) { const int j = i - BT_MARGIN; float v = 0.f;
            if (j >= 0 && j < 15 * 32 && (j & 31) < 31) v = p.rpb_b[(h * 15 + (j >> 5)) * 31 + (j & 31)] * LOG2E;
            bt[i] = v; }
    }
#pragma unroll
    for (int t0 = 0; t0 < NSLOT - 1; ++t0) { const bf16_t* r0p = ATT_TILE_ROW(t0); dma_tile(lds, t0, r0p + kcol, r0p + vcol, wid, lane); }
    bf16x8 qf[4];
    const int qc = ISB ? 16 * half + (r32 & 15) : 32 * half + r32;
    { const bf16_t* qp = lat + (size_t)(ISB ? qr * 64 + qc : q0 + r32) * INW + qcol + hi * 8;
#pragma unroll
      for (int d0 = 0; d0 < 4; ++d0) qf[d0] = *(const bf16x8*)(qp + d0 * 16); }
    float mref = 0.f, l_run = 0.f;
    if (!ISB) l_run = hi == 0 ? __builtin_amdgcn_exp2f(p.sink_a[h] * LOG2E) : 0.f;
    f32x16 o0, o1, negm;
#pragma unroll
    for (int r = 0; r < 16; ++r) { o0[r] = 0.f; o1[r] = 0.f; negm[r] = 0.f; }
    const int cs = qc - 8 < 0 ? 0 : (qc - 8 > 48 ? 48 : qc - 8);
    f32x16 pc0, pc1, pn0, pn1; float ref_cur = 0.f, ref_next = 0.f; bool act_cur = false, act_next = false;
#pragma unroll
    for (int r = 0; r < 16; ++r) { pn0[r] = 0.f; pn1[r] = 0.f; }
#define ATT_QK(SLOT, LOCB) do { const ATT_LAS unsigned char* kb_ = lds + LDS_K + (SLOT) * SLOTB + hi * 1024 + r32 * 16; \
        if (LOCB) { _Pragma("unroll") for (int d0 = 0; d0 < 4; ++d0) { \
            const bf16x8 k0_ = *(const ATT_LAS bf16x8*)(kb_ + bs * 16 + d0 * 2048); \
            pn0 = __builtin_amdgcn_mfma_f32_32x32x16_bf16(k0_, qf[d0], d0 == 0 ? negm : pn0, 0, 0, 0); } } \
        else { _Pragma("unroll") for (int d0 = 0; d0 < 4; ++d0) { \
            const bf16x8 k0_ = *(const ATT_LAS bf16x8*)(kb_ + d0 * 2048), k1_ = *(const ATT_LAS bf16x8*)(kb_ + d0 * 2048 + 512); \
            pn0 = __builtin_amdgcn_mfma_f32_32x32x16_bf16(k0_, qf[d0], d0 == 0 ? negm : pn0, 0, 0, 0); \
            pn1 = __builtin_amdgcn_mfma_f32_32x32x16_bf16(k1_, qf[d0], d0 == 0 ? negm : pn1, 0, 0, 0); } } } while (0)
    ATT_WAIT_BAR(4);
    act_next = ATT_ACTIVE(0);
    if (act_next) { ATT_QK(0, ISB); ref_next = mref; }
    int sc = 0, sn = 1, si = NSLOT - 1;
    for (int t = 0; t < NT; ++t) {
        const int ahead = NT - 2 - t < 0 ? 0 : (NT - 2 - t < NSLOT - 3 ? NT - 2 - t : NSLOT - 3);
        if (ahead == 1) ATT_WAIT_BAR(2); else ATT_WAIT_BAR(0);
        float cvv[32]; unsigned char* cvd = nullptr; int cvn = 0; const bool cvgo = cj.it < cj.end;
        if (cvgo) { cv_load(p, cj.it, lane, cvv, cvd, cvn); cj.it += NTHREADS / 64; }
        if (t + NSLOT - 1 < NT) { const bf16_t* rp = ATT_TILE_ROW(t + NSLOT - 1); dma_tile(lds, si, rp + kcol, rp + vcol, wid, lane); }
        pc0 = pn0; pc1 = pn1; ref_cur = ref_next; act_cur = act_next;
        act_next = (t + 1 < NT) && ATT_ACTIVE(t + 1);
        if (act_next) { if (ISB && t + 1 < nloc) ATT_QK(sn, true); else ATT_QK(sn, false); ref_next = mref; }
        if (act_cur) {
            if (ISB) {
                if (t < nloc) {
                    const int kr = row_lo + t;
                    const ATT_LAS float* bp = bt + BT_MARGIN + (kr - qr + 7) * 32 + 15 - qc + bs + 4 * hi;
                    const int e0 = ((kr >= rsq) && (kr <= rsq + 7)) ? bs + 4 * hi - cs : 0x4000;
#pragma unroll
                    for (int r = 0; r < 16; ++r) { const int c = (r & 3) + 8 * (r >> 2);
                        const float b0 = bp[c];
                        pc0[r] = ((unsigned)(c + e0) < 16u) ? pc0[r] + b0 : NEGBIG; }
                }
            } else {
                if (t < nloc) { const int j = jlo + t; const int qq = 32 * half + r32;
                    if (j == 0) {
#pragma unroll
                        for (int r = 0; r < 16; ++r) { const int c = crow(r, hi); if (c < qq) pc0[r] = NEGBIG; if (c + 32 < qq) pc1[r] = NEGBIG; }
                    } else if (j == 4) {
#pragma unroll
                        for (int r = 0; r < 16; ++r) { const int c = crow(r, hi); if (c > qq) pc0[r] = NEGBIG; if (c + 32 > qq) pc1[r] = NEGBIG; }
                    }
                }
            }
            const bool locb = ISB && (t < nloc);
            float rm;
            if (locb) { rm = fmaxf(pc0[0], pc0[1]);
#pragma unroll
                for (int r = 2; r < 16; r += 2) rm = fmaxf(fmaxf(rm, pc0[r]), pc0[r + 1]); }
            else { rm = fmaxf(pc0[0], pc1[0]);
#pragma unroll
                for (int r = 1; r < 16; ++r) rm = fmaxf(fmaxf(rm, pc0[r]), pc1[r]); }
            rm = fmaxf(rm, __shfl_xor(rm, 32));
            const float delta = mref - ref_cur;
            constexpr float RESC_THR = 8.f;
            const float dl = __any(rm - delta > RESC_THR) ? fmaxf(rm - delta, 0.f) : 0.f;
            const float sh = delta + dl;
            if (__any(dl > 0.f)) {
                const float f = __builtin_amdgcn_exp2f(-dl);
                l_run *= f; mref += dl;
                if (hi == 0) wsf[r32] = f;
                asm volatile("s_waitcnt lgkmcnt(0)" ::: "memory");
#pragma unroll
                for (int r = 0; r < 16; ++r) { const float fr_ = wsf[crow(r, hi)]; o0[r] *= fr_; o1[r] *= fr_; negm[r] = -mref; }
            }
            if (__any(sh != 0.f)) {
#pragma unroll
                for (int r = 0; r < 16; ++r) { pc0[r] -= sh; pc1[r] -= sh; }
            }
            float ls = 0.f, ls2 = 0.f;
#pragma unroll
            for (int r = 0; r < 16; r += 2) { pc0[r] = __builtin_amdgcn_exp2f(pc0[r]); pc0[r + 1] = __builtin_amdgcn_exp2f(pc0[r + 1]); ls += pc0[r]; ls2 += pc0[r + 1]; }
            if (!locb) {
#pragma unroll
                for (int r = 0; r < 16; r += 2) { pc1[r] = __builtin_amdgcn_exp2f(pc1[r]); pc1[r + 1] = __builtin_amdgcn_exp2f(pc1[r + 1]); ls += pc1[r]; ls2 += pc1[r + 1]; }
            }
            l_run += ls + ls2;
            typedef unsigned u4 __attribute__((ext_vector_type(4)));
            const u4 pw0 = {cvtpk(pc0[0], pc0[1]), cvtpk(pc0[2], pc0[3]), cvtpk(pc0[4], pc0[5]), cvtpk(pc0[6], pc0[7])};
            const u4 pw1 = {cvtpk(pc0[8], pc0[9]), cvtpk(pc0[10], pc0[11]), cvtpk(pc0[12], pc0[13]), cvtpk(pc0[14], pc0[15])};
            const ATT_LAS unsigned char* vp = lds + LDS_V + sc * SLOTB + ((lane >> 4) & 1) * 32 + (lane & 3) * 8 + (4 * hi + ((lane & 15) >> 2)) * 64 + (locb ? bs * 64 : 0);
#define ATT_PV(OACC, PW, D0, KS) do { const s16x4 lo_ = vtr(vp + (D0) * 4096 + (KS) * 1024), hi_ = vtr(vp + (D0) * 4096 + (KS) * 1024 + 512); \
                const bf16x8 vf_ = {lo_[0], lo_[1], lo_[2], lo_[3], hi_[0], hi_[1], hi_[2], hi_[3]}; \
                OACC = __builtin_amdgcn_mfma_f32_32x32x16_bf16(__builtin_bit_cast(bf16x8, PW), vf_, OACC, 0, 0, 0); } while (0)
            ATT_PV(o0, pw0, 0, 0); ATT_PV(o1, pw0, 1, 0); ATT_PV(o0, pw1, 0, 1); ATT_PV(o1, pw1, 1, 1);
            if (!locb) {
                const u4 pw2 = {cvtpk(pc1[0], pc1[1]), cvtpk(pc1[2], pc1[3]), cvtpk(pc1[4], pc1[5]), cvtpk(pc1[6], pc1[7])};
                const u4 pw3 = {cvtpk(pc1[8], pc1[9]), cvtpk(pc1[10], pc1[11]), cvtpk(pc1[12], pc1[13]), cvtpk(pc1[14], pc1[15])};
                ATT_PV(o0, pw2, 0, 2); ATT_PV(o1, pw2, 1, 2); ATT_PV(o0, pw3, 0, 3); ATT_PV(o1, pw3, 1, 3);
            }
#undef ATT_PV
        }
        if (cvgo) cv_store(lane, cvv, cvd, cvn, cvscr);
        sc = sn; sn = sn + 1 == NSLOT ? 0 : sn + 1; si = si + 1 == NSLOT ? 0 : si + 1;
    }
    l_run += __shfl_xor(l_run, 32);
    if (hi == 0) wsf[32 + r32] = l_run;
    asm volatile("s_waitcnt lgkmcnt(0)" ::: "memory");
    bf16_t* op = ob + (size_t)(b * L) * D + ocol + r32;
    float* ossp = (float*)(p.ws + WS_OSS) + (size_t)(b * L) * 16 + (ocol >> 6);
#pragma unroll
    for (int r = 0; r < 16; ++r) { const int qi = crow(r, hi); const float inv = __builtin_amdgcn_rcpf(wsf[32 + qi]);
        const int q = ISB ? (qrw + (qi >> 4)) * 64 + 16 * half + (qi & 15) : q0 + qi;
        const float a0 = o0[r] * inv, a1 = o1[r] * inv;
        op[(size_t)q * D] = (bf16_t)f2bf(a0); op[(size_t)q * D + 32] = (bf16_t)f2bf(a1);
        const float ss = row_sum16(a0 * a0 + a1 * a1);
        const float s01 = rdlane(ss, 0) + rdlane(ss, 16), s23 = rdlane(ss, 32) + rdlane(ss, 48);
        if (r32 == 0) ossp[(size_t)q * 16] = hi ? s23 : s01; }
    ATT_WAIT_BAR(0);
#undef ATT_TILE_ROW
#undef ATT_ACTIVE
#undef ATT_QK
}

__device__ __forceinline__ void attn_phase(const Params& p, ATT_LAS unsigned char* lds, int wv) {
    const int G = gridDim.x, bx = blockIdx.x;
    const int vcu = (G % 8 == 0) ? (bx % 8) * (G / 8) + bx / 8 : bx;
    const int per_blk = (CV_ITEMS + G - 1) / G;
    ConvJob cj; cj.it = bx * per_blk + wv; cj.end = (bx + 1) * per_blk < CV_ITEMS ? (bx + 1) * per_blk : CV_ITEMS;
    for (int u = vcu; u < 2048; u += G) {
        if (u < 1024) attn_unit<false>(p, lds, u, wv, cj); else attn_unit<true>(p, lds, u - 1024, wv, cj);
    }
    { const int lane = lane_id(); float cvv[32]; ATT_LAS float* cvscr = (ATT_LAS float*)(lds + LDS_CV + wv * CV_WAVE);
      unsigned char* cvd; int cvn;
      while (cj.it < cj.end) { cv_load(p, cj.it, lane, cvv, cvd, cvn); cv_store(lane, cvv, cvd, cvn, cvscr); cj.it += NTHREADS / 64; } }
}
}

constexpr int SW_STRIDE = 36;

__device__ void p4c_post(const Params& p, LAS3 float* sW, int wv) {
    const int tid = tid_opaque(wv), lane = tid & 63;
    const float* mod = (const float*)(p.ws + WS_MOD); const bf16_t* mix = (const bf16_t*)(p.ws + WS_MIX);
    unsigned char* h8 = p.ws + WS_HB;
    unsigned* counts = (unsigned*)(p.ws + WS_CTL);
    int* eslot = (int*)(p.ws + WS_ESLOT); float* ew = (float*)(p.ws + WS_EW);
    const int wave = tid >> 6;
    LAS3 int* lcnt = (LAS3 int*)(sW + 1024 * SW_STRIDE) + 128;
    LAS3 int* lbase = lcnt + 32;
    LAS3 int* stg_slot = lbase + 32; LAS3 int* stg_e = stg_slot + 512; LAS3 float* stg_w = (LAS3 float*)(stg_e + 512);
    if (tid < NE) lcnt[tid] = 0;
    for (int i = tid; i < D * 8; i += NTHREADS) { const int k = i >> 3, e4 = i & 7; const f32x4 w = ((const f32x4*)p.w_router)[i];
        LAS3 float* d = sW + ((k & 3) * 256 + (k >> 2)) * SW_STRIDE + e4 * 4; *(LAS3 f32x4*)d = w; }
    __syncthreads();
    constexpr int R = 16;
    const int m0 = ((int)blockIdx.x * (NTHREADS / 64) + wave) * R;
    if (m0 < NTOK) {
        const int b = m0 / L; const float* mb = mod + b * 6144;
        f32x4 pA[4], pB[4], pC[4], v[4], xx[4], nx[4]; u32x2 nv[4];
#pragma unroll
        for (int j = 0; j < 4; ++j) { const int c0 = 4 * (lane + 64 * j);
            pA[j] = *(const f32x4*)(p.g_post_mix + c0) * *(const f32x4*)(mb + 2048 + c0);
            pB[j] = *(const f32x4*)(p.g_pre_ffn + c0) * (*(const f32x4*)(mb + 4096 + c0) + 1.f);
            pC[j] = *(const f32x4*)(mb + 3072 + c0);
            nv[j] = ((const u32x2*)(mix + (size_t)m0 * D))[lane + 64 * j]; nx[j] = ((const f32x4*)(p.x + (size_t)m0 * D))[lane + 64 * j]; }
        const float brt0 = p.b_router[lane & 15], brt1 = p.b_router[16 + (lane & 15)];
#pragma unroll 1
        for (int it = 0; it < R; ++it) {
            const int m = m0 + it;
#pragma unroll
            for (int j = 0; j < 4; ++j) { v[j] = (f32x4){__uint_as_float(nv[j].x << 16), __uint_as_float(nv[j].x & 0xffff0000u), __uint_as_float(nv[j].y << 16), __uint_as_float(nv[j].y & 0xffff0000u)}; xx[j] = nx[j]; }
            if (it + 1 < R) {
#pragma unroll
                for (int j = 0; j < 4; ++j) { nv[j] = ((const u32x2*)(mix + (size_t)(m + 1) * D))[lane + 64 * j]; nx[j] = ((const f32x4*)(p.x + (size_t)(m + 1) * D))[lane + 64 * j]; }
            }
            float s = 0.f;
#pragma unroll
            for (int j = 0; j < 4; ++j) s += v[j].x * v[j].x + v[j].y * v[j].y + v[j].z * v[j].z + v[j].w * v[j].w;
            float rstd = rsqrtf(wave_sum(s) * (1.f / D) + EPS);
            s = 0.f;
            f32x4 xv[4];
#pragma unroll
            for (int j = 0; j < 4; ++j) {
                xv[j] = xx[j] + pA[j] * (v[j] * rstd);
                ((f32x4*)(p.out + (size_t)m * D))[lane + 64 * j] = xv[j];
                s += xv[j].x * xv[j].x + xv[j].y * xv[j].y + xv[j].z * xv[j].z + xv[j].w * xv[j].w; }
            rstd = rsqrtf(wave_sum(s) * (1.f / D) + EPS);
            f32x4 h2v[4];
#pragma unroll
            for (int j = 0; j < 4; ++j) { const int c0 = 4 * (lane + 64 * j);
                h2v[j] = (xv[j] * rstd) * pB[j] + pC[j];
                *(unsigned*)(h8 + (size_t)m * D + c0) = pk4_fp8(h2v[j].x, h2v[j].y, h2v[j].z, h2v[j].w); }
            const int li = lane & 15;
            unsigned lrow = (unsigned)lane * (SW_STRIDE * 4); asm volatile("" : "+v"(lrow));
            float zz[2];
#pragma unroll
            for (int ps = 0; ps < 2; ++ps) {
                float lg[16];
#pragma unroll
                for (int e = 0; e < 16; ++e) lg[e] = 0.f;
#pragma unroll
                for (int j = 0; j < 4; ++j)
#pragma unroll
                    for (int q = 0; q < 4; ++q) { const float hv = h2v[j][q]; const LAS3 f32x4* wr = (const LAS3 f32x4*)((LAS3 unsigned char*)sW + (lrow + (unsigned)((q * 256 + 64 * j) * SW_STRIDE * 4 + ps * 64)));
#pragma unroll
                        for (int e4 = 0; e4 < 4; ++e4) { const f32x4 ww = wr[e4]; lg[e4 * 4] = fmaf(hv, ww.x, lg[e4 * 4]); lg[e4 * 4 + 1] = fmaf(hv, ww.y, lg[e4 * 4 + 1]); lg[e4 * 4 + 2] = fmaf(hv, ww.z, lg[e4 * 4 + 2]); lg[e4 * 4 + 3] = fmaf(hv, ww.w, lg[e4 * 4 + 3]); }
                        asm volatile("" : "+v"(lg[0]), "+v"(lg[1]), "+v"(lg[2]), "+v"(lg[3]), "+v"(lg[4]), "+v"(lg[5]), "+v"(lg[6]), "+v"(lg[7]), "+v"(lg[8]), "+v"(lg[9]), "+v"(lg[10]), "+v"(lg[11]), "+v"(lg[12]), "+v"(lg[13]), "+v"(lg[14]), "+v"(lg[15]) :: "memory"); }
                float w8[8], w4[4], w2[2], z;
                { const bool up = li >= 8;
#pragma unroll
                  for (int j = 0; j < 8; ++j) { const float keep = up ? lg[8 + j] : lg[j], send = up ? lg[j] : lg[8 + j]; w8[j] = keep + dppmov<0x140>(send); } }
                { const bool up = (li & 7) >= 4;
#pragma unroll
                  for (int j = 0; j < 4; ++j) { const float keep = up ? w8[4 + j] : w8[j], send = up ? w8[j] : w8[4 + j]; w4[j] = keep + dppmov<0x141>(send); } }
                { const bool up = (li & 2) != 0;
#pragma unroll
                  for (int j = 0; j < 2; ++j) { const float keep = up ? w4[2 + j] : w4[j], send = up ? w4[j] : w4[2 + j]; w2[j] = keep + dppmov<0x4E>(send); } }
                { const bool up = (li & 1) != 0; const float keep = up ? w2[1] : w2[0], send = up ? w2[0] : w2[1]; z = keep + dppmov<0xB1>(send); }
                z += __shfl_xor(z, 16); z += __shfl_xor(z, 32);
                zz[ps] = z;
            }
            float z0 = zz[0] + brt0, z1 = zz[1] + brt1;
            float tv[4]; int ti[4];
#pragma unroll
            for (int k = 0; k < 4; ++k) {
                const bool first = z0 >= z1; const float bv = first ? z0 : z1;
                float mx = fmaxf(bv, dppmov<0xB1>(bv)); mx = fmaxf(mx, dppmov<0x4E>(mx)); mx = fmaxf(mx, dppmov<0x141>(mx)); mx = fmaxf(mx, dppmov<0x140>(mx));
                int ce = (bv == mx) ? (first ? li : 16 + li) : 99;
                { int o = __builtin_amdgcn_update_dpp(0, ce, 0xB1, 0xf, 0xf, true); ce = ce < o ? ce : o; o = __builtin_amdgcn_update_dpp(0, ce, 0x4E, 0xf, 0xf, true); ce = ce < o ? ce : o;
                  o = __builtin_amdgcn_update_dpp(0, ce, 0x141, 0xf, 0xf, true); ce = ce < o ? ce : o; o = __builtin_amdgcn_update_dpp(0, ce, 0x140, 0xf, 0xf, true); ce = ce < o ? ce : o; }
                ti[k] = __builtin_amdgcn_readfirstlane(ce); tv[k] = mx;
                { const bool mine = li == (ti[k] & 15); z0 = (mine && ti[k] < 16) ? -3.4e38f : z0; z1 = (mine && ti[k] >= 16) ? -3.4e38f : z1; }
            }
            const float e1 = __expf(tv[1] - tv[0]), e2 = __expf(tv[2] - tv[0]), e3 = __expf(tv[3] - tv[0]); const float inv = 1.f / (1.f + e1 + e2 + e3);
            const float tw[4] = {inv, e1 * inv, e2 * inv, e3 * inv};
            if (lane < 4) {
                int myi = ti[0]; float myw = tw[0];
#pragma unroll
                for (int k = 1; k < 4; ++k) if (lane == k) { myi = ti[k]; myw = tw[k]; }
                const int lr = __hip_atomic_fetch_add((LAS3 int*)&lcnt[myi], 1, __ATOMIC_RELAXED, __HIP_MEMORY_SCOPE_WORKGROUP);
                const int si = (wave * 16 + it) * 4 + lane;
                stg_slot[si] = m * 4 + lane; stg_e[si] = myi | (lr << 8); stg_w[si] = myw;
            }
        }
    }
    __syncthreads();
    if (tid < NE) { const int c = lcnt[tid]; lbase[tid] = c ? (int)atomicAdd(&counts[tid * 64], (unsigned)c) : 0; }
    __syncthreads();
    { const int si = tid, w = si >> 6;
      if (((int)blockIdx.x * (NTHREADS / 64) + w) * R < NTOK) {
        const int ee = stg_e[si], e = ee & 255, lr = ee >> 8; const int rank = lbase[e] + lr;
        eslot[(size_t)e * ECAP + rank] = stg_slot[si]; ew[(size_t)e * ECAP + rank] = stg_w[si]; } }
    __syncthreads();
}
__device__ __forceinline__ void expert_bases(const unsigned* counts, int* sbase_  , int wv) {
    LAS3 int* sbase = (LAS3 int*)sbase_;
    if (wv == 0) {
        const int lane = lane_id(); const int cn = lane < NE ? (int)counts[lane * 64] : 0; const int c = (cn + 255) & ~255;
        int incl = c;
#pragma unroll
        for (int o = 1; o < 32; o <<= 1) { const int v = __shfl_up(incl, o); if (lane >= o) incl += v; }
        if (lane < NE) { sbase[lane] = incl - c; sbase[40 + lane] = cn; }
        if (lane == NE - 1) sbase[NE] = incl;
    }
    __syncthreads();
}
typedef float f32x2v __attribute__((ext_vector_type(2)));
__device__ __forceinline__ void p6_load(const unsigned char* y, const float* out, int m, int lane, u32x2 (&yv)[2][4], f32x4 (&xv)[2][2]) {
#pragma unroll
    for (int j = 0; j < 2; ++j) { const int c0 = 8 * (lane + 64 * j);
#pragma unroll
        for (int k = 0; k < 4; ++k) yv[j][k] = *(const u32x2*)(y + (size_t)(m * 4 + k) * D + c0);
        xv[j][0] = *(const f32x4*)(out + (size_t)m * D + c0); xv[j][1] = *(const f32x4*)(out + (size_t)m * D + c0 + 4); }
}
__device__ void p6_final(const Params& p, int wv) {
    const int tid = tid_opaque(wv), lane = tid & 63;
    const float* mod = (const float*)(p.ws + WS_MOD); const unsigned char* y = p.ws + WS_Y;
    constexpr int R = 16;
    const int m0 = ((int)blockIdx.x * (NTHREADS / 64) + (tid >> 6)) * R;
    if (m0 >= NTOK) return;
    const int b = m0 / L; const float* ga2 = mod + b * 6144 + 5120;
    f32x4 pA[2][2];
#pragma unroll
    for (int j = 0; j < 2; ++j)
#pragma unroll
        for (int q = 0; q < 2; ++q) { const int c0 = 8 * (lane + 64 * j) + 4 * q; pA[j][q] = *(const f32x4*)(p.g_post_ffn + c0) * *(const f32x4*)(ga2 + c0); }
    u32x2 yv[2][4], ny[2][4]; f32x4 xv[2][2], nx[2][2];
    p6_load(y, p.out, m0, lane, ny, nx);
    for (int it = 0; it < R; ++it) {
        const int m = m0 + it;
#pragma unroll
        for (int j = 0; j < 2; ++j) {
#pragma unroll
            for (int k = 0; k < 4; ++k) yv[j][k] = ny[j][k];
            xv[j][0] = nx[j][0]; xv[j][1] = nx[j][1]; }
        if (it + 1 < R) p6_load(y, p.out, m + 1, lane, ny, nx);
        f32x4 a[2][2]; float s = 0.f;
#pragma unroll
        for (int j = 0; j < 2; ++j) { a[j][0] = (f32x4){0.f, 0.f, 0.f, 0.f}; a[j][1] = (f32x4){0.f, 0.f, 0.f, 0.f};
#pragma unroll
            for (int k = 0; k < 4; ++k) { const u32x2 w = yv[j][k];
                const f32x2v l0 = __builtin_amdgcn_cvt_pk_f32_fp8((int)w.x, false), l1 = __builtin_amdgcn_cvt_pk_f32_fp8((int)w.x, true);
                const f32x2v h0 = __builtin_amdgcn_cvt_pk_f32_fp8((int)w.y, false), h1 = __builtin_amdgcn_cvt_pk_f32_fp8((int)w.y, true);
                a[j][0].x += l0.x; a[j][0].y += l0.y; a[j][0].z += l1.x; a[j][0].w += l1.y;
                a[j][1].x += h0.x; a[j][1].y += h0.y; a[j][1].z += h1.x; a[j][1].w += h1.y; }
#pragma unroll
            for (int q = 0; q < 2; ++q) { a[j][q] = a[j][q] * Y8_INV; s += a[j][q].x * a[j][q].x + a[j][q].y * a[j][q].y + a[j][q].z * a[j][q].z + a[j][q].w * a[j][q].w; } }
        const float rstd = rsqrtf(wave_sum(s) * (1.f / D) + EPS);
#pragma unroll
        for (int j = 0; j < 2; ++j)
#pragma unroll
            for (int q = 0; q < 2; ++q) { const int c0 = 8 * (lane + 64 * j) + 4 * q;
                *(f32x4*)(p.out + (size_t)m * D + c0) = xv[j][q] + pA[j][q] * (a[j][q] * rstd); }
    }
}

constexpr int LDS_SBASE = 147456;
constexpr int LDS_BYTES = LDS_SBASE + 512 + (64 + 3 * 512) * 4 + 256;

__global__ void __launch_bounds__(NTHREADS, 2) fwd_kernel(Params p) {
    cg::grid_group grid = cg::this_grid();
    extern __shared__ __attribute__((aligned(16))) unsigned char lds[];
    int* sbase = (int*)(lds + LDS_SBASE);
    PG8_LAS unsigned char* lds3 = (PG8_LAS unsigned char*)lds;
    const PG8_LAS int* sbase3 = (const PG8_LAS int*)(lds3 + LDS_SBASE);
    volatile LAS3 unsigned* bst = (volatile LAS3 unsigned*)(lds3 + LDS_SBASE + 384);
    const int wv = __builtin_amdgcn_readfirstlane((int)(threadIdx.x >> 6));
    if (wv == 0 && lane_id() < 2) bst[lane_id()] = 0u;
    __syncthreads();
    XcdBarrier xb = xcd_barrier_post((unsigned*)(p.ws + WS_CTL) + CW_BAR, bst, wv);

    p0_mod(p, (float*)lds, (float*)(lds + 36864), wv);
    p0_tab(p, wv);
    p0_weights(p, lds, wv);
    grid.sync();
    p1_h(p, wv);
    xcd_barrier(xb);
    { pg8::Gemm g{(const bf16_t*)(p.ws + WS_HB), (const bf16_t*)(p.ws + WS_WIN), D, 0, nullptr, sbase3, wv};
      pg8::StaticOrder S; S.init(MROWS, INW, (int)gridDim.x, (int)blockIdx.x, nullptr);
      { const int t_ = tid_opaque(wv); *(PG8_LAS f32x4*)(lds3 + pg8::PAR_TAB + t_ * 16) = ((const f32x4*)(p.ws + WS_TAB))[t_]; }
      __syncthreads();
      pg8::EpiQKV E{(bf16_t*)(p.ws + WS_QKV)};
      pg8::gemm_phase<pg8::EpiQKV, pg8::StaticOrder, false, true>(lds3, g, S, E); }
    xcd_barrier(xb);
    att::attn_phase(p, lds3, wv);
    xcd_barrier(xb);
    { pg8::Gemm g{(const bf16_t*)(p.ws + WS_O), (const bf16_t*)(p.ws + WS_WOUT), D, 0, nullptr, sbase3, wv};
      pg8::StaticOrder S; S.init(NTOK, D, (int)gridDim.x, (int)blockIdx.x, nullptr);
      pg8::EpiOutProj E{(bf16_t*)(p.ws + WS_MIX), (const float*)(p.ws + WS_OSS)};
      pg8::gemm_phase<pg8::EpiOutProj, pg8::StaticOrder, false, true>(lds3, g, S, E); }
    xcd_barrier(xb);
    p4c_post(p, (LAS3 float*)lds3, wv);
    xcd_barrier(xb);
    expert_bases((const unsigned*)(p.ws + WS_CTL), sbase, wv);
    { const int total = sbase3[NE];
      pg8::Gemm g{(const bf16_t*)(p.ws + WS_HB), (const bf16_t*)(p.ws + WS_W1), D / 2, (size_t)2048 * D, (const int*)(p.ws + WS_ESLOT), sbase3, wv};
      pg8::StaticOrder S; S.init(total, 2048, (int)gridDim.x, (int)blockIdx.x, sbase3);
      pg8::EpiSwiglu E{p.ws + WS_ACT, p.b_mlp1};
      pg8::gemm_phase<pg8::EpiSwiglu, pg8::StaticOrder, true, true, true>(lds3, g, S, E); }
    xcd_barrier(xb);
    { const int total = sbase3[NE];
      pg8::Gemm g{(const bf16_t*)(p.ws + WS_ACT), (const bf16_t*)(p.ws + WS_W2), D / 2, (size_t)D * D, nullptr, sbase3, wv};
      pg8::StaticOrder S; S.init(total, D, (int)gridDim.x, (int)blockIdx.x, sbase3);
      pg8::EpiScatter E{p.ws + WS_Y, p.b_mlp2, (const int*)(p.ws + WS_ESLOT), (const float*)(p.ws + WS_EW), sbase3};
      pg8::gemm_phase<pg8::EpiScatter, pg8::StaticOrder, false, true, true>(lds3, g, S, E); }
    xcd_barrier(xb);
    p6_final(p, wv);
}

extern "C" void kernel_launch(void* const* d_in, const int* in_sizes, int n_in, void* d_out, int out_size, void* d_ws, size_t ws_size, hipStream_t stream) {
    static int grid_blocks = 0;
    if (grid_blocks == 0) {
        if (n_in != 22 || ws_size < WS_END) { fprintf(stderr, "kernel_launch: unexpected n_in %d / ws_size %zu (need %zu)\n", n_in, ws_size, (size_t)WS_END); grid_blocks = -1; return; }
        int dev = 0, cus = 0, per_cu = 0;
        (void)hipGetDevice(&dev);
        (void)hipDeviceGetAttribute(&cus, hipDeviceAttributeMultiprocessorCount, dev);
        if (hipFuncSetAttribute((const void*)fwd_kernel, hipFuncAttributeMaxDynamicSharedMemorySize, LDS_BYTES) != hipSuccess) { fprintf(stderr, "kernel_launch: hipFuncSetAttribute failed\n"); grid_blocks = -1; return; }
        (void)hipOccupancyMaxActiveBlocksPerMultiprocessor(&per_cu, (const void*)fwd_kernel, NTHREADS, LDS_BYTES);
        if (per_cu < 1) { fprintf(stderr, "kernel_launch: occupancy query returned %d\n", per_cu); grid_blocks = -1; return; }
        grid_blocks = cus;
        if (grid_blocks * (NTHREADS / 64) * 16 < NTOK) { fprintf(stderr, "kernel_launch: needs >= 256 CUs (got %d)\n", cus); grid_blocks = -1; return; }
    }
    if (grid_blocks < 0) return;
    (void)hipMemsetAsync((char*)d_ws + WS_CTL, 0, CTL_BYTES, stream);
    Params p{};
    const float** pp = (const float**)&p;
    for (int i = 0; i < 22; ++i) pp[i] = (const float*)d_in[i];
    p.out = (float*)d_out; p.ws = (unsigned char*)d_ws;
    void* args[] = {&p};
    hipError_t e = hipLaunchCooperativeKernel((const void*)fwd_kernel, dim3(grid_blocks), dim3(NTHREADS), args, LDS_BYTES, stream);
    if (e != hipSuccess) fprintf(stderr, "cooperative launch failed: %s (grid %d)\n", hipGetErrorString(e), grid_blocks);
}
```

```cpp
#include <hip/hip_runtime.h>
#include <hip/hip_cooperative_groups.h>
#include <cstdio>
#include <cstdint>
namespace cg = cooperative_groups;

constexpr int D = 1024, NB = 8, L = 4096, CTX = 256;
constexpr int NTOK = NB * L, NCTX = NB * CTX, MROWS = NTOK + NCTX;
constexpr int INW = 2304;
constexpr int C_QA = 0, C_KA = 512, C_VA = 640, C_QB = 768, C_KB = 1280, C_VB = 1792;
constexpr int NE = 32, TOPK = 4, NASG = NTOK * TOPK;
constexpr int PADROWS = NASG + NE * 256;
constexpr float LOG2E = 1.4426950408889634f;
constexpr float QSCALE = 0.125f * LOG2E;
constexpr float EPS = 1e-6f;
constexpr int NTHREADS = 512;

constexpr size_t MiB = 1u << 20;
constexpr size_t WS_CTL = 0;
constexpr size_t CTL_BYTES = 32768;
constexpr int CW_BAR = 2048;
constexpr size_t WS_MOD = 1 * MiB;
constexpr size_t WS_TAB = 1 * MiB + 256 * 1024;
constexpr size_t WS_OSTAT = 1 * MiB + 512 * 1024;
constexpr size_t WS_WIN = 2 * MiB;
constexpr size_t WS_WOUT = 7 * MiB;
constexpr size_t WS_W2 = 9 * MiB;
constexpr size_t WS_OSS = 41 * MiB;
constexpr size_t WS_W1 = 73 * MiB;
constexpr size_t WS_HB = 201 * MiB;
constexpr int ECAP = NTOK;
constexpr size_t WS_ESLOT = 269 * MiB;
constexpr size_t WS_EW = 273 * MiB;
constexpr size_t WS_QKV = 277 * MiB;
constexpr size_t WS_O = 430 * MiB;
constexpr size_t WS_MIX = 494 * MiB;
constexpr size_t WS_ACT = 277 * MiB;
constexpr size_t WS_Y = 622 * MiB;
constexpr size_t WS_END = 878 * MiB;
static_assert(WS_W1 + (size_t)NE * 2048 * D * 2 <= WS_HB && WS_W2 + (size_t)NE * D * D * 2 <= WS_W1, "map");
static_assert(WS_HB + (size_t)MROWS * D * 2 <= WS_ESLOT && WS_ESLOT + (size_t)NE * ECAP * 4 <= WS_EW && WS_EW + (size_t)NE * ECAP * 4 <= WS_QKV, "map");
static_assert(WS_QKV + (size_t)MROWS * INW * 2 <= WS_O && WS_O + (size_t)NTOK * D * 2 <= WS_MIX && WS_MIX + (size_t)NTOK * D * 4 <= WS_Y, "map");
static_assert(WS_ACT + (size_t)PADROWS * 1024 * 2 <= WS_Y && WS_Y + (size_t)NASG * D * 2 <= WS_END, "map");

typedef unsigned short bf16_t;
typedef float f32x4 __attribute__((ext_vector_type(4)));
typedef unsigned u32x4 __attribute__((ext_vector_type(4)));
typedef unsigned u32x2 __attribute__((ext_vector_type(2)));

struct Params {
    const float *x, *c, *ctx, *c_ctx, *w_ada, *b_ada, *g_pre_mix, *g_post_mix, *g_pre_ffn, *g_post_ffn, *w_in, *g_grp_a, *g_grp_b,
        *sink_a, *rpb_b, *w_out, *w_router, *b_router, *w_mlp1, *b_mlp1, *w_mlp2, *b_mlp2;
    float* out;
    unsigned char* ws;
};

__device__ __forceinline__ unsigned f2bf(float f) { unsigned u = __float_as_uint(f); return (u + 0x7fffu + ((u >> 16) & 1u)) >> 16; }
__device__ __forceinline__ unsigned pk2(float lo, float hi) { return f2bf(lo) | (f2bf(hi) << 16); }
__device__ __forceinline__ unsigned pk4_fp8(float v0, float v1, float v2, float v3) {
    int w = 0; w = __builtin_amdgcn_cvt_pk_fp8_f32(v0, v1, w, false); w = __builtin_amdgcn_cvt_pk_fp8_f32(v2, v3, w, true); return (unsigned)w; }
constexpr float Y8_SCALE = 16.f, Y8_INV = 1.f / 16.f;
constexpr float W8_SCALE = 64.f, W8_INV = 1.f / 64.f;
__device__ __forceinline__ int lane_id() { int l = (int)__builtin_amdgcn_mbcnt_hi(~0u, __builtin_amdgcn_mbcnt_lo(~0u, 0u)); asm volatile("" : "+v"(l)); return l; }
__device__ __forceinline__ int tid_opaque(int wv) { return wv * 64 + lane_id(); }
template <int CTRL> __device__ __forceinline__ float dppmov(float v) { return __builtin_bit_cast(float, __builtin_amdgcn_update_dpp(0, __builtin_bit_cast(int, v), CTRL, 0xf, 0xf, true)); }
__device__ __forceinline__ float row_sum16(float v) { v += dppmov<0xB1>(v); v += dppmov<0x4E>(v); v += dppmov<0x141>(v); v += dppmov<0x140>(v); return v; }
__device__ __forceinline__ float rdlane(float v, int l) { return __builtin_bit_cast(float, __builtin_amdgcn_readlane(__builtin_bit_cast(int, v), l)); }
__device__ __forceinline__ float wave_sum(float v) { v = row_sum16(v); return (rdlane(v, 0) + rdlane(v, 16)) + (rdlane(v, 32) + rdlane(v, 48)); }

#define LAS3 __attribute__((address_space(3)))
#define XB_TMO      128
#define XB_XCNT(j)  (256  + 64 * (j))
#define XB_XSUB(j)  (1280 + 64 * (j))
#define XB_XGEN(j)  (2304 + 64 * (j))
#define XB_TOP      3328
#define XB_TOPGEN   3392
#define XCD_BAR_WORDS 3456
#define XB_SPIN_CAP (1u << 18)
__device__ __forceinline__ unsigned xb_ld(unsigned* p)              { return __hip_atomic_load(p, __ATOMIC_RELAXED, __HIP_MEMORY_SCOPE_AGENT); }
__device__ __forceinline__ unsigned xb_add(unsigned* p, unsigned v) { return __hip_atomic_fetch_add(p, v, __ATOMIC_RELAXED, __HIP_MEMORY_SCOPE_AGENT); }
__device__ __forceinline__ unsigned xb_xcc_id() { return (unsigned)__builtin_amdgcn_s_getreg((3 << 11) | 20) & 0xFu; }
#define XB_SPIN(cond, bar) do { unsigned _sp = 0; while (cond) { __builtin_amdgcn_s_sleep(1); \
    if ((++_sp & 255u) == 0u) { if (xb_ld(&(bar)[XB_TMO])) break; if (_sp > XB_SPIN_CAP) { atomicAdd(&(bar)[XB_TMO], 1u); break; } } } } while (0)
struct XcdBarrier { unsigned* bar; unsigned x; volatile LAS3 unsigned* st; int wv; };
__device__ __forceinline__ XcdBarrier xcd_barrier_post(unsigned* bar, volatile LAS3 unsigned* st, int wv) {
    XcdBarrier b; b.bar = bar; b.x = xb_xcc_id(); b.st = st; b.wv = wv;
    if (tid_opaque(wv) == 0) (void)xb_add(&bar[XB_XCNT(b.x)], 1u);
    return b;
}
__device__ __forceinline__ void xcd_barrier_complete(unsigned* bar, unsigned x, unsigned& nloc, unsigned& nx) {
    const unsigned G = gridDim.x * gridDim.y * gridDim.z;
    unsigned sum, cnt, mine, sp = 0u;
    for (;;) {
        sum = 0u; cnt = 0u; mine = 0u;
#pragma unroll
        for (unsigned j = 0; j < 16; ++j) { const unsigned c = xb_ld(&bar[XB_XCNT(j)]); sum += c; cnt += (c > 0u) ? 1u : 0u; mine = (j == x) ? c : mine; }
        if (sum == G) break;
        __builtin_amdgcn_s_sleep(1);
        if ((++sp & 255u) == 0u) { if (xb_ld(&bar[XB_TMO])) break; if (sp > XB_SPIN_CAP) { atomicAdd(&bar[XB_TMO], 1u); break; } }
    }
    nloc = mine > 0u ? mine : 1u; nx = cnt > 0u ? cnt : 1u;
}
__device__ __forceinline__ void xcd_barrier(const XcdBarrier& b) {
    asm volatile("s_waitcnt vmcnt(0)" ::: "memory");
    __syncthreads();
    if (tid_opaque(b.wv) == 0) {
        unsigned* bar = b.bar;
        __builtin_amdgcn_s_waitcnt(0);
        unsigned nloc = b.st[0], nx = b.st[1];
        if (nloc == 0u) { xcd_barrier_complete(bar, b.x, nloc, nx); b.st[0] = nloc; b.st[1] = nx; }
        const unsigned old = xb_add(&bar[XB_XSUB(b.x)], 1u);
        const unsigned gen = old / nloc;
        if (old + 1u == (gen + 1u) * nloc) {
            __builtin_amdgcn_fence(__ATOMIC_RELEASE, "agent");
            asm volatile("s_waitcnt vmcnt(0)" ::: "memory");
            const unsigned og = xb_add(&bar[XB_TOP], 1u);
            const unsigned tg = og / nx;
            if (og + 1u == (tg + 1u) * nx) xb_add(&bar[XB_TOPGEN], 1u);
            else XB_SPIN(xb_ld(&bar[XB_TOPGEN]) == tg, bar);
            __builtin_amdgcn_fence(__ATOMIC_ACQUIRE, "agent");
            xb_add(&bar[XB_XGEN(b.x)], 1u);
            asm volatile("s_waitcnt vmcnt(0)" ::: "memory");
        } else {
            XB_SPIN(xb_ld(&bar[XB_XGEN(b.x)]) == gen, bar);
            __builtin_amdgcn_fence(__ATOMIC_ACQUIRE, "agent");
            asm volatile("s_waitcnt vmcnt(0)" ::: "memory");
        }
    }
    __syncthreads();
}

namespace pg8 {
#define PG8_LAS __attribute__((address_space(3)))
typedef short bf16x8 __attribute__((ext_vector_type(8)));
typedef int v8i __attribute__((ext_vector_type(8)));
typedef int v4i __attribute__((ext_vector_type(4)));
typedef short s16x16 __attribute__((ext_vector_type(16)));
constexpr int BM = 256, BK = 64, HALF = 128, HTB = HALF * BK * 2  , STAGE_BYTES = 8 * HTB, NXCD = 8, WGM = 8;
__device__ __forceinline__ int lds_byte(int r, int c) { const int st = (r >> 4) * 2 + (c >> 5), rr = r & 15, cc = c & 31, ob = rr * 64 + cc * 2; return st * 1024 + (ob ^ (((ob >> 9) & 1) << 5)); }
__device__ __forceinline__ void stage_rc(int b, int& R, int& C) { const int st = b / 1024, sb = b % 1024, swz = sb ^ (((sb >> 9) & 1) << 5); R = (st >> 1) * 16 + swz / 64; C = (st & 1) * 32 + (swz % 64) / 2; }
__device__ __forceinline__ int perm32(int rho) { const int n = rho >> 4, i = rho & 15; return 8 * (i >> 2) + 4 * n + (i & 3); }

constexpr int PAR_BASE = 131072, PAR_BUF = 4096, PAR_IDX = 0, PAR_W = 1024, PAR_BIAS = 2048, PAR_TAB = PAR_BASE + 2 * PAR_BUF;
typedef short s16x2 __attribute__((ext_vector_type(2)));
__device__ __forceinline__ int par_i32(PG8_LAS unsigned char* p) { return __builtin_bit_cast(int, *(const PG8_LAS s16x2*)p); }
__device__ __forceinline__ float par_f32(PG8_LAS unsigned char* p) { return __builtin_bit_cast(float, *(const PG8_LAS s16x2*)p); }
__device__ __forceinline__ f32x4 par_f32x4(PG8_LAS unsigned char* p) { return __builtin_bit_cast(f32x4, *(const PG8_LAS bf16x8*)p); }
struct Unit { int pm, pn, e; };
struct Gemm { const bf16_t* A; const bf16_t* Bt; int K; size_t bstride; const int* eslot; const PG8_LAS int* sb; int wv; };

struct StaticOrder {
    int nM, nN, nwg, G, c; const PG8_LAS int* sbase;
    __device__ void init(int M, int N, int G_, int c_, const PG8_LAS int* sb) { nM = M / BM; nN = N / BM; nwg = nM * nN; G = G_; c = c_; sbase = sb; }
    __device__ bool next(int i, Unit& u) const {
        const long Lx = (long)i * G + c; if (Lx >= nwg) return false;
        int wgid = (int)Lx; { const int q = nwg / NXCD, r = nwg % NXCD, xcd = wgid % NXCD, off = wgid / NXCD; wgid = (xcd < r ? xcd * (q + 1) : r * (q + 1) + (xcd - r) * q) + off; }
        const int nig = WGM * nN, gid = wgid / nig, fm = gid * WGM, gsz = (nM - fm) < WGM ? (nM - fm) : WGM;
        u.pm = fm + ((wgid % nig) % gsz); u.pn = (wgid % nig) / gsz; u.e = 0;
        if (sbase) { const int row = u.pm * BM; const int l = lane_id();
            const bool ge = (l >= 1) && (l < 32) && (row >= sbase[l & 31]);
            u.e = __builtin_popcountll(__ballot(ge)); }
        return true;
    }
};

template <class Epi, class Sched, bool GATHER, bool ALIGN_EPI, bool FP8 = false>
__device__ __forceinline__ void gemm_phase(PG8_LAS unsigned char* lds, const Gemm g, const Sched& S, const Epi& E) {
    const int tid = tid_opaque(g.wv), wid = g.wv,
              lane = tid & 63, wr = wid >> 2, wc = wid & 3, fr = lane & 15, fq = lane >> 4;
    const int K = g.K, nt = K / BK;
    unsigned voffA[2], voffB[2];
#pragma unroll
    for (int i = 0; i < 2; ++i) { const int R = 8 * (wid + 8 * i) + (lane >> 3), Sb = (((lane & 7) ^ (lane >> 3)) * 16); const int Rb = Epi::PERM ? ((R & ~31) + perm32(R & 31)) : R;
        voffA[i] = (unsigned)(R * K * 2 + Sb); voffB[i] = (unsigned)(Rb * K * 2 + Sb); }
    const size_t kstep = (size_t)(BK * 2);
    const size_t hstep = (size_t)HALF * K * 2;
    const size_t tstep = 2 * hstep;
    const unsigned ldsw = (unsigned)wid * 1024u;
    const int fsw0 = (fr & 7) * 128 + ((fq ^ (fr & 7)) * 16), fsw1 = (fr & 7) * 128 + (((fq + 4) ^ (fr & 7)) * 16);
    const int aoff0 = (wr * 8 + (fr >> 3)) * 1024 + fsw0, aoff1 = (wr * 8 + (fr >> 3)) * 1024 + fsw1, boff0 = (wc * 4 + (fr >> 3)) * 1024 + fsw0, boff1 = (wc * 4 + (fr >> 3)) * 1024 + fsw1;
#define PG8_SA(b, h) (((b) * 2 + (h)) * HTB)
#define PG8_SB(b, h) ((4 + (b) * 2 + (h)) * HTB)
#define PG8_STAGE(bufoff, gbase, voff) do { _Pragma("unroll") for (int _i = 0; _i < 2; ++_i) \
        __builtin_amdgcn_global_load_lds((const unsigned*)((const char*)(gbase) + (voff)[_i]), (PG8_LAS unsigned*)(lds + (bufoff) + ldsw + _i * 8192), 16, 0, 0); } while (0)
#define PG8_CAT(lo_, hi_) __builtin_bit_cast(v8i, __builtin_shufflevector((lo_), (hi_), 0, 1, 2, 3, 4, 5, 6, 7, 8, 9, 10, 11, 12, 13, 14, 15))
#define PG8_LDA(dst, b, h) do { _Pragma("unroll") for (int m = 0; m < 4; ++m) { \
        const bf16x8 f0_ = *(const PG8_LAS bf16x8*)(lds + PG8_SA(b, h) + aoff0 + m * 2048), f1_ = *(const PG8_LAS bf16x8*)(lds + PG8_SA(b, h) + aoff1 + m * 2048); \
        if constexpr (FP8) dst##8[m] = PG8_CAT(f0_, f1_); else { dst[m][0] = f0_; dst[m][1] = f1_; } } } while (0)
#define PG8_LDB(dst, b, h) do { _Pragma("unroll") for (int n = 0; n < 2; ++n) { \
        const bf16x8 f0_ = *(const PG8_LAS bf16x8*)(lds + PG8_SB(b, h) + boff0 + n * 2048), f1_ = *(const PG8_LAS bf16x8*)(lds + PG8_SB(b, h) + boff1 + n * 2048); \
        if constexpr (FP8) dst##8[n] = PG8_CAT(f0_, f1_); else { dst[n][0] = f0_; dst[n][1] = f1_; } } } while (0)
#define PG8_MMA(ai, bj, At, Bt) do { __builtin_amdgcn_s_setprio(1); _Pragma("unroll") for (int m = 0; m < 4; ++m) _Pragma("unroll") for (int n = 0; n < 2; ++n) { \
        if constexpr (FP8) asm volatile("v_mfma_scale_f32_16x16x128_f8f6f4 %0, %1, %2, %0, %3, %3 op_sel_hi:[0,0,0]" : "+v"(acc[ai][bj][m][n]) : "v"(Bt##8[n]), "v"(At##8[m]), "v"(one_scale)); \
        else { _Pragma("unroll") for (int k = 0; k < 2; ++k) acc[ai][bj][m][n] = __builtin_amdgcn_mfma_f32_16x16x32_bf16(Bt[n][k], At[m][k], acc[ai][bj][m][n], 0, 0, 0); } } \
        __builtin_amdgcn_s_setprio(0); } while (0)
#define PG8_WAIT_V(n) asm volatile("s_waitcnt vmcnt(" #n ")" ::: "memory")
#define PG8_WAIT_L(n) asm volatile("s_waitcnt lgkmcnt(" #n ")" ::: "memory")
#define PG8_BAR __builtin_amdgcn_s_barrier()
#define PG8_SCHED __builtin_amdgcn_sched_barrier(0)
#define PG8_SETOFF(off, pbuf_) do { _Pragma("unroll") for (int _h = 0; _h < 2; ++_h) _Pragma("unroll") for (int _i = 0; _i < 2; ++_i) { \
        if (GATHER) { const int R_ = 8 * (wid + 8 * _i) + (lane >> 3); \
            off[_h][_i] = (unsigned)(par_i32(lds + PAR_BASE + (pbuf_) * PAR_BUF + PAR_IDX + (_h * HALF + R_) * 4) >> 2) * (unsigned)(K * 2) + (unsigned)(((lane & 7) ^ (lane >> 3)) * 16); } \
        else off[_h][_i] = voffA[_i] + (unsigned)(_h * hstep); } } while (0)
#define PG8_IDXDMA(u, pbuf_) do { if (GATHER && wid < 4) { int rk_ = (u).pm * BM + wid * 64 + lane - g.sb[(u).e]; const int cm_ = g.sb[40 + (u).e] - 1; rk_ = rk_ < cm_ ? rk_ : cm_; \
        __builtin_amdgcn_global_load_lds((const unsigned*)(g.eslot + (size_t)(u).e * ECAP + rk_), (PG8_LAS unsigned*)(lds + PAR_BASE + (pbuf_) * PAR_BUF + PAR_IDX + wid * 256), 4, 0, 0); } } while (0)
    Unit cur, nxt; int ui = 0;
    if (!S.next(0, cur)) return;
    PG8_IDXDMA(cur, 0); E.prefetch(cur, 0, lds, wid, lane);
    PG8_WAIT_V(0); PG8_BAR;
    f32x4 acc[2][2][4][2];
#pragma unroll
    for (int a = 0; a < 2; ++a)
#pragma unroll
        for (int b = 0; b < 2; ++b)
#pragma unroll
            for (int m = 0; m < 4; ++m)
#pragma unroll
                for (int n = 0; n < 2; ++n) acc[a][b][m][n] = (f32x4){0.f, 0.f, 0.f, 0.f};
    bf16x8 At[4][2], B0[2][2], B1[2][2];
    v8i At8[4], B08[2], B18[2];
    const int one_scale = 0x7f7f7f7f;
    unsigned offc[2][2];
    PG8_SETOFF(offc, 0);
    const char* cA = GATHER ? (const char*)g.A : (const char*)g.A + (size_t)cur.pm * tstep;
    const char* cB = (const char*)g.Bt + (size_t)cur.e * g.bstride + (size_t)cur.pn * tstep;
    PG8_STAGE(PG8_SB(0, 0), cB, voffB); PG8_STAGE(PG8_SB(0, 1), cB + hstep, voffB); PG8_STAGE(PG8_SA(0, 0), cA, offc[0]); PG8_STAGE(PG8_SA(0, 1), cA, offc[1]);
    if (wr == 1) PG8_BAR;
    PG8_WAIT_V(2); PG8_BAR;
    PG8_STAGE(PG8_SB(1, 0), cB + kstep, voffB); PG8_STAGE(PG8_SA(1, 0), cA + kstep, offc[0]); PG8_STAGE(PG8_SB(1, 1), cB + hstep + kstep, voffB);
    PG8_WAIT_V(6); PG8_BAR;
    for (;;) {
        const bool has_next = S.next(ui + 1, nxt);
        const char* nA = GATHER ? cA : (has_next ? (const char*)g.A + (size_t)nxt.pm * tstep : cA);
        const char* nB = has_next ? (const char*)g.Bt + (size_t)nxt.e * g.bstride + (size_t)nxt.pn * tstep : cB;

        if constexpr (Epi::MIDSCALE) E.begin(cur, ui, lds, tid);
#pragma unroll 1
        for (int t = 0; t < nt; t += 2) {
            const bool last = (t == nt - 2);
            if constexpr (Epi::MIDSCALE) { if (t == nt / 2) E.mid(acc, ui, wr, fr, lds); }
            if (t == 2 && has_next) { PG8_IDXDMA(nxt, (ui + 1) & 1); E.prefetch(nxt, (ui + 1) & 1, lds, wid, lane); }
            const char* a1 = cA + (size_t)(t + 1) * kstep;
            const char* a2 = last ? nA : cA + (size_t)(t + 2) * kstep; const char* b2 = last ? nB : cB + (size_t)(t + 2) * kstep;
            const char* a3 = a2 + kstep; const char* b3 = b2 + kstep;
            PG8_LDB(B0, 0, 0); PG8_LDB(B1, 0, 1); PG8_SCHED; PG8_LDA(At, 0, 0); PG8_STAGE(PG8_SA(1, 1), a1, offc[1]);
            if (GATHER && last && has_next) { PG8_SETOFF(offc, (ui + 1) & 1); }
            PG8_WAIT_V(8); PG8_WAIT_L(0); PG8_BAR; PG8_MMA(0, 0, At, B0); PG8_MMA(0, 1, At, B1); PG8_BAR; PG8_SCHED;
            PG8_LDA(At, 0, 1); PG8_STAGE(PG8_SB(0, 0), b2, voffB); PG8_STAGE(PG8_SB(0, 1), b2 + hstep, voffB); PG8_STAGE(PG8_SA(0, 0), a2, offc[0]);
            PG8_WAIT_V(8); PG8_WAIT_L(0); PG8_BAR; PG8_MMA(1, 0, At, B0); PG8_MMA(1, 1, At, B1); PG8_BAR; PG8_SCHED;
            PG8_LDB(B0, 1, 0); PG8_LDB(B1, 1, 1); PG8_SCHED; PG8_LDA(At, 1, 0); PG8_STAGE(PG8_SA(0, 1), a2, offc[1]);
            PG8_WAIT_V(8); PG8_WAIT_L(0); PG8_BAR; PG8_MMA(0, 0, At, B0); PG8_MMA(0, 1, At, B1); PG8_BAR; PG8_SCHED;
            PG8_LDA(At, 1, 1); PG8_STAGE(PG8_SB(1, 0), b3, voffB); PG8_STAGE(PG8_SB(1, 1), b3 + hstep, voffB); PG8_STAGE(PG8_SA(1, 0), a3, offc[0]);
            PG8_WAIT_V(8); PG8_WAIT_L(0); PG8_BAR; PG8_MMA(1, 0, At, B0); PG8_MMA(1, 1, At, B1); PG8_BAR; PG8_SCHED;
        }
        if constexpr (ALIGN_EPI) { if (wr == 0) PG8_BAR; }
        if constexpr (FP8) asm volatile("s_nop 15\n\ts_nop 15" ::: "memory");
        E(acc, cur, ui, wr, wc, fr, fq, lds);
        if (!has_next) break;
#pragma unroll
        for (int a = 0; a < 2; ++a)
#pragma unroll
            for (int b = 0; b < 2; ++b)
#pragma unroll
                for (int m = 0; m < 4; ++m)
#pragma unroll
                    for (int n = 0; n < 2; ++n) acc[a][b][m][n] = (f32x4){0.f, 0.f, 0.f, 0.f};
        cur = nxt; cA = nA; cB = nB; ++ui;
        if constexpr (ALIGN_EPI) { if (wr == 1) PG8_BAR; }
    }
    PG8_WAIT_V(0);
    if constexpr (!ALIGN_EPI) { if (wr == 0) PG8_BAR; }
    PG8_BAR;
#undef PG8_SA
#undef PG8_SB
#undef PG8_STAGE
#undef PG8_LDA
#undef PG8_LDB
#undef PG8_MMA
#undef PG8_WAIT_V
#undef PG8_WAIT_L
#undef PG8_BAR
#undef PG8_SCHED
#undef PG8_SETOFF
#undef PG8_IDXDMA
#undef PG8_CAT
}

struct EpiQKV {
    static constexpr bool MIDSCALE = false, PERM = false;
    bf16_t* O;
    __device__ __forceinline__ void prefetch(const Unit&, int, PG8_LAS unsigned char*, int, int) const {}
    __device__ __forceinline__ void operator()(const f32x4 (&acc)[2][2][4][2], const Unit& u, int ui, int wr, int wc, int fr, int fq, PG8_LAS unsigned char* lds) const {
        const bool latent = u.pm < NTOK / BM;
#pragma unroll
        for (int ai = 0; ai < 2; ++ai)
#pragma unroll
            for (int m = 0; m < 4; ++m) {
                const int row = u.pm * BM + ai * HALF + wr * 64 + m * 16 + fr;
                bf16_t* rowp = O + (size_t)row * INW + u.pn * BM + wc * 32 + 4 * fq;
                const int pos = row & (L - 1), pp = (wc & 1) ? (pos & 63) : (pos >> 6);
                PG8_LAS unsigned char* tp = lds + PAR_TAB + (pp * 16 + 4 * fq) * 8;
#pragma unroll
                for (int bj = 0; bj < 2; ++bj) {
                    const int colbase = u.pn * BM + bj * HALF;
                    f32x4 v0 = acc[ai][bj][m][0], v1 = acc[ai][bj][m][1];
                    if (latent && colbase < C_VA) {
                        const f32x4 t0 = par_f32x4(tp), t1 = par_f32x4(tp + 16);
                        const f32x4 cs = {t0.x, t0.z, t1.x, t1.z}, sn = {t0.y, t0.w, t1.y, t1.w};
                        const f32x4 a0 = v0 * cs - v1 * sn, a1 = v1 * cs + v0 * sn; v0 = a0; v1 = a1;
                    }
                    if (colbase < C_KA || (colbase >= C_QB && colbase < C_KB)) { v0 = v0 * QSCALE; v1 = v1 * QSCALE; }
                    u32x2 w0, w1; w0.x = pk2(v0.x, v0.y); w0.y = pk2(v0.z, v0.w); w1.x = pk2(v1.x, v1.y); w1.y = pk2(v1.z, v1.w);
                    *(u32x2*)(rowp + bj * HALF) = w0; *(u32x2*)(rowp + bj * HALF + 16) = w1;
                }
            }
    }
};
struct EpiOutProj {
    static constexpr bool PERM = true, MIDSCALE = true;
    bf16_t* O; const float* oss;
    __device__ __forceinline__ void prefetch(const Unit&, int, PG8_LAS unsigned char*, int, int) const {}
    __device__ __forceinline__ void begin(const Unit& u, int ui, PG8_LAS unsigned char* lds, int tid) const {
        if (tid < 256) { const f32x4* sp = (const f32x4*)(oss + (size_t)(u.pm * BM + tid) * 16); const f32x4 a0 = sp[0], a1 = sp[1], b0 = sp[2], b1 = sp[3];
            const float sa = ((a0.x + a0.y) + (a0.z + a0.w)) + ((a1.x + a1.y) + (a1.z + a1.w)), sb = ((b0.x + b0.y) + (b0.z + b0.w)) + ((b1.x + b1.y) + (b1.z + b1.w));
            const float ra = rsqrtf(sa * (1.f / 512.f) + EPS), rb = rsqrtf(sb * (1.f / 512.f) + EPS);
            typedef float f2 __attribute__((ext_vector_type(2)));
            *(PG8_LAS f2*)(lds + 131072 + (ui & 1) * 2048 + tid * 8) = (f2){ra / rb, rb}; }
    }
    __device__ __forceinline__ void mid(f32x4 (&acc)[2][2][4][2], int ui, int wr, int fr, PG8_LAS unsigned char* lds) const {
#pragma unroll
        for (int ai = 0; ai < 2; ++ai)
#pragma unroll
            for (int m = 0; m < 4; ++m) { const float r = *(const PG8_LAS float*)(lds + 131072 + (ui & 1) * 2048 + (ai * HALF + wr * 64 + m * 16 + fr) * 8);
#pragma unroll
                for (int bj = 0; bj < 2; ++bj)
#pragma unroll
                    for (int n = 0; n < 2; ++n) acc[ai][bj][m][n] = acc[ai][bj][m][n] * r; }
    }
    __device__ __forceinline__ void operator()(const f32x4 (&acc)[2][2][4][2], const Unit& u, int ui, int wr, int wc, int fr, int fq, PG8_LAS unsigned char* lds) const {
#pragma unroll
        for (int ai = 0; ai < 2; ++ai)
#pragma unroll
            for (int m = 0; m < 4; ++m) {
                const int rl = ai * HALF + wr * 64 + m * 16 + fr;
                const float rb = *(const PG8_LAS float*)(lds + 131072 + (ui & 1) * 2048 + rl * 8 + 4);
                bf16_t* rowp = O + (size_t)(u.pm * BM + rl) * D + u.pn * BM + wc * 32 + 8 * fq;
#pragma unroll
                for (int bj = 0; bj < 2; ++bj) { const f32x4 v0 = acc[ai][bj][m][0] * rb, v1 = acc[ai][bj][m][1] * rb;
                    u32x4 o; o.x = pk2(v0.x, v0.y); o.y = pk2(v0.z, v0.w); o.z = pk2(v1.x, v1.y); o.w = pk2(v1.z, v1.w);
                    *(u32x4*)(rowp + bj * HALF) = o; }
            }
    }
};
struct EpiSwiglu {
    static constexpr bool MIDSCALE = false, PERM = false;
    unsigned char* act; const float* b1;
    __device__ __forceinline__ void prefetch(const Unit& u, int pb, PG8_LAS unsigned char* lds, int wid, int lane) const {
        if (wid == 4) __builtin_amdgcn_global_load_lds((const unsigned*)(b1 + (size_t)u.e * 2048 + u.pn * BM + lane * 4), (PG8_LAS unsigned*)(lds + PAR_BASE + pb * PAR_BUF + PAR_BIAS), 16, 0, 0);
    }
    __device__ __forceinline__ void operator()(const f32x4 (&acc)[2][2][4][2], const Unit& u, int ui, int wr, int wc, int fr, int fq, PG8_LAS unsigned char* lds) const {
#pragma unroll
        for (int bj = 0; bj < 2; ++bj) {
            const int f0 = 16 * (8 * u.pn + 4 * bj + wc) + 4 * fq;
            PG8_LAS unsigned char* bp = lds + PAR_BASE + (ui & 1) * PAR_BUF + PAR_BIAS + (128 * bj + 32 * wc + 8 * fq) * 4; const f32x4 bA = par_f32x4(bp), bB = par_f32x4(bp + 16);
            const f32x4 bg = {bA.x, bA.z, bB.x, bB.z}, bl = {bA.y, bA.w, bB.y, bB.w};
#pragma unroll
            for (int ai = 0; ai < 2; ++ai)
#pragma unroll
                for (int m = 0; m < 4; ++m) {
                    const int row = u.pm * BM + ai * HALF + wr * 64 + m * 16 + fr;
                    const f32x4 gt = acc[ai][bj][m][0] * W8_INV + bg, ln = acc[ai][bj][m][1] * W8_INV + bl; float a[4];
#pragma unroll
                    for (int j = 0; j < 4; ++j) { const float gg = fminf(gt[j], 7.f), ll = fminf(fmaxf(ln[j], -7.f), 7.f);
                        a[j] = gg * __builtin_amdgcn_rcpf(1.f + __expf(-1.702f * gg)) * (ll + 1.f); }
                    *(unsigned*)(act + (size_t)row * D + f0) = pk4_fp8(a[0], a[1], a[2], a[3]);
                }
        }
    }
};
struct EpiScatter {
    static constexpr bool MIDSCALE = false, PERM = true;
    unsigned char* y; const float* b2; const int* eslot; const float* ew; const PG8_LAS int* sb;
    __device__ __forceinline__ void prefetch(const Unit& u, int pb, PG8_LAS unsigned char* lds, int wid, int lane) const {
        const int w4 = wid & 3; int rk = u.pm * BM + w4 * 64 + lane - sb[u.e]; const int cm = sb[40 + u.e] - 1; rk = rk < cm ? rk : cm;
        const size_t gi = (size_t)u.e * ECAP + rk;
        if (wid < 4) __builtin_amdgcn_global_load_lds((const unsigned*)(eslot + gi), (PG8_LAS unsigned*)(lds + PAR_BASE + pb * PAR_BUF + PAR_IDX + w4 * 256), 4, 0, 0);
        else         __builtin_amdgcn_global_load_lds((const unsigned*)(ew + gi), (PG8_LAS unsigned*)(lds + PAR_BASE + pb * PAR_BUF + PAR_W + w4 * 256), 4, 0, 0);
        if (wid == 0) __builtin_amdgcn_global_load_lds((const unsigned*)(b2 + (size_t)u.e * D + u.pn * BM + lane * 4), (PG8_LAS unsigned*)(lds + PAR_BASE + pb * PAR_BUF + PAR_BIAS), 16, 0, 0);
    }
    __device__ __forceinline__ void operator()(const f32x4 (&acc)[2][2][4][2], const Unit& u, int ui, int wr, int wc, int fr, int fq, PG8_LAS unsigned char* lds) const {
        PG8_LAS unsigned char* par = lds + PAR_BASE + (ui & 1) * PAR_BUF;
        const int col0 = u.pn * BM + wc * 32 + 8 * fq;
        f32x4 bv[2][2];
#pragma unroll
        for (int bj = 0; bj < 2; ++bj)
#pragma unroll
            for (int n = 0; n < 2; ++n) bv[bj][n] = par_f32x4(par + PAR_BIAS + (wc * 32 + 8 * fq + bj * HALF + 4 * n) * 4);
        const int rbase = u.pm * BM - sb[u.e], cn = sb[40 + u.e];
#pragma unroll
        for (int ai = 0; ai < 2; ++ai)
#pragma unroll
            for (int m = 0; m < 4; ++m) {
                const int rl = ai * HALF + wr * 64 + m * 16 + fr;
                const int slot = par_i32(par + PAR_IDX + rl * 4); const float w = par_f32(par + PAR_W + rl * 4) * Y8_SCALE;
                if (rbase + rl < cn) {
                    unsigned char* rowp = y + (size_t)slot * D + col0;
#pragma unroll
                    for (int bj = 0; bj < 2; ++bj) { const f32x4 v0 = (acc[ai][bj][m][0] * W8_INV + bv[bj][0]) * w, v1 = (acc[ai][bj][m][1] * W8_INV + bv[bj][1]) * w;
                        u32x2 o; o.x = pk4_fp8(v0.x, v0.y, v0.z, v0.w); o.y = pk4_fp8(v1.x, v1.y, v1.z, v1.w);
                        *(u32x2*)(rowp + bj * HALF) = o; }
                }
            }
    }
};
}

__device__ void p0_mod(const Params& p, float* sS  , float* sP  , int wv) {
    float* mod = (float*)(p.ws + WS_MOD);
    const int tid = tid_opaque(wv), lane = tid & 63, wave = wv;
    if (blockIdx.x >= 96) return;
    for (int i = tid; i < 9 * D; i += NTHREADS) { const int r = i >> 10, k = i & 1023; const float cc = r < 8 ? p.c[r * D + k] : p.c_ctx[k]; sS[i] = cc / (1.f + __expf(-cc)); }
    __syncthreads();
    const int j = blockIdx.x * 64 + lane;
    float acc[9];
#pragma unroll
    for (int r = 0; r < 9; ++r) acc[r] = 0.f;
    const float* wp = p.w_ada + (size_t)(wave * 128) * 6144 + j;
#pragma unroll 1
    for (int k0 = 0; k0 < 128; k0 += 16) {
        float w[16];
#pragma unroll
        for (int kk = 0; kk < 16; ++kk) w[kk] = wp[(size_t)(k0 + kk) * 6144];
#pragma unroll
        for (int kk = 0; kk < 16; ++kk)
#pragma unroll
            for (int r = 0; r < 9; ++r) acc[r] = fmaf(sS[r * D + wave * 128 + k0 + kk], w[kk], acc[r]);
    }
#pragma unroll
    for (int r = 0; r < 9; ++r) sP[(wave * 9 + r) * 64 + lane] = acc[r];
    __syncthreads();
    for (int i = tid; i < 9 * 64; i += NTHREADS) { const int r = i >> 6, jj = i & 63; float s = p.b_ada[blockIdx.x * 64 + jj];
#pragma unroll
        for (int w = 0; w < 8; ++w) s += sP[(w * 9 + r) * 64 + jj];
        mod[r * 6144 + blockIdx.x * 64 + jj] = s; }
    __syncthreads();
}
__device__ void p0_tab(const Params& p, int wv) {
    float* tab = (float*)(p.ws + WS_TAB);
    const int gtid = blockIdx.x * NTHREADS + tid_opaque(wv), gsize = gridDim.x * NTHREADS;
    for (int idx = gtid; idx < 64 * 16; idx += gsize) {
        const int pos = idx >> 4, i = idx & 15;
        const float freq = exp2f(-(float)i * (13.287712379549449f / 16.f));
        const float ang = (float)pos * freq;
        const float n = rintf(ang * 0.15915494309189535f);
        float r = fmaf(-n, 6.28125f, ang); r = fmaf(-n, 1.9353071795864769e-3f, r);
        tab[idx * 2] = __cosf(r); tab[idx * 2 + 1] = __sinf(r);
    }
}
template <int MODE>
__device__ __forceinline__ void conv_item(const float* src, int K, int N, bf16_t* dst, int item, float* scr, int lane, const float* gA, const float* gB) {
    const int nblk = N / 32, kb = item / nblk, nb = item % nblk, k0 = 64 * kb, n0 = 32 * nb;
    const int c = lane & 31, kh = lane >> 5;
    const int nl = MODE == 1 ? 16 * (c & 1) + (c >> 1) : c;
    float v[32];
    const float* sp = src + (size_t)(k0 + kh) * N + n0 + c;
#pragma unroll
    for (int i = 0; i < 32; ++i) v[i] = sp[(size_t)(2 * i) * N];
#pragma unroll
    for (int i = 0; i < 32; ++i) { float x = v[i]; if (MODE == 2) { const int k = k0 + 2 * i + kh; x *= (k < 512 ? gA[k] : gB[k - 512]); } scr[(2 * i + kh) * 33 + nl] = x; }
    asm volatile("s_waitcnt lgkmcnt(0)" ::: "memory");
    const int ch = lane & 7;
#pragma unroll
    for (int j = 0; j < 4; ++j) { const int n = (lane >> 3) + 8 * j; const float* s = scr + (8 * ch) * 33 + n;
        u32x4 o; o.x = pk2(s[0 * 33], s[1 * 33]); o.y = pk2(s[2 * 33], s[3 * 33]); o.z = pk2(s[4 * 33], s[5 * 33]); o.w = pk2(s[6 * 33], s[7 * 33]);
        *(u32x4*)(dst + (size_t)(n0 + n) * K + k0 + 8 * ch) = o; }
    asm volatile("s_waitcnt lgkmcnt(0)" ::: "memory");
}
template <bool PERM1>
__device__ __forceinline__ void conv_item8(const float* src, int K, int N, unsigned char* dst, int item, float* scr, int lane) {
    const int nblk = N / 32, kb = item / nblk, nb = item % nblk, k0 = 64 * kb, n0 = 32 * nb;
    const int c = lane & 31, kh = lane >> 5;
    const int nl = PERM1 ? 16 * (c & 1) + (c >> 1) : c;
    float v[32];
    const float* sp = src + (size_t)(k0 + kh) * N + n0 + c;
#pragma unroll
    for (int i = 0; i < 32; ++i) v[i] = sp[(size_t)(2 * i) * N];
#pragma unroll
    for (int i = 0; i < 32; ++i) scr[(2 * i + kh) * 33 + nl] = v[i] * W8_SCALE;
    asm volatile("s_waitcnt lgkmcnt(0)" ::: "memory");
    const int ch = lane & 3;
#pragma unroll
    for (int j = 0; j < 2; ++j) { const int n = (lane >> 2) + 16 * j; const float* s = scr + (16 * ch) * 33 + n;
        u32x4 o; o.x = pk4_fp8(s[0 * 33], s[1 * 33], s[2 * 33], s[3 * 33]); o.y = pk4_fp8(s[4 * 33], s[5 * 33], s[6 * 33], s[7 * 33]);
        o.z = pk4_fp8(s[8 * 33], s[9 * 33], s[10 * 33], s[11 * 33]); o.w = pk4_fp8(s[12 * 33], s[13 * 33], s[14 * 33], s[15 * 33]);
        *(u32x4*)(dst + (size_t)(n0 + n) * K + k0 + 16 * ch) = o; }
    asm volatile("s_waitcnt lgkmcnt(0)" ::: "memory");
}
__device__ void p0_weights(const Params& p, unsigned char* ldsb, int wv) {
    const int tid = tid_opaque(wv), lane = tid & 63, wave = wv; float* scr = (float*)(ldsb + 57344 + wave * 8448);
    const int gw = blockIdx.x * (NTHREADS / 64) + wave, ngw = gridDim.x * (NTHREADS / 64);
    constexpr int I_IN = 16 * 72, I_OUT = 16 * 32;
    constexpr int NITEMS = I_IN + I_OUT;
    for (int it = gw; it < NITEMS; it += ngw) {
        int r = it;
        if (r < I_IN) { conv_item<0>(p.w_in, D, INW, (bf16_t*)(p.ws + WS_WIN), r, scr, lane, nullptr, nullptr); continue; } r -= I_IN;
        conv_item<2>(p.w_out, D, D, (bf16_t*)(p.ws + WS_WOUT), r, scr, lane, p.g_grp_a, p.g_grp_b);
    }
}

__device__ void p1_h(const Params& p, int wv) {
    const int tid = tid_opaque(wv), lane = tid & 63;
    const float* mod = (const float*)(p.ws + WS_MOD);
    bf16_t* hb = (bf16_t*)(p.ws + WS_HB);
    constexpr int R = 17;
    const int gwv = blockIdx.x * (NTHREADS / 64) + (tid >> 6);
    const int m0 = gwv * R; if (m0 >= MROWS) return;
    const int m1 = m0 + R < MROWS ? m0 + R : MROWS;
    f32x4 pB[4], pC[4], v[4], nv[4]; int curb = -1;
#define P1_ROWPTR(m) ((m) < NTOK ? p.x + (size_t)(m) * D : p.ctx + (size_t)((m) - NTOK) * D)
    { const float* xr = P1_ROWPTR(m0);
#pragma unroll
      for (int j = 0; j < 4; ++j) nv[j] = ((const f32x4*)xr)[lane + 64 * j]; }
    for (int m = m0; m < m1; ++m) {
#pragma unroll
        for (int j = 0; j < 4; ++j) v[j] = nv[j];
        if (m + 1 < m1) { const float* xr = P1_ROWPTR(m + 1);
#pragma unroll
            for (int j = 0; j < 4; ++j) nv[j] = ((const f32x4*)xr)[lane + 64 * j]; }
        const int b = m < NTOK ? m / L : 8;
        if (b != curb) { curb = b; const float* sh = mod + b * 6144, * sc = sh + 1024;
#pragma unroll
            for (int j = 0; j < 4; ++j) { const int c0 = 4 * (lane + 64 * j); pB[j] = *(const f32x4*)(p.g_pre_mix + c0) * (*(const f32x4*)(sc + c0) + 1.f); pC[j] = *(const f32x4*)(sh + c0); } }
        float s = 0.f;
#pragma unroll
        for (int j = 0; j < 4; ++j) s += v[j].x * v[j].x + v[j].y * v[j].y + v[j].z * v[j].z + v[j].w * v[j].w;
        const float rstd = rsqrtf(wave_sum(s) * (1.f / D) + EPS);
#pragma unroll
        for (int j = 0; j < 4; ++j) { const int c0 = 4 * (lane + 64 * j);
            const f32x4 o = (v[j] * rstd) * pB[j] + pC[j];
            u32x2 w; w.x = pk2(o.x, o.y); w.y = pk2(o.z, o.w);
            *(u32x2*)(hb + (size_t)m * D + c0) = w; }
    }
#undef P1_ROWPTR
}

namespace att {
#define ATT_LAS __attribute__((address_space(3)))
typedef float f32x16 __attribute__((ext_vector_type(16)));
typedef short bf16x8 __attribute__((ext_vector_type(8)));
typedef short s16x4 __attribute__((ext_vector_type(4)));
constexpr int SLOTB = 8192, NSLOT = 4;
constexpr int LDS_K = 0, LDS_V = NSLOT * SLOTB, LDS_WS = 2 * NSLOT * SLOTB, LDS_BT = LDS_WS + 8 * 256;
constexpr int BT_MARGIN = 128, BT_FLOATS = BT_MARGIN + 15 * 32 + 128;
constexpr float NEGBIG = -1e30f;
__device__ __forceinline__ int crow(int r, int hi) { return (r & 3) + 8 * (r >> 2) + 4 * hi; }
__device__ __forceinline__ unsigned cvtpk(float lo, float hi) { typedef float f2 __attribute__((ext_vector_type(2))); typedef __bf16 b2 __attribute__((ext_vector_type(2)));
    f2 v = {lo, hi}; b2 b = __builtin_convertvector(v, b2); return __builtin_bit_cast(unsigned, b); }
__device__ __forceinline__ s16x4 vtr(const ATT_LAS unsigned char* p) { typedef short v4i16 __attribute__((ext_vector_type(4)));
    return __builtin_bit_cast(s16x4, __builtin_amdgcn_ds_read_tr16_b64_v4i16((ATT_LAS v4i16*)p)); }
#define ATT_WAIT_BAR(N) asm volatile("s_waitcnt vmcnt(" #N ") lgkmcnt(0)\n\ts_barrier" ::: "memory")

constexpr int LDS_CV = 71680, CV_WAVE = 8448;
static_assert(LDS_BT + BT_FLOATS * 4 <= LDS_CV && LDS_CV + 8 * CV_WAVE <= 147456, "attention LDS map");
constexpr int CV_W1 = 16 * 64, CV_W2 = 16 * 32, CV_ITEMS = NE * (CV_W1 + CV_W2);
struct ConvJob { int it, end; };
__device__ __forceinline__ void cv_load(const Params& p, int it, int lane, float (&v)[32], unsigned char*& dlane, int& nl) {
    const float* src; unsigned char* dst; int N, q; bool perm;
    if (it < NE * CV_W1) { const int e = it / CV_W1; q = it % CV_W1; src = p.w_mlp1 + (size_t)e * D * 2048; dst = p.ws + WS_W1 + (size_t)e * 2048 * D; N = 2048; perm = true; }
    else { const int r = it - NE * CV_W1, e = r / CV_W2; q = r % CV_W2; src = p.w_mlp2 + (size_t)e * D * D; dst = p.ws + WS_W2 + (size_t)e * D * D; N = D; perm = false; }
    const int nblk = N / 32, k0 = 64 * (q / nblk), n0 = 32 * (q % nblk);
    const float* sp = src + (size_t)(k0 + (lane >> 5)) * N + n0 + (lane & 31);
#pragma unroll
    for (int i = 0; i < 32; ++i) v[i] = sp[(size_t)(2 * i) * N];
    const int cc = lane & 31; nl = perm ? 16 * (cc & 1) + (cc >> 1) : cc;
    dlane = dst + (size_t)(n0 + (lane >> 2)) * D + k0 + 16 * (lane & 3);
}
__device__ __forceinline__ void cv_store(int lane, float (&v)[32], unsigned char* dlane, int nl, ATT_LAS float* scr) {
    const int kh = lane >> 5;
#pragma unroll
    for (int i = 0; i < 32; ++i) asm volatile("" : "+v"(v[i]));
#pragma unroll
    for (int i = 0; i < 32; ++i) scr[(2 * i + kh) * 33 + nl] = v[i] * W8_SCALE;
    asm volatile("s_waitcnt lgkmcnt(0)" ::: "memory");
    const int ch = lane & 3;
#pragma unroll
    for (int j = 0; j < 2; ++j) { const int n = (lane >> 2) + 16 * j; const ATT_LAS float* s = scr + (16 * ch) * 33 + n;
        u32x4 o; o.x = pk4_fp8(s[0 * 33], s[1 * 33], s[2 * 33], s[3 * 33]); o.y = pk4_fp8(s[4 * 33], s[5 * 33], s[6 * 33], s[7 * 33]);
        o.z = pk4_fp8(s[8 * 33], s[9 * 33], s[10 * 33], s[11 * 33]); o.w = pk4_fp8(s[12 * 33], s[13 * 33], s[14 * 33], s[15 * 33]);
        *(u32x4*)(dlane + (size_t)j * 16 * D) = o; }
    asm volatile("s_waitcnt lgkmcnt(0)" ::: "memory");
}

__device__ __forceinline__ void dma_tile(ATT_LAS unsigned char* lds, int slot, const bf16_t* kbase, const bf16_t* vbase, int wid, int lane) {
    const bf16_t* ksrc = kbase + (size_t)lane * INW + wid * 8;
    const bf16_t* vsrc = vbase + (size_t)(16 * (wid & 3) + (lane >> 2)) * INW + (wid >> 2) * 32 + (lane & 3) * 8;
    __builtin_amdgcn_global_load_lds((const unsigned*)ksrc, (ATT_LAS unsigned*)(lds + LDS_K + slot * SLOTB + wid * 1024), 16, 0, 0);
    __builtin_amdgcn_global_load_lds((const unsigned*)vsrc, (ATT_LAS unsigned*)(lds + LDS_V + slot * SLOTB + wid * 1024), 16, 0, 0);
}

template <bool ISB>
__device__ __forceinline__ void attn_unit(const Params& p, ATT_LAS unsigned char* lds, int unit, int wv, ConvJob& cj) {
    const int tid = tid_opaque(wv), lane = tid & 63, r32 = lane & 31, hi = lane >> 5; const int wid = wv;
    const bf16_t* qkv = (const bf16_t*)(p.ws + WS_QKV); bf16_t* ob = (bf16_t*)(p.ws + WS_O);
    ATT_LAS float* wsf = (ATT_LAS float*)(lds + LDS_WS) + wid * 64;
    ATT_LAS float* bt = (ATT_LAS float*)(lds + LDS_BT);
    ATT_LAS float* cvscr = (ATT_LAS float*)(lds + LDS_CV + wid * CV_WAVE);
    int b, h, kcol, vcol, qcol, ocol, q0, nloc, row_lo = 0, qr = 0, half = 0, qb = 0, jlo = 0;
    if (!ISB) { b = unit >> 7; const int kvh = (unit >> 6) & 1; qb = unit & 63; h = kvh * 4 + (wid >> 1); half = wid & 1; q0 = qb * 64 + 32 * half;
        kcol = C_KA + kvh * 64; vcol = C_VA + kvh * 64; qcol = C_QA + h * 64; ocol = h * 64;
        jlo = 2 - qb > 0 ? 2 - qb : 0; const int jhi = 65 - qb < 4 ? 65 - qb : 4; nloc = jhi - jlo + 1;
    } else { b = unit >> 7; h = (unit >> 4) & 7; const int g = unit & 15;
        qr = 4 * g + 2 * (wid >> 2) + (r32 >> 4); half = wid & 3; q0 = 0;
        kcol = C_KB + h * 64; vcol = C_VB + h * 64; qcol = C_QB + h * 64; ocol = 512 + h * 64;
        const int r0 = 4 * g, r3 = 4 * g + 3; row_lo = r0 - 4 < 0 ? 0 : (r0 - 4 > 56 ? 56 : r0 - 4); const int rs3 = r3 - 4 < 0 ? 0 : (r3 - 4 > 56 ? 56 : r3 - 4); nloc = rs3 + 7 - row_lo + 1;
    }
    const int NT = nloc + 4;
    const bf16_t* lat = qkv + (size_t)b * L * INW; const bf16_t* cx = qkv + (size_t)(NTOK + b * CTX) * INW;
#define ATT_TILE_ROW(t) ((t) < nloc ? lat + (size_t)(ISB ? (row_lo + (t)) * 64 : (qb - 2 + jlo + (t)) * 64) * INW : cx + (size_t)((t) - nloc) * 64 * INW)
    const int rsq = qr - 4 < 0 ? 0 : (qr - 4 > 56 ? 56 : qr - 4);
    const int qrw = 4 * (unit & 15) + 2 * (wid >> 2);
    const int lo_w = qrw - 4 < 0 ? 0 : (qrw - 4 > 56 ? 56 : qrw - 4), hi_w = (qrw - 3 < 0 ? 0 : (qrw - 3 > 56 ? 56 : qrw - 3)) + 7;
    const int bs = ISB ? (half == 0 ? 0 : half == 1 ? 8 : half == 2 ? 24 : 32) : 0;
#define ATT_ACTIVE(t) (!(ISB && (t) < nloc) || ((row_lo + (t) >= lo_w) && (row_lo + (t) <= hi_w)))
    if (ISB) {
        for (int i = tid; i < BT_FLOATS; i += NTHREADS) { const int j = i - BT_MARGIN; float v = 0.f;
            if (j >= 0 && j < 15 * 32 && (j & 31) < 31) v = p.rpb_b[(h * 15 + (j >> 5)) * 31 + (j & 31)] * LOG2E;
            bt[i] = v; }
    }
#pragma unroll
    for (int t0 = 0; t0 < NSLOT - 1; ++t0) { const bf16_t* r0p = ATT_TILE_ROW(t0); dma_tile(lds, t0, r0p + kcol, r0p + vcol, wid, lane); }
    bf16x8 qf[4];
    const int qc = ISB ? 16 * half + (r32 & 15) : 32 * half + r32;
    { const bf16_t* qp = lat + (size_t)(ISB ? qr * 64 + qc : q0 + r32) * INW + qcol + hi * 8;
#pragma unroll
      for (int d0 = 0; d0 < 4; ++d0) qf[d0] = *(const bf16x8*)(qp + d0 * 16); }
    float mref = 0.f, l_run = 0.f;
    if (!ISB) l_run = hi == 0 ? __builtin_amdgcn_exp2f(p.sink_a[h] * LOG2E) : 0.f;
    f32x16 o0, o1, negm;
#pragma unroll
    for (int r = 0; r < 16; ++r) { o0[r] = 0.f; o1[r] = 0.f; negm[r] = 0.f; }
    const int cs = qc - 8 < 0 ? 0 : (qc - 8 > 48 ? 48 : qc - 8);
    f32x16 pc0, pc1, pn0, pn1; float ref_cur = 0.f, ref_next = 0.f; bool act_cur = false, act_next = false;
#pragma unroll
    for (int r = 0; r < 16; ++r) { pn0[r] = 0.f; pn1[r] = 0.f; }
#define ATT_QK(SLOT, LOCB) do { const ATT_LAS unsigned char* kb_ = lds + LDS_K + (SLOT) * SLOTB + hi * 1024 + r32 * 16; \
        if (LOCB) { _Pragma("unroll") for (int d0 = 0; d0 < 4; ++d0) { \
            const bf16x8 k0_ = *(const ATT_LAS bf16x8*)(kb_ + bs * 16 + d0 * 2048); \
            pn0 = __builtin_amdgcn_mfma_f32_32x32x16_bf16(k0_, qf[d0], d0 == 0 ? negm : pn0, 0, 0, 0); } } \
        else { _Pragma("unroll") for (int d0 = 0; d0 < 4; ++d0) { \
            const bf16x8 k0_ = *(const ATT_LAS bf16x8*)(kb_ + d0 * 2048), k1_ = *(const ATT_LAS bf16x8*)(kb_ + d0 * 2048 + 512); \
            pn0 = __builtin_amdgcn_mfma_f32_32x32x16_bf16(k0_, qf[d0], d0 == 0 ? negm : pn0, 0, 0, 0); \
            pn1 = __builtin_amdgcn_mfma_f32_32x32x16_bf16(k1_, qf[d0], d0 == 0 ? negm : pn1, 0, 0, 0); } } } while (0)
    ATT_WAIT_BAR(4);
    act_next = ATT_ACTIVE(0);
    if (act_next) { ATT_QK(0, ISB); ref_next = mref; }
    int sc = 0, sn = 1, si = NSLOT - 1;
    for (int t = 0; t < NT; ++t) {
        const int ahead = NT - 2 - t < 0 ? 0 : (NT - 2 - t < NSLOT - 3 ? NT - 2 - t : NSLOT - 3);
        if (ahead == 1) ATT_WAIT_BAR(2); else ATT_WAIT_BAR(0);
        float cvv[32]; unsigned char* cvd = nullptr; int cvn = 0; const bool cvgo = cj.it < cj.end;
        if (cvgo) { cv_load(p, cj.it, lane, cvv, cvd, cvn); cj.it += NTHREADS / 64; }
        if (t + NSLOT - 1 < NT) { const bf16_t* rp = ATT_TILE_ROW(t + NSLOT - 1); dma_tile(lds, si, rp + kcol, rp + vcol, wid, lane); }
        pc0 = pn0; pc1 = pn1; ref_cur = ref_next; act_cur = act_next;
        act_next = (t + 1 < NT) && ATT_ACTIVE(t + 1);
        if (act_next) { if (ISB && t + 1 < nloc) ATT_QK(sn, true); else ATT_QK(sn, false); ref_next = mref; }
        if (act_cur) {
            if (ISB) {
                if (t < nloc) {
                    const int kr = row_lo + t;
                    const ATT_LAS float* bp = bt + BT_MARGIN + (kr - qr + 7) * 32 + 15 - qc + bs + 4 * hi;
                    const int e0 = ((kr >= rsq) && (kr <= rsq + 7)) ? bs + 4 * hi - cs : 0x4000;
#pragma unroll
                    for (int r = 0; r < 16; ++r) { const int c = (r & 3) + 8 * (r >> 2);
                        const float b0 = bp[c];
                        pc0[r] = ((unsigned)(c + e0) < 16u) ? pc0[r] + b0 : NEGBIG; }
                }
            } else {
                if (t < nloc) { const int j = jlo + t; const int qq = 32 * half + r32;
                    if (j == 0) {
#pragma unroll
                        for (int r = 0; r < 16; ++r) { const int c = crow(r, hi); if (c < qq) pc0[r] = NEGBIG; if (c + 32 < qq) pc1[r] = NEGBIG; }
                    } else if (j == 4) {
#pragma unroll
                        for (int r = 0; r < 16; ++r) { const int c = crow(r, hi); if (c > qq) pc0[r] = NEGBIG; if (c + 32 > qq) pc1[r] = NEGBIG; }
                    }
                }
            }
            const bool locb = ISB && (t < nloc);
            float rm;
            if (locb) { rm = fmaxf(pc0[0], pc0[1]);
#pragma unroll
                for (int r = 2; r < 16; r += 2) rm = fmaxf(fmaxf(rm, pc0[r]), pc0[r + 1]); }
            else { rm = fmaxf(pc0[0], pc1[0]);
#pragma unroll
                for (int r = 1; r < 16; ++r) rm = fmaxf(fmaxf(rm, pc0[r]), pc1[r]); }
            rm = fmaxf(rm, __shfl_xor(rm, 32));
            const float delta = mref - ref_cur;
            constexpr float RESC_THR = 8.f;
            const float dl = __any(rm - delta > RESC_THR) ? fmaxf(rm - delta, 0.f) : 0.f;
            const float sh = delta + dl;
            if (__any(dl > 0.f)) {
                const float f = __builtin_amdgcn_exp2f(-dl);
                l_run *= f; mref += dl;
                if (hi == 0) wsf[r32] = f;
                asm volatile("s_waitcnt lgkmcnt(0)" ::: "memory");
#pragma unroll
                for (int r = 0; r < 16; ++r) { const float fr_ = wsf[crow(r, hi)]; o0[r] *= fr_; o1[r] *= fr_; negm[r] = -mref; }
            }
            if (__any(sh != 0.f)) {
#pragma unroll
                for (int r = 0; r < 16; ++r) { pc0[r] -= sh; pc1[r] -= sh; }
            }
            float ls = 0.f, ls2 = 0.f;
#pragma unroll
            for (int r = 0; r < 16; r += 2) { pc0[r] = __builtin_amdgcn_exp2f(pc0[r]); pc0[r + 1] = __builtin_amdgcn_exp2f(pc0[r + 1]); ls += pc0[r]; ls2 += pc0[r + 1]; }
            if (!locb) {
#pragma unroll
                for (int r = 0; r < 16; r += 2) { pc1[r] = __builtin_amdgcn_exp2f(pc1[r]); pc1[r + 1] = __builtin_amdgcn_exp2f(pc1[r + 1]); ls += pc1[r]; ls2 += pc1[r + 1]; }
            }
            l_run += ls + ls2;
            typedef unsigned u4 __attribute__((ext_vector_type(4)));
            const u4 pw0 = {cvtpk(pc0[0], pc0[1]), cvtpk(pc0[2], pc0[3]), cvtpk(pc0[4], pc0[5]), cvtpk(pc0[6], pc0[7])};
            const u4 pw1 = {cvtpk(pc0[8], pc0[9]), cvtpk(pc0[10], pc0[11]), cvtpk(pc0[12], pc0[13]), cvtpk(pc0[14], pc0[15])};
            const ATT_LAS unsigned char* vp = lds + LDS_V + sc * SLOTB + ((lane >> 4) & 1) * 32 + (lane & 3) * 8 + (4 * hi + ((lane & 15) >> 2)) * 64 + (locb ? bs * 64 : 0);
#define ATT_PV(OACC, PW, D0, KS) do { const s16x4 lo_ = vtr(vp + (D0) * 4096 + (KS) * 1024), hi_ = vtr(vp + (D0) * 4096 + (KS) * 1024 + 512); \
                const bf16x8 vf_ = {lo_[0], lo_[1], lo_[2], lo_[3], hi_[0], hi_[1], hi_[2], hi_[3]}; \
                OACC = __builtin_amdgcn_mfma_f32_32x32x16_bf16(__builtin_bit_cast(bf16x8, PW), vf_, OACC, 0, 0, 0); } while (0)
            ATT_PV(o0, pw0, 0, 0); ATT_PV(o1, pw0, 1, 0); ATT_PV(o0, pw1, 0, 1); ATT_PV(o1, pw1, 1, 1);
            if (!locb) {
                const u4 pw2 = {cvtpk(pc1[0], pc1[1]), cvtpk(pc1[2], pc1[3]), cvtpk(pc1[4], pc1[5]), cvtpk(pc1[6], pc1[7])};
                const u4 pw3 = {cvtpk(pc1[8], pc1[9]), cvtpk(pc1[10], pc1[11]), cvtpk(pc1[12], pc1[13]), cvtpk(pc1[14], pc1[15])};
                ATT_PV(o0, pw2, 0, 2); ATT_PV(o1, pw2, 1, 2); ATT_PV(o0, pw3, 0, 3); ATT_PV(o1, pw3, 1, 3);
            }
#undef ATT_PV
        }
        if (cvgo) cv_store(lane, cvv, cvd, cvn, cvscr);
        sc = sn; sn = sn + 1 == NSLOT ? 0 : sn + 1; si = si + 1 == NSLOT ? 0 : si + 1;
    }
    l_run += __shfl_xor(l_run, 32);
    if (hi == 0) wsf[32 + r32] = l_run;
    asm volatile("s_waitcnt lgkmcnt(0)" ::: "memory");
    bf16_t* op = ob + (size_t)(b * L) * D + ocol + r32;
    float* ossp = (float*)(p.ws + WS_OSS) + (size_t)(b * L) * 16 + (ocol >> 6);
#pragma unroll
    for (int r = 0; r < 16; ++r) { const int qi = crow(r, hi); const float inv = __builtin_amdgcn_rcpf(wsf[32 + qi]);
        const int q = ISB ? (qrw + (qi >> 4)) * 64 + 16 * half + (qi & 15) : q0 + qi;
        const float a0 = o0[r] * inv, a1 = o1[r] * inv;
        op[(size_t)q * D] = (bf16_t)f2bf(a0); op[(size_t)q * D + 32] = (bf16_t)f2bf(a1);
        const float ss = row_sum16(a0 * a0 + a1 * a1);
        const float s01 = rdlane(ss, 0) + rdlane(ss, 16), s23 = rdlane(ss, 32) + rdlane(ss, 48);
        if (r32 == 0) ossp[(size_t)q * 16] = hi ? s23 : s01; }
    ATT_WAIT_BAR(0);
#undef ATT_TILE_ROW
#undef ATT_ACTIVE
#undef ATT_QK
}

__device__ __forceinline__ void attn_phase(const Params& p, ATT_LAS unsigned char* lds, int wv) {
    const int G = gridDim.x, bx = blockIdx.x;
    const int vcu = (G % 8 == 0) ? (bx % 8) * (G / 8) + bx / 8 : bx;
    const int per_blk = (CV_ITEMS + G - 1) / G;
    ConvJob cj; cj.it = bx * per_blk + wv; cj.end = (bx + 1) * per_blk < CV_ITEMS ? (bx + 1) * per_blk : CV_ITEMS;
    for (int u = vcu; u < 2048; u += G) {
        if (u < 1024) attn_unit<false>(p, lds, u, wv, cj); else attn_unit<true>(p, lds, u - 1024, wv, cj);
    }
    { const int lane = lane_id(); float cvv[32]; ATT_LAS float* cvscr = (ATT_LAS float*)(lds + LDS_CV + wv * CV_WAVE);
      unsigned char* cvd; int cvn;
      while (cj.it < cj.end) { cv_load(p, cj.it, lane, cvv, cvd, cvn); cv_store(lane, cvv, cvd, cvn, cvscr); cj.it += NTHREADS / 64; } }
}
}

constexpr int SW_STRIDE = 36;

__device__ void p4c_post(const Params& p, LAS3 float* sW, int wv) {
    const int tid = tid_opaque(wv), lane = tid & 63;
    const float* mod = (const float*)(p.ws + WS_MOD); const bf16_t* mix = (const bf16_t*)(p.ws + WS_MIX);
    unsigned char* h8 = p.ws + WS_HB;
    unsigned* counts = (unsigned*)(p.ws + WS_CTL);
    int* eslot = (int*)(p.ws + WS_ESLOT); float* ew = (float*)(p.ws + WS_EW);
    const int wave = tid >> 6;
    LAS3 int* lcnt = (LAS3 int*)(sW + 1024 * SW_STRIDE) + 128;
    LAS3 int* lbase = lcnt + 32;
    LAS3 int* stg_slot = lbase + 32; LAS3 int* stg_e = stg_slot + 512; LAS3 float* stg_w = (LAS3 float*)(stg_e + 512);
    if (tid < NE) lcnt[tid] = 0;
    for (int i = tid; i < D * 8; i += NTHREADS) { const int k = i >> 3, e4 = i & 7; const f32x4 w = ((const f32x4*)p.w_router)[i];
        LAS3 float* d = sW + ((k & 3) * 256 + (k >> 2)) * SW_STRIDE + e4 * 4; *(LAS3 f32x4*)d = w; }
    __syncthreads();
    constexpr int R = 16;
    const int m0 = ((int)blockIdx.x * (NTHREADS / 64) + wave) * R;
    if (m0 < NTOK) {
        const int b = m0 / L; const float* mb = mod + b * 6144;
        f32x4 pA[4], pB[4], pC[4], v[4], xx[4], nx[4]; u32x2 nv[4];
#pragma unroll
        for (int j = 0; j < 4; ++j) { const int c0 = 4 * (lane + 64 * j);
            pA[j] = *(const f32x4*)(p.g_post_mix + c0) * *(const f32x4*)(mb + 2048 + c0);
            pB[j] = *(const f32x4*)(p.g_pre_ffn + c0) * (*(const f32x4*)(mb + 4096 + c0) + 1.f);
            pC[j] = *(const f32x4*)(mb + 3072 + c0);
            nv[j] = ((const u32x2*)(mix + (size_t)m0 * D))[lane + 64 * j]; nx[j] = ((const f32x4*)(p.x + (size_t)m0 * D))[lane + 64 * j]; }
        const float brt0 = p.b_router[lane & 15], brt1 = p.b_router[16 + (lane & 15)];
#pragma unroll 1
        for (int it = 0; it < R; ++it) {
            const int m = m0 + it;
#pragma unroll
            for (int j = 0; j < 4; ++j) { v[j] = (f32x4){__uint_as_float(nv[j].x << 16), __uint_as_float(nv[j].x & 0xffff0000u), __uint_as_float(nv[j].y << 16), __uint_as_float(nv[j].y & 0xffff0000u)}; xx[j] = nx[j]; }
            if (it + 1 < R) {
#pragma unroll
                for (int j = 0; j < 4; ++j) { nv[j] = ((const u32x2*)(mix + (size_t)(m + 1) * D))[lane + 64 * j]; nx[j] = ((const f32x4*)(p.x + (size_t)(m + 1) * D))[lane + 64 * j]; }
            }
            float s = 0.f;
#pragma unroll
            for (int j = 0; j < 4; ++j) s += v[j].x * v[j].x + v[j].y * v[j].y + v[j].z * v[j].z + v[j].w * v[j].w;
            float rstd = rsqrtf(wave_sum(s) * (1.f / D) + EPS);
            s = 0.f;
            f32x4 xv[4];
#pragma unroll
            for (int j = 0; j < 4; ++j) {
                xv[j] = xx[j] + pA[j] * (v[j] * rstd);
                ((f32x4*)(p.out + (size_t)m * D))[lane + 64 * j] = xv[j];
                s += xv[j].x * xv[j].x + xv[j].y * xv[j].y + xv[j].z * xv[j].z + xv[j].w * xv[j].w; }
            rstd = rsqrtf(wave_sum(s) * (1.f / D) + EPS);
            f32x4 h2v[4];
#pragma unroll
            for (int j = 0; j < 4; ++j) { const int c0 = 4 * (lane + 64 * j);
                h2v[j] = (xv[j] * rstd) * pB[j] + pC[j];
                *(unsigned*)(h8 + (size_t)m * D + c0) = pk4_fp8(h2v[j].x, h2v[j].y, h2v[j].z, h2v[j].w); }
            const int li = lane & 15;
            unsigned lrow = (unsigned)lane * (SW_STRIDE * 4); asm volatile("" : "+v"(lrow));
            float zz[2];
#pragma unroll
            for (int ps = 0; ps < 2; ++ps) {
                float lg[16];
#pragma unroll
                for (int e = 0; e < 16; ++e) lg[e] = 0.f;
#pragma unroll
                for (int j = 0; j < 4; ++j)
#pragma unroll
                    for (int q = 0; q < 4; ++q) { const float hv = h2v[j][q]; const LAS3 f32x4* wr = (const LAS3 f32x4*)((LAS3 unsigned char*)sW + (lrow + (unsigned)((q * 256 + 64 * j) * SW_STRIDE * 4 + ps * 64)));
#pragma unroll
                        for (int e4 = 0; e4 < 4; ++e4) { const f32x4 ww = wr[e4]; lg[e4 * 4] = fmaf(hv, ww.x, lg[e4 * 4]); lg[e4 * 4 + 1] = fmaf(hv, ww.y, lg[e4 * 4 + 1]); lg[e4 * 4 + 2] = fmaf(hv, ww.z, lg[e4 * 4 + 2]); lg[e4 * 4 + 3] = fmaf(hv, ww.w, lg[e4 * 4 + 3]); }
                        asm volatile("" : "+v"(lg[0]), "+v"(lg[1]), "+v"(lg[2]), "+v"(lg[3]), "+v"(lg[4]), "+v"(lg[5]), "+v"(lg[6]), "+v"(lg[7]), "+v"(lg[8]), "+v"(lg[9]), "+v"(lg[10]), "+v"(lg[11]), "+v"(lg[12]), "+v"(lg[13]), "+v"(lg[14]), "+v"(lg[15]) :: "memory"); }
                float w8[8], w4[4], w2[2], z;
                { const bool up = li >= 8;
#pragma unroll
                  for (int j = 0; j < 8; ++j) { const float keep = up ? lg[8 + j] : lg[j], send = up ? lg[j] : lg[8 + j]; w8[j] = keep + dppmov<0x140>(send); } }
                { const bool up = (li & 7) >= 4;
#pragma unroll
                  for (int j = 0; j < 4; ++j) { const float keep = up ? w8[4 + j] : w8[j], send = up ? w8[j] : w8[4 + j]; w4[j] = keep + dppmov<0x141>(send); } }
                { const bool up = (li & 2) != 0;
#pragma unroll
                  for (int j = 0; j < 2; ++j) { const float keep = up ? w4[2 + j] : w4[j], send = up ? w4[j] : w4[2 + j]; w2[j] = keep + dppmov<0x4E>(send); } }
                { const bool up = (li & 1) != 0; const float keep = up ? w2[1] : w2[0], send = up ? w2[0] : w2[1]; z = keep + dppmov<0xB1>(send); }
                z += __shfl_xor(z, 16); z += __shfl_xor(z, 32);
                zz[ps] = z;
            }
            float z0 = zz[0] + brt0, z1 = zz[1] + brt1;
            float tv[4]; int ti[4];
#pragma unroll
            for (int k = 0; k < 4; ++k) {
                const bool first = z0 >= z1; const float bv = first ? z0 : z1;
                float mx = fmaxf(bv, dppmov<0xB1>(bv)); mx = fmaxf(mx, dppmov<0x4E>(mx)); mx = fmaxf(mx, dppmov<0x141>(mx)); mx = fmaxf(mx, dppmov<0x140>(mx));
                int ce = (bv == mx) ? (first ? li : 16 + li) : 99;
                { int o = __builtin_amdgcn_update_dpp(0, ce, 0xB1, 0xf, 0xf, true); ce = ce < o ? ce : o; o = __builtin_amdgcn_update_dpp(0, ce, 0x4E, 0xf, 0xf, true); ce = ce < o ? ce : o;
                  o = __builtin_amdgcn_update_dpp(0, ce, 0x141, 0xf, 0xf, true); ce = ce < o ? ce : o; o = __builtin_amdgcn_update_dpp(0, ce, 0x140, 0xf, 0xf, true); ce = ce < o ? ce : o; }
                ti[k] = __builtin_amdgcn_readfirstlane(ce); tv[k] = mx;
                { const bool mine = li == (ti[k] & 15); z0 = (mine && ti[k] < 16) ? -3.4e38f : z0; z1 = (mine && ti[k] >= 16) ? -3.4e38f : z1; }
            }
            const float e1 = __expf(tv[1] - tv[0]), e2 = __expf(tv[2] - tv[0]), e3 = __expf(tv[3] - tv[0]); const float inv = 1.f / (1.f + e1 + e2 + e3);
            const float tw[4] = {inv, e1 * inv, e2 * inv, e3 * inv};
            if (lane < 4) {
                int myi = ti[0]; float myw = tw[0];
#pragma unroll
                for (int k = 1; k < 4; ++k) if (lane == k) { myi = ti[k]; myw = tw[k]; }
                const int lr = __hip_atomic_fetch_add((LAS3 int*)&lcnt[myi], 1, __ATOMIC_RELAXED, __HIP_MEMORY_SCOPE_WORKGROUP);
                const int si = (wave * 16 + it) * 4 + lane;
                stg_slot[si] = m * 4 + lane; stg_e[si] = myi | (lr << 8); stg_w[si] = myw;
            }
        }
    }
    __syncthreads();
    if (tid < NE) { const int c = lcnt[tid]; lbase[tid] = c ? (int)atomicAdd(&counts[tid * 64], (unsigned)c) : 0; }
    __syncthreads();
    { const int si = tid, w = si >> 6;
      if (((int)blockIdx.x * (NTHREADS / 64) + w) * R < NTOK) {
        const int ee = stg_e[si], e = ee & 255, lr = ee >> 8; const int rank = lbase[e] + lr;
        eslot[(size_t)e * ECAP + rank] = stg_slot[si]; ew[(size_t)e * ECAP + rank] = stg_w[si]; } }
    __syncthreads();
}
__device__ __forceinline__ void expert_bases(const unsigned* counts, int* sbase_  , int wv) {
    LAS3 int* sbase = (LAS3 int*)sbase_;
    if (wv == 0) {
        const int lane = lane_id(); const int cn = lane < NE ? (int)counts[lane * 64] : 0; const int c = (cn + 255) & ~255;
        int incl = c;
#pragma unroll
        for (int o = 1; o < 32; o <<= 1) { const int v = __shfl_up(incl, o); if (lane >= o) incl += v; }
        if (lane < NE) { sbase[lane] = incl - c; sbase[40 + lane] = cn; }
        if (lane == NE - 1) sbase[NE] = incl;
    }
    __syncthreads();
}
typedef float f32x2v __attribute__((ext_vector_type(2)));
__device__ __forceinline__ void p6_load(const unsigned char* y, const float* out, int m, int lane, u32x2 (&yv)[2][4], f32x4 (&xv)[2][2]) {
#pragma unroll
    for (int j = 0; j < 2; ++j) { const int c0 = 8 * (lane + 64 * j);
#pragma unroll
        for (int k = 0; k < 4; ++k) yv[j][k] = *(const u32x2*)(y + (size_t)(m * 4 + k) * D + c0);
        xv[j][0] = *(const f32x4*)(out + (size_t)m * D + c0); xv[j][1] = *(const f32x4*)(out + (size_t)m * D + c0 + 4); }
}
__device__ void p6_final(const Params& p, int wv) {
    const int tid = tid_opaque(wv), lane = tid & 63;
    const float* mod = (const float*)(p.ws + WS_MOD); const unsigned char* y = p.ws + WS_Y;
    constexpr int R = 16;
    const int m0 = ((int)blockIdx.x * (NTHREADS / 64) + (tid >> 6)) * R;
    if (m0 >= NTOK) return;
    const int b = m0 / L; const float* ga2 = mod + b * 6144 + 5120;
    f32x4 pA[2][2];
#pragma unroll
    for (int j = 0; j < 2; ++j)
#pragma unroll
        for (int q = 0; q < 2; ++q) { const int c0 = 8 * (lane + 64 * j) + 4 * q; pA[j][q] = *(const f32x4*)(p.g_post_ffn + c0) * *(const f32x4*)(ga2 + c0); }
    u32x2 yv[2][4], ny[2][4]; f32x4 xv[2][2], nx[2][2];
    p6_load(y, p.out, m0, lane, ny, nx);
    for (int it = 0; it < R; ++it) {
        const int m = m0 + it;
#pragma unroll
        for (int j = 0; j < 2; ++j) {
#pragma unroll
            for (int k = 0; k < 4; ++k) yv[j][k] = ny[j][k];
            xv[j][0] = nx[j][0]; xv[j][1] = nx[j][1]; }
        if (it + 1 < R) p6_load(y, p.out, m + 1, lane, ny, nx);
        f32x4 a[2][2]; float s = 0.f;
#pragma unroll
        for (int j = 0; j < 2; ++j) { a[j][0] = (f32x4){0.f, 0.f, 0.f, 0.f}; a[j][1] = (f32x4){0.f, 0.f, 0.f, 0.f};
#pragma unroll
            for (int k = 0; k < 4; ++k) { const u32x2 w = yv[j][k];
                const f32x2v l0 = __builtin_amdgcn_cvt_pk_f32_fp8((int)w.x, false), l1 = __builtin_amdgcn_cvt_pk_f32_fp8((int)w.x, true);
                const f32x2v h0 = __builtin_amdgcn_cvt_pk_f32_fp8((int)w.y, false), h1 = __builtin_amdgcn_cvt_pk_f32_fp8((int)w.y, true);
                a[j][0].x += l0.x; a[j][0].y += l0.y; a[j][0].z += l1.x; a[j][0].w += l1.y;
                a[j][1].x += h0.x; a[j][1].y += h0.y; a[j][1].z += h1.x; a[j][1].w += h1.y; }
#pragma unroll
            for (int q = 0; q < 2; ++q) { a[j][q] = a[j][q] * Y8_INV; s += a[j][q].x * a[j][q].x + a[j][q].y * a[j][q].y + a[j][q].z * a[j][q].z + a[j][q].w * a[j][q].w; } }
        const float rstd = rsqrtf(wave_sum(s) * (1.f / D) + EPS);
#pragma unroll
        for (int j = 0; j < 2; ++j)
#pragma unroll
            for (int q = 0; q < 2; ++q) { const int c0 = 8 * (lane + 64 * j) + 4 * q;
                *(f32x4*)(p.out + (size_t)m * D + c0) = xv[j][q] + pA[j][q] * (a[j][q] * rstd); }
    }
}

constexpr int LDS_SBASE = 147456;
constexpr int LDS_BYTES = LDS_SBASE + 512 + (64 + 3 * 512) * 4 + 256;

__global__ void __launch_bounds__(NTHREADS, 2) fwd_kernel(Params p) {
    cg::grid_group grid = cg::this_grid();
    extern __shared__ __attribute__((aligned(16))) unsigned char lds[];
    int* sbase = (int*)(lds + LDS_SBASE);
    PG8_LAS unsigned char* lds3 = (PG8_LAS unsigned char*)lds;
    const PG8_LAS int* sbase3 = (const PG8_LAS int*)(lds3 + LDS_SBASE);
    volatile LAS3 unsigned* bst = (volatile LAS3 unsigned*)(lds3 + LDS_SBASE + 384);
    const int wv = __builtin_amdgcn_readfirstlane((int)(threadIdx.x >> 6));
    if (wv == 0 && lane_id() < 2) bst[lane_id()] = 0u;
    __syncthreads();
    XcdBarrier xb = xcd_barrier_post((unsigned*)(p.ws + WS_CTL) + CW_BAR, bst, wv);

    p0_mod(p, (float*)lds, (float*)(lds + 36864), wv);
    p0_tab(p, wv);
    p0_weights(p, lds, wv);
    grid.sync();
    p1_h(p, wv);
    xcd_barrier(xb);
    { pg8::Gemm g{(const bf16_t*)(p.ws + WS_HB), (const bf16_t*)(p.ws + WS_WIN), D, 0, nullptr, sbase3, wv};
      pg8::StaticOrder S; S.init(MROWS, INW, (int)gridDim.x, (int)blockIdx.x, nullptr);
      { const int t_ = tid_opaque(wv); *(PG8_LAS f32x4*)(lds3 + pg8::PAR_TAB + t_ * 16) = ((const f32x4*)(p.ws + WS_TAB))[t_]; }
      __syncthreads();
      pg8::EpiQKV E{(bf16_t*)(p.ws + WS_QKV)};
      pg8::gemm_phase<pg8::EpiQKV, pg8::StaticOrder, false, true>(lds3, g, S, E); }
    xcd_barrier(xb);
    att::attn_phase(p, lds3, wv);
    xcd_barrier(xb);
    { pg8::Gemm g{(const bf16_t*)(p.ws + WS_O), (const bf16_t*)(p.ws + WS_WOUT), D, 0, nullptr, sbase3, wv};
      pg8::StaticOrder S; S.init(NTOK, D, (int)gridDim.x, (int)blockIdx.x, nullptr);
      pg8::EpiOutProj E{(bf16_t*)(p.ws + WS_MIX), (const float*)(p.ws + WS_OSS)};
      pg8::gemm_phase<pg8::EpiOutProj, pg8::StaticOrder, false, true>(lds3, g, S, E); }
    xcd_barrier(xb);
    p4c_post(p, (LAS3 float*)lds3, wv);
    xcd_barrier(xb);
    expert_bases((const unsigned*)(p.ws + WS_CTL), sbase, wv);
    { const int total = sbase3[NE];
      pg8::Gemm g{(const bf16_t*)(p.ws + WS_HB), (const bf16_t*)(p.ws + WS_W1), D / 2, (size_t)2048 * D, (const int*)(p.ws + WS_ESLOT), sbase3, wv};
      pg8::StaticOrder S; S.init(total, 2048, (int)gridDim.x, (int)blockIdx.x, sbase3);
      pg8::EpiSwiglu E{p.ws + WS_ACT, p.b_mlp1};
      pg8::gemm_phase<pg8::EpiSwiglu, pg8::StaticOrder, true, true, true>(lds3, g, S, E); }
    xcd_barrier(xb);
    { const int total = sbase3[NE];
      pg8::Gemm g{(const bf16_t*)(p.ws + WS_ACT), (const bf16_t*)(p.ws + WS_W2), D / 2, (size_t)D * D, nullptr, sbase3, wv};
      pg8::StaticOrder S; S.init(total, D, (int)gridDim.x, (int)blockIdx.x, sbase3);
      pg8::EpiScatter E{p.ws + WS_Y, p.b_mlp2, (const int*)(p.ws + WS_ESLOT), (const float*)(p.ws + WS_EW), sbase3};
      pg8::gemm_phase<pg8::EpiScatter, pg8::StaticOrder, false, true, true>(lds3, g, S, E); }
    xcd_barrier(xb);
    p6_final(p, wv);
}

extern "C" void kernel_launch(void* const* d_in, const int* in_sizes, int n_in, void* d_out, int out_size, void* d_ws, size_t ws_size, hipStream_t stream) {
    static int grid_blocks = 0;
    if (grid_blocks == 0) {
        if (n_in != 22 || ws_size < WS_END) { fprintf(stderr, "kernel_launch: unexpected n_in %d / ws_size %zu (need %zu)\n", n_in, ws_size, (size_t)WS_END); grid_blocks = -1; return; }
        int dev = 0, cus = 0, per_cu = 0;
        (void)hipGetDevice(&dev);
        (void)hipDeviceGetAttribute(&cus, hipDeviceAttributeMultiprocessorCount, dev);
        if (hipFuncSetAttribute((const void*)fwd_kernel, hipFuncAttributeMaxDynamicSharedMemorySize, LDS_BYTES) != hipSuccess) { fprintf(stderr, "kernel_launch: hipFuncSetAttribute failed\n"); grid_blocks = -1; return; }
        (void)hipOccupancyMaxActiveBlocksPerMultiprocessor(&per_cu, (const void*)fwd_kernel, NTHREADS, LDS_BYTES);
        if (per_cu < 1) { fprintf(stderr, "kernel_launch: occupancy query returned %d\n", per_cu); grid_blocks = -1; return; }
        grid_blocks = cus;
        if (grid_blocks * (NTHREADS / 64) * 16 < NTOK) { fprintf(stderr, "kernel_launch: needs >= 256 CUs (got %d)\n", cus); grid_blocks = -1; return; }
    }
    if (grid_blocks < 0) return;
    (void)hipMemsetAsync((char*)d_ws + WS_CTL, 0, CTL_BYTES, stream);
    Params p{};
    const float** pp = (const float**)&p;
    for (int i = 0; i < 22; ++i) pp[i] = (const float*)d_in[i];
    p.out = (float*)d_out; p.ws = (unsigned char*)d_ws;
    void* args[] = {&p};
    hipError_t e = hipLaunchCooperativeKernel((const void*)fwd_kernel, dim3(grid_blocks), dim3(NTHREADS), args, LDS_BYTES, stream);
    if (e != hipSuccess) fprintf(stderr, "cooperative launch failed: %s (grid %d)\n", hipGetErrorString(e), grid_blocks);
}
```

```cpp
#include <hip/hip_runtime.h>
#include <hip/hip_cooperative_groups.h>
#include <cstdio>
#include <cstdint>
namespace cg = cooperative_groups;

constexpr int D = 1024, NB = 8, L = 4096, CTX = 256;
constexpr int NTOK = NB * L, NCTX = NB * CTX, MROWS = NTOK + NCTX;
constexpr int INW = 2304;
constexpr int C_QA = 0, C_KA = 512, C_VA = 640, C_QB = 768, C_KB = 1280, C_VB = 1792;
constexpr int NE = 32, TOPK = 4, NASG = NTOK * TOPK;
constexpr int PADROWS = NASG + NE * 256;
constexpr float LOG2E = 1.4426950408889634f;
constexpr float QSCALE = 0.125f * LOG2E;
constexpr float EPS = 1e-6f;
constexpr int NTHREADS = 512;

constexpr size_t MiB = 1u << 20;
constexpr size_t WS_CTL = 0;
constexpr size_t CTL_BYTES = 32768;
constexpr int CW_BAR = 2048;
constexpr size_t WS_MOD = 1 * MiB;
constexpr size_t WS_TAB = 1 * MiB + 256 * 1024;
constexpr size_t WS_OSTAT = 1 * MiB + 512 * 1024;
constexpr size_t WS_WIN = 2 * MiB;
constexpr size_t WS_WOUT = 7 * MiB;
constexpr size_t WS_W2 = 9 * MiB;
constexpr size_t WS_OSS = 41 * MiB;
constexpr size_t WS_W1 = 73 * MiB;
constexpr size_t WS_HB = 201 * MiB;
constexpr int ECAP = NTOK;
constexpr size_t WS_ESLOT = 269 * MiB;
constexpr size_t WS_EW = 273 * MiB;
constexpr size_t WS_QKV = 277 * MiB;
constexpr size_t WS_O = 430 * MiB;
constexpr size_t WS_MIX = 494 * MiB;
constexpr size_t WS_ACT = 277 * MiB;
constexpr size_t WS_Y = 622 * MiB;
constexpr size_t WS_X1 = 750 * MiB;
constexpr size_t WS_END = 878 * MiB;
static_assert(WS_W1 + (size_t)NE * 2048 * D * 2 <= WS_HB && WS_W2 + (size_t)NE * D * D * 2 <= WS_W1, "map");
static_assert(WS_HB + (size_t)MROWS * D * 2 <= WS_ESLOT && WS_ESLOT + (size_t)NE * ECAP * 4 <= WS_EW && WS_EW + (size_t)NE * ECAP * 4 <= WS_QKV, "map");
static_assert(WS_QKV + (size_t)MROWS * INW * 2 <= WS_O && WS_O + (size_t)NTOK * D * 2 <= WS_MIX && WS_MIX + (size_t)NTOK * D * 4 <= WS_Y, "map");
static_assert(WS_ACT + (size_t)PADROWS * 1024 * 2 <= WS_Y && WS_Y + (size_t)NASG * D <= WS_X1 && WS_X1 + (size_t)NTOK * D * 2 <= WS_END, "map");

typedef unsigned short bf16_t;
typedef float f32x4 __attribute__((ext_vector_type(4)));
typedef unsigned u32x4 __attribute__((ext_vector_type(4)));
typedef unsigned u32x2 __attribute__((ext_vector_type(2)));

struct Params {
    const float *x, *c, *ctx, *c_ctx, *w_ada, *b_ada, *g_pre_mix, *g_post_mix, *g_pre_ffn, *g_post_ffn, *w_in, *g_grp_a, *g_grp_b,
        *sink_a, *rpb_b, *w_out, *w_router, *b_router, *w_mlp1, *b_mlp1, *w_mlp2, *b_mlp2;
    float* out;
    unsigned char* ws;
};

__device__ __forceinline__ unsigned f2bf(float f) { unsigned u = __float_as_uint(f); return (u + 0x7fffu + ((u >> 16) & 1u)) >> 16; }
__device__ __forceinline__ unsigned pk2(float lo, float hi) { typedef float f2_ __attribute__((ext_vector_type(2))); typedef __bf16 b2_ __attribute__((ext_vector_type(2)));
    f2_ v = {lo, hi}; b2_ b = __builtin_convertvector(v, b2_); return __builtin_bit_cast(unsigned, b); }
__device__ __forceinline__ unsigned pk4_fp8(float v0, float v1, float v2, float v3) {
    int w = 0; w = __builtin_amdgcn_cvt_pk_fp8_f32(v0, v1, w, false); w = __builtin_amdgcn_cvt_pk_fp8_f32(v2, v3, w, true); return (unsigned)w; }
constexpr float Y8_SCALE = 16.f, Y8_INV = 1.f / 16.f;
constexpr float W8_SCALE = 64.f, W8_INV = 1.f / 64.f;
__device__ __forceinline__ int lane_id() { int l; asm volatile("v_mbcnt_lo_u32_b32 %0, -1, 0\n\tv_mbcnt_hi_u32_b32 %0, -1, %0" : "=v"(l)); return l; }
__device__ __forceinline__ int tid_opaque(int wv) { return wv * 64 + lane_id(); }
template <int CTRL> __device__ __forceinline__ float dppmov(float v) { return __builtin_bit_cast(float, __builtin_amdgcn_update_dpp(0, __builtin_bit_cast(int, v), CTRL, 0xf, 0xf, true)); }
__device__ __forceinline__ float row_sum16(float v) { v += dppmov<0xB1>(v); v += dppmov<0x4E>(v); v += dppmov<0x141>(v); v += dppmov<0x140>(v); return v; }
__device__ __forceinline__ float rdlane(float v, int l) { return __builtin_bit_cast(float, __builtin_amdgcn_readlane(__builtin_bit_cast(int, v), l)); }
__device__ __forceinline__ float wave_sum(float v) { v = row_sum16(v); return (rdlane(v, 0) + rdlane(v, 16)) + (rdlane(v, 32) + rdlane(v, 48)); }

#define LAS3 __attribute__((address_space(3)))
#define XB_TMO      128
#define XB_XCNT(j)  (256  + 64 * (j))
#define XB_XSUB(j)  (1280 + 64 * (j))
#define XB_XGEN(j)  (2304 + 64 * (j))
#define XB_TOP      3328
#define XB_TOPGEN   3392
#define XCD_BAR_WORDS 3456
#define XB_SPIN_CAP (1u << 18)
__device__ __forceinline__ unsigned xb_ld(unsigned* p)              { return __hip_atomic_load(p, __ATOMIC_RELAXED, __HIP_MEMORY_SCOPE_AGENT); }
__device__ __forceinline__ unsigned xb_add(unsigned* p, unsigned v) { return __hip_atomic_fetch_add(p, v, __ATOMIC_RELAXED, __HIP_MEMORY_SCOPE_AGENT); }
__device__ __forceinline__ unsigned xb_xcc_id() { return (unsigned)__builtin_amdgcn_s_getreg((3 << 11) | 20) & 0xFu; }
#define XB_SPIN(cond, bar) do { unsigned _sp = 0; while (cond) { __builtin_amdgcn_s_sleep(1); \
    if ((++_sp & 255u) == 0u) { if (xb_ld(&(bar)[XB_TMO])) break; if (_sp > XB_SPIN_CAP) { atomicAdd(&(bar)[XB_TMO], 1u); break; } } } } while (0)
struct XcdBarrier { unsigned* bar; unsigned x; volatile LAS3 unsigned* st; int wv; };
__device__ __forceinline__ XcdBarrier xcd_barrier_post(unsigned* bar, volatile LAS3 unsigned* st, int wv) {
    XcdBarrier b; b.bar = bar; b.x = xb_xcc_id(); b.st = st; b.wv = wv;
    if (tid_opaque(wv) == 0) (void)xb_add(&bar[XB_XCNT(b.x)], 1u);
    return b;
}
__device__ __forceinline__ void xcd_barrier_complete(unsigned* bar, unsigned x, unsigned& nloc, unsigned& nx) {
    const unsigned G = gridDim.x * gridDim.y * gridDim.z;
    unsigned sum, cnt, mine, sp = 0u;
    for (;;) {
        sum = 0u; cnt = 0u; mine = 0u;
#pragma unroll
        for (unsigned j = 0; j < 16; ++j) { const unsigned c = xb_ld(&bar[XB_XCNT(j)]); sum += c; cnt += (c > 0u) ? 1u : 0u; mine = (j == x) ? c : mine; }
        if (sum == G) break;
        __builtin_amdgcn_s_sleep(1);
        if ((++sp & 255u) == 0u) { if (xb_ld(&bar[XB_TMO])) break; if (sp > XB_SPIN_CAP) { atomicAdd(&bar[XB_TMO], 1u); break; } }
    }
    nloc = mine > 0u ? mine : 1u; nx = cnt > 0u ? cnt : 1u;
}
__device__ __forceinline__ void xcd_barrier(const XcdBarrier& b) {
    asm volatile("s_waitcnt vmcnt(0)" ::: "memory");
    __syncthreads();
    if (tid_opaque(b.wv) == 0) {
        unsigned* bar = b.bar;
        __builtin_amdgcn_s_waitcnt(0);
        unsigned nloc = b.st[0], nx = b.st[1];
        if (nloc == 0u) { xcd_barrier_complete(bar, b.x, nloc, nx); b.st[0] = nloc; b.st[1] = nx; }
        const unsigned old = xb_add(&bar[XB_XSUB(b.x)], 1u);
        const unsigned gen = old / nloc;
        if (old + 1u == (gen + 1u) * nloc) {
            __builtin_amdgcn_fence(__ATOMIC_RELEASE, "agent");
            asm volatile("s_waitcnt vmcnt(0)" ::: "memory");
            const unsigned og = xb_add(&bar[XB_TOP], 1u);
            const unsigned tg = og / nx;
            if (og + 1u == (tg + 1u) * nx) xb_add(&bar[XB_TOPGEN], 1u);
            else XB_SPIN(xb_ld(&bar[XB_TOPGEN]) == tg, bar);
            __builtin_amdgcn_fence(__ATOMIC_ACQUIRE, "agent");
            xb_add(&bar[XB_XGEN(b.x)], 1u);
            asm volatile("s_waitcnt vmcnt(0)" ::: "memory");
        } else {
            XB_SPIN(xb_ld(&bar[XB_XGEN(b.x)]) == gen, bar);
            __builtin_amdgcn_fence(__ATOMIC_ACQUIRE, "agent");
            asm volatile("s_waitcnt vmcnt(0)" ::: "memory");
        }
    }
    __syncthreads();
}

namespace pg8 {
#define PG8_LAS __attribute__((address_space(3)))
typedef short bf16x8 __attribute__((ext_vector_type(8)));
typedef int v8i __attribute__((ext_vector_type(8)));
typedef int v4i __attribute__((ext_vector_type(4)));
typedef short s16x16 __attribute__((ext_vector_type(16)));
constexpr int BM = 256, BK = 64, HALF = 128, HTB = HALF * BK * 2  , STAGE_BYTES = 8 * HTB, NXCD = 8, WGM = 8;
__device__ __forceinline__ int lds_byte(int r, int c) { const int st = (r >> 4) * 2 + (c >> 5), rr = r & 15, cc = c & 31, ob = rr * 64 + cc * 2; return st * 1024 + (ob ^ (((ob >> 9) & 1) << 5)); }
__device__ __forceinline__ void stage_rc(int b, int& R, int& C) { const int st = b / 1024, sb = b % 1024, swz = sb ^ (((sb >> 9) & 1) << 5); R = (st >> 1) * 16 + swz / 64; C = (st & 1) * 32 + (swz % 64) / 2; }
__device__ __forceinline__ int perm32(int rho) { const int n = rho >> 4, i = rho & 15; return 8 * (i >> 2) + 4 * n + (i & 3); }

constexpr int PAR_BASE = 131072, PAR_BUF = 4096, PAR_IDX = 0, PAR_W = 1024, PAR_BIAS = 2048, PAR_TAB = PAR_BASE + 2 * PAR_BUF;
typedef short s16x2 __attribute__((ext_vector_type(2)));
__device__ __forceinline__ int par_i32(PG8_LAS unsigned char* p) { return __builtin_bit_cast(int, *(const PG8_LAS s16x2*)p); }
__device__ __forceinline__ float par_f32(PG8_LAS unsigned char* p) { return __builtin_bit_cast(float, *(const PG8_LAS s16x2*)p); }
__device__ __forceinline__ f32x4 par_f32x4(PG8_LAS unsigned char* p) { return __builtin_bit_cast(f32x4, *(const PG8_LAS bf16x8*)p); }
struct Unit { int pm, pn, e; };
struct Gemm { const bf16_t* A; const bf16_t* Bt; int K; size_t bstride; const int* eslot; const PG8_LAS int* sb; int wv; };

struct StaticOrder {
    int nM, nN, nwg, G, c; const PG8_LAS int* sbase;
    __device__ void init(int M, int N, int G_, int c_, const PG8_LAS int* sb) { nM = M / BM; nN = N / BM; nwg = nM * nN; G = G_; c = c_; sbase = sb; }
    __device__ bool next(int i, Unit& u) const {
        const long Lx = (long)i * G + c; if (Lx >= nwg) return false;
        int wgid = (int)Lx; { const int q = nwg / NXCD, r = nwg % NXCD, xcd = wgid % NXCD, off = wgid / NXCD; wgid = (xcd < r ? xcd * (q + 1) : r * (q + 1) + (xcd - r) * q) + off; }
        const int nig = WGM * nN, gid = wgid / nig, fm = gid * WGM, gsz = (nM - fm) < WGM ? (nM - fm) : WGM;
        u.pm = fm + ((wgid % nig) % gsz); u.pn = (wgid % nig) / gsz; u.e = 0;
        if (sbase) { const int row = u.pm * BM; const int l = lane_id();
            const bool ge = (l >= 1) && (l < 32) && (row >= sbase[l & 31]);
            u.e = __builtin_popcountll(__ballot(ge)); }
        return true;
    }
};

template <class Epi, class Sched, bool GATHER, bool ALIGN_EPI, bool FP8 = false>
__device__ __forceinline__ void gemm_phase(PG8_LAS unsigned char* lds, const Gemm g, const Sched& S, const Epi& E) {
    const int tid = tid_opaque(g.wv), wid = g.wv,
              lane = tid & 63, wr = wid >> 2, wc = wid & 3, fr = lane & 15, fq = lane >> 4;
    const int K = g.K, nt = K / BK;
    unsigned voffA[2], voffB[2];
#pragma unroll
    for (int i = 0; i < 2; ++i) { const int R = 8 * (wid + 8 * i) + (lane >> 3), Sb = (((lane & 7) ^ (lane >> 3)) * 16); const int Rb = Epi::PERM ? ((R & ~31) + perm32(R & 31)) : R;
        voffA[i] = (unsigned)(R * K * 2 + Sb); voffB[i] = (unsigned)(Rb * K * 2 + Sb); }
    const size_t kstep = (size_t)(BK * 2);
    const size_t hstep = (size_t)HALF * K * 2;
    const size_t tstep = 2 * hstep;
    const unsigned ldsw = (unsigned)wid * 1024u;
    const int fsw0 = (fr & 7) * 128 + ((fq ^ (fr & 7)) * 16), fsw1 = (fr & 7) * 128 + (((fq + 4) ^ (fr & 7)) * 16);
    const int aoff0 = (wr * 8 + (fr >> 3)) * 1024 + fsw0, aoff1 = (wr * 8 + (fr >> 3)) * 1024 + fsw1, boff0 = (wc * 4 + (fr >> 3)) * 1024 + fsw0, boff1 = (wc * 4 + (fr >> 3)) * 1024 + fsw1;
#define PG8_SA(b, h) (((b) * 2 + (h)) * HTB)
#define PG8_SB(b, h) ((4 + (b) * 2 + (h)) * HTB)
#define PG8_STAGE(bufoff, gbase, voff) do { _Pragma("unroll") for (int _i = 0; _i < 2; ++_i) \
        __builtin_amdgcn_global_load_lds((const unsigned*)((const char*)(gbase) + (voff)[_i]), (PG8_LAS unsigned*)(lds + (bufoff) + ldsw + _i * 8192), 16, 0, 0); } while (0)
#define PG8_CAT(lo_, hi_) __builtin_bit_cast(v8i, __builtin_shufflevector((lo_), (hi_), 0, 1, 2, 3, 4, 5, 6, 7, 8, 9, 10, 11, 12, 13, 14, 15))
#define PG8_LDA(dst, b, h) do { _Pragma("unroll") for (int m = 0; m < 4; ++m) { \
        const bf16x8 f0_ = *(const PG8_LAS bf16x8*)(lds + PG8_SA(b, h) + aoff0 + m * 2048), f1_ = *(const PG8_LAS bf16x8*)(lds + PG8_SA(b, h) + aoff1 + m * 2048); \
        if constexpr (FP8) dst##8[m] = PG8_CAT(f0_, f1_); else { dst[m][0] = f0_; dst[m][1] = f1_; } } } while (0)
#define PG8_LDB(dst, b, h) do { _Pragma("unroll") for (int n = 0; n < 2; ++n) { \
        const bf16x8 f0_ = *(const PG8_LAS bf16x8*)(lds + PG8_SB(b, h) + boff0 + n * 2048), f1_ = *(const PG8_LAS bf16x8*)(lds + PG8_SB(b, h) + boff1 + n * 2048); \
        if constexpr (FP8) dst##8[n] = PG8_CAT(f0_, f1_); else { dst[n][0] = f0_; dst[n][1] = f1_; } } } while (0)
#define PG8_MMA(ai, bj, At, Bt) do { __builtin_amdgcn_s_setprio(1); _Pragma("unroll") for (int m = 0; m < 4; ++m) _Pragma("unroll") for (int n = 0; n < 2; ++n) { \
        if constexpr (FP8) asm volatile("v_mfma_scale_f32_16x16x128_f8f6f4 %0, %1, %2, %0, %3, %3 op_sel_hi:[0,0,0]" : "+v"(acc[ai][bj][m][n]) : "v"(Bt##8[n]), "v"(At##8[m]), "v"(one_scale)); \
        else { _Pragma("unroll") for (int k = 0; k < 2; ++k) acc[ai][bj][m][n] = __builtin_amdgcn_mfma_f32_16x16x32_bf16(Bt[n][k], At[m][k], acc[ai][bj][m][n], 0, 0, 0); } } \
        __builtin_amdgcn_s_setprio(0); } while (0)
#define PG8_WAIT_V(n) asm volatile("s_waitcnt vmcnt(" #n ")" ::: "memory")
#define PG8_WAIT_L(n) asm volatile("s_waitcnt lgkmcnt(" #n ")" ::: "memory")
#define PG8_BAR __builtin_amdgcn_s_barrier()
#define PG8_SCHED __builtin_amdgcn_sched_barrier(0)
#define PG8_SETOFF(off, pbuf_) do { _Pragma("unroll") for (int _h = 0; _h < 2; ++_h) _Pragma("unroll") for (int _i = 0; _i < 2; ++_i) { \
        if (GATHER) { const int R_ = 8 * (wid + 8 * _i) + (lane >> 3); \
            off[_h][_i] = (unsigned)(par_i32(lds + PAR_BASE + (pbuf_) * PAR_BUF + PAR_IDX + (_h * HALF + R_) * 4) >> 2) * (unsigned)(K * 2) + (unsigned)(((lane & 7) ^ (lane >> 3)) * 16); } \
        else off[_h][_i] = voffA[_i] + (unsigned)(_h * hstep); } } while (0)
#define PG8_IDXDMA(u, pbuf_) do { if (GATHER && wid < 4) { int rk_ = (u).pm * BM + wid * 64 + lane - g.sb[(u).e]; const int cm_ = g.sb[40 + (u).e] - 1; rk_ = rk_ < cm_ ? rk_ : cm_; \
        __builtin_amdgcn_global_load_lds((const unsigned*)(g.eslot + (size_t)(u).e * ECAP + rk_), (PG8_LAS unsigned*)(lds + PAR_BASE + (pbuf_) * PAR_BUF + PAR_IDX + wid * 256), 4, 0, 0); } } while (0)
    Unit cur, nxt; int ui = 0;
    if (!S.next(0, cur)) return;
    PG8_IDXDMA(cur, 0); E.prefetch(cur, 0, lds, wid, lane);
    PG8_WAIT_V(0); PG8_BAR;
    f32x4 acc[2][2][4][2];
#pragma unroll
    for (int a = 0; a < 2; ++a)
#pragma unroll
        for (int b = 0; b < 2; ++b)
#pragma unroll
            for (int m = 0; m < 4; ++m)
#pragma unroll
                for (int n = 0; n < 2; ++n) acc[a][b][m][n] = (f32x4){0.f, 0.f, 0.f, 0.f};
    bf16x8 At[4][2], B0[2][2], B1[2][2];
    v8i At8[4], B08[2], B18[2];
    const int one_scale = 0x7f7f7f7f;
    unsigned offc[2][2];
    PG8_SETOFF(offc, 0);
    const char* cA = GATHER ? (const char*)g.A : (const char*)g.A + (size_t)cur.pm * tstep;
    const char* cB = (const char*)g.Bt + (size_t)cur.e * g.bstride + (size_t)cur.pn * tstep;
    PG8_STAGE(PG8_SB(0, 0), cB, voffB); PG8_STAGE(PG8_SB(0, 1), cB + hstep, voffB); PG8_STAGE(PG8_SA(0, 0), cA, offc[0]); PG8_STAGE(PG8_SA(0, 1), cA, offc[1]);
    if (wr == 1) PG8_BAR;
    PG8_WAIT_V(2); PG8_BAR;
    PG8_STAGE(PG8_SB(1, 0), cB + kstep, voffB); PG8_STAGE(PG8_SA(1, 0), cA + kstep, offc[0]); PG8_STAGE(PG8_SB(1, 1), cB + hstep + kstep, voffB);
    PG8_WAIT_V(6); PG8_BAR;
    for (;;) {
        const bool has_next = S.next(ui + 1, nxt);
        const char* nA = GATHER ? cA : (has_next ? (const char*)g.A + (size_t)nxt.pm * tstep : cA);
        const char* nB = has_next ? (const char*)g.Bt + (size_t)nxt.e * g.bstride + (size_t)nxt.pn * tstep : cB;

        if constexpr (Epi::MIDSCALE) E.begin(cur, ui, lds, tid);
#pragma unroll 1
        for (int t = 0; t < nt; t += 2) {
            const bool last = (t == nt - 2);
            if constexpr (Epi::MIDSCALE) { if (t == nt / 2) E.mid(acc, ui, wr, fr, lds); }
            if (t == 2 && has_next) { PG8_IDXDMA(nxt, (ui + 1) & 1); E.prefetch(nxt, (ui + 1) & 1, lds, wid, lane); }
            const char* a1 = cA + (size_t)(t + 1) * kstep;
            const char* a2 = last ? nA : cA + (size_t)(t + 2) * kstep; const char* b2 = last ? nB : cB + (size_t)(t + 2) * kstep;
            const char* a3 = a2 + kstep; const char* b3 = b2 + kstep;
            PG8_LDB(B0, 0, 0); PG8_LDB(B1, 0, 1); PG8_SCHED; PG8_LDA(At, 0, 0); PG8_STAGE(PG8_SA(1, 1), a1, offc[1]);
            if (GATHER && last && has_next) { PG8_SETOFF(offc, (ui + 1) & 1); }
            PG8_WAIT_V(8); PG8_WAIT_L(0); PG8_BAR; PG8_MMA(0, 0, At, B0); PG8_MMA(0, 1, At, B1); PG8_BAR; PG8_SCHED;
            PG8_LDA(At, 0, 1); PG8_STAGE(PG8_SB(0, 0), b2, voffB); PG8_STAGE(PG8_SB(0, 1), b2 + hstep, voffB); PG8_STAGE(PG8_SA(0, 0), a2, offc[0]);
            PG8_WAIT_V(8); PG8_WAIT_L(0); PG8_BAR; PG8_MMA(1, 0, At, B0); PG8_MMA(1, 1, At, B1); PG8_BAR; PG8_SCHED;
            PG8_LDB(B0, 1, 0); PG8_LDB(B1, 1, 1); PG8_SCHED; PG8_LDA(At, 1, 0); PG8_STAGE(PG8_SA(0, 1), a2, offc[1]);
            PG8_WAIT_V(8); PG8_WAIT_L(0); PG8_BAR; PG8_MMA(0, 0, At, B0); PG8_MMA(0, 1, At, B1); PG8_BAR; PG8_SCHED;
            PG8_LDA(At, 1, 1); PG8_STAGE(PG8_SB(1, 0), b3, voffB); PG8_STAGE(PG8_SB(1, 1), b3 + hstep, voffB); PG8_STAGE(PG8_SA(1, 0), a3, offc[0]);
            PG8_WAIT_V(8); PG8_WAIT_L(0); PG8_BAR; PG8_MMA(1, 0, At, B0); PG8_MMA(1, 1, At, B1); PG8_BAR; PG8_SCHED;
        }
        if constexpr (ALIGN_EPI) { if (wr == 0) PG8_BAR; }
        if constexpr (FP8) asm volatile("s_nop 15\n\ts_nop 15" ::: "memory");
        E(acc, cur, ui, wr, wc, fr, fq, lds);
        if (!has_next) break;
#pragma unroll
        for (int a = 0; a < 2; ++a)
#pragma unroll
            for (int b = 0; b < 2; ++b)
#pragma unroll
                for (int m = 0; m < 4; ++m)
#pragma unroll
                    for (int n = 0; n < 2; ++n) acc[a][b][m][n] = (f32x4){0.f, 0.f, 0.f, 0.f};
        cur = nxt; cA = nA; cB = nB; ++ui;
        if constexpr (ALIGN_EPI) { if (wr == 1) PG8_BAR; }
    }
    PG8_WAIT_V(0);
    if constexpr (!ALIGN_EPI) { if (wr == 0) PG8_BAR; }
    PG8_BAR;
#undef PG8_SA
#undef PG8_SB
#undef PG8_STAGE
#undef PG8_LDA
#undef PG8_LDB
#undef PG8_MMA
#undef PG8_WAIT_V
#undef PG8_WAIT_L
#undef PG8_BAR
#undef PG8_SCHED
#undef PG8_SETOFF
#undef PG8_IDXDMA
#undef PG8_CAT
}

struct EpiQKV {
    static constexpr bool MIDSCALE = false, PERM = false;
    bf16_t* O;
    __device__ __forceinline__ void prefetch(const Unit&, int, PG8_LAS unsigned char*, int, int) const {}
    __device__ __forceinline__ void operator()(const f32x4 (&acc)[2][2][4][2], const Unit& u, int ui, int wr, int wc, int fr, int fq, PG8_LAS unsigned char* lds) const {
        const bool latent = u.pm < NTOK / BM;
#pragma unroll
        for (int ai = 0; ai < 2; ++ai)
#pragma unroll
            for (int m = 0; m < 4; ++m) {
                const int row = u.pm * BM + ai * HALF + wr * 64 + m * 16 + fr;
                bf16_t* rowp = O + (size_t)row * INW + u.pn * BM + wc * 32 + 4 * fq;
                const int pos = row & (L - 1), pp = (wc & 1) ? (pos & 63) : (pos >> 6);
                PG8_LAS unsigned char* tp = lds + PAR_TAB + (pp * 16 + 4 * fq) * 8;
#pragma unroll
                for (int bj = 0; bj < 2; ++bj) {
                    const int colbase = u.pn * BM + bj * HALF;
                    f32x4 v0 = acc[ai][bj][m][0], v1 = acc[ai][bj][m][1];
                    if (latent && colbase < C_VA) {
                        const f32x4 t0 = par_f32x4(tp), t1 = par_f32x4(tp + 16);
                        const f32x4 cs = {t0.x, t0.z, t1.x, t1.z}, sn = {t0.y, t0.w, t1.y, t1.w};
                        const f32x4 a0 = v0 * cs - v1 * sn, a1 = v1 * cs + v0 * sn; v0 = a0; v1 = a1;
                    }
                    if (colbase < C_KA || (colbase >= C_QB && colbase < C_KB)) { v0 = v0 * QSCALE; v1 = v1 * QSCALE; }
                    u32x2 w0, w1; w0.x = pk2(v0.x, v0.y); w0.y = pk2(v0.z, v0.w); w1.x = pk2(v1.x, v1.y); w1.y = pk2(v1.z, v1.w);
                    *(u32x2*)(rowp + bj * HALF) = w0; *(u32x2*)(rowp + bj * HALF + 16) = w1;
                }
            }
    }
};
struct EpiOutProj {
    static constexpr bool PERM = true, MIDSCALE = true;
    bf16_t* O; const float* oss;
    __device__ __forceinline__ void prefetch(const Unit&, int, PG8_LAS unsigned char*, int, int) const {}
    __device__ __forceinline__ void begin(const Unit& u, int ui, PG8_LAS unsigned char* lds, int tid) const {
        if (tid < 256) { const f32x4* sp = (const f32x4*)(oss + (size_t)(u.pm * BM + tid) * 16); const f32x4 a0 = sp[0], a1 = sp[1], b0 = sp[2], b1 = sp[3];
            const float sa = ((a0.x + a0.y) + (a0.z + a0.w)) + ((a1.x + a1.y) + (a1.z + a1.w)), sb = ((b0.x + b0.y) + (b0.z + b0.w)) + ((b1.x + b1.y) + (b1.z + b1.w));
            const float ra = rsqrtf(sa * (1.f / 512.f) + EPS), rb = rsqrtf(sb * (1.f / 512.f) + EPS);
            typedef float f2 __attribute__((ext_vector_type(2)));
            *(PG8_LAS f2*)(lds + 131072 + (ui & 1) * 2048 + tid * 8) = (f2){ra / rb, rb}; }
    }
    __device__ __forceinline__ void mid(f32x4 (&acc)[2][2][4][2], int ui, int wr, int fr, PG8_LAS unsigned char* lds) const {
#pragma unroll
        for (int ai = 0; ai < 2; ++ai)
#pragma unroll
            for (int m = 0; m < 4; ++m) { const float r = *(const PG8_LAS float*)(lds + 131072 + (ui & 1) * 2048 + (ai * HALF + wr * 64 + m * 16 + fr) * 8);
#pragma unroll
                for (int bj = 0; bj < 2; ++bj)
#pragma unroll
                    for (int n = 0; n < 2; ++n) acc[ai][bj][m][n] = acc[ai][bj][m][n] * r; }
    }
    __device__ __forceinline__ void operator()(const f32x4 (&acc)[2][2][4][2], const Unit& u, int ui, int wr, int wc, int fr, int fq, PG8_LAS unsigned char* lds) const {
#pragma unroll
        for (int ai = 0; ai < 2; ++ai)
#pragma unroll
            for (int m = 0; m < 4; ++m) {
                const int rl = ai * HALF + wr * 64 + m * 16 + fr;
                const float rb = *(const PG8_LAS float*)(lds + 131072 + (ui & 1) * 2048 + rl * 8 + 4);
                bf16_t* rowp = O + (size_t)(u.pm * BM + rl) * D + u.pn * BM + wc * 32 + 8 * fq;
#pragma unroll
                for (int bj = 0; bj < 2; ++bj) { const f32x4 v0 = acc[ai][bj][m][0] * rb, v1 = acc[ai][bj][m][1] * rb;
                    u32x4 o; o.x = pk2(v0.x, v0.y); o.y = pk2(v0.z, v0.w); o.z = pk2(v1.x, v1.y); o.w = pk2(v1.z, v1.w);
                    *(u32x4*)(rowp + bj * HALF) = o; }
            }
    }
};
struct EpiSwiglu {
    static constexpr bool MIDSCALE = false, PERM = false;
    unsigned char* act; const float* b1;
    __device__ __forceinline__ void prefetch(const Unit& u, int pb, PG8_LAS unsigned char* lds, int wid, int lane) const {
        if (wid == 4) __builtin_amdgcn_global_load_lds((const unsigned*)(b1 + (size_t)u.e * 2048 + u.pn * BM + lane * 4), (PG8_LAS unsigned*)(lds + PAR_BASE + pb * PAR_BUF + PAR_BIAS), 16, 0, 0);
    }
    __device__ __forceinline__ void operator()(const f32x4 (&acc)[2][2][4][2], const Unit& u, int ui, int wr, int wc, int fr, int fq, PG8_LAS unsigned char* lds) const {
#pragma unroll
        for (int bj = 0; bj < 2; ++bj) {
            const int f0 = 16 * (8 * u.pn + 4 * bj + wc) + 4 * fq;
            PG8_LAS unsigned char* bp = lds + PAR_BASE + (ui & 1) * PAR_BUF + PAR_BIAS + (128 * bj + 32 * wc + 8 * fq) * 4; const f32x4 bA = par_f32x4(bp), bB = par_f32x4(bp + 16);
            const f32x4 bg = {bA.x, bA.z, bB.x, bB.z}, bl = {bA.y, bA.w, bB.y, bB.w};
#pragma unroll
            for (int ai = 0; ai < 2; ++ai)
#pragma unroll
                for (int m = 0; m < 4; ++m) {
                    const int row = u.pm * BM + ai * HALF + wr * 64 + m * 16 + fr;
                    typedef float f32x2 __attribute__((ext_vector_type(2)));
                    const f32x4 A0 = acc[ai][bj][m][0], A1 = acc[ai][bj][m][1]; float a[4];
#pragma unroll
                    for (int h2 = 0; h2 < 2; ++h2) {
                        const f32x2 g = __builtin_elementwise_fma((f32x2){A0[2 * h2], A0[2 * h2 + 1]}, (f32x2){W8_INV, W8_INV}, (f32x2){bg[2 * h2], bg[2 * h2 + 1]});
                        const f32x2 l = __builtin_elementwise_fma((f32x2){A1[2 * h2], A1[2 * h2 + 1]}, (f32x2){W8_INV, W8_INV}, (f32x2){bl[2 * h2], bl[2 * h2 + 1]});
                        const f32x2 gg = {fminf(g.x, 7.f), fminf(g.y, 7.f)}, ll = {fminf(fmaxf(l.x, -7.f), 7.f), fminf(fmaxf(l.y, -7.f), 7.f)};
                        const f32x2 t = gg * (f32x2){-1.702f * LOG2E, -1.702f * LOG2E};
                        const f32x2 d = (f32x2){__builtin_amdgcn_exp2f(t.x), __builtin_amdgcn_exp2f(t.y)} + (f32x2){1.f, 1.f};
                        const f32x2 s = gg * (f32x2){__builtin_amdgcn_rcpf(d.x), __builtin_amdgcn_rcpf(d.y)};
                        const f32x2 r = __builtin_elementwise_fma(s, ll, s);
                        a[2 * h2] = r.x; a[2 * h2 + 1] = r.y; }
                    *(unsigned*)(act + (size_t)row * D + f0) = pk4_fp8(a[0], a[1], a[2], a[3]);
                }
        }
    }
};
struct EpiScatter {
    static constexpr bool MIDSCALE = false, PERM = true;
    unsigned char* y; const float* b2; const int* eslot; const float* ew; const PG8_LAS int* sb;
    __device__ __forceinline__ void prefetch(const Unit& u, int pb, PG8_LAS unsigned char* lds, int wid, int lane) const {
        const int w4 = wid & 3; int rk = u.pm * BM + w4 * 64 + lane - sb[u.e]; const int cm = sb[40 + u.e] - 1; rk = rk < cm ? rk : cm;
        const size_t gi = (size_t)u.e * ECAP + rk;
        if (wid < 4) __builtin_amdgcn_global_load_lds((const unsigned*)(eslot + gi), (PG8_LAS unsigned*)(lds + PAR_BASE + pb * PAR_BUF + PAR_IDX + w4 * 256), 4, 0, 0);
        else         __builtin_amdgcn_global_load_lds((const unsigned*)(ew + gi), (PG8_LAS unsigned*)(lds + PAR_BASE + pb * PAR_BUF + PAR_W + w4 * 256), 4, 0, 0);
        if (wid == 0) __builtin_amdgcn_global_load_lds((const unsigned*)(b2 + (size_t)u.e * D + u.pn * BM + lane * 4), (PG8_LAS unsigned*)(lds + PAR_BASE + pb * PAR_BUF + PAR_BIAS), 16, 0, 0);
    }
    __device__ __forceinline__ void operator()(const f32x4 (&acc)[2][2][4][2], const Unit& u, int ui, int wr, int wc, int fr, int fq, PG8_LAS unsigned char* lds) const {
        PG8_LAS unsigned char* par = lds + PAR_BASE + (ui & 1) * PAR_BUF;
        const int col0 = u.pn * BM + wc * 32 + 8 * fq;
        f32x4 bv[2][2];
#pragma unroll
        for (int bj = 0; bj < 2; ++bj)
#pragma unroll
            for (int n = 0; n < 2; ++n) bv[bj][n] = par_f32x4(par + PAR_BIAS + (wc * 32 + 8 * fq + bj * HALF + 4 * n) * 4);
        const int rbase = u.pm * BM - sb[u.e], cn = sb[40 + u.e];
#pragma unroll
        for (int ai = 0; ai < 2; ++ai)
#pragma unroll
            for (int m = 0; m < 4; ++m) {
                const int rl = ai * HALF + wr * 64 + m * 16 + fr;
                const int slot = par_i32(par + PAR_IDX + rl * 4); const float w = par_f32(par + PAR_W + rl * 4) * Y8_SCALE;
                if (rbase + rl < cn) {
                    unsigned char* rowp = y + (size_t)slot * D + col0;
#pragma unroll
                    for (int bj = 0; bj < 2; ++bj) { const f32x4 v0 = (acc[ai][bj][m][0] * W8_INV + bv[bj][0]) * w, v1 = (acc[ai][bj][m][1] * W8_INV + bv[bj][1]) * w;
                        u32x2 o; o.x = pk4_fp8(v0.x, v0.y, v0.z, v0.w); o.y = pk4_fp8(v1.x, v1.y, v1.z, v1.w);
                        *(u32x2*)(rowp + bj * HALF) = o; }
                }
            }
    }
};
}

__device__ void p0_mod(const Params& p, float* sS  , float* sP  , int wv) {
    float* mod = (float*)(p.ws + WS_MOD);
    const int tid = tid_opaque(wv), lane = tid & 63, wave = wv;
    if (blockIdx.x >= 96) return;
    for (int i = tid; i < 9 * D; i += NTHREADS) { const int r = i >> 10, k = i & 1023; const float cc = r < 8 ? p.c[r * D + k] : p.c_ctx[k]; sS[i] = cc / (1.f + __expf(-cc)); }
    __syncthreads();
    const int j = blockIdx.x * 64 + lane;
    float acc[9];
#pragma unroll
    for (int r = 0; r < 9; ++r) acc[r] = 0.f;
    const float* wp = p.w_ada + (size_t)(wave * 128) * 6144 + j;
#pragma unroll 1
    for (int k0 = 0; k0 < 128; k0 += 16) {
        float w[16];
#pragma unroll
        for (int kk = 0; kk < 16; ++kk) w[kk] = wp[(size_t)(k0 + kk) * 6144];
#pragma unroll
        for (int kk = 0; kk < 16; ++kk)
#pragma unroll
            for (int r = 0; r < 9; ++r) acc[r] = fmaf(sS[r * D + wave * 128 + k0 + kk], w[kk], acc[r]);
    }
#pragma unroll
    for (int r = 0; r < 9; ++r) sP[(wave * 9 + r) * 64 + lane] = acc[r];
    __syncthreads();
    for (int i = tid; i < 9 * 64; i += NTHREADS) { const int r = i >> 6, jj = i & 63; float s = p.b_ada[blockIdx.x * 64 + jj];
#pragma unroll
        for (int w = 0; w < 8; ++w) s += sP[(w * 9 + r) * 64 + jj];
        mod[r * 6144 + blockIdx.x * 64 + jj] = s; }
    __syncthreads();
}
__device__ void p0_tab(const Params& p, int wv) {
    float* tab = (float*)(p.ws + WS_TAB);
    const int gtid = blockIdx.x * NTHREADS + tid_opaque(wv), gsize = gridDim.x * NTHREADS;
    for (int idx = gtid; idx < 64 * 16; idx += gsize) {
        const int pos = idx >> 4, i = idx & 15;
        const float freq = exp2f(-(float)i * (13.287712379549449f / 16.f));
        const float ang = (float)pos * freq;
        const float n = rintf(ang * 0.15915494309189535f);
        float r = fmaf(-n, 6.28125f, ang); r = fmaf(-n, 1.9353071795864769e-3f, r);
        tab[idx * 2] = __cosf(r); tab[idx * 2 + 1] = __sinf(r);
    }
}
template <int MODE>
__device__ __forceinline__ void conv_item(const float* src, int K, int N, bf16_t* dst, int item, float* scr, int lane, const float* gA, const float* gB) {
    const int nblk = N / 32, kb = item / nblk, nb = item % nblk, k0 = 64 * kb, n0 = 32 * nb;
    const int c = lane & 31, kh = lane >> 5;
    const int nl = MODE == 1 ? 16 * (c & 1) + (c >> 1) : c;
    float v[32];
    const float* sp = src + (size_t)(k0 + kh) * N + n0 + c;
#pragma unroll
    for (int i = 0; i < 32; ++i) v[i] = sp[(size_t)(2 * i) * N];
#pragma unroll
    for (int i = 0; i < 32; ++i) { float x = v[i]; if (MODE == 2) { const int k = k0 + 2 * i + kh; x *= (k < 512 ? gA[k] : gB[k - 512]); } scr[(2 * i + kh) * 33 + nl] = x; }
    asm volatile("s_waitcnt lgkmcnt(0)" ::: "memory");
    const int ch = lane & 7;
#pragma unroll
    for (int j = 0; j < 4; ++j) { const int n = (lane >> 3) + 8 * j; const float* s = scr + (8 * ch) * 33 + n;
        u32x4 o; o.x = pk2(s[0 * 33], s[1 * 33]); o.y = pk2(s[2 * 33], s[3 * 33]); o.z = pk2(s[4 * 33], s[5 * 33]); o.w = pk2(s[6 * 33], s[7 * 33]);
        *(u32x4*)(dst + (size_t)(n0 + n) * K + k0 + 8 * ch) = o; }
    asm volatile("s_waitcnt lgkmcnt(0)" ::: "memory");
}
template <bool PERM1>
__device__ __forceinline__ void conv_item8(const float* src, int K, int N, unsigned char* dst, int item, float* scr, int lane) {
    const int nblk = N / 32, kb = item / nblk, nb = item % nblk, k0 = 64 * kb, n0 = 32 * nb;
    const int c = lane & 31, kh = lane >> 5;
    const int nl = PERM1 ? 16 * (c & 1) + (c >> 1) : c;
    float v[32];
    const float* sp = src + (size_t)(k0 + kh) * N + n0 + c;
#pragma unroll
    for (int i = 0; i < 32; ++i) v[i] = sp[(size_t)(2 * i) * N];
#pragma unroll
    for (int i = 0; i < 32; ++i) scr[(2 * i + kh) * 33 + nl] = v[i] * W8_SCALE;
    asm volatile("s_waitcnt lgkmcnt(0)" ::: "memory");
    const int ch = lane & 3;
#pragma unroll
    for (int j = 0; j < 2; ++j) { const int n = (lane >> 2) + 16 * j; const float* s = scr + (16 * ch) * 33 + n;
        u32x4 o; o.x = pk4_fp8(s[0 * 33], s[1 * 33], s[2 * 33], s[3 * 33]); o.y = pk4_fp8(s[4 * 33], s[5 * 33], s[6 * 33], s[7 * 33]);
        o.z = pk4_fp8(s[8 * 33], s[9 * 33], s[10 * 33], s[11 * 33]); o.w = pk4_fp8(s[12 * 33], s[13 * 33], s[14 * 33], s[15 * 33]);
        *(u32x4*)(dst + (size_t)(n0 + n) * K + k0 + 16 * ch) = o; }
    asm volatile("s_waitcnt lgkmcnt(0)" ::: "memory");
}
__device__ void p0_weights(const Params& p, unsigned char* ldsb, int wv) {
    const int tid = tid_opaque(wv), lane = tid & 63, wave = wv; float* scr = (float*)(ldsb + 57344 + wave * 8448);
    const int gw = blockIdx.x * (NTHREADS / 64) + wave, ngw = gridDim.x * (NTHREADS / 64);
    constexpr int I_IN = 16 * 72, I_OUT = 16 * 32;
    constexpr int NITEMS = I_IN + I_OUT;
    for (int it = gw; it < NITEMS; it += ngw) {
        int r = it;
        if (r < I_IN) { conv_item<0>(p.w_in, D, INW, (bf16_t*)(p.ws + WS_WIN), r, scr, lane, nullptr, nullptr); continue; } r -= I_IN;
        conv_item<2>(p.w_out, D, D, (bf16_t*)(p.ws + WS_WOUT), r, scr, lane, p.g_grp_a, p.g_grp_b);
    }
}

__device__ void p1_h(const Params& p, int wv) {
    const int tid = tid_opaque(wv), lane = tid & 63;
    const float* mod = (const float*)(p.ws + WS_MOD);
    bf16_t* hb = (bf16_t*)(p.ws + WS_HB);
    constexpr int R = 17;
    const int gwv = blockIdx.x * (NTHREADS / 64) + (tid >> 6);
    const int m0 = gwv * R; if (m0 >= MROWS) return;
    const int m1 = m0 + R < MROWS ? m0 + R : MROWS;
    f32x4 pB[4], pC[4], v[4], nv[4]; int curb = -1;
#define P1_ROWPTR(m) ((m) < NTOK ? p.x + (size_t)(m) * D : p.ctx + (size_t)((m) - NTOK) * D)
    { const float* xr = P1_ROWPTR(m0);
#pragma unroll
      for (int j = 0; j < 4; ++j) nv[j] = ((const f32x4*)xr)[lane + 64 * j]; }
    for (int m = m0; m < m1; ++m) {
#pragma unroll
        for (int j = 0; j < 4; ++j) v[j] = nv[j];
        if (m + 1 < m1) { const float* xr = P1_ROWPTR(m + 1);
#pragma unroll
            for (int j = 0; j < 4; ++j) nv[j] = ((const f32x4*)xr)[lane + 64 * j]; }
        const int b = m < NTOK ? m / L : 8;
        if (b != curb) { curb = b; const float* sh = mod + b * 6144, * sc = sh + 1024;
#pragma unroll
            for (int j = 0; j < 4; ++j) { const int c0 = 4 * (lane + 64 * j); pB[j] = *(const f32x4*)(p.g_pre_mix + c0) * (*(const f32x4*)(sc + c0) + 1.f); pC[j] = *(const f32x4*)(sh + c0); } }
        float s = 0.f;
#pragma unroll
        for (int j = 0; j < 4; ++j) s += v[j].x * v[j].x + v[j].y * v[j].y + v[j].z * v[j].z + v[j].w * v[j].w;
        const float rstd = rsqrtf(wave_sum(s) * (1.f / D) + EPS);
#pragma unroll
        for (int j = 0; j < 4; ++j) { const int c0 = 4 * (lane + 64 * j);
            const f32x4 o = (v[j] * rstd) * pB[j] + pC[j];
            u32x2 w; w.x = pk2(o.x, o.y); w.y = pk2(o.z, o.w);
            *(u32x2*)(hb + (size_t)m * D + c0) = w; }
    }
#undef P1_ROWPTR
}

namespace att {
#define ATT_LAS __attribute__((address_space(3)))
typedef float f32x16 __attribute__((ext_vector_type(16)));
typedef short bf16x8 __attribute__((ext_vector_type(8)));
typedef short s16x4 __attribute__((ext_vector_type(4)));
constexpr int SLOTB = 8192, NSLOT = 4;
constexpr int LDS_K = 0, LDS_V = NSLOT * SLOTB, LDS_WS = 2 * NSLOT * SLOTB, LDS_BT = LDS_WS + 8 * 256;
constexpr int BT_MARGIN = 128, BT_FLOATS = BT_MARGIN + 15 * 32 + 128;
constexpr float NEGBIG = -1e30f;
__device__ __forceinline__ int crow(int r, int hi) { return (r & 3) + 8 * (r >> 2) + 4 * hi; }
__device__ __forceinline__ unsigned cvtpk(float lo, float hi) { typedef float f2 __attribute__((ext_vector_type(2))); typedef __bf16 b2 __attribute__((ext_vector_type(2)));
    f2 v = {lo, hi}; b2 b = __builtin_convertvector(v, b2); return __builtin_bit_cast(unsigned, b); }
__device__ __forceinline__ s16x4 vtr(const ATT_LAS unsigned char* p) { typedef short v4i16 __attribute__((ext_vector_type(4)));
    return __builtin_bit_cast(s16x4, __builtin_amdgcn_ds_read_tr16_b64_v4i16((ATT_LAS v4i16*)p)); }
#define ATT_WAIT_BAR(N) asm volatile("s_waitcnt vmcnt(" #N ") lgkmcnt(0)\n\ts_barrier" ::: "memory")

constexpr int LDS_CV = 71680, CV_BUF = 4096, CV_WAVE = 2 * CV_BUF;
static_assert(LDS_BT + BT_FLOATS * 4 <= LDS_CV && LDS_CV + 8 * CV_WAVE <= 147456, "attention LDS map");
constexpr int CV_W1 = 32 * 64, CV_W2 = 32 * 32, CV_ITEMS = NE * (CV_W1 + CV_W2);
constexpr int CV_PERIOD = 5, CV_DUTY = 3;
__device__ __forceinline__ void glds16(const void* gsrc, unsigned lds_dst) { unsigned keep;
    asm volatile("s_mov_b32 %0, m0\n\ts_mov_b32 m0, %2\n\ts_nop 0\n\tglobal_load_lds_dwordx4 %1, off\n\ts_mov_b32 m0, %0" : "=&s"(keep) : "v"(gsrc), "s"(lds_dst) : "memory"); }
__device__ __forceinline__ unsigned lds_addr(const ATT_LAS unsigned char* p) { return (unsigned)(unsigned long long)p; }
struct ConvJob { int it, end, con, nfl, pi, pc, stride, cnt; bool prev; };
__device__ __forceinline__ void cv_decode(const Params& p, int it, const float*& src, unsigned char*& dst, int& N, int& k0, int& n0, bool& perm) {
    int q;
    if (it < NE * CV_W1) { const int e = it / CV_W1; q = it % CV_W1; src = p.w_mlp1 + (size_t)e * D * 2048; dst = p.ws + WS_W1 + (size_t)e * 2048 * D; N = 2048; perm = true; }
    else { const int r = it - NE * CV_W1, e = r / CV_W2; q = r % CV_W2; src = p.w_mlp2 + (size_t)e * D * D; dst = p.ws + WS_W2 + (size_t)e * D * D; N = D; perm = false; }
    const int tile = q >> 3, sub = q & 7, ntn = N / 64, kt = tile / ntn, nt = tile % ntn; k0 = 128 * kt + 32 * (sub & 3); n0 = 64 * nt + 32 * (sub >> 2);
}
__device__ __forceinline__ void cv_issue(const Params& p, int it, int lane, ATT_LAS unsigned char* buf) {
    const float* src; unsigned char* dst; int N, k0, n0; bool perm; cv_decode(p, it, src, dst, N, k0, n0, perm);
    const float* sp = src + (size_t)(k0 + (lane >> 3)) * N + n0 + 4 * (lane & 7);
#pragma unroll
    for (int j = 0; j < 4; ++j) glds16(sp + (size_t)(8 * j) * N, (unsigned)__builtin_amdgcn_readfirstlane(lds_addr(buf + j * 1024)));
}
__device__ __forceinline__ void cv_consume(const Params& p, int it, int lane, ATT_LAS unsigned char* buf) {
    const float* src; unsigned char* dst; int N, k0, n0; bool perm; cv_decode(p, it, src, dst, N, k0, n0, perm);
    const int nr = lane >> 1, kh = lane & 1, cc = perm ? 2 * (nr & 15) + (nr >> 4) : nr;
    ATT_LAS unsigned char* s = buf + (16 * kh) * 128 + cc * 4;
    float v[16];
#pragma unroll
    for (int q = 0; q < 16; ++q) v[q] = pg8::par_f32(s + q * 128) * W8_SCALE;
    u32x4 o; o.x = pk4_fp8(v[0], v[1], v[2], v[3]); o.y = pk4_fp8(v[4], v[5], v[6], v[7]); o.z = pk4_fp8(v[8], v[9], v[10], v[11]); o.w = pk4_fp8(v[12], v[13], v[14], v[15]);
    *(u32x4*)(dst + (size_t)(n0 + nr) * D + k0 + 16 * kh) = o;
}

#define A2_SBAR() __builtin_amdgcn_sched_barrier(0)
#define A2_PIN(x) asm volatile("" : "+v"(x))
#define A2_MFMA(a, b, c) __builtin_amdgcn_mfma_f32_32x32x16_bf16(a, b, c, 0, 0, 0)
__device__ __forceinline__ void kload2(bf16x8* kf, const ATT_LAS unsigned char* kb, const unsigned (&kq)[4], int d0) { kf[2 * d0] = *(const ATT_LAS bf16x8*)(kb + kq[d0]); kf[2 * d0 + 1] = *(const ATT_LAS bf16x8*)(kb + kq[d0] + 4096); }
__device__ __forceinline__ float max3f(float a, float b, float c) { return __builtin_fmaxf(__builtin_fmaxf(a, b), c); }
__device__ __forceinline__ float rowmax32(const f32x16& p0, const f32x16& p1) {
    float a = max3f(p0[0], p0[1], p1[0]), b = max3f(p0[2], p0[3], p1[1]); a = max3f(a, p1[2], p1[3]);
#pragma unroll
    for (int r = 4; r < 16; r += 4) { a = max3f(a, p0[r], p0[r + 1]); b = max3f(b, p0[r + 2], p0[r + 3]); a = max3f(a, p1[r], p1[r + 1]); b = max3f(b, p1[r + 2], p1[r + 3]); }
    float x = __builtin_fmaxf(a, b), y = x;
    asm volatile("s_nop 1\n\tv_permlane32_swap_b32 %0, %1" : "+v"(x), "+v"(y));
    return __builtin_fmaxf(x, y); }
__device__ __forceinline__ void att_wait_bar(int n) {
    switch (n) { case 0: ATT_WAIT_BAR(0); break; case 1: ATT_WAIT_BAR(1); break; case 2: ATT_WAIT_BAR(2); break; case 3: ATT_WAIT_BAR(3); break;
                 case 4: ATT_WAIT_BAR(4); break; case 5: ATT_WAIT_BAR(5); break; case 6: ATT_WAIT_BAR(6); break; default: ATT_WAIT_BAR(7); break; } }

struct A2U { int b, kvh, qb, jlo, j1, nU, NTr, NT; };
__device__ __forceinline__ A2U a2_unit(int unit) { A2U u; u.b = unit >> 7; u.kvh = (unit >> 6) & 1; u.qb = unit & 63;
    const int jlo = 2 - u.qb > 0 ? 2 - u.qb : 0, jhi = 65 - u.qb < 4 ? 65 - u.qb : 4;
    const int j1 = jlo > 1 ? jlo : 1, j3 = jhi < 3 ? jhi : 3; u.jlo = jlo; u.j1 = j1; u.nU = j3 - j1 + 1; u.NTr = u.nU + 4 + (jlo == 0 ? 1 : 0) + (jhi == 4 ? 1 : 0); u.NT = u.NTr | 1; return u; }
__device__ __forceinline__ const bf16_t* a2_row(const bf16_t* qkv, const A2U& u, int t) {
    const bf16_t* lat = qkv + (size_t)u.b * L * INW;
    if (t < u.nU) return lat + (size_t)((u.qb - 2 + u.j1 + t) * 64) * INW;
    if (t < u.nU + 4) return qkv + (size_t)(NTOK + u.b * CTX + (t - u.nU) * 64) * INW;
    if (t >= u.NTr) return lat + (size_t)((u.qb - 2 + u.j1) * 64) * INW;
    return lat + (size_t)((u.qb - 2 + ((t == u.nU + 4 && u.jlo == 0) ? 0 : 4)) * 64) * INW; }

__device__ __forceinline__ void attn_a2_units(const Params& p, ATT_LAS unsigned char* lds, int wv, ConvJob& cj, int vcu, int G) {
    if (vcu >= 1024) return;
    const int tid = tid_opaque(wv), lane = tid & 63, r32 = lane & 31, hi = lane >> 5; const int wid = wv;
    const bf16_t* qkv = (const bf16_t*)(p.ws + WS_QKV); bf16_t* ob = (bf16_t*)(p.ws + WS_O);
    ATT_LAS float* wsf = (ATT_LAS float*)(lds + LDS_WS) + wid * 64;
    ATT_LAS unsigned char* cvbuf = lds + LDS_CV + wid * CV_WAVE;
    ATT_LAS unsigned char* stg = lds + (wid < 4 ? 3 * SLOTB + wid * 2048 : LDS_V + 3 * SLOTB + (wid - 4) * 2048);
    const int half = wid & 1;
    const int koff = (8 * wid + (lane >> 3)) * INW + (((lane & 7) ^ ((4 * wid + (lane >> 4)) & 7)) * 8), voff = (16 * (wid & 3) + (lane >> 2)) * INW + (wid >> 2) * 32 + (lane & 3) * 8;
    const ATT_LAS unsigned char* vp0 = lds + LDS_V + ((lane >> 4) & 1) * 32 + (lane & 3) * 8 + (4 * hi + ((lane & 15) >> 2)) * 64;
    const ATT_LAS unsigned char* kp0 = lds + LDS_K;
    unsigned kq[4];
#pragma unroll
    for (int d0 = 0; d0 < 4; ++d0) kq[d0] = (unsigned)(r32 * 128 + (((2 * d0 + hi) ^ ((r32 >> 1) & 7)) * 16));
#define A2_SLOT3(x) ((x) >= 3 * SLOTB ? (x) - 3 * SLOTB : (x))
#define A2_DMA_K(U, t, slot) glds16(a2_row(qkv, U, t) + (C_KA + (U).kvh * 64) + koff, (unsigned)__builtin_amdgcn_readfirstlane(lds_addr(lds + LDS_K + wid * 1024) + (unsigned)(slot)))
#define A2_DMA_V(U, t, slot) glds16(a2_row(qkv, U, t) + (C_VA + (U).kvh * 64) + voff, (unsigned)__builtin_amdgcn_readfirstlane(lds_addr(lds + LDS_V + wid * 1024) + (unsigned)(slot)))
#define A2_OPEN(U, RB) do { A2_DMA_K(U, 0, RB); A2_DMA_V(U, 0, RB); A2_DMA_K(U, 1, A2_SLOT3((RB) + SLOTB)); A2_DMA_K(U, 2, A2_SLOT3((RB) + 2 * SLOTB)); \
        const bf16_t* qp_ = qkv + (size_t)((U).b * L + (U).qb * 64 + 32 * half + r32) * INW + C_QA + ((U).kvh * 4 + (wid >> 1)) * 64 + hi * 8; \
        A2_QLD(qf[0], qp_, 0); A2_QLD(qf[1], qp_, 32); A2_QLD(qf[2], qp_, 64); A2_QLD(qf[3], qp_, 96); } while (0)
#define A2_QLD(dst, ptr, OFF) asm volatile("global_load_dwordx4 %0, %1, off offset:" #OFF : "=&v"(dst) : "v"(ptr) : "memory")
    bf16x8 qf[4];
    const float sink0 = __builtin_amdgcn_exp2f(p.sink_a[wid >> 1] * LOG2E), sink1 = __builtin_amdgcn_exp2f(p.sink_a[4 + (wid >> 1)] * LOG2E);
    int unit = vcu, rb = 0;
    A2U U = a2_unit(unit);
    A2_OPEN(U, rb);
    ATT_WAIT_BAR(0);
    f32x16 negm;
#pragma unroll 1
    for (;;) {
    const int NT = U.NT, h = U.kvh * 4 + (wid >> 1), q0 = U.qb * 64 + 32 * half, ocol = h * 64;
#define A2_MODE(t) ((t) < U.nU + 4 ? 0 : (t) >= U.NTr ? 3 : (((t) == U.nU + 4 && U.jlo == 0) ? 1 : 2))
    float mref = 0.f, l_run = hi == 0 ? (U.kvh ? sink1 : sink0) : 0.f;
    f32x16 o0, o1; float zero_ = 0.f; A2_PIN(zero_);
#pragma unroll
    for (int r = 0; r < 16; ++r) { o0[r] = zero_; o1[r] = zero_; negm[r] = zero_; }
    A2_PIN(negm);
    bool resc = false;
    f32x16 pA0, pA1, pB0, pB1; bf16x8 kf[8]; s16x4 vlo[8], vhi[8];
    typedef unsigned u4 __attribute__((ext_vector_type(4)));
    u4 pw0, pw1, pw2, pw3;
    int sl_prev = rb, sl_cur = rb, sl_next = A2_SLOT3(rb + SLOTB);
#define A2_ROT() do { sl_prev = sl_cur; sl_cur = sl_next; sl_next = (sl_next == 2 * SLOTB) ? 0 : sl_next + SLOTB; } while (0)
#define A2_EX(v) __builtin_amdgcn_exp2f(v)
#define A2_RESC() do { if (resc) { const int hr_ = lane_id() >> 5; _Pragma("unroll") for (int g = 0; g < 4; ++g) { const f32x4 f_ = *(const ATT_LAS f32x4*)(wsf + 8 * g + 4 * hr_);     \
        o0[4 * g] *= f_.x; o0[4 * g + 1] *= f_.y; o0[4 * g + 2] *= f_.z; o0[4 * g + 3] *= f_.w; o1[4 * g] *= f_.x; o1[4 * g + 1] *= f_.y; o1[4 * g + 2] *= f_.z; o1[4 * g + 3] *= f_.w; \
        asm volatile("" : "+v"(o0), "+v"(o1) :: "memory"); } } } while (0)
#define A2_DECIDE(C0, C1, MODE) do { \
        if (MODE) { const int l_ = lane_id(), qq_ = 32 * half + (l_ & 31), h4_ = (l_ >> 5) * 4;        \
                    if ((MODE) == 3) { _Pragma("unroll") for (int r = 0; r < 16; ++r) { C0[r] = NEGBIG; C1[r] = NEGBIG; } } \
                    else if ((MODE) == 1) { _Pragma("unroll") for (int r = 0; r < 16; ++r) { const int c = (r & 3) + 8 * (r >> 2) + h4_; if (c < qq_) C0[r] = NEGBIG; if (c + 32 < qq_) C1[r] = NEGBIG; } } \
                    else             { _Pragma("unroll") for (int r = 0; r < 16; ++r) { const int c = (r & 3) + 8 * (r >> 2) + h4_; if (c > qq_) C0[r] = NEGBIG; if (c + 32 > qq_) C1[r] = NEGBIG; } } } \
        const float rm_ = rowmax32(C0, C1); resc = false; \
        if (__builtin_expect(__any(rm_ > 8.f), 0)) { const float dl_ = __builtin_fmaxf(rm_, 0.f); mref += dl_; const float f_ = __builtin_amdgcn_exp2f(-dl_); l_run *= f_; { const int lw_ = lane_id(); if (lw_ < 32) wsf[lw_] = f_; } resc = true; \
            _Pragma("unroll") for (int r = 0; r < 16; ++r) { C0[r] -= dl_; C1[r] -= dl_; negm[r] = -mref; } } } while (0)
#pragma unroll
    for (int d0 = 0; d0 < 4; ++d0) kload2(kf, kp0 + sl_cur, kq, d0);
    pA0 = A2_MFMA(kf[0], qf[0], negm); pA1 = A2_MFMA(kf[1], qf[0], negm); pA0 = A2_MFMA(kf[2], qf[1], pA0); pA1 = A2_MFMA(kf[3], qf[1], pA1);
    pA0 = A2_MFMA(kf[4], qf[2], pA0); pA1 = A2_MFMA(kf[5], qf[2], pA1); pA0 = A2_MFMA(kf[6], qf[3], pA0); pA1 = A2_MFMA(kf[7], qf[3], pA1);
    A2_DECIDE(pA0, pA1, 0);
#pragma unroll
    for (int r = 0; r < 16; ++r) { pA0[r] = A2_EX(pA0[r]); pA1[r] = A2_EX(pA1[r]); }
    asm volatile("s_waitcnt lgkmcnt(0)\n\ts_barrier" ::: "memory");
    A2_DMA_K(U, 3, sl_cur); A2_DMA_V(U, 1, sl_next); A2_ROT();
#pragma unroll
    for (int d0 = 0; d0 < 4; ++d0) kload2(kf, kp0 + sl_cur, kq, d0);
    asm volatile("s_waitcnt lgkmcnt(0)\n\ts_barrier" ::: "memory");
#define A2_PKW(P, i) cvtpk(P[i], P[(i) + 1])
#define A2_PAF(k) __builtin_bit_cast(bf16x8, pw##k)
#define A2_VFR(i) (bf16x8){vlo[i][0], vlo[i][1], vlo[i][2], vlo[i][3], vhi[i][0], vhi[i][1], vhi[i][2], vhi[i][3]}
#define A2_VRD(i) do { vlo[i] = vtr(vp_ + (((i) >> 2) * 4096 + ((i) & 3) * 1024)); vhi[i] = vtr(vp_ + (((i) >> 2) * 4096 + ((i) & 3) * 1024 + 512)); } while (0)
#define A2_KRD(G, d0) do { if (G) { kload2(kf, kp0 + sl_next, kq, d0); A2_SBAR(); } } while (0)
#define A2_GAPA(MF, a0, a1, a2, a3, W0, W1, PW) do { MF; sacc += a0; sacc += a1; sacc += a2; sacc += a3; W0; W1; A2_PIN(PW); A2_PIN(sacc); A2_SBAR(); } while (0)
#define A2_GAPB(MF, X, i) do { MF; X[i] = A2_EX(X[i]); X[(i) + 1] = A2_EX(X[(i) + 1]); X[(i) + 2] = A2_EX(X[(i) + 2]); X[(i) + 3] = A2_EX(X[(i) + 3]); A2_PIN(X); A2_SBAR(); } while (0)
#define A2_STEP(C0, C1, P0, P1, T) do { A2_SBAR(); \
      \
    const bool con_ = cj.nfl == 2 || (cj.nfl > 0 && cj.it >= cj.end && !cj.prev);                          \
    if (con_) { cv_consume(p, cj.con, lane, cvbuf + cj.pc * CV_BUF); cj.con += cj.stride; --cj.nfl; cj.pc ^= 1; } \
    const bool iss_ = cj.it < cj.end && cj.nfl < 2 && cj.cnt < CV_DUTY; cj.cnt = cj.cnt + 1 == CV_PERIOD ? 0 : cj.cnt + 1;     \
    if (iss_) { cv_issue(p, cj.it, lane, cvbuf + cj.pi * CV_BUF); cj.it += cj.stride; ++cj.nfl; cj.pi ^= 1; } \
    cj.prev = iss_; A2_SBAR(); \
    const int t_ = (T); const bool gk_ = t_ + 3 < NT, gv_ = t_ + 1 < NT; const int mode_ = A2_MODE(t_); \
    const ATT_LAS unsigned char* vp_ = vp0 + sl_prev; \
    float sacc = P0[0] + P0[1]; \
                    A2_GAPA(C0 = A2_MFMA(kf[0], qf[0], negm), P0[2], P0[3], P0[4], P0[5],     pw0[0] = A2_PKW(P0, 0),  pw0[1] = A2_PKW(P0, 2),  pw0); \
                    A2_GAPA(C1 = A2_MFMA(kf[1], qf[0], negm), P0[6], P0[7], P0[8], P0[9],     pw0[2] = A2_PKW(P0, 4),  pw0[3] = A2_PKW(P0, 6),  pw0); \
                    A2_GAPA(C0 = A2_MFMA(kf[2], qf[1], C0),   P0[10], P0[11], P0[12], P0[13], pw1[0] = A2_PKW(P0, 8),  pw1[1] = A2_PKW(P0, 10), pw1); \
    A2_KRD(gv_, 0); A2_GAPA(C1 = A2_MFMA(kf[3], qf[1], C1),   P0[14], P0[15], P1[0], P1[1],   pw1[2] = A2_PKW(P0, 12), pw1[3] = A2_PKW(P0, 14), pw1); \
                    A2_GAPA(C0 = A2_MFMA(kf[4], qf[2], C0),   P1[2], P1[3], P1[4], P1[5],     pw2[0] = A2_PKW(P1, 0),  pw2[1] = A2_PKW(P1, 2),  pw2); \
    A2_KRD(gv_, 1); A2_GAPA(C1 = A2_MFMA(kf[5], qf[2], C1),   P1[6], P1[7], P1[8], P1[9],     pw2[2] = A2_PKW(P1, 4),  pw2[3] = A2_PKW(P1, 6),  pw2); \
                    A2_GAPA(C0 = A2_MFMA(kf[6], qf[3], C0),   P1[10], P1[11], P1[12], P1[13], pw3[0] = A2_PKW(P1, 8),  pw3[1] = A2_PKW(P1, 10), pw3); \
    A2_KRD(gv_, 2); A2_GAPA(C1 = A2_MFMA(kf[7], qf[3], C1),   P1[14], P1[15], 0.f, 0.f,       pw3[2] = A2_PKW(P1, 12), pw3[3] = A2_PKW(P1, 14), pw3); \
    l_run += sacc; \
    A2_VRD(0); A2_VRD(4); A2_SBAR(); \
    if (gk_) A2_DMA_K(U, t_ + 3, sl_cur); if (gv_) A2_DMA_V(U, t_ + 1, sl_next);                        \
    A2_DECIDE(C0, C1, mode_); A2_SBAR(); \
    A2_KRD(gv_, 3); \
    A2_VRD(1); A2_SBAR(); A2_GAPB(o0 = A2_MFMA(A2_PAF(0), A2_VFR(0), o0), C0, 0); \
    A2_VRD(5); A2_SBAR(); A2_GAPB(o1 = A2_MFMA(A2_PAF(0), A2_VFR(4), o1), C0, 4); \
    A2_VRD(2); A2_SBAR(); A2_GAPB(o0 = A2_MFMA(A2_PAF(1), A2_VFR(1), o0), C0, 8); \
    A2_VRD(6); A2_SBAR(); A2_GAPB(o1 = A2_MFMA(A2_PAF(1), A2_VFR(5), o1), C0, 12); \
    A2_VRD(3); A2_SBAR(); A2_GAPB(o0 = A2_MFMA(A2_PAF(2), A2_VFR(2), o0), C1, 0); \
    A2_VRD(7); A2_SBAR(); A2_GAPB(o1 = A2_MFMA(A2_PAF(2), A2_VFR(6), o1), C1, 4); \
                          A2_GAPB(o0 = A2_MFMA(A2_PAF(3), A2_VFR(3), o0), C1, 8); \
                          A2_GAPB(o1 = A2_MFMA(A2_PAF(3), A2_VFR(7), o1), C1, 12); \
      \
    att_wait_bar((gk_ ? 1 : 0) + (gv_ ? 1 : 0) + (con_ ? 1 : 0) + (iss_ ? 4 : 0)); \
    A2_RESC(); A2_ROT(); } while (0)
#define A2_DRAIN(P0, P1) do { float sacc = P0[0] + P0[1]; \
      _Pragma("unroll") for (int r = 2; r < 16; ++r) sacc += P0[r]; \
      _Pragma("unroll") for (int r = 0; r < 16; ++r) sacc += P1[r]; \
      l_run += sacc; \
      pw0 = (u4){A2_PKW(P0, 0), A2_PKW(P0, 2), A2_PKW(P0, 4), A2_PKW(P0, 6)}; pw1 = (u4){A2_PKW(P0, 8), A2_PKW(P0, 10), A2_PKW(P0, 12), A2_PKW(P0, 14)}; \
      pw2 = (u4){A2_PKW(P1, 0), A2_PKW(P1, 2), A2_PKW(P1, 4), A2_PKW(P1, 6)}; pw3 = (u4){A2_PKW(P1, 8), A2_PKW(P1, 10), A2_PKW(P1, 12), A2_PKW(P1, 14)}; \
      const ATT_LAS unsigned char* vp_ = vp0 + sl_prev; _Pragma("unroll") for (int i = 0; i < 8; ++i) A2_VRD(i); \
      o0 = A2_MFMA(A2_PAF(0), A2_VFR(0), o0); o1 = A2_MFMA(A2_PAF(0), A2_VFR(4), o1); o0 = A2_MFMA(A2_PAF(1), A2_VFR(1), o0); o1 = A2_MFMA(A2_PAF(1), A2_VFR(5), o1); \
      o0 = A2_MFMA(A2_PAF(2), A2_VFR(2), o0); o1 = A2_MFMA(A2_PAF(2), A2_VFR(6), o1); o0 = A2_MFMA(A2_PAF(3), A2_VFR(3), o0); o1 = A2_MFMA(A2_PAF(3), A2_VFR(7), o1); } while (0)
    const int nxt = unit + G; const bool has_next = nxt < 1024; A2U UN = a2_unit(has_next ? nxt : unit);
    int t = 1;
#pragma unroll 1
    for (; t + 1 < NT; t += 2) {
        A2_STEP(pB0, pB1, pA0, pA1, t);
        A2_STEP(pA0, pA1, pB0, pB1, t + 1);
    }
    if (has_next) A2_OPEN(UN, sl_cur);
    A2_DRAIN(pA0, pA1);
    { float x = l_run, y = l_run; asm volatile("s_nop 1\n\tv_permlane32_swap_b32 %0, %1" : "+v"(x), "+v"(y)); l_run = x + y; }
    const int le = lane_id(), he = le >> 5, re = le & 31;
    if (he == 0) wsf[32 + re] = l_run;
    asm volatile("s_waitcnt lgkmcnt(0)" ::: "memory");
    float inv[16];
#pragma unroll
    for (int g = 0; g < 4; ++g) { const f32x4 l4 = *(const ATT_LAS f32x4*)(wsf + 32 + 8 * g + 4 * he);
        inv[4 * g] = __builtin_amdgcn_rcpf(l4.x); inv[4 * g + 1] = __builtin_amdgcn_rcpf(l4.y); inv[4 * g + 2] = __builtin_amdgcn_rcpf(l4.z); inv[4 * g + 3] = __builtin_amdgcn_rcpf(l4.w); }
    asm volatile("; A2_EPI_BEGIN" ::: "memory");
    float ssq[2] = {0.f, 0.f};
    bf16_t* orow = ob + (size_t)(U.b * L + q0 + (le >> 2)) * D + ocol + (le & 3) * 8;
#pragma unroll
    for (int hh = 0; hh < 2; ++hh) {
#pragma unroll
        for (int r = 0; r < 16; ++r) { const float a = (hh ? o1[r] : o0[r]) * inv[r]; *(ATT_LAS bf16_t*)(stg + (crow(r, he) * 32 + re) * 2) = (bf16_t)f2bf(a); }
        asm volatile("s_waitcnt lgkmcnt(0)" ::: "memory");
#pragma unroll
        for (int i = 0; i < 2; ++i) { const u32x4 w = __builtin_bit_cast(u32x4, *(const ATT_LAS bf16x8*)(stg + (i * 16 + (le >> 2)) * 64 + (le & 3) * 16));
            *(u32x4*)(orow + (size_t)(i * 16) * D + hh * 32) = w;
            float s = 0.f;
#pragma unroll
            for (int k = 0; k < 4; ++k) { const float lo = __uint_as_float(w[k] << 16), hi_ = __uint_as_float(w[k] & 0xffff0000u); s = fmaf(lo, lo, s); s = fmaf(hi_, hi_, s); }
            ssq[i] += s; }
        asm volatile("s_waitcnt lgkmcnt(0)" ::: "memory");
    }
    { float* ossp = (float*)(p.ws + WS_OSS) + (size_t)(U.b * L + q0 + (le >> 2)) * 16 + (ocol >> 6);
#pragma unroll
      for (int i = 0; i < 2; ++i) { float s = ssq[i]; s += dppmov<0xB1>(s); s += dppmov<0x4E>(s);
          if ((le & 3) == 0) ossp[(size_t)(i * 16) * 16] = s; } }
    asm volatile("; A2_EPI_END" ::: "memory");
    if (!has_next) break;
    ATT_WAIT_BAR(6);
    unit = nxt; U = UN; rb = sl_cur;
    }
    ATT_WAIT_BAR(0);
    cj.prev = false;
#undef A2_OPEN
#undef A2_MODE
#undef A2_DMA_K
#undef A2_DMA_V
}

constexpr int LDS_BT2 = 137216, BT2_BUF = 2304, BT2_MARGIN = 64, LDS_BNEG = LDS_BT2 + 2 * BT2_BUF;
static_assert(LDS_BNEG + 128 <= 147456, "attention LDS map (group B tables)");
__device__ __forceinline__ void glds4(const void* gsrc, unsigned lds_dst) { unsigned keep;
    asm volatile("s_mov_b32 %0, m0\n\ts_mov_b32 m0, %2\n\ts_nop 0\n\tglobal_load_lds_dword %1, off\n\ts_mov_b32 m0, %0" : "=&s"(keep) : "v"(gsrc), "s"(lds_dst) : "memory"); }
struct B2U { int b, h, g, row_lo, nloc, nlocp, NT; };
__device__ __forceinline__ B2U b2_unit(int unit) { B2U u; u.b = unit >> 7; u.h = (unit >> 4) & 7; u.g = unit & 15;
    const int r0 = 4 * u.g, r3 = r0 + 3; u.row_lo = r0 - 4 < 0 ? 0 : (r0 - 4 > 56 ? 56 : r0 - 4); const int rs3 = r3 - 4 < 0 ? 0 : (r3 - 4 > 56 ? 56 : r3 - 4);
    u.nloc = rs3 + 7 - u.row_lo + 1; u.nlocp = u.nloc | 1; u.NT = u.nlocp + 4; return u; }
__device__ __forceinline__ const bf16_t* b2_row(const bf16_t* qkv, const B2U& u, int t) {
    if (t < u.nlocp) return qkv + (size_t)(u.b * L + (u.row_lo + (t < u.nloc ? t : 0)) * 64) * INW;
    return qkv + (size_t)(NTOK + u.b * CTX + (t - u.nlocp) * 64) * INW; }

__device__ __forceinline__ void attn_b2_units(const Params& p, ATT_LAS unsigned char* lds, int wv, ConvJob& cj, int vcu, int G) {
    if (vcu >= 1024) return;
    const int tid = tid_opaque(wv), lane = tid & 63, r32 = lane & 31, hi = lane >> 5; const int wid = wv;
    const bf16_t* qkv = (const bf16_t*)(p.ws + WS_QKV); bf16_t* ob = (bf16_t*)(p.ws + WS_O);
    ATT_LAS float* wsf = (ATT_LAS float*)(lds + LDS_WS) + wid * 64;
    ATT_LAS unsigned char* cvbuf = lds + LDS_CV + wid * CV_WAVE;
    ATT_LAS unsigned char* stg = lds + (wid < 4 ? 3 * SLOTB + wid * 2048 : LDS_V + 3 * SLOTB + (wid - 4) * 2048);
    const int half = wid & 3, bs = half == 0 ? 0 : half == 1 ? 8 : half == 2 ? 24 : 32;
    const int koff = (8 * wid + (lane >> 3)) * INW + (((lane & 7) ^ ((4 * wid + (lane >> 4)) & 7)) * 8), voff = (16 * (wid & 3) + (lane >> 2)) * INW + (wid >> 2) * 32 + (lane & 3) * 8;
    const ATT_LAS unsigned char* vp0 = lds + LDS_V + ((lane >> 4) & 1) * 32 + (lane & 3) * 8 + (4 * hi + ((lane & 15) >> 2)) * 64;
    const ATT_LAS unsigned char* kp0 = lds + LDS_K;
    const bool kflip = half == 1 || half == 2;
    unsigned kq[4];
#define B2_KQ_CTX() do { const int ln_ = lane_id(), r_ = ln_ & 31, h_ = ln_ >> 5; _Pragma("unroll") for (int d0 = 0; d0 < 4; ++d0) kq[d0] = (unsigned)(r_ * 128 + (((2 * d0 + h_) ^ ((r_ >> 1) & 7)) * 16)); } while (0)
#define B2_KQ_LOC() do { const int ln_ = lane_id(), r_ = ln_ & 31, h_ = ln_ >> 5; _Pragma("unroll") for (int d0 = 0; d0 < 4; ++d0) kq[d0] = (unsigned)((bs + r_) * 128 + (((2 * (d0 ^ (kflip ? 2 : 0)) + h_) ^ ((r_ >> 1) & 7)) * 16)); } while (0)
    const int qc = 16 * half + (r32 & 15);
    if (tid < 32) *(ATT_LAS float*)(lds + LDS_BNEG + tid * 4) = NEGBIG;
    if (tid < 32) { *(ATT_LAS float*)(lds + LDS_BT2 + (tid & 15) * 4 + (tid >> 4) * BT2_BUF) = 0.f; }
#define A2_DMA_K(U, t, slot) glds16(b2_row(qkv, U, t) + (C_KB + (U).h * 64) + koff, (unsigned)__builtin_amdgcn_readfirstlane(lds_addr(lds + LDS_K + wid * 1024) + (unsigned)(slot)))
#define A2_DMA_V(U, t, slot) glds16(b2_row(qkv, U, t) + (C_VB + (U).h * 64) + voff, (unsigned)__builtin_amdgcn_readfirstlane(lds_addr(lds + LDS_V + wid * 1024) + (unsigned)(slot)))
#define A2_MODE(t) 0
#define B2_OPEN(U, RB, PAR) do { A2_DMA_K(U, 0, RB); A2_DMA_V(U, 0, RB); A2_DMA_K(U, 1, A2_SLOT3((RB) + SLOTB)); A2_DMA_K(U, 2, A2_SLOT3((RB) + 2 * SLOTB)); \
        const int lo_ = lane_id();                                                                         \
        { const int e_ = wid * 64 + lo_; glds4(p.rpb_b + (size_t)(U).h * 465 + (e_ < 465 ? e_ : 464), (unsigned)__builtin_amdgcn_readfirstlane(lds_addr(lds + LDS_BT2 + (PAR) * BT2_BUF + BT2_MARGIN + wid * 256))); } \
        const bf16_t* qp_ = qkv + (size_t)((U).b * L + (4 * (U).g + 2 * (wid >> 2) + ((lo_ >> 4) & 1)) * 64 + 16 * half + (lo_ & 15)) * INW + C_QB + (U).h * 64 + (lo_ >> 5) * 8; \
        A2_QLD(qf[0], qp_, 0); A2_QLD(qf[1], qp_, 32); A2_QLD(qf[2], qp_, 64); A2_QLD(qf[3], qp_, 96); } while (0)
    bf16x8 qf[4];
    int unit = vcu, rb = 0, par = 0;
    B2U U = b2_unit(unit);
    B2_OPEN(U, rb, par);
    ATT_WAIT_BAR(0);
    f32x16 negm;
#pragma unroll 1
    for (;;) {
    const int NT = U.NT, nlocp = U.nlocp, qrw = 4 * U.g + 2 * (wid >> 2), ocol = 512 + U.h * 64;
    const int qr = qrw + (r32 >> 4), rsq = qr - 4 < 0 ? 0 : (qr - 4 > 56 ? 56 : qr - 4), tlo = rsq - U.row_lo;
    const unsigned bbase = lds_addr(lds + LDS_BT2 + par * BT2_BUF + BT2_MARGIN) + (unsigned)(((U.row_lo - qr + 7) * 31 + 15 - qc + bs + 4 * hi) * 4);
#define B2_BP(t) (((unsigned)((t) - tlo) < 8u) ? bbase + (unsigned)((t) * 124) : lds_addr(lds + LDS_BNEG))
#define B2_CINIT(X, t) do { const ATT_LAS float* bp_ = (const ATT_LAS float*)(ATT_LAS unsigned char*)(unsigned long long)B2_BP(t); \
        _Pragma("unroll") for (int r = 0; r < 16; ++r) X[r] = __builtin_fmaf(bp_[(r & 3) + 8 * (r >> 2)], LOG2E, negm[r]); } while (0)
#define B2_NEGMASK() do { const int ln_ = lane_id(), qc_ = 16 * half + (ln_ & 15), cs_ = qc_ - 8 < 0 ? 0 : (qc_ - 8 > 48 ? 48 : qc_ - 8), e0_ = bs + 4 * (ln_ >> 5) - cs_;     \
        _Pragma("unroll") for (int r = 0; r < 16; ++r) negm[r] = ((unsigned)((r & 3) + 8 * (r >> 2) + e0_) < 16u) ? -mref : NEGBIG; } while (0)
    float mref = 0.f, l_run = 0.f;
    f32x16 o0, o1; float zero_ = 0.f; A2_PIN(zero_);
#pragma unroll
    for (int r = 0; r < 16; ++r) { o0[r] = zero_; o1[r] = zero_; }
    B2_NEGMASK(); A2_PIN(negm);
    bool resc = false;
    f32x16 pA0, pA1, pB0, pB1; bf16x8 kf[8]; s16x4 vlo[8], vhi[8];
    typedef unsigned u4 __attribute__((ext_vector_type(4)));
    u4 pw0, pw1, pw2, pw3;
    int sl_prev = rb, sl_cur = rb, sl_next = A2_SLOT3(rb + SLOTB);
#define B2_DECIDE_L(C0) do { float a_ = max3f(C0[0], C0[1], C0[2]), b_ = max3f(C0[3], C0[4], C0[5]); \
        a_ = max3f(a_, C0[6], C0[7]); b_ = max3f(b_, C0[8], C0[9]); a_ = max3f(a_, C0[10], C0[11]); b_ = max3f(b_, C0[12], C0[13]); a_ = max3f(a_, C0[14], C0[15]); \
        float x_ = __builtin_fmaxf(a_, b_), y_ = x_; asm volatile("s_nop 1\n\tv_permlane32_swap_b32 %0, %1" : "+v"(x_), "+v"(y_)); const float rm_ = __builtin_fmaxf(x_, y_); resc = false; \
        if (__builtin_expect(__any(rm_ > 8.f), 0)) { const float dl_ = __builtin_fmaxf(rm_, 0.f); mref += dl_; const float f_ = __builtin_amdgcn_exp2f(-dl_); l_run *= f_; { const int lw_ = lane_id(); if (lw_ < 32) wsf[lw_] = f_; } resc = true; \
            _Pragma("unroll") for (int r = 0; r < 16; ++r) C0[r] -= dl_; B2_NEGMASK(); } } while (0)
    B2_KQ_LOC();
    B2_CINIT(pA0, 0);
    { const ATT_LAS unsigned char* kb_ = kp0 + sl_cur;
#pragma unroll
      for (int d0 = 0; d0 < 4; ++d0) kf[2 * d0] = *(const ATT_LAS bf16x8*)(kb_ + kq[d0]); }
    pA0 = A2_MFMA(kf[0], qf[0], pA0); pA0 = A2_MFMA(kf[2], qf[1], pA0); pA0 = A2_MFMA(kf[4], qf[2], pA0); pA0 = A2_MFMA(kf[6], qf[3], pA0);
    B2_DECIDE_L(pA0);
#pragma unroll
    for (int r = 0; r < 16; ++r) pA0[r] = A2_EX(pA0[r]);
    asm volatile("s_waitcnt lgkmcnt(0)\n\ts_barrier" ::: "memory");
    A2_DMA_K(U, 3, sl_cur); A2_DMA_V(U, 1, sl_next); A2_ROT();
    B2_CINIT(pB0, 1);
    { const ATT_LAS unsigned char* kb_ = kp0 + sl_cur;
#pragma unroll
      for (int d0 = 0; d0 < 4; ++d0) kf[2 * d0] = *(const ATT_LAS bf16x8*)(kb_ + kq[d0]); }
    asm volatile("s_waitcnt lgkmcnt(0)\n\ts_barrier" ::: "memory");
#define B2_KRDL(NC, d0) do { if (NC) kload2(kf, kp0 + sl_next, kq, d0); else kf[2 * (d0)] = *(const ATT_LAS bf16x8*)(kp0 + sl_next + kq[d0]); A2_SBAR(); } while (0)
#define B2_CIN4(X, bp_, i) do { X[i] = __builtin_fmaf(bp_[((i) & 3) + 8 * ((i) >> 2)], LOG2E, negm[i]); X[(i) + 1] = __builtin_fmaf(bp_[(((i) + 1) & 3) + 8 * (((i) + 1) >> 2)], LOG2E, negm[(i) + 1]); \
        X[(i) + 2] = __builtin_fmaf(bp_[(((i) + 2) & 3) + 8 * (((i) + 2) >> 2)], LOG2E, negm[(i) + 2]); X[(i) + 3] = __builtin_fmaf(bp_[(((i) + 3) & 3) + 8 * (((i) + 3) >> 2)], LOG2E, negm[(i) + 3]); } while (0)
#define B2_STEP_LL(C0, P0, T) do { A2_SBAR(); \
      \
    const bool con_ = cj.nfl == 2 || (cj.nfl > 0 && cj.it >= cj.end && !cj.prev);                          \
    if (con_) { cv_consume(p, cj.con, lane, cvbuf + cj.pc * CV_BUF); cj.con += cj.stride; --cj.nfl; cj.pc ^= 1; } \
    const bool iss_ = cj.it < cj.end && cj.nfl < 2 && cj.cnt < CV_DUTY; cj.cnt = cj.cnt + 1 == CV_PERIOD ? 0 : cj.cnt + 1;     \
    if (iss_) { cv_issue(p, cj.it, lane, cvbuf + cj.pi * CV_BUF); cj.it += cj.stride; ++cj.nfl; cj.pi ^= 1; } \
    cj.prev = iss_; A2_SBAR(); \
    const int t_ = (T); const bool gk_ = t_ + 3 < NT, gv_ = t_ + 1 < NT, nc_ = t_ + 1 >= nlocp; \
    const ATT_LAS unsigned char* vp_ = vp0 + sl_prev + bs * 64; \
    if (nc_) B2_KQ_CTX();                                                                                \
    float sacc = P0[0] + P0[1]; \
                        A2_GAPA(C0 = A2_MFMA(kf[0], qf[0], C0), P0[2], P0[3], P0[4], P0[5],     pw0[0] = A2_PKW(P0, 0),  pw0[1] = A2_PKW(P0, 2),  pw0); \
                        A2_GAPA(C0 = A2_MFMA(kf[2], qf[1], C0), P0[6], P0[7], P0[8], P0[9],     pw0[2] = A2_PKW(P0, 4),  pw0[3] = A2_PKW(P0, 6),  pw0); \
    B2_KRDL(nc_, 0);    A2_GAPA(C0 = A2_MFMA(kf[4], qf[2], C0), P0[10], P0[11], P0[12], P0[13], pw1[0] = A2_PKW(P0, 8),  pw1[1] = A2_PKW(P0, 10), pw1); \
    B2_KRDL(nc_, 1);    A2_GAPA(C0 = A2_MFMA(kf[6], qf[3], C0), P0[14], P0[15], 0.f, 0.f,       pw1[2] = A2_PKW(P0, 12), pw1[3] = A2_PKW(P0, 14), pw1); \
    l_run += sacc; \
    A2_VRD(0); A2_VRD(4); A2_SBAR(); \
    if (gk_) A2_DMA_K(U, t_ + 3, sl_cur); if (gv_) A2_DMA_V(U, t_ + 1, sl_next); \
    B2_DECIDE_L(C0); A2_SBAR(); \
    const ATT_LAS float* bpn_ = (const ATT_LAS float*)(ATT_LAS unsigned char*)(unsigned long long)B2_BP(t_ + 1); \
    B2_KRDL(nc_, 2); \
    A2_VRD(1); A2_SBAR(); if (!nc_) B2_CIN4(P0, bpn_, 0);  A2_GAPB(o0 = A2_MFMA(A2_PAF(0), A2_VFR(0), o0), C0, 0); \
    A2_VRD(5); A2_SBAR(); if (!nc_) B2_CIN4(P0, bpn_, 4);  A2_GAPB(o1 = A2_MFMA(A2_PAF(0), A2_VFR(4), o1), C0, 4); \
    B2_KRDL(nc_, 3);      if (!nc_) B2_CIN4(P0, bpn_, 8);  A2_GAPB(o0 = A2_MFMA(A2_PAF(1), A2_VFR(1), o0), C0, 8); \
                          if (!nc_) B2_CIN4(P0, bpn_, 12); A2_GAPB(o1 = A2_MFMA(A2_PAF(1), A2_VFR(5), o1), C0, 12); \
    A2_PIN(P0); \
    att_wait_bar((gk_ ? 1 : 0) + (gv_ ? 1 : 0) + (con_ ? 1 : 0) + (iss_ ? 4 : 0)); \
    A2_RESC(); A2_ROT(); } while (0)
#define B2_GAPA2(MF, a0, a1, W0, PW) do { MF; sacc += a0; sacc += a1; W0; A2_PIN(PW); A2_PIN(sacc); A2_SBAR(); } while (0)
#define B2_GAPB8(MF, X, i) do { MF; _Pragma("unroll") for (int q_ = 0; q_ < 8; ++q_) X[(i) + q_] = A2_EX(X[(i) + q_]); A2_PIN(X); A2_SBAR(); } while (0)
#define B2_STEP_LC(C0, C1, P0, T) do { A2_SBAR(); \
      \
    const bool con_ = cj.nfl == 2 || (cj.nfl > 0 && cj.it >= cj.end && !cj.prev);                          \
    if (con_) { cv_consume(p, cj.con, lane, cvbuf + cj.pc * CV_BUF); cj.con += cj.stride; --cj.nfl; cj.pc ^= 1; } \
    const bool iss_ = cj.it < cj.end && cj.nfl < 2 && cj.cnt < CV_DUTY; cj.cnt = cj.cnt + 1 == CV_PERIOD ? 0 : cj.cnt + 1;     \
    if (iss_) { cv_issue(p, cj.it, lane, cvbuf + cj.pi * CV_BUF); cj.it += cj.stride; ++cj.nfl; cj.pi ^= 1; } \
    cj.prev = iss_; A2_SBAR(); \
    const int t_ = (T); const bool gk_ = t_ + 3 < NT, gv_ = t_ + 1 < NT; \
    _Pragma("unroll") for (int r = 0; r < 16; ++r) negm[r] = -mref;                                     \
    A2_PIN(negm); \
    const ATT_LAS unsigned char* vp_ = vp0 + sl_prev + bs * 64; \
    float sacc = P0[0] + P0[1]; \
                    B2_GAPA2(C0 = A2_MFMA(kf[0], qf[0], negm), P0[2], P0[3],   pw0[0] = A2_PKW(P0, 0),  pw0); \
                    B2_GAPA2(C1 = A2_MFMA(kf[1], qf[0], negm), P0[4], P0[5],   pw0[1] = A2_PKW(P0, 2),  pw0); \
                    B2_GAPA2(C0 = A2_MFMA(kf[2], qf[1], C0),   P0[6], P0[7],   pw0[2] = A2_PKW(P0, 4),  pw0); \
    A2_KRD(gv_, 0); B2_GAPA2(C1 = A2_MFMA(kf[3], qf[1], C1),   P0[8], P0[9],   pw0[3] = A2_PKW(P0, 6),  pw0); \
                    B2_GAPA2(C0 = A2_MFMA(kf[4], qf[2], C0),   P0[10], P0[11], pw1[0] = A2_PKW(P0, 8),  pw1); \
    A2_KRD(gv_, 1); B2_GAPA2(C1 = A2_MFMA(kf[5], qf[2], C1),   P0[12], P0[13], pw1[1] = A2_PKW(P0, 10), pw1); \
                    B2_GAPA2(C0 = A2_MFMA(kf[6], qf[3], C0),   P0[14], P0[15], pw1[2] = A2_PKW(P0, 12), pw1); \
    A2_KRD(gv_, 2); B2_GAPA2(C1 = A2_MFMA(kf[7], qf[3], C1),   0.f, 0.f,       pw1[3] = A2_PKW(P0, 14), pw1); \
    l_run += sacc; \
    A2_VRD(0); A2_VRD(4); A2_SBAR(); \
    if (gk_) A2_DMA_K(U, t_ + 3, sl_cur); if (gv_) A2_DMA_V(U, t_ + 1, sl_next); \
    A2_DECIDE(C0, C1, 0); A2_SBAR(); \
    A2_KRD(gv_, 3); \
    A2_VRD(1); A2_SBAR(); B2_GAPB8(o0 = A2_MFMA(A2_PAF(0), A2_VFR(0), o0), C0, 0); \
    A2_VRD(5); A2_SBAR(); B2_GAPB8(o1 = A2_MFMA(A2_PAF(0), A2_VFR(4), o1), C0, 8); \
                          B2_GAPB8(o0 = A2_MFMA(A2_PAF(1), A2_VFR(1), o0), C1, 0); \
                          B2_GAPB8(o1 = A2_MFMA(A2_PAF(1), A2_VFR(5), o1), C1, 8); \
    att_wait_bar((gk_ ? 1 : 0) + (gv_ ? 1 : 0) + (con_ ? 1 : 0) + (iss_ ? 4 : 0)); \
    A2_RESC(); A2_ROT(); } while (0)
    const int nxt = unit + G; const bool has_next = nxt < 1024; B2U UN = b2_unit(has_next ? nxt : unit);
    int t = 1;
#pragma unroll 1
    for (; t + 1 < nlocp; t += 2) {
        B2_STEP_LL(pB0, pA0, t);
        B2_STEP_LL(pA0, pB0, t + 1);
    }
    B2_STEP_LC(pB0, pB1, pA0, t);
    A2_STEP(pA0, pA1, pB0, pB1, t + 1);
#pragma unroll 1
    for (int k = 0; k < 1; ++k) {
        A2_STEP(pB0, pB1, pA0, pA1, t + 2);
        A2_STEP(pA0, pA1, pB0, pB1, t + 3);
    }
    if (has_next) B2_OPEN(UN, sl_cur, par ^ 1);
    A2_DRAIN(pA0, pA1);
    { float x = l_run, y = l_run; asm volatile("s_nop 1\n\tv_permlane32_swap_b32 %0, %1" : "+v"(x), "+v"(y)); l_run = x + y; }
    const int le = lane_id(), he = le >> 5, re = le & 31;
    if (he == 0) wsf[32 + re] = l_run;
    asm volatile("s_waitcnt lgkmcnt(0)" ::: "memory");
    float inv[16];
#pragma unroll
    for (int g = 0; g < 4; ++g) { const f32x4 l4 = *(const ATT_LAS f32x4*)(wsf + 32 + 8 * g + 4 * he);
        inv[4 * g] = __builtin_amdgcn_rcpf(l4.x); inv[4 * g + 1] = __builtin_amdgcn_rcpf(l4.y); inv[4 * g + 2] = __builtin_amdgcn_rcpf(l4.z); inv[4 * g + 3] = __builtin_amdgcn_rcpf(l4.w); }
    asm volatile("; B2_EPI_BEGIN" ::: "memory");
    float ssq[2] = {0.f, 0.f};
    const size_t tok0 = (size_t)(U.b * L + qrw * 64 + 16 * half + (le >> 2));
    bf16_t* orow = ob + tok0 * D + ocol + (le & 3) * 8;
#pragma unroll
    for (int hh = 0; hh < 2; ++hh) {
#pragma unroll
        for (int r = 0; r < 16; ++r) { const float a = (hh ? o1[r] : o0[r]) * inv[r]; *(ATT_LAS bf16_t*)(stg + (crow(r, he) * 32 + re) * 2) = (bf16_t)f2bf(a); }
        asm volatile("s_waitcnt lgkmcnt(0)" ::: "memory");
#pragma unroll
        for (int i = 0; i < 2; ++i) { const u32x4 w = __builtin_bit_cast(u32x4, *(const ATT_LAS bf16x8*)(stg + (i * 16 + (le >> 2)) * 64 + (le & 3) * 16));
            *(u32x4*)(orow + (size_t)(i * 64) * D + hh * 32) = w;
            float s = 0.f;
#pragma unroll
            for (int k = 0; k < 4; ++k) { const float lo = __uint_as_float(w[k] << 16), hi_ = __uint_as_float(w[k] & 0xffff0000u); s = fmaf(lo, lo, s); s = fmaf(hi_, hi_, s); }
            ssq[i] += s; }
        asm volatile("s_waitcnt lgkmcnt(0)" ::: "memory");
    }
    { float* ossp = (float*)(p.ws + WS_OSS) + tok0 * 16 + (ocol >> 6);
#pragma unroll
      for (int i = 0; i < 2; ++i) { float s = ssq[i]; s += dppmov<0xB1>(s); s += dppmov<0x4E>(s);
          if ((le & 3) == 0) ossp[(size_t)(i * 64) * 16] = s; } }
    asm volatile("; B2_EPI_END" ::: "memory");
    if (!has_next) break;
    ATT_WAIT_BAR(6);
    unit = nxt; U = UN; rb = sl_cur; par ^= 1;
    }
    ATT_WAIT_BAR(0);
    cj.prev = false;
#undef B2_OPEN
#undef B2_KQ_CTX
#undef B2_KQ_LOC
#undef B2_BP
#undef B2_CINIT
#undef B2_NEGMASK
#undef B2_DECIDE_L
#undef B2_KRDL
#undef B2_CIN4
#undef B2_STEP_LL
#undef B2_GAPA2
#undef B2_GAPB8
#undef B2_STEP_LC
#undef A2_MODE
#undef A2_DMA_K
#undef A2_DMA_V
}

__device__ __forceinline__ void attn_phase(const Params& p, ATT_LAS unsigned char* lds, int wv) {
    const int G = gridDim.x, bx = blockIdx.x;
    const int vcu = (G % 8 == 0) ? (bx % 8) * (G / 8) + bx / 8 : bx;
    ConvJob cj; cj.stride = 8 * G; cj.it = bx * 8 + wv; cj.end = CV_ITEMS; cj.con = cj.it; cj.nfl = 0; cj.pi = 0; cj.pc = 0; cj.cnt = 0; cj.prev = false;
    attn_a2_units(p, lds, wv, cj, vcu, G);
    attn_b2_units(p, lds, wv, cj, vcu, G);
    { const int lane = lane_id(); ATT_LAS unsigned char* cvbuf = lds + LDS_CV + wv * CV_WAVE;
      asm volatile("s_waitcnt vmcnt(0)" ::: "memory");
      while (cj.nfl > 0) { cv_consume(p, cj.con, lane, cvbuf + cj.pc * CV_BUF); cj.con += cj.stride; --cj.nfl; cj.pc ^= 1; }
      while (cj.it < cj.end) { cv_issue(p, cj.it, lane, cvbuf); asm volatile("s_waitcnt vmcnt(0)" ::: "memory"); cv_consume(p, cj.it, lane, cvbuf); cj.it += cj.stride; } }
}
}

constexpr int SW_STRIDE = 36;

__device__ void p4c_post(const Params& p, LAS3 float* sW, int wv) {
    const int tid = tid_opaque(wv), lane = tid & 63;
    const float* mod = (const float*)(p.ws + WS_MOD); const bf16_t* mix = (const bf16_t*)(p.ws + WS_MIX);
    unsigned char* h8 = p.ws + WS_HB;
    bf16_t* x1b = (bf16_t*)(p.ws + WS_X1);
    unsigned* counts = (unsigned*)(p.ws + WS_CTL);
    int* eslot = (int*)(p.ws + WS_ESLOT); float* ew = (float*)(p.ws + WS_EW);
    const int wave = tid >> 6;
    LAS3 int* lcnt = (LAS3 int*)(sW + 1024 * SW_STRIDE) + 128;
    LAS3 int* lbase = lcnt + 32;
    LAS3 int* stg_slot = lbase + 32; LAS3 int* stg_e = stg_slot + 512; LAS3 float* stg_w = (LAS3 float*)(stg_e + 512);
    if (tid < NE) lcnt[tid] = 0;
    for (int i = tid; i < D * 8; i += NTHREADS) { const int k = i >> 3, e4 = i & 7; const f32x4 w = ((const f32x4*)p.w_router)[i];
        LAS3 float* d = sW + ((k & 3) * 256 + (k >> 2)) * SW_STRIDE + e4 * 4; *(LAS3 f32x4*)d = w; }
    __syncthreads();
    constexpr int R = 16;
    const int m0 = ((int)blockIdx.x * (NTHREADS / 64) + wave) * R;
    if (m0 < NTOK) {
        const int b = m0 / L; const float* mb = mod + b * 6144;
        f32x4 pA[4], pB[4], pC[4], v[4], xx[4], nx[4]; u32x2 nv[4];
#pragma unroll
        for (int j = 0; j < 4; ++j) { const int c0 = 4 * (lane + 64 * j);
            pA[j] = *(const f32x4*)(p.g_post_mix + c0) * *(const f32x4*)(mb + 2048 + c0);
            pB[j] = *(const f32x4*)(p.g_pre_ffn + c0) * (*(const f32x4*)(mb + 4096 + c0) + 1.f);
            pC[j] = *(const f32x4*)(mb + 3072 + c0);
            nv[j] = ((const u32x2*)(mix + (size_t)m0 * D))[lane + 64 * j]; nx[j] = ((const f32x4*)(p.x + (size_t)m0 * D))[lane + 64 * j]; }
        const float brt0 = p.b_router[lane & 15], brt1 = p.b_router[16 + (lane & 15)];
#pragma unroll 1
        for (int it = 0; it < R; ++it) {
            const int m = m0 + it;
#pragma unroll
            for (int j = 0; j < 4; ++j) { v[j] = (f32x4){__uint_as_float(nv[j].x << 16), __uint_as_float(nv[j].x & 0xffff0000u), __uint_as_float(nv[j].y << 16), __uint_as_float(nv[j].y & 0xffff0000u)}; xx[j] = nx[j]; }
            if (it + 1 < R) {
#pragma unroll
                for (int j = 0; j < 4; ++j) { nv[j] = ((const u32x2*)(mix + (size_t)(m + 1) * D))[lane + 64 * j]; nx[j] = ((const f32x4*)(p.x + (size_t)(m + 1) * D))[lane + 64 * j]; }
            }
            float s = 0.f;
#pragma unroll
            for (int j = 0; j < 4; ++j) s += v[j].x * v[j].x + v[j].y * v[j].y + v[j].z * v[j].z + v[j].w * v[j].w;
            float rstd = rsqrtf(wave_sum(s) * (1.f / D) + EPS);
            s = 0.f;
            f32x4 xv[4];
#pragma unroll
            for (int j = 0; j < 4; ++j) {
                xv[j] = xx[j] + pA[j] * (v[j] * rstd);
                { u32x2 w_; w_.x = pk2(xv[j].x, xv[j].y); w_.y = pk2(xv[j].z, xv[j].w); ((u32x2*)(x1b + (size_t)m * D))[lane + 64 * j] = w_; }
                s += xv[j].x * xv[j].x + xv[j].y * xv[j].y + xv[j].z * xv[j].z + xv[j].w * xv[j].w; }
            rstd = rsqrtf(wave_sum(s) * (1.f / D) + EPS);
            f32x4 h2v[4];
#pragma unroll
            for (int j = 0; j < 4; ++j) { const int c0 = 4 * (lane + 64 * j);
                h2v[j] = (xv[j] * rstd) * pB[j] + pC[j];
                *(unsigned*)(h8 + (size_t)m * D + c0) = pk4_fp8(h2v[j].x, h2v[j].y, h2v[j].z, h2v[j].w); }
            const int li = lane & 15;
            typedef float f32x2 __attribute__((ext_vector_type(2)));
            LAS3 unsigned char* lb0 = (LAS3 unsigned char*)sW + lane * (SW_STRIDE * 4); LAS3 unsigned char* lb1 = lb0 + 49152; LAS3 unsigned char* lb2 = lb0 + 98304;
            asm volatile("" : "+v"(lb0), "+v"(lb1), "+v"(lb2));
            float zz[2];
#pragma unroll
            for (int ps = 0; ps < 2; ++ps) {
                f32x2 lg2[8];
#pragma unroll
                for (int e = 0; e < 8; ++e) lg2[e] = (f32x2){0.f, 0.f};
#define P4C_WADDR(g) ((((((g) & 3) * 256 + 64 * ((g) >> 2)) * SW_STRIDE * 4 + ps * 64) < 49152 ? lb0 : ((((g) & 3) * 256 + 64 * ((g) >> 2)) * SW_STRIDE * 4 + ps * 64) < 98304 ? lb1 : lb2) + \
                      (((((g) & 3) * 256 + 64 * ((g) >> 2)) * SW_STRIDE * 4 + ps * 64) % 49152))
#define P4C_LOADW(W, g) do { const LAS3 f32x4* wr_ = (const LAS3 f32x4*)P4C_WADDR(g); W[0] = wr_[0]; W[1] = wr_[1]; W[2] = wr_[2]; W[3] = wr_[3]; } while (0)
#define P4C_FMAS(W, g) do { const float hv_ = h2v[(g) >> 2][(g) & 3]; const f32x2 hv2_ = {hv_, hv_}; \
                    _Pragma("unroll") for (int e4 = 0; e4 < 4; ++e4) { lg2[2 * e4] = __builtin_elementwise_fma(hv2_, (f32x2){W[e4].x, W[e4].y}, lg2[2 * e4]); lg2[2 * e4 + 1] = __builtin_elementwise_fma(hv2_, (f32x2){W[e4].z, W[e4].w}, lg2[2 * e4 + 1]); } \
                    asm volatile("" : "+v"(lg2[0]), "+v"(lg2[1]), "+v"(lg2[2]), "+v"(lg2[3]), "+v"(lg2[4]), "+v"(lg2[5]), "+v"(lg2[6]), "+v"(lg2[7]) :: "memory"); } while (0)
                f32x4 wA[4], wB[4];
                P4C_LOADW(wA, 0);
#pragma unroll
                for (int g = 0; g < 16; g += 2) {
                    P4C_LOADW(wB, g + 1); P4C_FMAS(wA, g);
                    if (g + 2 < 16) P4C_LOADW(wA, g + 2);
                    P4C_FMAS(wB, g + 1); }
#undef P4C_WADDR
#undef P4C_LOADW
#undef P4C_FMAS
                float lg[16];
#pragma unroll
                for (int e = 0; e < 16; ++e) lg[e] = lg2[e >> 1][e & 1];
                float w8[8], w4[4], w2[2], z;
                { const bool up = li >= 8;
#pragma unroll
                  for (int j = 0; j < 8; ++j) { const float keep = up ? lg[8 + j] : lg[j], send = up ? lg[j] : lg[8 + j]; w8[j] = keep + dppmov<0x140>(send); } }
                { const bool up = (li & 7) >= 4;
#pragma unroll
                  for (int j = 0; j < 4; ++j) { const float keep = up ? w8[4 + j] : w8[j], send = up ? w8[j] : w8[4 + j]; w4[j] = keep + dppmov<0x141>(send); } }
                { const bool up = (li & 2) != 0;
#pragma unroll
                  for (int j = 0; j < 2; ++j) { const float keep = up ? w4[2 + j] : w4[j], send = up ? w4[j] : w4[2 + j]; w2[j] = keep + dppmov<0x4E>(send); } }
                { const bool up = (li & 1) != 0; const float keep = up ? w2[1] : w2[0], send = up ? w2[0] : w2[1]; z = keep + dppmov<0xB1>(send); }
                z += __shfl_xor(z, 16); z += __shfl_xor(z, 32);
                zz[ps] = z;
            }
            float z0 = zz[0] + brt0, z1 = zz[1] + brt1;
            float tv[4]; int ti[4];
#pragma unroll
            for (int k = 0; k < 4; ++k) {
                const bool first = z0 >= z1; const float bv = first ? z0 : z1;
                float mx = fmaxf(bv, dppmov<0xB1>(bv)); mx = fmaxf(mx, dppmov<0x4E>(mx)); mx = fmaxf(mx, dppmov<0x141>(mx)); mx = fmaxf(mx, dppmov<0x140>(mx));
                int ce = (bv == mx) ? (first ? li : 16 + li) : 99;
                { int o = __builtin_amdgcn_update_dpp(0, ce, 0xB1, 0xf, 0xf, true); ce = ce < o ? ce : o; o = __builtin_amdgcn_update_dpp(0, ce, 0x4E, 0xf, 0xf, true); ce = ce < o ? ce : o;
                  o = __builtin_amdgcn_update_dpp(0, ce, 0x141, 0xf, 0xf, true); ce = ce < o ? ce : o; o = __builtin_amdgcn_update_dpp(0, ce, 0x140, 0xf, 0xf, true); ce = ce < o ? ce : o; }
                ti[k] = __builtin_amdgcn_readfirstlane(ce); tv[k] = mx;
                { const bool mine = li == (ti[k] & 15); z0 = (mine && ti[k] < 16) ? -3.4e38f : z0; z1 = (mine && ti[k] >= 16) ? -3.4e38f : z1; }
            }
            const float e1 = __expf(tv[1] - tv[0]), e2 = __expf(tv[2] - tv[0]), e3 = __expf(tv[3] - tv[0]); const float inv = 1.f / (1.f + e1 + e2 + e3);
            const float tw[4] = {inv, e1 * inv, e2 * inv, e3 * inv};
            if (lane < 4) {
                int myi = ti[0]; float myw = tw[0];
#pragma unroll
                for (int k = 1; k < 4; ++k) if (lane == k) { myi = ti[k]; myw = tw[k]; }
                const int lr = __hip_atomic_fetch_add((LAS3 int*)&lcnt[myi], 1, __ATOMIC_RELAXED, __HIP_MEMORY_SCOPE_WORKGROUP);
                const int si = (wave * 16 + it) * 4 + lane;
                stg_slot[si] = m * 4 + lane; stg_e[si] = myi | (lr << 8); stg_w[si] = myw;
            }
        }
    }
    __syncthreads();
    if (tid < NE) { const int c = lcnt[tid]; lbase[tid] = c ? (int)atomicAdd(&counts[tid * 64], (unsigned)c) : 0; }
    __syncthreads();
    { const int si = tid, w = si >> 6;
      if (((int)blockIdx.x * (NTHREADS / 64) + w) * R < NTOK) {
        const int ee = stg_e[si], e = ee & 255, lr = ee >> 8; const int rank = lbase[e] + lr;
        eslot[(size_t)e * ECAP + rank] = stg_slot[si]; ew[(size_t)e * ECAP + rank] = stg_w[si]; } }
    __syncthreads();
}
__device__ __forceinline__ void expert_bases(const unsigned* counts, int* sbase_  , int wv) {
    LAS3 int* sbase = (LAS3 int*)sbase_;
    if (wv == 0) {
        const int lane = lane_id(); const int cn = lane < NE ? (int)counts[lane * 64] : 0; const int c = (cn + 255) & ~255;
        int incl = c;
#pragma unroll
        for (int o = 1; o < 32; o <<= 1) { const int v = __shfl_up(incl, o); if (lane >= o) incl += v; }
        if (lane < NE) { sbase[lane] = incl - c; sbase[40 + lane] = cn; }
        if (lane == NE - 1) sbase[NE] = incl;
    }
    __syncthreads();
}
typedef float f32x2v __attribute__((ext_vector_type(2)));
__device__ __forceinline__ void p6_load(const unsigned char* y, const bf16_t* x1b, int m, int lane, u32x2 (&yv)[2][4], u32x4 (&xv)[2]) {
#pragma unroll
    for (int j = 0; j < 2; ++j) { const int c0 = 8 * (lane + 64 * j);
#pragma unroll
        for (int k = 0; k < 4; ++k) yv[j][k] = *(const u32x2*)(y + (size_t)(m * 4 + k) * D + c0);
        xv[j] = *(const u32x4*)(x1b + (size_t)m * D + c0); }
}
__device__ void p6_final(const Params& p, int wv) {
    const int tid = tid_opaque(wv), lane = tid & 63;
    const float* mod = (const float*)(p.ws + WS_MOD); const unsigned char* y = p.ws + WS_Y;
    constexpr int R = 16;
    const int m0 = ((int)blockIdx.x * (NTHREADS / 64) + (tid >> 6)) * R;
    if (m0 >= NTOK) return;
    const int b = m0 / L; const float* ga2 = mod + b * 6144 + 5120;
    f32x4 pA[2][2];
#pragma unroll
    for (int j = 0; j < 2; ++j)
#pragma unroll
        for (int q = 0; q < 2; ++q) { const int c0 = 8 * (lane + 64 * j) + 4 * q; pA[j][q] = *(const f32x4*)(p.g_post_ffn + c0) * *(const f32x4*)(ga2 + c0); }
    u32x2 yv[2][4], ny[2][4]; u32x4 xv[2], nx[2]; const bf16_t* x1b = (const bf16_t*)(p.ws + WS_X1);
    p6_load(y, x1b, m0, lane, ny, nx);
    for (int it = 0; it < R; ++it) {
        const int m = m0 + it;
#pragma unroll
        for (int j = 0; j < 2; ++j) {
#pragma unroll
            for (int k = 0; k < 4; ++k) yv[j][k] = ny[j][k];
            xv[j] = nx[j]; }
        if (it + 1 < R) p6_load(y, x1b, m + 1, lane, ny, nx);
        f32x4 a[2][2]; float s = 0.f;
#pragma unroll
        for (int j = 0; j < 2; ++j) { a[j][0] = (f32x4){0.f, 0.f, 0.f, 0.f}; a[j][1] = (f32x4){0.f, 0.f, 0.f, 0.f};
#pragma unroll
            for (int k = 0; k < 4; ++k) { const u32x2 w = yv[j][k];
                const f32x2v l0 = __builtin_amdgcn_cvt_pk_f32_fp8((int)w.x, false), l1 = __builtin_amdgcn_cvt_pk_f32_fp8((int)w.x, true);
                const f32x2v h0 = __builtin_amdgcn_cvt_pk_f32_fp8((int)w.y, false), h1 = __builtin_amdgcn_cvt_pk_f32_fp8((int)w.y, true);
                a[j][0].x += l0.x; a[j][0].y += l0.y; a[j][0].z += l1.x; a[j][0].w += l1.y;
                a[j][1].x += h0.x; a[j][1].y += h0.y; a[j][1].z += h1.x; a[j][1].w += h1.y; }
#pragma unroll
            for (int q = 0; q < 2; ++q) { a[j][q] = a[j][q] * Y8_INV; s += a[j][q].x * a[j][q].x + a[j][q].y * a[j][q].y + a[j][q].z * a[j][q].z + a[j][q].w * a[j][q].w; } }
        const float rstd = rsqrtf(wave_sum(s) * (1.f / D) + EPS);
#pragma unroll
        for (int j = 0; j < 2; ++j)
#pragma unroll
            for (int q = 0; q < 2; ++q) { const int c0 = 8 * (lane + 64 * j) + 4 * q; const unsigned w0_ = q ? xv[j].z : xv[j].x, w1_ = q ? xv[j].w : xv[j].y;
                const f32x4 x1v = {__uint_as_float(w0_ << 16), __uint_as_float(w0_ & 0xffff0000u), __uint_as_float(w1_ << 16), __uint_as_float(w1_ & 0xffff0000u)};
                *(f32x4*)(p.out + (size_t)m * D + c0) = x1v + pA[j][q] * (a[j][q] * rstd); }
    }
}

constexpr int LDS_SBASE = 147456;
constexpr int LDS_BYTES = LDS_SBASE + 512 + (64 + 3 * 512) * 4 + 256;

__global__ void __launch_bounds__(NTHREADS, 2) fwd_kernel(Params p_arg) {
#if defined(__HIP_DEVICE_COMPILE__)
#define PHASE_ARGS() const Params p = *(const __attribute__((address_space(4))) Params*)__builtin_amdgcn_kernarg_segment_ptr()
#else
#define PHASE_ARGS() const Params& p = p_arg
#endif
    cg::grid_group grid = cg::this_grid();
    extern __shared__ __attribute__((aligned(16))) unsigned char lds[];
    int* sbase = (int*)(lds + LDS_SBASE);
    PG8_LAS unsigned char* lds3 = (PG8_LAS unsigned char*)lds;
    const PG8_LAS int* sbase3 = (const PG8_LAS int*)(lds3 + LDS_SBASE);
    volatile LAS3 unsigned* bst = (volatile LAS3 unsigned*)(lds3 + LDS_SBASE + 384);
    const int wv = __builtin_amdgcn_readfirstlane((int)(threadIdx.x >> 6));
    if (wv == 0 && lane_id() < 2) bst[lane_id()] = 0u;
    __syncthreads();
    XcdBarrier xb = xcd_barrier_post((unsigned*)(p_arg.ws + WS_CTL) + CW_BAR, bst, wv);

    { PHASE_ARGS();
    p0_mod(p, (float*)lds, (float*)(lds + 36864), wv);
    p0_tab(p, wv);
    p0_weights(p, lds, wv);
    if (p.ws == nullptr) grid.sync(); }
    xcd_barrier(xb);
    { PHASE_ARGS(); p1_h(p, wv); }
    xcd_barrier(xb);
    { PHASE_ARGS(); pg8::Gemm g{(const bf16_t*)(p.ws + WS_HB), (const bf16_t*)(p.ws + WS_WIN), D, 0, nullptr, sbase3, wv};
      pg8::StaticOrder S; S.init(MROWS, INW, (int)gridDim.x, (int)blockIdx.x, nullptr);
      { const int t_ = tid_opaque(wv); *(PG8_LAS f32x4*)(lds3 + pg8::PAR_TAB + t_ * 16) = ((const f32x4*)(p.ws + WS_TAB))[t_]; }
      __syncthreads();
      pg8::EpiQKV E{(bf16_t*)(p.ws + WS_QKV)};
      pg8::gemm_phase<pg8::EpiQKV, pg8::StaticOrder, false, true>(lds3, g, S, E); }
    xcd_barrier(xb);
    { PHASE_ARGS(); att::attn_phase(p, lds3, wv); }
    xcd_barrier(xb);
    { PHASE_ARGS(); pg8::Gemm g{(const bf16_t*)(p.ws + WS_O), (const bf16_t*)(p.ws + WS_WOUT), D, 0, nullptr, sbase3, wv};
      pg8::StaticOrder S; S.init(NTOK, D, (int)gridDim.x, (int)blockIdx.x, nullptr);
      pg8::EpiOutProj E{(bf16_t*)(p.ws + WS_MIX), (const float*)(p.ws + WS_OSS)};
      pg8::gemm_phase<pg8::EpiOutProj, pg8::StaticOrder, false, true>(lds3, g, S, E); }
    xcd_barrier(xb);
    { PHASE_ARGS(); p4c_post(p, (LAS3 float*)lds3, wv); }
    xcd_barrier(xb);
    { PHASE_ARGS(); expert_bases((const unsigned*)(p.ws + WS_CTL), sbase, wv);
      const int total = sbase3[NE];
      pg8::Gemm g{(const bf16_t*)(p.ws + WS_HB), (const bf16_t*)(p.ws + WS_W1), D / 2, (size_t)2048 * D, (const int*)(p.ws + WS_ESLOT), sbase3, wv};
      pg8::StaticOrder S; S.init(total, 2048, (int)gridDim.x, (int)blockIdx.x, sbase3);
      pg8::EpiSwiglu E{p.ws + WS_ACT, p.b_mlp1};
      pg8::gemm_phase<pg8::EpiSwiglu, pg8::StaticOrder, true, true, true>(lds3, g, S, E); }
    xcd_barrier(xb);
    { PHASE_ARGS(); const int total = sbase3[NE];
      pg8::Gemm g{(const bf16_t*)(p.ws + WS_ACT), (const bf16_t*)(p.ws + WS_W2), D / 2, (size_t)D * D, nullptr, sbase3, wv};
      pg8::StaticOrder S; S.init(total, D, (int)gridDim.x, (int)blockIdx.x, sbase3);
      pg8::EpiScatter E{p.ws + WS_Y, p.b_mlp2, (const int*)(p.ws + WS_ESLOT), (const float*)(p.ws + WS_EW), sbase3};
      pg8::gemm_phase<pg8::EpiScatter, pg8::StaticOrder, false, true, true>(lds3, g, S, E); }
    xcd_barrier(xb);
    { PHASE_ARGS(); p6_final(p, wv); }
#undef PHASE_ARGS
}

extern "C" void kernel_launch(void* const* d_in, const int* in_sizes, int n_in, void* d_out, int out_size, void* d_ws, size_t ws_size, hipStream_t stream) {
    static int grid_blocks = 0;
    if (grid_blocks == 0) {
        if (n_in != 22 || ws_size < WS_END) { fprintf(stderr, "kernel_launch: unexpected n_in %d / ws_size %zu (need %zu)\n", n_in, ws_size, (size_t)WS_END); grid_blocks = -1; return; }
        int dev = 0, cus = 0, per_cu = 0;
        (void)hipGetDevice(&dev);
        (void)hipDeviceGetAttribute(&cus, hipDeviceAttributeMultiprocessorCount, dev);
        if (hipFuncSetAttribute((const void*)fwd_kernel, hipFuncAttributeMaxDynamicSharedMemorySize, LDS_BYTES) != hipSuccess) { fprintf(stderr, "kernel_launch: hipFuncSetAttribute failed\n"); grid_blocks = -1; return; }
        (void)hipOccupancyMaxActiveBlocksPerMultiprocessor(&per_cu, (const void*)fwd_kernel, NTHREADS, LDS_BYTES);
        if (per_cu < 1) { fprintf(stderr, "kernel_launch: occupancy query returned %d\n", per_cu); grid_blocks = -1; return; }
        grid_blocks = cus;
        if (grid_blocks * (NTHREADS / 64) * 16 < NTOK) { fprintf(stderr, "kernel_launch: needs >= 256 CUs (got %d)\n", cus); grid_blocks = -1; return; }
    }
    if (grid_blocks < 0) return;
    (void)hipMemsetAsync((char*)d_ws + WS_CTL, 0, CTL_BYTES, stream);
    Params p{};
    const float** pp = (const float**)&p;
    for (int i = 0; i < 22; ++i) pp[i] = (const float*)d_in[i];
    p.out = (float*)d_out; p.ws = (unsigned char*)d_ws;
    void* args[] = {&p};
    hipError_t e = hipLaunchCooperativeKernel((const void*)fwd_kernel, dim3(grid_blocks), dim3(NTHREADS), args, LDS_BYTES, stream);
    if (e != hipSuccess) fprintf(stderr, "cooperative launch failed: %s (grid %d)\n", hipGetErrorString(e), grid_blocks);
}
```

```cpp
#include <hip/hip_runtime.h>
#include <hip/hip_cooperative_groups.h>
#include <cstdio>
#include <cstdint>
namespace cg = cooperative_groups;

constexpr int D = 1024, NB = 8, L = 4096, CTX = 256;
constexpr int NTOK = NB * L, NCTX = NB * CTX, MROWS = NTOK + NCTX;
constexpr int INW = 2304;
constexpr int C_QA = 0, C_KA = 512, C_VA = 640, C_QB = 768, C_KB = 1280, C_VB = 1792;
constexpr int NE = 32, TOPK = 4, NASG = NTOK * TOPK;
constexpr int PADROWS = NASG + NE * 256;
constexpr float LOG2E = 1.4426950408889634f;
constexpr float QSCALE = 0.125f * LOG2E;
constexpr float EPS = 1e-6f;
constexpr int NTHREADS = 512;

constexpr size_t MiB = 1u << 20;
constexpr size_t WS_CTL = 0;
constexpr size_t CTL_BYTES = 32768;
constexpr int CW_BAR = 2048;
constexpr size_t WS_MOD = 1 * MiB;
constexpr size_t WS_TAB = 1 * MiB + 256 * 1024;
constexpr size_t WS_OSTAT = 1 * MiB + 512 * 1024;
constexpr size_t WS_WIN = 2 * MiB;
constexpr size_t WS_WOUT = 7 * MiB;
constexpr size_t WS_W2 = 9 * MiB;
constexpr size_t WS_OSS = 41 * MiB;
constexpr size_t WS_W1 = 73 * MiB;
constexpr size_t WS_HB = 201 * MiB;
constexpr int ECAP = NTOK;
constexpr size_t WS_ESLOT = 269 * MiB;
constexpr size_t WS_EW = 273 * MiB;
constexpr size_t WS_QKV = 277 * MiB;
constexpr size_t WS_O = 430 * MiB;
constexpr size_t WS_MIX = 494 * MiB;
constexpr size_t WS_ACT = 277 * MiB;
constexpr size_t WS_Y = 622 * MiB;
constexpr size_t WS_X1 = 750 * MiB;
constexpr size_t WS_END = 878 * MiB;
static_assert(WS_W1 + (size_t)NE * 2048 * D * 2 <= WS_HB && WS_W2 + (size_t)NE * D * D * 2 <= WS_W1, "map");
static_assert(WS_HB + (size_t)MROWS * D * 2 <= WS_ESLOT && WS_ESLOT + (size_t)NE * ECAP * 4 <= WS_EW && WS_EW + (size_t)NE * ECAP * 4 <= WS_QKV, "map");
static_assert(WS_QKV + (size_t)MROWS * INW * 2 <= WS_O && WS_O + (size_t)NTOK * D * 2 <= WS_MIX && WS_MIX + (size_t)NTOK * D * 4 <= WS_Y, "map");
static_assert(WS_ACT + (size_t)PADROWS * 1024 * 2 <= WS_Y && WS_Y + (size_t)NASG * D <= WS_X1 && WS_X1 + (size_t)NTOK * D * 2 <= WS_END, "map");

typedef unsigned short bf16_t;
typedef float f32x4 __attribute__((ext_vector_type(4)));
typedef unsigned u32x4 __attribute__((ext_vector_type(4)));
typedef unsigned u32x2 __attribute__((ext_vector_type(2)));

struct Params {
    const float *x, *c, *ctx, *c_ctx, *w_ada, *b_ada, *g_pre_mix, *g_post_mix, *g_pre_ffn, *g_post_ffn, *w_in, *g_grp_a, *g_grp_b,
        *sink_a, *rpb_b, *w_out, *w_router, *b_router, *w_mlp1, *b_mlp1, *w_mlp2, *b_mlp2;
    float* out;
    unsigned char* ws;
};

__device__ __forceinline__ unsigned f2bf(float f) { unsigned u = __float_as_uint(f); return (u + 0x7fffu + ((u >> 16) & 1u)) >> 16; }
__device__ __forceinline__ unsigned pk2(float lo, float hi) { typedef float f2_ __attribute__((ext_vector_type(2))); typedef __bf16 b2_ __attribute__((ext_vector_type(2)));
    f2_ v = {lo, hi}; b2_ b = __builtin_convertvector(v, b2_); return __builtin_bit_cast(unsigned, b); }
__device__ __forceinline__ unsigned pk4_fp8(float v0, float v1, float v2, float v3) {
    int w = 0; w = __builtin_amdgcn_cvt_pk_fp8_f32(v0, v1, w, false); w = __builtin_amdgcn_cvt_pk_fp8_f32(v2, v3, w, true); return (unsigned)w; }
constexpr float Y8_SCALE = 16.f, Y8_INV = 1.f / 16.f;
constexpr float O8_SCALE = 16.f;
constexpr float H8_SCALE = 8.f;
constexpr float W8_SCALE = 64.f, W8_INV = 1.f / 64.f;
__device__ __forceinline__ int lane_id() { int l; asm volatile("v_mbcnt_lo_u32_b32 %0, -1, 0\n\tv_mbcnt_hi_u32_b32 %0, -1, %0" : "=v"(l)); return l; }
__device__ __forceinline__ int tid_opaque(int wv) { return wv * 64 + lane_id(); }
template <int CTRL> __device__ __forceinline__ float dppmov(float v) { return __builtin_bit_cast(float, __builtin_amdgcn_update_dpp(0, __builtin_bit_cast(int, v), CTRL, 0xf, 0xf, true)); }
__device__ __forceinline__ float row_sum16(float v) { v += dppmov<0xB1>(v); v += dppmov<0x4E>(v); v += dppmov<0x141>(v); v += dppmov<0x140>(v); return v; }
__device__ __forceinline__ float rdlane(float v, int l) { return __builtin_bit_cast(float, __builtin_amdgcn_readlane(__builtin_bit_cast(int, v), l)); }
__device__ __forceinline__ float wave_sum(float v) { v = row_sum16(v); return (rdlane(v, 0) + rdlane(v, 16)) + (rdlane(v, 32) + rdlane(v, 48)); }

#define LAS3 __attribute__((address_space(3)))
#define XB_TMO      128
#define XB_XCNT(j)  (256  + 64 * (j))
#define XB_XSUB(j)  (1280 + 64 * (j))
#define XB_XGEN(j)  (2304 + 64 * (j))
#define XB_TOP      3328
#define XB_TOPGEN   3392
#define XCD_BAR_WORDS 3456
#define XB_SPIN_CAP (1u << 18)
__device__ __forceinline__ unsigned xb_ld(unsigned* p)              { return __hip_atomic_load(p, __ATOMIC_RELAXED, __HIP_MEMORY_SCOPE_AGENT); }
__device__ __forceinline__ unsigned xb_add(unsigned* p, unsigned v) { return __hip_atomic_fetch_add(p, v, __ATOMIC_RELAXED, __HIP_MEMORY_SCOPE_AGENT); }
__device__ __forceinline__ unsigned xb_xcc_id() { return (unsigned)__builtin_amdgcn_s_getreg((3 << 11) | 20) & 0xFu; }
#define XB_SPIN(cond, bar) do { unsigned _sp = 0; while (cond) { __builtin_amdgcn_s_sleep(1); \
    if ((++_sp & 255u) == 0u) { if (xb_ld(&(bar)[XB_TMO])) break; if (_sp > XB_SPIN_CAP) { atomicAdd(&(bar)[XB_TMO], 1u); break; } } } } while (0)
struct XcdBarrier { unsigned* bar; unsigned x; volatile LAS3 unsigned* st; int wv; };
__device__ __forceinline__ XcdBarrier xcd_barrier_post(unsigned* bar, volatile LAS3 unsigned* st, int wv) {
    XcdBarrier b; b.bar = bar; b.x = xb_xcc_id(); b.st = st; b.wv = wv;
    if (tid_opaque(wv) == 0) (void)xb_add(&bar[XB_XCNT(b.x)], 1u);
    return b;
}
__device__ __forceinline__ void xcd_barrier_complete(unsigned* bar, unsigned x, unsigned& nloc, unsigned& nx) {
    const unsigned G = gridDim.x * gridDim.y * gridDim.z;
    unsigned sum, cnt, mine, sp = 0u;
    for (;;) {
        sum = 0u; cnt = 0u; mine = 0u;
#pragma unroll
        for (unsigned j = 0; j < 16; ++j) { const unsigned c = xb_ld(&bar[XB_XCNT(j)]); sum += c; cnt += (c > 0u) ? 1u : 0u; mine = (j == x) ? c : mine; }
        if (sum == G) break;
        __builtin_amdgcn_s_sleep(1);
        if ((++sp & 255u) == 0u) { if (xb_ld(&bar[XB_TMO])) break; if (sp > XB_SPIN_CAP) { atomicAdd(&bar[XB_TMO], 1u); break; } }
    }
    nloc = mine > 0u ? mine : 1u; nx = cnt > 0u ? cnt : 1u;
}
__device__ __forceinline__ void xcd_barrier_core(const XcdBarrier& b) {
    if (tid_opaque(b.wv) == 0) {
        unsigned* bar = b.bar;
        __builtin_amdgcn_s_waitcnt(0);
        unsigned nloc = b.st[0], nx = b.st[1];
        if (nloc == 0u) { xcd_barrier_complete(bar, b.x, nloc, nx); b.st[0] = nloc; b.st[1] = nx; }
        const unsigned old = xb_add(&bar[XB_XSUB(b.x)], 1u);
        const unsigned gen = old / nloc;
        if (old + 1u == (gen + 1u) * nloc) {
            __builtin_amdgcn_fence(__ATOMIC_RELEASE, "agent");
            asm volatile("s_waitcnt vmcnt(0)" ::: "memory");
            const unsigned og = xb_add(&bar[XB_TOP], 1u);
            const unsigned tg = og / nx;
            if (og + 1u == (tg + 1u) * nx) xb_add(&bar[XB_TOPGEN], 1u);
            else XB_SPIN(xb_ld(&bar[XB_TOPGEN]) == tg, bar);
            __builtin_amdgcn_fence(__ATOMIC_ACQUIRE, "agent");
            xb_add(&bar[XB_XGEN(b.x)], 1u);
            asm volatile("s_waitcnt vmcnt(0)" ::: "memory");
        } else {
            XB_SPIN(xb_ld(&bar[XB_XGEN(b.x)]) == gen, bar);
            __builtin_amdgcn_fence(__ATOMIC_ACQUIRE, "agent");
            asm volatile("s_waitcnt vmcnt(0)" ::: "memory");
        }
    }
}
__device__ __forceinline__ void xcd_barrier(const XcdBarrier& b) {
    asm volatile("s_waitcnt vmcnt(0)" ::: "memory");
    __syncthreads();
    xcd_barrier_core(b);
    __syncthreads();
}
template <class F>
__device__ __forceinline__ void xcd_barrier_side(const XcdBarrier& b, F side) {
    asm volatile("s_waitcnt vmcnt(0)" ::: "memory");
    __syncthreads();
    xcd_barrier_core(b);
    if (b.wv != 0) side();
    __syncthreads();
}

constexpr int CW_DEP_E = 6144, CW_DEP_F = 6656;
__device__ __forceinline__ void dep_arrive(unsigned* ctr, unsigned nloc, unsigned x, int wv) {
    if (tid_opaque(wv) == 0) { const unsigned old = xb_add(ctr + 16 * (1 + x), 1u);
        if (old + 1u == nloc) { __builtin_amdgcn_fence(__ATOMIC_RELEASE, "agent"); asm volatile("s_waitcnt vmcnt(0)" ::: "memory"); (void)xb_add(ctr, nloc); } }
}
__device__ __forceinline__ void dep_wait(unsigned* ctr, unsigned G) {
    unsigned v, sp = 0u;
    for (;;) { asm volatile("global_load_dword %0, %1, off sc1\n\ts_waitcnt vmcnt(0)" : "=v"(v) : "v"(ctr) : "memory");
        if ((unsigned)__builtin_amdgcn_readfirstlane((int)v) >= G) break;
        __builtin_amdgcn_s_sleep(8); if (++sp > (1u << 21)) break; }
    __builtin_amdgcn_fence(__ATOMIC_ACQUIRE, "agent");
}

namespace pg8 {
#define PG8_LAS __attribute__((address_space(3)))
typedef short bf16x8 __attribute__((ext_vector_type(8)));
typedef int v8i __attribute__((ext_vector_type(8)));
typedef int v4i __attribute__((ext_vector_type(4)));
typedef short s16x16 __attribute__((ext_vector_type(16)));
constexpr int BM = 256, BK = 64, HALF = 128, HTB = HALF * BK * 2  , STAGE_BYTES = 8 * HTB, NXCD = 8, WGM = 4;
__device__ __forceinline__ int lds_byte(int r, int c) { const int st = (r >> 4) * 2 + (c >> 5), rr = r & 15, cc = c & 31, ob = rr * 64 + cc * 2; return st * 1024 + (ob ^ (((ob >> 9) & 1) << 5)); }
__device__ __forceinline__ void stage_rc(int b, int& R, int& C) { const int st = b / 1024, sb = b % 1024, swz = sb ^ (((sb >> 9) & 1) << 5); R = (st >> 1) * 16 + swz / 64; C = (st & 1) * 32 + (swz % 64) / 2; }
__device__ __forceinline__ int perm32(int rho) { const int n = rho >> 4, i = rho & 15; return 8 * (i >> 2) + 4 * n + (i & 3); }

constexpr int PAR_BASE = 131072, PAR_BUF = 4096, PAR_IDX = 0, PAR_W = 1024, PAR_BIAS = 2048, PAR_TAB = PAR_BASE + 2 * PAR_BUF;
typedef short s16x2 __attribute__((ext_vector_type(2)));
__device__ __forceinline__ int par_i32(PG8_LAS unsigned char* p) { return __builtin_bit_cast(int, *(const PG8_LAS s16x2*)p); }
__device__ __forceinline__ float par_f32(PG8_LAS unsigned char* p) { return __builtin_bit_cast(float, *(const PG8_LAS s16x2*)p); }
__device__ __forceinline__ f32x4 par_f32x4(PG8_LAS unsigned char* p) { return __builtin_bit_cast(f32x4, *(const PG8_LAS bf16x8*)p); }
struct Unit { int pm, pn, e; };
struct Gemm { const bf16_t* A; const bf16_t* Bt; int K; size_t bstride; const int* eslot; const PG8_LAS int* sb; int wv; };

struct StaticOrder {
    int nM, nN, nwg, G, c; const PG8_LAS int* sbase;
    __device__ void init(int M, int N, int G_, int c_, const PG8_LAS int* sb) { nM = M / BM; nN = N / BM; nwg = nM * nN; G = G_; c = c_; sbase = sb; }
    __device__ bool next(int i, Unit& u) const {
        const long Lx = (long)i * G + c; if (Lx >= nwg) return false;
        int wgid = (int)Lx; { const int q = nwg / NXCD, r = nwg % NXCD, xcd = wgid % NXCD, off = wgid / NXCD; wgid = (xcd < r ? xcd * (q + 1) : r * (q + 1) + (xcd - r) * q) + off; }
        const int nig = WGM * nN, gid = wgid / nig, fm = gid * WGM, gsz = (nM - fm) < WGM ? (nM - fm) : WGM;
        u.pm = fm + ((wgid % nig) % gsz); u.pn = (wgid % nig) / gsz; u.e = 0;
        if (sbase) { const int row = u.pm * BM; const int l = lane_id();
            const bool ge = (l >= 1) && (l < 32) && (row >= sbase[l & 31]);
            u.e = __builtin_popcountll(__ballot(ge)); }
        return true;
    }
};

struct DepOrder {
    StaticOrder S; unsigned* ctrE; unsigned* ctrF; int nwg1, R1, wv; mutable bool haveE, haveF;
    __device__ bool next(int i, Unit& u) const {
        { const long Lx = (long)i * S.G + S.c; if (Lx >= S.nwg) return false;
          const int wg0 = (int)Lx, q2 = S.nwg / NXCD, r2 = S.nwg % NXCD, xc = wg0 % NXCD; int of = wg0 / NXCD;
          const int base = xc < r2 ? xc * (q2 + 1) : r2 * (q2 + 1) + (xc - r2) * q2, size = xc < r2 ? q2 + 1 : q2, nig = WGM * S.nN;
          of += (nig - base % nig) % nig; if (of >= size) of -= size;
          const int wgid = base + of, gid = wgid / nig, fm = gid * WGM, gsz = (S.nM - fm) < WGM ? (S.nM - fm) : WGM;
          u.pm = fm + ((wgid % nig) % gsz); u.pn = (wgid % nig) / gsz;
          const int row = u.pm * BM; const int l = lane_id();
          const bool ge = (l >= 1) && (l < 32) && (row >= S.sbase[l & 31]);
          u.e = __builtin_popcountll(__ballot(ge)); }
        if (wv != 0) return true;
        const int w = (u.pm / WGM) * (WGM * 8) + lane_id();
        const int q = nwg1 / NXCD, r = nwg1 % NXCD;
        int xcd, off; if (w < r * (q + 1)) { xcd = w / (q + 1); off = w % (q + 1); } else { const int w2 = w - r * (q + 1); xcd = r + w2 / q; off = w2 % q; }
        const bool late = (lane_id() < WGM * 8) && (w < nwg1) && ((off * NXCD + xcd) / S.G >= R1 - 1);
        const bool needF = __ballot(late) != 0ull;
        if (needF) { if (!haveF) { dep_wait(ctrF, (unsigned)S.G); haveF = true; haveE = true; } }
        else if (!haveE) { dep_wait(ctrE, (unsigned)S.G); haveE = true; }
        return true;
    }
};

template <class Epi, class Sched, bool GATHER, bool ALIGN_EPI, bool FP8 = false>
__device__ __forceinline__ void gemm_phase(PG8_LAS unsigned char* lds, const Gemm g, const Sched& S, const Epi& E) {
    const int tid = tid_opaque(g.wv), wid = g.wv,
              lane = tid & 63, wr = wid >> 2, wc = wid & 3, fr = lane & 15, fq = lane >> 4;
    const int K = g.K, nt = K / BK;
    unsigned voffA[2], voffB[2];
#pragma unroll
    for (int i = 0; i < 2; ++i) { const int R = 8 * (wid + 8 * i) + (lane >> 3), Sb = (((lane & 7) ^ (lane >> 3)) * 16); const int Rb = Epi::PERMQ ? (64 * (R >> 5) + 32 * ((R & 15) >> 3) + 8 * (((R & 15) >> 2) & 1) + 4 * ((R >> 4) & 1) + (R & 3))
                     : Epi::PERMG1 ? (32 * (2 * (R >> 5) + ((R & 15) >> 3)) + 16 * ((R >> 4) & 1) + 8 * (((R & 15) >> 2) & 1) + (R & 3))
                     : Epi::PERM16 ? (64 * (R >> 5) + 16 * ((R & 15) >> 2) + 4 * ((R >> 4) & 1) + (R & 3)) : Epi::PERM ? ((R & ~31) + perm32(R & 31)) : R;
        voffA[i] = (unsigned)(R * K * 2 + Sb); voffB[i] = (unsigned)(Rb * K * 2 + Sb); }
    const size_t kstep = (size_t)(BK * 2);
    const size_t hstep = (size_t)HALF * K * 2;
    const size_t hstepB = Epi::PERMQ ? (size_t)16 * K * 2 : Epi::PERMG1 ? (size_t)4 * K * 2 : Epi::PERM16 ? (size_t)8 * K * 2 : hstep;
    const size_t tstep = 2 * hstep;
    const unsigned ldsw = (unsigned)wid * 1024u;
    const int fsw0 = (fr & 7) * 128 + ((fq ^ (fr & 7)) * 16), fsw1 = (fr & 7) * 128 + (((fq + 4) ^ (fr & 7)) * 16);
    const int aoff0 = (wr * 8 + (fr >> 3)) * 1024 + fsw0, aoff1 = (wr * 8 + (fr >> 3)) * 1024 + fsw1, boff0 = (wc * 4 + (fr >> 3)) * 1024 + fsw0, boff1 = (wc * 4 + (fr >> 3)) * 1024 + fsw1;
#define PG8_SA(b, h) (((b) * 2 + (h)) * HTB)
#define PG8_SB(b, h) ((4 + (b) * 2 + (h)) * HTB)
#define PG8_STAGE(bufoff, gbase, voff) do { _Pragma("unroll") for (int _i = 0; _i < 2; ++_i) \
        __builtin_amdgcn_global_load_lds((const unsigned*)((const char*)(gbase) + (voff)[_i]), (PG8_LAS unsigned*)(lds + (bufoff) + ldsw + _i * 8192), 16, 0, 0); } while (0)
#define PG8_CAT(lo_, hi_) __builtin_bit_cast(v8i, __builtin_shufflevector((lo_), (hi_), 0, 1, 2, 3, 4, 5, 6, 7, 8, 9, 10, 11, 12, 13, 14, 15))
#define PG8_LDA(dst, b, h) do { _Pragma("unroll") for (int m = 0; m < 4; ++m) { \
        const bf16x8 f0_ = *(const PG8_LAS bf16x8*)(lds + PG8_SA(b, h) + aoff0 + m * 2048), f1_ = *(const PG8_LAS bf16x8*)(lds + PG8_SA(b, h) + aoff1 + m * 2048); \
        if constexpr (FP8) dst##8[m] = PG8_CAT(f0_, f1_); else { dst[m][0] = f0_; dst[m][1] = f1_; } } } while (0)
#define PG8_LDB(dst, b, h) do { _Pragma("unroll") for (int n = 0; n < 2; ++n) { \
        const bf16x8 f0_ = *(const PG8_LAS bf16x8*)(lds + PG8_SB(b, h) + boff0 + n * 2048), f1_ = *(const PG8_LAS bf16x8*)(lds + PG8_SB(b, h) + boff1 + n * 2048); \
        if constexpr (FP8) dst##8[n] = PG8_CAT(f0_, f1_); else { dst[n][0] = f0_; dst[n][1] = f1_; } } } while (0)
#define PG8_MMA(ai, bj, At, Bt) do { __builtin_amdgcn_s_setprio(1); _Pragma("unroll") for (int m = 0; m < 4; ++m) _Pragma("unroll") for (int n = 0; n < 2; ++n) { \
        if constexpr (FP8) asm volatile("v_mfma_scale_f32_16x16x128_f8f6f4 %0, %1, %2, %0, %3, %3 op_sel_hi:[0,0,0]" : "+v"(acc[ai][bj][m][n]) : "v"(Bt##8[n]), "v"(At##8[m]), "v"(one_scale)); \
        else { _Pragma("unroll") for (int k = 0; k < 2; ++k) acc[ai][bj][m][n] = __builtin_amdgcn_mfma_f32_16x16x32_bf16(Bt[n][k], At[m][k], acc[ai][bj][m][n], 0, 0, 0); } } \
        __builtin_amdgcn_s_setprio(0); } while (0)
#define PG8_WAIT_V(n) asm volatile("s_waitcnt vmcnt(" #n ")" ::: "memory")
#define PG8_WAIT_L(n) asm volatile("s_waitcnt lgkmcnt(" #n ")" ::: "memory")
#define PG8_BAR __builtin_amdgcn_s_barrier()
#define PG8_SCHED __builtin_amdgcn_sched_barrier(0)
#define PG8_SETOFF(off, pbuf_) do { _Pragma("unroll") for (int _h = 0; _h < 2; ++_h) _Pragma("unroll") for (int _i = 0; _i < 2; ++_i) { \
        if (GATHER) { const int R_ = 8 * (wid + 8 * _i) + (lane >> 3); \
            off[_h][_i] = (unsigned)(par_i32(lds + PAR_BASE + (pbuf_) * PAR_BUF + PAR_IDX + (_h * HALF + R_) * 4) >> 2) * (unsigned)(K * 2) + (unsigned)(((lane & 7) ^ (lane >> 3)) * 16); } \
        else off[_h][_i] = voffA[_i] + (unsigned)(_h * hstep); } } while (0)
#define PG8_IDXDMA(u, pbuf_) do { if (GATHER && wid < 4) { int rk_ = (u).pm * BM + wid * 64 + lane - g.sb[(u).e]; const int cm_ = g.sb[40 + (u).e] - 1; rk_ = rk_ < cm_ ? rk_ : cm_; \
        __builtin_amdgcn_global_load_lds((const unsigned*)(g.eslot + (size_t)(u).e * ECAP + rk_), (PG8_LAS unsigned*)(lds + PAR_BASE + (pbuf_) * PAR_BUF + PAR_IDX + wid * 256), 4, 0, 0); } } while (0)
    Unit cur, nxt; int ui = 0;
    if (!S.next(0, cur)) return;
    PG8_IDXDMA(cur, 0); E.prefetch(cur, 0, lds, wid, lane);
    PG8_WAIT_V(0); PG8_BAR;
    f32x4 acc[2][2][4][2];
#pragma unroll
    for (int a = 0; a < 2; ++a)
#pragma unroll
        for (int b = 0; b < 2; ++b)
#pragma unroll
            for (int m = 0; m < 4; ++m)
#pragma unroll
                for (int n = 0; n < 2; ++n) acc[a][b][m][n] = (f32x4){0.f, 0.f, 0.f, 0.f};
    bf16x8 At[4][2], B0[2][2], B1[2][2];
    v8i At8[4], B08[2], B18[2];
    const int one_scale = 0x7f7f7f7f;
    unsigned offc[2][2];
    PG8_SETOFF(offc, 0);
    const char* cA = GATHER ? (const char*)g.A : (const char*)g.A + (size_t)cur.pm * tstep;
    const char* cB = (const char*)g.Bt + (size_t)cur.e * g.bstride + (size_t)cur.pn * tstep;
    PG8_STAGE(PG8_SB(0, 0), cB, voffB); PG8_STAGE(PG8_SB(0, 1), cB + hstepB, voffB); PG8_STAGE(PG8_SA(0, 0), cA, offc[0]); PG8_STAGE(PG8_SA(0, 1), cA, offc[1]);
    if (wr == 1) PG8_BAR;
    PG8_WAIT_V(2); PG8_BAR;
    PG8_STAGE(PG8_SB(1, 0), cB + kstep, voffB); PG8_STAGE(PG8_SA(1, 0), cA + kstep, offc[0]); PG8_STAGE(PG8_SB(1, 1), cB + hstepB + kstep, voffB);
    PG8_WAIT_V(6); PG8_BAR;
    for (;;) {
        const bool has_next = S.next(ui + 1, nxt);
        const char* nA = GATHER ? cA : (has_next ? (const char*)g.A + (size_t)nxt.pm * tstep : cA);
        const char* nB = has_next ? (const char*)g.Bt + (size_t)nxt.e * g.bstride + (size_t)nxt.pn * tstep : cB;

        if constexpr (Epi::MIDSCALE) E.begin(cur, ui, lds, tid);
#pragma unroll 1
        for (int t = 0; t < nt; t += 2) {
            const bool last = (t == nt - 2);
            if constexpr (Epi::MIDSCALE) { if (t == nt / 2) { if constexpr (FP8) asm volatile("s_nop 15\n\ts_nop 15" ::: "memory");
                E.mid(acc, ui, wr, fr, lds); } }
            if (t == 2 && has_next) { PG8_IDXDMA(nxt, (ui + 1) & 1); E.prefetch(nxt, (ui + 1) & 1, lds, wid, lane); }
            const char* a1 = cA + (size_t)(t + 1) * kstep;
            const char* a2 = last ? nA : cA + (size_t)(t + 2) * kstep; const char* b2 = last ? nB : cB + (size_t)(t + 2) * kstep;
            const char* a3 = a2 + kstep; const char* b3 = b2 + kstep;
            PG8_LDB(B0, 0, 0); PG8_LDB(B1, 0, 1); PG8_SCHED; PG8_LDA(At, 0, 0); PG8_STAGE(PG8_SA(1, 1), a1, offc[1]);
            if (GATHER && last && has_next) { PG8_SETOFF(offc, (ui + 1) & 1); }
            PG8_WAIT_V(8); PG8_WAIT_L(0); PG8_BAR; PG8_MMA(0, 0, At, B0); PG8_MMA(0, 1, At, B1); PG8_BAR; PG8_SCHED;
            PG8_LDA(At, 0, 1); PG8_STAGE(PG8_SB(0, 0), b2, voffB); PG8_STAGE(PG8_SB(0, 1), b2 + hstepB, voffB); PG8_STAGE(PG8_SA(0, 0), a2, offc[0]);
            PG8_WAIT_V(8); PG8_WAIT_L(0); PG8_BAR; PG8_MMA(1, 0, At, B0); PG8_MMA(1, 1, At, B1); PG8_BAR; PG8_SCHED;
            PG8_LDB(B0, 1, 0); PG8_LDB(B1, 1, 1); PG8_SCHED; PG8_LDA(At, 1, 0); PG8_STAGE(PG8_SA(0, 1), a2, offc[1]);
            PG8_WAIT_V(8); PG8_WAIT_L(0); PG8_BAR; PG8_MMA(0, 0, At, B0); PG8_MMA(0, 1, At, B1); PG8_BAR; PG8_SCHED;
            PG8_LDA(At, 1, 1); PG8_STAGE(PG8_SB(1, 0), b3, voffB); PG8_STAGE(PG8_SB(1, 1), b3 + hstepB, voffB); PG8_STAGE(PG8_SA(1, 0), a3, offc[0]);
            PG8_WAIT_V(8); PG8_WAIT_L(0); PG8_BAR; PG8_MMA(1, 0, At, B0); PG8_MMA(1, 1, At, B1); PG8_BAR; PG8_SCHED;
        }
        if constexpr (ALIGN_EPI) { if (wr == 0) PG8_BAR; }
        if constexpr (FP8) asm volatile("s_nop 15\n\ts_nop 15" ::: "memory");
        E(acc, cur, ui, wr, wc, fr, fq, lds);
        if constexpr (Epi::SIGNAL) { if (ui == E.sig_ui) { PG8_WAIT_V(0); PG8_BAR; dep_arrive(E.sigE, E.sig_nloc, E.sig_x, g.wv); } }
        if (!has_next) break;
#pragma unroll
        for (int a = 0; a < 2; ++a)
#pragma unroll
            for (int b = 0; b < 2; ++b)
#pragma unroll
                for (int m = 0; m < 4; ++m)
#pragma unroll
                    for (int n = 0; n < 2; ++n) acc[a][b][m][n] = (f32x4){0.f, 0.f, 0.f, 0.f};
        cur = nxt; cA = nA; cB = nB; ++ui;
        if constexpr (ALIGN_EPI) { if (wr == 1) PG8_BAR; }
    }
    PG8_WAIT_V(0);
    if constexpr (!ALIGN_EPI) { if (wr == 0) PG8_BAR; }
    PG8_BAR;
#undef PG8_SA
#undef PG8_SB
#undef PG8_STAGE
#undef PG8_LDA
#undef PG8_LDB
#undef PG8_MMA
#undef PG8_WAIT_V
#undef PG8_WAIT_L
#undef PG8_BAR
#undef PG8_SCHED
#undef PG8_SETOFF
#undef PG8_IDXDMA
#undef PG8_CAT
}

struct EpiQKV {
    static constexpr bool SIGNAL = false, MIDSCALE = false, PERM = false, PERM16 = false, PERMG1 = false, PERMQ = true;
    bf16_t* O;
    __device__ __forceinline__ void prefetch(const Unit&, int, PG8_LAS unsigned char*, int, int) const {}
    __device__ __forceinline__ void operator()(const f32x4 (&acc)[2][2][4][2], const Unit& u, int ui, int wr, int wc, int fr, int fq, PG8_LAS unsigned char* lds) const {
        const bool latent = u.pm < NTOK / BM;
        const int cb128 = u.pn * BM + 128 * (wc >> 1);
        const bool rope = latent && cb128 < C_VA, qs = cb128 < C_KA || (cb128 >= C_QB && cb128 < C_KB);
        const int colblk = u.pn * BM + 64 * wc + 32 * (fq >> 1) + 8 * (fq & 1);
#pragma unroll
        for (int ai = 0; ai < 2; ++ai)
#pragma unroll
            for (int m = 0; m < 4; ++m) {
                const int row = u.pm * BM + ai * HALF + wr * 64 + m * 16 + fr;
                bf16_t* rowp = O + (size_t)row * INW + colblk;
                const int pos = row & (L - 1), pp = (fq >> 1) ? (pos & 63) : (pos >> 6);
                PG8_LAS unsigned char* tp = lds + PAR_TAB + (pp * 16 + 8 * (fq & 1)) * 8;
                f32x4 x1[2], x2[2];
#pragma unroll
                for (int n = 0; n < 2; ++n) { x1[n] = acc[ai][0][m][n] * (1.f / (H8_SCALE * W8_SCALE)); x2[n] = acc[ai][1][m][n] * (1.f / (H8_SCALE * W8_SCALE));
                    if (rope) { const f32x4 t0 = par_f32x4(tp + n * 32), t1 = par_f32x4(tp + n * 32 + 16);
                        const f32x4 cs = {t0.x, t0.z, t1.x, t1.z}, sn = {t0.y, t0.w, t1.y, t1.w};
                        const f32x4 a0 = x1[n] * cs - x2[n] * sn, a1 = x2[n] * cs + x1[n] * sn; x1[n] = a0; x2[n] = a1; }
                    if (qs) { x1[n] = x1[n] * QSCALE; x2[n] = x2[n] * QSCALE; } }
                u32x4 w0, w1; w0.x = pk2(x1[0].x, x1[0].y); w0.y = pk2(x1[0].z, x1[0].w); w0.z = pk2(x1[1].x, x1[1].y); w0.w = pk2(x1[1].z, x1[1].w);
                w1.x = pk2(x2[0].x, x2[0].y); w1.y = pk2(x2[0].z, x2[0].w); w1.z = pk2(x2[1].x, x2[1].y); w1.w = pk2(x2[1].z, x2[1].w);
                *(u32x4*)rowp = w0; *(u32x4*)(rowp + 16) = w1;
            }
    }
};
struct EpiOutProj {
    static constexpr bool SIGNAL = false, PERM = true, MIDSCALE = true, PERM16 = false, PERMG1 = false, PERMQ = false;
    bf16_t* O; const float* oss;
    __device__ __forceinline__ void prefetch(const Unit&, int, PG8_LAS unsigned char*, int, int) const {}
    __device__ __forceinline__ void begin(const Unit& u, int ui, PG8_LAS unsigned char* lds, int tid) const {
        if (tid < 256) { const f32x4* sp = (const f32x4*)(oss + (size_t)(u.pm * BM + tid) * 16); const f32x4 a0 = sp[0], a1 = sp[1], b0 = sp[2], b1 = sp[3];
            const float sa = ((a0.x + a0.y) + (a0.z + a0.w)) + ((a1.x + a1.y) + (a1.z + a1.w)), sb = ((b0.x + b0.y) + (b0.z + b0.w)) + ((b1.x + b1.y) + (b1.z + b1.w));
            const float ra = rsqrtf(sa * (1.f / 512.f) + EPS), rb = rsqrtf(sb * (1.f / 512.f) + EPS);
            typedef float f2 __attribute__((ext_vector_type(2)));
            *(PG8_LAS f2*)(lds + 131072 + (ui & 1) * 2048 + tid * 8) = (f2){ra / rb, rb * (1.f / (O8_SCALE * W8_SCALE))}; }
    }
    __device__ __forceinline__ void mid(f32x4 (&acc)[2][2][4][2], int ui, int wr, int fr, PG8_LAS unsigned char* lds) const {
#pragma unroll
        for (int ai = 0; ai < 2; ++ai)
#pragma unroll
            for (int m = 0; m < 4; ++m) { const float r = *(const PG8_LAS float*)(lds + 131072 + (ui & 1) * 2048 + (ai * HALF + wr * 64 + m * 16 + fr) * 8);
#pragma unroll
                for (int bj = 0; bj < 2; ++bj)
#pragma unroll
                    for (int n = 0; n < 2; ++n) acc[ai][bj][m][n] = acc[ai][bj][m][n] * r; }
    }
    __device__ __forceinline__ void operator()(const f32x4 (&acc)[2][2][4][2], const Unit& u, int ui, int wr, int wc, int fr, int fq, PG8_LAS unsigned char* lds) const {
#pragma unroll
        for (int ai = 0; ai < 2; ++ai)
#pragma unroll
            for (int m = 0; m < 4; ++m) {
                const int rl = ai * HALF + wr * 64 + m * 16 + fr;
                const float rb = *(const PG8_LAS float*)(lds + 131072 + (ui & 1) * 2048 + rl * 8 + 4);
                bf16_t* rowp = O + (size_t)(u.pm * BM + rl) * D + u.pn * BM + wc * 32 + 8 * fq;
#pragma unroll
                for (int bj = 0; bj < 2; ++bj) { const f32x4 v0 = acc[ai][bj][m][0] * rb, v1 = acc[ai][bj][m][1] * rb;
                    u32x4 o; o.x = pk2(v0.x, v0.y); o.y = pk2(v0.z, v0.w); o.z = pk2(v1.x, v1.y); o.w = pk2(v1.z, v1.w);
                    *(u32x4*)(rowp + bj * HALF) = o; }
            }
    }
};
struct EpiSwiglu {
    static constexpr bool SIGNAL = true, MIDSCALE = false, PERM = false, PERM16 = false, PERMG1 = true, PERMQ = false;
    unsigned char* act; const float* b1; unsigned* sigE; int sig_ui; unsigned sig_nloc, sig_x;
    __device__ __forceinline__ void prefetch(const Unit& u, int pb, PG8_LAS unsigned char* lds, int wid, int lane) const {
        if (wid == 4) __builtin_amdgcn_global_load_lds((const unsigned*)(b1 + (size_t)u.e * 2048 + u.pn * BM + lane * 4), (PG8_LAS unsigned*)(lds + PAR_BASE + pb * PAR_BUF + PAR_BIAS), 16, 0, 0);
    }
    __device__ __forceinline__ void operator()(const f32x4 (&acc)[2][2][4][2], const Unit& u, int ui, int wr, int wc, int fr, int fq, PG8_LAS unsigned char* lds) const {
        typedef float f32x2 __attribute__((ext_vector_type(2)));
        const int f0 = 128 * u.pn + 32 * wc + 8 * fq;
        f32x4 bg[2], bl[2];
#pragma unroll
        for (int bj = 0; bj < 2; ++bj) { PG8_LAS unsigned char* bp = lds + PAR_BASE + (ui & 1) * PAR_BUF + PAR_BIAS + (64 * wc + 16 * fq + 8 * bj) * 4; const f32x4 bA = par_f32x4(bp), bB = par_f32x4(bp + 16);
            bg[bj] = (f32x4){bA.x, bA.z, bB.x, bB.z}; bl[bj] = (f32x4){bA.y, bA.w, bB.y, bB.w}; }
#pragma unroll
        for (int ai = 0; ai < 2; ++ai)
#pragma unroll
            for (int m = 0; m < 4; ++m) {
                const int row = u.pm * BM + ai * HALF + wr * 64 + m * 16 + fr;
                u32x2 o;
#pragma unroll
                for (int bj = 0; bj < 2; ++bj) {
                    const f32x4 A0 = acc[ai][bj][m][0], A1 = acc[ai][bj][m][1]; float a[4];
#pragma unroll
                    for (int h2 = 0; h2 < 2; ++h2) {
                        const f32x2 g = __builtin_elementwise_fma((f32x2){A0[2 * h2], A0[2 * h2 + 1]}, (f32x2){W8_INV, W8_INV}, (f32x2){bg[bj][2 * h2], bg[bj][2 * h2 + 1]});
                        const f32x2 l = __builtin_elementwise_fma((f32x2){A1[2 * h2], A1[2 * h2 + 1]}, (f32x2){W8_INV, W8_INV}, (f32x2){bl[bj][2 * h2], bl[bj][2 * h2 + 1]});
                        const f32x2 gg = {fminf(g.x, 7.f), fminf(g.y, 7.f)}, ll = {fminf(fmaxf(l.x, -7.f), 7.f), fminf(fmaxf(l.y, -7.f), 7.f)};
                        const f32x2 t = gg * (f32x2){-1.702f * LOG2E, -1.702f * LOG2E};
                        const f32x2 d = (f32x2){__builtin_amdgcn_exp2f(t.x), __builtin_amdgcn_exp2f(t.y)} + (f32x2){1.f, 1.f};
                        const f32x2 s = gg * (f32x2){__builtin_amdgcn_rcpf(d.x), __builtin_amdgcn_rcpf(d.y)};
                        const f32x2 r = __builtin_elementwise_fma(s, ll, s);
                        a[2 * h2] = r.x; a[2 * h2 + 1] = r.y; }
                    o[bj] = pk4_fp8(a[0], a[1], a[2], a[3]); }
                *(u32x2*)(act + (size_t)row * D + f0) = o;
            }
    }
};
struct EpiScatter {
    static constexpr bool SIGNAL = false, MIDSCALE = false, PERM = false, PERM16 = true, PERMG1 = false, PERMQ = false;
    unsigned char* y; const float* b2; const int* eslot; const float* ew; const PG8_LAS int* sb;
    __device__ __forceinline__ void prefetch(const Unit& u, int pb, PG8_LAS unsigned char* lds, int wid, int lane) const {
        const int w4 = wid & 3; int rk = u.pm * BM + w4 * 64 + lane - sb[u.e]; const int cm = sb[40 + u.e] - 1; rk = rk < cm ? rk : cm;
        const size_t gi = (size_t)u.e * ECAP + rk;
        if (wid < 4) __builtin_amdgcn_global_load_lds((const unsigned*)(eslot + gi), (PG8_LAS unsigned*)(lds + PAR_BASE + pb * PAR_BUF + PAR_IDX + w4 * 256), 4, 0, 0);
        else         __builtin_amdgcn_global_load_lds((const unsigned*)(ew + gi), (PG8_LAS unsigned*)(lds + PAR_BASE + pb * PAR_BUF + PAR_W + w4 * 256), 4, 0, 0);
        if (wid == 0) __builtin_amdgcn_global_load_lds((const unsigned*)(b2 + (size_t)u.e * D + u.pn * BM + lane * 4), (PG8_LAS unsigned*)(lds + PAR_BASE + pb * PAR_BUF + PAR_BIAS), 16, 0, 0);
    }
    __device__ __forceinline__ void operator()(const f32x4 (&acc)[2][2][4][2], const Unit& u, int ui, int wr, int wc, int fr, int fq, PG8_LAS unsigned char* lds) const {
        PG8_LAS unsigned char* par = lds + PAR_BASE + (ui & 1) * PAR_BUF;
        const int col0 = u.pn * BM + wc * 64 + 16 * fq;
        f32x4 bv[2][2];
#pragma unroll
        for (int bj = 0; bj < 2; ++bj)
#pragma unroll
            for (int n = 0; n < 2; ++n) bv[bj][n] = par_f32x4(par + PAR_BIAS + (wc * 64 + 16 * fq + 8 * bj + 4 * n) * 4);
        const int rbase = u.pm * BM - sb[u.e], cn = sb[40 + u.e];
#pragma unroll
        for (int ai = 0; ai < 2; ++ai)
#pragma unroll
            for (int m = 0; m < 4; ++m) {
                const int rl = ai * HALF + wr * 64 + m * 16 + fr;
                const int slot = par_i32(par + PAR_IDX + rl * 4); const float w = par_f32(par + PAR_W + rl * 4) * Y8_SCALE;
                if (rbase + rl < cn) {
                    unsigned char* rowp = y + (size_t)slot * D + col0;
                    u32x4 o;
#pragma unroll
                    for (int bj = 0; bj < 2; ++bj) { const f32x4 v0 = (acc[ai][bj][m][0] * W8_INV + bv[bj][0]) * w, v1 = (acc[ai][bj][m][1] * W8_INV + bv[bj][1]) * w;
                        o[2 * bj] = pk4_fp8(v0.x, v0.y, v0.z, v0.w); o[2 * bj + 1] = pk4_fp8(v1.x, v1.y, v1.z, v1.w); }
                    *(u32x4*)rowp = o;
                }
            }
    }
};
}

__device__ void p0_mod(const Params& p, float* sS  , float* sP  , int wv) {
    float* mod = (float*)(p.ws + WS_MOD);
    const int tid = tid_opaque(wv), lane = tid & 63, wave = wv;
    if (blockIdx.x >= 96) return;
    { float cv[18];
#pragma unroll
      for (int j = 0; j < 18; ++j) { const int i = tid + NTHREADS * j, r = i >> 10, k = i & 1023; cv[j] = r < 8 ? p.c[r * D + k] : p.c_ctx[k]; }
#pragma unroll
      for (int j = 0; j < 18; ++j) { const float cc = cv[j]; sS[tid + NTHREADS * j] = cc / (1.f + __expf(-cc)); } }
    __syncthreads();
    const int j = blockIdx.x * 64 + lane;
    float acc[9];
#pragma unroll
    for (int r = 0; r < 9; ++r) acc[r] = 0.f;
    const float* wp = p.w_ada + (size_t)(wave * 128) * 6144 + j;
    float wA[16], wB[16];
#define P0_LOADW(W, k0_) do { _Pragma("unroll") for (int kk = 0; kk < 16; ++kk) W[kk] = wp[(size_t)((k0_) + kk) * 6144]; } while (0)
#define P0_ACCW(W, k0_) do { _Pragma("unroll") for (int kk = 0; kk < 16; ++kk) _Pragma("unroll") for (int r = 0; r < 9; ++r) acc[r] = fmaf(sS[r * D + wave * 128 + (k0_) + kk], W[kk], acc[r]); } while (0)
    P0_LOADW(wA, 0);
#pragma unroll 1
    for (int k0 = 0; k0 < 128; k0 += 32) {
        P0_LOADW(wB, k0 + 16); P0_ACCW(wA, k0);
        if (k0 + 32 < 128) P0_LOADW(wA, k0 + 32);
        P0_ACCW(wB, k0 + 16);
    }
#undef P0_LOADW
#undef P0_ACCW
#pragma unroll
    for (int r = 0; r < 9; ++r) sP[(wave * 9 + r) * 64 + lane] = acc[r];
    __syncthreads();
    for (int i = tid; i < 9 * 64; i += NTHREADS) { const int r = i >> 6, jj = i & 63; float s = p.b_ada[blockIdx.x * 64 + jj];
#pragma unroll
        for (int w = 0; w < 8; ++w) s += sP[(w * 9 + r) * 64 + jj];
        mod[r * 6144 + blockIdx.x * 64 + jj] = s; }
    __syncthreads();
}
__device__ void p0_tab(const Params& p, int wv) {
    float* tab = (float*)(p.ws + WS_TAB);
    const int gtid = blockIdx.x * NTHREADS + tid_opaque(wv), gsize = gridDim.x * NTHREADS;
    for (int idx = gtid; idx < 64 * 16; idx += gsize) {
        const int pos = idx >> 4, i = idx & 15;
        const float freq = exp2f(-(float)i * (13.287712379549449f / 16.f));
        const float ang = (float)pos * freq;
        const float n = rintf(ang * 0.15915494309189535f);
        float r = fmaf(-n, 6.28125f, ang); r = fmaf(-n, 1.9353071795864769e-3f, r);
        tab[idx * 2] = __cosf(r); tab[idx * 2 + 1] = __sinf(r);
    }
}
template <int MODE>
__device__ __forceinline__ void conv_item(const float* src, int K, int N, bf16_t* dst, int item, float* scr, int lane, const float* gA, const float* gB) {
    const int nblk = N / 32, kb = item / nblk, nb = item % nblk, k0 = 64 * kb, n0 = 32 * nb;
    const int c = lane & 31, kh = lane >> 5;
    const int nl = MODE == 1 ? 16 * (c & 1) + (c >> 1) : c;
    float v[32];
    const float* sp = src + (size_t)(k0 + kh) * N + n0 + c;
#pragma unroll
    for (int i = 0; i < 32; ++i) v[i] = sp[(size_t)(2 * i) * N];
#pragma unroll
    for (int i = 0; i < 32; ++i) { float x = v[i]; if (MODE == 2) { const int k = k0 + 2 * i + kh; x *= (k < 512 ? gA[k] : gB[k - 512]); } scr[(2 * i + kh) * 33 + nl] = x; }
    asm volatile("s_waitcnt lgkmcnt(0)" ::: "memory");
    const int ch = lane & 7;
#pragma unroll
    for (int j = 0; j < 4; ++j) { const int n = (lane >> 3) + 8 * j; const float* s = scr + (8 * ch) * 33 + n;
        u32x4 o; o.x = pk2(s[0 * 33], s[1 * 33]); o.y = pk2(s[2 * 33], s[3 * 33]); o.z = pk2(s[4 * 33], s[5 * 33]); o.w = pk2(s[6 * 33], s[7 * 33]);
        *(u32x4*)(dst + (size_t)(n0 + n) * K + k0 + 8 * ch) = o; }
    asm volatile("s_waitcnt lgkmcnt(0)" ::: "memory");
}
template <bool PERM1, bool GAIN = false>
__device__ __forceinline__ void conv_item8(const float* src, int K, int N, unsigned char* dst, int item, float* scr, int lane, const float* gA = nullptr, const float* gB = nullptr) {
    const int nblk = N / 32, kb = item / nblk, nb = item % nblk, k0 = 64 * kb, n0 = 32 * nb;
    const int c = lane & 31, kh = lane >> 5;
    const int nl = PERM1 ? 16 * (c & 1) + (c >> 1) : c;
    float v[32];
    const float* sp = src + (size_t)(k0 + kh) * N + n0 + c;
#pragma unroll
    for (int i = 0; i < 32; ++i) v[i] = sp[(size_t)(2 * i) * N];
#pragma unroll
    for (int i = 0; i < 32; ++i) { float g_ = W8_SCALE; if (GAIN) { const int k = k0 + 2 * i + kh; g_ *= (k < 512 ? gA[k] : gB[k - 512]); } scr[(2 * i + kh) * 33 + nl] = v[i] * g_; }
    asm volatile("s_waitcnt lgkmcnt(0)" ::: "memory");
    const int ch = lane & 3;
#pragma unroll
    for (int j = 0; j < 2; ++j) { const int n = (lane >> 2) + 16 * j; const float* s = scr + (16 * ch) * 33 + n;
        u32x4 o; o.x = pk4_fp8(s[0 * 33], s[1 * 33], s[2 * 33], s[3 * 33]); o.y = pk4_fp8(s[4 * 33], s[5 * 33], s[6 * 33], s[7 * 33]);
        o.z = pk4_fp8(s[8 * 33], s[9 * 33], s[10 * 33], s[11 * 33]); o.w = pk4_fp8(s[12 * 33], s[13 * 33], s[14 * 33], s[15 * 33]);
        *(u32x4*)(dst + (size_t)(n0 + n) * K + k0 + 16 * ch) = o; }
    asm volatile("s_waitcnt lgkmcnt(0)" ::: "memory");
}
__device__ void p0_weights(const Params& p, unsigned char* ldsb, int wv) {
    const int tid = tid_opaque(wv), lane = tid & 63, wave = wv; float* scr = (float*)(ldsb + 57344 + wave * 8448);
    const int gw = blockIdx.x * (NTHREADS / 64) + wave, ngw = gridDim.x * (NTHREADS / 64);
    constexpr int I_IN = 16 * 72, I_OUT = 16 * 32;
    constexpr int NITEMS = I_IN + I_OUT;
    for (int it = gw; it < NITEMS; it += ngw) {
        int r = it;
        if (r < I_IN) { conv_item8<false>(p.w_in, D, INW, p.ws + WS_WIN, r, scr, lane); continue; } r -= I_IN;
        conv_item8<false, true>(p.w_out, D, D, p.ws + WS_WOUT, r, scr, lane, p.g_grp_a, p.g_grp_b);
    }
}

__device__ void p1_h(const Params& p, int wv) {
    const int tid = tid_opaque(wv), lane = tid & 63;
    const float* mod = (const float*)(p.ws + WS_MOD);
    unsigned char* hb = p.ws + WS_HB;
    constexpr int R = 17;
    const int gwv = blockIdx.x * (NTHREADS / 64) + (tid >> 6);
    const int m0 = gwv * R; if (m0 >= MROWS) return;
    const int m1 = m0 + R < MROWS ? m0 + R : MROWS;
    f32x4 pB[4], pC[4], v[4], nv[4]; int curb = -1;
#define P1_ROWPTR(m) ((m) < NTOK ? p.x + (size_t)(m) * D : p.ctx + (size_t)((m) - NTOK) * D)
    { const float* xr = P1_ROWPTR(m0);
#pragma unroll
      for (int j = 0; j < 4; ++j) nv[j] = ((const f32x4*)xr)[lane + 64 * j]; }
    for (int m = m0; m < m1; ++m) {
#pragma unroll
        for (int j = 0; j < 4; ++j) v[j] = nv[j];
        if (m + 1 < m1) { const float* xr = P1_ROWPTR(m + 1);
#pragma unroll
            for (int j = 0; j < 4; ++j) nv[j] = ((const f32x4*)xr)[lane + 64 * j]; }
        const int b = m < NTOK ? m / L : 8;
        if (b != curb) { curb = b; const float* sh = mod + b * 6144, * sc = sh + 1024;
#pragma unroll
            for (int j = 0; j < 4; ++j) { const int c0 = 4 * (lane + 64 * j); pB[j] = *(const f32x4*)(p.g_pre_mix + c0) * (*(const f32x4*)(sc + c0) + 1.f); pC[j] = *(const f32x4*)(sh + c0); } }
        float s = 0.f;
#pragma unroll
        for (int j = 0; j < 4; ++j) s += v[j].x * v[j].x + v[j].y * v[j].y + v[j].z * v[j].z + v[j].w * v[j].w;
        const float rstd = rsqrtf(wave_sum(s) * (1.f / D) + EPS);
#pragma unroll
        for (int j = 0; j < 4; ++j) { const int c0 = 4 * (lane + 64 * j);
            const f32x4 o = (v[j] * rstd) * pB[j] + pC[j];
            *(unsigned*)(hb + (size_t)m * D + c0) = pk4_fp8(o.x * H8_SCALE, o.y * H8_SCALE, o.z * H8_SCALE, o.w * H8_SCALE); }
    }
#undef P1_ROWPTR
}

namespace att {
#define ATT_LAS __attribute__((address_space(3)))
typedef float f32x16 __attribute__((ext_vector_type(16)));
typedef short bf16x8 __attribute__((ext_vector_type(8)));
typedef short s16x4 __attribute__((ext_vector_type(4)));
constexpr int SLOTB = 8192, NSLOT = 4;
constexpr int LDS_K = 0, LDS_V = NSLOT * SLOTB, LDS_WS = 2 * NSLOT * SLOTB, LDS_BT = LDS_WS + 8 * 256;
constexpr int BT_MARGIN = 128, BT_FLOATS = BT_MARGIN + 15 * 32 + 128;
constexpr float NEGBIG = -1e30f;
__device__ __forceinline__ int crow(int r, int hi) { return (r & 3) + 8 * (r >> 2) + 4 * hi; }
__device__ __forceinline__ unsigned cvtpk(float lo, float hi) { typedef float f2 __attribute__((ext_vector_type(2))); typedef __bf16 b2 __attribute__((ext_vector_type(2)));
    f2 v = {lo, hi}; b2 b = __builtin_convertvector(v, b2); return __builtin_bit_cast(unsigned, b); }
__device__ __forceinline__ s16x4 vtr(const ATT_LAS unsigned char* p) { typedef short v4i16 __attribute__((ext_vector_type(4)));
    return __builtin_bit_cast(s16x4, __builtin_amdgcn_ds_read_tr16_b64_v4i16((ATT_LAS v4i16*)p)); }
#define ATT_WAIT_BAR(N) asm volatile("s_waitcnt vmcnt(" #N ") lgkmcnt(0)\n\ts_barrier" ::: "memory")

constexpr int LDS_CV = 71680, CV_BUF = 4096, CV_WAVE = 2 * CV_BUF;
static_assert(LDS_BT + BT_FLOATS * 4 <= LDS_CV && LDS_CV + 8 * CV_WAVE <= 147456, "attention LDS map");
constexpr int CV_W1 = 32 * 64, CV_W2 = 32 * 32, CV_ITEMS = NE * (CV_W1 + CV_W2);
constexpr int CV_PERIOD = 5, CV_DUTY = 3;
__device__ __forceinline__ void glds16(const void* gsrc, unsigned lds_dst) { unsigned keep;
    asm volatile("s_mov_b32 %0, m0\n\ts_mov_b32 m0, %2\n\ts_nop 0\n\tglobal_load_lds_dwordx4 %1, off\n\ts_mov_b32 m0, %0" : "=&s"(keep) : "v"(gsrc), "s"(lds_dst) : "memory"); }
__device__ __forceinline__ unsigned lds_addr(const ATT_LAS unsigned char* p) { return (unsigned)(unsigned long long)p; }
struct ConvJob { int it, end, con, nfl, pi, pc, stride, cnt; bool prev; };
__device__ __forceinline__ void cv_decode(const Params& p, int it, const float*& src, unsigned char*& dst, int& N, int& k0, int& n0, bool& perm) {
    int q;
    if (it < NE * CV_W1) { const int e = it / CV_W1; q = it % CV_W1; src = p.w_mlp1 + (size_t)e * D * 2048; dst = p.ws + WS_W1 + (size_t)e * 2048 * D; N = 2048; perm = true; }
    else { const int r = it - NE * CV_W1, e = r / CV_W2; q = r % CV_W2; src = p.w_mlp2 + (size_t)e * D * D; dst = p.ws + WS_W2 + (size_t)e * D * D; N = D; perm = false; }
    const int tile = q >> 3, sub = q & 7, ntn = N / 64, kt = tile / ntn, nt = tile % ntn; k0 = 128 * kt + 32 * (sub & 3); n0 = 64 * nt + 32 * (sub >> 2);
}
__device__ __forceinline__ void cv_issue(const Params& p, int it, int lane, ATT_LAS unsigned char* buf) {
    const float* src; unsigned char* dst; int N, k0, n0; bool perm; cv_decode(p, it, src, dst, N, k0, n0, perm);
    const float* sp = src + (size_t)(k0 + (lane >> 3)) * N + n0 + 4 * (lane & 7);
#pragma unroll
    for (int j = 0; j < 4; ++j) glds16(sp + (size_t)(8 * j) * N, (unsigned)__builtin_amdgcn_readfirstlane(lds_addr(buf + j * 1024)));
}
__device__ __forceinline__ void cv_consume(const Params& p, int it, int lane, ATT_LAS unsigned char* buf) {
    const float* src; unsigned char* dst; int N, k0, n0; bool perm; cv_decode(p, it, src, dst, N, k0, n0, perm);
    const int nr = lane >> 1, kh = lane & 1, cc = perm ? 2 * (nr & 15) + (nr >> 4) : nr;
    ATT_LAS unsigned char* s = buf + (16 * kh) * 128 + cc * 4;
    float v[16];
#pragma unroll
    for (int q = 0; q < 16; ++q) v[q] = pg8::par_f32(s + q * 128) * W8_SCALE;
    u32x4 o; o.x = pk4_fp8(v[0], v[1], v[2], v[3]); o.y = pk4_fp8(v[4], v[5], v[6], v[7]); o.z = pk4_fp8(v[8], v[9], v[10], v[11]); o.w = pk4_fp8(v[12], v[13], v[14], v[15]);
    *(u32x4*)(dst + (size_t)(n0 + nr) * D + k0 + 16 * kh) = o;
}

#define A2_SBAR() __builtin_amdgcn_sched_barrier(0)
#define A2_PIN(x) asm volatile("" : "+v"(x))
#define A2_MFMA(a, b, c) __builtin_amdgcn_mfma_f32_32x32x16_bf16(a, b, c, 0, 0, 0)
__device__ __forceinline__ void kload2(bf16x8* kf, const ATT_LAS unsigned char* kb, const unsigned (&kq)[4], int d0) { kf[2 * d0] = *(const ATT_LAS bf16x8*)(kb + kq[d0]); kf[2 * d0 + 1] = *(const ATT_LAS bf16x8*)(kb + kq[d0] + 4096); }
__device__ __forceinline__ float max3f(float a, float b, float c) { return __builtin_fmaxf(__builtin_fmaxf(a, b), c); }
__device__ __forceinline__ float rowmax32(const f32x16& p0, const f32x16& p1) {
    float a = max3f(p0[0], p0[1], p1[0]), b = max3f(p0[2], p0[3], p1[1]); a = max3f(a, p1[2], p1[3]);
#pragma unroll
    for (int r = 4; r < 16; r += 4) { a = max3f(a, p0[r], p0[r + 1]); b = max3f(b, p0[r + 2], p0[r + 3]); a = max3f(a, p1[r], p1[r + 1]); b = max3f(b, p1[r + 2], p1[r + 3]); }
    float x = __builtin_fmaxf(a, b), y = x;
    asm volatile("s_nop 1\n\tv_permlane32_swap_b32 %0, %1" : "+v"(x), "+v"(y));
    return __builtin_fmaxf(x, y); }
__device__ __forceinline__ void att_wait_bar(int n) {
    switch (n) { case 0: ATT_WAIT_BAR(0); break; case 1: ATT_WAIT_BAR(1); break; case 2: ATT_WAIT_BAR(2); break; case 3: ATT_WAIT_BAR(3); break;
                 case 4: ATT_WAIT_BAR(4); break; case 5: ATT_WAIT_BAR(5); break; case 6: ATT_WAIT_BAR(6); break; default: ATT_WAIT_BAR(7); break; } }

struct A2U { int b, kvh, qb, jlo, j1, nU, NTr, NT; };
__device__ __forceinline__ A2U a2_unit(int unit) { A2U u; u.b = unit >> 7; u.kvh = (unit >> 6) & 1; u.qb = unit & 63;
    const int jlo = 2 - u.qb > 0 ? 2 - u.qb : 0, jhi = 65 - u.qb < 4 ? 65 - u.qb : 4;
    const int j1 = jlo > 1 ? jlo : 1, j3 = jhi < 3 ? jhi : 3; u.jlo = jlo; u.j1 = j1; u.nU = j3 - j1 + 1; u.NTr = u.nU + 4 + (jlo == 0 ? 1 : 0) + (jhi == 4 ? 1 : 0); u.NT = u.NTr | 1; return u; }
__device__ __forceinline__ const bf16_t* a2_row(const bf16_t* qkv, const A2U& u, int t) {
    const bf16_t* lat = qkv + (size_t)u.b * L * INW;
    if (t < u.nU) return lat + (size_t)((u.qb - 2 + u.j1 + t) * 64) * INW;
    if (t < u.nU + 4) return qkv + (size_t)(NTOK + u.b * CTX + (t - u.nU) * 64) * INW;
    if (t >= u.NTr) return lat + (size_t)((u.qb - 2 + u.j1) * 64) * INW;
    return lat + (size_t)((u.qb - 2 + ((t == u.nU + 4 && u.jlo == 0) ? 0 : 4)) * 64) * INW; }

__device__ __forceinline__ void attn_a2_units(const Params& p, ATT_LAS unsigned char* lds, int wv, ConvJob& cj, int vcu, int G) {
    if (vcu >= 1024) return;
    const int tid = tid_opaque(wv), lane = tid & 63, r32 = lane & 31, hi = lane >> 5; const int wid = wv;
    const bf16_t* qkv = (const bf16_t*)(p.ws + WS_QKV); unsigned char* ob = p.ws + WS_O;
    ATT_LAS float* wsf = (ATT_LAS float*)(lds + LDS_WS) + wid * 64;
    ATT_LAS unsigned char* cvbuf = lds + LDS_CV + wid * CV_WAVE;
    ATT_LAS unsigned char* stg = lds + (wid < 4 ? 3 * SLOTB + wid * 2048 : LDS_V + 3 * SLOTB + (wid - 4) * 2048);
    const int half = wid & 1;
    const int koff = (8 * wid + (lane >> 3)) * INW + (((lane & 7) ^ ((4 * wid + (lane >> 4)) & 7)) * 8), voff = (8 * wid + (lane >> 3)) * INW + ((((lane & 7) >> 2) ^ ((lane >> 4) & 1)) * 32 + (lane & 3) * 8);
    const ATT_LAS unsigned char* vp0 = lds + LDS_V + (4 * hi + ((lane & 15) >> 2)) * 128 + (((lane >> 3) & 1) * 64) + ((lane >> 4) & 1) * 32 + (lane & 3) * 8;
    const ATT_LAS unsigned char* kp0 = lds + LDS_K;
    unsigned kq[4];
#pragma unroll
    for (int d0 = 0; d0 < 4; ++d0) kq[d0] = (unsigned)(r32 * 128 + (((2 * d0 + hi) ^ ((r32 >> 1) & 7)) * 16));
#define A2_SLOT3(x) ((x) >= 3 * SLOTB ? (x) - 3 * SLOTB : (x))
#define A2_DMA_K(U, t, slot) glds16(a2_row(qkv, U, t) + (C_KA + (U).kvh * 64) + koff, (unsigned)__builtin_amdgcn_readfirstlane(lds_addr(lds + LDS_K + wid * 1024) + (unsigned)(slot)))
#define A2_DMA_V(U, t, slot) glds16(a2_row(qkv, U, t) + (C_VA + (U).kvh * 64) + voff, (unsigned)__builtin_amdgcn_readfirstlane(lds_addr(lds + LDS_V + wid * 1024) + (unsigned)(slot)))
#define A2_OPEN(U, RB) do { A2_DMA_K(U, 0, RB); A2_DMA_V(U, 0, RB); A2_DMA_K(U, 1, A2_SLOT3((RB) + SLOTB)); A2_DMA_K(U, 2, A2_SLOT3((RB) + 2 * SLOTB)); \
        const bf16_t* qp_ = qkv + (size_t)((U).b * L + (U).qb * 64 + 32 * half + r32) * INW + C_QA + ((U).kvh * 4 + (wid >> 1)) * 64 + hi * 8; \
        A2_QLD(qf[0], qp_, 0); A2_QLD(qf[1], qp_, 32); A2_QLD(qf[2], qp_, 64); A2_QLD(qf[3], qp_, 96); } while (0)
#define A2_QLD(dst, ptr, OFF) asm volatile("global_load_dwordx4 %0, %1, off offset:" #OFF : "=&v"(dst) : "v"(ptr) : "memory")
    bf16x8 qf[4];
    const float sink0 = __builtin_amdgcn_exp2f(p.sink_a[wid >> 1] * LOG2E), sink1 = __builtin_amdgcn_exp2f(p.sink_a[4 + (wid >> 1)] * LOG2E);
#define A2_STAG 1
    const bool ystag = wid >= 4;
    int unit = vcu, rb = 0;
    A2U U = a2_unit(unit);
    A2_OPEN(U, rb);
    ATT_WAIT_BAR(0);
    f32x16 negm;
#pragma unroll 1
    for (;;) {
    const int NT = U.NT, h = U.kvh * 4 + (wid >> 1), q0 = U.qb * 64 + 32 * half, ocol = h * 64;
#define A2_MODE(t) ((t) < U.nU + 4 ? 0 : (t) >= U.NTr ? 3 : (((t) == U.nU + 4 && U.jlo == 0) ? 1 : 2))
    float mref = 0.f, l_run = hi == 0 ? (U.kvh ? sink1 : sink0) : 0.f;
    f32x16 o0, o1; float zero_ = 0.f; A2_PIN(zero_);
#pragma unroll
    for (int r = 0; r < 16; ++r) { o0[r] = zero_; o1[r] = zero_; negm[r] = zero_; }
    A2_PIN(negm);
    bool resc = false;
    f32x16 pA0, pA1, pB0, pB1; bf16x8 kf[8]; s16x4 vlo[8], vhi[8];
    typedef unsigned u4 __attribute__((ext_vector_type(4)));
    u4 pw0, pw1, pw2, pw3;
    int sl_prev = rb, sl_cur = rb, sl_next = A2_SLOT3(rb + SLOTB);
#define A2_ROT() do { sl_prev = sl_cur; sl_cur = sl_next; sl_next = (sl_next == 2 * SLOTB) ? 0 : sl_next + SLOTB; } while (0)
#define A2_EX(v) __builtin_amdgcn_exp2f(v)
#define A2_RESC() do { if (resc) { const int hr_ = lane_id() >> 5; _Pragma("unroll") for (int g = 0; g < 4; ++g) { const f32x4 f_ = *(const ATT_LAS f32x4*)(wsf + 8 * g + 4 * hr_);     \
        o0[4 * g] *= f_.x; o0[4 * g + 1] *= f_.y; o0[4 * g + 2] *= f_.z; o0[4 * g + 3] *= f_.w; o1[4 * g] *= f_.x; o1[4 * g + 1] *= f_.y; o1[4 * g + 2] *= f_.z; o1[4 * g + 3] *= f_.w; \
        asm volatile("" : "+v"(o0), "+v"(o1) :: "memory"); } } } while (0)
#define A2_DECIDE(C0, C1, MODE) do { \
        if (MODE) { const int l_ = lane_id(), qq_ = 32 * half + (l_ & 31), h4_ = (l_ >> 5) * 4;        \
                    if ((MODE) == 3) { _Pragma("unroll") for (int r = 0; r < 16; ++r) { C0[r] = NEGBIG; C1[r] = NEGBIG; } } \
                    else if ((MODE) == 1) { _Pragma("unroll") for (int r = 0; r < 16; ++r) { const int c = (r & 3) + 8 * (r >> 2) + h4_; if (c < qq_) C0[r] = NEGBIG; if (c + 32 < qq_) C1[r] = NEGBIG; } } \
                    else             { _Pragma("unroll") for (int r = 0; r < 16; ++r) { const int c = (r & 3) + 8 * (r >> 2) + h4_; if (c > qq_) C0[r] = NEGBIG; if (c + 32 > qq_) C1[r] = NEGBIG; } } } \
        const float rm_ = rowmax32(C0, C1); resc = false; \
        if (__builtin_expect(__any(rm_ > 8.f), 0)) { const float dl_ = __builtin_fmaxf(rm_, 0.f); mref += dl_; const float f_ = __builtin_amdgcn_exp2f(-dl_); l_run *= f_; { const int lw_ = lane_id(); if (lw_ < 32) wsf[lw_] = f_; } resc = true; \
            _Pragma("unroll") for (int r = 0; r < 16; ++r) { C0[r] -= dl_; C1[r] -= dl_; negm[r] = -mref; } } } while (0)
#pragma unroll
    for (int d0 = 0; d0 < 4; ++d0) kload2(kf, kp0 + sl_cur, kq, d0);
    pA0 = A2_MFMA(kf[0], qf[0], negm); pA1 = A2_MFMA(kf[1], qf[0], negm); pA0 = A2_MFMA(kf[2], qf[1], pA0); pA1 = A2_MFMA(kf[3], qf[1], pA1);
    pA0 = A2_MFMA(kf[4], qf[2], pA0); pA1 = A2_MFMA(kf[5], qf[2], pA1); pA0 = A2_MFMA(kf[6], qf[3], pA0); pA1 = A2_MFMA(kf[7], qf[3], pA1);
    A2_DECIDE(pA0, pA1, 0);
#pragma unroll
    for (int r = 0; r < 16; ++r) { pA0[r] = A2_EX(pA0[r]); pA1[r] = A2_EX(pA1[r]); }
    asm volatile("s_waitcnt lgkmcnt(0)\n\ts_barrier" ::: "memory");
    A2_DMA_K(U, 3, sl_cur); A2_DMA_V(U, 1, sl_next); A2_ROT();
#pragma unroll
    for (int d0 = 0; d0 < 4; ++d0) kload2(kf, kp0 + sl_cur, kq, d0);
    asm volatile("s_waitcnt lgkmcnt(0)\n\ts_barrier" ::: "memory");
#define A2_PKW(P, i) cvtpk(P[i], P[(i) + 1])
#define A2_PAF(k) __builtin_bit_cast(bf16x8, pw##k)
#define A2_VFR(i) (bf16x8){vlo[i][0], vlo[i][1], vlo[i][2], vlo[i][3], vhi[i][0], vhi[i][1], vhi[i][2], vhi[i][3]}
#define A2_VRD(i) do { const ATT_LAS unsigned char* vb_ = ((i) >> 2) ? vq_ : vp_; vlo[i] = vtr(vb_ + ((i) & 3) * 2048); vhi[i] = vtr(vb_ + ((i) & 3) * 2048 + 1024); } while (0)
#define A2_KRD(G, d0) do { if (G) { kload2(kf, kp0 + sl_next, kq, d0); A2_SBAR(); } } while (0)
#define A2_GAPA(MF, a0, a1, a2, a3, W0, W1, PW) do { MF; sacc += a0; sacc += a1; sacc += a2; sacc += a3; W0; W1; A2_PIN(PW); A2_PIN(sacc); A2_SBAR(); } while (0)
#define A2_GAPB(MF, X, i) do { MF; X[i] = A2_EX(X[i]); X[(i) + 1] = A2_EX(X[(i) + 1]); X[(i) + 2] = A2_EX(X[(i) + 2]); X[(i) + 3] = A2_EX(X[(i) + 3]); A2_PIN(X); A2_SBAR(); } while (0)
#define A2_STEP(C0, C1, P0, P1, T) do { A2_SBAR(); \
    if (A2_STAG && !ystag && (T) >= 2) A2_DMA_V(U, (T), sl_cur);                                            \
      \
    const bool con_ = cj.nfl == 2 || (cj.nfl > 0 && cj.it >= cj.end && !cj.prev);                          \
    if (con_) { cv_consume(p, cj.con, lane, cvbuf + cj.pc * CV_BUF); cj.con += cj.stride; --cj.nfl; cj.pc ^= 1; } \
    const bool iss_ = cj.it < cj.end && cj.nfl < 2 && cj.cnt < CV_DUTY; cj.cnt = cj.cnt + 1 == CV_PERIOD ? 0 : cj.cnt + 1;     \
    if (iss_) { cv_issue(p, cj.it, lane, cvbuf + cj.pi * CV_BUF); cj.it += cj.stride; ++cj.nfl; cj.pi ^= 1; } \
    cj.prev = iss_; A2_SBAR(); \
    const int t_ = (T); const bool gk_ = t_ + 3 < NT, gv_ = t_ + 1 < NT; const int mode_ = A2_MODE(t_); \
    const ATT_LAS unsigned char* vp_ = vp0 + sl_prev; const ATT_LAS unsigned char* vq_ = (const ATT_LAS unsigned char*)(lds_addr(vp0) ^ 64u) + sl_prev; \
    float sacc = P0[0] + P0[1]; \
                    A2_GAPA(C0 = A2_MFMA(kf[0], qf[0], negm), P0[2], P0[3], P0[4], P0[5],     pw0[0] = A2_PKW(P0, 0),  pw0[1] = A2_PKW(P0, 2),  pw0); \
                    A2_GAPA(C1 = A2_MFMA(kf[1], qf[0], negm), P0[6], P0[7], P0[8], P0[9],     pw0[2] = A2_PKW(P0, 4),  pw0[3] = A2_PKW(P0, 6),  pw0); \
                    A2_GAPA(C0 = A2_MFMA(kf[2], qf[1], C0),   P0[10], P0[11], P0[12], P0[13], pw1[0] = A2_PKW(P0, 8),  pw1[1] = A2_PKW(P0, 10), pw1); \
    A2_KRD(gv_, 0); A2_GAPA(C1 = A2_MFMA(kf[3], qf[1], C1),   P0[14], P0[15], P1[0], P1[1],   pw1[2] = A2_PKW(P0, 12), pw1[3] = A2_PKW(P0, 14), pw1); \
                    A2_GAPA(C0 = A2_MFMA(kf[4], qf[2], C0),   P1[2], P1[3], P1[4], P1[5],     pw2[0] = A2_PKW(P1, 0),  pw2[1] = A2_PKW(P1, 2),  pw2); \
    A2_KRD(gv_, 1); A2_GAPA(C1 = A2_MFMA(kf[5], qf[2], C1),   P1[6], P1[7], P1[8], P1[9],     pw2[2] = A2_PKW(P1, 4),  pw2[3] = A2_PKW(P1, 6),  pw2); \
                    A2_GAPA(C0 = A2_MFMA(kf[6], qf[3], C0),   P1[10], P1[11], P1[12], P1[13], pw3[0] = A2_PKW(P1, 8),  pw3[1] = A2_PKW(P1, 10), pw3); \
    A2_KRD(gv_, 2); A2_GAPA(C1 = A2_MFMA(kf[7], qf[3], C1),   P1[14], P1[15], 0.f, 0.f,       pw3[2] = A2_PKW(P1, 12), pw3[3] = A2_PKW(P1, 14), pw3); \
    l_run += sacc; \
    A2_VRD(0); A2_VRD(4); A2_SBAR(); \
    if (!(A2_STAG && ystag)) { if (gk_) A2_DMA_K(U, t_ + 3, sl_cur); if (gv_ && !A2_STAG) A2_DMA_V(U, t_ + 1, sl_next); }     \
    A2_DECIDE(C0, C1, mode_); A2_SBAR(); \
    A2_KRD(gv_, 3); \
    if (A2_STAG && ystag) { asm volatile("s_waitcnt lgkmcnt(0)" ::: "memory"); att_wait_bar((con_ ? 1 : 0) + (iss_ ? 4 : 0));     \
        if (gk_) A2_DMA_K(U, t_ + 3, sl_cur); if (gv_) A2_DMA_V(U, t_ + 1, sl_next); } \
    A2_VRD(1); A2_SBAR(); A2_GAPB(o0 = A2_MFMA(A2_PAF(0), A2_VFR(0), o0), C0, 0); \
    A2_VRD(5); A2_SBAR(); A2_GAPB(o1 = A2_MFMA(A2_PAF(0), A2_VFR(4), o1), C0, 4); \
    A2_VRD(2); A2_SBAR(); A2_GAPB(o0 = A2_MFMA(A2_PAF(1), A2_VFR(1), o0), C0, 8); \
    A2_VRD(6); A2_SBAR(); A2_GAPB(o1 = A2_MFMA(A2_PAF(1), A2_VFR(5), o1), C0, 12); \
    A2_VRD(3); A2_SBAR(); A2_GAPB(o0 = A2_MFMA(A2_PAF(2), A2_VFR(2), o0), C1, 0); \
    A2_VRD(7); A2_SBAR(); A2_GAPB(o1 = A2_MFMA(A2_PAF(2), A2_VFR(6), o1), C1, 4); \
                          A2_GAPB(o0 = A2_MFMA(A2_PAF(3), A2_VFR(3), o0), C1, 8); \
                          A2_GAPB(o1 = A2_MFMA(A2_PAF(3), A2_VFR(7), o1), C1, 12); \
      \
    if (!(A2_STAG && ystag)) att_wait_bar((gk_ ? 1 : 0) + ((gv_ && !A2_STAG) ? 1 : 0) + (con_ ? 1 : 0) + (iss_ ? 4 : 0)); \
    A2_RESC(); A2_ROT(); } while (0)
#define A2_DRAIN(P0, P1) do { float sacc = P0[0] + P0[1]; \
      _Pragma("unroll") for (int r = 2; r < 16; ++r) sacc += P0[r]; \
      _Pragma("unroll") for (int r = 0; r < 16; ++r) sacc += P1[r]; \
      l_run += sacc; \
      pw0 = (u4){A2_PKW(P0, 0), A2_PKW(P0, 2), A2_PKW(P0, 4), A2_PKW(P0, 6)}; pw1 = (u4){A2_PKW(P0, 8), A2_PKW(P0, 10), A2_PKW(P0, 12), A2_PKW(P0, 14)}; \
      pw2 = (u4){A2_PKW(P1, 0), A2_PKW(P1, 2), A2_PKW(P1, 4), A2_PKW(P1, 6)}; pw3 = (u4){A2_PKW(P1, 8), A2_PKW(P1, 10), A2_PKW(P1, 12), A2_PKW(P1, 14)}; \
      const ATT_LAS unsigned char* vp_ = vp0 + sl_prev; const ATT_LAS unsigned char* vq_ = (const ATT_LAS unsigned char*)(lds_addr(vp0) ^ 64u) + sl_prev; _Pragma("unroll") for (int i = 0; i < 8; ++i) A2_VRD(i); \
      o0 = A2_MFMA(A2_PAF(0), A2_VFR(0), o0); o1 = A2_MFMA(A2_PAF(0), A2_VFR(4), o1); o0 = A2_MFMA(A2_PAF(1), A2_VFR(1), o0); o1 = A2_MFMA(A2_PAF(1), A2_VFR(5), o1); \
      o0 = A2_MFMA(A2_PAF(2), A2_VFR(2), o0); o1 = A2_MFMA(A2_PAF(2), A2_VFR(6), o1); o0 = A2_MFMA(A2_PAF(3), A2_VFR(3), o0); o1 = A2_MFMA(A2_PAF(3), A2_VFR(7), o1); } while (0)
    const int nxt = unit + G; const bool has_next = nxt < 1024; A2U UN = a2_unit(has_next ? nxt : unit);
    int t = 1;
#pragma unroll 1
    for (; t + 1 < NT; t += 2) {
        A2_STEP(pB0, pB1, pA0, pA1, t);
        A2_STEP(pA0, pA1, pB0, pB1, t + 1);
    }
    if (has_next) A2_OPEN(UN, sl_cur);
    A2_DRAIN(pA0, pA1);
    { float x = l_run, y = l_run; asm volatile("s_nop 1\n\tv_permlane32_swap_b32 %0, %1" : "+v"(x), "+v"(y)); l_run = x + y; }
    const int le = lane_id(), he = le >> 5, re = le & 31;
    if (he == 0) wsf[32 + re] = l_run;
    asm volatile("s_waitcnt lgkmcnt(0)" ::: "memory");
    float inv[16];
#pragma unroll
    for (int g = 0; g < 4; ++g) { const f32x4 l4 = *(const ATT_LAS f32x4*)(wsf + 32 + 8 * g + 4 * he);
        inv[4 * g] = __builtin_amdgcn_rcpf(l4.x); inv[4 * g + 1] = __builtin_amdgcn_rcpf(l4.y); inv[4 * g + 2] = __builtin_amdgcn_rcpf(l4.z); inv[4 * g + 3] = __builtin_amdgcn_rcpf(l4.w); }
    asm volatile("; A2_EPI_BEGIN" ::: "memory");
    float ssq[2] = {0.f, 0.f};
    unsigned char* orow = ob + (size_t)(U.b * L + q0 + (le >> 2)) * D + ocol + (le & 3) * 8;
#pragma unroll
    for (int hh = 0; hh < 2; ++hh) {
#pragma unroll
        for (int r = 0; r < 16; r += 2) { const float a = (hh ? o1[r] : o0[r]) * inv[r] * O8_SCALE, a2 = (hh ? o1[r + 1] : o0[r + 1]) * inv[r + 1] * O8_SCALE;
            const int w8_ = __builtin_amdgcn_cvt_pk_fp8_f32(a, a2, 0, false);
            *(ATT_LAS unsigned char*)(stg + crow(r, he) * 32 + re) = (unsigned char)(w8_ & 0xff); *(ATT_LAS unsigned char*)(stg + crow(r + 1, he) * 32 + re) = (unsigned char)((w8_ >> 8) & 0xff); }
        asm volatile("s_waitcnt lgkmcnt(0)" ::: "memory");
#pragma unroll
        for (int i = 0; i < 2; ++i) { const u32x2 w = __builtin_bit_cast(u32x2, *(const ATT_LAS s16x4*)(stg + (i * 16 + (le >> 2)) * 32 + (le & 3) * 8));
            *(u32x2*)(orow + (size_t)(i * 16) * D + hh * 32) = w;
            float s = 0.f;
#pragma unroll
            for (int k = 0; k < 2; ++k) { typedef float f2q_ __attribute__((ext_vector_type(2))); const f2q_ l_ = __builtin_amdgcn_cvt_pk_f32_fp8((int)w[k], false), h_ = __builtin_amdgcn_cvt_pk_f32_fp8((int)w[k], true);
                s = fmaf(l_.x, l_.x, s); s = fmaf(l_.y, l_.y, s); s = fmaf(h_.x, h_.x, s); s = fmaf(h_.y, h_.y, s); }
            ssq[i] += s * (1.f / (O8_SCALE * O8_SCALE)); }
        asm volatile("s_waitcnt lgkmcnt(0)" ::: "memory");
    }
    { float* ossp = (float*)(p.ws + WS_OSS) + (size_t)(U.b * L + q0 + (le >> 2)) * 16 + (ocol >> 6);
#pragma unroll
      for (int i = 0; i < 2; ++i) { float s = ssq[i]; s += dppmov<0xB1>(s); s += dppmov<0x4E>(s);
          if ((le & 3) == 0) ossp[(size_t)(i * 16) * 16] = s; } }
    asm volatile("; A2_EPI_END" ::: "memory");
    if (!has_next) break;
    ATT_WAIT_BAR(6);
    unit = nxt; U = UN; rb = sl_cur;
    }
    ATT_WAIT_BAR(0);
    cj.prev = false;
#undef A2_OPEN
#undef A2_MODE
#undef A2_DMA_K
#undef A2_DMA_V
}

constexpr int LDS_BT2 = 137216, BT2_BUF = 2304, BT2_MARGIN = 64, LDS_BNEG = LDS_BT2 + 2 * BT2_BUF;
static_assert(LDS_BNEG + 128 <= 147456, "attention LDS map (group B tables)");
__device__ __forceinline__ void glds4(const void* gsrc, unsigned lds_dst) { unsigned keep;
    asm volatile("s_mov_b32 %0, m0\n\ts_mov_b32 m0, %2\n\ts_nop 0\n\tglobal_load_lds_dword %1, off\n\ts_mov_b32 m0, %0" : "=&s"(keep) : "v"(gsrc), "s"(lds_dst) : "memory"); }
struct B2U { int b, h, g, row_lo, nloc, nlocp, NT; };
__device__ __forceinline__ B2U b2_unit(int unit) { B2U u; u.b = unit >> 7; u.h = (unit >> 4) & 7; u.g = unit & 15;
    const int r0 = 4 * u.g, r3 = r0 + 3; u.row_lo = r0 - 4 < 0 ? 0 : (r0 - 4 > 56 ? 56 : r0 - 4); const int rs3 = r3 - 4 < 0 ? 0 : (r3 - 4 > 56 ? 56 : r3 - 4);
    u.nloc = rs3 + 7 - u.row_lo + 1; u.nlocp = u.nloc | 1; u.NT = u.nlocp + 4; return u; }
__device__ __forceinline__ const bf16_t* b2_row(const bf16_t* qkv, const B2U& u, int t) {
    if (t < u.nlocp) return qkv + (size_t)(u.b * L + (u.row_lo + (t < u.nloc ? t : 0)) * 64) * INW;
    return qkv + (size_t)(NTOK + u.b * CTX + (t - u.nlocp) * 64) * INW; }

__device__ __forceinline__ void attn_b2_units(const Params& p, ATT_LAS unsigned char* lds, int wv, ConvJob& cj, int vcu, int G) {
    if (vcu >= 1024) return;
    const int tid = tid_opaque(wv), lane = tid & 63, r32 = lane & 31, hi = lane >> 5; const int wid = wv;
    const bf16_t* qkv = (const bf16_t*)(p.ws + WS_QKV); unsigned char* ob = p.ws + WS_O;
    ATT_LAS float* wsf = (ATT_LAS float*)(lds + LDS_WS) + wid * 64;
    ATT_LAS unsigned char* cvbuf = lds + LDS_CV + wid * CV_WAVE;
    ATT_LAS unsigned char* stg = lds + (wid < 4 ? 3 * SLOTB + wid * 2048 : LDS_V + 3 * SLOTB + (wid - 4) * 2048);
    const int half = wid & 3, bs = half == 0 ? 0 : half == 1 ? 8 : half == 2 ? 24 : 32;
    const int koff = (8 * wid + (lane >> 3)) * INW + (((lane & 7) ^ ((4 * wid + (lane >> 4)) & 7)) * 8), voff = (8 * wid + (lane >> 3)) * INW + ((((lane & 7) >> 2) ^ ((lane >> 4) & 1)) * 32 + (lane & 3) * 8);
    const ATT_LAS unsigned char* vp0 = lds + LDS_V + (4 * hi + ((lane & 15) >> 2)) * 128 + (((lane >> 3) & 1) * 64) + ((lane >> 4) & 1) * 32 + (lane & 3) * 8;
    const ATT_LAS unsigned char* kp0 = lds + LDS_K;
    const bool kflip = half == 1 || half == 2;
    unsigned kq[4];
#define B2_KQ_CTX() do { const int ln_ = lane_id(), r_ = ln_ & 31, h_ = ln_ >> 5; _Pragma("unroll") for (int d0 = 0; d0 < 4; ++d0) kq[d0] = (unsigned)(r_ * 128 + (((2 * d0 + h_) ^ ((r_ >> 1) & 7)) * 16)); } while (0)
#define B2_KQ_LOC() do { const int ln_ = lane_id(), r_ = ln_ & 31, h_ = ln_ >> 5; _Pragma("unroll") for (int d0 = 0; d0 < 4; ++d0) kq[d0] = (unsigned)((bs + r_) * 128 + (((2 * (d0 ^ (kflip ? 2 : 0)) + h_) ^ ((r_ >> 1) & 7)) * 16)); } while (0)
    const int qc = 16 * half + (r32 & 15);
    if (tid < 32) *(ATT_LAS float*)(lds + LDS_BNEG + tid * 4) = NEGBIG;
    if (tid < 32) { *(ATT_LAS float*)(lds + LDS_BT2 + (tid & 15) * 4 + (tid >> 4) * BT2_BUF) = 0.f; }
#define A2_DMA_K(U, t, slot) glds16(b2_row(qkv, U, t) + (C_KB + (U).h * 64) + koff, (unsigned)__builtin_amdgcn_readfirstlane(lds_addr(lds + LDS_K + wid * 1024) + (unsigned)(slot)))
#define A2_DMA_V(U, t, slot) glds16(b2_row(qkv, U, t) + (C_VB + (U).h * 64) + voff, (unsigned)__builtin_amdgcn_readfirstlane(lds_addr(lds + LDS_V + wid * 1024) + (unsigned)(slot)))
#define A2_MODE(t) 0
#define B2_OPEN(U, RB, PAR) do { A2_DMA_K(U, 0, RB); A2_DMA_V(U, 0, RB); A2_DMA_K(U, 1, A2_SLOT3((RB) + SLOTB)); A2_DMA_K(U, 2, A2_SLOT3((RB) + 2 * SLOTB)); \
        const int lo_ = lane_id();                                                                         \
        { const int e_ = wid * 64 + lo_; glds4(p.rpb_b + (size_t)(U).h * 465 + (e_ < 465 ? e_ : 464), (unsigned)__builtin_amdgcn_readfirstlane(lds_addr(lds + LDS_BT2 + (PAR) * BT2_BUF + BT2_MARGIN + wid * 256))); } \
        const bf16_t* qp_ = qkv + (size_t)((U).b * L + (4 * (U).g + 2 * (wid >> 2) + ((lo_ >> 4) & 1)) * 64 + 16 * half + (lo_ & 15)) * INW + C_QB + (U).h * 64 + (lo_ >> 5) * 8; \
        A2_QLD(qf[0], qp_, 0); A2_QLD(qf[1], qp_, 32); A2_QLD(qf[2], qp_, 64); A2_QLD(qf[3], qp_, 96); } while (0)
    bf16x8 qf[4];
#undef A2_STAG
#define A2_STAG 0
    const bool ystag = false;
    int unit = vcu, rb = 0, par = 0;
    B2U U = b2_unit(unit);
    B2_OPEN(U, rb, par);
    ATT_WAIT_BAR(0);
    f32x16 negm;
#pragma unroll 1
    for (;;) {
    const int NT = U.NT, nlocp = U.nlocp, qrw = 4 * U.g + 2 * (wid >> 2), ocol = 512 + U.h * 64;
    const int qr = qrw + (r32 >> 4), rsq = qr - 4 < 0 ? 0 : (qr - 4 > 56 ? 56 : qr - 4), tlo = rsq - U.row_lo;
    const unsigned bbase = lds_addr(lds + LDS_BT2 + par * BT2_BUF + BT2_MARGIN) + (unsigned)(((U.row_lo - qr + 7) * 31 + 15 - qc + bs + 4 * hi) * 4);
#define B2_BP(t) (((unsigned)((t) - tlo) < 8u) ? bbase + (unsigned)((t) * 124) : lds_addr(lds + LDS_BNEG))
#define B2_CINIT(X, t) do { const ATT_LAS float* bp_ = (const ATT_LAS float*)(ATT_LAS unsigned char*)(unsigned long long)B2_BP(t); \
        _Pragma("unroll") for (int r = 0; r < 16; ++r) X[r] = __builtin_fmaf(bp_[(r & 3) + 8 * (r >> 2)], LOG2E, negm[r]); } while (0)
#define B2_NEGMASK() do { const int ln_ = lane_id(), qc_ = 16 * half + (ln_ & 15), cs_ = qc_ - 8 < 0 ? 0 : (qc_ - 8 > 48 ? 48 : qc_ - 8), e0_ = bs + 4 * (ln_ >> 5) - cs_;     \
        _Pragma("unroll") for (int r = 0; r < 16; ++r) negm[r] = ((unsigned)((r & 3) + 8 * (r >> 2) + e0_) < 16u) ? -mref : NEGBIG; } while (0)
    float mref = 0.f, l_run = 0.f;
    f32x16 o0, o1; float zero_ = 0.f; A2_PIN(zero_);
#pragma unroll
    for (int r = 0; r < 16; ++r) { o0[r] = zero_; o1[r] = zero_; }
    B2_NEGMASK(); A2_PIN(negm);
    bool resc = false;
    f32x16 pA0, pA1, pB0, pB1; bf16x8 kf[8]; s16x4 vlo[8], vhi[8];
    typedef unsigned u4 __attribute__((ext_vector_type(4)));
    u4 pw0, pw1, pw2, pw3;
    int sl_prev = rb, sl_cur = rb, sl_next = A2_SLOT3(rb + SLOTB);
#define B2_DECIDE_L(C0) do { float a_ = max3f(C0[0], C0[1], C0[2]), b_ = max3f(C0[3], C0[4], C0[5]); \
        a_ = max3f(a_, C0[6], C0[7]); b_ = max3f(b_, C0[8], C0[9]); a_ = max3f(a_, C0[10], C0[11]); b_ = max3f(b_, C0[12], C0[13]); a_ = max3f(a_, C0[14], C0[15]); \
        float x_ = __builtin_fmaxf(a_, b_), y_ = x_; asm volatile("s_nop 1\n\tv_permlane32_swap_b32 %0, %1" : "+v"(x_), "+v"(y_)); const float rm_ = __builtin_fmaxf(x_, y_); resc = false; \
        if (__builtin_expect(__any(rm_ > 8.f), 0)) { const float dl_ = __builtin_fmaxf(rm_, 0.f); mref += dl_; const float f_ = __builtin_amdgcn_exp2f(-dl_); l_run *= f_; { const int lw_ = lane_id(); if (lw_ < 32) wsf[lw_] = f_; } resc = true; \
            _Pragma("unroll") for (int r = 0; r < 16; ++r) C0[r] -= dl_; B2_NEGMASK(); } } while (0)
    B2_KQ_LOC();
    B2_CINIT(pA0, 0);
    { const ATT_LAS unsigned char* kb_ = kp0 + sl_cur;
#pragma unroll
      for (int d0 = 0; d0 < 4; ++d0) kf[2 * d0] = *(const ATT_LAS bf16x8*)(kb_ + kq[d0]); }
    pA0 = A2_MFMA(kf[0], qf[0], pA0); pA0 = A2_MFMA(kf[2], qf[1], pA0); pA0 = A2_MFMA(kf[4], qf[2], pA0); pA0 = A2_MFMA(kf[6], qf[3], pA0);
    B2_DECIDE_L(pA0);
#pragma unroll
    for (int r = 0; r < 16; ++r) pA0[r] = A2_EX(pA0[r]);
    asm volatile("s_waitcnt lgkmcnt(0)\n\ts_barrier" ::: "memory");
    A2_DMA_K(U, 3, sl_cur); A2_DMA_V(U, 1, sl_next); A2_ROT();
    B2_CINIT(pB0, 1);
    { const ATT_LAS unsigned char* kb_ = kp0 + sl_cur;
#pragma unroll
      for (int d0 = 0; d0 < 4; ++d0) kf[2 * d0] = *(const ATT_LAS bf16x8*)(kb_ + kq[d0]); }
    asm volatile("s_waitcnt lgkmcnt(0)\n\ts_barrier" ::: "memory");
#define B2_KRDL(NC, d0) do { if (NC) kload2(kf, kp0 + sl_next, kq, d0); else kf[2 * (d0)] = *(const ATT_LAS bf16x8*)(kp0 + sl_next + kq[d0]); A2_SBAR(); } while (0)
#define B2_FMA1(dst, a, c) asm("v_fma_f32 %0, %1, %2, %3" : "=v"(dst) : "v"(a), "s"(LOG2E), "v"(c))
#define B2_CIN4(X, bp_, i) do { float t0_, t1_, t2_, t3_; \
        B2_FMA1(t0_, bp_[((i) & 3) + 8 * ((i) >> 2)], negm[i]); B2_FMA1(t1_, bp_[(((i) + 1) & 3) + 8 * (((i) + 1) >> 2)], negm[(i) + 1]); \
        B2_FMA1(t2_, bp_[(((i) + 2) & 3) + 8 * (((i) + 2) >> 2)], negm[(i) + 2]); B2_FMA1(t3_, bp_[(((i) + 3) & 3) + 8 * (((i) + 3) >> 2)], negm[(i) + 3]); \
        X[i] = t0_; X[(i) + 1] = t1_; X[(i) + 2] = t2_; X[(i) + 3] = t3_; } while (0)
#define B2_STEP_LL(C0, P0, T) do { A2_SBAR(); \
      \
    const bool con_ = cj.nfl == 2 || (cj.nfl > 0 && cj.it >= cj.end && !cj.prev);                          \
    if (con_) { cv_consume(p, cj.con, lane, cvbuf + cj.pc * CV_BUF); cj.con += cj.stride; --cj.nfl; cj.pc ^= 1; } \
    const bool iss_ = cj.it < cj.end && cj.nfl < 2 && cj.cnt < CV_DUTY; cj.cnt = cj.cnt + 1 == CV_PERIOD ? 0 : cj.cnt + 1;     \
    if (iss_) { cv_issue(p, cj.it, lane, cvbuf + cj.pi * CV_BUF); cj.it += cj.stride; ++cj.nfl; cj.pi ^= 1; } \
    cj.prev = iss_; A2_SBAR(); \
    const int t_ = (T); const bool gk_ = t_ + 3 < NT, gv_ = t_ + 1 < NT, nc_ = t_ + 1 >= nlocp; \
    const ATT_LAS unsigned char* vp_ = vp0 + sl_prev + bs * 128; const ATT_LAS unsigned char* vq_ = (const ATT_LAS unsigned char*)(lds_addr(vp0) ^ 64u) + sl_prev + bs * 128; \
    if (nc_) B2_KQ_CTX();                                                                                \
    float sacc = P0[0] + P0[1]; \
                        A2_GAPA(C0 = A2_MFMA(kf[0], qf[0], C0), P0[2], P0[3], P0[4], P0[5],     pw0[0] = A2_PKW(P0, 0),  pw0[1] = A2_PKW(P0, 2),  pw0); \
                        A2_GAPA(C0 = A2_MFMA(kf[2], qf[1], C0), P0[6], P0[7], P0[8], P0[9],     pw0[2] = A2_PKW(P0, 4),  pw0[3] = A2_PKW(P0, 6),  pw0); \
    B2_KRDL(nc_, 0);    A2_GAPA(C0 = A2_MFMA(kf[4], qf[2], C0), P0[10], P0[11], P0[12], P0[13], pw1[0] = A2_PKW(P0, 8),  pw1[1] = A2_PKW(P0, 10), pw1); \
    B2_KRDL(nc_, 1);    A2_GAPA(C0 = A2_MFMA(kf[6], qf[3], C0), P0[14], P0[15], 0.f, 0.f,       pw1[2] = A2_PKW(P0, 12), pw1[3] = A2_PKW(P0, 14), pw1); \
    l_run += sacc; \
    A2_VRD(0); A2_VRD(4); A2_SBAR(); \
    if (gk_) A2_DMA_K(U, t_ + 3, sl_cur); if (gv_) A2_DMA_V(U, t_ + 1, sl_next); \
    B2_DECIDE_L(C0); A2_SBAR(); \
    const ATT_LAS float* bpn_ = (const ATT_LAS float*)(ATT_LAS unsigned char*)(unsigned long long)B2_BP(t_ + 1); \
    B2_KRDL(nc_, 2); \
    A2_VRD(1); A2_SBAR(); if (!nc_) B2_CIN4(P0, bpn_, 0);  A2_GAPB(o0 = A2_MFMA(A2_PAF(0), A2_VFR(0), o0), C0, 0); \
    A2_VRD(5); A2_SBAR(); if (!nc_) B2_CIN4(P0, bpn_, 4);  A2_GAPB(o1 = A2_MFMA(A2_PAF(0), A2_VFR(4), o1), C0, 4); \
    B2_KRDL(nc_, 3);      if (!nc_) B2_CIN4(P0, bpn_, 8);  A2_GAPB(o0 = A2_MFMA(A2_PAF(1), A2_VFR(1), o0), C0, 8); \
                          if (!nc_) B2_CIN4(P0, bpn_, 12); A2_GAPB(o1 = A2_MFMA(A2_PAF(1), A2_VFR(5), o1), C0, 12); \
    A2_PIN(P0); \
    att_wait_bar((gk_ ? 1 : 0) + (gv_ ? 1 : 0) + (con_ ? 1 : 0) + (iss_ ? 4 : 0)); \
    A2_RESC(); A2_ROT(); } while (0)
#define B2_GAPA2(MF, a0, a1, W0, PW) do { MF; sacc += a0; sacc += a1; W0; A2_PIN(PW); A2_PIN(sacc); A2_SBAR(); } while (0)
#define B2_GAPB8(MF, X, i) do { MF; _Pragma("unroll") for (int q_ = 0; q_ < 8; ++q_) X[(i) + q_] = A2_EX(X[(i) + q_]); A2_PIN(X); A2_SBAR(); } while (0)
#define B2_STEP_LC(C0, C1, P0, T) do { A2_SBAR(); \
      \
    const bool con_ = cj.nfl == 2 || (cj.nfl > 0 && cj.it >= cj.end && !cj.prev);                          \
    if (con_) { cv_consume(p, cj.con, lane, cvbuf + cj.pc * CV_BUF); cj.con += cj.stride; --cj.nfl; cj.pc ^= 1; } \
    const bool iss_ = cj.it < cj.end && cj.nfl < 2 && cj.cnt < CV_DUTY; cj.cnt = cj.cnt + 1 == CV_PERIOD ? 0 : cj.cnt + 1;     \
    if (iss_) { cv_issue(p, cj.it, lane, cvbuf + cj.pi * CV_BUF); cj.it += cj.stride; ++cj.nfl; cj.pi ^= 1; } \
    cj.prev = iss_; A2_SBAR(); \
    const int t_ = (T); const bool gk_ = t_ + 3 < NT, gv_ = t_ + 1 < NT; \
    _Pragma("unroll") for (int r = 0; r < 16; ++r) negm[r] = -mref;                                     \
    A2_PIN(negm); \
    const ATT_LAS unsigned char* vp_ = vp0 + sl_prev + bs * 128; const ATT_LAS unsigned char* vq_ = (const ATT_LAS unsigned char*)(lds_addr(vp0) ^ 64u) + sl_prev + bs * 128; \
    float sacc = P0[0] + P0[1]; \
                    B2_GAPA2(C0 = A2_MFMA(kf[0], qf[0], negm), P0[2], P0[3],   pw0[0] = A2_PKW(P0, 0),  pw0); \
                    B2_GAPA2(C1 = A2_MFMA(kf[1], qf[0], negm), P0[4], P0[5],   pw0[1] = A2_PKW(P0, 2),  pw0); \
                    B2_GAPA2(C0 = A2_MFMA(kf[2], qf[1], C0),   P0[6], P0[7],   pw0[2] = A2_PKW(P0, 4),  pw0); \
    A2_KRD(gv_, 0); B2_GAPA2(C1 = A2_MFMA(kf[3], qf[1], C1),   P0[8], P0[9],   pw0[3] = A2_PKW(P0, 6),  pw0); \
                    B2_GAPA2(C0 = A2_MFMA(kf[4], qf[2], C0),   P0[10], P0[11], pw1[0] = A2_PKW(P0, 8),  pw1); \
    A2_KRD(gv_, 1); B2_GAPA2(C1 = A2_MFMA(kf[5], qf[2], C1),   P0[12], P0[13], pw1[1] = A2_PKW(P0, 10), pw1); \
                    B2_GAPA2(C0 = A2_MFMA(kf[6], qf[3], C0),   P0[14], P0[15], pw1[2] = A2_PKW(P0, 12), pw1); \
    A2_KRD(gv_, 2); B2_GAPA2(C1 = A2_MFMA(kf[7], qf[3], C1),   0.f, 0.f,       pw1[3] = A2_PKW(P0, 14), pw1); \
    l_run += sacc; \
    A2_VRD(0); A2_VRD(4); A2_SBAR(); \
    if (gk_) A2_DMA_K(U, t_ + 3, sl_cur); if (gv_) A2_DMA_V(U, t_ + 1, sl_next); \
    A2_DECIDE(C0, C1, 0); A2_SBAR(); \
    A2_KRD(gv_, 3); \
    A2_VRD(1); A2_SBAR(); B2_GAPB8(o0 = A2_MFMA(A2_PAF(0), A2_VFR(0), o0), C0, 0); \
    A2_VRD(5); A2_SBAR(); B2_GAPB8(o1 = A2_MFMA(A2_PAF(0), A2_VFR(4), o1), C0, 8); \
                          B2_GAPB8(o0 = A2_MFMA(A2_PAF(1), A2_VFR(1), o0), C1, 0); \
                          B2_GAPB8(o1 = A2_MFMA(A2_PAF(1), A2_VFR(5), o1), C1, 8); \
    att_wait_bar((gk_ ? 1 : 0) + (gv_ ? 1 : 0) + (con_ ? 1 : 0) + (iss_ ? 4 : 0)); \
    A2_RESC(); A2_ROT(); } while (0)
    const int nxt = unit + G; const bool has_next = nxt < 1024; B2U UN = b2_unit(has_next ? nxt : unit);
    int t = 1;
#pragma unroll 1
    for (; t + 1 < nlocp; t += 2) {
        B2_STEP_LL(pB0, pA0, t);
        B2_STEP_LL(pA0, pB0, t + 1);
    }
    B2_STEP_LC(pB0, pB1, pA0, t);
    A2_STEP(pA0, pA1, pB0, pB1, t + 1);
#pragma unroll 1
    for (int k = 0; k < 1; ++k) {
        A2_STEP(pB0, pB1, pA0, pA1, t + 2);
        A2_STEP(pA0, pA1, pB0, pB1, t + 3);
    }
    if (has_next) B2_OPEN(UN, sl_cur, par ^ 1);
    A2_DRAIN(pA0, pA1);
    { float x = l_run, y = l_run; asm volatile("s_nop 1\n\tv_permlane32_swap_b32 %0, %1" : "+v"(x), "+v"(y)); l_run = x + y; }
    const int le = lane_id(), he = le >> 5, re = le & 31;
    if (he == 0) wsf[32 + re] = l_run;
    asm volatile("s_waitcnt lgkmcnt(0)" ::: "memory");
    float inv[16];
#pragma unroll
    for (int g = 0; g < 4; ++g) { const f32x4 l4 = *(const ATT_LAS f32x4*)(wsf + 32 + 8 * g + 4 * he);
        inv[4 * g] = __builtin_amdgcn_rcpf(l4.x); inv[4 * g + 1] = __builtin_amdgcn_rcpf(l4.y); inv[4 * g + 2] = __builtin_amdgcn_rcpf(l4.z); inv[4 * g + 3] = __builtin_amdgcn_rcpf(l4.w); }
    asm volatile("; B2_EPI_BEGIN" ::: "memory");
    float ssq[2] = {0.f, 0.f};
    const size_t tok0 = (size_t)(U.b * L + qrw * 64 + 16 * half + (le >> 2));
    unsigned char* orow = ob + tok0 * D + ocol + (le & 3) * 8;
#pragma unroll
    for (int hh = 0; hh < 2; ++hh) {
#pragma unroll
        for (int r = 0; r < 16; r += 2) { const float a = (hh ? o1[r] : o0[r]) * inv[r] * O8_SCALE, a2 = (hh ? o1[r + 1] : o0[r + 1]) * inv[r + 1] * O8_SCALE;
            const int w8_ = __builtin_amdgcn_cvt_pk_fp8_f32(a, a2, 0, false);
            *(ATT_LAS unsigned char*)(stg + crow(r, he) * 32 + re) = (unsigned char)(w8_ & 0xff); *(ATT_LAS unsigned char*)(stg + crow(r + 1, he) * 32 + re) = (unsigned char)((w8_ >> 8) & 0xff); }
        asm volatile("s_waitcnt lgkmcnt(0)" ::: "memory");
#pragma unroll
        for (int i = 0; i < 2; ++i) { const u32x2 w = __builtin_bit_cast(u32x2, *(const ATT_LAS s16x4*)(stg + (i * 16 + (le >> 2)) * 32 + (le & 3) * 8));
            *(u32x2*)(orow + (size_t)(i * 64) * D + hh * 32) = w;
            float s = 0.f;
#pragma unroll
            for (int k = 0; k < 2; ++k) { typedef float f2q_ __attribute__((ext_vector_type(2))); const f2q_ l_ = __builtin_amdgcn_cvt_pk_f32_fp8((int)w[k], false), h_ = __builtin_amdgcn_cvt_pk_f32_fp8((int)w[k], true);
                s = fmaf(l_.x, l_.x, s); s = fmaf(l_.y, l_.y, s); s = fmaf(h_.x, h_.x, s); s = fmaf(h_.y, h_.y, s); }
            ssq[i] += s * (1.f / (O8_SCALE * O8_SCALE)); }
        asm volatile("s_waitcnt lgkmcnt(0)" ::: "memory");
    }
    { float* ossp = (float*)(p.ws + WS_OSS) + tok0 * 16 + (ocol >> 6);
#pragma unroll
      for (int i = 0; i < 2; ++i) { float s = ssq[i]; s += dppmov<0xB1>(s); s += dppmov<0x4E>(s);
          if ((le & 3) == 0) ossp[(size_t)(i * 64) * 16] = s; } }
    asm volatile("; B2_EPI_END" ::: "memory");
    if (!has_next) break;
    ATT_WAIT_BAR(6);
    unit = nxt; U = UN; rb = sl_cur; par ^= 1;
    }
    ATT_WAIT_BAR(0);
    cj.prev = false;
#undef B2_OPEN
#undef B2_KQ_CTX
#undef B2_KQ_LOC
#undef B2_BP
#undef B2_CINIT
#undef B2_NEGMASK
#undef B2_DECIDE_L
#undef B2_KRDL
#undef B2_CIN4
#undef B2_STEP_LL
#undef B2_GAPA2
#undef B2_GAPB8
#undef B2_STEP_LC
#undef A2_MODE
#undef A2_DMA_K
#undef A2_DMA_V
}

__device__ __forceinline__ void attn_phase(const Params& p, ATT_LAS unsigned char* lds, int wv) {
    const int G = gridDim.x, bx = blockIdx.x;
    const int vcu = (G % 8 == 0) ? (bx % 8) * (G / 8) + bx / 8 : bx;
    ConvJob cj; cj.stride = 8 * G; cj.it = bx * 8 + wv; cj.end = CV_ITEMS; cj.con = cj.it; cj.nfl = 0; cj.pi = 0; cj.pc = 0; cj.cnt = 0; cj.prev = false;
    attn_a2_units(p, lds, wv, cj, vcu, G);
    attn_b2_units(p, lds, wv, cj, vcu, G);
    { const int lane = lane_id(); ATT_LAS unsigned char* cvbuf = lds + LDS_CV + wv * CV_WAVE;
      asm volatile("s_waitcnt vmcnt(0)" ::: "memory");
      while (cj.nfl > 0) { cv_consume(p, cj.con, lane, cvbuf + cj.pc * CV_BUF); cj.con += cj.stride; --cj.nfl; cj.pc ^= 1; }
      while (cj.it < cj.end) { cv_issue(p, cj.it, lane, cvbuf); asm volatile("s_waitcnt vmcnt(0)" ::: "memory"); cv_consume(p, cj.it, lane, cvbuf); cj.it += cj.stride; } }
}
}

constexpr int SW_STRIDE = 36;

__device__ void p4c_post(const Params& p, LAS3 float* sW, int wv) {
    const int tid = tid_opaque(wv), lane = tid & 63;
    const float* mod = (const float*)(p.ws + WS_MOD); const bf16_t* mix = (const bf16_t*)(p.ws + WS_MIX);
    unsigned char* h8 = p.ws + WS_HB;
    bf16_t* x1b = (bf16_t*)(p.ws + WS_X1);
    unsigned* counts = (unsigned*)(p.ws + WS_CTL);
    int* eslot = (int*)(p.ws + WS_ESLOT); float* ew = (float*)(p.ws + WS_EW);
    const int wave = tid >> 6;
    LAS3 int* lcnt = (LAS3 int*)(sW + 1024 * SW_STRIDE) + 128;
    LAS3 int* lbase = lcnt + 32;
    LAS3 int* stg_slot = lbase + 32; LAS3 int* stg_e = stg_slot + 512; LAS3 float* stg_w = (LAS3 float*)(stg_e + 512);
    if (tid < NE) lcnt[tid] = 0;
    __syncthreads();
    constexpr int R = 16;
    const int m0 = ((int)blockIdx.x * (NTHREADS / 64) + wave) * R;
    if (m0 < NTOK) {
        const int b = m0 / L; const float* mb = mod + b * 6144;
        f32x4 pA[4], pB[4], pC[4], v[4], xx[4], nx[4]; u32x2 nv[4];
#pragma unroll
        for (int j = 0; j < 4; ++j) { const int c0 = 4 * (lane + 64 * j);
            pA[j] = *(const f32x4*)(p.g_post_mix + c0) * *(const f32x4*)(mb + 2048 + c0);
            pB[j] = *(const f32x4*)(p.g_pre_ffn + c0) * (*(const f32x4*)(mb + 4096 + c0) + 1.f);
            pC[j] = *(const f32x4*)(mb + 3072 + c0);
            nv[j] = ((const u32x2*)(mix + (size_t)m0 * D))[lane + 64 * j]; nx[j] = ((const f32x4*)(p.x + (size_t)m0 * D))[lane + 64 * j]; }
        const float brt0 = p.b_router[lane & 15], brt1 = p.b_router[16 + (lane & 15)];
#pragma unroll 1
        for (int it = 0; it < R; ++it) {
            const int m = m0 + it;
#pragma unroll
            for (int j = 0; j < 4; ++j) { v[j] = (f32x4){__uint_as_float(nv[j].x << 16), __uint_as_float(nv[j].x & 0xffff0000u), __uint_as_float(nv[j].y << 16), __uint_as_float(nv[j].y & 0xffff0000u)}; xx[j] = nx[j]; }
            if (it + 1 < R) {
#pragma unroll
                for (int j = 0; j < 4; ++j) { nv[j] = ((const u32x2*)(mix + (size_t)(m + 1) * D))[lane + 64 * j]; nx[j] = ((const f32x4*)(p.x + (size_t)(m + 1) * D))[lane + 64 * j]; }
            }
            float s = 0.f;
#pragma unroll
            for (int j = 0; j < 4; ++j) s += v[j].x * v[j].x + v[j].y * v[j].y + v[j].z * v[j].z + v[j].w * v[j].w;
            float rstd = rsqrtf(wave_sum(s) * (1.f / D) + EPS);
            s = 0.f;
            f32x4 xv[4];
#pragma unroll
            for (int j = 0; j < 4; ++j) {
                xv[j] = xx[j] + pA[j] * (v[j] * rstd);
                { u32x2 w_; w_.x = pk2(xv[j].x, xv[j].y); w_.y = pk2(xv[j].z, xv[j].w); ((u32x2*)(x1b + (size_t)m * D))[lane + 64 * j] = w_; }
                s += xv[j].x * xv[j].x + xv[j].y * xv[j].y + xv[j].z * xv[j].z + xv[j].w * xv[j].w; }
            rstd = rsqrtf(wave_sum(s) * (1.f / D) + EPS);
            f32x4 h2v[4];
#pragma unroll
            for (int j = 0; j < 4; ++j) { const int c0 = 4 * (lane + 64 * j);
                h2v[j] = (xv[j] * rstd) * pB[j] + pC[j];
                *(unsigned*)(h8 + (size_t)m * D + c0) = pk4_fp8(h2v[j].x, h2v[j].y, h2v[j].z, h2v[j].w); }
            const int li = lane & 15;
            typedef float f32x2 __attribute__((ext_vector_type(2)));
            LAS3 unsigned char* lb0 = (LAS3 unsigned char*)sW + lane * (SW_STRIDE * 4); LAS3 unsigned char* lb1 = lb0 + 49152; LAS3 unsigned char* lb2 = lb0 + 98304;
            asm volatile("" : "+v"(lb0), "+v"(lb1), "+v"(lb2));
            float zz[2];
#pragma unroll
            for (int ps = 0; ps < 2; ++ps) {
                f32x2 lg2[8];
#pragma unroll
                for (int e = 0; e < 8; ++e) lg2[e] = (f32x2){0.f, 0.f};
#define P4C_WADDR(g) ((((((g) & 3) * 256 + 64 * ((g) >> 2)) * SW_STRIDE * 4 + ps * 64) < 49152 ? lb0 : ((((g) & 3) * 256 + 64 * ((g) >> 2)) * SW_STRIDE * 4 + ps * 64) < 98304 ? lb1 : lb2) + \
                      (((((g) & 3) * 256 + 64 * ((g) >> 2)) * SW_STRIDE * 4 + ps * 64) % 49152))
#define P4C_LOADW(W, g) do { const LAS3 f32x4* wr_ = (const LAS3 f32x4*)P4C_WADDR(g); W[0] = wr_[0]; W[1] = wr_[1]; W[2] = wr_[2]; W[3] = wr_[3]; } while (0)
#define P4C_FMAS(W, g) do { const float hv_ = h2v[(g) >> 2][(g) & 3]; const f32x2 hv2_ = {hv_, hv_}; \
                    _Pragma("unroll") for (int e4 = 0; e4 < 4; ++e4) { lg2[2 * e4] = __builtin_elementwise_fma(hv2_, (f32x2){W[e4].x, W[e4].y}, lg2[2 * e4]); lg2[2 * e4 + 1] = __builtin_elementwise_fma(hv2_, (f32x2){W[e4].z, W[e4].w}, lg2[2 * e4 + 1]); } \
                    asm volatile("" : "+v"(lg2[0]), "+v"(lg2[1]), "+v"(lg2[2]), "+v"(lg2[3]), "+v"(lg2[4]), "+v"(lg2[5]), "+v"(lg2[6]), "+v"(lg2[7]) :: "memory"); } while (0)
                f32x4 wA[4], wB[4];
                P4C_LOADW(wA, 0);
#pragma unroll
                for (int g = 0; g < 16; g += 2) {
                    P4C_LOADW(wB, g + 1); P4C_FMAS(wA, g);
                    if (g + 2 < 16) P4C_LOADW(wA, g + 2);
                    P4C_FMAS(wB, g + 1); }
#undef P4C_WADDR
#undef P4C_LOADW
#undef P4C_FMAS
                float lg[16];
#pragma unroll
                for (int e = 0; e < 16; ++e) lg[e] = lg2[e >> 1][e & 1];
                float w8[8], w4[4], w2[2], z;
                { const bool up = li >= 8;
#pragma unroll
                  for (int j = 0; j < 8; ++j) { const float keep = up ? lg[8 + j] : lg[j], send = up ? lg[j] : lg[8 + j]; w8[j] = keep + dppmov<0x140>(send); } }
                { const bool up = (li & 7) >= 4;
#pragma unroll
                  for (int j = 0; j < 4; ++j) { const float keep = up ? w8[4 + j] : w8[j], send = up ? w8[j] : w8[4 + j]; w4[j] = keep + dppmov<0x141>(send); } }
                { const bool up = (li & 2) != 0;
#pragma unroll
                  for (int j = 0; j < 2; ++j) { const float keep = up ? w4[2 + j] : w4[j], send = up ? w4[j] : w4[2 + j]; w2[j] = keep + dppmov<0x4E>(send); } }
                { const bool up = (li & 1) != 0; const float keep = up ? w2[1] : w2[0], send = up ? w2[0] : w2[1]; z = keep + dppmov<0xB1>(send); }
                z += __shfl_xor(z, 16); z += __shfl_xor(z, 32);
                zz[ps] = z;
            }
            float z0 = zz[0] + brt0, z1 = zz[1] + brt1;
            float tv[4]; int ti[4];
#pragma unroll
            for (int k = 0; k < 4; ++k) {
                const bool first = z0 >= z1; const float bv = first ? z0 : z1;
                float mx = fmaxf(bv, dppmov<0xB1>(bv)); mx = fmaxf(mx, dppmov<0x4E>(mx)); mx = fmaxf(mx, dppmov<0x141>(mx)); mx = fmaxf(mx, dppmov<0x140>(mx));
                int ce = (bv == mx) ? (first ? li : 16 + li) : 99;
                { int o = __builtin_amdgcn_update_dpp(0, ce, 0xB1, 0xf, 0xf, true); ce = ce < o ? ce : o; o = __builtin_amdgcn_update_dpp(0, ce, 0x4E, 0xf, 0xf, true); ce = ce < o ? ce : o;
                  o = __builtin_amdgcn_update_dpp(0, ce, 0x141, 0xf, 0xf, true); ce = ce < o ? ce : o; o = __builtin_amdgcn_update_dpp(0, ce, 0x140, 0xf, 0xf, true); ce = ce < o ? ce : o; }
                ti[k] = __builtin_amdgcn_readfirstlane(ce); tv[k] = mx;
                { const bool mine = li == (ti[k] & 15); z0 = (mine && ti[k] < 16) ? -3.4e38f : z0; z1 = (mine && ti[k] >= 16) ? -3.4e38f : z1; }
            }
            const float e1 = __expf(tv[1] - tv[0]), e2 = __expf(tv[2] - tv[0]), e3 = __expf(tv[3] - tv[0]); const float inv = 1.f / (1.f + e1 + e2 + e3);
            const float tw[4] = {inv, e1 * inv, e2 * inv, e3 * inv};
            if (lane < 4) {
                int myi = ti[0]; float myw = tw[0];
#pragma unroll
                for (int k = 1; k < 4; ++k) if (lane == k) { myi = ti[k]; myw = tw[k]; }
                const int lr = __hip_atomic_fetch_add((LAS3 int*)&lcnt[myi], 1, __ATOMIC_RELAXED, __HIP_MEMORY_SCOPE_WORKGROUP);
                const int si = (wave * 16 + it) * 4 + lane;
                stg_slot[si] = m * 4 + lane; stg_e[si] = myi | (lr << 8); stg_w[si] = myw;
            }
        }
    }
    __syncthreads();
    if (tid < NE) { const int c = lcnt[tid]; lbase[tid] = c ? (int)atomicAdd(&counts[tid * 64], (unsigned)c) : 0; }
    __syncthreads();
    { const int si = tid, w = si >> 6;
      if (((int)blockIdx.x * (NTHREADS / 64) + w) * R < NTOK) {
        const int ee = stg_e[si], e = ee & 255, lr = ee >> 8; const int rank = lbase[e] + lr;
        eslot[(size_t)e * ECAP + rank] = stg_slot[si]; ew[(size_t)e * ECAP + rank] = stg_w[si]; } }
    __syncthreads();
}
__device__ __forceinline__ void expert_bases(const unsigned* counts, int* sbase_  , int wv) {
    LAS3 int* sbase = (LAS3 int*)sbase_;
    if (wv == 0) {
        const int lane = lane_id(); const int cn = lane < NE ? (int)counts[lane * 64] : 0; const int c = (cn + 255) & ~255;
        int incl = c;
#pragma unroll
        for (int o = 1; o < 32; o <<= 1) { const int v = __shfl_up(incl, o); if (lane >= o) incl += v; }
        if (lane < NE) { sbase[lane] = incl - c; sbase[40 + lane] = cn; }
        if (lane == NE - 1) sbase[NE] = incl;
    }
    __syncthreads();
}
typedef float f32x2v __attribute__((ext_vector_type(2)));
__device__ __forceinline__ void p6_load(const unsigned char* y, const bf16_t* x1b, int m, int lane, unsigned (&yv)[4][4], u32x2 (&xv)[4]) {
#pragma unroll
    for (int j = 0; j < 4; ++j) { const int c0 = 4 * (lane + 64 * j);
#pragma unroll
        for (int k = 0; k < 4; ++k) yv[j][k] = *(const unsigned*)(y + (size_t)(m * 4 + k) * D + c0);
        xv[j] = *(const u32x2*)(x1b + (size_t)m * D + c0); }
}
__device__ void p6_final(const Params& p, int wv) {
    const int tid = tid_opaque(wv), lane = tid & 63;
    const float* mod = (const float*)(p.ws + WS_MOD); const unsigned char* y = p.ws + WS_Y;
    constexpr int R = 16;
    const int m0 = ((int)blockIdx.x * (NTHREADS / 64) + (tid >> 6)) * R;
    if (m0 >= NTOK) return;
    const int b = m0 / L; const float* ga2 = mod + b * 6144 + 5120;
    f32x4 pA[4];
#pragma unroll
    for (int j = 0; j < 4; ++j) { const int c0 = 4 * (lane + 64 * j); pA[j] = *(const f32x4*)(p.g_post_ffn + c0) * *(const f32x4*)(ga2 + c0); }
    unsigned yv[4][4], ny[4][4]; u32x2 xv[4], nx[4]; const bf16_t* x1b = (const bf16_t*)(p.ws + WS_X1);
    p6_load(y, x1b, m0, lane, ny, nx);
    for (int it = 0; it < R; ++it) {
        const int m = m0 + it;
#pragma unroll
        for (int j = 0; j < 4; ++j) {
#pragma unroll
            for (int k = 0; k < 4; ++k) yv[j][k] = ny[j][k];
            xv[j] = nx[j]; }
        if (it + 1 < R) p6_load(y, x1b, m + 1, lane, ny, nx);
        f32x4 a[4]; float s = 0.f;
#pragma unroll
        for (int j = 0; j < 4; ++j) { a[j] = (f32x4){0.f, 0.f, 0.f, 0.f};
#pragma unroll
            for (int k = 0; k < 4; ++k) { const unsigned w = yv[j][k];
                const f32x2v l0 = __builtin_amdgcn_cvt_pk_f32_fp8((int)w, false), l1 = __builtin_amdgcn_cvt_pk_f32_fp8((int)w, true);
                a[j].x += l0.x; a[j].y += l0.y; a[j].z += l1.x; a[j].w += l1.y; }
            a[j] = a[j] * Y8_INV; s += a[j].x * a[j].x + a[j].y * a[j].y + a[j].z * a[j].z + a[j].w * a[j].w; }
        const float rstd = rsqrtf(wave_sum(s) * (1.f / D) + EPS);
#pragma unroll
        for (int j = 0; j < 4; ++j) { const int c0 = 4 * (lane + 64 * j);
            const f32x4 x1v = {__uint_as_float(xv[j].x << 16), __uint_as_float(xv[j].x & 0xffff0000u), __uint_as_float(xv[j].y << 16), __uint_as_float(xv[j].y & 0xffff0000u)};
            *(f32x4*)(p.out + (size_t)m * D + c0) = x1v + pA[j] * (a[j] * rstd); }
    }
}

constexpr int LDS_SBASE = 147456;
constexpr int LDS_BYTES = LDS_SBASE + 512 + (64 + 3 * 512) * 4 + 256;

__global__ void __launch_bounds__(NTHREADS, 2) fwd_kernel(Params p_arg) {
#if defined(__HIP_DEVICE_COMPILE__)
#define PHASE_ARGS() const Params p = *(const __attribute__((address_space(4))) Params*)__builtin_amdgcn_kernarg_segment_ptr()
#else
#define PHASE_ARGS() const Params& p = p_arg
#endif
    cg::grid_group grid = cg::this_grid();
    extern __shared__ __attribute__((aligned(16))) unsigned char lds[];
    int* sbase = (int*)(lds + LDS_SBASE);
    PG8_LAS unsigned char* lds3 = (PG8_LAS unsigned char*)lds;
    const PG8_LAS int* sbase3 = (const PG8_LAS int*)(lds3 + LDS_SBASE);
    volatile LAS3 unsigned* bst = (volatile LAS3 unsigned*)(lds3 + LDS_SBASE + 384);
    const int wv = __builtin_amdgcn_readfirstlane((int)(threadIdx.x >> 6));
    if (wv == 0 && lane_id() < 2) bst[lane_id()] = 0u;
    __syncthreads();
    XcdBarrier xb = xcd_barrier_post((unsigned*)(p_arg.ws + WS_CTL) + CW_BAR, bst, wv);

    { PHASE_ARGS();
    p0_mod(p, (float*)lds, (float*)(lds + 36864), wv);
    p0_tab(p, wv);
    p0_weights(p, lds, wv);
    if (p.ws == nullptr) grid.sync(); }
    xcd_barrier(xb);
    { PHASE_ARGS(); p1_h(p, wv); }
    { PHASE_ARGS(); const f32x4* tabg = (const f32x4*)(p.ws + WS_TAB);
      xcd_barrier_side(xb, [&]() { for (int t_ = tid_opaque(wv) - 64; t_ < 512; t_ += NTHREADS - 64) *(PG8_LAS f32x4*)(lds3 + pg8::PAR_TAB + t_ * 16) = tabg[t_]; }); }
    { PHASE_ARGS(); pg8::Gemm g{(const bf16_t*)(p.ws + WS_HB), (const bf16_t*)(p.ws + WS_WIN), D / 2, 0, nullptr, sbase3, wv};
      pg8::StaticOrder S; S.init(MROWS, INW, (int)gridDim.x, (int)blockIdx.x, nullptr);
      pg8::EpiQKV E{(bf16_t*)(p.ws + WS_QKV)};
      pg8::gemm_phase<pg8::EpiQKV, pg8::StaticOrder, false, true, true>(lds3, g, S, E); }
    xcd_barrier(xb);
    { PHASE_ARGS(); att::attn_phase(p, lds3, wv); }
    xcd_barrier(xb);
    { PHASE_ARGS(); pg8::Gemm g{(const bf16_t*)(p.ws + WS_O), (const bf16_t*)(p.ws + WS_WOUT), D / 2, 0, nullptr, sbase3, wv};
      pg8::StaticOrder S; S.init(NTOK, D, (int)gridDim.x, (int)blockIdx.x, nullptr);
      pg8::EpiOutProj E{(bf16_t*)(p.ws + WS_MIX), (const float*)(p.ws + WS_OSS)};
      pg8::gemm_phase<pg8::EpiOutProj, pg8::StaticOrder, false, true, true>(lds3, g, S, E); }
    { PHASE_ARGS(); const f32x4* wrg = (const f32x4*)p.w_router; LAS3 float* sW_ = (LAS3 float*)lds3;
      xcd_barrier_side(xb, [&]() {
          const int t7 = tid_opaque(wv) - 64; f32x4 w_[19];
#pragma unroll
          for (int j = 0; j < 19; ++j) { const int i = t7 + (NTHREADS - 64) * j; w_[j] = wrg[i < 8192 ? i : 8191]; }
#pragma unroll
          for (int j = 0; j < 19; ++j) { const int i = t7 + (NTHREADS - 64) * j, k = i >> 3, e4 = i & 7;
              if (i < 8192) *(LAS3 f32x4*)(sW_ + ((k & 3) * 256 + (k >> 2)) * SW_STRIDE + e4 * 4) = w_[j]; } }); }
    { PHASE_ARGS(); p4c_post(p, (LAS3 float*)lds3, wv); }
    xcd_barrier(xb);
    { PHASE_ARGS(); expert_bases((const unsigned*)(p.ws + WS_CTL), sbase, wv);
      const int total = sbase3[NE];
      pg8::Gemm g{(const bf16_t*)(p.ws + WS_HB), (const bf16_t*)(p.ws + WS_W1), D / 2, (size_t)2048 * D, (const int*)(p.ws + WS_ESLOT), sbase3, wv};
      pg8::StaticOrder S; S.init(total, 2048, (int)gridDim.x, (int)blockIdx.x, sbase3);
      const int G_ = (int)gridDim.x, R1 = (S.nwg + G_ - 1) / G_;
      unsigned* ctl = (unsigned*)(p.ws + WS_CTL);
      const unsigned nloc_ = xb.st[0];
      if (R1 < 2) { __syncthreads(); dep_arrive(ctl + CW_DEP_E, nloc_, xb.x, wv); }
      pg8::EpiSwiglu E{p.ws + WS_ACT, p.b_mlp1, ctl + CW_DEP_E, R1 - 2, nloc_, xb.x};
      pg8::gemm_phase<pg8::EpiSwiglu, pg8::StaticOrder, true, true, true>(lds3, g, S, E);
      __syncthreads(); dep_arrive(ctl + CW_DEP_F, nloc_, xb.x, wv); }
    { PHASE_ARGS(); const int total = sbase3[NE];
      pg8::Gemm g{(const bf16_t*)(p.ws + WS_ACT), (const bf16_t*)(p.ws + WS_W2), D / 2, (size_t)D * D, nullptr, sbase3, wv};
      const int G_ = (int)gridDim.x, nwg1 = (total / pg8::BM) * (2048 / pg8::BM), R1 = (nwg1 + G_ - 1) / G_, r1 = nwg1 % G_;
      pg8::DepOrder S; S.S.init(total, D, G_, ((int)blockIdx.x + G_ - r1) % G_, sbase3);
      S.ctrE = (unsigned*)(p.ws + WS_CTL) + CW_DEP_E; S.ctrF = (unsigned*)(p.ws + WS_CTL) + CW_DEP_F; S.nwg1 = nwg1; S.R1 = R1; S.wv = wv; S.haveE = false; S.haveF = false;
      pg8::EpiScatter E{p.ws + WS_Y, p.b_mlp2, (const int*)(p.ws + WS_ESLOT), (const float*)(p.ws + WS_EW), sbase3};
      pg8::gemm_phase<pg8::EpiScatter, pg8::DepOrder, false, true, true>(lds3, g, S, E); }
    xcd_barrier(xb);
    { PHASE_ARGS(); p6_final(p, wv); }
#undef PHASE_ARGS
}

extern "C" void kernel_launch(void* const* d_in, const int* in_sizes, int n_in, void* d_out, int out_size, void* d_ws, size_t ws_size, hipStream_t stream) {
    static int grid_blocks = 0;
    if (grid_blocks == 0) {
        if (n_in != 22 || ws_size < WS_END) { fprintf(stderr, "kernel_launch: unexpected n_in %d / ws_size %zu (need %zu)\n", n_in, ws_size, (size_t)WS_END); grid_blocks = -1; return; }
        int dev = 0, cus = 0, per_cu = 0;
        (void)hipGetDevice(&dev);
        (void)hipDeviceGetAttribute(&cus, hipDeviceAttributeMultiprocessorCount, dev);
        if (hipFuncSetAttribute((const void*)fwd_kernel, hipFuncAttributeMaxDynamicSharedMemorySize, LDS_BYTES) != hipSuccess) { fprintf(stderr, "kernel_launch: hipFuncSetAttribute failed\n"); grid_blocks = -1; return; }
        (void)hipOccupancyMaxActiveBlocksPerMultiprocessor(&per_cu, (const void*)fwd_kernel, NTHREADS, LDS_BYTES);
        if (per_cu < 1) { fprintf(stderr, "kernel_launch: occupancy query returned %d\n", per_cu); grid_blocks = -1; return; }
        grid_blocks = cus;
        if (grid_blocks * (NTHREADS / 64) * 16 < NTOK) { fprintf(stderr, "kernel_launch: needs >= 256 CUs (got %d)\n", cus); grid_blocks = -1; return; }
    }
    if (grid_blocks < 0) return;
    (void)hipMemsetAsync((char*)d_ws + WS_CTL, 0, CTL_BYTES, stream);
    Params p{};
    const float** pp = (const float**)&p;
    for (int i = 0; i < 22; ++i) pp[i] = (const float*)d_in[i];
    p.out = (float*)d_out; p.ws = (unsigned char*)d_ws;
    void* args[] = {&p};
    hipError_t e = hipLaunchCooperativeKernel((const void*)fwd_kernel, dim3(grid_blocks), dim3(NTHREADS), args, LDS_BYTES, stream);
    if (e != hipSuccess) fprintf(stderr, "cooperative launch failed: %s (grid %d)\n", hipGetErrorString(e), grid_blocks);
}
```
